# Optimizing an MI355X kernel written in HIP

```python
import math
import jax, jax.numpy as jnp
from jax import lax
import numpy as np

D_MODEL = 2048
BATCH = 4
SEQ = 2048
DEPTH = 2

CTX_LEN = 256
GRID_W = 64
N_MIXERS = 2
N_ATTN_LAYERS = (DEPTH + N_MIXERS - 1) // N_MIXERS
N_HYENA_LAYERS = DEPTH // N_MIXERS

HEAD_DIM = 128
N_HEADS = D_MODEL // HEAD_DIM
N_KV_HEADS = N_HEADS // 4
GQA_GROUP = N_HEADS // N_KV_HEADS
ATTN_WIDTH = N_HEADS * HEAD_DIM
KV_WIDTH = N_KV_HEADS * HEAD_DIM
ATTN_IN = 2 * ATTN_WIDTH + 2 * KV_WIDTH
WINDOW = 128
BLOCK = 128
ROPE_BASE = 10000.0

HYENA_WIDTH = D_MODEL
HYENA_ORDER = 2
HYENA_IN = (HYENA_ORDER + 2) * HYENA_WIDTH
SHORT_CONV = 3
FILTER_EMB = 33
FILTER_HIDDEN = 64
DECAY_FAST = 0.3
DECAY_SLOW = 1.5
DECAY_TARGET = 1e-2
WINDOW_SHIFT = 0.05

NORM_EPS = 1e-6
NEG_INF = -1e30

kernel_name = "hybrid_swa_hyena_prefix_dit"


def rms_norm(x, g):
    x32 = x.astype(jnp.float32)
    y = x32 * lax.rsqrt(jnp.mean(x32 * x32, axis=-1, keepdims=True) + NORM_EPS)
    return (y * g.astype(jnp.float32)).astype(x.dtype)


def modulate(h, shift, scale):
    return h * (1.0 + scale) + shift


def axial_rope_tables(S):
    rows = S // GRID_W
    row = jnp.repeat(jnp.arange(rows), GRID_W).astype(jnp.float32)
    col = jnp.tile(jnp.arange(GRID_W), rows).astype(jnp.float32)
    half = HEAD_DIM // 2
    inv = ROPE_BASE ** (-jnp.arange(0, half, 2, dtype=jnp.float32) / half)
    ang = jnp.stack([row[:, None] * inv[None], col[:, None] * inv[None]], axis=1)
    return jnp.cos(ang), jnp.sin(ang)


def apply_axial_rope(t, cos, sin):
    B, S, nh, _ = t.shape
    half = HEAD_DIM // 2
    q = half // 2
    seg = t.astype(jnp.float32).reshape(B, S, nh, 2, half)
    a, b = seg[..., :q], seg[..., q:]
    cs = cos[None, :, None]
    sn = sin[None, :, None]
    out = jnp.concatenate([a * cs - b * sn, b * cs + a * sn], axis=-1)
    return out.reshape(t.shape).astype(t.dtype)


def _band(t, nb):
    B = t.shape[0]
    tb = t.reshape(B, nb, BLOCK, t.shape[2], t.shape[3])
    tp = jnp.pad(tb, ((0, 0), (1, 1), (0, 0), (0, 0), (0, 0)))
    return jnp.concatenate([tp[:, :-2], tp[:, 1:-1], tp[:, 2:]], axis=2)


def banded_attention(q, k, v, kc, vc, sink):
    B, S = q.shape[0], q.shape[1]
    C = kc.shape[1]
    nb = S // BLOCK
    scale = HEAD_DIM ** -0.5
    qb = q.reshape(B, nb, BLOCK, N_KV_HEADS, GQA_GROUP, HEAD_DIM)
    kb = _band(k, nb)
    vb = _band(v, nb)
    s_loc = jnp.einsum("bnqkgd,bnskd->bnkgqs", qb, kb).astype(jnp.float32) * scale
    qpos = jnp.arange(nb)[:, None] * BLOCK + jnp.arange(BLOCK)[None]
    kpos = jnp.arange(nb)[:, None] * BLOCK - BLOCK + jnp.arange(3 * BLOCK)[None]
    rel = kpos[:, None, :] - qpos[:, :, None]
    valid = (jnp.abs(rel) <= WINDOW) & (kpos[:, None, :] >= 0) & (kpos[:, None, :] < S)
    s_loc = jnp.where(valid[None, :, None, None], s_loc, NEG_INF)
    s_ctx = jnp.einsum("bnqkgd,bckd->bnkgqc", qb, kc).astype(jnp.float32) * scale
    sk = sink.astype(jnp.float32).reshape(N_KV_HEADS, GQA_GROUP)[None, None, :, :, None, None]
    s_sink = jnp.broadcast_to(sk, s_loc.shape[:-1] + (1,))
    p = jax.nn.softmax(jnp.concatenate([s_loc, s_ctx, s_sink], axis=-1), axis=-1).astype(v.dtype)
    nl = 3 * BLOCK
    o = (jnp.einsum("bnkgqs,bnskd->bnqkgd", p[..., :nl], vb)
         + jnp.einsum("bnkgqc,bckd->bnqkgd", p[..., nl:nl + C], vc))
    return o.reshape(B, S, ATTN_WIDTH)


def context_attention(qc, kc, vc, sink):
    B, C = qc.shape[0], qc.shape[1]
    scale = HEAD_DIM ** -0.5
    qg = qc.reshape(B, C, N_KV_HEADS, GQA_GROUP, HEAD_DIM)
    s = jnp.einsum("bqkgd,bskd->bkgqs", qg, kc).astype(jnp.float32) * scale
    sk = sink.astype(jnp.float32).reshape(N_KV_HEADS, GQA_GROUP)[None, :, :, None, None]
    s_sink = jnp.broadcast_to(sk, s.shape[:-1] + (1,))
    p = jax.nn.softmax(jnp.concatenate([s, s_sink], axis=-1), axis=-1).astype(vc.dtype)
    o = jnp.einsum("bkgqs,bskd->bqkgd", p[..., :C], vc)
    return o.reshape(B, C, ATTN_WIDTH)


def attention_layer(hx, hc, w_in, w_out, sink, cos, sin, ctx_out):
    B, S, _ = hx.shape
    C = hc.shape[1]
    px = hx @ w_in
    q = px[..., :ATTN_WIDTH].reshape(B, S, N_HEADS, HEAD_DIM)
    k = px[..., ATTN_WIDTH:ATTN_WIDTH + KV_WIDTH].reshape(B, S, N_KV_HEADS, HEAD_DIM)
    v = px[..., ATTN_WIDTH + KV_WIDTH:ATTN_WIDTH + 2 * KV_WIDTH].reshape(B, S, N_KV_HEADS, HEAD_DIM)
    g = px[..., ATTN_WIDTH + 2 * KV_WIDTH:]
    q = apply_axial_rope(q, cos, sin)
    k = apply_axial_rope(k, cos, sin)
    if ctx_out:
        pc = hc @ w_in
        kvc = pc[..., ATTN_WIDTH:ATTN_WIDTH + 2 * KV_WIDTH]
    else:
        kvc = hc @ w_in[:, ATTN_WIDTH:ATTN_WIDTH + 2 * KV_WIDTH]
    kc = kvc[..., :KV_WIDTH].reshape(B, C, N_KV_HEADS, HEAD_DIM)
    vc = kvc[..., KV_WIDTH:].reshape(B, C, N_KV_HEADS, HEAD_DIM)
    o = banded_attention(q, k, v, kc, vc, sink)
    out_x = (o * jax.nn.silu(g)) @ w_out
    out_c = None
    if ctx_out:
        qc = pc[..., :ATTN_WIDTH].reshape(B, C, N_HEADS, HEAD_DIM)
        gc = pc[..., ATTN_WIDTH + 2 * KV_WIDTH:]
        oc = context_attention(qc, kc, vc, sink)
        out_c = (oc * jax.nn.silu(gc)) @ w_out
    return out_x, out_c


def short_conv(u, w, b):
    L = u.shape[1]
    pad = SHORT_CONV // 2
    up = jnp.pad(u, ((0, 0), (pad, pad), (0, 0)))
    y = up[:, 0:L] * w[0]
    for j in range(1, SHORT_CONV):
        y = y + up[:, j:j + L] * w[j]
    return y + b


def implicit_filters(L, w1, b1, w2, b2, w3, b3, freq):
    f32 = jnp.float32
    t = jnp.linspace(0.0, 1.0, L, dtype=f32)[:, None]
    bands = (FILTER_EMB - 1) // 2
    w = 2.0 * math.pi * jnp.arange(L, dtype=f32) / L
    fr = jnp.linspace(1e-4, bands - 1, bands, dtype=f32)
    ang = w[:, None] * fr[None]
    z = jnp.concatenate([t, jnp.cos(ang), -jnp.sin(ang)], axis=-1)
    fq = freq.astype(f32)
    hid = jnp.sin(fq * (z @ w1.astype(f32) + b1.astype(f32)))
    hid = jnp.sin(fq * (hid @ w2.astype(f32) + b2.astype(f32)))
    hf = (hid @ w3.astype(f32) + b3.astype(f32)).reshape(L, HYENA_ORDER, 2, HYENA_WIDTH)
    max_decay = math.log(DECAY_TARGET) / DECAY_FAST
    min_decay = math.log(DECAY_TARGET) / DECAY_SLOW
    deltas = jnp.linspace(min_decay, max_decay, HYENA_WIDTH, dtype=f32)
    window = jnp.exp(-t * jnp.abs(deltas)[None])[:, None, None, :] + WINDOW_SHIFT
    return hf * window


def bidir_long_conv(u, h_fwd, h_bwd, d):
    L = u.shape[1]
    k = jnp.concatenate([h_fwd, jnp.zeros((1, h_fwd.shape[1]), jnp.float32), h_bwd[1:][::-1]], axis=0)
    u32 = u.astype(jnp.float32)
    U = jnp.fft.rfft(u32, n=2 * L, axis=1)
    K = jnp.fft.rfft(k, n=2 * L, axis=0)
    y = jnp.fft.irfft(U * K[None], n=2 * L, axis=1)[:, :L]
    return (y + u32 * d.astype(jnp.float32)).astype(u.dtype)


def hyena_branch(h, w_in, conv_w, conv_b, w1, b1, w2, b2, w3, b3, freq, bias_d, w_out):
    L = h.shape[1]
    p = h @ w_in
    u = short_conv(p[..., :3 * HYENA_WIDTH], conv_w, conv_b)
    g = p[..., 3 * HYENA_WIDTH:]
    x1 = u[..., :HYENA_WIDTH]
    x2 = u[..., HYENA_WIDTH:2 * HYENA_WIDTH]
    v = u[..., 2 * HYENA_WIDTH:]
    filt = implicit_filters(L, w1, b1, w2, b2, w3, b3, freq)
    z = x1 * bidir_long_conv(v, filt[:, 0, 0], filt[:, 0, 1], bias_d[0])
    y = x2 * bidir_long_conv(z, filt[:, 1, 0], filt[:, 1, 1], bias_d[1])
    return (y * jax.nn.silu(g)) @ w_out


def setup_inputs(seed: int = 0) -> dict:
    key = jax.random.key(seed)
    ks = jax.random.split(key, 24)
    D = D_MODEL
    nrm = jax.random.normal
    return {
        "x": nrm(ks[0], (BATCH, SEQ, D), jnp.float32),
        "c": nrm(ks[1], (BATCH, D), jnp.float32),
        "ctx": nrm(ks[2], (BATCH, CTX_LEN, D), jnp.float32),
        "c_ctx": nrm(ks[3], (D,), jnp.float32),
        "norm_g": 1.0 + 0.02 * nrm(ks[4], (DEPTH, D), jnp.float32),
        "ada_w": 0.5 * D ** -0.5 * nrm(ks[5], (DEPTH, D, 3 * D), jnp.float32),
        "ada_b": 0.02 * nrm(ks[6], (DEPTH, 3 * D), jnp.float32),
        "attn_w_in": D ** -0.5 * nrm(ks[7], (N_ATTN_LAYERS, D, ATTN_IN), jnp.float32),
        "attn_w_out": ATTN_WIDTH ** -0.5 * nrm(ks[8], (N_ATTN_LAYERS, ATTN_WIDTH, D), jnp.float32),
        "attn_sink": 0.5 * nrm(ks[9], (N_ATTN_LAYERS, N_HEADS), jnp.float32),
        "hy_w_in": D ** -0.5 * nrm(ks[10], (N_HYENA_LAYERS, D, HYENA_IN), jnp.float32),
        "hy_conv_w": SHORT_CONV ** -0.5 * nrm(ks[11], (N_HYENA_LAYERS, SHORT_CONV, 3 * HYENA_WIDTH), jnp.float32),
        "hy_conv_b": 0.02 * nrm(ks[12], (N_HYENA_LAYERS, 3 * HYENA_WIDTH), jnp.float32),
        "hy_w1": FILTER_EMB ** -0.5 * nrm(ks[13], (N_HYENA_LAYERS, FILTER_EMB, FILTER_HIDDEN), jnp.float32),
        "hy_b1": 0.02 * nrm(ks[14], (N_HYENA_LAYERS, FILTER_HIDDEN), jnp.float32),
        "hy_w2": FILTER_HIDDEN ** -0.5 * nrm(ks[15], (N_HYENA_LAYERS, FILTER_HIDDEN, FILTER_HIDDEN), jnp.float32),
        "hy_b2": 0.02 * nrm(ks[16], (N_HYENA_LAYERS, FILTER_HIDDEN), jnp.float32),
        "hy_w3": 0.05 * FILTER_HIDDEN ** -0.5 * nrm(ks[17], (N_HYENA_LAYERS, FILTER_HIDDEN, HYENA_ORDER * 2 * HYENA_WIDTH), jnp.float32),
        "hy_b3": 0.01 * nrm(ks[18], (N_HYENA_LAYERS, HYENA_ORDER * 2 * HYENA_WIDTH), jnp.float32),
        "hy_freq": 1.0 + 0.02 * nrm(ks[19], (N_HYENA_LAYERS, FILTER_HIDDEN), jnp.float32),
        "hy_bias_d": 0.1 * nrm(ks[20], (N_HYENA_LAYERS, HYENA_ORDER, HYENA_WIDTH), jnp.float32),
        "hy_w_out": HYENA_WIDTH ** -0.5 * nrm(ks[21], (N_HYENA_LAYERS, HYENA_WIDTH, D), jnp.float32),
        "final_g": 1.0 + 0.02 * nrm(ks[22], (D,), jnp.float32),
    }


def reference(x, c, ctx, c_ctx, norm_g, ada_w, ada_b, attn_w_in, attn_w_out, attn_sink,
              hy_w_in, hy_conv_w, hy_conv_b, hy_w1, hy_b1, hy_w2, hy_b2, hy_w3, hy_b3,
              hy_freq, hy_bias_d, hy_w_out, final_g):
    S = x.shape[1]
    cos, sin = axial_rope_tables(S)
    xc = ctx
    sc = jax.nn.silu(c)
    scc = jax.nn.silu(c_ctx)
    for i in range(DEPTH):
        li = i // N_MIXERS
        ctx_later = any(j % N_MIXERS == 0 for j in range(i + 1, DEPTH))
        mod = sc @ ada_w[i] + ada_b[i]
        shift, scale, gate = jnp.split(mod, 3, axis=-1)
        hx = modulate(rms_norm(x, norm_g[i]), shift[:, None], scale[:, None])
        if i % N_MIXERS == 0:
            mod_c = scc @ ada_w[i] + ada_b[i]
            shift_c, scale_c, gate_c = jnp.split(mod_c, 3, axis=-1)
            hc = modulate(rms_norm(xc, norm_g[i]), shift_c, scale_c)
            out_x, out_c = attention_layer(hx, hc, attn_w_in[li], attn_w_out[li], attn_sink[li],
                                           cos, sin, ctx_later)
            x = x + gate[:, None] * out_x
            if ctx_later:
                xc = xc + gate_c * out_c
        else:
            hp = (hy_w_in[li], hy_conv_w[li], hy_conv_b[li], hy_w1[li], hy_b1[li], hy_w2[li],
                  hy_b2[li], hy_w3[li], hy_b3[li], hy_freq[li], hy_bias_d[li], hy_w_out[li])
            x = x + gate[:, None] * hyena_branch(hx, *hp)
            if ctx_later:
                mod_c = scc @ ada_w[i] + ada_b[i]
                shift_c, scale_c, gate_c = jnp.split(mod_c, 3, axis=-1)
                hc = modulate(rms_norm(xc, norm_g[i]), shift_c, scale_c)
                xc = xc + gate_c * hyena_branch(hc, *hp)
    return rms_norm(x, final_g)
```

```cpp
#include <hip/hip_runtime.h>
#include <hip/hip_bf16.h>
#include <hip/hip_cooperative_groups.h>
#include <cstdio>
namespace cg = cooperative_groups;
typedef unsigned short u16;

#define NTHREADS 512
constexpr int Bn = 4, Sn = 2048, Dn = 2048, Cn = 256;
constexpr int MT = Bn * Sn;
constexpr int MC = Bn * Cn;
constexpr int ATTN_IN = 5120;
constexpr int HY_IN = 8192;

constexpr size_t OFF_WT_AI = 0;
constexpr size_t OFF_WT_AO = OFF_WT_AI + (size_t)5120 * 2048 * 2;
constexpr size_t OFF_WT_HI = OFF_WT_AO + (size_t)2048 * 2048 * 2;
constexpr size_t OFF_WT_HO = OFF_WT_HI + (size_t)8192 * 2048 * 2;
constexpr size_t OFF_MOD   = OFF_WT_HO + (size_t)2048 * 2048 * 2;
constexpr size_t OFF_ROPE  = OFF_MOD + (size_t)2 * 5 * 6144 * 4 + 256;
constexpr size_t OFF_FILT  = OFF_ROPE + (size_t)64 * 32 * 8;
constexpr size_t OFF_ACT   = OFF_FILT + (size_t)2 * 2048 * 4096 * 2;
constexpr size_t OFF_HC    = OFF_ACT + (size_t)8192 * 2048 * 2;
constexpr size_t OFF_KVC   = OFF_HC + (size_t)1024 * 2048 * 2;
constexpr size_t OFF_BIG   = OFF_KVC + (size_t)1024 * 1024 * 2;

struct Params {
  const float *x, *c, *ctx, *c_ctx, *norm_g, *ada_w, *ada_b, *attn_w_in, *attn_w_out, *attn_sink;
  const float *hy_w_in, *hy_conv_w, *hy_conv_b, *hy_w1, *hy_b1, *hy_w2, *hy_b2, *hy_w3, *hy_b3;
  const float *hy_freq, *hy_bias_d, *hy_w_out, *final_g;
  float* out;
  char* ws;
};

__device__ __forceinline__ u16 f2bf(float f) {
  unsigned u = __float_as_uint(f);
  u += 0x7fffu + ((u >> 16) & 1u);
  return (u16)(u >> 16);
}
__device__ __forceinline__ float bf2f(u16 h) { return __uint_as_float(((unsigned)h) << 16); }
__device__ __forceinline__ float bflo(unsigned w) { return __uint_as_float(w << 16); }
__device__ __forceinline__ float bfhi(unsigned w) { return __uint_as_float(w & 0xffff0000u); }
__device__ __forceinline__ float siluf(float v) { return v / (1.f + __expf(-v)); }
__device__ __forceinline__ float wave_sum(float v) {
#pragma unroll
  for (int o = 32; o > 0; o >>= 1) v += __shfl_xor(v, o, 64);
  return v;
}
__device__ __forceinline__ float wave_max(float v) {
#pragma unroll
  for (int o = 32; o > 0; o >>= 1) v = fmaxf(v, __shfl_xor(v, o, 64));
  return v;
}

__device__ void p0_convert(const float* __restrict__ W, u16* __restrict__ Wt, int N, int tk, int tn,
                           bool perm, float* sm) {
  const int tid = threadIdx.x;
  for (int i = tid; i < 64 * 32; i += NTHREADS) {
    int r = i >> 5, c4 = i & 31;
    float4 v = *(const float4*)(W + (size_t)(tk * 64 + r) * N + tn * 128 + c4 * 4);
    float* d = sm + r * 129 + c4 * 4;
    d[0] = v.x; d[1] = v.y; d[2] = v.z; d[3] = v.w;
  }
  __syncthreads();
  for (int i = tid; i < 128 * 8; i += NTHREADS) {
    int nrow = i >> 3, kc = i & 7;
    int src = nrow;
    if (perm && (tn * 128 < 2560)) {
      int g = nrow >> 5, nn = (nrow >> 4) & 1, fr = nrow & 15;
      src = (g >> 1) * 64 + nn * 32 + (g & 1) * 16 + fr;
    }
    unsigned w[4];
#pragma unroll
    for (int j = 0; j < 4; ++j) {
      float a = sm[(kc * 8 + 2 * j) * 129 + src];
      float b = sm[(kc * 8 + 2 * j + 1) * 129 + src];
      w[j] = (unsigned)f2bf(a) | ((unsigned)f2bf(b) << 16);
    }
    *(uint4*)(Wt + (size_t)(tn * 128 + nrow) * 2048 + tk * 64 + kc * 8) = make_uint4(w[0], w[1], w[2], w[3]);
  }
  __syncthreads();
}

__device__ void p0_adaln(const Params& p, int item, float* sm) {
  const int tid = threadIdx.x;
  float* sv = sm;
  float* red = sm + 5 * 2048;
  int col0 = item * 48;
  int l = col0 / 6144, n0 = col0 % 6144;
  for (int i = tid; i < 5 * 2048; i += NTHREADS) {
    int v = i >> 11, k = i & 2047;
    float cv = v < 4 ? p.c[v * 2048 + k] : p.c_ctx[k];
    sv[i] = cv / (1.f + expf(-cv));
  }
  __syncthreads();
  int kg = tid / 12, cq = tid % 12;
  float acc[5][4];
#pragma unroll
  for (int v = 0; v < 5; ++v)
#pragma unroll
    for (int j = 0; j < 4; ++j) acc[v][j] = 0.f;
  if (kg < 42) {
    const float* W = p.ada_w + (size_t)l * 2048 * 6144 + n0 + cq * 4;
#pragma unroll 2
    for (int k = kg; k < 2048; k += 42) {
      float4 w = *(const float4*)(W + (size_t)k * 6144);
#pragma unroll
      for (int v = 0; v < 5; ++v) {
        float s = sv[v * 2048 + k];
        acc[v][0] += s * w.x; acc[v][1] += s * w.y; acc[v][2] += s * w.z; acc[v][3] += s * w.w;
      }
    }
  }
  if (kg >= 21 && kg < 42) {
#pragma unroll
    for (int v = 0; v < 5; ++v)
#pragma unroll
      for (int j = 0; j < 4; ++j) red[((kg - 21) * 5 + v) * 48 + cq * 4 + j] = acc[v][j];
  }
  __syncthreads();
  if (kg < 21) {
#pragma unroll
    for (int v = 0; v < 5; ++v)
#pragma unroll
      for (int j = 0; j < 4; ++j) red[(kg * 5 + v) * 48 + cq * 4 + j] += acc[v][j];
  }
  __syncthreads();
  if (tid < 240) {
    int v = tid / 48, cc = tid % 48;
    float s = 0.f;
    for (int g = 0; g < 21; ++g) s += red[(g * 5 + v) * 48 + cc];
    float* mod = (float*)(p.ws + OFF_MOD);
    mod[(l * 5 + v) * 6144 + n0 + cc] = s + p.ada_b[l * 6144 + n0 + cc];
  }
  __syncthreads();
}

__device__ void p0_rope(const Params& p) {
  float2* rope = (float2*)(p.ws + OFF_ROPE);
  for (int i = threadIdx.x; i < 64 * 32; i += NTHREADS) {
    int pos = i >> 5, j = i & 31;
    float inv = powf(10000.f, -(float)(2 * j) / 64.f);
    float ang = (float)pos * inv;
    rope[i] = make_float2(cosf(ang), sinf(ang));
  }
}

__device__ void p0_filter(const Params& p, int item, float* sm) {
  const int tid = threadIdx.x;
  int tt = item >> 5, nc = item & 31;
  float* z = sm;
  float* h1 = z + 32 * 33;
  float* h2 = h1 + 32 * 64;
  u16* outT = (u16*)(h2 + 32 * 64);
  for (int i = tid; i < 32 * 33; i += NTHREADS) {
    int pos = i / 33, e = i % 33;
    int t = tt * 32 + pos;
    float val;
    if (e == 0) val = (float)t / 2047.f;
    else {
      int bi = (e - 1) & 15;
      float w = 6.283185307179586f * (float)t / 2048.f;
      float fr = 1e-4f + (float)bi * ((15.f - 1e-4f) / 15.f);
      float ang = w * fr;
      val = (e <= 16) ? cosf(ang) : -sinf(ang);
    }
    z[i] = val;
  }
  __syncthreads();
  for (int i = tid; i < 32 * 64; i += NTHREADS) {
    int pos = i >> 6, j = i & 63;
    float a = p.hy_b1[j];
#pragma unroll 3
    for (int e = 0; e < 33; ++e) a += z[pos * 33 + e] * p.hy_w1[e * 64 + j];
    h1[i] = sinf(p.hy_freq[j] * a);
  }
  __syncthreads();
  for (int i = tid; i < 32 * 64; i += NTHREADS) {
    int pos = i >> 6, j = i & 63;
    float a = p.hy_b2[j];
#pragma unroll 4
    for (int e = 0; e < 64; ++e) a += h1[pos * 64 + e] * p.hy_w2[e * 64 + j];
    h2[i] = sinf(p.hy_freq[j] * a);
  }
  __syncthreads();
  {
    int nl = tid & 255, ph = tid >> 8;
    int n = nc * 256 + nl;
    float acc[16];
#pragma unroll
    for (int q = 0; q < 16; ++q) acc[q] = 0.f;
#pragma unroll 2
    for (int k = 0; k < 64; ++k) {
      float w = p.hy_w3[(size_t)k * 8192 + n];
#pragma unroll
      for (int q = 0; q < 16; ++q) acc[q] += h2[(ph * 16 + q) * 64 + k] * w;
    }
    int ch = n & 2047, od = n >> 11;
    float b3 = p.hy_b3[n];
    const float min_decay = -3.0701134573253945f, max_decay = -15.350567286626972f;
    float delta = min_decay + (float)ch * ((max_decay - min_decay) / 2047.f);
    float ad = fabsf(delta);
    float bias = ((od & 1) == 0) ? p.hy_bias_d[(od >> 1) * 2048 + ch] : 0.f;
#pragma unroll
    for (int q = 0; q < 16; ++q) {
      int pos = ph * 16 + q;
      int t = tt * 32 + pos;
      float tn = (float)t / 2047.f;
      float v = (acc[q] + b3) * (expf(-tn * ad) + 0.05f);
      if (t == 0) v += bias;
      outT[nl * 34 + pos] = f2bf(v);
    }
  }
  __syncthreads();
  {
    u16* Rg = (u16*)(p.ws + OFF_FILT);
    for (int i = tid; i < 256 * 32; i += NTHREADS) {
      int nl = i >> 5, pos = i & 31;
      int n = nc * 256 + nl;
      int ch = n & 2047, od = n >> 11;
      int o = od >> 1, dir = od & 1;
      int t = tt * 32 + pos;
      u16 v = outT[nl * 34 + pos];
      u16* R = Rg + ((size_t)o * 2048 + ch) * 4096;
      if (dir == 0) R[2048 - t] = v;
      else {
        if (t > 0) R[2048 + t] = v;
        else R[0] = 0;
      }
    }
  }
  __syncthreads();
}

constexpr int N_ADA = 256;
constexpr int N_CV_AI = 32 * 40, N_CV_AO = 32 * 16, N_CV_HI = 32 * 64, N_CV_HO = 32 * 16;
constexpr int N_FILT = 64 * 32;
__device__ void phase0(const Params& p, float* sm) {
  const int total = N_ADA + 1 + N_FILT + N_CV_AI + N_CV_AO + N_CV_HI + N_CV_HO;
  for (int it = blockIdx.x; it < total; it += gridDim.x) {
    int i = it;
    if (i < N_ADA) { p0_adaln(p, i, sm); continue; }
    i -= N_ADA;
    if (i < 1) { p0_rope(p); continue; }
    i -= 1;
    if (i < N_FILT) { p0_filter(p, i, sm); continue; }
    i -= N_FILT;
    if (i < N_CV_AI) { p0_convert(p.attn_w_in, (u16*)(p.ws + OFF_WT_AI), 5120, i / 40, i % 40, true, sm); continue; }
    i -= N_CV_AI;
    if (i < N_CV_AO) { p0_convert(p.attn_w_out, (u16*)(p.ws + OFF_WT_AO), 2048, i / 16, i % 16, false, sm); continue; }
    i -= N_CV_AO;
    if (i < N_CV_HI) { p0_convert(p.hy_w_in, (u16*)(p.ws + OFF_WT_HI), 8192, i / 64, i % 64, false, sm); continue; }
    i -= N_CV_HI;
    p0_convert(p.hy_w_out, (u16*)(p.ws + OFF_WT_HO), 2048, i / 16, i % 16, false, sm);
  }
}

__device__ void norm_row(const float* __restrict__ src, const float* __restrict__ g, const float* shift,
                         const float* scale, u16* dst_bf, float* dst_f, int lane) {
  float4 v[8];
  float ss = 0.f;
#pragma unroll
  for (int j = 0; j < 8; ++j) {
    v[j] = *(const float4*)(src + (j * 64 + lane) * 4);
    ss += v[j].x * v[j].x + v[j].y * v[j].y + v[j].z * v[j].z + v[j].w * v[j].w;
  }
  ss = wave_sum(ss);
  float r = rsqrtf(ss * (1.f / 2048.f) + 1e-6f);
#pragma unroll
  for (int j = 0; j < 8; ++j) {
    int c = (j * 64 + lane) * 4;
    float4 gg = *(const float4*)(g + c);
    float4 o = make_float4(v[j].x * r * gg.x, v[j].y * r * gg.y, v[j].z * r * gg.z, v[j].w * r * gg.w);
    if (dst_bf) {
      float4 sh = *(const float4*)(shift + c);
      float4 sc = *(const float4*)(scale + c);
      o.x = o.x * (1.f + sc.x) + sh.x; o.y = o.y * (1.f + sc.y) + sh.y;
      o.z = o.z * (1.f + sc.z) + sh.z; o.w = o.w * (1.f + sc.w) + sh.w;
      uint2 pk;
      pk.x = (unsigned)f2bf(o.x) | ((unsigned)f2bf(o.y) << 16);
      pk.y = (unsigned)f2bf(o.z) | ((unsigned)f2bf(o.w) << 16);
      *(uint2*)(dst_bf + c) = pk;
    } else {
      *(float4*)(dst_f + c) = o;
    }
  }
}

__device__ void phase_norm(const Params& p, int mode) {
  const int wid = threadIdx.x >> 6, lane = threadIdx.x & 63;
  const float* mod = (const float*)(p.ws + OFF_MOD);
  int nrows = (mode == 0) ? (MT + MC) : MT;
  for (int row = blockIdx.x * 8 + wid; row < nrows; row += gridDim.x * 8) {
    if (mode == 0) {
      if (row < MT) {
        int b = row >> 11;
        const float* m = mod + (0 * 5 + b) * 6144;
        norm_row(p.x + (size_t)row * 2048, p.norm_g, m, m + 2048, (u16*)(p.ws + OFF_ACT) + (size_t)row * 2048, nullptr, lane);
      } else {
        int rc = row - MT;
        const float* m = mod + (0 * 5 + 4) * 6144;
        norm_row(p.ctx + (size_t)rc * 2048, p.norm_g, m, m + 2048, (u16*)(p.ws + OFF_HC) + (size_t)rc * 2048, nullptr, lane);
      }
    } else if (mode == 1) {
      int b = row >> 11;
      const float* m = mod + (1 * 5 + b) * 6144;
      norm_row(p.out + (size_t)row * 2048, p.norm_g + 2048, m, m + 2048, (u16*)(p.ws + OFF_ACT) + (size_t)row * 2048, nullptr, lane);
    } else {
      norm_row(p.out + (size_t)row * 2048, p.final_g, nullptr, nullptr, nullptr, p.out + (size_t)row * 2048, lane);
    }
  }
}

template <int MODE>
__device__ __forceinline__ void epi_pair(const Params& p, int m, int n, float a0, float a1) {
  if (MODE == 1) {
    u16* px = (u16*)(p.ws + OFF_BIG);
    float o0 = a0, o1 = a1;
    if (n < 2560) {
      int g = (n >> 5) & 3, fr = n & 15;
      int axis = g >> 1, i = (g & 1) * 16 + fr;
      int s = m & 2047;
      int pos = axis ? (s & 63) : (s >> 6);
      float2 cs = ((const float2*)(p.ws + OFF_ROPE))[pos * 32 + i];
      o0 = a0 * cs.x - a1 * cs.y;
      o1 = a1 * cs.x + a0 * cs.y;
    }
    px[(size_t)m * 5120 + n] = f2bf(o0);
    px[(size_t)m * 5120 + n + 16] = f2bf(o1);
  } else if (MODE == 5) {
    u16* kvc = (u16*)(p.ws + OFF_KVC);
    kvc[(size_t)m * 1024 + n] = f2bf(a0);
    kvc[(size_t)m * 1024 + n + 16] = f2bf(a1);
  } else if (MODE == 2) {
    const float* mod = (const float*)(p.ws + OFF_MOD);
    int b = m >> 11;
    const float* gate = mod + (0 * 5 + b) * 6144 + 4096;
    p.out[(size_t)m * 2048 + n] = p.x[(size_t)m * 2048 + n] + gate[n] * a0;
    p.out[(size_t)m * 2048 + n + 16] = p.x[(size_t)m * 2048 + n + 16] + gate[n + 16] * a1;
  } else if (MODE == 3) {
    u16* pp = (u16*)(p.ws + OFF_BIG);
    pp[(size_t)m * 8192 + n] = f2bf(a0);
    pp[(size_t)m * 8192 + n + 16] = f2bf(a1);
  } else if (MODE == 4) {
    const float* mod = (const float*)(p.ws + OFF_MOD);
    int b = m >> 11;
    const float* gate = mod + (1 * 5 + b) * 6144 + 4096;
    p.out[(size_t)m * 2048 + n] += gate[n] * a0;
    p.out[(size_t)m * 2048 + n + 16] += gate[n + 16] * a1;
  }
}

template <int MODE>
__device__ void naive_gemm(const Params& p, const u16* __restrict__ A, const u16* __restrict__ Wt, int M, int N) {
  const int tid = threadIdx.x;
  const int ml = tid >> 5, pl = tid & 31;
  const int ntn = N / 64, ntm = M / 16;
  for (int tile = blockIdx.x; tile < ntn * ntm; tile += gridDim.x) {
    int tm = tile / ntn, tn = tile % ntn;
    int m = tm * 16 + ml;
    int n = tn * 64 + (pl >> 4) * 32 + (pl & 15);
    const uint4* a = (const uint4*)(A + (size_t)m * 2048);
    const uint4* w0 = (const uint4*)(Wt + (size_t)n * 2048);
    const uint4* w1 = (const uint4*)(Wt + (size_t)(n + 16) * 2048);
    float acc0 = 0.f, acc1 = 0.f;
#pragma unroll 2
    for (int k = 0; k < 256; ++k) {
      uint4 av = a[k], b0 = w0[k], b1 = w1[k];
      acc0 += bflo(av.x) * bflo(b0.x) + bfhi(av.x) * bfhi(b0.x) + bflo(av.y) * bflo(b0.y) + bfhi(av.y) * bfhi(b0.y)
            + bflo(av.z) * bflo(b0.z) + bfhi(av.z) * bfhi(b0.z) + bflo(av.w) * bflo(b0.w) + bfhi(av.w) * bfhi(b0.w);
      acc1 += bflo(av.x) * bflo(b1.x) + bfhi(av.x) * bfhi(b1.x) + bflo(av.y) * bflo(b1.y) + bfhi(av.y) * bfhi(b1.y)
            + bflo(av.z) * bflo(b1.z) + bfhi(av.z) * bfhi(b1.z) + bflo(av.w) * bflo(b1.w) + bfhi(av.w) * bfhi(b1.w);
    }
    epi_pair<MODE>(p, m, n, acc0, acc1);
  }
}

__device__ void phase_attn_naive(const Params& p, float* sm) {
  const int wid = threadIdx.x >> 6, lane = threadIdx.x & 63;
  float* qs = sm + wid * (128 + 640);
  float* pr = qs + 128;
  const u16* px = (const u16*)(p.ws + OFF_BIG);
  const u16* kvc = (const u16*)(p.ws + OFF_KVC);
  u16* og = (u16*)(p.ws + OFF_ACT);
  const float scale = 0.08838834764831845f;
  for (int item = blockIdx.x * 8 + wid; item < MT * 16; item += gridDim.x * 8) {
    int m = item >> 4, h = item & 15;
    int b = m >> 11, s = m & 2047, kvh = h >> 2, nblk = s >> 7;
    const u16* qrow = px + (size_t)m * 5120 + h * 128;
    qs[lane] = bf2f(qrow[lane]) * scale;
    qs[lane + 64] = bf2f(qrow[lane + 64]) * scale;
    asm volatile("s_waitcnt lgkmcnt(0)" ::: "memory");
    float mx = p.attn_sink[h];
#pragma unroll 1
    for (int j = 0; j < 10; ++j) {
      int kidx = j * 64 + lane;
      const u16* krow;
      bool valid;
      if (kidx < 384) {
        int kpos = (nblk - 1) * 128 + kidx;
        int rel = kpos - s;
        valid = (kpos >= 0) && (kpos < 2048) && (rel <= 128) && (rel >= -128);
        krow = px + (size_t)(b * 2048 + (valid ? kpos : 0)) * 5120 + 2048 + kvh * 128;
      } else {
        valid = true;
        krow = kvc + (size_t)(b * 256 + (kidx - 384)) * 1024 + kvh * 128;
      }
      float d = -1e30f;
      if (valid) {
        d = 0.f;
#pragma unroll 4
        for (int c = 0; c < 16; ++c) {
          uint4 kk = *(const uint4*)(krow + c * 8);
          const float* q8 = qs + c * 8;
          d += q8[0] * bflo(kk.x) + q8[1] * bfhi(kk.x) + q8[2] * bflo(kk.y) + q8[3] * bfhi(kk.y)
             + q8[4] * bflo(kk.z) + q8[5] * bfhi(kk.z) + q8[6] * bflo(kk.w) + q8[7] * bfhi(kk.w);
        }
      }
      pr[kidx] = d;
      mx = fmaxf(mx, d);
    }
    mx = wave_max(mx);
    float sum = 0.f;
#pragma unroll 1
    for (int j = 0; j < 10; ++j) {
      float d = pr[j * 64 + lane];
      float e = (d > -1e29f) ? __expf(d - mx) : 0.f;
      pr[j * 64 + lane] = e;
      sum += e;
    }
    sum = wave_sum(sum);
    sum += __expf(p.attn_sink[h] - mx);
    asm volatile("s_waitcnt lgkmcnt(0)" ::: "memory");
    float o0 = 0.f, o1 = 0.f;
    int k0 = s - 128 < 0 ? 0 : s - 128, k1 = s + 128 > 2047 ? 2047 : s + 128;
    for (int kpos = k0; kpos <= k1; ++kpos) {
      float pv = pr[kpos - (nblk - 1) * 128];
      unsigned vv = *(const unsigned*)(px + (size_t)(b * 2048 + kpos) * 5120 + 2560 + kvh * 128 + lane * 2);
      o0 += pv * bflo(vv); o1 += pv * bfhi(vv);
    }
    for (int c = 0; c < 256; ++c) {
      float pv = pr[384 + c];
      unsigned vv = *(const unsigned*)(kvc + (size_t)(b * 256 + c) * 1024 + 512 + kvh * 128 + lane * 2);
      o0 += pv * bflo(vv); o1 += pv * bfhi(vv);
    }
    float inv = 1.f / sum;
    unsigned gg = *(const unsigned*)(px + (size_t)m * 5120 + 3072 + h * 128 + lane * 2);
    float r0 = o0 * inv * siluf(bflo(gg)), r1 = o1 * inv * siluf(bfhi(gg));
    *(unsigned*)(og + (size_t)m * 2048 + h * 128 + lane * 2) = (unsigned)f2bf(r0) | ((unsigned)f2bf(r1) << 16);
    asm volatile("s_waitcnt lgkmcnt(0)" ::: "memory");
  }
}

__device__ __forceinline__ float sconv(const u16* pp, const float* cw, const float* cb, int b, int t, int c) {
  const u16* base = pp + (size_t)(b * 2048 + t) * 8192 + c;
  float v = cw[6144 + c] * bf2f(base[0]) + cb[c];
  if (t > 0) v += cw[c] * bf2f(base[-8192]);
  if (t < 2047) v += cw[2 * 6144 + c] * bf2f(base[8192]);
  return v;
}

__device__ void phase_conv_naive(const Params& p, float* sm) {
  const int tid = threadIdx.x;
  float* u = sm;
  float* R = sm + 8192;
  const u16* pp = (const u16*)(p.ws + OFF_BIG);
  const u16* Rg = (const u16*)(p.ws + OFF_FILT);
  u16* yg = (u16*)(p.ws + OFF_ACT);
  for (int ch = blockIdx.x; ch < 2048; ch += gridDim.x) {
    for (int i = tid; i < 8192; i += NTHREADS) u[i] = sconv(pp, p.hy_conv_w, p.hy_conv_b, i >> 11, i & 2047, 4096 + ch);
    for (int i = tid; i < 4096; i += NTHREADS) R[i] = bf2f(Rg[((size_t)0 * 2048 + ch) * 4096 + i]);
    __syncthreads();
    float zr[16];
#pragma unroll
    for (int q = 0; q < 16; ++q) {
      int i = tid + q * NTHREADS;
      int b = i >> 11, t = i & 2047;
      const float* ub = u + b * 2048;
      const float* Rb = R + 2048 - t;
      float a = 0.f;
      for (int s = 0; s < 2048; ++s) a += Rb[s] * ub[s];
      zr[q] = a * sconv(pp, p.hy_conv_w, p.hy_conv_b, b, t, ch);
    }
    __syncthreads();
#pragma unroll
    for (int q = 0; q < 16; ++q) u[tid + q * NTHREADS] = zr[q];
    for (int i = tid; i < 4096; i += NTHREADS) R[i] = bf2f(Rg[((size_t)1 * 2048 + ch) * 4096 + i]);
    __syncthreads();
#pragma unroll
    for (int q = 0; q < 16; ++q) {
      int i = tid + q * NTHREADS;
      int b = i >> 11, t = i & 2047;
      const float* ub = u + b * 2048;
      const float* Rb = R + 2048 - t;
      float a = 0.f;
      for (int s = 0; s < 2048; ++s) a += Rb[s] * ub[s];
      float y = a * sconv(pp, p.hy_conv_w, p.hy_conv_b, b, t, 2048 + ch);
      float g = bf2f(pp[(size_t)(b * 2048 + t) * 8192 + 6144 + ch]);
      yg[(size_t)(b * 2048 + t) * 2048 + ch] = f2bf(y * siluf(g));
    }
    __syncthreads();
  }
}

constexpr int N_PHASES = 10;
__global__ void __launch_bounds__(NTHREADS) mega(Params p, int ph0, int ph1) {
  extern __shared__ __attribute__((aligned(16))) float sm[];
#define PH(i, body) if (ph0 <= (i) && (i) < ph1) { body; if ((i) + 1 < ph1) cg::this_grid().sync(); }
  PH(0, phase0(p, sm))
  PH(1, phase_norm(p, 0))
  PH(2, naive_gemm<1>(p, (const u16*)(p.ws + OFF_ACT), (const u16*)(p.ws + OFF_WT_AI), MT, ATTN_IN);
        naive_gemm<5>(p, (const u16*)(p.ws + OFF_HC), (const u16*)(p.ws + OFF_WT_AI) + (size_t)2048 * 2048, MC, 1024))
  PH(3, phase_attn_naive(p, sm))
  PH(4, naive_gemm<2>(p, (const u16*)(p.ws + OFF_ACT), (const u16*)(p.ws + OFF_WT_AO), MT, 2048))
  PH(5, phase_norm(p, 1))
  PH(6, naive_gemm<3>(p, (const u16*)(p.ws + OFF_ACT), (const u16*)(p.ws + OFF_WT_HI), MT, HY_IN))
  PH(7, phase_conv_naive(p, sm))
  PH(8, naive_gemm<4>(p, (const u16*)(p.ws + OFF_ACT), (const u16*)(p.ws + OFF_WT_HO), MT, 2048))
  PH(9, phase_norm(p, 2))
}

extern "C" void kernel_launch(void* const* d_in, const int* in_sizes, int n_in, void* d_out, int out_size,
                              void* d_ws, size_t ws_size, hipStream_t stream) {
  Params p{};
  const float** f = (const float**)&p;
  for (int i = 0; i < 23; ++i) f[i] = (const float*)d_in[i];
  p.out = (float*)d_out;
  p.ws = (char*)d_ws;
  constexpr size_t kLds = 64 * 1024;
  static int grid_blocks = 0;
  if (!grid_blocks) {
    (void)hipFuncSetAttribute((const void*)mega, hipFuncAttributeMaxDynamicSharedMemorySize, (int)kLds);
    int dev = 0, cus = 0, per_cu = 0;
    (void)hipGetDevice(&dev);
    (void)hipDeviceGetAttribute(&cus, hipDeviceAttributeMultiprocessorCount, dev);
    (void)hipOccupancyMaxActiveBlocksPerMultiprocessor(&per_cu, mega, NTHREADS, kLds);
    if (per_cu < 1) per_cu = 1;
    grid_blocks = cus * per_cu;
  }
  int ph0 = 0, ph1 = N_PHASES;
  void* args[] = {(void*)&p, (void*)&ph0, (void*)&ph1};
  hipError_t e = hipLaunchCooperativeKernel((const void*)mega, dim3(grid_blocks), dim3(NTHREADS), args, kLds, stream);
  if (e != hipSuccess) fprintf(stderr, "cooperative launch failed: %s (grid %d)\n", hipGetErrorString(e), grid_blocks);
}
```

```cpp
#include <hip/hip_runtime.h>
#include <hip/hip_bf16.h>
#include <hip/hip_cooperative_groups.h>
#include <cstdio>
namespace cg = cooperative_groups;
typedef unsigned short u16;

#define NTHREADS 512
constexpr int Bn = 4, Sn = 2048, Dn = 2048, Cn = 256;
constexpr int MT = Bn * Sn;
constexpr int MC = Bn * Cn;
constexpr int ATTN_IN = 5120;
constexpr int HY_IN = 8192;

constexpr size_t OFF_WT_AI = 0;
constexpr size_t OFF_WT_AO = OFF_WT_AI + (size_t)5120 * 2048 * 2;
constexpr size_t OFF_WT_HI = OFF_WT_AO + (size_t)2048 * 2048 * 2;
constexpr size_t OFF_WT_HO = OFF_WT_HI + (size_t)8192 * 2048 * 2;
constexpr size_t OFF_MOD   = OFF_WT_HO + (size_t)2048 * 2048 * 2;
constexpr size_t OFF_ROPE  = OFF_MOD + (size_t)2 * 5 * 6144 * 4 + 256;
constexpr size_t OFF_FILT  = OFF_ROPE + (size_t)64 * 32 * 8;
constexpr size_t OFF_ACT   = OFF_FILT + (size_t)2 * 2048 * 4096 * 2;
constexpr size_t OFF_HC    = OFF_ACT + (size_t)8192 * 2048 * 2;
constexpr size_t OFF_KVC   = OFF_HC + (size_t)1024 * 2048 * 2;
constexpr size_t OFF_BIG   = OFF_KVC + (size_t)1024 * 1024 * 2;

struct Params {
  const float *x, *c, *ctx, *c_ctx, *norm_g, *ada_w, *ada_b, *attn_w_in, *attn_w_out, *attn_sink;
  const float *hy_w_in, *hy_conv_w, *hy_conv_b, *hy_w1, *hy_b1, *hy_w2, *hy_b2, *hy_w3, *hy_b3;
  const float *hy_freq, *hy_bias_d, *hy_w_out, *final_g;
  float* out;
  char* ws;
};

__device__ __forceinline__ u16 f2bf(float f) {
  unsigned u = __float_as_uint(f);
  u += 0x7fffu + ((u >> 16) & 1u);
  return (u16)(u >> 16);
}
__device__ __forceinline__ float bf2f(u16 h) { return __uint_as_float(((unsigned)h) << 16); }
__device__ __forceinline__ float bflo(unsigned w) { return __uint_as_float(w << 16); }
__device__ __forceinline__ float bfhi(unsigned w) { return __uint_as_float(w & 0xffff0000u); }
__device__ __forceinline__ float siluf(float v) { return v / (1.f + __expf(-v)); }
__device__ __forceinline__ float wave_sum(float v) {
#pragma unroll
  for (int o = 32; o > 0; o >>= 1) v += __shfl_xor(v, o, 64);
  return v;
}
__device__ __forceinline__ float wave_max(float v) {
#pragma unroll
  for (int o = 32; o > 0; o >>= 1) v = fmaxf(v, __shfl_xor(v, o, 64));
  return v;
}

__device__ void p0_convert(const float* __restrict__ W, u16* __restrict__ Wt, int N, int tk, int tn,
                           bool perm, float* sm) {
  const int tid = threadIdx.x;
  for (int i = tid; i < 64 * 32; i += NTHREADS) {
    int r = i >> 5, c4 = i & 31;
    float4 v = *(const float4*)(W + (size_t)(tk * 64 + r) * N + tn * 128 + c4 * 4);
    float* d = sm + r * 129 + c4 * 4;
    d[0] = v.x; d[1] = v.y; d[2] = v.z; d[3] = v.w;
  }
  __syncthreads();
  for (int i = tid; i < 128 * 8; i += NTHREADS) {
    int nrow = i >> 3, kc = i & 7;
    int src = nrow;
    if (perm && (tn * 128 < 2560)) {
      int g = nrow >> 5, nn = (nrow >> 4) & 1, fr = nrow & 15;
      src = (g >> 1) * 64 + nn * 32 + (g & 1) * 16 + fr;
    }
    unsigned w[4];
#pragma unroll
    for (int j = 0; j < 4; ++j) {
      float a = sm[(kc * 8 + 2 * j) * 129 + src];
      float b = sm[(kc * 8 + 2 * j + 1) * 129 + src];
      w[j] = (unsigned)f2bf(a) | ((unsigned)f2bf(b) << 16);
    }
    *(uint4*)(Wt + (size_t)(tn * 128 + nrow) * 2048 + tk * 64 + kc * 8) = make_uint4(w[0], w[1], w[2], w[3]);
  }
  __syncthreads();
}

__device__ void p0_adaln(const Params& p, int item, float* sm) {
  const int tid = threadIdx.x;
  float* sv = sm;
  float* red = sm + 5 * 2048;
  int col0 = item * 48;
  int l = col0 / 6144, n0 = col0 % 6144;
  for (int i = tid; i < 5 * 2048; i += NTHREADS) {
    int v = i >> 11, k = i & 2047;
    float cv = v < 4 ? p.c[v * 2048 + k] : p.c_ctx[k];
    sv[i] = cv / (1.f + expf(-cv));
  }
  __syncthreads();
  int kg = tid / 12, cq = tid % 12;
  float acc[5][4];
#pragma unroll
  for (int v = 0; v < 5; ++v)
#pragma unroll
    for (int j = 0; j < 4; ++j) acc[v][j] = 0.f;
  if (kg < 42) {
    const float* W = p.ada_w + (size_t)l * 2048 * 6144 + n0 + cq * 4;
#pragma unroll 2
    for (int k = kg; k < 2048; k += 42) {
      float4 w = *(const float4*)(W + (size_t)k * 6144);
#pragma unroll
      for (int v = 0; v < 5; ++v) {
        float s = sv[v * 2048 + k];
        acc[v][0] += s * w.x; acc[v][1] += s * w.y; acc[v][2] += s * w.z; acc[v][3] += s * w.w;
      }
    }
  }
  if (kg >= 21 && kg < 42) {
#pragma unroll
    for (int v = 0; v < 5; ++v)
#pragma unroll
      for (int j = 0; j < 4; ++j) red[((kg - 21) * 5 + v) * 48 + cq * 4 + j] = acc[v][j];
  }
  __syncthreads();
  if (kg < 21) {
#pragma unroll
    for (int v = 0; v < 5; ++v)
#pragma unroll
      for (int j = 0; j < 4; ++j) red[(kg * 5 + v) * 48 + cq * 4 + j] += acc[v][j];
  }
  __syncthreads();
  if (tid < 240) {
    int v = tid / 48, cc = tid % 48;
    float s = 0.f;
    for (int g = 0; g < 21; ++g) s += red[(g * 5 + v) * 48 + cc];
    float* mod = (float*)(p.ws + OFF_MOD);
    mod[(l * 5 + v) * 6144 + n0 + cc] = s + p.ada_b[l * 6144 + n0 + cc];
  }
  __syncthreads();
}

__device__ void p0_rope(const Params& p) {
  float2* rope = (float2*)(p.ws + OFF_ROPE);
  for (int i = threadIdx.x; i < 64 * 32; i += NTHREADS) {
    int pos = i >> 5, j = i & 31;
    float inv = powf(10000.f, -(float)(2 * j) / 64.f);
    float ang = (float)pos * inv;
    rope[i] = make_float2(cosf(ang), sinf(ang));
  }
}

__device__ void p0_filter(const Params& p, int item, float* sm) {
  const int tid = threadIdx.x;
  int tt = item >> 5, nc = item & 31;
  float* z = sm;
  float* h1 = z + 32 * 33;
  float* h2 = h1 + 32 * 64;
  u16* outT = (u16*)(h2 + 32 * 64);
  for (int i = tid; i < 32 * 33; i += NTHREADS) {
    int pos = i / 33, e = i % 33;
    int t = tt * 32 + pos;
    float val;
    if (e == 0) val = (float)t / 2047.f;
    else {
      int bi = (e - 1) & 15;
      float w = 6.283185307179586f * (float)t / 2048.f;
      float fr = 1e-4f + (float)bi * ((15.f - 1e-4f) / 15.f);
      float ang = w * fr;
      val = (e <= 16) ? cosf(ang) : -sinf(ang);
    }
    z[i] = val;
  }
  __syncthreads();
  for (int i = tid; i < 32 * 64; i += NTHREADS) {
    int pos = i >> 6, j = i & 63;
    float a = p.hy_b1[j];
#pragma unroll 3
    for (int e = 0; e < 33; ++e) a += z[pos * 33 + e] * p.hy_w1[e * 64 + j];
    h1[i] = sinf(p.hy_freq[j] * a);
  }
  __syncthreads();
  for (int i = tid; i < 32 * 64; i += NTHREADS) {
    int pos = i >> 6, j = i & 63;
    float a = p.hy_b2[j];
#pragma unroll 4
    for (int e = 0; e < 64; ++e) a += h1[pos * 64 + e] * p.hy_w2[e * 64 + j];
    h2[i] = sinf(p.hy_freq[j] * a);
  }
  __syncthreads();
  {
    int nl = tid & 255, ph = tid >> 8;
    int n = nc * 256 + nl;
    float acc[16];
#pragma unroll
    for (int q = 0; q < 16; ++q) acc[q] = 0.f;
#pragma unroll 2
    for (int k = 0; k < 64; ++k) {
      float w = p.hy_w3[(size_t)k * 8192 + n];
#pragma unroll
      for (int q = 0; q < 16; ++q) acc[q] += h2[(ph * 16 + q) * 64 + k] * w;
    }
    int ch = n & 2047, od = n >> 11;
    float b3 = p.hy_b3[n];
    const float min_decay = -3.0701134573253945f, max_decay = -15.350567286626972f;
    float delta = min_decay + (float)ch * ((max_decay - min_decay) / 2047.f);
    float ad = fabsf(delta);
    float bias = ((od & 1) == 0) ? p.hy_bias_d[(od >> 1) * 2048 + ch] : 0.f;
#pragma unroll
    for (int q = 0; q < 16; ++q) {
      int pos = ph * 16 + q;
      int t = tt * 32 + pos;
      float tn = (float)t / 2047.f;
      float v = (acc[q] + b3) * (expf(-tn * ad) + 0.05f);
      if (t == 0) v += bias;
      outT[nl * 34 + pos] = f2bf(v);
    }
  }
  __syncthreads();
  {
    u16* Rg = (u16*)(p.ws + OFF_FILT);
    for (int i = tid; i < 256 * 32; i += NTHREADS) {
      int nl = i >> 5, pos = i & 31;
      int n = nc * 256 + nl;
      int ch = n & 2047, od = n >> 11;
      int o = od >> 1, dir = od & 1;
      int t = tt * 32 + pos;
      u16 v = outT[nl * 34 + pos];
      u16* R = Rg + ((size_t)o * 2048 + ch) * 4096;
      if (dir == 0) R[2048 - t] = v;
      else {
        if (t > 0) R[2048 + t] = v;
        else R[0] = 0;
      }
    }
  }
  __syncthreads();
}

constexpr int N_ADA = 256;
constexpr int N_CV_AI = 32 * 40, N_CV_AO = 32 * 16, N_CV_HI = 32 * 64, N_CV_HO = 32 * 16;
constexpr int N_FILT = 64 * 32;
__device__ void phase0(const Params& p, float* sm) {
  const int total = N_ADA + 1 + N_FILT + N_CV_AI + N_CV_AO + N_CV_HI + N_CV_HO;
  for (int it = blockIdx.x; it < total; it += gridDim.x) {
    int i = it;
    if (i < N_ADA) { p0_adaln(p, i, sm); continue; }
    i -= N_ADA;
    if (i < 1) { p0_rope(p); continue; }
    i -= 1;
    if (i < N_FILT) { p0_filter(p, i, sm); continue; }
    i -= N_FILT;
    if (i < N_CV_AI) { p0_convert(p.attn_w_in, (u16*)(p.ws + OFF_WT_AI), 5120, i / 40, i % 40, true, sm); continue; }
    i -= N_CV_AI;
    if (i < N_CV_AO) { p0_convert(p.attn_w_out, (u16*)(p.ws + OFF_WT_AO), 2048, i / 16, i % 16, false, sm); continue; }
    i -= N_CV_AO;
    if (i < N_CV_HI) { p0_convert(p.hy_w_in, (u16*)(p.ws + OFF_WT_HI), 8192, i / 64, i % 64, false, sm); continue; }
    i -= N_CV_HI;
    p0_convert(p.hy_w_out, (u16*)(p.ws + OFF_WT_HO), 2048, i / 16, i % 16, false, sm);
  }
}

__device__ void norm_row(const float* __restrict__ src, const float* __restrict__ g, const float* shift,
                         const float* scale, u16* dst_bf, float* dst_f, int lane) {
  float4 v[8];
  float ss = 0.f;
#pragma unroll
  for (int j = 0; j < 8; ++j) {
    v[j] = *(const float4*)(src + (j * 64 + lane) * 4);
    ss += v[j].x * v[j].x + v[j].y * v[j].y + v[j].z * v[j].z + v[j].w * v[j].w;
  }
  ss = wave_sum(ss);
  float r = rsqrtf(ss * (1.f / 2048.f) + 1e-6f);
#pragma unroll
  for (int j = 0; j < 8; ++j) {
    int c = (j * 64 + lane) * 4;
    float4 gg = *(const float4*)(g + c);
    float4 o = make_float4(v[j].x * r * gg.x, v[j].y * r * gg.y, v[j].z * r * gg.z, v[j].w * r * gg.w);
    if (dst_bf) {
      float4 sh = *(const float4*)(shift + c);
      float4 sc = *(const float4*)(scale + c);
      o.x = o.x * (1.f + sc.x) + sh.x; o.y = o.y * (1.f + sc.y) + sh.y;
      o.z = o.z * (1.f + sc.z) + sh.z; o.w = o.w * (1.f + sc.w) + sh.w;
      uint2 pk;
      pk.x = (unsigned)f2bf(o.x) | ((unsigned)f2bf(o.y) << 16);
      pk.y = (unsigned)f2bf(o.z) | ((unsigned)f2bf(o.w) << 16);
      *(uint2*)(dst_bf + c) = pk;
    } else {
      *(float4*)(dst_f + c) = o;
    }
  }
}

__device__ void phase_norm(const Params& p, int mode) {
  const int wid = threadIdx.x >> 6, lane = threadIdx.x & 63;
  const float* mod = (const float*)(p.ws + OFF_MOD);
  int nrows = (mode == 0) ? (MT + MC) : MT;
  for (int row = blockIdx.x * 8 + wid; row < nrows; row += gridDim.x * 8) {
    if (mode == 0) {
      if (row < MT) {
        int b = row >> 11;
        const float* m = mod + (0 * 5 + b) * 6144;
        norm_row(p.x + (size_t)row * 2048, p.norm_g, m, m + 2048, (u16*)(p.ws + OFF_ACT) + (size_t)row * 2048, nullptr, lane);
      } else {
        int rc = row - MT;
        const float* m = mod + (0 * 5 + 4) * 6144;
        norm_row(p.ctx + (size_t)rc * 2048, p.norm_g, m, m + 2048, (u16*)(p.ws + OFF_HC) + (size_t)rc * 2048, nullptr, lane);
      }
    } else if (mode == 1) {
      int b = row >> 11;
      const float* m = mod + (1 * 5 + b) * 6144;
      norm_row(p.out + (size_t)row * 2048, p.norm_g + 2048, m, m + 2048, (u16*)(p.ws + OFF_ACT) + (size_t)row * 2048, nullptr, lane);
    } else {
      norm_row(p.out + (size_t)row * 2048, p.final_g, nullptr, nullptr, nullptr, p.out + (size_t)row * 2048, lane);
    }
  }
}

namespace pg8 {
#define PG8_LAS __attribute__((address_space(3)))
typedef unsigned short bf16_t;
typedef short bf16x8 __attribute__((ext_vector_type(8)));
typedef float f32x4 __attribute__((ext_vector_type(4)));
typedef unsigned u32x4 __attribute__((ext_vector_type(4)));
constexpr int BM = 256, BK = 64, HALF = 128, HTB = HALF * BK * 2  , STAGE_BYTES = 8 * HTB, NXCD = 8, WGM = 8;

__host__ __device__ __forceinline__ int lds_byte(int r, int c) { const int st = (r >> 4) * 2 + (c >> 5), rr = r & 15, cc = c & 31, ob = rr * 64 + cc * 2; return st * 1024 + (ob ^ (((ob >> 9) & 1) << 5)); }
__host__ __device__ __forceinline__ void stage_rc(int b, int& R, int& C) { const int st = b / 1024, sb = b % 1024, swz = sb ^ (((sb >> 9) & 1) << 5); R = (st >> 1) * 16 + swz / 64; C = (st & 1) * 32 + (swz % 64) / 2; }
__host__ __device__ __forceinline__ int perm32(int rho) { const int n = rho >> 4, i = rho & 15; return 8 * (i >> 2) + 4 * n + (i & 3); }

struct Unit { int pm, pn; };
struct Gemm { const bf16_t* A; const bf16_t* Bt; int M, N, K; };

struct StaticOrder {
    int nM, nN, nwg, G, c;
    __host__ __device__ void init(int M, int N, int G_, int c_) { nM = M / BM; nN = N / BM; nwg = nM * nN; G = G_; c = c_; }
    __host__ __device__ bool next(int i, Unit& u) const {
        const long L = (long)i * G + c; if (L >= nwg) return false;
        int wgid = (int)L; { const int q = nwg / NXCD, r = nwg % NXCD, xcd = wgid % NXCD, off = wgid / NXCD; wgid = (xcd < r ? xcd * (q + 1) : r * (q + 1) + (xcd - r) * q) + off; }
        const int nig = WGM * nN, gid = wgid / nig, fm = gid * WGM, gsz = (nM - fm) < WGM ? (nM - fm) : WGM;
        u.pm = fm + ((wgid % nig) % gsz); u.pn = (wgid % nig) / gsz; return true;
    }
    __device__ __forceinline__ void a_ready(const Unit&) const {}
    __device__ __forceinline__ void done(const Unit&) const {}
};
__device__ __forceinline__ unsigned cvt_pk_bf16(float lo, float hi) { unsigned r; asm volatile("v_cvt_pk_bf16_f32 %0, %1, %2" : "=v"(r) : "v"(lo), "v"(hi)); return r; }
template <class Epi, class Sched>
__device__ __forceinline__ void gemm_phase(PG8_LAS unsigned char* lds, const Gemm g, const Sched& S, const Epi& E) {
    const int tid = threadIdx.x, wid = __builtin_amdgcn_readfirstlane(tid >> 6), lane = tid & 63, wr = wid >> 2, wc = wid & 3, fr = lane & 15, fq = lane >> 4;
    const int K = g.K, nt = K / BK;
    unsigned voffA[2], voffB[2];
#pragma unroll
    for (int i = 0; i < 2; ++i) { int R, C; stage_rc(tid * 16 + i * 8192, R, C); const int Rb = Epi::PERM ? ((R & ~31) + perm32(R & 31)) : R;
        voffA[i] = (unsigned)(R * K + C) * 2u; voffB[i] = (unsigned)(Rb * K + C) * 2u; }
    const size_t kstep = (size_t)(BK * 2);
    const size_t hstep = (size_t)HALF * K * 2;
    const size_t tstep = 2 * hstep;
    const unsigned ldsw = (unsigned)wid * 1024u;
    const int aoff = lds_byte(wr * 64 + fr, fq * 8), boff = lds_byte(wc * 32 + fr, fq * 8);
#define PG8_SA(b, h) (((b) * 2 + (h)) * HTB)
#define PG8_SB(b, h) ((4 + (b) * 2 + (h)) * HTB)
#define PG8_STAGE(bufoff, gbase, voff) do { _Pragma("unroll") for (int _i = 0; _i < 2; ++_i) \
        __builtin_amdgcn_global_load_lds((const unsigned*)((const char*)(gbase) + (voff)[_i]), (PG8_LAS unsigned*)(lds + (bufoff) + ldsw + _i * 8192), 16, 0, 0); } while (0)
#define PG8_LDA(dst, b, h) do { _Pragma("unroll") for (int m = 0; m < 4; ++m) _Pragma("unroll") for (int k = 0; k < 2; ++k) dst[m][k] = *(const PG8_LAS bf16x8*)(lds + PG8_SA(b, h) + aoff + m * 2048 + k * 1024); } while (0)
#define PG8_LDB(dst, b, h) do { _Pragma("unroll") for (int n = 0; n < 2; ++n) _Pragma("unroll") for (int k = 0; k < 2; ++k) dst[n][k] = *(const PG8_LAS bf16x8*)(lds + PG8_SB(b, h) + boff + n * 2048 + k * 1024); } while (0)
#define PG8_MMA(ai, bj, At, Bt) do { __builtin_amdgcn_s_setprio(1); _Pragma("unroll") for (int m = 0; m < 4; ++m) _Pragma("unroll") for (int n = 0; n < 2; ++n) _Pragma("unroll") for (int k = 0; k < 2; ++k) \
        acc[ai][bj][m][n] = __builtin_amdgcn_mfma_f32_16x16x32_bf16(Bt[n][k], At[m][k], acc[ai][bj][m][n], 0, 0, 0); __builtin_amdgcn_s_setprio(0); } while (0)
#define PG8_WAIT_V(n) asm volatile("s_waitcnt vmcnt(" #n ")" ::: "memory")
#define PG8_WAIT_L(n) asm volatile("s_waitcnt lgkmcnt(" #n ")" ::: "memory")
#define PG8_BAR __builtin_amdgcn_s_barrier()
#define PG8_SCHED __builtin_amdgcn_sched_barrier(0)
    Unit cur, nxt; int ui = 0;
    if (!S.next(0, cur)) return;
    f32x4 acc[2][2][4][2];
#pragma unroll
    for (int a = 0; a < 2; ++a)
#pragma unroll
        for (int b = 0; b < 2; ++b)
#pragma unroll
            for (int m = 0; m < 4; ++m)
#pragma unroll
                for (int n = 0; n < 2; ++n) acc[a][b][m][n] = (f32x4){0.f, 0.f, 0.f, 0.f};
    bf16x8 At[4][2], B0[2][2], B1[2][2];
    const char* cA = (const char*)g.A + (size_t)cur.pm * tstep; const char* cB = (const char*)g.Bt + (size_t)cur.pn * tstep;
    S.a_ready(cur);
    PG8_STAGE(PG8_SB(0, 0), cB, voffB); PG8_STAGE(PG8_SA(0, 0), cA, voffA); PG8_STAGE(PG8_SB(0, 1), cB + hstep, voffB); PG8_STAGE(PG8_SA(0, 1), cA + hstep, voffA);
    if (wr == 1) PG8_BAR;
    PG8_WAIT_V(4); PG8_BAR;
    PG8_STAGE(PG8_SB(1, 0), cB + kstep, voffB); PG8_STAGE(PG8_SA(1, 0), cA + kstep, voffA); PG8_STAGE(PG8_SB(1, 1), cB + hstep + kstep, voffB);
    PG8_WAIT_V(6); PG8_BAR;
    for (;;) {
        const bool has_next = S.next(ui + 1, nxt);
        const char* nA = has_next ? (const char*)g.A + (size_t)nxt.pm * tstep : cA; const char* nB = has_next ? (const char*)g.Bt + (size_t)nxt.pn * tstep : cB;
        for (int t = 0; t < nt; t += 2) {
            const bool last = (t == nt - 2);
            const char* a1 = cA + (size_t)(t + 1) * kstep;
            const char* a2 = last ? nA : cA + (size_t)(t + 2) * kstep; const char* b2 = last ? nB : cB + (size_t)(t + 2) * kstep;
            const char* a3 = a2 + kstep; const char* b3 = b2 + kstep;
            if (last && has_next) S.a_ready(nxt);
            PG8_LDB(B0, 0, 0); PG8_SCHED; PG8_LDA(At, 0, 0); PG8_STAGE(PG8_SA(1, 1), a1 + hstep, voffA);
            PG8_WAIT_L(8); PG8_BAR; PG8_WAIT_L(0); PG8_MMA(0, 0, At, B0); PG8_BAR; PG8_SCHED;
            PG8_LDB(B1, 0, 1); PG8_STAGE(PG8_SB(0, 0), b2, voffB);
            PG8_BAR; PG8_WAIT_L(0); PG8_MMA(0, 1, At, B1); PG8_BAR;
            PG8_LDA(At, 0, 1); PG8_STAGE(PG8_SA(0, 0), a2, voffA);
            PG8_BAR; PG8_WAIT_L(0); PG8_MMA(1, 0, At, B0); PG8_BAR; PG8_SCHED;
            PG8_STAGE(PG8_SB(0, 1), b2 + hstep, voffB);
            PG8_WAIT_V(6); PG8_BAR; PG8_MMA(1, 1, At, B1); PG8_BAR;
            PG8_LDB(B0, 1, 0); PG8_SCHED; PG8_LDA(At, 1, 0); PG8_STAGE(PG8_SA(0, 1), a2 + hstep, voffA);
            PG8_WAIT_L(8); PG8_BAR; PG8_WAIT_L(0); PG8_MMA(0, 0, At, B0); PG8_BAR; PG8_SCHED;
            PG8_LDB(B1, 1, 1); PG8_STAGE(PG8_SB(1, 0), b3, voffB);
            PG8_BAR; PG8_WAIT_L(0); PG8_MMA(0, 1, At, B1); PG8_BAR;
            PG8_LDA(At, 1, 1); PG8_STAGE(PG8_SA(1, 0), a3, voffA);
            PG8_BAR; PG8_WAIT_L(0); PG8_MMA(1, 0, At, B0); PG8_BAR; PG8_SCHED;
            PG8_STAGE(PG8_SB(1, 1), b3 + hstep, voffB);
            PG8_WAIT_V(6); PG8_BAR; PG8_MMA(1, 1, At, B1); PG8_BAR;
        }
        if constexpr (!Epi::AFTER_DRAIN) { E(acc, cur, wr, wc, fr, fq); S.done(cur); }
        if (!has_next) break;
#pragma unroll
        for (int a = 0; a < 2; ++a)
#pragma unroll
            for (int b = 0; b < 2; ++b)
#pragma unroll
                for (int m = 0; m < 4; ++m)
#pragma unroll
                    for (int n = 0; n < 2; ++n) acc[a][b][m][n] = (f32x4){0.f, 0.f, 0.f, 0.f};
        cur = nxt; cA = nA; cB = nB; ++ui;
    }
    PG8_WAIT_V(0);
    if (wr == 0) PG8_BAR;
    PG8_BAR;
    if constexpr (Epi::AFTER_DRAIN) { E.fused(acc, cur, wr, wc, fr, fq, lds, wid, lane); S.done(cur); }
#undef PG8_SA
#undef PG8_SB
#undef PG8_STAGE
#undef PG8_LDA
#undef PG8_LDB
#undef PG8_MMA
#undef PG8_WAIT_V
#undef PG8_WAIT_L
#undef PG8_BAR
#undef PG8_SCHED
}
}

__device__ __forceinline__ uint2 pack4(pg8::f32x4 v) {
  uint2 r;
  r.x = (unsigned)f2bf(v[0]) | ((unsigned)f2bf(v[1]) << 16);
  r.y = (unsigned)f2bf(v[2]) | ((unsigned)f2bf(v[3]) << 16);
  return r;
}
struct EpiAttnIn {
  static constexpr bool PERM = false, AFTER_DRAIN = false;
  u16* O; const float* rope;
  __device__ __forceinline__ void operator()(const pg8::f32x4 (&acc)[2][2][4][2], const pg8::Unit& u, int wr, int wc, int fr, int fq) const {
    const int row0 = u.pm * 256 + wr * 64 + fr, col0 = u.pn * 256 + wc * 32 + 4 * fq;
    const bool dorope = (u.pn < 10);
    const int axis = wc >> 1, i0 = (wc & 1) * 16 + 4 * fq;
#pragma unroll
    for (int ai = 0; ai < 2; ++ai)
#pragma unroll
      for (int m = 0; m < 4; ++m) {
        const int row = row0 + ai * 128 + m * 16;
        u16* rowp = O + (size_t)row * 5120 + col0;
        if (dorope) {
          const int s = row & 2047;
          const int pos = axis ? (s & 63) : (s >> 6);
          const float4* rp = (const float4*)(rope + (pos * 32 + i0) * 2);
          float4 c01 = rp[0], c23 = rp[1];
#pragma unroll
          for (int bj = 0; bj < 2; ++bj) {
            pg8::f32x4 a = acc[ai][bj][m][0], b = acc[ai][bj][m][1], o0, o1;
            o0[0] = a[0] * c01.x - b[0] * c01.y; o1[0] = b[0] * c01.x + a[0] * c01.y;
            o0[1] = a[1] * c01.z - b[1] * c01.w; o1[1] = b[1] * c01.z + a[1] * c01.w;
            o0[2] = a[2] * c23.x - b[2] * c23.y; o1[2] = b[2] * c23.x + a[2] * c23.y;
            o0[3] = a[3] * c23.z - b[3] * c23.w; o1[3] = b[3] * c23.z + a[3] * c23.w;
            *(uint2*)(rowp + bj * 128) = pack4(o0);
            *(uint2*)(rowp + bj * 128 + 16) = pack4(o1);
          }
        } else {
#pragma unroll
          for (int bj = 0; bj < 2; ++bj) {
            *(uint2*)(rowp + bj * 128) = pack4(acc[ai][bj][m][0]);
            *(uint2*)(rowp + bj * 128 + 16) = pack4(acc[ai][bj][m][1]);
          }
        }
      }
  }
};
struct EpiRaw {
  static constexpr bool PERM = false, AFTER_DRAIN = false;
  u16* O; int ldc;
  __device__ __forceinline__ void operator()(const pg8::f32x4 (&acc)[2][2][4][2], const pg8::Unit& u, int wr, int wc, int fr, int fq) const {
    const int row0 = u.pm * 256 + wr * 64 + fr, col0 = u.pn * 256 + wc * 32 + 4 * fq;
#pragma unroll
    for (int ai = 0; ai < 2; ++ai)
#pragma unroll
      for (int m = 0; m < 4; ++m) {
        u16* rowp = O + (size_t)(row0 + ai * 128 + m * 16) * ldc + col0;
#pragma unroll
        for (int bj = 0; bj < 2; ++bj) {
          *(uint2*)(rowp + bj * 128) = pack4(acc[ai][bj][m][0]);
          *(uint2*)(rowp + bj * 128 + 16) = pack4(acc[ai][bj][m][1]);
        }
      }
  }
};
struct EpiRes {
  static constexpr bool PERM = false, AFTER_DRAIN = false;
  float* out; const float* base; const float* gate;
  __device__ __forceinline__ void operator()(const pg8::f32x4 (&acc)[2][2][4][2], const pg8::Unit& u, int wr, int wc, int fr, int fq) const {
    const int row0 = u.pm * 256 + wr * 64 + fr, col0 = u.pn * 256 + wc * 32 + 4 * fq;
    const int b = (u.pm * 256) >> 11;
    pg8::f32x4 gv[2][2];
#pragma unroll
    for (int bj = 0; bj < 2; ++bj)
#pragma unroll
      for (int n = 0; n < 2; ++n) gv[bj][n] = *(const pg8::f32x4*)(gate + b * 6144 + col0 + bj * 128 + n * 16);
#pragma unroll
    for (int ai = 0; ai < 2; ++ai)
#pragma unroll
      for (int m = 0; m < 4; ++m) {
        const size_t off = (size_t)(row0 + ai * 128 + m * 16) * 2048 + col0;
#pragma unroll
        for (int bj = 0; bj < 2; ++bj)
#pragma unroll
          for (int n = 0; n < 2; ++n) {
            pg8::f32x4 bv = *(const pg8::f32x4*)(base + off + bj * 128 + n * 16);
            *(pg8::f32x4*)(out + off + bj * 128 + n * 16) = bv + gv[bj][n] * acc[ai][bj][m][n];
          }
      }
  }
};
template <class Epi>
__device__ __forceinline__ void run_gemm(float* sm, const u16* A, const u16* Bt, int M, int N, const Epi& E, int c) {
  pg8::Gemm g{A, Bt, M, N, 2048};
  pg8::StaticOrder S; S.init(M, N, (int)gridDim.x, c);
  pg8::gemm_phase<Epi, pg8::StaticOrder>((PG8_LAS unsigned char*)sm, g, S, E);
  __syncthreads();
}

template <int MODE>
__device__ __forceinline__ void epi_pair(const Params& p, int m, int n, float a0, float a1) {
  if (MODE == 1) {
    u16* px = (u16*)(p.ws + OFF_BIG);
    float o0 = a0, o1 = a1;
    if (n < 2560) {
      int g = (n >> 5) & 3, fr = n & 15;
      int axis = g >> 1, i = (g & 1) * 16 + fr;
      int s = m & 2047;
      int pos = axis ? (s & 63) : (s >> 6);
      float2 cs = ((const float2*)(p.ws + OFF_ROPE))[pos * 32 + i];
      o0 = a0 * cs.x - a1 * cs.y;
      o1 = a1 * cs.x + a0 * cs.y;
    }
    px[(size_t)m * 5120 + n] = f2bf(o0);
    px[(size_t)m * 5120 + n + 16] = f2bf(o1);
  } else if (MODE == 5) {
    u16* kvc = (u16*)(p.ws + OFF_KVC);
    kvc[(size_t)m * 1024 + n] = f2bf(a0);
    kvc[(size_t)m * 1024 + n + 16] = f2bf(a1);
  } else if (MODE == 2) {
    const float* mod = (const float*)(p.ws + OFF_MOD);
    int b = m >> 11;
    const float* gate = mod + (0 * 5 + b) * 6144 + 4096;
    p.out[(size_t)m * 2048 + n] = p.x[(size_t)m * 2048 + n] + gate[n] * a0;
    p.out[(size_t)m * 2048 + n + 16] = p.x[(size_t)m * 2048 + n + 16] + gate[n + 16] * a1;
  } else if (MODE == 3) {
    u16* pp = (u16*)(p.ws + OFF_BIG);
    pp[(size_t)m * 8192 + n] = f2bf(a0);
    pp[(size_t)m * 8192 + n + 16] = f2bf(a1);
  } else if (MODE == 4) {
    const float* mod = (const float*)(p.ws + OFF_MOD);
    int b = m >> 11;
    const float* gate = mod + (1 * 5 + b) * 6144 + 4096;
    p.out[(size_t)m * 2048 + n] += gate[n] * a0;
    p.out[(size_t)m * 2048 + n + 16] += gate[n + 16] * a1;
  }
}

template <int MODE>
__device__ void naive_gemm(const Params& p, const u16* __restrict__ A, const u16* __restrict__ Wt, int M, int N) {
  const int tid = threadIdx.x;
  const int ml = tid >> 5, pl = tid & 31;
  const int ntn = N / 64, ntm = M / 16;
  for (int tile = blockIdx.x; tile < ntn * ntm; tile += gridDim.x) {
    int tm = tile / ntn, tn = tile % ntn;
    int m = tm * 16 + ml;
    int n = tn * 64 + (pl >> 4) * 32 + (pl & 15);
    const uint4* a = (const uint4*)(A + (size_t)m * 2048);
    const uint4* w0 = (const uint4*)(Wt + (size_t)n * 2048);
    const uint4* w1 = (const uint4*)(Wt + (size_t)(n + 16) * 2048);
    float acc0 = 0.f, acc1 = 0.f;
#pragma unroll 2
    for (int k = 0; k < 256; ++k) {
      uint4 av = a[k], b0 = w0[k], b1 = w1[k];
      acc0 += bflo(av.x) * bflo(b0.x) + bfhi(av.x) * bfhi(b0.x) + bflo(av.y) * bflo(b0.y) + bfhi(av.y) * bfhi(b0.y)
            + bflo(av.z) * bflo(b0.z) + bfhi(av.z) * bfhi(b0.z) + bflo(av.w) * bflo(b0.w) + bfhi(av.w) * bfhi(b0.w);
      acc1 += bflo(av.x) * bflo(b1.x) + bfhi(av.x) * bfhi(b1.x) + bflo(av.y) * bflo(b1.y) + bfhi(av.y) * bfhi(b1.y)
            + bflo(av.z) * bflo(b1.z) + bfhi(av.z) * bfhi(b1.z) + bflo(av.w) * bflo(b1.w) + bfhi(av.w) * bfhi(b1.w);
    }
    epi_pair<MODE>(p, m, n, acc0, acc1);
  }
}

__device__ void phase_attn_naive(const Params& p, float* sm) {
  const int wid = threadIdx.x >> 6, lane = threadIdx.x & 63;
  float* qs = sm + wid * (128 + 640);
  float* pr = qs + 128;
  const u16* px = (const u16*)(p.ws + OFF_BIG);
  const u16* kvc = (const u16*)(p.ws + OFF_KVC);
  u16* og = (u16*)(p.ws + OFF_ACT);
  const float scale = 0.08838834764831845f;
  for (int item = blockIdx.x * 8 + wid; item < MT * 16; item += gridDim.x * 8) {
    int m = item >> 4, h = item & 15;
    int b = m >> 11, s = m & 2047, kvh = h >> 2, nblk = s >> 7;
    const u16* qrow = px + (size_t)m * 5120 + h * 128;
    qs[lane] = bf2f(qrow[lane]) * scale;
    qs[lane + 64] = bf2f(qrow[lane + 64]) * scale;
    asm volatile("s_waitcnt lgkmcnt(0)" ::: "memory");
    float mx = p.attn_sink[h];
#pragma unroll 1
    for (int j = 0; j < 10; ++j) {
      int kidx = j * 64 + lane;
      const u16* krow;
      bool valid;
      if (kidx < 384) {
        int kpos = (nblk - 1) * 128 + kidx;
        int rel = kpos - s;
        valid = (kpos >= 0) && (kpos < 2048) && (rel <= 128) && (rel >= -128);
        krow = px + (size_t)(b * 2048 + (valid ? kpos : 0)) * 5120 + 2048 + kvh * 128;
      } else {
        valid = true;
        krow = kvc + (size_t)(b * 256 + (kidx - 384)) * 1024 + kvh * 128;
      }
      float d = -1e30f;
      if (valid) {
        d = 0.f;
#pragma unroll 4
        for (int c = 0; c < 16; ++c) {
          uint4 kk = *(const uint4*)(krow + c * 8);
          const float* q8 = qs + c * 8;
          d += q8[0] * bflo(kk.x) + q8[1] * bfhi(kk.x) + q8[2] * bflo(kk.y) + q8[3] * bfhi(kk.y)
             + q8[4] * bflo(kk.z) + q8[5] * bfhi(kk.z) + q8[6] * bflo(kk.w) + q8[7] * bfhi(kk.w);
        }
      }
      pr[kidx] = d;
      mx = fmaxf(mx, d);
    }
    mx = wave_max(mx);
    float sum = 0.f;
#pragma unroll 1
    for (int j = 0; j < 10; ++j) {
      float d = pr[j * 64 + lane];
      float e = (d > -1e29f) ? __expf(d - mx) : 0.f;
      pr[j * 64 + lane] = e;
      sum += e;
    }
    sum = wave_sum(sum);
    sum += __expf(p.attn_sink[h] - mx);
    asm volatile("s_waitcnt lgkmcnt(0)" ::: "memory");
    float o0 = 0.f, o1 = 0.f;
    int k0 = s - 128 < 0 ? 0 : s - 128, k1 = s + 128 > 2047 ? 2047 : s + 128;
    for (int kpos = k0; kpos <= k1; ++kpos) {
      float pv = pr[kpos - (nblk - 1) * 128];
      unsigned vv = *(const unsigned*)(px + (size_t)(b * 2048 + kpos) * 5120 + 2560 + kvh * 128 + lane * 2);
      o0 += pv * bflo(vv); o1 += pv * bfhi(vv);
    }
    for (int c = 0; c < 256; ++c) {
      float pv = pr[384 + c];
      unsigned vv = *(const unsigned*)(kvc + (size_t)(b * 256 + c) * 1024 + 512 + kvh * 128 + lane * 2);
      o0 += pv * bflo(vv); o1 += pv * bfhi(vv);
    }
    float inv = 1.f / sum;
    unsigned gg = *(const unsigned*)(px + (size_t)m * 5120 + 3072 + h * 128 + lane * 2);
    float r0 = o0 * inv * siluf(bflo(gg)), r1 = o1 * inv * siluf(bfhi(gg));
    *(unsigned*)(og + (size_t)m * 2048 + h * 128 + lane * 2) = (unsigned)f2bf(r0) | ((unsigned)f2bf(r1) << 16);
    asm volatile("s_waitcnt lgkmcnt(0)" ::: "memory");
  }
}

__device__ __forceinline__ float sconv(const u16* pp, const float* cw, const float* cb, int b, int t, int c) {
  const u16* base = pp + (size_t)(b * 2048 + t) * 8192 + c;
  float v = cw[6144 + c] * bf2f(base[0]) + cb[c];
  if (t > 0) v += cw[c] * bf2f(base[-8192]);
  if (t < 2047) v += cw[2 * 6144 + c] * bf2f(base[8192]);
  return v;
}

__device__ void phase_conv_naive(const Params& p, float* sm) {
  const int tid = threadIdx.x;
  float* u = sm;
  float* R = sm + 8192;
  const u16* pp = (const u16*)(p.ws + OFF_BIG);
  const u16* Rg = (const u16*)(p.ws + OFF_FILT);
  u16* yg = (u16*)(p.ws + OFF_ACT);
  for (int ch = blockIdx.x; ch < 2048; ch += gridDim.x) {
    for (int i = tid; i < 8192; i += NTHREADS) u[i] = sconv(pp, p.hy_conv_w, p.hy_conv_b, i >> 11, i & 2047, 4096 + ch);
    for (int i = tid; i < 4096; i += NTHREADS) R[i] = bf2f(Rg[((size_t)0 * 2048 + ch) * 4096 + i]);
    __syncthreads();
    float zr[16];
#pragma unroll
    for (int q = 0; q < 16; ++q) {
      int i = tid + q * NTHREADS;
      int b = i >> 11, t = i & 2047;
      const float* ub = u + b * 2048;
      const float* Rb = R + 2048 - t;
      float a = 0.f;
      for (int s = 0; s < 2048; ++s) a += Rb[s] * ub[s];
      zr[q] = a * sconv(pp, p.hy_conv_w, p.hy_conv_b, b, t, ch);
    }
    __syncthreads();
#pragma unroll
    for (int q = 0; q < 16; ++q) u[tid + q * NTHREADS] = zr[q];
    for (int i = tid; i < 4096; i += NTHREADS) R[i] = bf2f(Rg[((size_t)1 * 2048 + ch) * 4096 + i]);
    __syncthreads();
#pragma unroll
    for (int q = 0; q < 16; ++q) {
      int i = tid + q * NTHREADS;
      int b = i >> 11, t = i & 2047;
      const float* ub = u + b * 2048;
      const float* Rb = R + 2048 - t;
      float a = 0.f;
      for (int s = 0; s < 2048; ++s) a += Rb[s] * ub[s];
      float y = a * sconv(pp, p.hy_conv_w, p.hy_conv_b, b, t, 2048 + ch);
      float g = bf2f(pp[(size_t)(b * 2048 + t) * 8192 + 6144 + ch]);
      yg[(size_t)(b * 2048 + t) * 2048 + ch] = f2bf(y * siluf(g));
    }
    __syncthreads();
  }
}

constexpr int N_PHASES = 10;
__global__ void __launch_bounds__(NTHREADS, 2) mega(Params p, int ph0, int ph1) {
  extern __shared__ __attribute__((aligned(16))) float sm[];
#define PH(i, body) if (ph0 <= (i) && (i) < ph1) { body; if ((i) + 1 < ph1) cg::this_grid().sync(); }
  PH(0, phase0(p, sm))
  PH(1, phase_norm(p, 0))
  PH(2, run_gemm(sm, (const u16*)(p.ws + OFF_ACT), (const u16*)(p.ws + OFF_WT_AI), MT, ATTN_IN,
                 EpiAttnIn{(u16*)(p.ws + OFF_BIG), (const float*)(p.ws + OFF_ROPE)}, (int)blockIdx.x);
        run_gemm(sm, (const u16*)(p.ws + OFF_HC), (const u16*)(p.ws + OFF_WT_AI) + (size_t)2048 * 2048, MC, 1024,
                 EpiRaw{(u16*)(p.ws + OFF_KVC), 1024}, (int)((blockIdx.x + (gridDim.x >> 1)) % gridDim.x)))
  PH(3, phase_attn_naive(p, sm))
  PH(4, run_gemm(sm, (const u16*)(p.ws + OFF_ACT), (const u16*)(p.ws + OFF_WT_AO), MT, 2048,
                 EpiRes{p.out, p.x, (const float*)(p.ws + OFF_MOD) + 4096}, (int)blockIdx.x))
  PH(5, phase_norm(p, 1))
  PH(6, run_gemm(sm, (const u16*)(p.ws + OFF_ACT), (const u16*)(p.ws + OFF_WT_HI), MT, HY_IN,
                 EpiRaw{(u16*)(p.ws + OFF_BIG), 8192}, (int)blockIdx.x))
  PH(7, phase_conv_naive(p, sm))
  PH(8, run_gemm(sm, (const u16*)(p.ws + OFF_ACT), (const u16*)(p.ws + OFF_WT_HO), MT, 2048,
                 EpiRes{p.out, p.out, (const float*)(p.ws + OFF_MOD) + 5 * 6144 + 4096}, (int)blockIdx.x))
  PH(9, phase_norm(p, 2))
}

extern "C" void kernel_launch(void* const* d_in, const int* in_sizes, int n_in, void* d_out, int out_size,
                              void* d_ws, size_t ws_size, hipStream_t stream) {
  Params p{};
  const float** f = (const float**)&p;
  for (int i = 0; i < 23; ++i) f[i] = (const float*)d_in[i];
  p.out = (float*)d_out;
  p.ws = (char*)d_ws;
  constexpr size_t kLds = 128 * 1024;
  static int grid_blocks = 0;
  if (!grid_blocks) {
    (void)hipFuncSetAttribute((const void*)mega, hipFuncAttributeMaxDynamicSharedMemorySize, (int)kLds);
    int dev = 0, cus = 0, per_cu = 0;
    (void)hipGetDevice(&dev);
    (void)hipDeviceGetAttribute(&cus, hipDeviceAttributeMultiprocessorCount, dev);
    (void)hipOccupancyMaxActiveBlocksPerMultiprocessor(&per_cu, mega, NTHREADS, kLds);
    if (per_cu < 1) per_cu = 1;
    grid_blocks = cus * per_cu;
  }
  int ph0 = 0, ph1 = N_PHASES;
  void* args[] = {(void*)&p, (void*)&ph0, (void*)&ph1};
  hipError_t e = hipLaunchCooperativeKernel((const void*)mega, dim3(grid_blocks), dim3(NTHREADS), args, kLds, stream);
  if (e != hipSuccess) fprintf(stderr, "cooperative launch failed: %s (grid %d)\n", hipGetErrorString(e), grid_blocks);
}
```

```cpp
#include <hip/hip_runtime.h>
#include <hip/hip_bf16.h>
#include <hip/hip_cooperative_groups.h>
#include <cstdio>
namespace cg = cooperative_groups;
typedef unsigned short u16;

#define NTHREADS 512
constexpr int Bn = 4, Sn = 2048, Dn = 2048, Cn = 256;
constexpr int MT = Bn * Sn;
constexpr int MC = Bn * Cn;
constexpr int ATTN_IN = 5120;
constexpr int HY_IN = 8192;

constexpr size_t OFF_WT_AI = 0;
constexpr size_t OFF_WT_AO = OFF_WT_AI + (size_t)5120 * 2048 * 2;
constexpr size_t OFF_WT_HI = OFF_WT_AO + (size_t)2048 * 2048 * 2;
constexpr size_t OFF_WT_HO = OFF_WT_HI + (size_t)8192 * 2048 * 2;
constexpr size_t OFF_MOD   = OFF_WT_HO + (size_t)2048 * 2048 * 2;
constexpr size_t OFF_ROPE  = OFF_MOD + (size_t)2 * 5 * 6144 * 4 + 256;
constexpr size_t OFF_FILT  = OFF_ROPE + (size_t)64 * 32 * 8;
constexpr size_t OFF_ACT   = OFF_FILT + (size_t)2 * 2048 * 4096 * 2;
constexpr size_t OFF_HC    = OFF_ACT + (size_t)8192 * 2048 * 2;
constexpr size_t OFF_KVC   = OFF_HC + (size_t)1024 * 2048 * 2;
constexpr size_t OFF_BIG   = OFF_KVC + (size_t)1024 * 1024 * 2;

struct Params {
  const float *x, *c, *ctx, *c_ctx, *norm_g, *ada_w, *ada_b, *attn_w_in, *attn_w_out, *attn_sink;
  const float *hy_w_in, *hy_conv_w, *hy_conv_b, *hy_w1, *hy_b1, *hy_w2, *hy_b2, *hy_w3, *hy_b3;
  const float *hy_freq, *hy_bias_d, *hy_w_out, *final_g;
  float* out;
  char* ws;
};

__device__ __forceinline__ u16 f2bf(float f) {
  unsigned u = __float_as_uint(f);
  u += 0x7fffu + ((u >> 16) & 1u);
  return (u16)(u >> 16);
}
__device__ __forceinline__ float bf2f(u16 h) { return __uint_as_float(((unsigned)h) << 16); }
__device__ __forceinline__ float bflo(unsigned w) { return __uint_as_float(w << 16); }
__device__ __forceinline__ float bfhi(unsigned w) { return __uint_as_float(w & 0xffff0000u); }
__device__ __forceinline__ float siluf(float v) { return v / (1.f + __expf(-v)); }
__device__ __forceinline__ float wave_sum(float v) {
#pragma unroll
  for (int o = 32; o > 0; o >>= 1) v += __shfl_xor(v, o, 64);
  return v;
}
__device__ __forceinline__ float wave_max(float v) {
#pragma unroll
  for (int o = 32; o > 0; o >>= 1) v = fmaxf(v, __shfl_xor(v, o, 64));
  return v;
}

__device__ void p0_convert(const float* __restrict__ W, u16* __restrict__ Wt, int N, int tk, int tn,
                           bool perm, float* sm) {
  const int tid = threadIdx.x;
  for (int i = tid; i < 64 * 32; i += NTHREADS) {
    int r = i >> 5, c4 = i & 31;
    float4 v = *(const float4*)(W + (size_t)(tk * 64 + r) * N + tn * 128 + c4 * 4);
    float* d = sm + r * 129 + c4 * 4;
    d[0] = v.x; d[1] = v.y; d[2] = v.z; d[3] = v.w;
  }
  __syncthreads();
  for (int i = tid; i < 128 * 8; i += NTHREADS) {
    int nrow = i >> 3, kc = i & 7;
    int src = nrow;
    if (perm && (tn * 128 < 2560)) {
      int g = nrow >> 5, nn = (nrow >> 4) & 1, fr = nrow & 15;
      src = (g >> 1) * 64 + nn * 32 + (g & 1) * 16 + fr;
    }
    unsigned w[4];
#pragma unroll
    for (int j = 0; j < 4; ++j) {
      float a = sm[(kc * 8 + 2 * j) * 129 + src];
      float b = sm[(kc * 8 + 2 * j + 1) * 129 + src];
      w[j] = (unsigned)f2bf(a) | ((unsigned)f2bf(b) << 16);
    }
    *(uint4*)(Wt + (size_t)(tn * 128 + nrow) * 2048 + tk * 64 + kc * 8) = make_uint4(w[0], w[1], w[2], w[3]);
  }
  __syncthreads();
}

__device__ void p0_adaln(const Params& p, int item, float* sm) {
  const int tid = threadIdx.x;
  float* sv = sm;
  float* red = sm + 5 * 2048;
  int col0 = item * 48;
  int l = col0 / 6144, n0 = col0 % 6144;
  for (int i = tid; i < 5 * 2048; i += NTHREADS) {
    int v = i >> 11, k = i & 2047;
    float cv = v < 4 ? p.c[v * 2048 + k] : p.c_ctx[k];
    sv[i] = cv / (1.f + expf(-cv));
  }
  __syncthreads();
  int kg = tid / 12, cq = tid % 12;
  float acc[5][4];
#pragma unroll
  for (int v = 0; v < 5; ++v)
#pragma unroll
    for (int j = 0; j < 4; ++j) acc[v][j] = 0.f;
  if (kg < 42) {
    const float* W = p.ada_w + (size_t)l * 2048 * 6144 + n0 + cq * 4;
#pragma unroll 2
    for (int k = kg; k < 2048; k += 42) {
      float4 w = *(const float4*)(W + (size_t)k * 6144);
#pragma unroll
      for (int v = 0; v < 5; ++v) {
        float s = sv[v * 2048 + k];
        acc[v][0] += s * w.x; acc[v][1] += s * w.y; acc[v][2] += s * w.z; acc[v][3] += s * w.w;
      }
    }
  }
  if (kg >= 21 && kg < 42) {
#pragma unroll
    for (int v = 0; v < 5; ++v)
#pragma unroll
      for (int j = 0; j < 4; ++j) red[((kg - 21) * 5 + v) * 48 + cq * 4 + j] = acc[v][j];
  }
  __syncthreads();
  if (kg < 21) {
#pragma unroll
    for (int v = 0; v < 5; ++v)
#pragma unroll
      for (int j = 0; j < 4; ++j) red[(kg * 5 + v) * 48 + cq * 4 + j] += acc[v][j];
  }
  __syncthreads();
  if (tid < 240) {
    int v = tid / 48, cc = tid % 48;
    float s = 0.f;
    for (int g = 0; g < 21; ++g) s += red[(g * 5 + v) * 48 + cc];
    float* mod = (float*)(p.ws + OFF_MOD);
    mod[(l * 5 + v) * 6144 + n0 + cc] = s + p.ada_b[l * 6144 + n0 + cc];
  }
  __syncthreads();
}

__device__ void p0_rope(const Params& p) {
  float2* rope = (float2*)(p.ws + OFF_ROPE);
  for (int i = threadIdx.x; i < 64 * 32; i += NTHREADS) {
    int pos = i >> 5, j = i & 31;
    float inv = powf(10000.f, -(float)(2 * j) / 64.f);
    float ang = (float)pos * inv;
    rope[i] = make_float2(cosf(ang), sinf(ang));
  }
}

__device__ void p0_filter(const Params& p, int item, float* sm) {
  const int tid = threadIdx.x;
  int tt = item >> 5, nc = item & 31;
  float* z = sm;
  float* h1 = z + 32 * 33;
  float* h2 = h1 + 32 * 64;
  u16* outT = (u16*)(h2 + 32 * 64);
  for (int i = tid; i < 32 * 33; i += NTHREADS) {
    int pos = i / 33, e = i % 33;
    int t = tt * 32 + pos;
    float val;
    if (e == 0) val = (float)t / 2047.f;
    else {
      int bi = (e - 1) & 15;
      float w = 6.283185307179586f * (float)t / 2048.f;
      float fr = 1e-4f + (float)bi * ((15.f - 1e-4f) / 15.f);
      float ang = w * fr;
      val = (e <= 16) ? cosf(ang) : -sinf(ang);
    }
    z[i] = val;
  }
  __syncthreads();
  for (int i = tid; i < 32 * 64; i += NTHREADS) {
    int pos = i >> 6, j = i & 63;
    float a = p.hy_b1[j];
#pragma unroll 3
    for (int e = 0; e < 33; ++e) a += z[pos * 33 + e] * p.hy_w1[e * 64 + j];
    h1[i] = sinf(p.hy_freq[j] * a);
  }
  __syncthreads();
  for (int i = tid; i < 32 * 64; i += NTHREADS) {
    int pos = i >> 6, j = i & 63;
    float a = p.hy_b2[j];
#pragma unroll 4
    for (int e = 0; e < 64; ++e) a += h1[pos * 64 + e] * p.hy_w2[e * 64 + j];
    h2[i] = sinf(p.hy_freq[j] * a);
  }
  __syncthreads();
  {
    int nl = tid & 255, ph = tid >> 8;
    int n = nc * 256 + nl;
    float acc[16];
#pragma unroll
    for (int q = 0; q < 16; ++q) acc[q] = 0.f;
#pragma unroll 2
    for (int k = 0; k < 64; ++k) {
      float w = p.hy_w3[(size_t)k * 8192 + n];
#pragma unroll
      for (int q = 0; q < 16; ++q) acc[q] += h2[(ph * 16 + q) * 64 + k] * w;
    }
    int ch = n & 2047, od = n >> 11;
    float b3 = p.hy_b3[n];
    const float min_decay = -3.0701134573253945f, max_decay = -15.350567286626972f;
    float delta = min_decay + (float)ch * ((max_decay - min_decay) / 2047.f);
    float ad = fabsf(delta);
    float bias = ((od & 1) == 0) ? p.hy_bias_d[(od >> 1) * 2048 + ch] : 0.f;
#pragma unroll
    for (int q = 0; q < 16; ++q) {
      int pos = ph * 16 + q;
      int t = tt * 32 + pos;
      float tn = (float)t / 2047.f;
      float v = (acc[q] + b3) * (expf(-tn * ad) + 0.05f);
      if (t == 0) v += bias;
      outT[nl * 34 + pos] = f2bf(v);
    }
  }
  __syncthreads();
  {
    u16* Rg = (u16*)(p.ws + OFF_FILT);
    for (int i = tid; i < 256 * 32; i += NTHREADS) {
      int nl = i >> 5, pos = i & 31;
      int n = nc * 256 + nl;
      int ch = n & 2047, od = n >> 11;
      int o = od >> 1, dir = od & 1;
      int t = tt * 32 + pos;
      u16 v = outT[nl * 34 + pos];
      u16* R = Rg + ((size_t)o * 2048 + ch) * 4096;
      if (dir == 0) R[2048 - t] = v;
      else {
        if (t > 0) R[2048 + t] = v;
        else R[0] = 0;
      }
    }
  }
  __syncthreads();
}

constexpr int N_ADA = 256;
constexpr int N_CV_AI = 32 * 40, N_CV_AO = 32 * 16, N_CV_HI = 32 * 64, N_CV_HO = 32 * 16;
constexpr int N_FILT = 64 * 32;
__device__ void phase0(const Params& p, float* sm) {
  const int total = N_ADA + 1 + N_FILT + N_CV_AI + N_CV_AO + N_CV_HI + N_CV_HO;
  for (int it = blockIdx.x; it < total; it += gridDim.x) {
    int i = it;
    if (i < N_ADA) { p0_adaln(p, i, sm); continue; }
    i -= N_ADA;
    if (i < 1) { p0_rope(p); continue; }
    i -= 1;
    if (i < N_FILT) { p0_filter(p, i, sm); continue; }
    i -= N_FILT;
    if (i < N_CV_AI) { p0_convert(p.attn_w_in, (u16*)(p.ws + OFF_WT_AI), 5120, i / 40, i % 40, true, sm); continue; }
    i -= N_CV_AI;
    if (i < N_CV_AO) { p0_convert(p.attn_w_out, (u16*)(p.ws + OFF_WT_AO), 2048, i / 16, i % 16, false, sm); continue; }
    i -= N_CV_AO;
    if (i < N_CV_HI) { p0_convert(p.hy_w_in, (u16*)(p.ws + OFF_WT_HI), 8192, i / 64, i % 64, false, sm); continue; }
    i -= N_CV_HI;
    p0_convert(p.hy_w_out, (u16*)(p.ws + OFF_WT_HO), 2048, i / 16, i % 16, false, sm);
  }
}

__device__ void norm_row(const float* __restrict__ src, const float* __restrict__ g, const float* shift,
                         const float* scale, u16* dst_bf, float* dst_f, int lane) {
  float4 v[8];
  float ss = 0.f;
#pragma unroll
  for (int j = 0; j < 8; ++j) {
    v[j] = *(const float4*)(src + (j * 64 + lane) * 4);
    ss += v[j].x * v[j].x + v[j].y * v[j].y + v[j].z * v[j].z + v[j].w * v[j].w;
  }
  ss = wave_sum(ss);
  float r = rsqrtf(ss * (1.f / 2048.f) + 1e-6f);
#pragma unroll
  for (int j = 0; j < 8; ++j) {
    int c = (j * 64 + lane) * 4;
    float4 gg = *(const float4*)(g + c);
    float4 o = make_float4(v[j].x * r * gg.x, v[j].y * r * gg.y, v[j].z * r * gg.z, v[j].w * r * gg.w);
    if (dst_bf) {
      float4 sh = *(const float4*)(shift + c);
      float4 sc = *(const float4*)(scale + c);
      o.x = o.x * (1.f + sc.x) + sh.x; o.y = o.y * (1.f + sc.y) + sh.y;
      o.z = o.z * (1.f + sc.z) + sh.z; o.w = o.w * (1.f + sc.w) + sh.w;
      uint2 pk;
      pk.x = (unsigned)f2bf(o.x) | ((unsigned)f2bf(o.y) << 16);
      pk.y = (unsigned)f2bf(o.z) | ((unsigned)f2bf(o.w) << 16);
      *(uint2*)(dst_bf + c) = pk;
    } else {
      *(float4*)(dst_f + c) = o;
    }
  }
}

__device__ void phase_norm(const Params& p, int mode) {
  const int wid = threadIdx.x >> 6, lane = threadIdx.x & 63;
  const float* mod = (const float*)(p.ws + OFF_MOD);
  int nrows = (mode == 0) ? (MT + MC) : MT;
  for (int row = blockIdx.x * 8 + wid; row < nrows; row += gridDim.x * 8) {
    if (mode == 0) {
      if (row < MT) {
        int b = row >> 11;
        const float* m = mod + (0 * 5 + b) * 6144;
        norm_row(p.x + (size_t)row * 2048, p.norm_g, m, m + 2048, (u16*)(p.ws + OFF_ACT) + (size_t)row * 2048, nullptr, lane);
      } else {
        int rc = row - MT;
        const float* m = mod + (0 * 5 + 4) * 6144;
        norm_row(p.ctx + (size_t)rc * 2048, p.norm_g, m, m + 2048, (u16*)(p.ws + OFF_HC) + (size_t)rc * 2048, nullptr, lane);
      }
    } else if (mode == 1) {
      int b = row >> 11;
      const float* m = mod + (1 * 5 + b) * 6144;
      norm_row(p.out + (size_t)row * 2048, p.norm_g + 2048, m, m + 2048, (u16*)(p.ws + OFF_ACT) + (size_t)row * 2048, nullptr, lane);
    } else {
      norm_row(p.out + (size_t)row * 2048, p.final_g, nullptr, nullptr, nullptr, p.out + (size_t)row * 2048, lane);
    }
  }
}

namespace pg8 {
#define PG8_LAS __attribute__((address_space(3)))
typedef unsigned short bf16_t;
typedef short bf16x8 __attribute__((ext_vector_type(8)));
typedef float f32x4 __attribute__((ext_vector_type(4)));
typedef unsigned u32x4 __attribute__((ext_vector_type(4)));
constexpr int BM = 256, BK = 64, HALF = 128, HTB = HALF * BK * 2  , STAGE_BYTES = 8 * HTB, NXCD = 8, WGM = 8;

__host__ __device__ __forceinline__ int lds_byte(int r, int c) { const int st = (r >> 4) * 2 + (c >> 5), rr = r & 15, cc = c & 31, ob = rr * 64 + cc * 2; return st * 1024 + (ob ^ (((ob >> 9) & 1) << 5)); }
__host__ __device__ __forceinline__ void stage_rc(int b, int& R, int& C) { const int st = b / 1024, sb = b % 1024, swz = sb ^ (((sb >> 9) & 1) << 5); R = (st >> 1) * 16 + swz / 64; C = (st & 1) * 32 + (swz % 64) / 2; }
__host__ __device__ __forceinline__ int perm32(int rho) { const int n = rho >> 4, i = rho & 15; return 8 * (i >> 2) + 4 * n + (i & 3); }

struct Unit { int pm, pn; };
struct Gemm { const bf16_t* A; const bf16_t* Bt; int M, N, K; };

struct StaticOrder {
    int nM, nN, nwg, G, c;
    __host__ __device__ void init(int M, int N, int G_, int c_) { nM = M / BM; nN = N / BM; nwg = nM * nN; G = G_; c = c_; }
    __host__ __device__ bool next(int i, Unit& u) const {
        const long L = (long)i * G + c; if (L >= nwg) return false;
        int wgid = (int)L; { const int q = nwg / NXCD, r = nwg % NXCD, xcd = wgid % NXCD, off = wgid / NXCD; wgid = (xcd < r ? xcd * (q + 1) : r * (q + 1) + (xcd - r) * q) + off; }
        const int nig = WGM * nN, gid = wgid / nig, fm = gid * WGM, gsz = (nM - fm) < WGM ? (nM - fm) : WGM;
        u.pm = fm + ((wgid % nig) % gsz); u.pn = (wgid % nig) / gsz; return true;
    }
    __device__ __forceinline__ void a_ready(const Unit&) const {}
    __device__ __forceinline__ void done(const Unit&) const {}
};
__device__ __forceinline__ unsigned cvt_pk_bf16(float lo, float hi) { unsigned r; asm volatile("v_cvt_pk_bf16_f32 %0, %1, %2" : "=v"(r) : "v"(lo), "v"(hi)); return r; }
template <class Epi, class Sched>
__device__ __forceinline__ void gemm_phase(PG8_LAS unsigned char* lds, const Gemm g, const Sched& S, const Epi& E) {
    const int tid = threadIdx.x, wid = __builtin_amdgcn_readfirstlane(tid >> 6), lane = tid & 63, wr = wid >> 2, wc = wid & 3, fr = lane & 15, fq = lane >> 4;
    const int K = g.K, nt = K / BK;
    unsigned voffA[2], voffB[2];
#pragma unroll
    for (int i = 0; i < 2; ++i) { int R, C; stage_rc(tid * 16 + i * 8192, R, C); const int Rb = Epi::PERM ? ((R & ~31) + perm32(R & 31)) : R;
        voffA[i] = (unsigned)(R * K + C) * 2u; voffB[i] = (unsigned)(Rb * K + C) * 2u; }
    const size_t kstep = (size_t)(BK * 2);
    const size_t hstep = (size_t)HALF * K * 2;
    const size_t tstep = 2 * hstep;
    const unsigned ldsw = (unsigned)wid * 1024u;
    const int aoff = lds_byte(wr * 64 + fr, fq * 8), boff = lds_byte(wc * 32 + fr, fq * 8);
#define PG8_SA(b, h) (((b) * 2 + (h)) * HTB)
#define PG8_SB(b, h) ((4 + (b) * 2 + (h)) * HTB)
#define PG8_STAGE(bufoff, gbase, voff) do { _Pragma("unroll") for (int _i = 0; _i < 2; ++_i) \
        __builtin_amdgcn_global_load_lds((const unsigned*)((const char*)(gbase) + (voff)[_i]), (PG8_LAS unsigned*)(lds + (bufoff) + ldsw + _i * 8192), 16, 0, 0); } while (0)
#define PG8_LDA(dst, b, h) do { _Pragma("unroll") for (int m = 0; m < 4; ++m) _Pragma("unroll") for (int k = 0; k < 2; ++k) dst[m][k] = *(const PG8_LAS bf16x8*)(lds + PG8_SA(b, h) + aoff + m * 2048 + k * 1024); } while (0)
#define PG8_LDB(dst, b, h) do { _Pragma("unroll") for (int n = 0; n < 2; ++n) _Pragma("unroll") for (int k = 0; k < 2; ++k) dst[n][k] = *(const PG8_LAS bf16x8*)(lds + PG8_SB(b, h) + boff + n * 2048 + k * 1024); } while (0)
#define PG8_MMA(ai, bj, At, Bt) do { __builtin_amdgcn_s_setprio(1); _Pragma("unroll") for (int m = 0; m < 4; ++m) _Pragma("unroll") for (int n = 0; n < 2; ++n) _Pragma("unroll") for (int k = 0; k < 2; ++k) \
        acc[ai][bj][m][n] = __builtin_amdgcn_mfma_f32_16x16x32_bf16(Bt[n][k], At[m][k], acc[ai][bj][m][n], 0, 0, 0); __builtin_amdgcn_s_setprio(0); } while (0)
#define PG8_WAIT_V(n) asm volatile("s_waitcnt vmcnt(" #n ")" ::: "memory")
#define PG8_WAIT_L(n) asm volatile("s_waitcnt lgkmcnt(" #n ")" ::: "memory")
#define PG8_BAR __builtin_amdgcn_s_barrier()
#define PG8_SCHED __builtin_amdgcn_sched_barrier(0)
    Unit cur, nxt; int ui = 0;
    if (!S.next(0, cur)) return;
    f32x4 acc[2][2][4][2];
#pragma unroll
    for (int a = 0; a < 2; ++a)
#pragma unroll
        for (int b = 0; b < 2; ++b)
#pragma unroll
            for (int m = 0; m < 4; ++m)
#pragma unroll
                for (int n = 0; n < 2; ++n) acc[a][b][m][n] = (f32x4){0.f, 0.f, 0.f, 0.f};
    bf16x8 At[4][2], B0[2][2], B1[2][2];
    const char* cA = (const char*)g.A + (size_t)cur.pm * tstep; const char* cB = (const char*)g.Bt + (size_t)cur.pn * tstep;
    S.a_ready(cur);
    PG8_STAGE(PG8_SB(0, 0), cB, voffB); PG8_STAGE(PG8_SA(0, 0), cA, voffA); PG8_STAGE(PG8_SB(0, 1), cB + hstep, voffB); PG8_STAGE(PG8_SA(0, 1), cA + hstep, voffA);
    if (wr == 1) PG8_BAR;
    PG8_WAIT_V(4); PG8_BAR;
    PG8_STAGE(PG8_SB(1, 0), cB + kstep, voffB); PG8_STAGE(PG8_SA(1, 0), cA + kstep, voffA); PG8_STAGE(PG8_SB(1, 1), cB + hstep + kstep, voffB);
    PG8_WAIT_V(6); PG8_BAR;
    for (;;) {
        const bool has_next = S.next(ui + 1, nxt);
        const char* nA = has_next ? (const char*)g.A + (size_t)nxt.pm * tstep : cA; const char* nB = has_next ? (const char*)g.Bt + (size_t)nxt.pn * tstep : cB;
        for (int t = 0; t < nt; t += 2) {
            const bool last = (t == nt - 2);
            const char* a1 = cA + (size_t)(t + 1) * kstep;
            const char* a2 = last ? nA : cA + (size_t)(t + 2) * kstep; const char* b2 = last ? nB : cB + (size_t)(t + 2) * kstep;
            const char* a3 = a2 + kstep; const char* b3 = b2 + kstep;
            if (last && has_next) S.a_ready(nxt);
            PG8_LDB(B0, 0, 0); PG8_SCHED; PG8_LDA(At, 0, 0); PG8_STAGE(PG8_SA(1, 1), a1 + hstep, voffA);
            PG8_WAIT_L(8); PG8_BAR; PG8_WAIT_L(0); PG8_MMA(0, 0, At, B0); PG8_BAR; PG8_SCHED;
            PG8_LDB(B1, 0, 1); PG8_STAGE(PG8_SB(0, 0), b2, voffB);
            PG8_BAR; PG8_WAIT_L(0); PG8_MMA(0, 1, At, B1); PG8_BAR;
            PG8_LDA(At, 0, 1); PG8_STAGE(PG8_SA(0, 0), a2, voffA);
            PG8_BAR; PG8_WAIT_L(0); PG8_MMA(1, 0, At, B0); PG8_BAR; PG8_SCHED;
            PG8_STAGE(PG8_SB(0, 1), b2 + hstep, voffB);
            PG8_WAIT_V(6); PG8_BAR; PG8_MMA(1, 1, At, B1); PG8_BAR;
            PG8_LDB(B0, 1, 0); PG8_SCHED; PG8_LDA(At, 1, 0); PG8_STAGE(PG8_SA(0, 1), a2 + hstep, voffA);
            PG8_WAIT_L(8); PG8_BAR; PG8_WAIT_L(0); PG8_MMA(0, 0, At, B0); PG8_BAR; PG8_SCHED;
            PG8_LDB(B1, 1, 1); PG8_STAGE(PG8_SB(1, 0), b3, voffB);
            PG8_BAR; PG8_WAIT_L(0); PG8_MMA(0, 1, At, B1); PG8_BAR;
            PG8_LDA(At, 1, 1); PG8_STAGE(PG8_SA(1, 0), a3, voffA);
            PG8_BAR; PG8_WAIT_L(0); PG8_MMA(1, 0, At, B0); PG8_BAR; PG8_SCHED;
            PG8_STAGE(PG8_SB(1, 1), b3 + hstep, voffB);
            PG8_WAIT_V(6); PG8_BAR; PG8_MMA(1, 1, At, B1); PG8_BAR;
        }
        if constexpr (!Epi::AFTER_DRAIN) { E(acc, cur, wr, wc, fr, fq); S.done(cur); }
        if (!has_next) break;
#pragma unroll
        for (int a = 0; a < 2; ++a)
#pragma unroll
            for (int b = 0; b < 2; ++b)
#pragma unroll
                for (int m = 0; m < 4; ++m)
#pragma unroll
                    for (int n = 0; n < 2; ++n) acc[a][b][m][n] = (f32x4){0.f, 0.f, 0.f, 0.f};
        cur = nxt; cA = nA; cB = nB; ++ui;
    }
    PG8_WAIT_V(0);
    if (wr == 0) PG8_BAR;
    PG8_BAR;
    if constexpr (Epi::AFTER_DRAIN) { E.fused(acc, cur, wr, wc, fr, fq, lds, wid, lane); S.done(cur); }
#undef PG8_SA
#undef PG8_SB
#undef PG8_STAGE
#undef PG8_LDA
#undef PG8_LDB
#undef PG8_MMA
#undef PG8_WAIT_V
#undef PG8_WAIT_L
#undef PG8_BAR
#undef PG8_SCHED
}
}

__device__ __forceinline__ uint2 pack4(pg8::f32x4 v) {
  uint2 r;
  r.x = (unsigned)f2bf(v[0]) | ((unsigned)f2bf(v[1]) << 16);
  r.y = (unsigned)f2bf(v[2]) | ((unsigned)f2bf(v[3]) << 16);
  return r;
}
struct EpiAttnIn {
  static constexpr bool PERM = false, AFTER_DRAIN = false;
  u16* O; const float* rope;
  __device__ __forceinline__ void operator()(const pg8::f32x4 (&acc)[2][2][4][2], const pg8::Unit& u, int wr, int wc, int fr, int fq) const {
    const int row0 = u.pm * 256 + wr * 64 + fr, col0 = u.pn * 256 + wc * 32 + 4 * fq;
    const bool dorope = (u.pn < 10);
    const int axis = wc >> 1, i0 = (wc & 1) * 16 + 4 * fq;
#pragma unroll
    for (int ai = 0; ai < 2; ++ai)
#pragma unroll
      for (int m = 0; m < 4; ++m) {
        const int row = row0 + ai * 128 + m * 16;
        u16* rowp = O + (size_t)row * 5120 + col0;
        if (dorope) {
          const int s = row & 2047;
          const int pos = axis ? (s & 63) : (s >> 6);
          const float4* rp = (const float4*)(rope + (pos * 32 + i0) * 2);
          float4 c01 = rp[0], c23 = rp[1];
#pragma unroll
          for (int bj = 0; bj < 2; ++bj) {
            pg8::f32x4 a = acc[ai][bj][m][0], b = acc[ai][bj][m][1], o0, o1;
            o0[0] = a[0] * c01.x - b[0] * c01.y; o1[0] = b[0] * c01.x + a[0] * c01.y;
            o0[1] = a[1] * c01.z - b[1] * c01.w; o1[1] = b[1] * c01.z + a[1] * c01.w;
            o0[2] = a[2] * c23.x - b[2] * c23.y; o1[2] = b[2] * c23.x + a[2] * c23.y;
            o0[3] = a[3] * c23.z - b[3] * c23.w; o1[3] = b[3] * c23.z + a[3] * c23.w;
            *(uint2*)(rowp + bj * 128) = pack4(o0);
            *(uint2*)(rowp + bj * 128 + 16) = pack4(o1);
          }
        } else {
#pragma unroll
          for (int bj = 0; bj < 2; ++bj) {
            *(uint2*)(rowp + bj * 128) = pack4(acc[ai][bj][m][0]);
            *(uint2*)(rowp + bj * 128 + 16) = pack4(acc[ai][bj][m][1]);
          }
        }
      }
  }
};
struct EpiRaw {
  static constexpr bool PERM = false, AFTER_DRAIN = false;
  u16* O; int ldc;
  __device__ __forceinline__ void operator()(const pg8::f32x4 (&acc)[2][2][4][2], const pg8::Unit& u, int wr, int wc, int fr, int fq) const {
    const int row0 = u.pm * 256 + wr * 64 + fr, col0 = u.pn * 256 + wc * 32 + 4 * fq;
#pragma unroll
    for (int ai = 0; ai < 2; ++ai)
#pragma unroll
      for (int m = 0; m < 4; ++m) {
        u16* rowp = O + (size_t)(row0 + ai * 128 + m * 16) * ldc + col0;
#pragma unroll
        for (int bj = 0; bj < 2; ++bj) {
          *(uint2*)(rowp + bj * 128) = pack4(acc[ai][bj][m][0]);
          *(uint2*)(rowp + bj * 128 + 16) = pack4(acc[ai][bj][m][1]);
        }
      }
  }
};
struct EpiRes {
  static constexpr bool PERM = false, AFTER_DRAIN = false;
  float* out; const float* base; const float* gate;
  __device__ __forceinline__ void operator()(const pg8::f32x4 (&acc)[2][2][4][2], const pg8::Unit& u, int wr, int wc, int fr, int fq) const {
    const int row0 = u.pm * 256 + wr * 64 + fr, col0 = u.pn * 256 + wc * 32 + 4 * fq;
    const int b = (u.pm * 256) >> 11;
    pg8::f32x4 gv[2][2];
#pragma unroll
    for (int bj = 0; bj < 2; ++bj)
#pragma unroll
      for (int n = 0; n < 2; ++n) gv[bj][n] = *(const pg8::f32x4*)(gate + b * 6144 + col0 + bj * 128 + n * 16);
#pragma unroll
    for (int ai = 0; ai < 2; ++ai)
#pragma unroll
      for (int m = 0; m < 4; ++m) {
        const size_t off = (size_t)(row0 + ai * 128 + m * 16) * 2048 + col0;
#pragma unroll
        for (int bj = 0; bj < 2; ++bj)
#pragma unroll
          for (int n = 0; n < 2; ++n) {
            pg8::f32x4 bv = *(const pg8::f32x4*)(base + off + bj * 128 + n * 16);
            *(pg8::f32x4*)(out + off + bj * 128 + n * 16) = bv + gv[bj][n] * acc[ai][bj][m][n];
          }
      }
  }
};
template <class Epi>
__device__ __forceinline__ void run_gemm(float* sm, const u16* A, const u16* Bt, int M, int N, const Epi& E, int c) {
  pg8::Gemm g{A, Bt, M, N, 2048};
  pg8::StaticOrder S; S.init(M, N, (int)gridDim.x, c);
  pg8::gemm_phase<Epi, pg8::StaticOrder>((PG8_LAS unsigned char*)sm, g, S, E);
  __syncthreads();
}

template <int MODE>
__device__ __forceinline__ void epi_pair(const Params& p, int m, int n, float a0, float a1) {
  if (MODE == 1) {
    u16* px = (u16*)(p.ws + OFF_BIG);
    float o0 = a0, o1 = a1;
    if (n < 2560) {
      int g = (n >> 5) & 3, fr = n & 15;
      int axis = g >> 1, i = (g & 1) * 16 + fr;
      int s = m & 2047;
      int pos = axis ? (s & 63) : (s >> 6);
      float2 cs = ((const float2*)(p.ws + OFF_ROPE))[pos * 32 + i];
      o0 = a0 * cs.x - a1 * cs.y;
      o1 = a1 * cs.x + a0 * cs.y;
    }
    px[(size_t)m * 5120 + n] = f2bf(o0);
    px[(size_t)m * 5120 + n + 16] = f2bf(o1);
  } else if (MODE == 5) {
    u16* kvc = (u16*)(p.ws + OFF_KVC);
    kvc[(size_t)m * 1024 + n] = f2bf(a0);
    kvc[(size_t)m * 1024 + n + 16] = f2bf(a1);
  } else if (MODE == 2) {
    const float* mod = (const float*)(p.ws + OFF_MOD);
    int b = m >> 11;
    const float* gate = mod + (0 * 5 + b) * 6144 + 4096;
    p.out[(size_t)m * 2048 + n] = p.x[(size_t)m * 2048 + n] + gate[n] * a0;
    p.out[(size_t)m * 2048 + n + 16] = p.x[(size_t)m * 2048 + n + 16] + gate[n + 16] * a1;
  } else if (MODE == 3) {
    u16* pp = (u16*)(p.ws + OFF_BIG);
    pp[(size_t)m * 8192 + n] = f2bf(a0);
    pp[(size_t)m * 8192 + n + 16] = f2bf(a1);
  } else if (MODE == 4) {
    const float* mod = (const float*)(p.ws + OFF_MOD);
    int b = m >> 11;
    const float* gate = mod + (1 * 5 + b) * 6144 + 4096;
    p.out[(size_t)m * 2048 + n] += gate[n] * a0;
    p.out[(size_t)m * 2048 + n + 16] += gate[n + 16] * a1;
  }
}

template <int MODE>
__device__ void naive_gemm(const Params& p, const u16* __restrict__ A, const u16* __restrict__ Wt, int M, int N) {
  const int tid = threadIdx.x;
  const int ml = tid >> 5, pl = tid & 31;
  const int ntn = N / 64, ntm = M / 16;
  for (int tile = blockIdx.x; tile < ntn * ntm; tile += gridDim.x) {
    int tm = tile / ntn, tn = tile % ntn;
    int m = tm * 16 + ml;
    int n = tn * 64 + (pl >> 4) * 32 + (pl & 15);
    const uint4* a = (const uint4*)(A + (size_t)m * 2048);
    const uint4* w0 = (const uint4*)(Wt + (size_t)n * 2048);
    const uint4* w1 = (const uint4*)(Wt + (size_t)(n + 16) * 2048);
    float acc0 = 0.f, acc1 = 0.f;
#pragma unroll 2
    for (int k = 0; k < 256; ++k) {
      uint4 av = a[k], b0 = w0[k], b1 = w1[k];
      acc0 += bflo(av.x) * bflo(b0.x) + bfhi(av.x) * bfhi(b0.x) + bflo(av.y) * bflo(b0.y) + bfhi(av.y) * bfhi(b0.y)
            + bflo(av.z) * bflo(b0.z) + bfhi(av.z) * bfhi(b0.z) + bflo(av.w) * bflo(b0.w) + bfhi(av.w) * bfhi(b0.w);
      acc1 += bflo(av.x) * bflo(b1.x) + bfhi(av.x) * bfhi(b1.x) + bflo(av.y) * bflo(b1.y) + bfhi(av.y) * bfhi(b1.y)
            + bflo(av.z) * bflo(b1.z) + bfhi(av.z) * bfhi(b1.z) + bflo(av.w) * bflo(b1.w) + bfhi(av.w) * bfhi(b1.w);
    }
    epi_pair<MODE>(p, m, n, acc0, acc1);
  }
}

__device__ void phase_attn_naive(const Params& p, float* sm) {
  const int wid = threadIdx.x >> 6, lane = threadIdx.x & 63;
  float* qs = sm + wid * (128 + 640);
  float* pr = qs + 128;
  const u16* px = (const u16*)(p.ws + OFF_BIG);
  const u16* kvc = (const u16*)(p.ws + OFF_KVC);
  u16* og = (u16*)(p.ws + OFF_ACT);
  const float scale = 0.08838834764831845f;
  for (int item = blockIdx.x * 8 + wid; item < MT * 16; item += gridDim.x * 8) {
    int m = item >> 4, h = item & 15;
    int b = m >> 11, s = m & 2047, kvh = h >> 2, nblk = s >> 7;
    const u16* qrow = px + (size_t)m * 5120 + h * 128;
    qs[lane] = bf2f(qrow[lane]) * scale;
    qs[lane + 64] = bf2f(qrow[lane + 64]) * scale;
    asm volatile("s_waitcnt lgkmcnt(0)" ::: "memory");
    float mx = p.attn_sink[h];
#pragma unroll 1
    for (int j = 0; j < 10; ++j) {
      int kidx = j * 64 + lane;
      const u16* krow;
      bool valid;
      if (kidx < 384) {
        int kpos = (nblk - 1) * 128 + kidx;
        int rel = kpos - s;
        valid = (kpos >= 0) && (kpos < 2048) && (rel <= 128) && (rel >= -128);
        krow = px + (size_t)(b * 2048 + (valid ? kpos : 0)) * 5120 + 2048 + kvh * 128;
      } else {
        valid = true;
        krow = kvc + (size_t)(b * 256 + (kidx - 384)) * 1024 + kvh * 128;
      }
      float d = -1e30f;
      if (valid) {
        d = 0.f;
#pragma unroll 4
        for (int c = 0; c < 16; ++c) {
          uint4 kk = *(const uint4*)(krow + c * 8);
          const float* q8 = qs + c * 8;
          d += q8[0] * bflo(kk.x) + q8[1] * bfhi(kk.x) + q8[2] * bflo(kk.y) + q8[3] * bfhi(kk.y)
             + q8[4] * bflo(kk.z) + q8[5] * bfhi(kk.z) + q8[6] * bflo(kk.w) + q8[7] * bfhi(kk.w);
        }
      }
      pr[kidx] = d;
      mx = fmaxf(mx, d);
    }
    mx = wave_max(mx);
    float sum = 0.f;
#pragma unroll 1
    for (int j = 0; j < 10; ++j) {
      float d = pr[j * 64 + lane];
      float e = (d > -1e29f) ? __expf(d - mx) : 0.f;
      pr[j * 64 + lane] = e;
      sum += e;
    }
    sum = wave_sum(sum);
    sum += __expf(p.attn_sink[h] - mx);
    asm volatile("s_waitcnt lgkmcnt(0)" ::: "memory");
    float o0 = 0.f, o1 = 0.f;
    int k0 = s - 128 < 0 ? 0 : s - 128, k1 = s + 128 > 2047 ? 2047 : s + 128;
    for (int kpos = k0; kpos <= k1; ++kpos) {
      float pv = pr[kpos - (nblk - 1) * 128];
      unsigned vv = *(const unsigned*)(px + (size_t)(b * 2048 + kpos) * 5120 + 2560 + kvh * 128 + lane * 2);
      o0 += pv * bflo(vv); o1 += pv * bfhi(vv);
    }
    for (int c = 0; c < 256; ++c) {
      float pv = pr[384 + c];
      unsigned vv = *(const unsigned*)(kvc + (size_t)(b * 256 + c) * 1024 + 512 + kvh * 128 + lane * 2);
      o0 += pv * bflo(vv); o1 += pv * bfhi(vv);
    }
    float inv = 1.f / sum;
    unsigned gg = *(const unsigned*)(px + (size_t)m * 5120 + 3072 + h * 128 + lane * 2);
    float r0 = o0 * inv * siluf(bflo(gg)), r1 = o1 * inv * siluf(bfhi(gg));
    *(unsigned*)(og + (size_t)m * 2048 + h * 128 + lane * 2) = (unsigned)f2bf(r0) | ((unsigned)f2bf(r1) << 16);
    asm volatile("s_waitcnt lgkmcnt(0)" ::: "memory");
  }
}

__device__ __forceinline__ float sconv(const u16* pp, const float* cw, const float* cb, int b, int t, int c) {
  const u16* base = pp + (size_t)(b * 2048 + t) * 8192 + c;
  float v = cw[6144 + c] * bf2f(base[0]) + cb[c];
  if (t > 0) v += cw[c] * bf2f(base[-8192]);
  if (t < 2047) v += cw[2 * 6144 + c] * bf2f(base[8192]);
  return v;
}

__device__ void phase_conv_naive(const Params& p, float* sm) {
  const int tid = threadIdx.x;
  float* u = sm;
  float* R = sm + 8192;
  const u16* pp = (const u16*)(p.ws + OFF_BIG);
  const u16* Rg = (const u16*)(p.ws + OFF_FILT);
  u16* yg = (u16*)(p.ws + OFF_ACT);
  for (int ch = blockIdx.x; ch < 2048; ch += gridDim.x) {
    for (int i = tid; i < 8192; i += NTHREADS) u[i] = sconv(pp, p.hy_conv_w, p.hy_conv_b, i >> 11, i & 2047, 4096 + ch);
    for (int i = tid; i < 4096; i += NTHREADS) R[i] = bf2f(Rg[((size_t)0 * 2048 + ch) * 4096 + i]);
    __syncthreads();
    float zr[16];
#pragma unroll
    for (int q = 0; q < 16; ++q) {
      int i = tid + q * NTHREADS;
      int b = i >> 11, t = i & 2047;
      const float* ub = u + b * 2048;
      const float* Rb = R + 2048 - t;
      float a = 0.f;
      for (int s = 0; s < 2048; ++s) a += Rb[s] * ub[s];
      zr[q] = a * sconv(pp, p.hy_conv_w, p.hy_conv_b, b, t, ch);
    }
    __syncthreads();
#pragma unroll
    for (int q = 0; q < 16; ++q) u[tid + q * NTHREADS] = zr[q];
    for (int i = tid; i < 4096; i += NTHREADS) R[i] = bf2f(Rg[((size_t)1 * 2048 + ch) * 4096 + i]);
    __syncthreads();
#pragma unroll
    for (int q = 0; q < 16; ++q) {
      int i = tid + q * NTHREADS;
      int b = i >> 11, t = i & 2047;
      const float* ub = u + b * 2048;
      const float* Rb = R + 2048 - t;
      float a = 0.f;
      for (int s = 0; s < 2048; ++s) a += Rb[s] * ub[s];
      float y = a * sconv(pp, p.hy_conv_w, p.hy_conv_b, b, t, 2048 + ch);
      float g = bf2f(pp[(size_t)(b * 2048 + t) * 8192 + 6144 + ch]);
      yg[(size_t)(b * 2048 + t) * 2048 + ch] = f2bf(y * siluf(g));
    }
    __syncthreads();
  }
}


typedef float f32x16 __attribute__((ext_vector_type(16)));
typedef pg8::bf16x8 bfx8;
constexpr int CONV_RF_BYTES = 4 * 8192;
constexpr int CONV_UB_ONE = 192 * 64;
__device__ __forceinline__ int ub_addr(int col, int chunk) { return col * 64 + ((chunk ^ ((col >> 2) & 3)) << 4); }

__device__ __forceinline__ void conv_mfma(const char* Rf_ci, const char* Ub_w, int lane, f32x16 (&acc)[4]) {
  const int t2 = lane & 31, h = lane >> 5, n = lane & 31;
  const unsigned sh = (unsigned)(t2 & 1) * 16u;
  const int lanedw = (2048 - t2 + 8 * h) >> 1;
#pragma unroll
  for (int j = 0; j < 4; ++j)
#pragma unroll
    for (int r = 0; r < 16; ++r) acc[j][r] = 0.f;
#pragma unroll 1
  for (int f = 0; f < 16; ++f) {
    bfx8 Bw[5][2];
#pragma unroll
    for (int m = 0; m < 5; ++m) {
      const int col = (16 * m - f + 16) * 2 + n;
#pragma unroll
      for (int kh = 0; kh < 2; ++kh) Bw[m][kh] = *(const bfx8*)(Ub_w + ub_addr(col, 2 * kh + h));
    }
    const unsigned* Rp = (const unsigned*)Rf_ci + lanedw - 16 * f;
#pragma unroll
    for (int e = -4; e <= 3; ++e) {
      int ee = e;
      if (e == -4) ee = (f == 0) ? -3 : -4;
      bfx8 A[2];
#pragma unroll
      for (int kh = 0; kh < 2; ++kh) {
        const unsigned* q = Rp - 256 * ee + 8 * kh;
        unsigned w0 = q[0], w1 = q[1], w2 = q[2], w3 = q[3], w4 = q[4];
        pg8::u32x4 pk;
        pk[0] = __builtin_amdgcn_alignbit(w1, w0, sh);
        pk[1] = __builtin_amdgcn_alignbit(w2, w1, sh);
        pk[2] = __builtin_amdgcn_alignbit(w3, w2, sh);
        pk[3] = __builtin_amdgcn_alignbit(w4, w3, sh);
        A[kh] = __builtin_bit_cast(bfx8, pk);
      }
#pragma unroll
      for (int j = 0; j < 4; ++j) {
        const int m = j - e;
        if (m >= 0 && m <= 4) acc[j] = __builtin_amdgcn_mfma_f32_32x32x16_bf16(A[0], Bw[m][0], acc[j], 0, 0, 0);
      }
#pragma unroll
      for (int j = 0; j < 4; ++j) {
        const int m = j - e;
        if (m >= 0 && m <= 4) acc[j] = __builtin_amdgcn_mfma_f32_32x32x16_bf16(A[1], Bw[m][1], acc[j], 0, 0, 0);
      }
    }
  }
}

__device__ __forceinline__ void sconv4(const u16* xp, int t, float w0, float w1, float w2, float cb, float (&o)[4]) {
  uint2 x4 = *(const uint2*)xp;
  float pv = t > 0 ? bf2f(xp[-1]) : 0.f;
  float nx = (t + 4 < 2048) ? bf2f(xp[4]) : 0.f;
  float e0 = bflo(x4.x), e1 = bfhi(x4.x), e2 = bflo(x4.y), e3 = bfhi(x4.y);
  o[0] = w0 * pv + w1 * e0 + w2 * e1 + cb;
  o[1] = w0 * e0 + w1 * e1 + w2 * e2 + cb;
  o[2] = w0 * e1 + w1 * e2 + w2 * e3 + cb;
  o[3] = w0 * e2 + w1 * e3 + w2 * nx + cb;
}

__device__ void phase_conv(const Params& p, float* smf) {
  char* sm = (char*)smf;
  char* Rf = sm;
  char* Ub = sm + CONV_RF_BYTES;
  const int tid = threadIdx.x, wid = tid >> 6, lane = tid & 63;
  const int ci = wid >> 1, bp = wid & 1;
  const u16* pT = (const u16*)(p.ws + OFF_BIG);
  const u16* Rg = (const u16*)(p.ws + OFF_FILT);
  u16* yg = (u16*)(p.ws + OFF_ACT);
  for (int i = tid; i < 8 * CONV_UB_ONE / 16; i += NTHREADS) ((uint4*)Ub)[i] = make_uint4(0, 0, 0, 0);
  __syncthreads();
  char* Ub_w = Ub + (ci * 2 + bp) * CONV_UB_ONE;
  const char* Rf_ci = Rf + ci * 8192;
  const int h = lane >> 5, n = lane & 31;
  for (int item = blockIdx.x; item < 512; item += gridDim.x) {
    const int ch0 = item * 4;
    for (int task = tid; task < 4096; task += NTHREADS) {
      const int q = task & 255, b = (task >> 8) & 3, c = task >> 10;
      const int cc = 4096 + ch0 + c;
      const u16* xp = pT + (size_t)cc * 8192 + b * 2048 + q * 8;
      uint4 x8 = *(const uint4*)xp;
      float pv = q > 0 ? bf2f(xp[-1]) : 0.f;
      float nx = q < 255 ? bf2f(xp[8]) : 0.f;
      float w0 = p.hy_conv_w[cc], w1 = p.hy_conv_w[6144 + cc], w2 = p.hy_conv_w[2 * 6144 + cc], cb = p.hy_conv_b[cc];
      float e[10];
      e[0] = pv; e[1] = bflo(x8.x); e[2] = bfhi(x8.x); e[3] = bflo(x8.y); e[4] = bfhi(x8.y);
      e[5] = bflo(x8.z); e[6] = bfhi(x8.z); e[7] = bflo(x8.w); e[8] = bfhi(x8.w); e[9] = nx;
      unsigned o[4];
#pragma unroll
      for (int k = 0; k < 4; ++k) {
        float a = w0 * e[2 * k] + w1 * e[2 * k + 1] + w2 * e[2 * k + 2] + cb;
        float bb = w0 * e[2 * k + 1] + w1 * e[2 * k + 2] + w2 * e[2 * k + 3] + cb;
        o[k] = (unsigned)f2bf(a) | ((unsigned)f2bf(bb) << 16);
      }
      const int t0 = q * 8, s1 = t0 >> 5, s2 = t0 & 31;
      const int col = (s1 + 16) * 2 + (b & 1);
      *(uint4*)(Ub + (c * 2 + (b >> 1)) * CONV_UB_ONE + ub_addr(col, s2 >> 3)) = make_uint4(o[0], o[1], o[2], o[3]);
    }
    for (int i = tid; i < 2048; i += NTHREADS) {
      const int c = i >> 9, k = i & 511;
      ((uint4*)Rf)[i] = ((const uint4*)(Rg + ((size_t)0 * 2048 + ch0 + c) * 4096))[k];
    }
    __syncthreads();
    f32x16 acc[4];
    const int ch = ch0 + ci;
    conv_mfma(Rf_ci, Ub_w, lane, acc);
    {
      const float w0 = p.hy_conv_w[ch], w1 = p.hy_conv_w[6144 + ch], w2 = p.hy_conv_w[2 * 6144 + ch], cb = p.hy_conv_b[ch];
#pragma unroll
      for (int j = 0; j < 4; ++j)
#pragma unroll
        for (int vg = 0; vg < 4; ++vg) {
          const int t1 = 16 * j + (n >> 1), bl = n & 1, b = 2 * bp + bl, t = 32 * t1 + 8 * vg + 4 * h;
          float x1[4];
          sconv4(pT + (size_t)ch * 8192 + b * 2048 + t, t, w0, w1, w2, cb, x1);
          uint2 pk;
          pk.x = (unsigned)f2bf(x1[0] * acc[j][4 * vg + 0]) | ((unsigned)f2bf(x1[1] * acc[j][4 * vg + 1]) << 16);
          pk.y = (unsigned)f2bf(x1[2] * acc[j][4 * vg + 2]) | ((unsigned)f2bf(x1[3] * acc[j][4 * vg + 3]) << 16);
          const int col = (t1 + 16) * 2 + bl;
          *(uint2*)(Ub_w + ub_addr(col, vg) + 8 * h) = pk;
        }
    }
    __syncthreads();
    for (int i = tid; i < 2048; i += NTHREADS) {
      const int c = i >> 9, k = i & 511;
      ((uint4*)Rf)[i] = ((const uint4*)(Rg + ((size_t)1 * 2048 + ch0 + c) * 4096))[k];
    }
    __syncthreads();
    conv_mfma(Rf_ci, Ub_w, lane, acc);
    {
      const int c2 = 2048 + ch;
      const float w0 = p.hy_conv_w[c2], w1 = p.hy_conv_w[6144 + c2], w2 = p.hy_conv_w[2 * 6144 + c2], cb = p.hy_conv_b[c2];
#pragma unroll
      for (int j = 0; j < 4; ++j)
#pragma unroll
        for (int vg = 0; vg < 4; ++vg) {
          const int t1 = 16 * j + (n >> 1), bl = n & 1, b = 2 * bp + bl, t = 32 * t1 + 8 * vg + 4 * h;
          float x2[4];
          sconv4(pT + (size_t)c2 * 8192 + b * 2048 + t, t, w0, w1, w2, cb, x2);
          uint2 g4 = *(const uint2*)(pT + (size_t)(6144 + ch) * 8192 + b * 2048 + t);
          float y0 = x2[0] * acc[j][4 * vg + 0] * siluf(bflo(g4.x));
          float y1 = x2[1] * acc[j][4 * vg + 1] * siluf(bfhi(g4.x));
          float y2 = x2[2] * acc[j][4 * vg + 2] * siluf(bflo(g4.y));
          float y3 = x2[3] * acc[j][4 * vg + 3] * siluf(bfhi(g4.y));
          uint2 pk;
          pk.x = (unsigned)f2bf(y0) | ((unsigned)f2bf(y1) << 16);
          pk.y = (unsigned)f2bf(y2) | ((unsigned)f2bf(y3) << 16);
          const int col = (t1 + 16) * 2 + bl;
          *(uint2*)(Ub_w + ub_addr(col, vg) + 8 * h) = pk;
        }
    }
    __syncthreads();
    for (int idx = tid; idx < 8192; idx += NTHREADS) {
      const int b = idx >> 11, t = idx & 2047;
      const int s1 = t >> 5, s2 = t & 31;
      const int col = (s1 + 16) * 2 + (b & 1);
      const int a = ub_addr(col, s2 >> 3) + (s2 & 7) * 2;
      const char* base = Ub + (b >> 1) * CONV_UB_ONE + a;
      unsigned v0 = *(const u16*)(base + 0 * 2 * CONV_UB_ONE), v1 = *(const u16*)(base + 1 * 2 * CONV_UB_ONE);
      unsigned v2 = *(const u16*)(base + 2 * 2 * CONV_UB_ONE), v3 = *(const u16*)(base + 3 * 2 * CONV_UB_ONE);
      *(uint2*)(yg + (size_t)idx * 2048 + ch0) = make_uint2(v0 | (v1 << 16), v2 | (v3 << 16));
    }
    __syncthreads();
  }
}

constexpr int N_PHASES = 10;
__global__ void __launch_bounds__(NTHREADS, 2) mega(Params p, int ph0, int ph1) {
  extern __shared__ __attribute__((aligned(16))) float sm[];
#define PH(i, body) if (ph0 <= (i) && (i) < ph1) { body; if ((i) + 1 < ph1) cg::this_grid().sync(); }
  PH(0, phase0(p, sm))
  PH(1, phase_norm(p, 0))
  PH(2, run_gemm(sm, (const u16*)(p.ws + OFF_ACT), (const u16*)(p.ws + OFF_WT_AI), MT, ATTN_IN,
                 EpiAttnIn{(u16*)(p.ws + OFF_BIG), (const float*)(p.ws + OFF_ROPE)}, (int)blockIdx.x);
        run_gemm(sm, (const u16*)(p.ws + OFF_HC), (const u16*)(p.ws + OFF_WT_AI) + (size_t)2048 * 2048, MC, 1024,
                 EpiRaw{(u16*)(p.ws + OFF_KVC), 1024}, (int)((blockIdx.x + (gridDim.x >> 1)) % gridDim.x)))
  PH(3, phase_attn_naive(p, sm))
  PH(4, run_gemm(sm, (const u16*)(p.ws + OFF_ACT), (const u16*)(p.ws + OFF_WT_AO), MT, 2048,
                 EpiRes{p.out, p.x, (const float*)(p.ws + OFF_MOD) + 4096}, (int)blockIdx.x))
  PH(5, phase_norm(p, 1))
  PH(6, run_gemm(sm, (const u16*)(p.ws + OFF_WT_HI), (const u16*)(p.ws + OFF_ACT), HY_IN, MT,
                 EpiRaw{(u16*)(p.ws + OFF_BIG), 8192}, (int)blockIdx.x))
  PH(7, phase_conv(p, sm))
  PH(8, run_gemm(sm, (const u16*)(p.ws + OFF_ACT), (const u16*)(p.ws + OFF_WT_HO), MT, 2048,
                 EpiRes{p.out, p.out, (const float*)(p.ws + OFF_MOD) + 5 * 6144 + 4096}, (int)blockIdx.x))
  PH(9, phase_norm(p, 2))
}

extern "C" void kernel_launch(void* const* d_in, const int* in_sizes, int n_in, void* d_out, int out_size,
                              void* d_ws, size_t ws_size, hipStream_t stream) {
  Params p{};
  const float** f = (const float**)&p;
  for (int i = 0; i < 23; ++i) f[i] = (const float*)d_in[i];
  p.out = (float*)d_out;
  p.ws = (char*)d_ws;
  constexpr size_t kLds = 128 * 1024;
  static int grid_blocks = 0;
  if (!grid_blocks) {
    (void)hipFuncSetAttribute((const void*)mega, hipFuncAttributeMaxDynamicSharedMemorySize, (int)kLds);
    int dev = 0, cus = 0, per_cu = 0;
    (void)hipGetDevice(&dev);
    (void)hipDeviceGetAttribute(&cus, hipDeviceAttributeMultiprocessorCount, dev);
    (void)hipOccupancyMaxActiveBlocksPerMultiprocessor(&per_cu, mega, NTHREADS, kLds);
    if (per_cu < 1) per_cu = 1;
    grid_blocks = cus * per_cu;
  }
  int ph0 = 0, ph1 = N_PHASES;
  void* args[] = {(void*)&p, (void*)&ph0, (void*)&ph1};
  hipError_t e = hipLaunchCooperativeKernel((const void*)mega, dim3(grid_blocks), dim3(NTHREADS), args, kLds, stream);
  if (e != hipSuccess) fprintf(stderr, "cooperative launch failed: %s (grid %d)\n", hipGetErrorString(e), grid_blocks);
}
```

```cpp
#include <hip/hip_runtime.h>
#include <hip/hip_bf16.h>
#include <hip/hip_cooperative_groups.h>
#include <cstdio>
namespace cg = cooperative_groups;
typedef unsigned short u16;

#define NTHREADS 512
constexpr int Bn = 4, Sn = 2048, Dn = 2048, Cn = 256;
constexpr int MT = Bn * Sn;
constexpr int MC = Bn * Cn;
constexpr int ATTN_IN = 5120;
constexpr int HY_IN = 8192;

constexpr size_t OFF_WT_AI = 0;
constexpr size_t OFF_WT_AO = OFF_WT_AI + (size_t)5120 * 2048 * 2;
constexpr size_t OFF_WT_HI = OFF_WT_AO + (size_t)2048 * 2048 * 2;
constexpr size_t OFF_WT_HO = OFF_WT_HI + (size_t)8192 * 2048 * 2;
constexpr size_t OFF_MOD   = OFF_WT_HO + (size_t)2048 * 2048 * 2;
constexpr size_t OFF_ROPE  = OFF_MOD + (size_t)2 * 5 * 6144 * 4 + 256;
constexpr size_t OFF_FILT  = OFF_ROPE + (size_t)64 * 32 * 8;
constexpr size_t OFF_ACT   = OFF_FILT + (size_t)2 * 2048 * 4096 * 2;
constexpr size_t OFF_HC    = OFF_ACT + (size_t)8192 * 2048 * 2;
constexpr size_t OFF_KVC   = OFF_HC + (size_t)1024 * 2048 * 2;
constexpr size_t OFF_VT    = OFF_KVC + (size_t)1024 * 1024 * 2;
constexpr size_t OFF_VCT   = OFF_VT + (size_t)512 * 8192 * 2;
constexpr size_t OFF_BIG   = OFF_VCT + (size_t)512 * 1024 * 2;

struct Params {
  const float *x, *c, *ctx, *c_ctx, *norm_g, *ada_w, *ada_b, *attn_w_in, *attn_w_out, *attn_sink;
  const float *hy_w_in, *hy_conv_w, *hy_conv_b, *hy_w1, *hy_b1, *hy_w2, *hy_b2, *hy_w3, *hy_b3;
  const float *hy_freq, *hy_bias_d, *hy_w_out, *final_g;
  float* out;
  char* ws;
};

__device__ __forceinline__ u16 f2bf(float f) {
  unsigned u = __float_as_uint(f);
  u += 0x7fffu + ((u >> 16) & 1u);
  return (u16)(u >> 16);
}
__device__ __forceinline__ float bf2f(u16 h) { return __uint_as_float(((unsigned)h) << 16); }
__device__ __forceinline__ float bflo(unsigned w) { return __uint_as_float(w << 16); }
__device__ __forceinline__ float bfhi(unsigned w) { return __uint_as_float(w & 0xffff0000u); }
__device__ __forceinline__ float siluf(float v) { return v / (1.f + __expf(-v)); }
__device__ __forceinline__ float wave_sum(float v) {
#pragma unroll
  for (int o = 32; o > 0; o >>= 1) v += __shfl_xor(v, o, 64);
  return v;
}
__device__ __forceinline__ float wave_max(float v) {
#pragma unroll
  for (int o = 32; o > 0; o >>= 1) v = fmaxf(v, __shfl_xor(v, o, 64));
  return v;
}

__device__ void p0_convert(const float* __restrict__ W, u16* __restrict__ Wt, int N, int tk, int tn,
                           bool perm, float* sm) {
  const int tid = threadIdx.x;
  for (int i = tid; i < 64 * 32; i += NTHREADS) {
    int r = i >> 5, c4 = i & 31;
    float4 v = *(const float4*)(W + (size_t)(tk * 64 + r) * N + tn * 128 + c4 * 4);
    float* d = sm + r * 129 + c4 * 4;
    d[0] = v.x; d[1] = v.y; d[2] = v.z; d[3] = v.w;
  }
  __syncthreads();
  for (int i = tid; i < 128 * 8; i += NTHREADS) {
    int nrow = i >> 3, kc = i & 7;
    int src = nrow;
    if (perm && (tn * 128 < 2560)) {
      int g = nrow >> 5, nn = (nrow >> 4) & 1, fr = nrow & 15;
      src = (g >> 1) * 64 + nn * 32 + (g & 1) * 16 + fr;
    }
    unsigned w[4];
#pragma unroll
    for (int j = 0; j < 4; ++j) {
      float a = sm[(kc * 8 + 2 * j) * 129 + src];
      float b = sm[(kc * 8 + 2 * j + 1) * 129 + src];
      w[j] = (unsigned)f2bf(a) | ((unsigned)f2bf(b) << 16);
    }
    *(uint4*)(Wt + (size_t)(tn * 128 + nrow) * 2048 + tk * 64 + kc * 8) = make_uint4(w[0], w[1], w[2], w[3]);
  }
  __syncthreads();
}

__device__ void p0_adaln(const Params& p, int item, float* sm) {
  const int tid = threadIdx.x;
  float* sv = sm;
  float* red = sm + 5 * 2048;
  int col0 = item * 48;
  int l = col0 / 6144, n0 = col0 % 6144;
  for (int i = tid; i < 5 * 2048; i += NTHREADS) {
    int v = i >> 11, k = i & 2047;
    float cv = v < 4 ? p.c[v * 2048 + k] : p.c_ctx[k];
    sv[i] = cv / (1.f + expf(-cv));
  }
  __syncthreads();
  int kg = tid / 12, cq = tid % 12;
  float acc[5][4];
#pragma unroll
  for (int v = 0; v < 5; ++v)
#pragma unroll
    for (int j = 0; j < 4; ++j) acc[v][j] = 0.f;
  if (kg < 42) {
    const float* W = p.ada_w + (size_t)l * 2048 * 6144 + n0 + cq * 4;
#pragma unroll 2
    for (int k = kg; k < 2048; k += 42) {
      float4 w = *(const float4*)(W + (size_t)k * 6144);
#pragma unroll
      for (int v = 0; v < 5; ++v) {
        float s = sv[v * 2048 + k];
        acc[v][0] += s * w.x; acc[v][1] += s * w.y; acc[v][2] += s * w.z; acc[v][3] += s * w.w;
      }
    }
  }
  if (kg >= 21 && kg < 42) {
#pragma unroll
    for (int v = 0; v < 5; ++v)
#pragma unroll
      for (int j = 0; j < 4; ++j) red[((kg - 21) * 5 + v) * 48 + cq * 4 + j] = acc[v][j];
  }
  __syncthreads();
  if (kg < 21) {
#pragma unroll
    for (int v = 0; v < 5; ++v)
#pragma unroll
      for (int j = 0; j < 4; ++j) red[(kg * 5 + v) * 48 + cq * 4 + j] += acc[v][j];
  }
  __syncthreads();
  if (tid < 240) {
    int v = tid / 48, cc = tid % 48;
    float s = 0.f;
    for (int g = 0; g < 21; ++g) s += red[(g * 5 + v) * 48 + cc];
    float* mod = (float*)(p.ws + OFF_MOD);
    mod[(l * 5 + v) * 6144 + n0 + cc] = s + p.ada_b[l * 6144 + n0 + cc];
  }
  __syncthreads();
}

__device__ void p0_rope(const Params& p) {
  float2* rope = (float2*)(p.ws + OFF_ROPE);
  for (int i = threadIdx.x; i < 64 * 32; i += NTHREADS) {
    int pos = i >> 5, j = i & 31;
    float inv = powf(10000.f, -(float)(2 * j) / 64.f);
    float ang = (float)pos * inv;
    rope[i] = make_float2(cosf(ang), sinf(ang));
  }
}

__device__ void p0_filter(const Params& p, int item, float* sm) {
  const int tid = threadIdx.x;
  int tt = item >> 5, nc = item & 31;
  float* z = sm;
  float* h1 = z + 32 * 33;
  float* h2 = h1 + 32 * 64;
  u16* outT = (u16*)(h2 + 32 * 64);
  for (int i = tid; i < 32 * 33; i += NTHREADS) {
    int pos = i / 33, e = i % 33;
    int t = tt * 32 + pos;
    float val;
    if (e == 0) val = (float)t / 2047.f;
    else {
      int bi = (e - 1) & 15;
      float w = 6.283185307179586f * (float)t / 2048.f;
      float fr = 1e-4f + (float)bi * ((15.f - 1e-4f) / 15.f);
      float ang = w * fr;
      val = (e <= 16) ? cosf(ang) : -sinf(ang);
    }
    z[i] = val;
  }
  __syncthreads();
  for (int i = tid; i < 32 * 64; i += NTHREADS) {
    int pos = i >> 6, j = i & 63;
    float a = p.hy_b1[j];
#pragma unroll 3
    for (int e = 0; e < 33; ++e) a += z[pos * 33 + e] * p.hy_w1[e * 64 + j];
    h1[i] = sinf(p.hy_freq[j] * a);
  }
  __syncthreads();
  for (int i = tid; i < 32 * 64; i += NTHREADS) {
    int pos = i >> 6, j = i & 63;
    float a = p.hy_b2[j];
#pragma unroll 4
    for (int e = 0; e < 64; ++e) a += h1[pos * 64 + e] * p.hy_w2[e * 64 + j];
    h2[i] = sinf(p.hy_freq[j] * a);
  }
  __syncthreads();
  {
    int nl = tid & 255, ph = tid >> 8;
    int n = nc * 256 + nl;
    float acc[16];
#pragma unroll
    for (int q = 0; q < 16; ++q) acc[q] = 0.f;
#pragma unroll 2
    for (int k = 0; k < 64; ++k) {
      float w = p.hy_w3[(size_t)k * 8192 + n];
#pragma unroll
      for (int q = 0; q < 16; ++q) acc[q] += h2[(ph * 16 + q) * 64 + k] * w;
    }
    int ch = n & 2047, od = n >> 11;
    float b3 = p.hy_b3[n];
    const float min_decay = -3.0701134573253945f, max_decay = -15.350567286626972f;
    float delta = min_decay + (float)ch * ((max_decay - min_decay) / 2047.f);
    float ad = fabsf(delta);
    float bias = ((od & 1) == 0) ? p.hy_bias_d[(od >> 1) * 2048 + ch] : 0.f;
#pragma unroll
    for (int q = 0; q < 16; ++q) {
      int pos = ph * 16 + q;
      int t = tt * 32 + pos;
      float tn = (float)t / 2047.f;
      float v = (acc[q] + b3) * (expf(-tn * ad) + 0.05f);
      if (t == 0) v += bias;
      outT[nl * 34 + pos] = f2bf(v);
    }
  }
  __syncthreads();
  {
    u16* Rg = (u16*)(p.ws + OFF_FILT);
    for (int i = tid; i < 256 * 32; i += NTHREADS) {
      int nl = i >> 5, pos = i & 31;
      int n = nc * 256 + nl;
      int ch = n & 2047, od = n >> 11;
      int o = od >> 1, dir = od & 1;
      int t = tt * 32 + pos;
      u16 v = outT[nl * 34 + pos];
      u16* R = Rg + ((size_t)o * 2048 + ch) * 4096;
      if (dir == 0) R[2048 - t] = v;
      else {
        if (t > 0) R[2048 + t] = v;
        else R[0] = 0;
      }
    }
  }
  __syncthreads();
}

constexpr int N_ADA = 256;
constexpr int N_CV_AI = 32 * 40, N_CV_AO = 32 * 16, N_CV_HI = 32 * 64, N_CV_HO = 32 * 16;
constexpr int N_FILT = 64 * 32;
__device__ void phase0(const Params& p, float* sm) {
  const int total = N_ADA + 1 + N_FILT + N_CV_AI + N_CV_AO + N_CV_HI + N_CV_HO;
  for (int it = blockIdx.x; it < total; it += gridDim.x) {
    int i = it;
    if (i < N_ADA) { p0_adaln(p, i, sm); continue; }
    i -= N_ADA;
    if (i < 1) { p0_rope(p); continue; }
    i -= 1;
    if (i < N_FILT) { p0_filter(p, i, sm); continue; }
    i -= N_FILT;
    if (i < N_CV_AI) { p0_convert(p.attn_w_in, (u16*)(p.ws + OFF_WT_AI), 5120, i / 40, i % 40, true, sm); continue; }
    i -= N_CV_AI;
    if (i < N_CV_AO) { p0_convert(p.attn_w_out, (u16*)(p.ws + OFF_WT_AO), 2048, i / 16, i % 16, false, sm); continue; }
    i -= N_CV_AO;
    if (i < N_CV_HI) { p0_convert(p.hy_w_in, (u16*)(p.ws + OFF_WT_HI), 8192, i / 64, i % 64, false, sm); continue; }
    i -= N_CV_HI;
    p0_convert(p.hy_w_out, (u16*)(p.ws + OFF_WT_HO), 2048, i / 16, i % 16, false, sm);
  }
}

__device__ void norm_row(const float* __restrict__ src, const float* __restrict__ g, const float* shift,
                         const float* scale, u16* dst_bf, float* dst_f, int lane) {
  float4 v[8];
  float ss = 0.f;
#pragma unroll
  for (int j = 0; j < 8; ++j) {
    v[j] = *(const float4*)(src + (j * 64 + lane) * 4);
    ss += v[j].x * v[j].x + v[j].y * v[j].y + v[j].z * v[j].z + v[j].w * v[j].w;
  }
  ss = wave_sum(ss);
  float r = rsqrtf(ss * (1.f / 2048.f) + 1e-6f);
#pragma unroll
  for (int j = 0; j < 8; ++j) {
    int c = (j * 64 + lane) * 4;
    float4 gg = *(const float4*)(g + c);
    float4 o = make_float4(v[j].x * r * gg.x, v[j].y * r * gg.y, v[j].z * r * gg.z, v[j].w * r * gg.w);
    if (dst_bf) {
      float4 sh = *(const float4*)(shift + c);
      float4 sc = *(const float4*)(scale + c);
      o.x = o.x * (1.f + sc.x) + sh.x; o.y = o.y * (1.f + sc.y) + sh.y;
      o.z = o.z * (1.f + sc.z) + sh.z; o.w = o.w * (1.f + sc.w) + sh.w;
      uint2 pk;
      pk.x = (unsigned)f2bf(o.x) | ((unsigned)f2bf(o.y) << 16);
      pk.y = (unsigned)f2bf(o.z) | ((unsigned)f2bf(o.w) << 16);
      *(uint2*)(dst_bf + c) = pk;
    } else {
      *(float4*)(dst_f + c) = o;
    }
  }
}

__device__ void phase_norm(const Params& p, int mode) {
  const int wid = threadIdx.x >> 6, lane = threadIdx.x & 63;
  const float* mod = (const float*)(p.ws + OFF_MOD);
  int nrows = (mode == 0) ? (MT + MC) : MT;
  for (int row = blockIdx.x * 8 + wid; row < nrows; row += gridDim.x * 8) {
    if (mode == 0) {
      if (row < MT) {
        int b = row >> 11;
        const float* m = mod + (0 * 5 + b) * 6144;
        norm_row(p.x + (size_t)row * 2048, p.norm_g, m, m + 2048, (u16*)(p.ws + OFF_ACT) + (size_t)row * 2048, nullptr, lane);
      } else {
        int rc = row - MT;
        const float* m = mod + (0 * 5 + 4) * 6144;
        norm_row(p.ctx + (size_t)rc * 2048, p.norm_g, m, m + 2048, (u16*)(p.ws + OFF_HC) + (size_t)rc * 2048, nullptr, lane);
      }
    } else if (mode == 1) {
      int b = row >> 11;
      const float* m = mod + (1 * 5 + b) * 6144;
      norm_row(p.out + (size_t)row * 2048, p.norm_g + 2048, m, m + 2048, (u16*)(p.ws + OFF_ACT) + (size_t)row * 2048, nullptr, lane);
    } else {
      norm_row(p.out + (size_t)row * 2048, p.final_g, nullptr, nullptr, nullptr, p.out + (size_t)row * 2048, lane);
    }
  }
}

namespace pg8 {
#define PG8_LAS __attribute__((address_space(3)))
typedef unsigned short bf16_t;
typedef short bf16x8 __attribute__((ext_vector_type(8)));
typedef float f32x4 __attribute__((ext_vector_type(4)));
typedef unsigned u32x4 __attribute__((ext_vector_type(4)));
constexpr int BM = 256, BK = 64, HALF = 128, HTB = HALF * BK * 2  , STAGE_BYTES = 8 * HTB, NXCD = 8, WGM = 8;

__host__ __device__ __forceinline__ int lds_byte(int r, int c) { const int st = (r >> 4) * 2 + (c >> 5), rr = r & 15, cc = c & 31, ob = rr * 64 + cc * 2; return st * 1024 + (ob ^ (((ob >> 9) & 1) << 5)); }
__host__ __device__ __forceinline__ void stage_rc(int b, int& R, int& C) { const int st = b / 1024, sb = b % 1024, swz = sb ^ (((sb >> 9) & 1) << 5); R = (st >> 1) * 16 + swz / 64; C = (st & 1) * 32 + (swz % 64) / 2; }
__host__ __device__ __forceinline__ int perm32(int rho) { const int n = rho >> 4, i = rho & 15; return 8 * (i >> 2) + 4 * n + (i & 3); }

struct Unit { int pm, pn; };
struct Gemm { const bf16_t* A; const bf16_t* Bt; int M, N, K; };

struct StaticOrder {
    int nM, nN, nwg, G, c;
    __host__ __device__ void init(int M, int N, int G_, int c_) { nM = M / BM; nN = N / BM; nwg = nM * nN; G = G_; c = c_; }
    __host__ __device__ bool next(int i, Unit& u) const {
        const long L = (long)i * G + c; if (L >= nwg) return false;
        int wgid = (int)L; { const int q = nwg / NXCD, r = nwg % NXCD, xcd = wgid % NXCD, off = wgid / NXCD; wgid = (xcd < r ? xcd * (q + 1) : r * (q + 1) + (xcd - r) * q) + off; }
        const int nig = WGM * nN, gid = wgid / nig, fm = gid * WGM, gsz = (nM - fm) < WGM ? (nM - fm) : WGM;
        u.pm = fm + ((wgid % nig) % gsz); u.pn = (wgid % nig) / gsz; return true;
    }
    __device__ __forceinline__ void a_ready(const Unit&) const {}
    __device__ __forceinline__ void done(const Unit&) const {}
};
__device__ __forceinline__ unsigned cvt_pk_bf16(float lo, float hi) { unsigned r; asm volatile("v_cvt_pk_bf16_f32 %0, %1, %2" : "=v"(r) : "v"(lo), "v"(hi)); return r; }
template <class Epi, class Sched>
__device__ __forceinline__ void gemm_phase(PG8_LAS unsigned char* lds, const Gemm g, const Sched& S, const Epi& E) {
    const int tid = threadIdx.x, wid = __builtin_amdgcn_readfirstlane(tid >> 6), lane = tid & 63, wr = wid >> 2, wc = wid & 3, fr = lane & 15, fq = lane >> 4;
    const int K = g.K, nt = K / BK;
    unsigned voffA[2], voffB[2];
#pragma unroll
    for (int i = 0; i < 2; ++i) { int R, C; stage_rc(tid * 16 + i * 8192, R, C); const int Rb = Epi::PERM ? ((R & ~31) + perm32(R & 31)) : R;
        voffA[i] = (unsigned)(R * K + C) * 2u; voffB[i] = (unsigned)(Rb * K + C) * 2u; }
    const size_t kstep = (size_t)(BK * 2);
    const size_t hstep = (size_t)HALF * K * 2;
    const size_t tstep = 2 * hstep;
    const unsigned ldsw = (unsigned)wid * 1024u;
    const int aoff = lds_byte(wr * 64 + fr, fq * 8), boff = lds_byte(wc * 32 + fr, fq * 8);
#define PG8_SA(b, h) (((b) * 2 + (h)) * HTB)
#define PG8_SB(b, h) ((4 + (b) * 2 + (h)) * HTB)
#define PG8_STAGE(bufoff, gbase, voff) do { _Pragma("unroll") for (int _i = 0; _i < 2; ++_i) \
        __builtin_amdgcn_global_load_lds((const unsigned*)((const char*)(gbase) + (voff)[_i]), (PG8_LAS unsigned*)(lds + (bufoff) + ldsw + _i * 8192), 16, 0, 0); } while (0)
#define PG8_LDA(dst, b, h) do { _Pragma("unroll") for (int m = 0; m < 4; ++m) _Pragma("unroll") for (int k = 0; k < 2; ++k) dst[m][k] = *(const PG8_LAS bf16x8*)(lds + PG8_SA(b, h) + aoff + m * 2048 + k * 1024); } while (0)
#define PG8_LDB(dst, b, h) do { _Pragma("unroll") for (int n = 0; n < 2; ++n) _Pragma("unroll") for (int k = 0; k < 2; ++k) dst[n][k] = *(const PG8_LAS bf16x8*)(lds + PG8_SB(b, h) + boff + n * 2048 + k * 1024); } while (0)
#define PG8_MMA(ai, bj, At, Bt) do { __builtin_amdgcn_s_setprio(1); _Pragma("unroll") for (int m = 0; m < 4; ++m) _Pragma("unroll") for (int n = 0; n < 2; ++n) _Pragma("unroll") for (int k = 0; k < 2; ++k) \
        acc[ai][bj][m][n] = __builtin_amdgcn_mfma_f32_16x16x32_bf16(Bt[n][k], At[m][k], acc[ai][bj][m][n], 0, 0, 0); __builtin_amdgcn_s_setprio(0); } while (0)
#define PG8_WAIT_V(n) asm volatile("s_waitcnt vmcnt(" #n ")" ::: "memory")
#define PG8_WAIT_L(n) asm volatile("s_waitcnt lgkmcnt(" #n ")" ::: "memory")
#define PG8_BAR __builtin_amdgcn_s_barrier()
#define PG8_SCHED __builtin_amdgcn_sched_barrier(0)
    Unit cur, nxt; int ui = 0;
    if (!S.next(0, cur)) return;
    f32x4 acc[2][2][4][2];
#pragma unroll
    for (int a = 0; a < 2; ++a)
#pragma unroll
        for (int b = 0; b < 2; ++b)
#pragma unroll
            for (int m = 0; m < 4; ++m)
#pragma unroll
                for (int n = 0; n < 2; ++n) acc[a][b][m][n] = (f32x4){0.f, 0.f, 0.f, 0.f};
    bf16x8 At[4][2], B0[2][2], B1[2][2];
    const char* cA = (const char*)g.A + (size_t)cur.pm * tstep; const char* cB = (const char*)g.Bt + (size_t)cur.pn * tstep;
    S.a_ready(cur);
    PG8_STAGE(PG8_SB(0, 0), cB, voffB); PG8_STAGE(PG8_SA(0, 0), cA, voffA); PG8_STAGE(PG8_SB(0, 1), cB + hstep, voffB); PG8_STAGE(PG8_SA(0, 1), cA + hstep, voffA);
    if (wr == 1) PG8_BAR;
    PG8_WAIT_V(4); PG8_BAR;
    PG8_STAGE(PG8_SB(1, 0), cB + kstep, voffB); PG8_STAGE(PG8_SA(1, 0), cA + kstep, voffA); PG8_STAGE(PG8_SB(1, 1), cB + hstep + kstep, voffB);
    PG8_WAIT_V(6); PG8_BAR;
    for (;;) {
        const bool has_next = S.next(ui + 1, nxt);
        const char* nA = has_next ? (const char*)g.A + (size_t)nxt.pm * tstep : cA; const char* nB = has_next ? (const char*)g.Bt + (size_t)nxt.pn * tstep : cB;
        for (int t = 0; t < nt; t += 2) {
            const bool last = (t == nt - 2);
            const char* a1 = cA + (size_t)(t + 1) * kstep;
            const char* a2 = last ? nA : cA + (size_t)(t + 2) * kstep; const char* b2 = last ? nB : cB + (size_t)(t + 2) * kstep;
            const char* a3 = a2 + kstep; const char* b3 = b2 + kstep;
            if (last && has_next) S.a_ready(nxt);
            PG8_LDB(B0, 0, 0); PG8_SCHED; PG8_LDA(At, 0, 0); PG8_STAGE(PG8_SA(1, 1), a1 + hstep, voffA);
            PG8_WAIT_L(8); PG8_BAR; PG8_WAIT_L(0); PG8_MMA(0, 0, At, B0); PG8_BAR; PG8_SCHED;
            PG8_LDB(B1, 0, 1); PG8_STAGE(PG8_SB(0, 0), b2, voffB);
            PG8_BAR; PG8_WAIT_L(0); PG8_MMA(0, 1, At, B1); PG8_BAR;
            PG8_LDA(At, 0, 1); PG8_STAGE(PG8_SA(0, 0), a2, voffA);
            PG8_BAR; PG8_WAIT_L(0); PG8_MMA(1, 0, At, B0); PG8_BAR; PG8_SCHED;
            PG8_STAGE(PG8_SB(0, 1), b2 + hstep, voffB);
            PG8_WAIT_V(6); PG8_BAR; PG8_MMA(1, 1, At, B1); PG8_BAR;
            PG8_LDB(B0, 1, 0); PG8_SCHED; PG8_LDA(At, 1, 0); PG8_STAGE(PG8_SA(0, 1), a2 + hstep, voffA);
            PG8_WAIT_L(8); PG8_BAR; PG8_WAIT_L(0); PG8_MMA(0, 0, At, B0); PG8_BAR; PG8_SCHED;
            PG8_LDB(B1, 1, 1); PG8_STAGE(PG8_SB(1, 0), b3, voffB);
            PG8_BAR; PG8_WAIT_L(0); PG8_MMA(0, 1, At, B1); PG8_BAR;
            PG8_LDA(At, 1, 1); PG8_STAGE(PG8_SA(1, 0), a3, voffA);
            PG8_BAR; PG8_WAIT_L(0); PG8_MMA(1, 0, At, B0); PG8_BAR; PG8_SCHED;
            PG8_STAGE(PG8_SB(1, 1), b3 + hstep, voffB);
            PG8_WAIT_V(6); PG8_BAR; PG8_MMA(1, 1, At, B1); PG8_BAR;
        }
        if constexpr (!Epi::AFTER_DRAIN) { E(acc, cur, wr, wc, fr, fq); S.done(cur); }
        if (!has_next) break;
#pragma unroll
        for (int a = 0; a < 2; ++a)
#pragma unroll
            for (int b = 0; b < 2; ++b)
#pragma unroll
                for (int m = 0; m < 4; ++m)
#pragma unroll
                    for (int n = 0; n < 2; ++n) acc[a][b][m][n] = (f32x4){0.f, 0.f, 0.f, 0.f};
        cur = nxt; cA = nA; cB = nB; ++ui;
    }
    PG8_WAIT_V(0);
    if (wr == 0) PG8_BAR;
    PG8_BAR;
    if constexpr (Epi::AFTER_DRAIN) { E.fused(acc, cur, wr, wc, fr, fq, lds, wid, lane); S.done(cur); }
#undef PG8_SA
#undef PG8_SB
#undef PG8_STAGE
#undef PG8_LDA
#undef PG8_LDB
#undef PG8_MMA
#undef PG8_WAIT_V
#undef PG8_WAIT_L
#undef PG8_BAR
#undef PG8_SCHED
}
}

__device__ __forceinline__ uint2 pack4(pg8::f32x4 v) {
  uint2 r;
  r.x = (unsigned)f2bf(v[0]) | ((unsigned)f2bf(v[1]) << 16);
  r.y = (unsigned)f2bf(v[2]) | ((unsigned)f2bf(v[3]) << 16);
  return r;
}
struct EpiAttnIn {
  static constexpr bool PERM = false, AFTER_DRAIN = false;
  u16* O; const float* rope;
  __device__ __forceinline__ void operator()(const pg8::f32x4 (&acc)[2][2][4][2], const pg8::Unit& u, int wr, int wc, int fr, int fq) const {
    const int row0 = u.pm * 256 + wr * 64 + fr, col0 = u.pn * 256 + wc * 32 + 4 * fq;
    const bool dorope = (u.pn < 10);
    const int axis = wc >> 1, i0 = (wc & 1) * 16 + 4 * fq;
#pragma unroll
    for (int ai = 0; ai < 2; ++ai)
#pragma unroll
      for (int m = 0; m < 4; ++m) {
        const int row = row0 + ai * 128 + m * 16;
        u16* rowp = O + (size_t)row * 5120 + col0;
        if (dorope) {
          const int s = row & 2047;
          const int pos = axis ? (s & 63) : (s >> 6);
          const float4* rp = (const float4*)(rope + (pos * 32 + i0) * 2);
          float4 c01 = rp[0], c23 = rp[1];
#pragma unroll
          for (int bj = 0; bj < 2; ++bj) {
            pg8::f32x4 a = acc[ai][bj][m][0], b = acc[ai][bj][m][1], o0, o1;
            o0[0] = a[0] * c01.x - b[0] * c01.y; o1[0] = b[0] * c01.x + a[0] * c01.y;
            o0[1] = a[1] * c01.z - b[1] * c01.w; o1[1] = b[1] * c01.z + a[1] * c01.w;
            o0[2] = a[2] * c23.x - b[2] * c23.y; o1[2] = b[2] * c23.x + a[2] * c23.y;
            o0[3] = a[3] * c23.z - b[3] * c23.w; o1[3] = b[3] * c23.z + a[3] * c23.w;
            *(uint2*)(rowp + bj * 128) = pack4(o0);
            *(uint2*)(rowp + bj * 128 + 16) = pack4(o1);
          }
        } else {
#pragma unroll
          for (int bj = 0; bj < 2; ++bj) {
            *(uint2*)(rowp + bj * 128) = pack4(acc[ai][bj][m][0]);
            *(uint2*)(rowp + bj * 128 + 16) = pack4(acc[ai][bj][m][1]);
          }
        }
      }
  }
};
struct EpiRaw {
  static constexpr bool PERM = false, AFTER_DRAIN = false;
  u16* O; int ldc;
  __device__ __forceinline__ void operator()(const pg8::f32x4 (&acc)[2][2][4][2], const pg8::Unit& u, int wr, int wc, int fr, int fq) const {
    const int row0 = u.pm * 256 + wr * 64 + fr, col0 = u.pn * 256 + wc * 32 + 4 * fq;
#pragma unroll
    for (int ai = 0; ai < 2; ++ai)
#pragma unroll
      for (int m = 0; m < 4; ++m) {
        u16* rowp = O + (size_t)(row0 + ai * 128 + m * 16) * ldc + col0;
#pragma unroll
        for (int bj = 0; bj < 2; ++bj) {
          *(uint2*)(rowp + bj * 128) = pack4(acc[ai][bj][m][0]);
          *(uint2*)(rowp + bj * 128 + 16) = pack4(acc[ai][bj][m][1]);
        }
      }
  }
};
struct EpiRes {
  static constexpr bool PERM = false, AFTER_DRAIN = false;
  float* out; const float* base; const float* gate;
  __device__ __forceinline__ void operator()(const pg8::f32x4 (&acc)[2][2][4][2], const pg8::Unit& u, int wr, int wc, int fr, int fq) const {
    const int row0 = u.pm * 256 + wr * 64 + fr, col0 = u.pn * 256 + wc * 32 + 4 * fq;
    const int b = (u.pm * 256) >> 11;
    pg8::f32x4 gv[2][2];
#pragma unroll
    for (int bj = 0; bj < 2; ++bj)
#pragma unroll
      for (int n = 0; n < 2; ++n) gv[bj][n] = *(const pg8::f32x4*)(gate + b * 6144 + col0 + bj * 128 + n * 16);
#pragma unroll
    for (int ai = 0; ai < 2; ++ai)
#pragma unroll
      for (int m = 0; m < 4; ++m) {
        const size_t off = (size_t)(row0 + ai * 128 + m * 16) * 2048 + col0;
#pragma unroll
        for (int bj = 0; bj < 2; ++bj)
#pragma unroll
          for (int n = 0; n < 2; ++n) {
            pg8::f32x4 bv = *(const pg8::f32x4*)(base + off + bj * 128 + n * 16);
            *(pg8::f32x4*)(out + off + bj * 128 + n * 16) = bv + gv[bj][n] * acc[ai][bj][m][n];
          }
      }
  }
};
template <class Epi>
__device__ __forceinline__ void run_gemm(float* sm, const u16* A, const u16* Bt, int M, int N, const Epi& E, int c) {
  pg8::Gemm g{A, Bt, M, N, 2048};
  pg8::StaticOrder S; S.init(M, N, (int)gridDim.x, c);
  pg8::gemm_phase<Epi, pg8::StaticOrder>((PG8_LAS unsigned char*)sm, g, S, E);
  __syncthreads();
}

template <int MODE>
__device__ __forceinline__ void epi_pair(const Params& p, int m, int n, float a0, float a1) {
  if (MODE == 1) {
    u16* px = (u16*)(p.ws + OFF_BIG);
    float o0 = a0, o1 = a1;
    if (n < 2560) {
      int g = (n >> 5) & 3, fr = n & 15;
      int axis = g >> 1, i = (g & 1) * 16 + fr;
      int s = m & 2047;
      int pos = axis ? (s & 63) : (s >> 6);
      float2 cs = ((const float2*)(p.ws + OFF_ROPE))[pos * 32 + i];
      o0 = a0 * cs.x - a1 * cs.y;
      o1 = a1 * cs.x + a0 * cs.y;
    }
    px[(size_t)m * 5120 + n] = f2bf(o0);
    px[(size_t)m * 5120 + n + 16] = f2bf(o1);
  } else if (MODE == 5) {
    u16* kvc = (u16*)(p.ws + OFF_KVC);
    kvc[(size_t)m * 1024 + n] = f2bf(a0);
    kvc[(size_t)m * 1024 + n + 16] = f2bf(a1);
  } else if (MODE == 2) {
    const float* mod = (const float*)(p.ws + OFF_MOD);
    int b = m >> 11;
    const float* gate = mod + (0 * 5 + b) * 6144 + 4096;
    p.out[(size_t)m * 2048 + n] = p.x[(size_t)m * 2048 + n] + gate[n] * a0;
    p.out[(size_t)m * 2048 + n + 16] = p.x[(size_t)m * 2048 + n + 16] + gate[n + 16] * a1;
  } else if (MODE == 3) {
    u16* pp = (u16*)(p.ws + OFF_BIG);
    pp[(size_t)m * 8192 + n] = f2bf(a0);
    pp[(size_t)m * 8192 + n + 16] = f2bf(a1);
  } else if (MODE == 4) {
    const float* mod = (const float*)(p.ws + OFF_MOD);
    int b = m >> 11;
    const float* gate = mod + (1 * 5 + b) * 6144 + 4096;
    p.out[(size_t)m * 2048 + n] += gate[n] * a0;
    p.out[(size_t)m * 2048 + n + 16] += gate[n + 16] * a1;
  }
}

template <int MODE>
__device__ void naive_gemm(const Params& p, const u16* __restrict__ A, const u16* __restrict__ Wt, int M, int N) {
  const int tid = threadIdx.x;
  const int ml = tid >> 5, pl = tid & 31;
  const int ntn = N / 64, ntm = M / 16;
  for (int tile = blockIdx.x; tile < ntn * ntm; tile += gridDim.x) {
    int tm = tile / ntn, tn = tile % ntn;
    int m = tm * 16 + ml;
    int n = tn * 64 + (pl >> 4) * 32 + (pl & 15);
    const uint4* a = (const uint4*)(A + (size_t)m * 2048);
    const uint4* w0 = (const uint4*)(Wt + (size_t)n * 2048);
    const uint4* w1 = (const uint4*)(Wt + (size_t)(n + 16) * 2048);
    float acc0 = 0.f, acc1 = 0.f;
#pragma unroll 2
    for (int k = 0; k < 256; ++k) {
      uint4 av = a[k], b0 = w0[k], b1 = w1[k];
      acc0 += bflo(av.x) * bflo(b0.x) + bfhi(av.x) * bfhi(b0.x) + bflo(av.y) * bflo(b0.y) + bfhi(av.y) * bfhi(b0.y)
            + bflo(av.z) * bflo(b0.z) + bfhi(av.z) * bfhi(b0.z) + bflo(av.w) * bflo(b0.w) + bfhi(av.w) * bfhi(b0.w);
      acc1 += bflo(av.x) * bflo(b1.x) + bfhi(av.x) * bfhi(b1.x) + bflo(av.y) * bflo(b1.y) + bfhi(av.y) * bfhi(b1.y)
            + bflo(av.z) * bflo(b1.z) + bfhi(av.z) * bfhi(b1.z) + bflo(av.w) * bflo(b1.w) + bfhi(av.w) * bfhi(b1.w);
    }
    epi_pair<MODE>(p, m, n, acc0, acc1);
  }
}

__device__ void phase_attn_naive(const Params& p, float* sm) {
  const int wid = threadIdx.x >> 6, lane = threadIdx.x & 63;
  float* qs = sm + wid * (128 + 640);
  float* pr = qs + 128;
  const u16* px = (const u16*)(p.ws + OFF_BIG);
  const u16* kvc = (const u16*)(p.ws + OFF_KVC);
  u16* og = (u16*)(p.ws + OFF_ACT);
  const float scale = 0.08838834764831845f;
  for (int item = blockIdx.x * 8 + wid; item < MT * 16; item += gridDim.x * 8) {
    int m = item >> 4, h = item & 15;
    int b = m >> 11, s = m & 2047, kvh = h >> 2, nblk = s >> 7;
    const u16* qrow = px + (size_t)m * 5120 + h * 128;
    qs[lane] = bf2f(qrow[lane]) * scale;
    qs[lane + 64] = bf2f(qrow[lane + 64]) * scale;
    asm volatile("s_waitcnt lgkmcnt(0)" ::: "memory");
    float mx = p.attn_sink[h];
#pragma unroll 1
    for (int j = 0; j < 10; ++j) {
      int kidx = j * 64 + lane;
      const u16* krow;
      bool valid;
      if (kidx < 384) {
        int kpos = (nblk - 1) * 128 + kidx;
        int rel = kpos - s;
        valid = (kpos >= 0) && (kpos < 2048) && (rel <= 128) && (rel >= -128);
        krow = px + (size_t)(b * 2048 + (valid ? kpos : 0)) * 5120 + 2048 + kvh * 128;
      } else {
        valid = true;
        krow = kvc + (size_t)(b * 256 + (kidx - 384)) * 1024 + kvh * 128;
      }
      float d = -1e30f;
      if (valid) {
        d = 0.f;
#pragma unroll 4
        for (int c = 0; c < 16; ++c) {
          uint4 kk = *(const uint4*)(krow + c * 8);
          const float* q8 = qs + c * 8;
          d += q8[0] * bflo(kk.x) + q8[1] * bfhi(kk.x) + q8[2] * bflo(kk.y) + q8[3] * bfhi(kk.y)
             + q8[4] * bflo(kk.z) + q8[5] * bfhi(kk.z) + q8[6] * bflo(kk.w) + q8[7] * bfhi(kk.w);
        }
      }
      pr[kidx] = d;
      mx = fmaxf(mx, d);
    }
    mx = wave_max(mx);
    float sum = 0.f;
#pragma unroll 1
    for (int j = 0; j < 10; ++j) {
      float d = pr[j * 64 + lane];
      float e = (d > -1e29f) ? __expf(d - mx) : 0.f;
      pr[j * 64 + lane] = e;
      sum += e;
    }
    sum = wave_sum(sum);
    sum += __expf(p.attn_sink[h] - mx);
    asm volatile("s_waitcnt lgkmcnt(0)" ::: "memory");
    float o0 = 0.f, o1 = 0.f;
    int k0 = s - 128 < 0 ? 0 : s - 128, k1 = s + 128 > 2047 ? 2047 : s + 128;
    for (int kpos = k0; kpos <= k1; ++kpos) {
      float pv = pr[kpos - (nblk - 1) * 128];
      unsigned vv = *(const unsigned*)(px + (size_t)(b * 2048 + kpos) * 5120 + 2560 + kvh * 128 + lane * 2);
      o0 += pv * bflo(vv); o1 += pv * bfhi(vv);
    }
    for (int c = 0; c < 256; ++c) {
      float pv = pr[384 + c];
      unsigned vv = *(const unsigned*)(kvc + (size_t)(b * 256 + c) * 1024 + 512 + kvh * 128 + lane * 2);
      o0 += pv * bflo(vv); o1 += pv * bfhi(vv);
    }
    float inv = 1.f / sum;
    unsigned gg = *(const unsigned*)(px + (size_t)m * 5120 + 3072 + h * 128 + lane * 2);
    float r0 = o0 * inv * siluf(bflo(gg)), r1 = o1 * inv * siluf(bfhi(gg));
    *(unsigned*)(og + (size_t)m * 2048 + h * 128 + lane * 2) = (unsigned)f2bf(r0) | ((unsigned)f2bf(r1) << 16);
    asm volatile("s_waitcnt lgkmcnt(0)" ::: "memory");
  }
}

__device__ __forceinline__ float sconv(const u16* pp, const float* cw, const float* cb, int b, int t, int c) {
  const u16* base = pp + (size_t)(b * 2048 + t) * 8192 + c;
  float v = cw[6144 + c] * bf2f(base[0]) + cb[c];
  if (t > 0) v += cw[c] * bf2f(base[-8192]);
  if (t < 2047) v += cw[2 * 6144 + c] * bf2f(base[8192]);
  return v;
}

__device__ void phase_conv_naive(const Params& p, float* sm) {
  const int tid = threadIdx.x;
  float* u = sm;
  float* R = sm + 8192;
  const u16* pp = (const u16*)(p.ws + OFF_BIG);
  const u16* Rg = (const u16*)(p.ws + OFF_FILT);
  u16* yg = (u16*)(p.ws + OFF_ACT);
  for (int ch = blockIdx.x; ch < 2048; ch += gridDim.x) {
    for (int i = tid; i < 8192; i += NTHREADS) u[i] = sconv(pp, p.hy_conv_w, p.hy_conv_b, i >> 11, i & 2047, 4096 + ch);
    for (int i = tid; i < 4096; i += NTHREADS) R[i] = bf2f(Rg[((size_t)0 * 2048 + ch) * 4096 + i]);
    __syncthreads();
    float zr[16];
#pragma unroll
    for (int q = 0; q < 16; ++q) {
      int i = tid + q * NTHREADS;
      int b = i >> 11, t = i & 2047;
      const float* ub = u + b * 2048;
      const float* Rb = R + 2048 - t;
      float a = 0.f;
      for (int s = 0; s < 2048; ++s) a += Rb[s] * ub[s];
      zr[q] = a * sconv(pp, p.hy_conv_w, p.hy_conv_b, b, t, ch);
    }
    __syncthreads();
#pragma unroll
    for (int q = 0; q < 16; ++q) u[tid + q * NTHREADS] = zr[q];
    for (int i = tid; i < 4096; i += NTHREADS) R[i] = bf2f(Rg[((size_t)1 * 2048 + ch) * 4096 + i]);
    __syncthreads();
#pragma unroll
    for (int q = 0; q < 16; ++q) {
      int i = tid + q * NTHREADS;
      int b = i >> 11, t = i & 2047;
      const float* ub = u + b * 2048;
      const float* Rb = R + 2048 - t;
      float a = 0.f;
      for (int s = 0; s < 2048; ++s) a += Rb[s] * ub[s];
      float y = a * sconv(pp, p.hy_conv_w, p.hy_conv_b, b, t, 2048 + ch);
      float g = bf2f(pp[(size_t)(b * 2048 + t) * 8192 + 6144 + ch]);
      yg[(size_t)(b * 2048 + t) * 2048 + ch] = f2bf(y * siluf(g));
    }
    __syncthreads();
  }
}


typedef float f32x16 __attribute__((ext_vector_type(16)));
typedef pg8::bf16x8 bfx8;
constexpr int CONV_RF_BYTES = 4 * 8192;
constexpr int CONV_UB_ONE = 192 * 64;
__device__ __forceinline__ int ub_addr(int col, int chunk) { return col * 64 + ((chunk ^ ((col >> 2) & 3)) << 4); }

__device__ __forceinline__ void conv_mfma(const char* Rf_ci, const char* Ub_w, int lane, f32x16 (&acc)[4]) {
  const int t2 = lane & 31, h = lane >> 5, n = lane & 31;
  const unsigned sh = (unsigned)(t2 & 1) * 16u;
  const int lanedw = (2048 - t2 + 8 * h) >> 1;
#pragma unroll
  for (int j = 0; j < 4; ++j)
#pragma unroll
    for (int r = 0; r < 16; ++r) acc[j][r] = 0.f;
#pragma unroll 1
  for (int f = 0; f < 16; ++f) {
    bfx8 Bw[5][2];
#pragma unroll
    for (int m = 0; m < 5; ++m) {
      const int col = (16 * m - f + 16) * 2 + n;
#pragma unroll
      for (int kh = 0; kh < 2; ++kh) Bw[m][kh] = *(const bfx8*)(Ub_w + ub_addr(col, 2 * kh + h));
    }
    const unsigned* Rp = (const unsigned*)Rf_ci + lanedw - 16 * f;
#pragma unroll
    for (int e = -4; e <= 3; ++e) {
      int ee = e;
      if (e == -4) ee = (f == 0) ? -3 : -4;
      bfx8 A[2];
#pragma unroll
      for (int kh = 0; kh < 2; ++kh) {
        const unsigned* q = Rp - 256 * ee + 8 * kh;
        unsigned w0 = q[0], w1 = q[1], w2 = q[2], w3 = q[3], w4 = q[4];
        pg8::u32x4 pk;
        pk[0] = __builtin_amdgcn_alignbit(w1, w0, sh);
        pk[1] = __builtin_amdgcn_alignbit(w2, w1, sh);
        pk[2] = __builtin_amdgcn_alignbit(w3, w2, sh);
        pk[3] = __builtin_amdgcn_alignbit(w4, w3, sh);
        A[kh] = __builtin_bit_cast(bfx8, pk);
      }
#pragma unroll
      for (int j = 0; j < 4; ++j) {
        const int m = j - e;
        if (m >= 0 && m <= 4) acc[j] = __builtin_amdgcn_mfma_f32_32x32x16_bf16(A[0], Bw[m][0], acc[j], 0, 0, 0);
      }
#pragma unroll
      for (int j = 0; j < 4; ++j) {
        const int m = j - e;
        if (m >= 0 && m <= 4) acc[j] = __builtin_amdgcn_mfma_f32_32x32x16_bf16(A[1], Bw[m][1], acc[j], 0, 0, 0);
      }
    }
  }
}

__device__ __forceinline__ void sconv4(const u16* xp, int t, float w0, float w1, float w2, float cb, float (&o)[4]) {
  uint2 x4 = *(const uint2*)xp;
  float pv = t > 0 ? bf2f(xp[-1]) : 0.f;
  float nx = (t + 4 < 2048) ? bf2f(xp[4]) : 0.f;
  float e0 = bflo(x4.x), e1 = bfhi(x4.x), e2 = bflo(x4.y), e3 = bfhi(x4.y);
  o[0] = w0 * pv + w1 * e0 + w2 * e1 + cb;
  o[1] = w0 * e0 + w1 * e1 + w2 * e2 + cb;
  o[2] = w0 * e1 + w1 * e2 + w2 * e3 + cb;
  o[3] = w0 * e2 + w1 * e3 + w2 * nx + cb;
}

__device__ void phase_conv(const Params& p, float* smf) {
  char* sm = (char*)smf;
  char* Rf = sm;
  char* Ub = sm + CONV_RF_BYTES;
  const int tid = threadIdx.x, wid = tid >> 6, lane = tid & 63;
  const int ci = wid >> 1, bp = wid & 1;
  const u16* pT = (const u16*)(p.ws + OFF_BIG);
  const u16* Rg = (const u16*)(p.ws + OFF_FILT);
  u16* yg = (u16*)(p.ws + OFF_ACT);
  for (int i = tid; i < 8 * CONV_UB_ONE / 16; i += NTHREADS) ((uint4*)Ub)[i] = make_uint4(0, 0, 0, 0);
  __syncthreads();
  char* Ub_w = Ub + (ci * 2 + bp) * CONV_UB_ONE;
  const char* Rf_ci = Rf + ci * 8192;
  const int h = lane >> 5, n = lane & 31;
  for (int item = blockIdx.x; item < 512; item += gridDim.x) {
    const int ch0 = item * 4;
    for (int task = tid; task < 4096; task += NTHREADS) {
      const int q = task & 255, b = (task >> 8) & 3, c = task >> 10;
      const int cc = 4096 + ch0 + c;
      const u16* xp = pT + (size_t)cc * 8192 + b * 2048 + q * 8;
      uint4 x8 = *(const uint4*)xp;
      float pv = q > 0 ? bf2f(xp[-1]) : 0.f;
      float nx = q < 255 ? bf2f(xp[8]) : 0.f;
      float w0 = p.hy_conv_w[cc], w1 = p.hy_conv_w[6144 + cc], w2 = p.hy_conv_w[2 * 6144 + cc], cb = p.hy_conv_b[cc];
      float e[10];
      e[0] = pv; e[1] = bflo(x8.x); e[2] = bfhi(x8.x); e[3] = bflo(x8.y); e[4] = bfhi(x8.y);
      e[5] = bflo(x8.z); e[6] = bfhi(x8.z); e[7] = bflo(x8.w); e[8] = bfhi(x8.w); e[9] = nx;
      unsigned o[4];
#pragma unroll
      for (int k = 0; k < 4; ++k) {
        float a = w0 * e[2 * k] + w1 * e[2 * k + 1] + w2 * e[2 * k + 2] + cb;
        float bb = w0 * e[2 * k + 1] + w1 * e[2 * k + 2] + w2 * e[2 * k + 3] + cb;
        o[k] = (unsigned)f2bf(a) | ((unsigned)f2bf(bb) << 16);
      }
      const int t0 = q * 8, s1 = t0 >> 5, s2 = t0 & 31;
      const int col = (s1 + 16) * 2 + (b & 1);
      *(uint4*)(Ub + (c * 2 + (b >> 1)) * CONV_UB_ONE + ub_addr(col, s2 >> 3)) = make_uint4(o[0], o[1], o[2], o[3]);
    }
    for (int i = tid; i < 2048; i += NTHREADS) {
      const int c = i >> 9, k = i & 511;
      ((uint4*)Rf)[i] = ((const uint4*)(Rg + ((size_t)0 * 2048 + ch0 + c) * 4096))[k];
    }
    __syncthreads();
    f32x16 acc[4];
    const int ch = ch0 + ci;
    conv_mfma(Rf_ci, Ub_w, lane, acc);
    {
      const float w0 = p.hy_conv_w[ch], w1 = p.hy_conv_w[6144 + ch], w2 = p.hy_conv_w[2 * 6144 + ch], cb = p.hy_conv_b[ch];
#pragma unroll
      for (int j = 0; j < 4; ++j)
#pragma unroll
        for (int vg = 0; vg < 4; ++vg) {
          const int t1 = 16 * j + (n >> 1), bl = n & 1, b = 2 * bp + bl, t = 32 * t1 + 8 * vg + 4 * h;
          float x1[4];
          sconv4(pT + (size_t)ch * 8192 + b * 2048 + t, t, w0, w1, w2, cb, x1);
          uint2 pk;
          pk.x = (unsigned)f2bf(x1[0] * acc[j][4 * vg + 0]) | ((unsigned)f2bf(x1[1] * acc[j][4 * vg + 1]) << 16);
          pk.y = (unsigned)f2bf(x1[2] * acc[j][4 * vg + 2]) | ((unsigned)f2bf(x1[3] * acc[j][4 * vg + 3]) << 16);
          const int col = (t1 + 16) * 2 + bl;
          *(uint2*)(Ub_w + ub_addr(col, vg) + 8 * h) = pk;
        }
    }
    __syncthreads();
    for (int i = tid; i < 2048; i += NTHREADS) {
      const int c = i >> 9, k = i & 511;
      ((uint4*)Rf)[i] = ((const uint4*)(Rg + ((size_t)1 * 2048 + ch0 + c) * 4096))[k];
    }
    __syncthreads();
    conv_mfma(Rf_ci, Ub_w, lane, acc);
    {
      const int c2 = 2048 + ch;
      const float w0 = p.hy_conv_w[c2], w1 = p.hy_conv_w[6144 + c2], w2 = p.hy_conv_w[2 * 6144 + c2], cb = p.hy_conv_b[c2];
#pragma unroll
      for (int j = 0; j < 4; ++j)
#pragma unroll
        for (int vg = 0; vg < 4; ++vg) {
          const int t1 = 16 * j + (n >> 1), bl = n & 1, b = 2 * bp + bl, t = 32 * t1 + 8 * vg + 4 * h;
          float x2[4];
          sconv4(pT + (size_t)c2 * 8192 + b * 2048 + t, t, w0, w1, w2, cb, x2);
          uint2 g4 = *(const uint2*)(pT + (size_t)(6144 + ch) * 8192 + b * 2048 + t);
          float y0 = x2[0] * acc[j][4 * vg + 0] * siluf(bflo(g4.x));
          float y1 = x2[1] * acc[j][4 * vg + 1] * siluf(bfhi(g4.x));
          float y2 = x2[2] * acc[j][4 * vg + 2] * siluf(bflo(g4.y));
          float y3 = x2[3] * acc[j][4 * vg + 3] * siluf(bfhi(g4.y));
          uint2 pk;
          pk.x = (unsigned)f2bf(y0) | ((unsigned)f2bf(y1) << 16);
          pk.y = (unsigned)f2bf(y2) | ((unsigned)f2bf(y3) << 16);
          const int col = (t1 + 16) * 2 + bl;
          *(uint2*)(Ub_w + ub_addr(col, vg) + 8 * h) = pk;
        }
    }
    __syncthreads();
    for (int idx = tid; idx < 8192; idx += NTHREADS) {
      const int b = idx >> 11, t = idx & 2047;
      const int s1 = t >> 5, s2 = t & 31;
      const int col = (s1 + 16) * 2 + (b & 1);
      const int a = ub_addr(col, s2 >> 3) + (s2 & 7) * 2;
      const char* base = Ub + (b >> 1) * CONV_UB_ONE + a;
      unsigned v0 = *(const u16*)(base + 0 * 2 * CONV_UB_ONE), v1 = *(const u16*)(base + 1 * 2 * CONV_UB_ONE);
      unsigned v2 = *(const u16*)(base + 2 * 2 * CONV_UB_ONE), v3 = *(const u16*)(base + 3 * 2 * CONV_UB_ONE);
      *(uint2*)(yg + (size_t)idx * 2048 + ch0) = make_uint2(v0 | (v1 << 16), v2 | (v3 << 16));
    }
    __syncthreads();
  }
}


constexpr int AT_KROW = 272, AT_VROW = 136;
constexpr int AT_K_BYTES = 64 * AT_KROW, AT_V_BYTES = 128 * AT_VROW;
__device__ void phase_attn(const Params& p, float* smf) {
  char* sm = (char*)smf;
  char* Ks = sm;
  char* Vs = sm + AT_K_BYTES;
  const int tid = threadIdx.x, wid = tid >> 6, lane = tid & 63, r = lane & 31, h = lane >> 5;
  const u16* px = (const u16*)(p.ws + OFF_BIG);
  const u16* kvc = (const u16*)(p.ws + OFF_KVC);
  const u16* vT = (const u16*)(p.ws + OFF_VT);
  const u16* vcT = (const u16*)(p.ws + OFF_VCT);
  u16* og = (u16*)(p.ws + OFF_ACT);
  const float LOG2E = 1.4426950408889634f;
  const float sl2 = 0.08838834764831845f * LOG2E;
  for (int item = blockIdx.x; item < 512; item += gridDim.x) {
    const int hp = item & 1, kvh = (item >> 1) & 3, nblk = (item >> 3) & 15, b = item >> 7;
    const int hq = kvh * 4 + hp * 2 + (wid >> 2);
    const int qs = nblk * 128 + (wid & 3) * 32 + r;
    bfx8 Q[8];
    {
      const u16* qrow = px + (size_t)(b * 2048 + qs) * 5120 + hq * 128 + 8 * h;
#pragma unroll
      for (int st = 0; st < 8; ++st) Q[st] = *(const bfx8*)(qrow + 16 * st);
    }
    f32x16 O[4];
#pragma unroll
    for (int dt = 0; dt < 4; ++dt)
#pragma unroll
      for (int i = 0; i < 16; ++i) O[dt][i] = 0.f;
    float m = p.attn_sink[hq] * LOG2E;
    float l = (h == 0) ? 1.f : 0.f;
    const int first = (nblk == 0) ? 2 : 0, lastlocal = (nblk == 15) ? 3 : 5;
    uint4 kreg0, kreg1, vreg0, vreg1;
#define AT_LOAD_TILE(TI) do { \
      const int _ti = (TI); const bool _loc = _ti < 6; \
      const int _kpos0 = 128 * (nblk - 1) + 64 * _ti, _c0 = 64 * (_ti - 6); \
      const u16* _kb = _loc ? px + (size_t)(b * 2048 + _kpos0) * 5120 + 2048 + kvh * 128 : kvc + (size_t)(b * 256 + _c0) * 1024 + kvh * 128; \
      const size_t _ks = _loc ? 5120 : 1024; \
      const u16* _vb = _loc ? vT + (size_t)(kvh * 128) * 8192 + b * 2048 + _kpos0 : vcT + (size_t)(kvh * 128) * 1024 + b * 256 + _c0; \
      const size_t _vs = _loc ? 8192 : 1024; \
      const int _c1 = tid + NTHREADS; \
      kreg0 = *(const uint4*)(_kb + (size_t)(tid >> 4) * _ks + (tid & 15) * 8); \
      kreg1 = *(const uint4*)(_kb + (size_t)(_c1 >> 4) * _ks + (_c1 & 15) * 8); \
      vreg0 = *(const uint4*)(_vb + (size_t)(tid >> 3) * _vs + (tid & 7) * 8); \
      vreg1 = *(const uint4*)(_vb + (size_t)(_c1 >> 3) * _vs + (_c1 & 7) * 8); \
    } while (0)
    int ti = first;
    AT_LOAD_TILE(ti);
    while (true) {
      __syncthreads();
      {
        const int c1 = tid + NTHREADS;
        *(uint4*)(Ks + (tid >> 4) * AT_KROW + (tid & 15) * 16) = kreg0;
        *(uint4*)(Ks + (c1 >> 4) * AT_KROW + (c1 & 15) * 16) = kreg1;
        char* v0p = Vs + (tid >> 3) * AT_VROW + (tid & 7) * 16;
        char* v1p = Vs + (c1 >> 3) * AT_VROW + (c1 & 7) * 16;
        *(uint2*)(v0p) = make_uint2(vreg0.x, vreg0.y);
        *(uint2*)(v0p + 8) = make_uint2(vreg0.z, vreg0.w);
        *(uint2*)(v1p) = make_uint2(vreg1.x, vreg1.y);
        *(uint2*)(v1p + 8) = make_uint2(vreg1.z, vreg1.w);
      }
      __syncthreads();
      int tn = ti + 1;
      if (tn > lastlocal && tn < 6) tn = 6;
      if (tn < 10) AT_LOAD_TILE(tn);
      {
        const bool local = ti < 6;
        const int kpos0 = 128 * (nblk - 1) + 64 * ti;
        f32x16 S[2];
#pragma unroll
        for (int ks = 0; ks < 2; ++ks) {
#pragma unroll
          for (int i = 0; i < 16; ++i) S[ks][i] = 0.f;
#pragma unroll
          for (int st = 0; st < 8; ++st) {
            bfx8 A = *(const bfx8*)(Ks + (ks * 32 + r) * AT_KROW + (16 * st + 8 * h) * 2);
            S[ks] = __builtin_amdgcn_mfma_f32_32x32x16_bf16(A, Q[st], S[ks], 0, 0, 0);
          }
        }
        float mx = m;
#pragma unroll
        for (int ks = 0; ks < 2; ++ks)
#pragma unroll
          for (int i = 0; i < 16; ++i) {
            float sv = S[ks][i] * sl2;
            if (local) {
              const int kpos = kpos0 + ks * 32 + (i & 3) + 8 * (i >> 2) + 4 * h;
              const int rel = kpos - qs;
              if (rel > 128 || rel < -128) sv = -1e30f;
            }
            S[ks][i] = sv;
            mx = fmaxf(mx, sv);
          }
        mx = fmaxf(mx, __shfl_xor(mx, 32, 64));
        const float alpha = __builtin_amdgcn_exp2f(m - mx);
        m = mx;
        l *= alpha;
#pragma unroll
        for (int dt = 0; dt < 4; ++dt)
#pragma unroll
          for (int i = 0; i < 16; ++i) O[dt][i] *= alpha;
#pragma unroll
        for (int ks = 0; ks < 2; ++ks)
#pragma unroll
          for (int i = 0; i < 16; ++i) {
            float pv = __builtin_amdgcn_exp2f(S[ks][i] - m);
            l += pv;
            S[ks][i] = pv;
          }
#pragma unroll
        for (int s4 = 0; s4 < 4; ++s4) {
          const int ks = s4 >> 1, hf = s4 & 1;
          pg8::u32x4 pk;
#pragma unroll
          for (int j = 0; j < 4; ++j)
            pk[j] = (unsigned)f2bf(S[ks][8 * hf + 2 * j]) | ((unsigned)f2bf(S[ks][8 * hf + 2 * j + 1]) << 16);
          bfx8 P = __builtin_bit_cast(bfx8, pk);
#pragma unroll
          for (int dt = 0; dt < 4; ++dt) {
            const char* vp = Vs + (dt * 32 + r) * AT_VROW + (32 * ks + 16 * hf + 4 * h) * 2;
            uint2 v0 = *(const uint2*)vp, v1 = *(const uint2*)(vp + 16);
            pg8::u32x4 vv; vv[0] = v0.x; vv[1] = v0.y; vv[2] = v1.x; vv[3] = v1.y;
            O[dt] = __builtin_amdgcn_mfma_f32_32x32x16_bf16(__builtin_bit_cast(bfx8, vv), P, O[dt], 0, 0, 0);
          }
        }
      }
      if (tn >= 10) break;
      ti = tn;
    }
    const float ltot = l + __shfl_xor(l, 32, 64);
    const float inv = 1.f / ltot;
    const size_t tok = (size_t)(b * 2048 + qs);
#pragma unroll
    for (int dt = 0; dt < 4; ++dt)
#pragma unroll
      for (int g4 = 0; g4 < 4; ++g4) {
        const int d = dt * 32 + 8 * g4 + 4 * h;
        uint2 gg = *(const uint2*)(px + tok * 5120 + 3072 + hq * 128 + d);
        float o0 = O[dt][4 * g4 + 0] * inv * siluf(bflo(gg.x));
        float o1 = O[dt][4 * g4 + 1] * inv * siluf(bfhi(gg.x));
        float o2 = O[dt][4 * g4 + 2] * inv * siluf(bflo(gg.y));
        float o3 = O[dt][4 * g4 + 3] * inv * siluf(bfhi(gg.y));
        uint2 pk;
        pk.x = (unsigned)f2bf(o0) | ((unsigned)f2bf(o1) << 16);
        pk.y = (unsigned)f2bf(o2) | ((unsigned)f2bf(o3) << 16);
        *(uint2*)(og + tok * 2048 + hq * 128 + d) = pk;
      }
  }
}

constexpr int N_PHASES = 10;
__global__ void __launch_bounds__(NTHREADS, 2) mega(Params p, int ph0, int ph1) {
  extern __shared__ __attribute__((aligned(16))) float sm[];
#define PH(i, body) if (ph0 <= (i) && (i) < ph1) { body; if ((i) + 1 < ph1) cg::this_grid().sync(); }
  PH(0, phase0(p, sm))
  PH(1, phase_norm(p, 0))
  PH(2, run_gemm(sm, (const u16*)(p.ws + OFF_ACT), (const u16*)(p.ws + OFF_WT_AI), MT, ATTN_IN,
                 EpiAttnIn{(u16*)(p.ws + OFF_BIG), (const float*)(p.ws + OFF_ROPE)}, (int)blockIdx.x);
        run_gemm(sm, (const u16*)(p.ws + OFF_HC), (const u16*)(p.ws + OFF_WT_AI) + (size_t)2048 * 2048, MC, 1024,
                 EpiRaw{(u16*)(p.ws + OFF_KVC), 1024}, (int)((blockIdx.x + 64) % gridDim.x));
        run_gemm(sm, (const u16*)(p.ws + OFF_WT_AI) + (size_t)2560 * 2048, (const u16*)(p.ws + OFF_ACT), 512, MT,
                 EpiRaw{(u16*)(p.ws + OFF_VT), 8192}, (int)((blockIdx.x + 128) % gridDim.x));
        run_gemm(sm, (const u16*)(p.ws + OFF_WT_AI) + (size_t)2560 * 2048, (const u16*)(p.ws + OFF_HC), 512, MC,
                 EpiRaw{(u16*)(p.ws + OFF_VCT), 1024}, (int)((blockIdx.x + 48) % gridDim.x)))
  PH(3, phase_attn(p, sm))
  PH(4, run_gemm(sm, (const u16*)(p.ws + OFF_ACT), (const u16*)(p.ws + OFF_WT_AO), MT, 2048,
                 EpiRes{p.out, p.x, (const float*)(p.ws + OFF_MOD) + 4096}, (int)blockIdx.x))
  PH(5, phase_norm(p, 1))
  PH(6, run_gemm(sm, (const u16*)(p.ws + OFF_WT_HI), (const u16*)(p.ws + OFF_ACT), HY_IN, MT,
                 EpiRaw{(u16*)(p.ws + OFF_BIG), 8192}, (int)blockIdx.x))
  PH(7, phase_conv(p, sm))
  PH(8, run_gemm(sm, (const u16*)(p.ws + OFF_ACT), (const u16*)(p.ws + OFF_WT_HO), MT, 2048,
                 EpiRes{p.out, p.out, (const float*)(p.ws + OFF_MOD) + 5 * 6144 + 4096}, (int)blockIdx.x))
  PH(9, phase_norm(p, 2))
}

extern "C" void kernel_launch(void* const* d_in, const int* in_sizes, int n_in, void* d_out, int out_size,
                              void* d_ws, size_t ws_size, hipStream_t stream) {
  Params p{};
  const float** f = (const float**)&p;
  for (int i = 0; i < 23; ++i) f[i] = (const float*)d_in[i];
  p.out = (float*)d_out;
  p.ws = (char*)d_ws;
  constexpr size_t kLds = 128 * 1024;
  static int grid_blocks = 0;
  if (!grid_blocks) {
    (void)hipFuncSetAttribute((const void*)mega, hipFuncAttributeMaxDynamicSharedMemorySize, (int)kLds);
    int dev = 0, cus = 0, per_cu = 0;
    (void)hipGetDevice(&dev);
    (void)hipDeviceGetAttribute(&cus, hipDeviceAttributeMultiprocessorCount, dev);
    (void)hipOccupancyMaxActiveBlocksPerMultiprocessor(&per_cu, mega, NTHREADS, kLds);
    if (per_cu < 1) per_cu = 1;
    grid_blocks = cus * per_cu;
  }
  int ph0 = 0, ph1 = N_PHASES;
  void* args[] = {(void*)&p, (void*)&ph0, (void*)&ph1};
  hipError_t e = hipLaunchCooperativeKernel((const void*)mega, dim3(grid_blocks), dim3(NTHREADS), args, kLds, stream);
  if (e != hipSuccess) fprintf(stderr, "cooperative launch failed: %s (grid %d)\n", hipGetErrorString(e), grid_blocks);
}
```

```cpp
#include <hip/hip_runtime.h>
#include <hip/hip_bf16.h>
#include <hip/hip_cooperative_groups.h>
#include <cstdio>
namespace cg = cooperative_groups;
typedef unsigned short u16;

#define NTHREADS 512
constexpr int Bn = 4, Sn = 2048, Dn = 2048, Cn = 256;
constexpr int MT = Bn * Sn;
constexpr int MC = Bn * Cn;
constexpr int ATTN_IN = 5120;
constexpr int HY_IN = 8192;

constexpr size_t OFF_WT_AI = 0;
constexpr size_t OFF_WT_AO = OFF_WT_AI + (size_t)5120 * 2048 * 2;
constexpr size_t OFF_WT_HI = OFF_WT_AO + (size_t)2048 * 2048 * 2;
constexpr size_t OFF_WT_HO = OFF_WT_HI + (size_t)8192 * 2048 * 2;
constexpr size_t OFF_MOD   = OFF_WT_HO + (size_t)2048 * 2048 * 2;
constexpr size_t OFF_ROPE  = OFF_MOD + (size_t)2 * 5 * 6144 * 4 + 256;
constexpr size_t OFF_FILT  = OFF_ROPE + (size_t)64 * 32 * 8;
constexpr size_t OFF_ACT   = OFF_FILT + (size_t)2 * 2048 * 4096 * 2;
constexpr size_t OFF_HC    = OFF_ACT + (size_t)8192 * 2048 * 2;
constexpr size_t OFF_KVC   = OFF_HC + (size_t)1024 * 2048 * 2;
constexpr size_t OFF_VT    = OFF_KVC + (size_t)1024 * 1024 * 2;
constexpr size_t OFF_VCT   = OFF_VT + (size_t)512 * 8192 * 2;
constexpr size_t OFF_BIG   = OFF_VCT + (size_t)512 * 1024 * 2;

struct Params {
  const float *x, *c, *ctx, *c_ctx, *norm_g, *ada_w, *ada_b, *attn_w_in, *attn_w_out, *attn_sink;
  const float *hy_w_in, *hy_conv_w, *hy_conv_b, *hy_w1, *hy_b1, *hy_w2, *hy_b2, *hy_w3, *hy_b3;
  const float *hy_freq, *hy_bias_d, *hy_w_out, *final_g;
  float* out;
  char* ws;
};

__device__ __forceinline__ u16 f2bf(float f) {
  unsigned u = __float_as_uint(f);
  u += 0x7fffu + ((u >> 16) & 1u);
  return (u16)(u >> 16);
}
__device__ __forceinline__ float bf2f(u16 h) { return __uint_as_float(((unsigned)h) << 16); }
__device__ __forceinline__ float bflo(unsigned w) { return __uint_as_float(w << 16); }
__device__ __forceinline__ float bfhi(unsigned w) { return __uint_as_float(w & 0xffff0000u); }
__device__ __forceinline__ float siluf(float v) { return v / (1.f + __expf(-v)); }
__device__ __forceinline__ float wave_sum(float v) {
#pragma unroll
  for (int o = 32; o > 0; o >>= 1) v += __shfl_xor(v, o, 64);
  return v;
}
__device__ __forceinline__ float wave_max(float v) {
#pragma unroll
  for (int o = 32; o > 0; o >>= 1) v = fmaxf(v, __shfl_xor(v, o, 64));
  return v;
}

__device__ void p0_convert(const float* __restrict__ W, u16* __restrict__ Wt, int N, int tk, int tn,
                           bool perm, float* sm) {
  const int tid = threadIdx.x;
  for (int i = tid; i < 64 * 32; i += NTHREADS) {
    int r = i >> 5, c4 = i & 31;
    float4 v = *(const float4*)(W + (size_t)(tk * 64 + r) * N + tn * 128 + c4 * 4);
    float* d = sm + r * 129 + c4 * 4;
    d[0] = v.x; d[1] = v.y; d[2] = v.z; d[3] = v.w;
  }
  __syncthreads();
  for (int i = tid; i < 128 * 8; i += NTHREADS) {
    int nrow = i >> 3, kc = i & 7;
    int src = nrow;
    if (perm && (tn * 128 < 2560)) {
      int g = nrow >> 5, nn = (nrow >> 4) & 1, fr = nrow & 15;
      src = (g >> 1) * 64 + nn * 32 + (g & 1) * 16 + fr;
    }
    unsigned w[4];
#pragma unroll
    for (int j = 0; j < 4; ++j) {
      float a = sm[(kc * 8 + 2 * j) * 129 + src];
      float b = sm[(kc * 8 + 2 * j + 1) * 129 + src];
      w[j] = (unsigned)f2bf(a) | ((unsigned)f2bf(b) << 16);
    }
    *(uint4*)(Wt + (size_t)(tn * 128 + nrow) * 2048 + tk * 64 + kc * 8) = make_uint4(w[0], w[1], w[2], w[3]);
  }
  __syncthreads();
}

__device__ void p0_adaln(const Params& p, int item, float* sm) {
  const int tid = threadIdx.x;
  float* sv = sm;
  float* red = sm + 5 * 2048;
  int col0 = item * 48;
  int l = col0 / 6144, n0 = col0 % 6144;
  for (int i = tid; i < 5 * 2048; i += NTHREADS) {
    int v = i >> 11, k = i & 2047;
    float cv = v < 4 ? p.c[v * 2048 + k] : p.c_ctx[k];
    sv[i] = cv / (1.f + expf(-cv));
  }
  __syncthreads();
  int kg = tid / 12, cq = tid % 12;
  float acc[5][4];
#pragma unroll
  for (int v = 0; v < 5; ++v)
#pragma unroll
    for (int j = 0; j < 4; ++j) acc[v][j] = 0.f;
  if (kg < 42) {
    const float* W = p.ada_w + (size_t)l * 2048 * 6144 + n0 + cq * 4;
#pragma unroll 8
    for (int k = kg; k < 2048; k += 42) {
      float4 w = *(const float4*)(W + (size_t)k * 6144);
#pragma unroll
      for (int v = 0; v < 5; ++v) {
        float s = sv[v * 2048 + k];
        acc[v][0] += s * w.x; acc[v][1] += s * w.y; acc[v][2] += s * w.z; acc[v][3] += s * w.w;
      }
    }
  }
  if (kg >= 21 && kg < 42) {
#pragma unroll
    for (int v = 0; v < 5; ++v)
#pragma unroll
      for (int j = 0; j < 4; ++j) red[((kg - 21) * 5 + v) * 48 + cq * 4 + j] = acc[v][j];
  }
  __syncthreads();
  if (kg < 21) {
#pragma unroll
    for (int v = 0; v < 5; ++v)
#pragma unroll
      for (int j = 0; j < 4; ++j) red[(kg * 5 + v) * 48 + cq * 4 + j] += acc[v][j];
  }
  __syncthreads();
  if (tid < 240) {
    int v = tid / 48, cc = tid % 48;
    float s = 0.f;
    for (int g = 0; g < 21; ++g) s += red[(g * 5 + v) * 48 + cc];
    float* mod = (float*)(p.ws + OFF_MOD);
    mod[(l * 5 + v) * 6144 + n0 + cc] = s + p.ada_b[l * 6144 + n0 + cc];
  }
  __syncthreads();
}

__device__ void p0_rope(const Params& p) {
  float2* rope = (float2*)(p.ws + OFF_ROPE);
  for (int i = threadIdx.x; i < 64 * 32; i += NTHREADS) {
    int pos = i >> 5, j = i & 31;
    float inv = powf(10000.f, -(float)(2 * j) / 64.f);
    float ang = (float)pos * inv;
    rope[i] = make_float2(cosf(ang), sinf(ang));
  }
}

typedef short bf16x8_t __attribute__((ext_vector_type(8)));
typedef unsigned u32x4_t __attribute__((ext_vector_type(4)));
typedef float f32x16_t __attribute__((ext_vector_type(16)));
__device__ __forceinline__ void split8(const float (&v)[8], bf16x8_t& hi, bf16x8_t& lo) {
  u32x4_t H, L;
#pragma unroll
  for (int j = 0; j < 4; ++j) {
    const u16 h0 = f2bf(v[2 * j]), h1 = f2bf(v[2 * j + 1]);
    const float r0 = v[2 * j] - bf2f(h0), r1 = v[2 * j + 1] - bf2f(h1);
    H[j] = (unsigned)h0 | ((unsigned)h1 << 16);
    L[j] = (unsigned)f2bf(r0) | ((unsigned)f2bf(r1) << 16);
  }
  hi = __builtin_bit_cast(bf16x8_t, H);
  lo = __builtin_bit_cast(bf16x8_t, L);
}
__device__ void p0_filter(const Params& p, int item, float* sm) {
  int tid = threadIdx.x;
  asm volatile("" : "+v"(tid));
  const int lane = tid & 63, wid = tid >> 6, r = lane & 31, h = lane >> 5;
  const int cc = item & 15, pg = item >> 4;
  float* z = sm;
  float* h1 = z + 128 * 36;
  float* h2 = h1 + 128 * 64;
  for (int i = tid; i < 128 * 33; i += NTHREADS) {
    int pos = i / 33, e = i % 33;
    int t = pg * 128 + pos;
    float val;
    if (e == 0) val = (float)t / 2047.f;
    else {
      int bi = (e - 1) & 15;
      float w = 6.283185307179586f * (float)t / 2048.f;
      float fr = 1e-4f + (float)bi * ((15.f - 1e-4f) / 15.f);
      float ang = w * fr;
      val = (e <= 16) ? cosf(ang) : -sinf(ang);
    }
    z[pos * 36 + e] = val;
  }
  __syncthreads();
  {
    const int j = lane;
    float w1r[33];
#pragma unroll
    for (int e = 0; e < 33; ++e) w1r[e] = p.hy_w1[e * 64 + j];
    const float fq = p.hy_freq[j], b1 = p.hy_b1[j];
#pragma unroll 1
    for (int q = 0; q < 16; ++q) {
      const int pos = wid * 16 + q;
      const float4* zp = (const float4*)(z + pos * 36);
      float a = b1;
#pragma unroll
      for (int e4 = 0; e4 < 8; ++e4) {
        float4 zv = zp[e4];
        a += zv.x * w1r[4 * e4] + zv.y * w1r[4 * e4 + 1] + zv.z * w1r[4 * e4 + 2] + zv.w * w1r[4 * e4 + 3];
      }
      a += z[pos * 36 + 32] * w1r[32];
      h1[pos * 64 + j] = sinf(fq * a);
    }
  }
  __syncthreads();
  {
    const int j = lane;
    float w2r[64];
#pragma unroll
    for (int e = 0; e < 64; ++e) w2r[e] = p.hy_w2[e * 64 + j];
    const float fq = p.hy_freq[j], b2 = p.hy_b2[j];
#pragma unroll 1
    for (int q = 0; q < 16; ++q) {
      const int pos = wid * 16 + q;
      const float4* hp = (const float4*)(h1 + pos * 64);
      float a = b2;
#pragma unroll
      for (int e4 = 0; e4 < 16; ++e4) {
        float4 hv = hp[e4];
        a += hv.x * w2r[4 * e4] + hv.y * w2r[4 * e4 + 1] + hv.z * w2r[4 * e4 + 2] + hv.w * w2r[4 * e4 + 3];
      }
      h2[pos * 68 + j] = sinf(fq * a);
    }
  }
  __syncthreads();
  const int colw = cc * 512 + wid * 64;
  bf16x8_t Ahi[2][4], Alo[2][4];
#pragma unroll
  for (int ct = 0; ct < 2; ++ct)
#pragma unroll
    for (int ks = 0; ks < 4; ++ks) {
      float v[8];
#pragma unroll
      for (int j = 0; j < 8; ++j) v[j] = p.hy_w3[(size_t)(16 * ks + 8 * h + j) * 8192 + colw + ct * 32 + r];
      split8(v, Ahi[ct][ks], Alo[ct][ks]);
    }
  const int o = cc >> 3, dir = (cc >> 2) & 1;
  u16* Rg = (u16*)(p.ws + OFF_FILT) + (size_t)o * 2048 * 4096;
  const float min_decay = -3.0701134573253945f, max_decay = -15.350567286626972f;
#pragma unroll 1
  for (int pp = 0; pp < 2; ++pp) {
    f32x16_t acc[2][2];
#pragma unroll
    for (int ct = 0; ct < 2; ++ct)
#pragma unroll
      for (int q = 0; q < 2; ++q)
#pragma unroll
        for (int i = 0; i < 16; ++i) acc[ct][q][i] = 0.f;
#pragma unroll
    for (int q = 0; q < 2; ++q)
#pragma unroll
      for (int ks = 0; ks < 4; ++ks) {
        const float* hp = h2 + ((pp * 2 + q) * 32 + r) * 68 + 16 * ks + 8 * h;
        float4 x0 = *(const float4*)hp, x1 = *(const float4*)(hp + 4);
        float v[8] = {x0.x, x0.y, x0.z, x0.w, x1.x, x1.y, x1.z, x1.w};
        bf16x8_t Bhi, Blo;
        split8(v, Bhi, Blo);
#pragma unroll
        for (int ct = 0; ct < 2; ++ct) {
          acc[ct][q] = __builtin_amdgcn_mfma_f32_32x32x16_bf16(Ahi[ct][ks], Bhi, acc[ct][q], 0, 0, 0);
          acc[ct][q] = __builtin_amdgcn_mfma_f32_32x32x16_bf16(Ahi[ct][ks], Blo, acc[ct][q], 0, 0, 0);
          acc[ct][q] = __builtin_amdgcn_mfma_f32_32x32x16_bf16(Alo[ct][ks], Bhi, acc[ct][q], 0, 0, 0);
        }
      }
    int hh = h;
    asm volatile("" : "+v"(hh));
#pragma unroll
    for (int ct = 0; ct < 2; ++ct)
#pragma unroll
      for (int i = 0; i < 16; ++i) {
        const int col = colw + ct * 32 + (i & 3) + 8 * (i >> 2) + 4 * hh;
        const int ch = col & 2047;
        const float b3 = p.hy_b3[col];
        const float ad = fabsf(min_decay + (float)ch * ((max_decay - min_decay) / 2047.f));
        u16* R = Rg + (size_t)ch * 4096;
#pragma unroll
        for (int q = 0; q < 2; ++q) {
          const int t = pg * 128 + (pp * 2 + q) * 32 + r;
          const float tn = (float)t / 2047.f;
          float v = (acc[ct][q][i] + b3) * (__expf(-tn * ad) + 0.05f);
          if (dir == 0) {
            if (t == 0) v += p.hy_bias_d[o * 2048 + ch];
            R[2048 - t] = f2bf(v);
          } else {
            if (t > 0) R[2048 + t] = f2bf(v);
            else R[0] = 0;
          }
        }
      }
  }
  __syncthreads();
}

constexpr int N_CV_AI = 16 * 40, N_CV_AO = 16 * 16, N_CV_HI = 16 * 64, N_CV_HO = 16 * 16;
constexpr int N_CV = N_CV_AI + N_CV_AO + N_CV_HI + N_CV_HO;
#define CV_DECODE(I, W_, Wt_, N_, tk_, tn_, perm_) do { int _i = (I); \
    const bool _a = _i < N_CV_AI, _b2 = _i < N_CV_AI + N_CV_AO, _c = _i < N_CV_AI + N_CV_AO + N_CV_HI; \
    W_ = _a ? p.attn_w_in : (_b2 ? p.attn_w_out : (_c ? p.hy_w_in : p.hy_w_out)); \
    Wt_ = (u16*)(p.ws + (_a ? OFF_WT_AI : (_b2 ? OFF_WT_AO : (_c ? OFF_WT_HI : OFF_WT_HO)))); \
    N_ = _a ? 5120 : (_b2 ? 2048 : (_c ? 8192 : 2048)); \
    const int _nt = _a ? 40 : (_b2 ? 16 : (_c ? 64 : 16)); \
    _i -= _a ? 0 : (_b2 ? N_CV_AI : (_c ? N_CV_AI + N_CV_AO : N_CV_AI + N_CV_AO + N_CV_HI)); \
    tk_ = _i / _nt; tn_ = _i - tk_ * _nt; perm_ = _a && (tn_ * 128 < 2560); } while (0)
__device__ void p0_convert_all(const Params& p, float* sm) {
  const int tid = threadIdx.x;
  float4 r0, r1, r2, r3, r4, r5, r6, r7;
#define CV_LOAD(W_, N_, tk_, tn_) do { const float* _b = (W_) + (size_t)((tk_) * 128 + (tid >> 5)) * (N_) + (tn_) * 128 + (tid & 31) * 4; const size_t _s = (size_t)16 * (N_); \
    r0 = *(const float4*)(_b); r1 = *(const float4*)(_b + _s); r2 = *(const float4*)(_b + 2 * _s); r3 = *(const float4*)(_b + 3 * _s); \
    r4 = *(const float4*)(_b + 4 * _s); r5 = *(const float4*)(_b + 5 * _s); r6 = *(const float4*)(_b + 6 * _s); r7 = *(const float4*)(_b + 7 * _s); } while (0)
#define CV_PUT(R, I) do { float* _d = sm + ((tid >> 5) + 16 * (I)) * 129 + (tid & 31) * 4; _d[0] = (R).x; _d[1] = (R).y; _d[2] = (R).z; _d[3] = (R).w; } while (0)
  int it = blockIdx.x;
  const float* cW; u16* cWt; int cN, ctk, ctn; bool cperm;
  CV_DECODE(it < N_CV ? it : 0, cW, cWt, cN, ctk, ctn, cperm);
  if (it < N_CV) CV_LOAD(cW, cN, ctk, ctn);
  while (it < N_CV) {
    __syncthreads();
    CV_PUT(r0, 0); CV_PUT(r1, 1); CV_PUT(r2, 2); CV_PUT(r3, 3); CV_PUT(r4, 4); CV_PUT(r5, 5); CV_PUT(r6, 6); CV_PUT(r7, 7);
    __syncthreads();
    const int nit = it + gridDim.x;
    const float* nW; u16* nWt; int nN, ntk, ntn; bool nperm;
    CV_DECODE(nit < N_CV ? nit : 0, nW, nWt, nN, ntk, ntn, nperm);
    if (nit < N_CV) CV_LOAD(nW, nN, ntk, ntn);
    const int row = (tid & 15) | (((tid >> 6) & 7) << 4);
    int src = row;
    if (cperm) { const int g = row >> 5, nn = (row >> 4) & 1, fr = row & 15; src = (g >> 1) * 64 + nn * 32 + (g & 1) * 16 + fr; }
#pragma unroll
    for (int i = 0; i < 4; ++i) {
      const int kch = ((tid >> 4) & 3) | (i << 2);
      unsigned w[4];
#pragma unroll
      for (int j = 0; j < 4; ++j) {
        float a = sm[(kch * 8 + 2 * j) * 129 + src];
        float b = sm[(kch * 8 + 2 * j + 1) * 129 + src];
        w[j] = (unsigned)f2bf(a) | ((unsigned)f2bf(b) << 16);
      }
      *(uint4*)(cWt + (size_t)(ctn * 128 + row) * 2048 + ctk * 128 + kch * 8) = make_uint4(w[0], w[1], w[2], w[3]);
    }
    cW = nW; cWt = nWt; cN = nN; ctk = ntk; ctn = ntn; cperm = nperm;
    it = nit;
  }
#undef CV_LOAD
#undef CV_PUT
}

__device__ void phase0(const Params& p, float* sm) {
  for (int it = blockIdx.x; it < 256; it += gridDim.x) p0_adaln(p, it, sm);
  if (blockIdx.x == gridDim.x - 1) p0_rope(p);
  __syncthreads();
  for (int it = blockIdx.x; it < 256; it += gridDim.x) p0_filter(p, it, sm);
  __syncthreads();
  p0_convert_all(p, sm);
}

__device__ void norm_row(const float* __restrict__ src, const float* __restrict__ g, const float* shift,
                         const float* scale, u16* dst_bf, float* dst_f, int lane) {
  float4 v[8];
  float ss = 0.f;
#pragma unroll
  for (int j = 0; j < 8; ++j) {
    v[j] = *(const float4*)(src + (j * 64 + lane) * 4);
    ss += v[j].x * v[j].x + v[j].y * v[j].y + v[j].z * v[j].z + v[j].w * v[j].w;
  }
  ss = wave_sum(ss);
  float r = rsqrtf(ss * (1.f / 2048.f) + 1e-6f);
#pragma unroll
  for (int j = 0; j < 8; ++j) {
    int c = (j * 64 + lane) * 4;
    float4 gg = *(const float4*)(g + c);
    float4 o = make_float4(v[j].x * r * gg.x, v[j].y * r * gg.y, v[j].z * r * gg.z, v[j].w * r * gg.w);
    if (dst_bf) {
      float4 sh = *(const float4*)(shift + c);
      float4 sc = *(const float4*)(scale + c);
      o.x = o.x * (1.f + sc.x) + sh.x; o.y = o.y * (1.f + sc.y) + sh.y;
      o.z = o.z * (1.f + sc.z) + sh.z; o.w = o.w * (1.f + sc.w) + sh.w;
      uint2 pk;
      pk.x = (unsigned)f2bf(o.x) | ((unsigned)f2bf(o.y) << 16);
      pk.y = (unsigned)f2bf(o.z) | ((unsigned)f2bf(o.w) << 16);
      *(uint2*)(dst_bf + c) = pk;
    } else {
      *(float4*)(dst_f + c) = o;
    }
  }
}

__device__ void phase_norm(const Params& p, int mode) {
  const int wid = threadIdx.x >> 6, lane = threadIdx.x & 63;
  const float* mod = (const float*)(p.ws + OFF_MOD);
  int nrows = (mode == 0) ? (MT + MC) : MT;
  for (int row = blockIdx.x * 8 + wid; row < nrows; row += gridDim.x * 8) {
    if (mode == 0) {
      if (row < MT) {
        int b = row >> 11;
        const float* m = mod + (0 * 5 + b) * 6144;
        norm_row(p.x + (size_t)row * 2048, p.norm_g, m, m + 2048, (u16*)(p.ws + OFF_ACT) + (size_t)row * 2048, nullptr, lane);
      } else {
        int rc = row - MT;
        const float* m = mod + (0 * 5 + 4) * 6144;
        norm_row(p.ctx + (size_t)rc * 2048, p.norm_g, m, m + 2048, (u16*)(p.ws + OFF_HC) + (size_t)rc * 2048, nullptr, lane);
      }
    } else if (mode == 1) {
      int b = row >> 11;
      const float* m = mod + (1 * 5 + b) * 6144;
      norm_row(p.out + (size_t)row * 2048, p.norm_g + 2048, m, m + 2048, (u16*)(p.ws + OFF_ACT) + (size_t)row * 2048, nullptr, lane);
    } else {
      norm_row(p.out + (size_t)row * 2048, p.final_g, nullptr, nullptr, nullptr, p.out + (size_t)row * 2048, lane);
    }
  }
}

namespace pg8 {
#define PG8_LAS __attribute__((address_space(3)))
typedef unsigned short bf16_t;
typedef short bf16x8 __attribute__((ext_vector_type(8)));
typedef float f32x4 __attribute__((ext_vector_type(4)));
typedef unsigned u32x4 __attribute__((ext_vector_type(4)));
constexpr int BM = 256, BK = 64, HALF = 128, HTB = HALF * BK * 2  , STAGE_BYTES = 8 * HTB, NXCD = 8, WGM = 8;

__host__ __device__ __forceinline__ int lds_byte(int r, int c) { const int st = (r >> 4) * 2 + (c >> 5), rr = r & 15, cc = c & 31, ob = rr * 64 + cc * 2; return st * 1024 + (ob ^ (((ob >> 9) & 1) << 5)); }
__host__ __device__ __forceinline__ void stage_rc(int b, int& R, int& C) { const int st = b / 1024, sb = b % 1024, swz = sb ^ (((sb >> 9) & 1) << 5); R = (st >> 1) * 16 + swz / 64; C = (st & 1) * 32 + (swz % 64) / 2; }
__host__ __device__ __forceinline__ int perm32(int rho) { const int n = rho >> 4, i = rho & 15; return 8 * (i >> 2) + 4 * n + (i & 3); }

struct Unit { int pm, pn; };
struct Gemm { const bf16_t* A; const bf16_t* Bt; int M, N, K; };

struct StaticOrder {
    int nM, nN, nwg, G, c;
    __host__ __device__ void init(int M, int N, int G_, int c_) { nM = M / BM; nN = N / BM; nwg = nM * nN; G = G_; c = c_; }
    __host__ __device__ bool next(int i, Unit& u) const {
        const long L = (long)i * G + c; if (L >= nwg) return false;
        int wgid = (int)L; { const int q = nwg / NXCD, r = nwg % NXCD, xcd = wgid % NXCD, off = wgid / NXCD; wgid = (xcd < r ? xcd * (q + 1) : r * (q + 1) + (xcd - r) * q) + off; }
        const int nig = WGM * nN, gid = wgid / nig, fm = gid * WGM, gsz = (nM - fm) < WGM ? (nM - fm) : WGM;
        u.pm = fm + ((wgid % nig) % gsz); u.pn = (wgid % nig) / gsz; return true;
    }
    __device__ __forceinline__ void a_ready(const Unit&) const {}
    __device__ __forceinline__ void done(const Unit&) const {}
};
__device__ __forceinline__ unsigned cvt_pk_bf16(float lo, float hi) { unsigned r; asm volatile("v_cvt_pk_bf16_f32 %0, %1, %2" : "=v"(r) : "v"(lo), "v"(hi)); return r; }
template <class Epi, class Sched>
__device__ __forceinline__ void gemm_phase(PG8_LAS unsigned char* lds, const Gemm g, const Sched& S, const Epi& E) {
    const int tid = threadIdx.x, wid = __builtin_amdgcn_readfirstlane(tid >> 6), lane = tid & 63, wr = wid >> 2, wc = wid & 3, fr = lane & 15, fq = lane >> 4;
    const int K = g.K, nt = K / BK;
    unsigned voffA[2], voffB[2];
#pragma unroll
    for (int i = 0; i < 2; ++i) { int R, C; stage_rc(tid * 16 + i * 8192, R, C); const int Rb = Epi::PERM ? ((R & ~31) + perm32(R & 31)) : R;
        voffA[i] = (unsigned)(R * K + C) * 2u; voffB[i] = (unsigned)(Rb * K + C) * 2u; }
    const size_t kstep = (size_t)(BK * 2);
    const size_t hstep = (size_t)HALF * K * 2;
    const size_t tstep = 2 * hstep;
    const unsigned ldsw = (unsigned)wid * 1024u;
    const int aoff = lds_byte(wr * 64 + fr, fq * 8), boff = lds_byte(wc * 32 + fr, fq * 8);
#define PG8_SA(b, h) (((b) * 2 + (h)) * HTB)
#define PG8_SB(b, h) ((4 + (b) * 2 + (h)) * HTB)
#define PG8_STAGE(bufoff, gbase, voff) do { _Pragma("unroll") for (int _i = 0; _i < 2; ++_i) \
        __builtin_amdgcn_global_load_lds((const unsigned*)((const char*)(gbase) + (voff)[_i]), (PG8_LAS unsigned*)(lds + (bufoff) + ldsw + _i * 8192), 16, 0, 0); } while (0)
#define PG8_LDA(dst, b, h) do { _Pragma("unroll") for (int m = 0; m < 4; ++m) _Pragma("unroll") for (int k = 0; k < 2; ++k) dst[m][k] = *(const PG8_LAS bf16x8*)(lds + PG8_SA(b, h) + aoff + m * 2048 + k * 1024); } while (0)
#define PG8_LDB(dst, b, h) do { _Pragma("unroll") for (int n = 0; n < 2; ++n) _Pragma("unroll") for (int k = 0; k < 2; ++k) dst[n][k] = *(const PG8_LAS bf16x8*)(lds + PG8_SB(b, h) + boff + n * 2048 + k * 1024); } while (0)
#define PG8_MMA(ai, bj, At, Bt) do { __builtin_amdgcn_s_setprio(1); _Pragma("unroll") for (int m = 0; m < 4; ++m) _Pragma("unroll") for (int n = 0; n < 2; ++n) _Pragma("unroll") for (int k = 0; k < 2; ++k) \
        acc[ai][bj][m][n] = __builtin_amdgcn_mfma_f32_16x16x32_bf16(Bt[n][k], At[m][k], acc[ai][bj][m][n], 0, 0, 0); __builtin_amdgcn_s_setprio(0); } while (0)
#define PG8_WAIT_V(n) asm volatile("s_waitcnt vmcnt(" #n ")" ::: "memory")
#define PG8_WAIT_L(n) asm volatile("s_waitcnt lgkmcnt(" #n ")" ::: "memory")
#define PG8_BAR __builtin_amdgcn_s_barrier()
#define PG8_SCHED __builtin_amdgcn_sched_barrier(0)
    Unit cur, nxt; int ui = 0;
    if (!S.next(0, cur)) return;
    f32x4 acc[2][2][4][2];
#pragma unroll
    for (int a = 0; a < 2; ++a)
#pragma unroll
        for (int b = 0; b < 2; ++b)
#pragma unroll
            for (int m = 0; m < 4; ++m)
#pragma unroll
                for (int n = 0; n < 2; ++n) acc[a][b][m][n] = (f32x4){0.f, 0.f, 0.f, 0.f};
    bf16x8 At[4][2], B0[2][2], B1[2][2];
    const char* cA = (const char*)g.A + (size_t)cur.pm * tstep; const char* cB = (const char*)g.Bt + (size_t)cur.pn * tstep;
    S.a_ready(cur);
    PG8_STAGE(PG8_SB(0, 0), cB, voffB); PG8_STAGE(PG8_SA(0, 0), cA, voffA); PG8_STAGE(PG8_SB(0, 1), cB + hstep, voffB); PG8_STAGE(PG8_SA(0, 1), cA + hstep, voffA);
    if (wr == 1) PG8_BAR;
    PG8_WAIT_V(4); PG8_BAR;
    PG8_STAGE(PG8_SB(1, 0), cB + kstep, voffB); PG8_STAGE(PG8_SA(1, 0), cA + kstep, voffA); PG8_STAGE(PG8_SB(1, 1), cB + hstep + kstep, voffB);
    PG8_WAIT_V(6); PG8_BAR;
    for (;;) {
        const bool has_next = S.next(ui + 1, nxt);
        const char* nA = has_next ? (const char*)g.A + (size_t)nxt.pm * tstep : cA; const char* nB = has_next ? (const char*)g.Bt + (size_t)nxt.pn * tstep : cB;
        for (int t = 0; t < nt; t += 2) {
            const bool last = (t == nt - 2);
            const char* a1 = cA + (size_t)(t + 1) * kstep;
            const char* a2 = last ? nA : cA + (size_t)(t + 2) * kstep; const char* b2 = last ? nB : cB + (size_t)(t + 2) * kstep;
            const char* a3 = a2 + kstep; const char* b3 = b2 + kstep;
            if (last && has_next) S.a_ready(nxt);
            PG8_LDB(B0, 0, 0); PG8_SCHED; PG8_LDA(At, 0, 0); PG8_STAGE(PG8_SA(1, 1), a1 + hstep, voffA);
            PG8_WAIT_L(8); PG8_BAR; PG8_WAIT_L(0); PG8_MMA(0, 0, At, B0); PG8_BAR; PG8_SCHED;
            PG8_LDB(B1, 0, 1); PG8_STAGE(PG8_SB(0, 0), b2, voffB);
            PG8_BAR; PG8_WAIT_L(0); PG8_MMA(0, 1, At, B1); PG8_BAR;
            PG8_LDA(At, 0, 1); PG8_STAGE(PG8_SA(0, 0), a2, voffA);
            PG8_BAR; PG8_WAIT_L(0); PG8_MMA(1, 0, At, B0); PG8_BAR; PG8_SCHED;
            PG8_STAGE(PG8_SB(0, 1), b2 + hstep, voffB);
            PG8_WAIT_V(6); PG8_BAR; PG8_MMA(1, 1, At, B1); PG8_BAR;
            PG8_LDB(B0, 1, 0); PG8_SCHED; PG8_LDA(At, 1, 0); PG8_STAGE(PG8_SA(0, 1), a2 + hstep, voffA);
            PG8_WAIT_L(8); PG8_BAR; PG8_WAIT_L(0); PG8_MMA(0, 0, At, B0); PG8_BAR; PG8_SCHED;
            PG8_LDB(B1, 1, 1); PG8_STAGE(PG8_SB(1, 0), b3, voffB);
            PG8_BAR; PG8_WAIT_L(0); PG8_MMA(0, 1, At, B1); PG8_BAR;
            PG8_LDA(At, 1, 1); PG8_STAGE(PG8_SA(1, 0), a3, voffA);
            PG8_BAR; PG8_WAIT_L(0); PG8_MMA(1, 0, At, B0); PG8_BAR; PG8_SCHED;
            PG8_STAGE(PG8_SB(1, 1), b3 + hstep, voffB);
            PG8_WAIT_V(6); PG8_BAR; PG8_MMA(1, 1, At, B1); PG8_BAR;
        }
        if constexpr (!Epi::AFTER_DRAIN) { E(acc, cur, wr, wc, fr, fq); S.done(cur); }
        if (!has_next) break;
#pragma unroll
        for (int a = 0; a < 2; ++a)
#pragma unroll
            for (int b = 0; b < 2; ++b)
#pragma unroll
                for (int m = 0; m < 4; ++m)
#pragma unroll
                    for (int n = 0; n < 2; ++n) acc[a][b][m][n] = (f32x4){0.f, 0.f, 0.f, 0.f};
        cur = nxt; cA = nA; cB = nB; ++ui;
    }
    PG8_WAIT_V(0);
    if (wr == 0) PG8_BAR;
    PG8_BAR;
    if constexpr (Epi::AFTER_DRAIN) { E.fused(acc, cur, wr, wc, fr, fq, lds, wid, lane); S.done(cur); }
#undef PG8_SA
#undef PG8_SB
#undef PG8_STAGE
#undef PG8_LDA
#undef PG8_LDB
#undef PG8_MMA
#undef PG8_WAIT_V
#undef PG8_WAIT_L
#undef PG8_BAR
#undef PG8_SCHED
}
}

__device__ __forceinline__ uint2 pack4(pg8::f32x4 v) {
  uint2 r;
  r.x = (unsigned)f2bf(v[0]) | ((unsigned)f2bf(v[1]) << 16);
  r.y = (unsigned)f2bf(v[2]) | ((unsigned)f2bf(v[3]) << 16);
  return r;
}
struct EpiAttnIn {
  static constexpr bool PERM = false, AFTER_DRAIN = false;
  u16* O; const float* rope;
  __device__ __forceinline__ void operator()(const pg8::f32x4 (&acc)[2][2][4][2], const pg8::Unit& u, int wr, int wc, int fr, int fq) const {
    const int row0 = u.pm * 256 + wr * 64 + fr, col0 = u.pn * 256 + wc * 32 + 4 * fq;
    const bool dorope = (u.pn < 10);
    const int axis = wc >> 1, i0 = (wc & 1) * 16 + 4 * fq;
#pragma unroll
    for (int ai = 0; ai < 2; ++ai)
#pragma unroll
      for (int m = 0; m < 4; ++m) {
        const int row = row0 + ai * 128 + m * 16;
        u16* rowp = O + (size_t)row * 5120 + col0;
        if (dorope) {
          const int s = row & 2047;
          const int pos = axis ? (s & 63) : (s >> 6);
          const float4* rp = (const float4*)(rope + (pos * 32 + i0) * 2);
          float4 c01 = rp[0], c23 = rp[1];
#pragma unroll
          for (int bj = 0; bj < 2; ++bj) {
            pg8::f32x4 a = acc[ai][bj][m][0], b = acc[ai][bj][m][1], o0, o1;
            o0[0] = a[0] * c01.x - b[0] * c01.y; o1[0] = b[0] * c01.x + a[0] * c01.y;
            o0[1] = a[1] * c01.z - b[1] * c01.w; o1[1] = b[1] * c01.z + a[1] * c01.w;
            o0[2] = a[2] * c23.x - b[2] * c23.y; o1[2] = b[2] * c23.x + a[2] * c23.y;
            o0[3] = a[3] * c23.z - b[3] * c23.w; o1[3] = b[3] * c23.z + a[3] * c23.w;
            *(uint2*)(rowp + bj * 128) = pack4(o0);
            *(uint2*)(rowp + bj * 128 + 16) = pack4(o1);
          }
        } else {
#pragma unroll
          for (int bj = 0; bj < 2; ++bj) {
            *(uint2*)(rowp + bj * 128) = pack4(acc[ai][bj][m][0]);
            *(uint2*)(rowp + bj * 128 + 16) = pack4(acc[ai][bj][m][1]);
          }
        }
      }
  }
};
struct EpiRaw {
  static constexpr bool PERM = false, AFTER_DRAIN = false;
  u16* O; int ldc;
  __device__ __forceinline__ void operator()(const pg8::f32x4 (&acc)[2][2][4][2], const pg8::Unit& u, int wr, int wc, int fr, int fq) const {
    const int row0 = u.pm * 256 + wr * 64 + fr, col0 = u.pn * 256 + wc * 32 + 4 * fq;
#pragma unroll
    for (int ai = 0; ai < 2; ++ai)
#pragma unroll
      for (int m = 0; m < 4; ++m) {
        u16* rowp = O + (size_t)(row0 + ai * 128 + m * 16) * ldc + col0;
#pragma unroll
        for (int bj = 0; bj < 2; ++bj) {
          *(uint2*)(rowp + bj * 128) = pack4(acc[ai][bj][m][0]);
          *(uint2*)(rowp + bj * 128 + 16) = pack4(acc[ai][bj][m][1]);
        }
      }
  }
};
struct EpiRes {
  static constexpr bool PERM = false, AFTER_DRAIN = false;
  float* out; const float* base; const float* gate;
  __device__ __forceinline__ void operator()(const pg8::f32x4 (&acc)[2][2][4][2], const pg8::Unit& u, int wr, int wc, int fr, int fq) const {
    const int row0 = u.pm * 256 + wr * 64 + fr, col0 = u.pn * 256 + wc * 32 + 4 * fq;
    const int b = (u.pm * 256) >> 11;
    pg8::f32x4 gv[2][2];
#pragma unroll
    for (int bj = 0; bj < 2; ++bj)
#pragma unroll
      for (int n = 0; n < 2; ++n) gv[bj][n] = *(const pg8::f32x4*)(gate + b * 6144 + col0 + bj * 128 + n * 16);
#pragma unroll
    for (int ai = 0; ai < 2; ++ai)
#pragma unroll
      for (int m = 0; m < 4; ++m) {
        const size_t off = (size_t)(row0 + ai * 128 + m * 16) * 2048 + col0;
#pragma unroll
        for (int bj = 0; bj < 2; ++bj)
#pragma unroll
          for (int n = 0; n < 2; ++n) {
            pg8::f32x4 bv = *(const pg8::f32x4*)(base + off + bj * 128 + n * 16);
            *(pg8::f32x4*)(out + off + bj * 128 + n * 16) = bv + gv[bj][n] * acc[ai][bj][m][n];
          }
      }
  }
};
template <class Epi>
__device__ __forceinline__ void run_gemm(float* sm, const u16* A, const u16* Bt, int M, int N, const Epi& E, int c) {
  pg8::Gemm g{A, Bt, M, N, 2048};
  pg8::StaticOrder S; S.init(M, N, (int)gridDim.x, c);
  pg8::gemm_phase<Epi, pg8::StaticOrder>((PG8_LAS unsigned char*)sm, g, S, E);
  __syncthreads();
}

template <int MODE>
__device__ __forceinline__ void epi_pair(const Params& p, int m, int n, float a0, float a1) {
  if (MODE == 1) {
    u16* px = (u16*)(p.ws + OFF_BIG);
    float o0 = a0, o1 = a1;
    if (n < 2560) {
      int g = (n >> 5) & 3, fr = n & 15;
      int axis = g >> 1, i = (g & 1) * 16 + fr;
      int s = m & 2047;
      int pos = axis ? (s & 63) : (s >> 6);
      float2 cs = ((const float2*)(p.ws + OFF_ROPE))[pos * 32 + i];
      o0 = a0 * cs.x - a1 * cs.y;
      o1 = a1 * cs.x + a0 * cs.y;
    }
    px[(size_t)m * 5120 + n] = f2bf(o0);
    px[(size_t)m * 5120 + n + 16] = f2bf(o1);
  } else if (MODE == 5) {
    u16* kvc = (u16*)(p.ws + OFF_KVC);
    kvc[(size_t)m * 1024 + n] = f2bf(a0);
    kvc[(size_t)m * 1024 + n + 16] = f2bf(a1);
  } else if (MODE == 2) {
    const float* mod = (const float*)(p.ws + OFF_MOD);
    int b = m >> 11;
    const float* gate = mod + (0 * 5 + b) * 6144 + 4096;
    p.out[(size_t)m * 2048 + n] = p.x[(size_t)m * 2048 + n] + gate[n] * a0;
    p.out[(size_t)m * 2048 + n + 16] = p.x[(size_t)m * 2048 + n + 16] + gate[n + 16] * a1;
  } else if (MODE == 3) {
    u16* pp = (u16*)(p.ws + OFF_BIG);
    pp[(size_t)m * 8192 + n] = f2bf(a0);
    pp[(size_t)m * 8192 + n + 16] = f2bf(a1);
  } else if (MODE == 4) {
    const float* mod = (const float*)(p.ws + OFF_MOD);
    int b = m >> 11;
    const float* gate = mod + (1 * 5 + b) * 6144 + 4096;
    p.out[(size_t)m * 2048 + n] += gate[n] * a0;
    p.out[(size_t)m * 2048 + n + 16] += gate[n + 16] * a1;
  }
}

template <int MODE>
__device__ void naive_gemm(const Params& p, const u16* __restrict__ A, const u16* __restrict__ Wt, int M, int N) {
  const int tid = threadIdx.x;
  const int ml = tid >> 5, pl = tid & 31;
  const int ntn = N / 64, ntm = M / 16;
  for (int tile = blockIdx.x; tile < ntn * ntm; tile += gridDim.x) {
    int tm = tile / ntn, tn = tile % ntn;
    int m = tm * 16 + ml;
    int n = tn * 64 + (pl >> 4) * 32 + (pl & 15);
    const uint4* a = (const uint4*)(A + (size_t)m * 2048);
    const uint4* w0 = (const uint4*)(Wt + (size_t)n * 2048);
    const uint4* w1 = (const uint4*)(Wt + (size_t)(n + 16) * 2048);
    float acc0 = 0.f, acc1 = 0.f;
#pragma unroll 2
    for (int k = 0; k < 256; ++k) {
      uint4 av = a[k], b0 = w0[k], b1 = w1[k];
      acc0 += bflo(av.x) * bflo(b0.x) + bfhi(av.x) * bfhi(b0.x) + bflo(av.y) * bflo(b0.y) + bfhi(av.y) * bfhi(b0.y)
            + bflo(av.z) * bflo(b0.z) + bfhi(av.z) * bfhi(b0.z) + bflo(av.w) * bflo(b0.w) + bfhi(av.w) * bfhi(b0.w);
      acc1 += bflo(av.x) * bflo(b1.x) + bfhi(av.x) * bfhi(b1.x) + bflo(av.y) * bflo(b1.y) + bfhi(av.y) * bfhi(b1.y)
            + bflo(av.z) * bflo(b1.z) + bfhi(av.z) * bfhi(b1.z) + bflo(av.w) * bflo(b1.w) + bfhi(av.w) * bfhi(b1.w);
    }
    epi_pair<MODE>(p, m, n, acc0, acc1);
  }
}

__device__ void phase_attn_naive(const Params& p, float* sm) {
  const int wid = threadIdx.x >> 6, lane = threadIdx.x & 63;
  float* qs = sm + wid * (128 + 640);
  float* pr = qs + 128;
  const u16* px = (const u16*)(p.ws + OFF_BIG);
  const u16* kvc = (const u16*)(p.ws + OFF_KVC);
  u16* og = (u16*)(p.ws + OFF_ACT);
  const float scale = 0.08838834764831845f;
  for (int item = blockIdx.x * 8 + wid; item < MT * 16; item += gridDim.x * 8) {
    int m = item >> 4, h = item & 15;
    int b = m >> 11, s = m & 2047, kvh = h >> 2, nblk = s >> 7;
    const u16* qrow = px + (size_t)m * 5120 + h * 128;
    qs[lane] = bf2f(qrow[lane]) * scale;
    qs[lane + 64] = bf2f(qrow[lane + 64]) * scale;
    asm volatile("s_waitcnt lgkmcnt(0)" ::: "memory");
    float mx = p.attn_sink[h];
#pragma unroll 1
    for (int j = 0; j < 10; ++j) {
      int kidx = j * 64 + lane;
      const u16* krow;
      bool valid;
      if (kidx < 384) {
        int kpos = (nblk - 1) * 128 + kidx;
        int rel = kpos - s;
        valid = (kpos >= 0) && (kpos < 2048) && (rel <= 128) && (rel >= -128);
        krow = px + (size_t)(b * 2048 + (valid ? kpos : 0)) * 5120 + 2048 + kvh * 128;
      } else {
        valid = true;
        krow = kvc + (size_t)(b * 256 + (kidx - 384)) * 1024 + kvh * 128;
      }
      float d = -1e30f;
      if (valid) {
        d = 0.f;
#pragma unroll 4
        for (int c = 0; c < 16; ++c) {
          uint4 kk = *(const uint4*)(krow + c * 8);
          const float* q8 = qs + c * 8;
          d += q8[0] * bflo(kk.x) + q8[1] * bfhi(kk.x) + q8[2] * bflo(kk.y) + q8[3] * bfhi(kk.y)
             + q8[4] * bflo(kk.z) + q8[5] * bfhi(kk.z) + q8[6] * bflo(kk.w) + q8[7] * bfhi(kk.w);
        }
      }
      pr[kidx] = d;
      mx = fmaxf(mx, d);
    }
    mx = wave_max(mx);
    float sum = 0.f;
#pragma unroll 1
    for (int j = 0; j < 10; ++j) {
      float d = pr[j * 64 + lane];
      float e = (d > -1e29f) ? __expf(d - mx) : 0.f;
      pr[j * 64 + lane] = e;
      sum += e;
    }
    sum = wave_sum(sum);
    sum += __expf(p.attn_sink[h] - mx);
    asm volatile("s_waitcnt lgkmcnt(0)" ::: "memory");
    float o0 = 0.f, o1 = 0.f;
    int k0 = s - 128 < 0 ? 0 : s - 128, k1 = s + 128 > 2047 ? 2047 : s + 128;
    for (int kpos = k0; kpos <= k1; ++kpos) {
      float pv = pr[kpos - (nblk - 1) * 128];
      unsigned vv = *(const unsigned*)(px + (size_t)(b * 2048 + kpos) * 5120 + 2560 + kvh * 128 + lane * 2);
      o0 += pv * bflo(vv); o1 += pv * bfhi(vv);
    }
    for (int c = 0; c < 256; ++c) {
      float pv = pr[384 + c];
      unsigned vv = *(const unsigned*)(kvc + (size_t)(b * 256 + c) * 1024 + 512 + kvh * 128 + lane * 2);
      o0 += pv * bflo(vv); o1 += pv * bfhi(vv);
    }
    float inv = 1.f / sum;
    unsigned gg = *(const unsigned*)(px + (size_t)m * 5120 + 3072 + h * 128 + lane * 2);
    float r0 = o0 * inv * siluf(bflo(gg)), r1 = o1 * inv * siluf(bfhi(gg));
    *(unsigned*)(og + (size_t)m * 2048 + h * 128 + lane * 2) = (unsigned)f2bf(r0) | ((unsigned)f2bf(r1) << 16);
    asm volatile("s_waitcnt lgkmcnt(0)" ::: "memory");
  }
}

__device__ __forceinline__ float sconv(const u16* pp, const float* cw, const float* cb, int b, int t, int c) {
  const u16* base = pp + (size_t)(b * 2048 + t) * 8192 + c;
  float v = cw[6144 + c] * bf2f(base[0]) + cb[c];
  if (t > 0) v += cw[c] * bf2f(base[-8192]);
  if (t < 2047) v += cw[2 * 6144 + c] * bf2f(base[8192]);
  return v;
}

__device__ void phase_conv_naive(const Params& p, float* sm) {
  const int tid = threadIdx.x;
  float* u = sm;
  float* R = sm + 8192;
  const u16* pp = (const u16*)(p.ws + OFF_BIG);
  const u16* Rg = (const u16*)(p.ws + OFF_FILT);
  u16* yg = (u16*)(p.ws + OFF_ACT);
  for (int ch = blockIdx.x; ch < 2048; ch += gridDim.x) {
    for (int i = tid; i < 8192; i += NTHREADS) u[i] = sconv(pp, p.hy_conv_w, p.hy_conv_b, i >> 11, i & 2047, 4096 + ch);
    for (int i = tid; i < 4096; i += NTHREADS) R[i] = bf2f(Rg[((size_t)0 * 2048 + ch) * 4096 + i]);
    __syncthreads();
    float zr[16];
#pragma unroll
    for (int q = 0; q < 16; ++q) {
      int i = tid + q * NTHREADS;
      int b = i >> 11, t = i & 2047;
      const float* ub = u + b * 2048;
      const float* Rb = R + 2048 - t;
      float a = 0.f;
      for (int s = 0; s < 2048; ++s) a += Rb[s] * ub[s];
      zr[q] = a * sconv(pp, p.hy_conv_w, p.hy_conv_b, b, t, ch);
    }
    __syncthreads();
#pragma unroll
    for (int q = 0; q < 16; ++q) u[tid + q * NTHREADS] = zr[q];
    for (int i = tid; i < 4096; i += NTHREADS) R[i] = bf2f(Rg[((size_t)1 * 2048 + ch) * 4096 + i]);
    __syncthreads();
#pragma unroll
    for (int q = 0; q < 16; ++q) {
      int i = tid + q * NTHREADS;
      int b = i >> 11, t = i & 2047;
      const float* ub = u + b * 2048;
      const float* Rb = R + 2048 - t;
      float a = 0.f;
      for (int s = 0; s < 2048; ++s) a += Rb[s] * ub[s];
      float y = a * sconv(pp, p.hy_conv_w, p.hy_conv_b, b, t, 2048 + ch);
      float g = bf2f(pp[(size_t)(b * 2048 + t) * 8192 + 6144 + ch]);
      yg[(size_t)(b * 2048 + t) * 2048 + ch] = f2bf(y * siluf(g));
    }
    __syncthreads();
  }
}


typedef float f32x16 __attribute__((ext_vector_type(16)));
typedef pg8::bf16x8 bfx8;
constexpr int CONV_RF_BYTES = 4 * 8192;
constexpr int CONV_UB_ONE = 192 * 64;
__device__ __forceinline__ int ub_addr(int col, int chunk) { return col * 64 + ((chunk ^ ((col >> 2) & 3)) << 4); }

__device__ __forceinline__ void conv_mfma(const char* Rf_ci, const char* Ub_w, int lane, f32x16 (&acc)[4]) {
  const int t2 = lane & 31, h = lane >> 5, n = lane & 31;
  const unsigned sh = (unsigned)(t2 & 1) * 16u;
  const int lanedw = (2048 - t2 + 8 * h) >> 1;
#pragma unroll
  for (int j = 0; j < 4; ++j)
#pragma unroll
    for (int r = 0; r < 16; ++r) acc[j][r] = 0.f;
#pragma unroll 1
  for (int f = 0; f < 16; ++f) {
    bfx8 Bw[5][2];
#pragma unroll
    for (int m = 0; m < 5; ++m) {
      const int col = (16 * m - f + 16) * 2 + n;
#pragma unroll
      for (int kh = 0; kh < 2; ++kh) Bw[m][kh] = *(const bfx8*)(Ub_w + ub_addr(col, 2 * kh + h));
    }
    const unsigned* Rp = (const unsigned*)Rf_ci + lanedw - 16 * f;
#pragma unroll
    for (int e = -4; e <= 3; ++e) {
      int ee = e;
      if (e == -4) ee = (f == 0) ? -3 : -4;
      bfx8 A[2];
#pragma unroll
      for (int kh = 0; kh < 2; ++kh) {
        const unsigned* q = Rp - 256 * ee + 8 * kh;
        unsigned w0 = q[0], w1 = q[1], w2 = q[2], w3 = q[3], w4 = q[4];
        pg8::u32x4 pk;
        pk[0] = __builtin_amdgcn_alignbit(w1, w0, sh);
        pk[1] = __builtin_amdgcn_alignbit(w2, w1, sh);
        pk[2] = __builtin_amdgcn_alignbit(w3, w2, sh);
        pk[3] = __builtin_amdgcn_alignbit(w4, w3, sh);
        A[kh] = __builtin_bit_cast(bfx8, pk);
      }
#pragma unroll
      for (int j = 0; j < 4; ++j) {
        const int m = j - e;
        if (m >= 0 && m <= 4) acc[j] = __builtin_amdgcn_mfma_f32_32x32x16_bf16(A[0], Bw[m][0], acc[j], 0, 0, 0);
      }
#pragma unroll
      for (int j = 0; j < 4; ++j) {
        const int m = j - e;
        if (m >= 0 && m <= 4) acc[j] = __builtin_amdgcn_mfma_f32_32x32x16_bf16(A[1], Bw[m][1], acc[j], 0, 0, 0);
      }
    }
  }
}

__device__ __forceinline__ void sconv4(const u16* xp, int t, float w0, float w1, float w2, float cb, float (&o)[4]) {
  uint2 x4 = *(const uint2*)xp;
  float pv = t > 0 ? bf2f(xp[-1]) : 0.f;
  float nx = (t + 4 < 2048) ? bf2f(xp[4]) : 0.f;
  float e0 = bflo(x4.x), e1 = bfhi(x4.x), e2 = bflo(x4.y), e3 = bfhi(x4.y);
  o[0] = w0 * pv + w1 * e0 + w2 * e1 + cb;
  o[1] = w0 * e0 + w1 * e1 + w2 * e2 + cb;
  o[2] = w0 * e1 + w1 * e2 + w2 * e3 + cb;
  o[3] = w0 * e2 + w1 * e3 + w2 * nx + cb;
}

__device__ void phase_conv(const Params& p, float* smf) {
  char* sm = (char*)smf;
  char* Rf = sm;
  char* Ub = sm + CONV_RF_BYTES;
  const int tid = threadIdx.x, wid = tid >> 6, lane = tid & 63;
  const int ci = wid >> 1, bp = wid & 1;
  const u16* pT = (const u16*)(p.ws + OFF_BIG);
  const u16* Rg = (const u16*)(p.ws + OFF_FILT);
  u16* yg = (u16*)(p.ws + OFF_ACT);
  for (int i = tid; i < 8 * CONV_UB_ONE / 16; i += NTHREADS) ((uint4*)Ub)[i] = make_uint4(0, 0, 0, 0);
  __syncthreads();
  char* Ub_w = Ub + (ci * 2 + bp) * CONV_UB_ONE;
  const char* Rf_ci = Rf + ci * 8192;
  const int h = lane >> 5, n = lane & 31;
  for (int item = blockIdx.x; item < 512; item += gridDim.x) {
    const int ch0 = item * 4;
    for (int task = tid; task < 4096; task += NTHREADS) {
      const int q = task & 255, b = (task >> 8) & 3, c = task >> 10;
      const int cc = 4096 + ch0 + c;
      const u16* xp = pT + (size_t)cc * 8192 + b * 2048 + q * 8;
      uint4 x8 = *(const uint4*)xp;
      float pv = q > 0 ? bf2f(xp[-1]) : 0.f;
      float nx = q < 255 ? bf2f(xp[8]) : 0.f;
      float w0 = p.hy_conv_w[cc], w1 = p.hy_conv_w[6144 + cc], w2 = p.hy_conv_w[2 * 6144 + cc], cb = p.hy_conv_b[cc];
      float e[10];
      e[0] = pv; e[1] = bflo(x8.x); e[2] = bfhi(x8.x); e[3] = bflo(x8.y); e[4] = bfhi(x8.y);
      e[5] = bflo(x8.z); e[6] = bfhi(x8.z); e[7] = bflo(x8.w); e[8] = bfhi(x8.w); e[9] = nx;
      unsigned o[4];
#pragma unroll
      for (int k = 0; k < 4; ++k) {
        float a = w0 * e[2 * k] + w1 * e[2 * k + 1] + w2 * e[2 * k + 2] + cb;
        float bb = w0 * e[2 * k + 1] + w1 * e[2 * k + 2] + w2 * e[2 * k + 3] + cb;
        o[k] = (unsigned)f2bf(a) | ((unsigned)f2bf(bb) << 16);
      }
      const int t0 = q * 8, s1 = t0 >> 5, s2 = t0 & 31;
      const int col = (s1 + 16) * 2 + (b & 1);
      *(uint4*)(Ub + (c * 2 + (b >> 1)) * CONV_UB_ONE + ub_addr(col, s2 >> 3)) = make_uint4(o[0], o[1], o[2], o[3]);
    }
    for (int i = tid; i < 2048; i += NTHREADS) {
      const int c = i >> 9, k = i & 511;
      ((uint4*)Rf)[i] = ((const uint4*)(Rg + ((size_t)0 * 2048 + ch0 + c) * 4096))[k];
    }
    __syncthreads();
    f32x16 acc[4];
    const int ch = ch0 + ci;
    conv_mfma(Rf_ci, Ub_w, lane, acc);
    {
      const float w0 = p.hy_conv_w[ch], w1 = p.hy_conv_w[6144 + ch], w2 = p.hy_conv_w[2 * 6144 + ch], cb = p.hy_conv_b[ch];
#pragma unroll
      for (int j = 0; j < 4; ++j)
#pragma unroll
        for (int vg = 0; vg < 4; ++vg) {
          const int t1 = 16 * j + (n >> 1), bl = n & 1, b = 2 * bp + bl, t = 32 * t1 + 8 * vg + 4 * h;
          float x1[4];
          sconv4(pT + (size_t)ch * 8192 + b * 2048 + t, t, w0, w1, w2, cb, x1);
          uint2 pk;
          pk.x = (unsigned)f2bf(x1[0] * acc[j][4 * vg + 0]) | ((unsigned)f2bf(x1[1] * acc[j][4 * vg + 1]) << 16);
          pk.y = (unsigned)f2bf(x1[2] * acc[j][4 * vg + 2]) | ((unsigned)f2bf(x1[3] * acc[j][4 * vg + 3]) << 16);
          const int col = (t1 + 16) * 2 + bl;
          *(uint2*)(Ub_w + ub_addr(col, vg) + 8 * h) = pk;
        }
    }
    __syncthreads();
    for (int i = tid; i < 2048; i += NTHREADS) {
      const int c = i >> 9, k = i & 511;
      ((uint4*)Rf)[i] = ((const uint4*)(Rg + ((size_t)1 * 2048 + ch0 + c) * 4096))[k];
    }
    __syncthreads();
    conv_mfma(Rf_ci, Ub_w, lane, acc);
    {
      const int c2 = 2048 + ch;
      const float w0 = p.hy_conv_w[c2], w1 = p.hy_conv_w[6144 + c2], w2 = p.hy_conv_w[2 * 6144 + c2], cb = p.hy_conv_b[c2];
#pragma unroll
      for (int j = 0; j < 4; ++j)
#pragma unroll
        for (int vg = 0; vg < 4; ++vg) {
          const int t1 = 16 * j + (n >> 1), bl = n & 1, b = 2 * bp + bl, t = 32 * t1 + 8 * vg + 4 * h;
          float x2[4];
          sconv4(pT + (size_t)c2 * 8192 + b * 2048 + t, t, w0, w1, w2, cb, x2);
          uint2 g4 = *(const uint2*)(pT + (size_t)(6144 + ch) * 8192 + b * 2048 + t);
          float y0 = x2[0] * acc[j][4 * vg + 0] * siluf(bflo(g4.x));
          float y1 = x2[1] * acc[j][4 * vg + 1] * siluf(bfhi(g4.x));
          float y2 = x2[2] * acc[j][4 * vg + 2] * siluf(bflo(g4.y));
          float y3 = x2[3] * acc[j][4 * vg + 3] * siluf(bfhi(g4.y));
          uint2 pk;
          pk.x = (unsigned)f2bf(y0) | ((unsigned)f2bf(y1) << 16);
          pk.y = (unsigned)f2bf(y2) | ((unsigned)f2bf(y3) << 16);
          const int col = (t1 + 16) * 2 + bl;
          *(uint2*)(Ub_w + ub_addr(col, vg) + 8 * h) = pk;
        }
    }
    __syncthreads();
    for (int idx = tid; idx < 8192; idx += NTHREADS) {
      const int b = idx >> 11, t = idx & 2047;
      const int s1 = t >> 5, s2 = t & 31;
      const int col = (s1 + 16) * 2 + (b & 1);
      const int a = ub_addr(col, s2 >> 3) + (s2 & 7) * 2;
      const char* base = Ub + (b >> 1) * CONV_UB_ONE + a;
      unsigned v0 = *(const u16*)(base + 0 * 2 * CONV_UB_ONE), v1 = *(const u16*)(base + 1 * 2 * CONV_UB_ONE);
      unsigned v2 = *(const u16*)(base + 2 * 2 * CONV_UB_ONE), v3 = *(const u16*)(base + 3 * 2 * CONV_UB_ONE);
      *(uint2*)(yg + (size_t)idx * 2048 + ch0) = make_uint2(v0 | (v1 << 16), v2 | (v3 << 16));
    }
    __syncthreads();
  }
}


constexpr int AT_KROW = 272, AT_VROW = 136;
constexpr int AT_K_BYTES = 64 * AT_KROW, AT_V_BYTES = 128 * AT_VROW;
__device__ void phase_attn(const Params& p, float* smf) {
  char* sm = (char*)smf;
  char* Ks = sm;
  char* Vs = sm + AT_K_BYTES;
  const int tid = threadIdx.x, wid = tid >> 6, lane = tid & 63, r = lane & 31, h = lane >> 5;
  const u16* px = (const u16*)(p.ws + OFF_BIG);
  const u16* kvc = (const u16*)(p.ws + OFF_KVC);
  const u16* vT = (const u16*)(p.ws + OFF_VT);
  const u16* vcT = (const u16*)(p.ws + OFF_VCT);
  u16* og = (u16*)(p.ws + OFF_ACT);
  const float LOG2E = 1.4426950408889634f;
  const float sl2 = 0.08838834764831845f * LOG2E;
  for (int item = blockIdx.x; item < 512; item += gridDim.x) {
    const int hp = item & 1, kvh = (item >> 1) & 3, nblk = (item >> 3) & 15, b = item >> 7;
    const int hq = kvh * 4 + hp * 2 + (wid >> 2);
    const int qs = nblk * 128 + (wid & 3) * 32 + r;
    bfx8 Q[8];
    {
      const u16* qrow = px + (size_t)(b * 2048 + qs) * 5120 + hq * 128 + 8 * h;
#pragma unroll
      for (int st = 0; st < 8; ++st) Q[st] = *(const bfx8*)(qrow + 16 * st);
    }
    f32x16 O[4];
#pragma unroll
    for (int dt = 0; dt < 4; ++dt)
#pragma unroll
      for (int i = 0; i < 16; ++i) O[dt][i] = 0.f;
    float m = p.attn_sink[hq] * LOG2E;
    float l = (h == 0) ? 1.f : 0.f;
    const int first = (nblk == 0) ? 2 : 0, lastlocal = (nblk == 15) ? 3 : 5;
    uint4 kreg0, kreg1, vreg0, vreg1;
#define AT_LOAD_TILE(TI) do { \
      const int _ti = (TI); const bool _loc = _ti < 6; \
      const int _kpos0 = 128 * (nblk - 1) + 64 * _ti, _c0 = 64 * (_ti - 6); \
      const u16* _kb = _loc ? px + (size_t)(b * 2048 + _kpos0) * 5120 + 2048 + kvh * 128 : kvc + (size_t)(b * 256 + _c0) * 1024 + kvh * 128; \
      const size_t _ks = _loc ? 5120 : 1024; \
      const u16* _vb = _loc ? vT + (size_t)(kvh * 128) * 8192 + b * 2048 + _kpos0 : vcT + (size_t)(kvh * 128) * 1024 + b * 256 + _c0; \
      const size_t _vs = _loc ? 8192 : 1024; \
      const int _c1 = tid + NTHREADS; \
      kreg0 = *(const uint4*)(_kb + (size_t)(tid >> 4) * _ks + (tid & 15) * 8); \
      kreg1 = *(const uint4*)(_kb + (size_t)(_c1 >> 4) * _ks + (_c1 & 15) * 8); \
      vreg0 = *(const uint4*)(_vb + (size_t)(tid >> 3) * _vs + (tid & 7) * 8); \
      vreg1 = *(const uint4*)(_vb + (size_t)(_c1 >> 3) * _vs + (_c1 & 7) * 8); \
    } while (0)
    int ti = first;
    AT_LOAD_TILE(ti);
    while (true) {
      __syncthreads();
      {
        const int c1 = tid + NTHREADS;
        *(uint4*)(Ks + (tid >> 4) * AT_KROW + (tid & 15) * 16) = kreg0;
        *(uint4*)(Ks + (c1 >> 4) * AT_KROW + (c1 & 15) * 16) = kreg1;
        char* v0p = Vs + (tid >> 3) * AT_VROW + (tid & 7) * 16;
        char* v1p = Vs + (c1 >> 3) * AT_VROW + (c1 & 7) * 16;
        *(uint2*)(v0p) = make_uint2(vreg0.x, vreg0.y);
        *(uint2*)(v0p + 8) = make_uint2(vreg0.z, vreg0.w);
        *(uint2*)(v1p) = make_uint2(vreg1.x, vreg1.y);
        *(uint2*)(v1p + 8) = make_uint2(vreg1.z, vreg1.w);
      }
      __syncthreads();
      int tn = ti + 1;
      if (tn > lastlocal && tn < 6) tn = 6;
      if (tn < 10) AT_LOAD_TILE(tn);
      {
        const bool local = ti < 6;
        const int kpos0 = 128 * (nblk - 1) + 64 * ti;
        f32x16 S[2];
#pragma unroll
        for (int ks = 0; ks < 2; ++ks) {
#pragma unroll
          for (int i = 0; i < 16; ++i) S[ks][i] = 0.f;
#pragma unroll
          for (int st = 0; st < 8; ++st) {
            bfx8 A = *(const bfx8*)(Ks + (ks * 32 + r) * AT_KROW + (16 * st + 8 * h) * 2);
            S[ks] = __builtin_amdgcn_mfma_f32_32x32x16_bf16(A, Q[st], S[ks], 0, 0, 0);
          }
        }
        float mx = m;
#pragma unroll
        for (int ks = 0; ks < 2; ++ks)
#pragma unroll
          for (int i = 0; i < 16; ++i) {
            float sv = S[ks][i] * sl2;
            if (local) {
              const int kpos = kpos0 + ks * 32 + (i & 3) + 8 * (i >> 2) + 4 * h;
              const int rel = kpos - qs;
              if (rel > 128 || rel < -128) sv = -1e30f;
            }
            S[ks][i] = sv;
            mx = fmaxf(mx, sv);
          }
        mx = fmaxf(mx, __shfl_xor(mx, 32, 64));
        const float alpha = __builtin_amdgcn_exp2f(m - mx);
        m = mx;
        l *= alpha;
#pragma unroll
        for (int dt = 0; dt < 4; ++dt)
#pragma unroll
          for (int i = 0; i < 16; ++i) O[dt][i] *= alpha;
#pragma unroll
        for (int ks = 0; ks < 2; ++ks)
#pragma unroll
          for (int i = 0; i < 16; ++i) {
            float pv = __builtin_amdgcn_exp2f(S[ks][i] - m);
            l += pv;
            S[ks][i] = pv;
          }
#pragma unroll
        for (int s4 = 0; s4 < 4; ++s4) {
          const int ks = s4 >> 1, hf = s4 & 1;
          pg8::u32x4 pk;
#pragma unroll
          for (int j = 0; j < 4; ++j)
            pk[j] = (unsigned)f2bf(S[ks][8 * hf + 2 * j]) | ((unsigned)f2bf(S[ks][8 * hf + 2 * j + 1]) << 16);
          bfx8 P = __builtin_bit_cast(bfx8, pk);
#pragma unroll
          for (int dt = 0; dt < 4; ++dt) {
            const char* vp = Vs + (dt * 32 + r) * AT_VROW + (32 * ks + 16 * hf + 4 * h) * 2;
            uint2 v0 = *(const uint2*)vp, v1 = *(const uint2*)(vp + 16);
            pg8::u32x4 vv; vv[0] = v0.x; vv[1] = v0.y; vv[2] = v1.x; vv[3] = v1.y;
            O[dt] = __builtin_amdgcn_mfma_f32_32x32x16_bf16(__builtin_bit_cast(bfx8, vv), P, O[dt], 0, 0, 0);
          }
        }
      }
      if (tn >= 10) break;
      ti = tn;
    }
    const float ltot = l + __shfl_xor(l, 32, 64);
    const float inv = 1.f / ltot;
    const size_t tok = (size_t)(b * 2048 + qs);
#pragma unroll
    for (int dt = 0; dt < 4; ++dt)
#pragma unroll
      for (int g4 = 0; g4 < 4; ++g4) {
        const int d = dt * 32 + 8 * g4 + 4 * h;
        uint2 gg = *(const uint2*)(px + tok * 5120 + 3072 + hq * 128 + d);
        float o0 = O[dt][4 * g4 + 0] * inv * siluf(bflo(gg.x));
        float o1 = O[dt][4 * g4 + 1] * inv * siluf(bfhi(gg.x));
        float o2 = O[dt][4 * g4 + 2] * inv * siluf(bflo(gg.y));
        float o3 = O[dt][4 * g4 + 3] * inv * siluf(bfhi(gg.y));
        uint2 pk;
        pk.x = (unsigned)f2bf(o0) | ((unsigned)f2bf(o1) << 16);
        pk.y = (unsigned)f2bf(o2) | ((unsigned)f2bf(o3) << 16);
        *(uint2*)(og + tok * 2048 + hq * 128 + d) = pk;
      }
  }
}

constexpr int N_PHASES = 10;
__global__ void __launch_bounds__(NTHREADS, 2) mega(Params p, int ph0, int ph1) {
  extern __shared__ __attribute__((aligned(16))) float sm[];
#define PH(i, body) if (ph0 <= (i) && (i) < ph1) { body; if ((i) + 1 < ph1) cg::this_grid().sync(); }
  PH(0, phase0(p, sm))
  PH(1, phase_norm(p, 0))
  PH(2, run_gemm(sm, (const u16*)(p.ws + OFF_ACT), (const u16*)(p.ws + OFF_WT_AI), MT, ATTN_IN,
                 EpiAttnIn{(u16*)(p.ws + OFF_BIG), (const float*)(p.ws + OFF_ROPE)}, (int)blockIdx.x);
        run_gemm(sm, (const u16*)(p.ws + OFF_HC), (const u16*)(p.ws + OFF_WT_AI) + (size_t)2048 * 2048, MC, 1024,
                 EpiRaw{(u16*)(p.ws + OFF_KVC), 1024}, (int)((blockIdx.x + 64) % gridDim.x));
        run_gemm(sm, (const u16*)(p.ws + OFF_WT_AI) + (size_t)2560 * 2048, (const u16*)(p.ws + OFF_ACT), 512, MT,
                 EpiRaw{(u16*)(p.ws + OFF_VT), 8192}, (int)((blockIdx.x + 128) % gridDim.x));
        run_gemm(sm, (const u16*)(p.ws + OFF_WT_AI) + (size_t)2560 * 2048, (const u16*)(p.ws + OFF_HC), 512, MC,
                 EpiRaw{(u16*)(p.ws + OFF_VCT), 1024}, (int)((blockIdx.x + 48) % gridDim.x)))
  PH(3, phase_attn(p, sm))
  PH(4, run_gemm(sm, (const u16*)(p.ws + OFF_ACT), (const u16*)(p.ws + OFF_WT_AO), MT, 2048,
                 EpiRes{p.out, p.x, (const float*)(p.ws + OFF_MOD) + 4096}, (int)blockIdx.x))
  PH(5, phase_norm(p, 1))
  PH(6, run_gemm(sm, (const u16*)(p.ws + OFF_WT_HI), (const u16*)(p.ws + OFF_ACT), HY_IN, MT,
                 EpiRaw{(u16*)(p.ws + OFF_BIG), 8192}, (int)blockIdx.x))
  PH(7, phase_conv(p, sm))
  PH(8, run_gemm(sm, (const u16*)(p.ws + OFF_ACT), (const u16*)(p.ws + OFF_WT_HO), MT, 2048,
                 EpiRes{p.out, p.out, (const float*)(p.ws + OFF_MOD) + 5 * 6144 + 4096}, (int)blockIdx.x))
  PH(9, phase_norm(p, 2))
}

extern "C" void kernel_launch(void* const* d_in, const int* in_sizes, int n_in, void* d_out, int out_size,
                              void* d_ws, size_t ws_size, hipStream_t stream) {
  Params p{};
  const float** f = (const float**)&p;
  for (int i = 0; i < 23; ++i) f[i] = (const float*)d_in[i];
  p.out = (float*)d_out;
  p.ws = (char*)d_ws;
  constexpr size_t kLds = 128 * 1024;
  static int grid_blocks = 0;
  if (!grid_blocks) {
    (void)hipFuncSetAttribute((const void*)mega, hipFuncAttributeMaxDynamicSharedMemorySize, (int)kLds);
    int dev = 0, cus = 0, per_cu = 0;
    (void)hipGetDevice(&dev);
    (void)hipDeviceGetAttribute(&cus, hipDeviceAttributeMultiprocessorCount, dev);
    (void)hipOccupancyMaxActiveBlocksPerMultiprocessor(&per_cu, mega, NTHREADS, kLds);
    if (per_cu < 1) per_cu = 1;
    grid_blocks = cus * per_cu;
  }
  int ph0 = 0, ph1 = N_PHASES;
  void* args[] = {(void*)&p, (void*)&ph0, (void*)&ph1};
  hipError_t e = hipLaunchCooperativeKernel((const void*)mega, dim3(grid_blocks), dim3(NTHREADS), args, kLds, stream);
  if (e != hipSuccess) fprintf(stderr, "cooperative launch failed: %s (grid %d)\n", hipGetErrorString(e), grid_blocks);
}
```

```cpp
#include <hip/hip_runtime.h>
#include <hip/hip_bf16.h>
#include <hip/hip_cooperative_groups.h>
#include <cstdio>
namespace cg = cooperative_groups;
typedef unsigned short u16;

#define NTHREADS 512
constexpr int Bn = 4, Sn = 2048, Dn = 2048, Cn = 256;
constexpr int MT = Bn * Sn;
constexpr int MC = Bn * Cn;
constexpr int ATTN_IN = 5120;
constexpr int HY_IN = 8192;

constexpr size_t OFF_WT_AI = 0;
constexpr size_t OFF_WT_AO = OFF_WT_AI + (size_t)5120 * 2048 * 2;
constexpr size_t OFF_WT_HI = OFF_WT_AO + (size_t)2048 * 2048 * 2;
constexpr size_t OFF_WT_HO = OFF_WT_HI + (size_t)8192 * 2048 * 2;
constexpr size_t OFF_MOD   = OFF_WT_HO + (size_t)2048 * 2048 * 2;
constexpr size_t OFF_ROPE  = OFF_MOD + (size_t)2 * 5 * 6144 * 4 + 256;
constexpr size_t OFF_FILT  = OFF_ROPE + (size_t)64 * 32 * 8;
constexpr size_t OFF_ACT   = OFF_FILT + (size_t)2 * 2048 * 4096 * 2;
constexpr size_t OFF_HC    = OFF_ACT + (size_t)8192 * 2048 * 2;
constexpr size_t OFF_KVC   = OFF_HC + (size_t)1024 * 2048 * 2;
constexpr size_t OFF_VT    = OFF_KVC + (size_t)1024 * 1024 * 2;
constexpr size_t OFF_VCT   = OFF_VT + (size_t)512 * 8192 * 2;
constexpr size_t OFF_BIG   = OFF_VCT + (size_t)512 * 1024 * 2;

constexpr size_t OFF_BAR   = OFF_BIG + (size_t)8192 * 8192 * 2;

struct Params {
  const float *x, *c, *ctx, *c_ctx, *norm_g, *ada_w, *ada_b, *attn_w_in, *attn_w_out, *attn_sink;
  const float *hy_w_in, *hy_conv_w, *hy_conv_b, *hy_w1, *hy_b1, *hy_w2, *hy_b2, *hy_w3, *hy_b3;
  const float *hy_freq, *hy_bias_d, *hy_w_out, *final_g;
  float* out;
  char* ws;
};

__device__ __forceinline__ u16 f2bf(float f) {
  unsigned u = __float_as_uint(f);
  u += 0x7fffu + ((u >> 16) & 1u);
  return (u16)(u >> 16);
}
__device__ __forceinline__ float bf2f(u16 h) { return __uint_as_float(((unsigned)h) << 16); }
__device__ __forceinline__ float bflo(unsigned w) { return __uint_as_float(w << 16); }
__device__ __forceinline__ float bfhi(unsigned w) { return __uint_as_float(w & 0xffff0000u); }
__device__ __forceinline__ float siluf(float v) { return v / (1.f + __expf(-v)); }
__device__ __forceinline__ float wave_sum(float v) {
#pragma unroll
  for (int o = 32; o > 0; o >>= 1) v += __shfl_xor(v, o, 64);
  return v;
}
__device__ __forceinline__ float wave_max(float v) {
#pragma unroll
  for (int o = 32; o > 0; o >>= 1) v = fmaxf(v, __shfl_xor(v, o, 64));
  return v;
}

__device__ void p0_convert(const float* __restrict__ W, u16* __restrict__ Wt, int N, int tk, int tn,
                           bool perm, float* sm) {
  const int tid = threadIdx.x;
  for (int i = tid; i < 64 * 32; i += NTHREADS) {
    int r = i >> 5, c4 = i & 31;
    float4 v = *(const float4*)(W + (size_t)(tk * 64 + r) * N + tn * 128 + c4 * 4);
    float* d = sm + r * 129 + c4 * 4;
    d[0] = v.x; d[1] = v.y; d[2] = v.z; d[3] = v.w;
  }
  __syncthreads();
  for (int i = tid; i < 128 * 8; i += NTHREADS) {
    int nrow = i >> 3, kc = i & 7;
    int src = nrow;
    if (perm && (tn * 128 < 2560)) {
      int g = nrow >> 5, nn = (nrow >> 4) & 1, fr = nrow & 15;
      src = (g >> 1) * 64 + nn * 32 + (g & 1) * 16 + fr;
    }
    unsigned w[4];
#pragma unroll
    for (int j = 0; j < 4; ++j) {
      float a = sm[(kc * 8 + 2 * j) * 129 + src];
      float b = sm[(kc * 8 + 2 * j + 1) * 129 + src];
      w[j] = (unsigned)f2bf(a) | ((unsigned)f2bf(b) << 16);
    }
    *(uint4*)(Wt + (size_t)(tn * 128 + nrow) * 2048 + tk * 64 + kc * 8) = make_uint4(w[0], w[1], w[2], w[3]);
  }
  __syncthreads();
}

__device__ void p0_adaln(const Params& p, int item, float* sm) {
  const int tid = threadIdx.x;
  float* sv = sm;
  float* red = sm + 5 * 2048;
  int col0 = item * 48;
  int l = col0 / 6144, n0 = col0 % 6144;
  for (int i = tid; i < 5 * 2048; i += NTHREADS) {
    int v = i >> 11, k = i & 2047;
    float cv = v < 4 ? p.c[v * 2048 + k] : p.c_ctx[k];
    sv[i] = cv / (1.f + expf(-cv));
  }
  __syncthreads();
  int kg = tid / 12, cq = tid % 12;
  float acc[5][4];
#pragma unroll
  for (int v = 0; v < 5; ++v)
#pragma unroll
    for (int j = 0; j < 4; ++j) acc[v][j] = 0.f;
  if (kg < 42) {
    const float* W = p.ada_w + (size_t)l * 2048 * 6144 + n0 + cq * 4;
#pragma unroll 8
    for (int k = kg; k < 2048; k += 42) {
      float4 w = *(const float4*)(W + (size_t)k * 6144);
#pragma unroll
      for (int v = 0; v < 5; ++v) {
        float s = sv[v * 2048 + k];
        acc[v][0] += s * w.x; acc[v][1] += s * w.y; acc[v][2] += s * w.z; acc[v][3] += s * w.w;
      }
    }
  }
  if (kg >= 21 && kg < 42) {
#pragma unroll
    for (int v = 0; v < 5; ++v)
#pragma unroll
      for (int j = 0; j < 4; ++j) red[((kg - 21) * 5 + v) * 48 + cq * 4 + j] = acc[v][j];
  }
  __syncthreads();
  if (kg < 21) {
#pragma unroll
    for (int v = 0; v < 5; ++v)
#pragma unroll
      for (int j = 0; j < 4; ++j) red[(kg * 5 + v) * 48 + cq * 4 + j] += acc[v][j];
  }
  __syncthreads();
  if (tid < 240) {
    int v = tid / 48, cc = tid % 48;
    float s = 0.f;
    for (int g = 0; g < 21; ++g) s += red[(g * 5 + v) * 48 + cc];
    float* mod = (float*)(p.ws + OFF_MOD);
    mod[(l * 5 + v) * 6144 + n0 + cc] = s + p.ada_b[l * 6144 + n0 + cc];
  }
  __syncthreads();
}

__device__ void p0_rope(const Params& p) {
  float2* rope = (float2*)(p.ws + OFF_ROPE);
  for (int i = threadIdx.x; i < 64 * 32; i += NTHREADS) {
    int pos = i >> 5, j = i & 31;
    float inv = powf(10000.f, -(float)(2 * j) / 64.f);
    float ang = (float)pos * inv;
    rope[i] = make_float2(cosf(ang), sinf(ang));
  }
}

typedef short bf16x8_t __attribute__((ext_vector_type(8)));
typedef unsigned u32x4_t __attribute__((ext_vector_type(4)));
typedef float f32x16_t __attribute__((ext_vector_type(16)));
__device__ __forceinline__ void split8(const float (&v)[8], bf16x8_t& hi, bf16x8_t& lo) {
  u32x4_t H, L;
#pragma unroll
  for (int j = 0; j < 4; ++j) {
    const u16 h0 = f2bf(v[2 * j]), h1 = f2bf(v[2 * j + 1]);
    const float r0 = v[2 * j] - bf2f(h0), r1 = v[2 * j + 1] - bf2f(h1);
    H[j] = (unsigned)h0 | ((unsigned)h1 << 16);
    L[j] = (unsigned)f2bf(r0) | ((unsigned)f2bf(r1) << 16);
  }
  hi = __builtin_bit_cast(bf16x8_t, H);
  lo = __builtin_bit_cast(bf16x8_t, L);
}
__device__ void p0_filter(const Params& p, int item, float* sm) {
  int tid = threadIdx.x;
  asm volatile("" : "+v"(tid));
  const int lane = tid & 63, wid = tid >> 6, r = lane & 31, h = lane >> 5;
  const int cc = item & 15, pg = item >> 4;
  float* z = sm;
  float* h1 = z + 128 * 36;
  float* h2 = h1 + 128 * 64;
  for (int i = tid; i < 128 * 33; i += NTHREADS) {
    int pos = i / 33, e = i % 33;
    int t = pg * 128 + pos;
    float val;
    if (e == 0) val = (float)t / 2047.f;
    else {
      int bi = (e - 1) & 15;
      float w = 6.283185307179586f * (float)t / 2048.f;
      float fr = 1e-4f + (float)bi * ((15.f - 1e-4f) / 15.f);
      float ang = w * fr;
      val = (e <= 16) ? cosf(ang) : -sinf(ang);
    }
    z[pos * 36 + e] = val;
  }
  __syncthreads();
  {
    const int j = lane;
    float w1r[33];
#pragma unroll
    for (int e = 0; e < 33; ++e) w1r[e] = p.hy_w1[e * 64 + j];
    const float fq = p.hy_freq[j], b1 = p.hy_b1[j];
#pragma unroll 1
    for (int q = 0; q < 16; ++q) {
      const int pos = wid * 16 + q;
      const float4* zp = (const float4*)(z + pos * 36);
      float a = b1;
#pragma unroll
      for (int e4 = 0; e4 < 8; ++e4) {
        float4 zv = zp[e4];
        a += zv.x * w1r[4 * e4] + zv.y * w1r[4 * e4 + 1] + zv.z * w1r[4 * e4 + 2] + zv.w * w1r[4 * e4 + 3];
      }
      a += z[pos * 36 + 32] * w1r[32];
      h1[pos * 64 + j] = sinf(fq * a);
    }
  }
  __syncthreads();
  {
    const int j = lane;
    float w2r[64];
#pragma unroll
    for (int e = 0; e < 64; ++e) w2r[e] = p.hy_w2[e * 64 + j];
    const float fq = p.hy_freq[j], b2 = p.hy_b2[j];
#pragma unroll 1
    for (int q = 0; q < 16; ++q) {
      const int pos = wid * 16 + q;
      const float4* hp = (const float4*)(h1 + pos * 64);
      float a = b2;
#pragma unroll
      for (int e4 = 0; e4 < 16; ++e4) {
        float4 hv = hp[e4];
        a += hv.x * w2r[4 * e4] + hv.y * w2r[4 * e4 + 1] + hv.z * w2r[4 * e4 + 2] + hv.w * w2r[4 * e4 + 3];
      }
      h2[pos * 68 + j] = sinf(fq * a);
    }
  }
  __syncthreads();
  const int colw = cc * 512 + wid * 64;
  bf16x8_t Ahi[2][4], Alo[2][4];
#pragma unroll
  for (int ct = 0; ct < 2; ++ct)
#pragma unroll
    for (int ks = 0; ks < 4; ++ks) {
      float v[8];
#pragma unroll
      for (int j = 0; j < 8; ++j) v[j] = p.hy_w3[(size_t)(16 * ks + 8 * h + j) * 8192 + colw + ct * 32 + r];
      split8(v, Ahi[ct][ks], Alo[ct][ks]);
    }
  const int o = cc >> 3, dir = (cc >> 2) & 1;
  u16* Rg = (u16*)(p.ws + OFF_FILT) + (size_t)o * 2048 * 4096;
  const float min_decay = -3.0701134573253945f, max_decay = -15.350567286626972f;
#pragma unroll 1
  for (int pp = 0; pp < 2; ++pp) {
    f32x16_t acc[2][2];
#pragma unroll
    for (int ct = 0; ct < 2; ++ct)
#pragma unroll
      for (int q = 0; q < 2; ++q)
#pragma unroll
        for (int i = 0; i < 16; ++i) acc[ct][q][i] = 0.f;
#pragma unroll
    for (int q = 0; q < 2; ++q)
#pragma unroll
      for (int ks = 0; ks < 4; ++ks) {
        const float* hp = h2 + ((pp * 2 + q) * 32 + r) * 68 + 16 * ks + 8 * h;
        float4 x0 = *(const float4*)hp, x1 = *(const float4*)(hp + 4);
        float v[8] = {x0.x, x0.y, x0.z, x0.w, x1.x, x1.y, x1.z, x1.w};
        bf16x8_t Bhi, Blo;
        split8(v, Bhi, Blo);
#pragma unroll
        for (int ct = 0; ct < 2; ++ct) {
          acc[ct][q] = __builtin_amdgcn_mfma_f32_32x32x16_bf16(Ahi[ct][ks], Bhi, acc[ct][q], 0, 0, 0);
          acc[ct][q] = __builtin_amdgcn_mfma_f32_32x32x16_bf16(Ahi[ct][ks], Blo, acc[ct][q], 0, 0, 0);
          acc[ct][q] = __builtin_amdgcn_mfma_f32_32x32x16_bf16(Alo[ct][ks], Bhi, acc[ct][q], 0, 0, 0);
        }
      }
    int hh = h;
    asm volatile("" : "+v"(hh));
#pragma unroll
    for (int ct = 0; ct < 2; ++ct)
#pragma unroll
      for (int i = 0; i < 16; ++i) {
        const int col = colw + ct * 32 + (i & 3) + 8 * (i >> 2) + 4 * hh;
        const int ch = col & 2047;
        const float b3 = p.hy_b3[col];
        const float ad = fabsf(min_decay + (float)ch * ((max_decay - min_decay) / 2047.f));
        u16* R = Rg + (size_t)ch * 4096;
#pragma unroll
        for (int q = 0; q < 2; ++q) {
          const int t = pg * 128 + (pp * 2 + q) * 32 + r;
          const float tn = (float)t / 2047.f;
          float v = (acc[ct][q][i] + b3) * (__expf(-tn * ad) + 0.05f);
          if (dir == 0) {
            if (t == 0) v += p.hy_bias_d[o * 2048 + ch];
            R[2048 - t] = f2bf(v);
          } else {
            if (t > 0) R[2048 + t] = f2bf(v);
            else R[0] = 0;
          }
        }
      }
  }
  __syncthreads();
}

constexpr int N_CV_AI = 16 * 40, N_CV_AO = 16 * 16, N_CV_HI = 16 * 64, N_CV_HO = 16 * 16;
constexpr int N_CV = N_CV_AI + N_CV_AO + N_CV_HI + N_CV_HO;
#define CV_DECODE(I, W_, Wt_, N_, tk_, tn_, perm_) do { int _i = (I); \
    const bool _a = _i < N_CV_AI, _b2 = _i < N_CV_AI + N_CV_AO, _c = _i < N_CV_AI + N_CV_AO + N_CV_HI; \
    W_ = _a ? p.attn_w_in : (_b2 ? p.attn_w_out : (_c ? p.hy_w_in : p.hy_w_out)); \
    Wt_ = (u16*)(p.ws + (_a ? OFF_WT_AI : (_b2 ? OFF_WT_AO : (_c ? OFF_WT_HI : OFF_WT_HO)))); \
    N_ = _a ? 5120 : (_b2 ? 2048 : (_c ? 8192 : 2048)); \
    const int _nt = _a ? 40 : (_b2 ? 16 : (_c ? 64 : 16)); \
    _i -= _a ? 0 : (_b2 ? N_CV_AI : (_c ? N_CV_AI + N_CV_AO : N_CV_AI + N_CV_AO + N_CV_HI)); \
    tk_ = _i / _nt; tn_ = _i - tk_ * _nt; perm_ = _a && (tn_ * 128 < 2560); } while (0)
__device__ void p0_convert_all(const Params& p, float* sm) {
  const int tid = threadIdx.x;
  float4 r0, r1, r2, r3, r4, r5, r6, r7;
#define CV_LOAD(W_, N_, tk_, tn_) do { const float* _b = (W_) + (size_t)((tk_) * 128 + (tid >> 5)) * (N_) + (tn_) * 128 + (tid & 31) * 4; const size_t _s = (size_t)16 * (N_); \
    r0 = *(const float4*)(_b); r1 = *(const float4*)(_b + _s); r2 = *(const float4*)(_b + 2 * _s); r3 = *(const float4*)(_b + 3 * _s); \
    r4 = *(const float4*)(_b + 4 * _s); r5 = *(const float4*)(_b + 5 * _s); r6 = *(const float4*)(_b + 6 * _s); r7 = *(const float4*)(_b + 7 * _s); } while (0)
#define CV_PUT(R, I) do { float* _d = sm + ((tid >> 5) + 16 * (I)) * 129 + (tid & 31) * 4; _d[0] = (R).x; _d[1] = (R).y; _d[2] = (R).z; _d[3] = (R).w; } while (0)
  int it = blockIdx.x;
  const float* cW; u16* cWt; int cN, ctk, ctn; bool cperm;
  CV_DECODE(it < N_CV ? it : 0, cW, cWt, cN, ctk, ctn, cperm);
  if (it < N_CV) CV_LOAD(cW, cN, ctk, ctn);
  while (it < N_CV) {
    __syncthreads();
    CV_PUT(r0, 0); CV_PUT(r1, 1); CV_PUT(r2, 2); CV_PUT(r3, 3); CV_PUT(r4, 4); CV_PUT(r5, 5); CV_PUT(r6, 6); CV_PUT(r7, 7);
    __syncthreads();
    const int nit = it + gridDim.x;
    const float* nW; u16* nWt; int nN, ntk, ntn; bool nperm;
    CV_DECODE(nit < N_CV ? nit : 0, nW, nWt, nN, ntk, ntn, nperm);
    if (nit < N_CV) CV_LOAD(nW, nN, ntk, ntn);
    const int row = (tid & 15) | (((tid >> 6) & 7) << 4);
    int src = row;
    if (cperm) { const int g = row >> 5, nn = (row >> 4) & 1, fr = row & 15; src = (g >> 1) * 64 + nn * 32 + (g & 1) * 16 + fr; }
#pragma unroll
    for (int i = 0; i < 4; ++i) {
      const int kch = ((tid >> 4) & 3) | (i << 2);
      unsigned w[4];
#pragma unroll
      for (int j = 0; j < 4; ++j) {
        float a = sm[(kch * 8 + 2 * j) * 129 + src];
        float b = sm[(kch * 8 + 2 * j + 1) * 129 + src];
        w[j] = (unsigned)f2bf(a) | ((unsigned)f2bf(b) << 16);
      }
      *(uint4*)(cWt + (size_t)(ctn * 128 + row) * 2048 + ctk * 128 + kch * 8) = make_uint4(w[0], w[1], w[2], w[3]);
    }
    cW = nW; cWt = nWt; cN = nN; ctk = ntk; ctn = ntn; cperm = nperm;
    it = nit;
  }
#undef CV_LOAD
#undef CV_PUT
}

__device__ void phase0(const Params& p, float* sm) {
  for (int it = blockIdx.x; it < 256; it += gridDim.x) p0_adaln(p, it, sm);
  if (blockIdx.x == gridDim.x - 1) p0_rope(p);
  __syncthreads();
  for (int it = blockIdx.x; it < 256; it += gridDim.x) p0_filter(p, it, sm);
  __syncthreads();
  p0_convert_all(p, sm);
}

__device__ void norm_row(const float* __restrict__ src, const float* __restrict__ g, const float* shift,
                         const float* scale, u16* dst_bf, float* dst_f, int lane) {
  float4 v[8];
  float ss = 0.f;
#pragma unroll
  for (int j = 0; j < 8; ++j) {
    v[j] = *(const float4*)(src + (j * 64 + lane) * 4);
    ss += v[j].x * v[j].x + v[j].y * v[j].y + v[j].z * v[j].z + v[j].w * v[j].w;
  }
  ss = wave_sum(ss);
  float r = rsqrtf(ss * (1.f / 2048.f) + 1e-6f);
#pragma unroll
  for (int j = 0; j < 8; ++j) {
    int c = (j * 64 + lane) * 4;
    float4 gg = *(const float4*)(g + c);
    float4 o = make_float4(v[j].x * r * gg.x, v[j].y * r * gg.y, v[j].z * r * gg.z, v[j].w * r * gg.w);
    if (dst_bf) {
      float4 sh = *(const float4*)(shift + c);
      float4 sc = *(const float4*)(scale + c);
      o.x = o.x * (1.f + sc.x) + sh.x; o.y = o.y * (1.f + sc.y) + sh.y;
      o.z = o.z * (1.f + sc.z) + sh.z; o.w = o.w * (1.f + sc.w) + sh.w;
      uint2 pk;
      pk.x = (unsigned)f2bf(o.x) | ((unsigned)f2bf(o.y) << 16);
      pk.y = (unsigned)f2bf(o.z) | ((unsigned)f2bf(o.w) << 16);
      *(uint2*)(dst_bf + c) = pk;
    } else {
      *(float4*)(dst_f + c) = o;
    }
  }
}

__device__ void phase_norm(const Params& p, int mode) {
  const int wid = threadIdx.x >> 6, lane = threadIdx.x & 63;
  const float* mod = (const float*)(p.ws + OFF_MOD);
  int nrows = (mode == 0) ? (MT + MC) : MT;
  for (int row = blockIdx.x * 8 + wid; row < nrows; row += gridDim.x * 8) {
    if (mode == 0) {
      if (row < MT) {
        int b = row >> 11;
        const float* m = mod + (0 * 5 + b) * 6144;
        norm_row(p.x + (size_t)row * 2048, p.norm_g, m, m + 2048, (u16*)(p.ws + OFF_ACT) + (size_t)row * 2048, nullptr, lane);
      } else {
        int rc = row - MT;
        const float* m = mod + (0 * 5 + 4) * 6144;
        norm_row(p.ctx + (size_t)rc * 2048, p.norm_g, m, m + 2048, (u16*)(p.ws + OFF_HC) + (size_t)rc * 2048, nullptr, lane);
      }
    } else if (mode == 1) {
      int b = row >> 11;
      const float* m = mod + (1 * 5 + b) * 6144;
      norm_row(p.out + (size_t)row * 2048, p.norm_g + 2048, m, m + 2048, (u16*)(p.ws + OFF_ACT) + (size_t)row * 2048, nullptr, lane);
    } else {
      norm_row(p.out + (size_t)row * 2048, p.final_g, nullptr, nullptr, nullptr, p.out + (size_t)row * 2048, lane);
    }
  }
}

namespace pg8 {
#define PG8_LAS __attribute__((address_space(3)))
typedef unsigned short bf16_t;
typedef short bf16x8 __attribute__((ext_vector_type(8)));
typedef float f32x4 __attribute__((ext_vector_type(4)));
typedef unsigned u32x4 __attribute__((ext_vector_type(4)));
constexpr int BM = 256, BK = 64, HALF = 128, HTB = HALF * BK * 2  , STAGE_BYTES = 8 * HTB, NXCD = 8, WGM = 8;

__host__ __device__ __forceinline__ int lds_byte(int r, int c) { const int st = (r >> 4) * 2 + (c >> 5), rr = r & 15, cc = c & 31, ob = rr * 64 + cc * 2; return st * 1024 + (ob ^ (((ob >> 9) & 1) << 5)); }
__host__ __device__ __forceinline__ void stage_rc(int b, int& R, int& C) { const int st = b / 1024, sb = b % 1024, swz = sb ^ (((sb >> 9) & 1) << 5); R = (st >> 1) * 16 + swz / 64; C = (st & 1) * 32 + (swz % 64) / 2; }
__host__ __device__ __forceinline__ int perm32(int rho) { const int n = rho >> 4, i = rho & 15; return 8 * (i >> 2) + 4 * n + (i & 3); }

struct Unit { int pm, pn; };
struct Gemm { const bf16_t* A; const bf16_t* Bt; int M, N, K; };

struct StaticOrder {
    int nM, nN, nwg, G, c;
    __host__ __device__ void init(int M, int N, int G_, int c_) { nM = M / BM; nN = N / BM; nwg = nM * nN; G = G_; c = c_; }
    __host__ __device__ bool next(int i, Unit& u) const {
        const long L = (long)i * G + c; if (L >= nwg) return false;
        int wgid = (int)L; { const int q = nwg / NXCD, r = nwg % NXCD, xcd = wgid % NXCD, off = wgid / NXCD; wgid = (xcd < r ? xcd * (q + 1) : r * (q + 1) + (xcd - r) * q) + off; }
        const int nig = WGM * nN, gid = wgid / nig, fm = gid * WGM, gsz = (nM - fm) < WGM ? (nM - fm) : WGM;
        u.pm = fm + ((wgid % nig) % gsz); u.pn = (wgid % nig) / gsz; return true;
    }
    __device__ __forceinline__ void a_ready(const Unit&) const {}
    __device__ __forceinline__ void done(const Unit&) const {}
};
__device__ __forceinline__ unsigned cvt_pk_bf16(float lo, float hi) { unsigned r; asm volatile("v_cvt_pk_bf16_f32 %0, %1, %2" : "=v"(r) : "v"(lo), "v"(hi)); return r; }
template <class Epi, class Sched>
__device__ __forceinline__ void gemm_phase(PG8_LAS unsigned char* lds, const Gemm g, const Sched& S, const Epi& E) {
    const int tid = threadIdx.x, wid = __builtin_amdgcn_readfirstlane(tid >> 6), lane = tid & 63, wr = wid >> 2, wc = wid & 3, fr = lane & 15, fq = lane >> 4;
    const int K = g.K, nt = K / BK;
    unsigned voffA[2], voffB[2];
#pragma unroll
    for (int i = 0; i < 2; ++i) { int R, C; stage_rc(tid * 16 + i * 8192, R, C); const int Rb = Epi::PERM ? ((R & ~31) + perm32(R & 31)) : R;
        voffA[i] = (unsigned)(R * K + C) * 2u; voffB[i] = (unsigned)(Rb * K + C) * 2u; }
    const size_t kstep = (size_t)(BK * 2);
    const size_t hstep = (size_t)HALF * K * 2;
    const size_t tstep = 2 * hstep;
    const unsigned ldsw = (unsigned)wid * 1024u;
    const int aoff = lds_byte(wr * 64 + fr, fq * 8), boff = lds_byte(wc * 32 + fr, fq * 8);
#define PG8_SA(b, h) (((b) * 2 + (h)) * HTB)
#define PG8_SB(b, h) ((4 + (b) * 2 + (h)) * HTB)
#define PG8_STAGE(bufoff, gbase, voff) do { _Pragma("unroll") for (int _i = 0; _i < 2; ++_i) \
        __builtin_amdgcn_global_load_lds((const unsigned*)((const char*)(gbase) + (voff)[_i]), (PG8_LAS unsigned*)(lds + (bufoff) + ldsw + _i * 8192), 16, 0, 0); } while (0)
#define PG8_LDA(dst, b, h) do { _Pragma("unroll") for (int m = 0; m < 4; ++m) _Pragma("unroll") for (int k = 0; k < 2; ++k) dst[m][k] = *(const PG8_LAS bf16x8*)(lds + PG8_SA(b, h) + aoff + m * 2048 + k * 1024); } while (0)
#define PG8_LDB(dst, b, h) do { _Pragma("unroll") for (int n = 0; n < 2; ++n) _Pragma("unroll") for (int k = 0; k < 2; ++k) dst[n][k] = *(const PG8_LAS bf16x8*)(lds + PG8_SB(b, h) + boff + n * 2048 + k * 1024); } while (0)
#define PG8_MMA(ai, bj, At, Bt) do { __builtin_amdgcn_s_setprio(1); _Pragma("unroll") for (int m = 0; m < 4; ++m) _Pragma("unroll") for (int n = 0; n < 2; ++n) _Pragma("unroll") for (int k = 0; k < 2; ++k) \
        acc[ai][bj][m][n] = __builtin_amdgcn_mfma_f32_16x16x32_bf16(Bt[n][k], At[m][k], acc[ai][bj][m][n], 0, 0, 0); __builtin_amdgcn_s_setprio(0); } while (0)
#define PG8_WAIT_V(n) asm volatile("s_waitcnt vmcnt(" #n ")" ::: "memory")
#define PG8_WAIT_L(n) asm volatile("s_waitcnt lgkmcnt(" #n ")" ::: "memory")
#define PG8_BAR __builtin_amdgcn_s_barrier()
#define PG8_SCHED __builtin_amdgcn_sched_barrier(0)
    Unit cur, nxt; int ui = 0;
    if (!S.next(0, cur)) return;
    f32x4 acc[2][2][4][2];
#pragma unroll
    for (int a = 0; a < 2; ++a)
#pragma unroll
        for (int b = 0; b < 2; ++b)
#pragma unroll
            for (int m = 0; m < 4; ++m)
#pragma unroll
                for (int n = 0; n < 2; ++n) acc[a][b][m][n] = (f32x4){0.f, 0.f, 0.f, 0.f};
    bf16x8 At[4][2], B0[2][2], B1[2][2];
    const char* cA = (const char*)g.A + (size_t)cur.pm * tstep; const char* cB = (const char*)g.Bt + (size_t)cur.pn * tstep;
    S.a_ready(cur);
    PG8_STAGE(PG8_SB(0, 0), cB, voffB); PG8_STAGE(PG8_SA(0, 0), cA, voffA); PG8_STAGE(PG8_SB(0, 1), cB + hstep, voffB); PG8_STAGE(PG8_SA(0, 1), cA + hstep, voffA);
    if (wr == 1) PG8_BAR;
    PG8_WAIT_V(4); PG8_BAR;
    PG8_STAGE(PG8_SB(1, 0), cB + kstep, voffB); PG8_STAGE(PG8_SA(1, 0), cA + kstep, voffA); PG8_STAGE(PG8_SB(1, 1), cB + hstep + kstep, voffB);
    PG8_WAIT_V(6); PG8_BAR;
    for (;;) {
        const bool has_next = S.next(ui + 1, nxt);
        const char* nA = has_next ? (const char*)g.A + (size_t)nxt.pm * tstep : cA; const char* nB = has_next ? (const char*)g.Bt + (size_t)nxt.pn * tstep : cB;
        for (int t = 0; t < nt; t += 2) {
            const bool last = (t == nt - 2);
            const char* a1 = cA + (size_t)(t + 1) * kstep;
            const char* a2 = last ? nA : cA + (size_t)(t + 2) * kstep; const char* b2 = last ? nB : cB + (size_t)(t + 2) * kstep;
            const char* a3 = a2 + kstep; const char* b3 = b2 + kstep;
            if (last && has_next) S.a_ready(nxt);
            PG8_LDB(B0, 0, 0); PG8_SCHED; PG8_LDA(At, 0, 0); PG8_STAGE(PG8_SA(1, 1), a1 + hstep, voffA);
            PG8_WAIT_L(8); PG8_BAR; PG8_WAIT_L(0); PG8_MMA(0, 0, At, B0); PG8_BAR; PG8_SCHED;
            PG8_LDB(B1, 0, 1); PG8_STAGE(PG8_SB(0, 0), b2, voffB);
            PG8_BAR; PG8_WAIT_L(0); PG8_MMA(0, 1, At, B1); PG8_BAR;
            PG8_LDA(At, 0, 1); PG8_STAGE(PG8_SA(0, 0), a2, voffA);
            PG8_BAR; PG8_WAIT_L(0); PG8_MMA(1, 0, At, B0); PG8_BAR; PG8_SCHED;
            PG8_STAGE(PG8_SB(0, 1), b2 + hstep, voffB);
            PG8_WAIT_V(6); PG8_BAR; PG8_MMA(1, 1, At, B1); PG8_BAR;
            PG8_LDB(B0, 1, 0); PG8_SCHED; PG8_LDA(At, 1, 0); PG8_STAGE(PG8_SA(0, 1), a2 + hstep, voffA);
            PG8_WAIT_L(8); PG8_BAR; PG8_WAIT_L(0); PG8_MMA(0, 0, At, B0); PG8_BAR; PG8_SCHED;
            PG8_LDB(B1, 1, 1); PG8_STAGE(PG8_SB(1, 0), b3, voffB);
            PG8_BAR; PG8_WAIT_L(0); PG8_MMA(0, 1, At, B1); PG8_BAR;
            PG8_LDA(At, 1, 1); PG8_STAGE(PG8_SA(1, 0), a3, voffA);
            PG8_BAR; PG8_WAIT_L(0); PG8_MMA(1, 0, At, B0); PG8_BAR; PG8_SCHED;
            PG8_STAGE(PG8_SB(1, 1), b3 + hstep, voffB);
            PG8_WAIT_V(6); PG8_BAR; PG8_MMA(1, 1, At, B1); PG8_BAR;
        }
        if constexpr (!Epi::AFTER_DRAIN) { E(acc, cur, wr, wc, fr, fq); S.done(cur); }
        if (!has_next) break;
#pragma unroll
        for (int a = 0; a < 2; ++a)
#pragma unroll
            for (int b = 0; b < 2; ++b)
#pragma unroll
                for (int m = 0; m < 4; ++m)
#pragma unroll
                    for (int n = 0; n < 2; ++n) acc[a][b][m][n] = (f32x4){0.f, 0.f, 0.f, 0.f};
        cur = nxt; cA = nA; cB = nB; ++ui;
    }
    PG8_WAIT_V(0);
    if (wr == 0) PG8_BAR;
    PG8_BAR;
    if constexpr (Epi::AFTER_DRAIN) { E.fused(acc, cur, wr, wc, fr, fq, lds, wid, lane); S.done(cur); }
#undef PG8_SA
#undef PG8_SB
#undef PG8_STAGE
#undef PG8_LDA
#undef PG8_LDB
#undef PG8_MMA
#undef PG8_WAIT_V
#undef PG8_WAIT_L
#undef PG8_BAR
#undef PG8_SCHED
}
}

__device__ __forceinline__ uint2 pack4(pg8::f32x4 v) {
  uint2 r;
  r.x = (unsigned)f2bf(v[0]) | ((unsigned)f2bf(v[1]) << 16);
  r.y = (unsigned)f2bf(v[2]) | ((unsigned)f2bf(v[3]) << 16);
  return r;
}
struct EpiAttnIn {
  static constexpr bool PERM = false, AFTER_DRAIN = false;
  u16* O; const float* rope;
  __device__ __forceinline__ void operator()(const pg8::f32x4 (&acc)[2][2][4][2], const pg8::Unit& u, int wr, int wc, int fr, int fq) const {
    const int row0 = u.pm * 256 + wr * 64 + fr, col0 = u.pn * 256 + wc * 32 + 4 * fq;
    const bool dorope = (u.pn < 10);
    const int axis = wc >> 1, i0 = (wc & 1) * 16 + 4 * fq;
#pragma unroll
    for (int ai = 0; ai < 2; ++ai)
#pragma unroll
      for (int m = 0; m < 4; ++m) {
        const int row = row0 + ai * 128 + m * 16;
        u16* rowp = O + (size_t)row * 5120 + col0;
        if (dorope) {
          const int s = row & 2047;
          const int pos = axis ? (s & 63) : (s >> 6);
          const float4* rp = (const float4*)(rope + (pos * 32 + i0) * 2);
          float4 c01 = rp[0], c23 = rp[1];
#pragma unroll
          for (int bj = 0; bj < 2; ++bj) {
            pg8::f32x4 a = acc[ai][bj][m][0], b = acc[ai][bj][m][1], o0, o1;
            o0[0] = a[0] * c01.x - b[0] * c01.y; o1[0] = b[0] * c01.x + a[0] * c01.y;
            o0[1] = a[1] * c01.z - b[1] * c01.w; o1[1] = b[1] * c01.z + a[1] * c01.w;
            o0[2] = a[2] * c23.x - b[2] * c23.y; o1[2] = b[2] * c23.x + a[2] * c23.y;
            o0[3] = a[3] * c23.z - b[3] * c23.w; o1[3] = b[3] * c23.z + a[3] * c23.w;
            *(uint2*)(rowp + bj * 128) = pack4(o0);
            *(uint2*)(rowp + bj * 128 + 16) = pack4(o1);
          }
        } else {
#pragma unroll
          for (int bj = 0; bj < 2; ++bj) {
            *(uint2*)(rowp + bj * 128) = pack4(acc[ai][bj][m][0]);
            *(uint2*)(rowp + bj * 128 + 16) = pack4(acc[ai][bj][m][1]);
          }
        }
      }
  }
};
struct EpiRaw {
  static constexpr bool PERM = false, AFTER_DRAIN = false;
  u16* O; int ldc;
  __device__ __forceinline__ void operator()(const pg8::f32x4 (&acc)[2][2][4][2], const pg8::Unit& u, int wr, int wc, int fr, int fq) const {
    const int row0 = u.pm * 256 + wr * 64 + fr, col0 = u.pn * 256 + wc * 32 + 4 * fq;
#pragma unroll
    for (int ai = 0; ai < 2; ++ai)
#pragma unroll
      for (int m = 0; m < 4; ++m) {
        u16* rowp = O + (size_t)(row0 + ai * 128 + m * 16) * ldc + col0;
#pragma unroll
        for (int bj = 0; bj < 2; ++bj) {
          *(uint2*)(rowp + bj * 128) = pack4(acc[ai][bj][m][0]);
          *(uint2*)(rowp + bj * 128 + 16) = pack4(acc[ai][bj][m][1]);
        }
      }
  }
};
struct EpiRes {
  static constexpr bool PERM = false, AFTER_DRAIN = false;
  float* out; const float* base; const float* gate;
  __device__ __forceinline__ void operator()(const pg8::f32x4 (&acc)[2][2][4][2], const pg8::Unit& u, int wr, int wc, int fr, int fq) const {
    const int row0 = u.pm * 256 + wr * 64 + fr, col0 = u.pn * 256 + wc * 32 + 4 * fq;
    const int b = (u.pm * 256) >> 11;
    pg8::f32x4 gv[2][2];
#pragma unroll
    for (int bj = 0; bj < 2; ++bj)
#pragma unroll
      for (int n = 0; n < 2; ++n) gv[bj][n] = *(const pg8::f32x4*)(gate + b * 6144 + col0 + bj * 128 + n * 16);
#pragma unroll
    for (int ai = 0; ai < 2; ++ai)
#pragma unroll
      for (int m = 0; m < 4; ++m) {
        const size_t off = (size_t)(row0 + ai * 128 + m * 16) * 2048 + col0;
#pragma unroll
        for (int bj = 0; bj < 2; ++bj)
#pragma unroll
          for (int n = 0; n < 2; ++n) {
            pg8::f32x4 bv = *(const pg8::f32x4*)(base + off + bj * 128 + n * 16);
            *(pg8::f32x4*)(out + off + bj * 128 + n * 16) = bv + gv[bj][n] * acc[ai][bj][m][n];
          }
      }
  }
};
template <class Epi>
__device__ __forceinline__ void run_gemm(float* sm, const u16* A, const u16* Bt, int M, int N, const Epi& E, int c) {
  pg8::Gemm g{A, Bt, M, N, 2048};
  pg8::StaticOrder S; S.init(M, N, (int)gridDim.x, c);
  pg8::gemm_phase<Epi, pg8::StaticOrder>((PG8_LAS unsigned char*)sm, g, S, E);
  __syncthreads();
}

template <int MODE>
__device__ __forceinline__ void epi_pair(const Params& p, int m, int n, float a0, float a1) {
  if (MODE == 1) {
    u16* px = (u16*)(p.ws + OFF_BIG);
    float o0 = a0, o1 = a1;
    if (n < 2560) {
      int g = (n >> 5) & 3, fr = n & 15;
      int axis = g >> 1, i = (g & 1) * 16 + fr;
      int s = m & 2047;
      int pos = axis ? (s & 63) : (s >> 6);
      float2 cs = ((const float2*)(p.ws + OFF_ROPE))[pos * 32 + i];
      o0 = a0 * cs.x - a1 * cs.y;
      o1 = a1 * cs.x + a0 * cs.y;
    }
    px[(size_t)m * 5120 + n] = f2bf(o0);
    px[(size_t)m * 5120 + n + 16] = f2bf(o1);
  } else if (MODE == 5) {
    u16* kvc = (u16*)(p.ws + OFF_KVC);
    kvc[(size_t)m * 1024 + n] = f2bf(a0);
    kvc[(size_t)m * 1024 + n + 16] = f2bf(a1);
  } else if (MODE == 2) {
    const float* mod = (const float*)(p.ws + OFF_MOD);
    int b = m >> 11;
    const float* gate = mod + (0 * 5 + b) * 6144 + 4096;
    p.out[(size_t)m * 2048 + n] = p.x[(size_t)m * 2048 + n] + gate[n] * a0;
    p.out[(size_t)m * 2048 + n + 16] = p.x[(size_t)m * 2048 + n + 16] + gate[n + 16] * a1;
  } else if (MODE == 3) {
    u16* pp = (u16*)(p.ws + OFF_BIG);
    pp[(size_t)m * 8192 + n] = f2bf(a0);
    pp[(size_t)m * 8192 + n + 16] = f2bf(a1);
  } else if (MODE == 4) {
    const float* mod = (const float*)(p.ws + OFF_MOD);
    int b = m >> 11;
    const float* gate = mod + (1 * 5 + b) * 6144 + 4096;
    p.out[(size_t)m * 2048 + n] += gate[n] * a0;
    p.out[(size_t)m * 2048 + n + 16] += gate[n + 16] * a1;
  }
}

template <int MODE>
__device__ void naive_gemm(const Params& p, const u16* __restrict__ A, const u16* __restrict__ Wt, int M, int N) {
  const int tid = threadIdx.x;
  const int ml = tid >> 5, pl = tid & 31;
  const int ntn = N / 64, ntm = M / 16;
  for (int tile = blockIdx.x; tile < ntn * ntm; tile += gridDim.x) {
    int tm = tile / ntn, tn = tile % ntn;
    int m = tm * 16 + ml;
    int n = tn * 64 + (pl >> 4) * 32 + (pl & 15);
    const uint4* a = (const uint4*)(A + (size_t)m * 2048);
    const uint4* w0 = (const uint4*)(Wt + (size_t)n * 2048);
    const uint4* w1 = (const uint4*)(Wt + (size_t)(n + 16) * 2048);
    float acc0 = 0.f, acc1 = 0.f;
#pragma unroll 2
    for (int k = 0; k < 256; ++k) {
      uint4 av = a[k], b0 = w0[k], b1 = w1[k];
      acc0 += bflo(av.x) * bflo(b0.x) + bfhi(av.x) * bfhi(b0.x) + bflo(av.y) * bflo(b0.y) + bfhi(av.y) * bfhi(b0.y)
            + bflo(av.z) * bflo(b0.z) + bfhi(av.z) * bfhi(b0.z) + bflo(av.w) * bflo(b0.w) + bfhi(av.w) * bfhi(b0.w);
      acc1 += bflo(av.x) * bflo(b1.x) + bfhi(av.x) * bfhi(b1.x) + bflo(av.y) * bflo(b1.y) + bfhi(av.y) * bfhi(b1.y)
            + bflo(av.z) * bflo(b1.z) + bfhi(av.z) * bfhi(b1.z) + bflo(av.w) * bflo(b1.w) + bfhi(av.w) * bfhi(b1.w);
    }
    epi_pair<MODE>(p, m, n, acc0, acc1);
  }
}

__device__ void phase_attn_naive(const Params& p, float* sm) {
  const int wid = threadIdx.x >> 6, lane = threadIdx.x & 63;
  float* qs = sm + wid * (128 + 640);
  float* pr = qs + 128;
  const u16* px = (const u16*)(p.ws + OFF_BIG);
  const u16* kvc = (const u16*)(p.ws + OFF_KVC);
  u16* og = (u16*)(p.ws + OFF_ACT);
  const float scale = 0.08838834764831845f;
  for (int item = blockIdx.x * 8 + wid; item < MT * 16; item += gridDim.x * 8) {
    int m = item >> 4, h = item & 15;
    int b = m >> 11, s = m & 2047, kvh = h >> 2, nblk = s >> 7;
    const u16* qrow = px + (size_t)m * 5120 + h * 128;
    qs[lane] = bf2f(qrow[lane]) * scale;
    qs[lane + 64] = bf2f(qrow[lane + 64]) * scale;
    asm volatile("s_waitcnt lgkmcnt(0)" ::: "memory");
    float mx = p.attn_sink[h];
#pragma unroll 1
    for (int j = 0; j < 10; ++j) {
      int kidx = j * 64 + lane;
      const u16* krow;
      bool valid;
      if (kidx < 384) {
        int kpos = (nblk - 1) * 128 + kidx;
        int rel = kpos - s;
        valid = (kpos >= 0) && (kpos < 2048) && (rel <= 128) && (rel >= -128);
        krow = px + (size_t)(b * 2048 + (valid ? kpos : 0)) * 5120 + 2048 + kvh * 128;
      } else {
        valid = true;
        krow = kvc + (size_t)(b * 256 + (kidx - 384)) * 1024 + kvh * 128;
      }
      float d = -1e30f;
      if (valid) {
        d = 0.f;
#pragma unroll 4
        for (int c = 0; c < 16; ++c) {
          uint4 kk = *(const uint4*)(krow + c * 8);
          const float* q8 = qs + c * 8;
          d += q8[0] * bflo(kk.x) + q8[1] * bfhi(kk.x) + q8[2] * bflo(kk.y) + q8[3] * bfhi(kk.y)
             + q8[4] * bflo(kk.z) + q8[5] * bfhi(kk.z) + q8[6] * bflo(kk.w) + q8[7] * bfhi(kk.w);
        }
      }
      pr[kidx] = d;
      mx = fmaxf(mx, d);
    }
    mx = wave_max(mx);
    float sum = 0.f;
#pragma unroll 1
    for (int j = 0; j < 10; ++j) {
      float d = pr[j * 64 + lane];
      float e = (d > -1e29f) ? __expf(d - mx) : 0.f;
      pr[j * 64 + lane] = e;
      sum += e;
    }
    sum = wave_sum(sum);
    sum += __expf(p.attn_sink[h] - mx);
    asm volatile("s_waitcnt lgkmcnt(0)" ::: "memory");
    float o0 = 0.f, o1 = 0.f;
    int k0 = s - 128 < 0 ? 0 : s - 128, k1 = s + 128 > 2047 ? 2047 : s + 128;
    for (int kpos = k0; kpos <= k1; ++kpos) {
      float pv = pr[kpos - (nblk - 1) * 128];
      unsigned vv = *(const unsigned*)(px + (size_t)(b * 2048 + kpos) * 5120 + 2560 + kvh * 128 + lane * 2);
      o0 += pv * bflo(vv); o1 += pv * bfhi(vv);
    }
    for (int c = 0; c < 256; ++c) {
      float pv = pr[384 + c];
      unsigned vv = *(const unsigned*)(kvc + (size_t)(b * 256 + c) * 1024 + 512 + kvh * 128 + lane * 2);
      o0 += pv * bflo(vv); o1 += pv * bfhi(vv);
    }
    float inv = 1.f / sum;
    unsigned gg = *(const unsigned*)(px + (size_t)m * 5120 + 3072 + h * 128 + lane * 2);
    float r0 = o0 * inv * siluf(bflo(gg)), r1 = o1 * inv * siluf(bfhi(gg));
    *(unsigned*)(og + (size_t)m * 2048 + h * 128 + lane * 2) = (unsigned)f2bf(r0) | ((unsigned)f2bf(r1) << 16);
    asm volatile("s_waitcnt lgkmcnt(0)" ::: "memory");
  }
}

__device__ __forceinline__ float sconv(const u16* pp, const float* cw, const float* cb, int b, int t, int c) {
  const u16* base = pp + (size_t)(b * 2048 + t) * 8192 + c;
  float v = cw[6144 + c] * bf2f(base[0]) + cb[c];
  if (t > 0) v += cw[c] * bf2f(base[-8192]);
  if (t < 2047) v += cw[2 * 6144 + c] * bf2f(base[8192]);
  return v;
}

__device__ void phase_conv_naive(const Params& p, float* sm) {
  const int tid = threadIdx.x;
  float* u = sm;
  float* R = sm + 8192;
  const u16* pp = (const u16*)(p.ws + OFF_BIG);
  const u16* Rg = (const u16*)(p.ws + OFF_FILT);
  u16* yg = (u16*)(p.ws + OFF_ACT);
  for (int ch = blockIdx.x; ch < 2048; ch += gridDim.x) {
    for (int i = tid; i < 8192; i += NTHREADS) u[i] = sconv(pp, p.hy_conv_w, p.hy_conv_b, i >> 11, i & 2047, 4096 + ch);
    for (int i = tid; i < 4096; i += NTHREADS) R[i] = bf2f(Rg[((size_t)0 * 2048 + ch) * 4096 + i]);
    __syncthreads();
    float zr[16];
#pragma unroll
    for (int q = 0; q < 16; ++q) {
      int i = tid + q * NTHREADS;
      int b = i >> 11, t = i & 2047;
      const float* ub = u + b * 2048;
      const float* Rb = R + 2048 - t;
      float a = 0.f;
      for (int s = 0; s < 2048; ++s) a += Rb[s] * ub[s];
      zr[q] = a * sconv(pp, p.hy_conv_w, p.hy_conv_b, b, t, ch);
    }
    __syncthreads();
#pragma unroll
    for (int q = 0; q < 16; ++q) u[tid + q * NTHREADS] = zr[q];
    for (int i = tid; i < 4096; i += NTHREADS) R[i] = bf2f(Rg[((size_t)1 * 2048 + ch) * 4096 + i]);
    __syncthreads();
#pragma unroll
    for (int q = 0; q < 16; ++q) {
      int i = tid + q * NTHREADS;
      int b = i >> 11, t = i & 2047;
      const float* ub = u + b * 2048;
      const float* Rb = R + 2048 - t;
      float a = 0.f;
      for (int s = 0; s < 2048; ++s) a += Rb[s] * ub[s];
      float y = a * sconv(pp, p.hy_conv_w, p.hy_conv_b, b, t, 2048 + ch);
      float g = bf2f(pp[(size_t)(b * 2048 + t) * 8192 + 6144 + ch]);
      yg[(size_t)(b * 2048 + t) * 2048 + ch] = f2bf(y * siluf(g));
    }
    __syncthreads();
  }
}


typedef float f32x16 __attribute__((ext_vector_type(16)));
typedef pg8::bf16x8 bfx8;
constexpr int CONV_RF_BYTES = 4 * 8192;
constexpr int CONV_UB_ONE = 192 * 64;
__device__ __forceinline__ int ub_addr(int col, int chunk) { return col * 64 + ((chunk ^ ((col >> 2) & 3)) << 4); }

__device__ __forceinline__ void conv_mfma(const char* Rf_ci, const char* Ub_w, int lane, f32x16 (&acc)[4]) {
  const int t2 = lane & 31, h = lane >> 5, n = lane & 31;
  const unsigned sh = (unsigned)(t2 & 1) * 16u;
  const int lanedw = (2048 - t2 + 8 * h) >> 1;
#pragma unroll
  for (int j = 0; j < 4; ++j)
#pragma unroll
    for (int r = 0; r < 16; ++r) acc[j][r] = 0.f;
#pragma unroll 1
  for (int f = 0; f < 16; ++f) {
    bfx8 Bw[5][2];
#pragma unroll
    for (int m = 0; m < 5; ++m) {
      const int col = (16 * m - f + 16) * 2 + n;
#pragma unroll
      for (int kh = 0; kh < 2; ++kh) Bw[m][kh] = *(const bfx8*)(Ub_w + ub_addr(col, 2 * kh + h));
    }
    const unsigned* Rp = (const unsigned*)Rf_ci + lanedw - 16 * f;
#pragma unroll
    for (int e = -4; e <= 3; ++e) {
      int ee = e;
      if (e == -4) ee = (f == 0) ? -3 : -4;
      bfx8 A[2];
#pragma unroll
      for (int kh = 0; kh < 2; ++kh) {
        const unsigned* q = Rp - 256 * ee + 8 * kh;
        unsigned w0 = q[0], w1 = q[1], w2 = q[2], w3 = q[3], w4 = q[4];
        pg8::u32x4 pk;
        pk[0] = __builtin_amdgcn_alignbit(w1, w0, sh);
        pk[1] = __builtin_amdgcn_alignbit(w2, w1, sh);
        pk[2] = __builtin_amdgcn_alignbit(w3, w2, sh);
        pk[3] = __builtin_amdgcn_alignbit(w4, w3, sh);
        A[kh] = __builtin_bit_cast(bfx8, pk);
      }
#pragma unroll
      for (int j = 0; j < 4; ++j) {
        const int m = j - e;
        if (m >= 0 && m <= 4) acc[j] = __builtin_amdgcn_mfma_f32_32x32x16_bf16(A[0], Bw[m][0], acc[j], 0, 0, 0);
      }
#pragma unroll
      for (int j = 0; j < 4; ++j) {
        const int m = j - e;
        if (m >= 0 && m <= 4) acc[j] = __builtin_amdgcn_mfma_f32_32x32x16_bf16(A[1], Bw[m][1], acc[j], 0, 0, 0);
      }
    }
  }
}

__device__ __forceinline__ void sconv4(const u16* xp, int t, float w0, float w1, float w2, float cb, float (&o)[4]) {
  uint2 x4 = *(const uint2*)xp;
  float pv = t > 0 ? bf2f(xp[-1]) : 0.f;
  float nx = (t + 4 < 2048) ? bf2f(xp[4]) : 0.f;
  float e0 = bflo(x4.x), e1 = bfhi(x4.x), e2 = bflo(x4.y), e3 = bfhi(x4.y);
  o[0] = w0 * pv + w1 * e0 + w2 * e1 + cb;
  o[1] = w0 * e0 + w1 * e1 + w2 * e2 + cb;
  o[2] = w0 * e1 + w1 * e2 + w2 * e3 + cb;
  o[3] = w0 * e2 + w1 * e3 + w2 * nx + cb;
}

struct SC4 { uint2 x; unsigned pn; };
__device__ __forceinline__ SC4 sc4_load(const u16* xp, int t) {
  SC4 r;
  r.x = *(const uint2*)xp;
  const unsigned pv = t > 0 ? (unsigned)xp[-1] : 0u;
  const unsigned nx = (t + 4 < 2048) ? (unsigned)xp[4] : 0u;
  r.pn = pv | (nx << 16);
  return r;
}
__device__ __forceinline__ void sc4_apply(const SC4& r, float w0, float w1, float w2, float cb, float (&o)[4]) {
  const float pv = bflo(r.pn), nx = bfhi(r.pn);
  const float e0 = bflo(r.x.x), e1 = bfhi(r.x.x), e2 = bflo(r.x.y), e3 = bfhi(r.x.y);
  o[0] = w0 * pv + w1 * e0 + w2 * e1 + cb;
  o[1] = w0 * e0 + w1 * e1 + w2 * e2 + cb;
  o[2] = w0 * e1 + w1 * e2 + w2 * e3 + cb;
  o[3] = w0 * e2 + w1 * e3 + w2 * nx + cb;
}

__device__ void phase_conv(const Params& p, float* smf) {
  char* sm = (char*)smf;
  char* Rf = sm;
  char* Ub = sm + CONV_RF_BYTES;
  int tid = threadIdx.x;
  asm volatile("" : "+v"(tid));
  const int wid = tid >> 6, lane = tid & 63;
  const int ci = wid >> 1, bp = wid & 1;
  const u16* pT = (const u16*)(p.ws + OFF_BIG);
  const u16* Rg = (const u16*)(p.ws + OFF_FILT);
  u16* yg = (u16*)(p.ws + OFF_ACT);
  for (int kk = 0; kk < 8 * CONV_UB_ONE / 16 / NTHREADS; ++kk) ((uint4*)Ub)[tid + kk * NTHREADS] = make_uint4(0, 0, 0, 0);
  __syncthreads();
  char* Ub_w = Ub + (ci * 2 + bp) * CONV_UB_ONE;
  const char* Rf_ci = Rf + ci * 8192;
  const int h = lane >> 5, n = lane & 31;
  const bool xmap = (gridDim.x == 256);
  for (int it0 = blockIdx.x; it0 < 512; it0 += gridDim.x) {
    int item = it0;
    if (xmap) {
      const int bx = blockIdx.x & 7, by = blockIdx.x >> 3, rr = it0 >> 8;
      item = (bx + 8 * ((by >> 4) + 2 * rr)) * 16 + (by & 15);
    }
    const int ch0 = item * 4;
    {
      const int q = tid & 255, hb = tid >> 8;
      uint4 x8[8]; unsigned pn[8]; uint4 fr[4];
#pragma unroll
      for (int k = 0; k < 8; ++k) {
        const int cc = 4096 + ch0 + (k >> 1), b = (k & 1) * 2 + hb;
        const u16* xp = pT + (size_t)cc * 8192 + b * 2048 + q * 8;
        x8[k] = *(const uint4*)xp;
        const unsigned pv = q > 0 ? (unsigned)xp[-1] : 0u;
        const unsigned nx = q < 255 ? (unsigned)xp[8] : 0u;
        pn[k] = pv | (nx << 16);
      }
#pragma unroll
      for (int k = 0; k < 4; ++k) fr[k] = ((const uint4*)(Rg + ((size_t)0 * 2048 + ch0 + k) * 4096))[tid];
#pragma unroll
      for (int k = 0; k < 8; ++k) {
        const int c = k >> 1, cc = 4096 + ch0 + c, b = (k & 1) * 2 + hb;
        const float w0 = p.hy_conv_w[cc], w1 = p.hy_conv_w[6144 + cc], w2 = p.hy_conv_w[2 * 6144 + cc], cb = p.hy_conv_b[cc];
        float e[10];
        e[0] = bflo(pn[k]); e[1] = bflo(x8[k].x); e[2] = bfhi(x8[k].x); e[3] = bflo(x8[k].y); e[4] = bfhi(x8[k].y);
        e[5] = bflo(x8[k].z); e[6] = bfhi(x8[k].z); e[7] = bflo(x8[k].w); e[8] = bfhi(x8[k].w); e[9] = bfhi(pn[k]);
        unsigned o[4];
#pragma unroll
        for (int kk = 0; kk < 4; ++kk) {
          float a = w0 * e[2 * kk] + w1 * e[2 * kk + 1] + w2 * e[2 * kk + 2] + cb;
          float bb = w0 * e[2 * kk + 1] + w1 * e[2 * kk + 2] + w2 * e[2 * kk + 3] + cb;
          o[kk] = (unsigned)f2bf(a) | ((unsigned)f2bf(bb) << 16);
        }
        const int t0 = q * 8, s1 = t0 >> 5, s2 = t0 & 31;
        const int col = (s1 + 16) * 2 + (b & 1);
        *(uint4*)(Ub + (c * 2 + (b >> 1)) * CONV_UB_ONE + ub_addr(col, s2 >> 3)) = make_uint4(o[0], o[1], o[2], o[3]);
      }
#pragma unroll
      for (int k = 0; k < 4; ++k) ((uint4*)(Rf + k * 8192))[tid] = fr[k];
    }
    __syncthreads();
    f32x16 acc[4];
    const int ch = ch0 + ci;
    {
      conv_mfma(Rf_ci, Ub_w, lane, acc);
      SC4 xr[16];
#pragma unroll
      for (int j = 0; j < 4; ++j)
#pragma unroll
        for (int vg = 0; vg < 4; ++vg) {
          const int t1 = 16 * j + (n >> 1), b = 2 * bp + (n & 1), t = 32 * t1 + 8 * vg + 4 * h;
          xr[j * 4 + vg] = sc4_load(pT + (size_t)ch * 8192 + b * 2048 + t, t);
        }
      const uint4 f1a = ((const uint4*)(Rg + ((size_t)1 * 2048 + ch0 + 0) * 4096))[tid];
      const uint4 f1b = ((const uint4*)(Rg + ((size_t)1 * 2048 + ch0 + 1) * 4096))[tid];
      const uint4 f1c = ((const uint4*)(Rg + ((size_t)1 * 2048 + ch0 + 2) * 4096))[tid];
      const uint4 f1d = ((const uint4*)(Rg + ((size_t)1 * 2048 + ch0 + 3) * 4096))[tid];
      const float w0 = p.hy_conv_w[ch], w1 = p.hy_conv_w[6144 + ch], w2 = p.hy_conv_w[2 * 6144 + ch], cb = p.hy_conv_b[ch];
#pragma unroll
      for (int j = 0; j < 4; ++j)
#pragma unroll
        for (int vg = 0; vg < 4; ++vg) {
          const int t1 = 16 * j + (n >> 1), bl = n & 1;
          float x1[4];
          sc4_apply(xr[j * 4 + vg], w0, w1, w2, cb, x1);
          uint2 pk;
          pk.x = (unsigned)f2bf(x1[0] * acc[j][4 * vg + 0]) | ((unsigned)f2bf(x1[1] * acc[j][4 * vg + 1]) << 16);
          pk.y = (unsigned)f2bf(x1[2] * acc[j][4 * vg + 2]) | ((unsigned)f2bf(x1[3] * acc[j][4 * vg + 3]) << 16);
          const int col = (t1 + 16) * 2 + bl;
          *(uint2*)(Ub_w + ub_addr(col, vg) + 8 * h) = pk;
        }
      __syncthreads();
      ((uint4*)(Rf + 0 * 8192))[tid] = f1a;
      ((uint4*)(Rf + 1 * 8192))[tid] = f1b;
      ((uint4*)(Rf + 2 * 8192))[tid] = f1c;
      ((uint4*)(Rf + 3 * 8192))[tid] = f1d;
    }
    __syncthreads();
    {
      const int c2 = 2048 + ch;
      SC4 xr[16]; uint2 gr[16];
      conv_mfma(Rf_ci, Ub_w, lane, acc);
#pragma unroll
      for (int j = 0; j < 4; ++j)
#pragma unroll
        for (int vg = 0; vg < 4; ++vg) {
          const int t1 = 16 * j + (n >> 1), b = 2 * bp + (n & 1), t = 32 * t1 + 8 * vg + 4 * h;
          xr[j * 4 + vg] = sc4_load(pT + (size_t)c2 * 8192 + b * 2048 + t, t);
          gr[j * 4 + vg] = *(const uint2*)(pT + (size_t)(6144 + ch) * 8192 + b * 2048 + t);
        }
      const float w0 = p.hy_conv_w[c2], w1 = p.hy_conv_w[6144 + c2], w2 = p.hy_conv_w[2 * 6144 + c2], cb = p.hy_conv_b[c2];
#pragma unroll
      for (int j = 0; j < 4; ++j)
#pragma unroll
        for (int vg = 0; vg < 4; ++vg) {
          const int t1 = 16 * j + (n >> 1), bl = n & 1;
          float x2[4];
          sc4_apply(xr[j * 4 + vg], w0, w1, w2, cb, x2);
          const uint2 g4 = gr[j * 4 + vg];
          float y0 = x2[0] * acc[j][4 * vg + 0] * siluf(bflo(g4.x));
          float y1 = x2[1] * acc[j][4 * vg + 1] * siluf(bfhi(g4.x));
          float y2 = x2[2] * acc[j][4 * vg + 2] * siluf(bflo(g4.y));
          float y3 = x2[3] * acc[j][4 * vg + 3] * siluf(bfhi(g4.y));
          uint2 pk;
          pk.x = (unsigned)f2bf(y0) | ((unsigned)f2bf(y1) << 16);
          pk.y = (unsigned)f2bf(y2) | ((unsigned)f2bf(y3) << 16);
          const int col = (t1 + 16) * 2 + bl;
          *(uint2*)(Ub_w + ub_addr(col, vg) + 8 * h) = pk;
        }
    }
    __syncthreads();
#pragma unroll 4
    for (int kk = 0; kk < 16; ++kk) {
      const int idx = tid + kk * NTHREADS;
      const int b = idx >> 11, t = idx & 2047;
      const int s1 = t >> 5, s2 = t & 31;
      const int col = (s1 + 16) * 2 + (b & 1);
      const int a = ub_addr(col, s2 >> 3) + (s2 & 7) * 2;
      const char* base = Ub + (b >> 1) * CONV_UB_ONE + a;
      unsigned v0 = *(const u16*)(base + 0 * 2 * CONV_UB_ONE), v1 = *(const u16*)(base + 1 * 2 * CONV_UB_ONE);
      unsigned v2 = *(const u16*)(base + 2 * 2 * CONV_UB_ONE), v3 = *(const u16*)(base + 3 * 2 * CONV_UB_ONE);
      *(uint2*)(yg + (size_t)idx * 2048 + ch0) = make_uint2(v0 | (v1 << 16), v2 | (v3 << 16));
    }
    __syncthreads();
  }
}

constexpr int AT_KROW = 272, AT_VROW = 136;
constexpr int AT_K_BYTES = 64 * AT_KROW, AT_V_BYTES = 128 * AT_VROW;
__device__ void phase_attn(const Params& p, float* smf) {
  char* sm = (char*)smf;
  char* Ks = sm;
  char* Vs = sm + AT_K_BYTES;
  const int tid = threadIdx.x, wid = tid >> 6, lane = tid & 63, r = lane & 31, h = lane >> 5;
  const u16* px = (const u16*)(p.ws + OFF_BIG);
  const u16* kvc = (const u16*)(p.ws + OFF_KVC);
  const u16* vT = (const u16*)(p.ws + OFF_VT);
  const u16* vcT = (const u16*)(p.ws + OFF_VCT);
  u16* og = (u16*)(p.ws + OFF_ACT);
  const float LOG2E = 1.4426950408889634f;
  const float sl2 = 0.08838834764831845f * LOG2E;
  for (int item = blockIdx.x; item < 512; item += gridDim.x) {
    const int hp = item & 1, kvh = (item >> 1) & 3, nblk = (item >> 3) & 15, b = item >> 7;
    const int hq = kvh * 4 + hp * 2 + (wid >> 2);
    const int qs = nblk * 128 + (wid & 3) * 32 + r;
    bfx8 Q[8];
    {
      const u16* qrow = px + (size_t)(b * 2048 + qs) * 5120 + hq * 128 + 8 * h;
#pragma unroll
      for (int st = 0; st < 8; ++st) Q[st] = *(const bfx8*)(qrow + 16 * st);
    }
    f32x16 O[4];
#pragma unroll
    for (int dt = 0; dt < 4; ++dt)
#pragma unroll
      for (int i = 0; i < 16; ++i) O[dt][i] = 0.f;
    float m = p.attn_sink[hq] * LOG2E;
    float l = (h == 0) ? 1.f : 0.f;
    const int first = (nblk == 0) ? 2 : 0, lastlocal = (nblk == 15) ? 3 : 5;
    uint4 kreg0, kreg1, vreg0, vreg1;
#define AT_LOAD_TILE(TI) do { \
      const int _ti = (TI); const bool _loc = _ti < 6; \
      const int _kpos0 = 128 * (nblk - 1) + 64 * _ti, _c0 = 64 * (_ti - 6); \
      const u16* _kb = _loc ? px + (size_t)(b * 2048 + _kpos0) * 5120 + 2048 + kvh * 128 : kvc + (size_t)(b * 256 + _c0) * 1024 + kvh * 128; \
      const size_t _ks = _loc ? 5120 : 1024; \
      const u16* _vb = _loc ? vT + (size_t)(kvh * 128) * 8192 + b * 2048 + _kpos0 : vcT + (size_t)(kvh * 128) * 1024 + b * 256 + _c0; \
      const size_t _vs = _loc ? 8192 : 1024; \
      const int _c1 = tid + NTHREADS; \
      kreg0 = *(const uint4*)(_kb + (size_t)(tid >> 4) * _ks + (tid & 15) * 8); \
      kreg1 = *(const uint4*)(_kb + (size_t)(_c1 >> 4) * _ks + (_c1 & 15) * 8); \
      vreg0 = *(const uint4*)(_vb + (size_t)(tid >> 3) * _vs + (tid & 7) * 8); \
      vreg1 = *(const uint4*)(_vb + (size_t)(_c1 >> 3) * _vs + (_c1 & 7) * 8); \
    } while (0)
    int ti = first;
    AT_LOAD_TILE(ti);
    while (true) {
      __syncthreads();
      {
        const int c1 = tid + NTHREADS;
        *(uint4*)(Ks + (tid >> 4) * AT_KROW + (tid & 15) * 16) = kreg0;
        *(uint4*)(Ks + (c1 >> 4) * AT_KROW + (c1 & 15) * 16) = kreg1;
        char* v0p = Vs + (tid >> 3) * AT_VROW + (tid & 7) * 16;
        char* v1p = Vs + (c1 >> 3) * AT_VROW + (c1 & 7) * 16;
        *(uint2*)(v0p) = make_uint2(vreg0.x, vreg0.y);
        *(uint2*)(v0p + 8) = make_uint2(vreg0.z, vreg0.w);
        *(uint2*)(v1p) = make_uint2(vreg1.x, vreg1.y);
        *(uint2*)(v1p + 8) = make_uint2(vreg1.z, vreg1.w);
      }
      __syncthreads();
      int tn = ti + 1;
      if (tn > lastlocal && tn < 6) tn = 6;
      if (tn < 10) AT_LOAD_TILE(tn);
      {
        const bool local = ti < 6;
        const int kpos0 = 128 * (nblk - 1) + 64 * ti;
        f32x16 S[2];
#pragma unroll
        for (int ks = 0; ks < 2; ++ks) {
#pragma unroll
          for (int i = 0; i < 16; ++i) S[ks][i] = 0.f;
#pragma unroll
          for (int st = 0; st < 8; ++st) {
            bfx8 A = *(const bfx8*)(Ks + (ks * 32 + r) * AT_KROW + (16 * st + 8 * h) * 2);
            S[ks] = __builtin_amdgcn_mfma_f32_32x32x16_bf16(A, Q[st], S[ks], 0, 0, 0);
          }
        }
        float mx = m;
#pragma unroll
        for (int ks = 0; ks < 2; ++ks)
#pragma unroll
          for (int i = 0; i < 16; ++i) {
            float sv = S[ks][i] * sl2;
            if (local) {
              const int kpos = kpos0 + ks * 32 + (i & 3) + 8 * (i >> 2) + 4 * h;
              const int rel = kpos - qs;
              if (rel > 128 || rel < -128) sv = -1e30f;
            }
            S[ks][i] = sv;
            mx = fmaxf(mx, sv);
          }
        mx = fmaxf(mx, __shfl_xor(mx, 32, 64));
        const float alpha = __builtin_amdgcn_exp2f(m - mx);
        m = mx;
        l *= alpha;
#pragma unroll
        for (int dt = 0; dt < 4; ++dt)
#pragma unroll
          for (int i = 0; i < 16; ++i) O[dt][i] *= alpha;
#pragma unroll
        for (int ks = 0; ks < 2; ++ks)
#pragma unroll
          for (int i = 0; i < 16; ++i) {
            float pv = __builtin_amdgcn_exp2f(S[ks][i] - m);
            l += pv;
            S[ks][i] = pv;
          }
#pragma unroll
        for (int s4 = 0; s4 < 4; ++s4) {
          const int ks = s4 >> 1, hf = s4 & 1;
          pg8::u32x4 pk;
#pragma unroll
          for (int j = 0; j < 4; ++j)
            pk[j] = (unsigned)f2bf(S[ks][8 * hf + 2 * j]) | ((unsigned)f2bf(S[ks][8 * hf + 2 * j + 1]) << 16);
          bfx8 P = __builtin_bit_cast(bfx8, pk);
#pragma unroll
          for (int dt = 0; dt < 4; ++dt) {
            const char* vp = Vs + (dt * 32 + r) * AT_VROW + (32 * ks + 16 * hf + 4 * h) * 2;
            uint2 v0 = *(const uint2*)vp, v1 = *(const uint2*)(vp + 16);
            pg8::u32x4 vv; vv[0] = v0.x; vv[1] = v0.y; vv[2] = v1.x; vv[3] = v1.y;
            O[dt] = __builtin_amdgcn_mfma_f32_32x32x16_bf16(__builtin_bit_cast(bfx8, vv), P, O[dt], 0, 0, 0);
          }
        }
      }
      if (tn >= 10) break;
      ti = tn;
    }
    const float ltot = l + __shfl_xor(l, 32, 64);
    const float inv = 1.f / ltot;
    const size_t tok = (size_t)(b * 2048 + qs);
#pragma unroll
    for (int dt = 0; dt < 4; ++dt)
#pragma unroll
      for (int g4 = 0; g4 < 4; ++g4) {
        const int d = dt * 32 + 8 * g4 + 4 * h;
        uint2 gg = *(const uint2*)(px + tok * 5120 + 3072 + hq * 128 + d);
        float o0 = O[dt][4 * g4 + 0] * inv * siluf(bflo(gg.x));
        float o1 = O[dt][4 * g4 + 1] * inv * siluf(bfhi(gg.x));
        float o2 = O[dt][4 * g4 + 2] * inv * siluf(bflo(gg.y));
        float o3 = O[dt][4 * g4 + 3] * inv * siluf(bfhi(gg.y));
        uint2 pk;
        pk.x = (unsigned)f2bf(o0) | ((unsigned)f2bf(o1) << 16);
        pk.y = (unsigned)f2bf(o2) | ((unsigned)f2bf(o3) << 16);
        *(uint2*)(og + tok * 2048 + hq * 128 + d) = pk;
      }
  }
}

#define XB_TMO      128
#define XB_XCNT(j)  (256  + 64 * (j))
#define XB_XSUB(j)  (1280 + 64 * (j))
#define XB_XGEN(j)  (2304 + 64 * (j))
#define XB_TOP      3328
#define XB_TOPGEN   3392
#define XCD_BAR_WORDS 3456
#define XB_SPIN_CAP (1u << 18)
#define LAS __attribute__((address_space(3)))

__device__ __forceinline__ unsigned xb_ld(unsigned* p)              { return __hip_atomic_load(p, __ATOMIC_RELAXED, __HIP_MEMORY_SCOPE_AGENT); }
__device__ __forceinline__ unsigned xb_add(unsigned* p, unsigned v) { return __hip_atomic_fetch_add(p, v, __ATOMIC_RELAXED, __HIP_MEMORY_SCOPE_AGENT); }
__device__ __forceinline__ unsigned xb_xcc_id() { return (unsigned)__builtin_amdgcn_s_getreg((3 << 11) | 20) & 0xFu; }
#define XB_SPIN(cond, bar) do { unsigned _sp = 0; while (cond) { __builtin_amdgcn_s_sleep(1); \
    if ((++_sp & 255u) == 0u) { if (xb_ld(&(bar)[XB_TMO])) break; if (_sp > XB_SPIN_CAP) { atomicAdd(&(bar)[XB_TMO], 1u); break; } } } } while (0)

struct XcdBarrier {
    unsigned* bar; unsigned x;
    volatile LAS unsigned* st;
};

__device__ __forceinline__ XcdBarrier xcd_barrier_post(unsigned* bar, volatile LAS unsigned* st) {
    XcdBarrier b; b.bar = bar; b.x = xb_xcc_id(); b.st = st;
    if (threadIdx.x == 0) (void)xb_add(&bar[XB_XCNT(b.x)], 1u);
    return b;
}
__device__ __forceinline__ void xcd_barrier_complete(unsigned* bar, unsigned x, unsigned& nloc, unsigned& nx) {
    const unsigned G = gridDim.x * gridDim.y * gridDim.z;
    unsigned sum, cnt, mine, sp = 0u;
    for (;;) {
        sum = 0u; cnt = 0u; mine = 0u;
#pragma unroll
        for (unsigned j = 0; j < 16; ++j) { const unsigned c = xb_ld(&bar[XB_XCNT(j)]); sum += c; cnt += (c > 0u) ? 1u : 0u; mine = (j == x) ? c : mine; }
        if (sum == G) break;
        __builtin_amdgcn_s_sleep(1);
        if ((++sp & 255u) == 0u) { if (xb_ld(&bar[XB_TMO])) break; if (sp > XB_SPIN_CAP) { atomicAdd(&bar[XB_TMO], 1u); break; } }
    }
    nloc = mine > 0u ? mine : 1u; nx = cnt > 0u ? cnt : 1u;
}

__device__ __forceinline__ void xcd_barrier(const XcdBarrier& b) {
    asm volatile("s_waitcnt vmcnt(0)" ::: "memory");
    __syncthreads();
    if (threadIdx.x == 0) {
        unsigned* bar = b.bar;
        __builtin_amdgcn_s_waitcnt(0);
        unsigned nloc = b.st[0], nx = b.st[1];
        if (nloc == 0u) { xcd_barrier_complete(bar, b.x, nloc, nx); b.st[0] = nloc; b.st[1] = nx; }
        const unsigned old = xb_add(&bar[XB_XSUB(b.x)], 1u);
        const unsigned gen = old / nloc;
        if (old + 1u == (gen + 1u) * nloc) {
            __builtin_amdgcn_fence(__ATOMIC_RELEASE, "agent");
            asm volatile("s_waitcnt vmcnt(0)" ::: "memory");
            const unsigned og = xb_add(&bar[XB_TOP], 1u);
            const unsigned tg = og / nx;
            if (og + 1u == (tg + 1u) * nx) xb_add(&bar[XB_TOPGEN], 1u);
            else XB_SPIN(xb_ld(&bar[XB_TOPGEN]) == tg, bar);
            __builtin_amdgcn_fence(__ATOMIC_ACQUIRE, "agent");
            xb_add(&bar[XB_XGEN(b.x)], 1u);
            asm volatile("s_waitcnt vmcnt(0)" ::: "memory");
        } else {
            XB_SPIN(xb_ld(&bar[XB_XGEN(b.x)]) == gen, bar);
            __builtin_amdgcn_fence(__ATOMIC_ACQUIRE, "agent");
            asm volatile("s_waitcnt vmcnt(0)" ::: "memory");
        }
    }
    __syncthreads();
}


constexpr int N_PHASES = 10;
__global__ void __launch_bounds__(NTHREADS, 2) mega(Params p, int ph0, int ph1) {
  extern __shared__ __attribute__((aligned(16))) float sm[];
  volatile LAS unsigned* xb_st = (volatile LAS unsigned*)((LAS unsigned char*)sm + 131072);
  if (threadIdx.x < 4) xb_st[threadIdx.x] = 0u;
  __syncthreads();
  const XcdBarrier xb = xcd_barrier_post((unsigned*)(p.ws + OFF_BAR), xb_st);
#define PH(i, body) if (ph0 <= (i) && (i) < ph1) { body; if ((i) + 1 < ph1) { if ((i) == 0) cg::this_grid().sync(); else xcd_barrier(xb); } }
  PH(0, phase0(p, sm))
  PH(1, phase_norm(p, 0))
  PH(2, run_gemm(sm, (const u16*)(p.ws + OFF_ACT), (const u16*)(p.ws + OFF_WT_AI), MT, ATTN_IN,
                 EpiAttnIn{(u16*)(p.ws + OFF_BIG), (const float*)(p.ws + OFF_ROPE)}, (int)blockIdx.x);
        run_gemm(sm, (const u16*)(p.ws + OFF_HC), (const u16*)(p.ws + OFF_WT_AI) + (size_t)2048 * 2048, MC, 1024,
                 EpiRaw{(u16*)(p.ws + OFF_KVC), 1024}, (int)((blockIdx.x + 64) % gridDim.x));
        run_gemm(sm, (const u16*)(p.ws + OFF_WT_AI) + (size_t)2560 * 2048, (const u16*)(p.ws + OFF_ACT), 512, MT,
                 EpiRaw{(u16*)(p.ws + OFF_VT), 8192}, (int)((blockIdx.x + 128) % gridDim.x));
        run_gemm(sm, (const u16*)(p.ws + OFF_WT_AI) + (size_t)2560 * 2048, (const u16*)(p.ws + OFF_HC), 512, MC,
                 EpiRaw{(u16*)(p.ws + OFF_VCT), 1024}, (int)((blockIdx.x + 48) % gridDim.x)))
  PH(3, phase_attn(p, sm))
  PH(4, run_gemm(sm, (const u16*)(p.ws + OFF_ACT), (const u16*)(p.ws + OFF_WT_AO), MT, 2048,
                 EpiRes{p.out, p.x, (const float*)(p.ws + OFF_MOD) + 4096}, (int)blockIdx.x))
  PH(5, phase_norm(p, 1))
  PH(6, run_gemm(sm, (const u16*)(p.ws + OFF_WT_HI), (const u16*)(p.ws + OFF_ACT), HY_IN, MT,
                 EpiRaw{(u16*)(p.ws + OFF_BIG), 8192}, (int)blockIdx.x))
  PH(7, phase_conv(p, sm))
  PH(8, run_gemm(sm, (const u16*)(p.ws + OFF_ACT), (const u16*)(p.ws + OFF_WT_HO), MT, 2048,
                 EpiRes{p.out, p.out, (const float*)(p.ws + OFF_MOD) + 5 * 6144 + 4096}, (int)blockIdx.x))
  PH(9, phase_norm(p, 2))
}

extern "C" void kernel_launch(void* const* d_in, const int* in_sizes, int n_in, void* d_out, int out_size,
                              void* d_ws, size_t ws_size, hipStream_t stream) {
  Params p{};
  const float** f = (const float**)&p;
  for (int i = 0; i < 23; ++i) f[i] = (const float*)d_in[i];
  p.out = (float*)d_out;
  p.ws = (char*)d_ws;
  constexpr size_t kLds = 128 * 1024 + 16;
  static int grid_blocks = 0;
  if (!grid_blocks) {
    (void)hipFuncSetAttribute((const void*)mega, hipFuncAttributeMaxDynamicSharedMemorySize, (int)kLds);
    int dev = 0, cus = 0, per_cu = 0;
    (void)hipGetDevice(&dev);
    (void)hipDeviceGetAttribute(&cus, hipDeviceAttributeMultiprocessorCount, dev);
    (void)hipOccupancyMaxActiveBlocksPerMultiprocessor(&per_cu, mega, NTHREADS, kLds);
    if (per_cu < 1) per_cu = 1;
    grid_blocks = cus * per_cu;
  }
  (void)hipMemsetAsync((char*)d_ws + OFF_BAR, 0, XCD_BAR_WORDS * sizeof(unsigned), stream);
  int ph0 = 0, ph1 = N_PHASES;
  void* args[] = {(void*)&p, (void*)&ph0, (void*)&ph1};
  hipError_t e = hipLaunchCooperativeKernel((const void*)mega, dim3(grid_blocks), dim3(NTHREADS), args, kLds, stream);
  if (e != hipSuccess) fprintf(stderr, "cooperative launch failed: %s (grid %d)\n", hipGetErrorString(e), grid_blocks);
}
```

```cpp
#include <hip/hip_runtime.h>
#include <hip/hip_bf16.h>
#include <hip/hip_cooperative_groups.h>
#include <cstdio>
namespace cg = cooperative_groups;
typedef unsigned short u16;

#define NTHREADS 512
constexpr int Bn = 4, Sn = 2048, Dn = 2048, Cn = 256;
constexpr int MT = Bn * Sn;
constexpr int MC = Bn * Cn;
constexpr int ATTN_IN = 5120;
constexpr int HY_IN = 8192;

constexpr size_t OFF_WT_AI = 0;
constexpr size_t OFF_WT_AO = OFF_WT_AI + (size_t)5120 * 2048 * 2;
constexpr size_t OFF_WT_HI = OFF_WT_AO + (size_t)2048 * 2048 * 2;
constexpr size_t OFF_WT_HO = OFF_WT_HI + (size_t)8192 * 2048 * 2;
constexpr size_t OFF_MOD   = OFF_WT_HO + (size_t)2048 * 2048 * 2;
constexpr size_t OFF_ROPE  = OFF_MOD + (size_t)2 * 5 * 6144 * 4 + 256;
constexpr size_t OFF_FILT  = OFF_ROPE + (size_t)64 * 32 * 8;
constexpr size_t OFF_ACT   = OFF_FILT + (size_t)2 * 2048 * 4096 * 2;
constexpr size_t OFF_HC    = OFF_ACT + (size_t)8192 * 2048 * 2;
constexpr size_t OFF_KVC   = OFF_HC + (size_t)1024 * 2048 * 2;
constexpr size_t OFF_VT    = OFF_KVC + (size_t)1024 * 1024 * 2;
constexpr size_t OFF_VCT   = OFF_VT + (size_t)512 * 8192 * 2;
constexpr size_t OFF_BIG   = OFF_VCT + (size_t)512 * 1024 * 2;

constexpr size_t OFF_BAR   = OFF_BIG + (size_t)8192 * 8192 * 2;

constexpr size_t OFF_ROWSS = OFF_BAR + 16384;
constexpr size_t OFF_PCNT  = OFF_ROWSS + (size_t)2 * 8192 * 4;
constexpr size_t ZERO_BYTES = 16384 + (size_t)2 * 8192 * 4 + (size_t)2 * 32 * 64 * 4;

struct Params {
  const float *x, *c, *ctx, *c_ctx, *norm_g, *ada_w, *ada_b, *attn_w_in, *attn_w_out, *attn_sink;
  const float *hy_w_in, *hy_conv_w, *hy_conv_b, *hy_w1, *hy_b1, *hy_w2, *hy_b2, *hy_w3, *hy_b3;
  const float *hy_freq, *hy_bias_d, *hy_w_out, *final_g;
  float* out;
  char* ws;
};

__device__ __forceinline__ u16 f2bf(float f) {
  unsigned u = __float_as_uint(f);
  u += 0x7fffu + ((u >> 16) & 1u);
  return (u16)(u >> 16);
}
__device__ __forceinline__ float bf2f(u16 h) { return __uint_as_float(((unsigned)h) << 16); }
__device__ __forceinline__ float bflo(unsigned w) { return __uint_as_float(w << 16); }
__device__ __forceinline__ float bfhi(unsigned w) { return __uint_as_float(w & 0xffff0000u); }
__device__ __forceinline__ float siluf(float v) { return v / (1.f + __expf(-v)); }
__device__ __forceinline__ float wave_sum(float v) {
#pragma unroll
  for (int o = 32; o > 0; o >>= 1) v += __shfl_xor(v, o, 64);
  return v;
}
__device__ __forceinline__ float wave_max(float v) {
#pragma unroll
  for (int o = 32; o > 0; o >>= 1) v = fmaxf(v, __shfl_xor(v, o, 64));
  return v;
}

__device__ __forceinline__ void p0_convert(const float* __restrict__ W, u16* __restrict__ Wt, int N, int tk, int tn,
                           bool perm, float* sm) {
  const int tid = threadIdx.x;
  for (int i = tid; i < 64 * 32; i += NTHREADS) {
    int r = i >> 5, c4 = i & 31;
    float4 v = *(const float4*)(W + (size_t)(tk * 64 + r) * N + tn * 128 + c4 * 4);
    float* d = sm + r * 129 + c4 * 4;
    d[0] = v.x; d[1] = v.y; d[2] = v.z; d[3] = v.w;
  }
  __syncthreads();
  for (int i = tid; i < 128 * 8; i += NTHREADS) {
    int nrow = i >> 3, kc = i & 7;
    int src = nrow;
    if (perm && (tn * 128 < 2560)) {
      int g = nrow >> 5, nn = (nrow >> 4) & 1, fr = nrow & 15;
      src = (g >> 1) * 64 + nn * 32 + (g & 1) * 16 + fr;
    }
    unsigned w[4];
#pragma unroll
    for (int j = 0; j < 4; ++j) {
      float a = sm[(kc * 8 + 2 * j) * 129 + src];
      float b = sm[(kc * 8 + 2 * j + 1) * 129 + src];
      w[j] = (unsigned)f2bf(a) | ((unsigned)f2bf(b) << 16);
    }
    *(uint4*)(Wt + (size_t)(tn * 128 + nrow) * 2048 + tk * 64 + kc * 8) = make_uint4(w[0], w[1], w[2], w[3]);
  }
  __syncthreads();
}

__device__ __forceinline__ void p0_adaln(const Params& p, int item, float* sm) {
  const int tid = threadIdx.x;
  float* sv = sm;
  float* red = sm + 5 * 2048;
  int col0 = item * 48;
  int l = col0 / 6144, n0 = col0 % 6144;
  for (int i = tid; i < 5 * 2048; i += NTHREADS) {
    int v = i >> 11, k = i & 2047;
    float cv = v < 4 ? p.c[v * 2048 + k] : p.c_ctx[k];
    sv[i] = cv / (1.f + expf(-cv));
  }
  __syncthreads();
  int kg = tid / 12, cq = tid % 12;
  float acc[5][4];
#pragma unroll
  for (int v = 0; v < 5; ++v)
#pragma unroll
    for (int j = 0; j < 4; ++j) acc[v][j] = 0.f;
  if (kg < 42) {
    const float* W = p.ada_w + (size_t)l * 2048 * 6144 + n0 + cq * 4;
#pragma unroll 8
    for (int k = kg; k < 2048; k += 42) {
      float4 w = *(const float4*)(W + (size_t)k * 6144);
#pragma unroll
      for (int v = 0; v < 5; ++v) {
        float s = sv[v * 2048 + k];
        acc[v][0] += s * w.x; acc[v][1] += s * w.y; acc[v][2] += s * w.z; acc[v][3] += s * w.w;
      }
    }
  }
  if (kg >= 21 && kg < 42) {
#pragma unroll
    for (int v = 0; v < 5; ++v)
#pragma unroll
      for (int j = 0; j < 4; ++j) red[((kg - 21) * 5 + v) * 48 + cq * 4 + j] = acc[v][j];
  }
  __syncthreads();
  if (kg < 21) {
#pragma unroll
    for (int v = 0; v < 5; ++v)
#pragma unroll
      for (int j = 0; j < 4; ++j) red[(kg * 5 + v) * 48 + cq * 4 + j] += acc[v][j];
  }
  __syncthreads();
  if (tid < 240) {
    int v = tid / 48, cc = tid % 48;
    float s = 0.f;
    for (int g = 0; g < 21; ++g) s += red[(g * 5 + v) * 48 + cc];
    float* mod = (float*)(p.ws + OFF_MOD);
    mod[(l * 5 + v) * 6144 + n0 + cc] = s + p.ada_b[l * 6144 + n0 + cc];
  }
  __syncthreads();
}

__device__ __forceinline__ void p0_rope(const Params& p) {
  float2* rope = (float2*)(p.ws + OFF_ROPE);
  for (int i = threadIdx.x; i < 64 * 32; i += NTHREADS) {
    int pos = i >> 5, j = i & 31;
    float inv = powf(10000.f, -(float)(2 * j) / 64.f);
    float ang = (float)pos * inv;
    rope[i] = make_float2(cosf(ang), sinf(ang));
  }
}

typedef short bf16x8_t __attribute__((ext_vector_type(8)));
typedef unsigned u32x4_t __attribute__((ext_vector_type(4)));
typedef float f32x16_t __attribute__((ext_vector_type(16)));
__device__ __forceinline__ void split8(const float (&v)[8], bf16x8_t& hi, bf16x8_t& lo) {
  u32x4_t H, L;
#pragma unroll
  for (int j = 0; j < 4; ++j) {
    const u16 h0 = f2bf(v[2 * j]), h1 = f2bf(v[2 * j + 1]);
    const float r0 = v[2 * j] - bf2f(h0), r1 = v[2 * j + 1] - bf2f(h1);
    H[j] = (unsigned)h0 | ((unsigned)h1 << 16);
    L[j] = (unsigned)f2bf(r0) | ((unsigned)f2bf(r1) << 16);
  }
  hi = __builtin_bit_cast(bf16x8_t, H);
  lo = __builtin_bit_cast(bf16x8_t, L);
}
__device__ __forceinline__ void p0_filter(const Params& p, int item, float* sm) {
  int tid = threadIdx.x;
  asm volatile("" : "+v"(tid));
  const int lane = tid & 63, wid = tid >> 6, r = lane & 31, h = lane >> 5;
  const int cc = item & 15, pg = item >> 4;
  float* z = sm;
  float* h1 = z + 128 * 36;
  float* h2 = h1 + 128 * 64;
  for (int i = tid; i < 128 * 33; i += NTHREADS) {
    int pos = i / 33, e = i % 33;
    int t = pg * 128 + pos;
    float val;
    if (e == 0) val = (float)t / 2047.f;
    else {
      int bi = (e - 1) & 15;
      float w = 6.283185307179586f * (float)t / 2048.f;
      float fr = 1e-4f + (float)bi * ((15.f - 1e-4f) / 15.f);
      float ang = w * fr;
      val = (e <= 16) ? cosf(ang) : -sinf(ang);
    }
    z[pos * 36 + e] = val;
  }
  __syncthreads();
  {
    const int j = lane;
    float w1r[33];
#pragma unroll
    for (int e = 0; e < 33; ++e) w1r[e] = p.hy_w1[e * 64 + j];
    const float fq = p.hy_freq[j], b1 = p.hy_b1[j];
#pragma unroll 1
    for (int q = 0; q < 16; ++q) {
      const int pos = wid * 16 + q;
      const float4* zp = (const float4*)(z + pos * 36);
      float a = b1;
#pragma unroll
      for (int e4 = 0; e4 < 8; ++e4) {
        float4 zv = zp[e4];
        a += zv.x * w1r[4 * e4] + zv.y * w1r[4 * e4 + 1] + zv.z * w1r[4 * e4 + 2] + zv.w * w1r[4 * e4 + 3];
      }
      a += z[pos * 36 + 32] * w1r[32];
      h1[pos * 64 + j] = sinf(fq * a);
    }
  }
  __syncthreads();
  {
    const int j = lane;
    float w2r[64];
#pragma unroll
    for (int e = 0; e < 64; ++e) w2r[e] = p.hy_w2[e * 64 + j];
    const float fq = p.hy_freq[j], b2 = p.hy_b2[j];
#pragma unroll 1
    for (int q = 0; q < 16; ++q) {
      const int pos = wid * 16 + q;
      const float4* hp = (const float4*)(h1 + pos * 64);
      float a = b2;
#pragma unroll
      for (int e4 = 0; e4 < 16; ++e4) {
        float4 hv = hp[e4];
        a += hv.x * w2r[4 * e4] + hv.y * w2r[4 * e4 + 1] + hv.z * w2r[4 * e4 + 2] + hv.w * w2r[4 * e4 + 3];
      }
      h2[pos * 68 + j] = sinf(fq * a);
    }
  }
  __syncthreads();
  const int colw = cc * 512 + wid * 64;
  bf16x8_t Ahi[2][4], Alo[2][4];
#pragma unroll
  for (int ct = 0; ct < 2; ++ct)
#pragma unroll
    for (int ks = 0; ks < 4; ++ks) {
      float v[8];
#pragma unroll
      for (int j = 0; j < 8; ++j) v[j] = p.hy_w3[(size_t)(16 * ks + 8 * h + j) * 8192 + colw + ct * 32 + r];
      split8(v, Ahi[ct][ks], Alo[ct][ks]);
    }
  const int o = cc >> 3, dir = (cc >> 2) & 1;
  u16* Rg = (u16*)(p.ws + OFF_FILT) + (size_t)o * 2048 * 4096;
  const float min_decay = -3.0701134573253945f, max_decay = -15.350567286626972f;
#pragma unroll 1
  for (int pp = 0; pp < 2; ++pp) {
    f32x16_t acc[2][2];
#pragma unroll
    for (int ct = 0; ct < 2; ++ct)
#pragma unroll
      for (int q = 0; q < 2; ++q)
#pragma unroll
        for (int i = 0; i < 16; ++i) acc[ct][q][i] = 0.f;
#pragma unroll
    for (int q = 0; q < 2; ++q)
#pragma unroll
      for (int ks = 0; ks < 4; ++ks) {
        const float* hp = h2 + ((pp * 2 + q) * 32 + r) * 68 + 16 * ks + 8 * h;
        float4 x0 = *(const float4*)hp, x1 = *(const float4*)(hp + 4);
        float v[8] = {x0.x, x0.y, x0.z, x0.w, x1.x, x1.y, x1.z, x1.w};
        bf16x8_t Bhi, Blo;
        split8(v, Bhi, Blo);
#pragma unroll
        for (int ct = 0; ct < 2; ++ct) {
          acc[ct][q] = __builtin_amdgcn_mfma_f32_32x32x16_bf16(Ahi[ct][ks], Bhi, acc[ct][q], 0, 0, 0);
          acc[ct][q] = __builtin_amdgcn_mfma_f32_32x32x16_bf16(Ahi[ct][ks], Blo, acc[ct][q], 0, 0, 0);
          acc[ct][q] = __builtin_amdgcn_mfma_f32_32x32x16_bf16(Alo[ct][ks], Bhi, acc[ct][q], 0, 0, 0);
        }
      }
    int hh = h;
    asm volatile("" : "+v"(hh));
#pragma unroll
    for (int ct = 0; ct < 2; ++ct)
#pragma unroll
      for (int i = 0; i < 16; ++i) {
        const int col = colw + ct * 32 + (i & 3) + 8 * (i >> 2) + 4 * hh;
        const int ch = col & 2047;
        const float b3 = p.hy_b3[col];
        const float ad = fabsf(min_decay + (float)ch * ((max_decay - min_decay) / 2047.f));
        u16* R = Rg + (size_t)ch * 4096;
#pragma unroll
        for (int q = 0; q < 2; ++q) {
          const int t = pg * 128 + (pp * 2 + q) * 32 + r;
          const float tn = (float)t / 2047.f;
          float v = (acc[ct][q][i] + b3) * (__expf(-tn * ad) + 0.05f);
          if (dir == 0) {
            if (t == 0) v += p.hy_bias_d[o * 2048 + ch];
            R[2048 - t] = f2bf(v);
          } else {
            if (t > 0) R[2048 + t] = f2bf(v);
            else R[0] = 0;
          }
        }
      }
  }
  __syncthreads();
}

constexpr int N_CV_AI = 16 * 40, N_CV_AO = 16 * 16, N_CV_HI = 16 * 64, N_CV_HO = 16 * 16;
constexpr int N_CV = N_CV_AI + N_CV_AO + N_CV_HI + N_CV_HO;
#define CV_DECODE(I, W_, Wt_, N_, tk_, tn_, perm_) do { int _i = (I); \
    const bool _a = _i < N_CV_AI, _b2 = _i < N_CV_AI + N_CV_AO, _c = _i < N_CV_AI + N_CV_AO + N_CV_HI; \
    W_ = _a ? p.attn_w_in : (_b2 ? p.attn_w_out : (_c ? p.hy_w_in : p.hy_w_out)); \
    Wt_ = (u16*)(p.ws + (_a ? OFF_WT_AI : (_b2 ? OFF_WT_AO : (_c ? OFF_WT_HI : OFF_WT_HO)))); \
    N_ = _a ? 5120 : (_b2 ? 2048 : (_c ? 8192 : 2048)); \
    const int _nt = _a ? 40 : (_b2 ? 16 : (_c ? 64 : 16)); \
    _i -= _a ? 0 : (_b2 ? N_CV_AI : (_c ? N_CV_AI + N_CV_AO : N_CV_AI + N_CV_AO + N_CV_HI)); \
    tk_ = _i / _nt; tn_ = _i - tk_ * _nt; perm_ = _a && (tn_ * 128 < 2560); } while (0)
__device__ __forceinline__ void p0_convert_all(const Params& p, float* sm) {
  const int tid = threadIdx.x;
  float4 r0, r1, r2, r3, r4, r5, r6, r7;
#define CV_LOAD(W_, N_, tk_, tn_) do { const float* _b = (W_) + (size_t)((tk_) * 128 + (tid >> 5)) * (N_) + (tn_) * 128 + (tid & 31) * 4; const size_t _s = (size_t)16 * (N_); \
    r0 = *(const float4*)(_b); r1 = *(const float4*)(_b + _s); r2 = *(const float4*)(_b + 2 * _s); r3 = *(const float4*)(_b + 3 * _s); \
    r4 = *(const float4*)(_b + 4 * _s); r5 = *(const float4*)(_b + 5 * _s); r6 = *(const float4*)(_b + 6 * _s); r7 = *(const float4*)(_b + 7 * _s); } while (0)
#define CV_PUT(R, I) do { float* _d = sm + ((tid >> 5) + 16 * (I)) * 129 + (tid & 31) * 4; _d[0] = (R).x; _d[1] = (R).y; _d[2] = (R).z; _d[3] = (R).w; } while (0)
  int it = blockIdx.x;
  const float* cW; u16* cWt; int cN, ctk, ctn; bool cperm;
  CV_DECODE(it < N_CV ? it : 0, cW, cWt, cN, ctk, ctn, cperm);
  if (it < N_CV) CV_LOAD(cW, cN, ctk, ctn);
  while (it < N_CV) {
    __syncthreads();
    CV_PUT(r0, 0); CV_PUT(r1, 1); CV_PUT(r2, 2); CV_PUT(r3, 3); CV_PUT(r4, 4); CV_PUT(r5, 5); CV_PUT(r6, 6); CV_PUT(r7, 7);
    __syncthreads();
    const int nit = it + gridDim.x;
    const float* nW; u16* nWt; int nN, ntk, ntn; bool nperm;
    CV_DECODE(nit < N_CV ? nit : 0, nW, nWt, nN, ntk, ntn, nperm);
    if (nit < N_CV) CV_LOAD(nW, nN, ntk, ntn);
    const int row = (tid & 15) | (((tid >> 6) & 7) << 4);
    int src = row;
    if (cperm) { const int g = row >> 5, nn = (row >> 4) & 1, fr = row & 15; src = (g >> 1) * 64 + nn * 32 + (g & 1) * 16 + fr; }
#pragma unroll
    for (int i = 0; i < 4; ++i) {
      const int kch = ((tid >> 4) & 3) | (i << 2);
      unsigned w[4];
#pragma unroll
      for (int j = 0; j < 4; ++j) {
        float a = sm[(kch * 8 + 2 * j) * 129 + src];
        float b = sm[(kch * 8 + 2 * j + 1) * 129 + src];
        w[j] = (unsigned)f2bf(a) | ((unsigned)f2bf(b) << 16);
      }
      *(uint4*)(cWt + (size_t)(ctn * 128 + row) * 2048 + ctk * 128 + kch * 8) = make_uint4(w[0], w[1], w[2], w[3]);
    }
    cW = nW; cWt = nWt; cN = nN; ctk = ntk; ctn = ntn; cperm = nperm;
    it = nit;
  }
#undef CV_LOAD
#undef CV_PUT
}

__device__ __forceinline__ void phase0(const Params& p, float* sm) {
  for (int it = blockIdx.x; it < 256; it += gridDim.x) p0_adaln(p, it, sm);
  if (blockIdx.x == gridDim.x - 1) p0_rope(p);
  __syncthreads();
  for (int it = blockIdx.x; it < 256; it += gridDim.x) p0_filter(p, it, sm);
  __syncthreads();
  p0_convert_all(p, sm);
}

__device__ __forceinline__ void norm_row(const float* __restrict__ src, const float* __restrict__ g, const float* shift,
                         const float* scale, u16* dst_bf, float* dst_f, int lane) {
  float4 v[8];
  float ss = 0.f;
#pragma unroll
  for (int j = 0; j < 8; ++j) {
    v[j] = *(const float4*)(src + (j * 64 + lane) * 4);
    ss += v[j].x * v[j].x + v[j].y * v[j].y + v[j].z * v[j].z + v[j].w * v[j].w;
  }
  ss = wave_sum(ss);
  float r = rsqrtf(ss * (1.f / 2048.f) + 1e-6f);
#pragma unroll
  for (int j = 0; j < 8; ++j) {
    int c = (j * 64 + lane) * 4;
    float4 gg = *(const float4*)(g + c);
    float4 o = make_float4(v[j].x * r * gg.x, v[j].y * r * gg.y, v[j].z * r * gg.z, v[j].w * r * gg.w);
    if (dst_bf) {
      float4 sh = *(const float4*)(shift + c);
      float4 sc = *(const float4*)(scale + c);
      o.x = o.x * (1.f + sc.x) + sh.x; o.y = o.y * (1.f + sc.y) + sh.y;
      o.z = o.z * (1.f + sc.z) + sh.z; o.w = o.w * (1.f + sc.w) + sh.w;
      uint2 pk;
      pk.x = (unsigned)f2bf(o.x) | ((unsigned)f2bf(o.y) << 16);
      pk.y = (unsigned)f2bf(o.z) | ((unsigned)f2bf(o.w) << 16);
      *(uint2*)(dst_bf + c) = pk;
    } else {
      *(float4*)(dst_f + c) = o;
    }
  }
}

__device__ __forceinline__ void phase_norm(const Params& p, int mode) {
  const int wid = threadIdx.x >> 6, lane = threadIdx.x & 63;
  const float* mod = (const float*)(p.ws + OFF_MOD);
  int nrows = (mode == 0) ? (MT + MC) : MT;
  for (int row = blockIdx.x * 8 + wid; row < nrows; row += gridDim.x * 8) {
    if (mode == 0) {
      if (row < MT) {
        int b = row >> 11;
        const float* m = mod + (0 * 5 + b) * 6144;
        norm_row(p.x + (size_t)row * 2048, p.norm_g, m, m + 2048, (u16*)(p.ws + OFF_ACT) + (size_t)row * 2048, nullptr, lane);
      } else {
        int rc = row - MT;
        const float* m = mod + (0 * 5 + 4) * 6144;
        norm_row(p.ctx + (size_t)rc * 2048, p.norm_g, m, m + 2048, (u16*)(p.ws + OFF_HC) + (size_t)rc * 2048, nullptr, lane);
      }
    } else if (mode == 1) {
      int b = row >> 11;
      const float* m = mod + (1 * 5 + b) * 6144;
      norm_row(p.out + (size_t)row * 2048, p.norm_g + 2048, m, m + 2048, (u16*)(p.ws + OFF_ACT) + (size_t)row * 2048, nullptr, lane);
    } else {
      norm_row(p.out + (size_t)row * 2048, p.final_g, nullptr, nullptr, nullptr, p.out + (size_t)row * 2048, lane);
    }
  }
}

namespace pg8 {
#define PG8_LAS __attribute__((address_space(3)))
typedef unsigned short bf16_t;
typedef short bf16x8 __attribute__((ext_vector_type(8)));
typedef float f32x4 __attribute__((ext_vector_type(4)));
typedef unsigned u32x4 __attribute__((ext_vector_type(4)));
constexpr int BM = 256, BK = 64, HALF = 128, HTB = HALF * BK * 2  , STAGE_BYTES = 8 * HTB, NXCD = 8, WGM = 8;

__host__ __device__ __forceinline__ int lds_byte(int r, int c) { const int st = (r >> 4) * 2 + (c >> 5), rr = r & 15, cc = c & 31, ob = rr * 64 + cc * 2; return st * 1024 + (ob ^ (((ob >> 9) & 1) << 5)); }
__host__ __device__ __forceinline__ void stage_rc(int b, int& R, int& C) { const int st = b / 1024, sb = b % 1024, swz = sb ^ (((sb >> 9) & 1) << 5); R = (st >> 1) * 16 + swz / 64; C = (st & 1) * 32 + (swz % 64) / 2; }
__host__ __device__ __forceinline__ int perm32(int rho) { const int n = rho >> 4, i = rho & 15; return 8 * (i >> 2) + 4 * n + (i & 3); }

struct Unit { int pm, pn; };
struct Gemm { const bf16_t* A; const bf16_t* Bt; int M, N, K; int agroup; };

struct StaticOrder {
    int nM, nN, nwg, G, c;
    __host__ __device__ void init(int M, int N, int G_, int c_) { nM = M / BM; nN = N / BM; nwg = nM * nN; G = G_; c = c_; }
    __host__ __device__ bool next(int i, Unit& u) const {
        const long L = (long)i * G + c; if (L >= nwg) return false;
        int wgid = (int)L; { const int q = nwg / NXCD, r = nwg % NXCD, xcd = wgid % NXCD, off = wgid / NXCD; wgid = (xcd < r ? xcd * (q + 1) : r * (q + 1) + (xcd - r) * q) + off; }
        const int nig = WGM * nN, gid = wgid / nig, fm = gid * WGM, gsz = (nM - fm) < WGM ? (nM - fm) : WGM;
        u.pm = fm + ((wgid % nig) % gsz); u.pn = (wgid % nig) / gsz; return true;
    }
    __device__ __forceinline__ void a_ready(const Unit&) const {}
    __device__ __forceinline__ void done(const Unit&) const {}
};
__device__ __forceinline__ unsigned cvt_pk_bf16(float lo, float hi) { unsigned r; asm volatile("v_cvt_pk_bf16_f32 %0, %1, %2" : "=v"(r) : "v"(lo), "v"(hi)); return r; }
template <class Epi, class Sched, bool AGROUP = false>
__device__ __forceinline__ void gemm_phase(PG8_LAS unsigned char* lds, const Gemm g, const Sched& S, const Epi& E) {
    const int tid = threadIdx.x, wid = __builtin_amdgcn_readfirstlane(tid >> 6), lane = tid & 63, wr = wid >> 2, wc = wid & 3, fr = lane & 15, fq = lane >> 4;
    const int K = g.K, nt = K / BK;
    unsigned voffA[2], voffB[2];
#pragma unroll
    for (int i = 0; i < 2; ++i) { int R, C; stage_rc(tid * 16 + i * 8192, R, C); const int Rb = Epi::PERM ? ((R & ~31) + perm32(R & 31)) : R;
        voffA[i] = AGROUP ? (unsigned)((C >> 3) * g.M + R) * 16u : (unsigned)(R * K + C) * 2u; voffB[i] = (unsigned)(Rb * K + C) * 2u; }
    const size_t kstep = (size_t)(BK * 2);
    const size_t hstep = (size_t)HALF * K * 2;
    const size_t tstep = 2 * hstep;
    const size_t kstepA = AGROUP ? (size_t)(BK / 8) * g.M * 16 : kstep, hstepA = AGROUP ? (size_t)HALF * 16 : hstep, tstepA = 2 * hstepA;
    const unsigned ldsw = (unsigned)wid * 1024u;
    const int aoff = lds_byte(wr * 64 + fr, fq * 8), boff = lds_byte(wc * 32 + fr, fq * 8);
#define PG8_SA(b, h) (((b) * 2 + (h)) * HTB)
#define PG8_SB(b, h) ((4 + (b) * 2 + (h)) * HTB)
#define PG8_STAGE(bufoff, gbase, voff) do { _Pragma("unroll") for (int _i = 0; _i < 2; ++_i) \
        __builtin_amdgcn_global_load_lds((const unsigned*)((const char*)(gbase) + (voff)[_i]), (PG8_LAS unsigned*)(lds + (bufoff) + ldsw + _i * 8192), 16, 0, 0); } while (0)
#define PG8_LDA(dst, b, h) do { _Pragma("unroll") for (int m = 0; m < 4; ++m) _Pragma("unroll") for (int k = 0; k < 2; ++k) dst[m][k] = *(const PG8_LAS bf16x8*)(lds + PG8_SA(b, h) + aoff + m * 2048 + k * 1024); } while (0)
#define PG8_LDB(dst, b, h) do { _Pragma("unroll") for (int n = 0; n < 2; ++n) _Pragma("unroll") for (int k = 0; k < 2; ++k) dst[n][k] = *(const PG8_LAS bf16x8*)(lds + PG8_SB(b, h) + boff + n * 2048 + k * 1024); } while (0)
#define PG8_MMA(ai, bj, At, Bt) do { __builtin_amdgcn_s_setprio(1); _Pragma("unroll") for (int m = 0; m < 4; ++m) _Pragma("unroll") for (int n = 0; n < 2; ++n) _Pragma("unroll") for (int k = 0; k < 2; ++k) \
        acc[ai][bj][m][n] = __builtin_amdgcn_mfma_f32_16x16x32_bf16(Bt[n][k], At[m][k], acc[ai][bj][m][n], 0, 0, 0); __builtin_amdgcn_s_setprio(0); } while (0)
#define PG8_WAIT_V(n) asm volatile("s_waitcnt vmcnt(" #n ")" ::: "memory")
#define PG8_WAIT_L(n) asm volatile("s_waitcnt lgkmcnt(" #n ")" ::: "memory")
#define PG8_BAR __builtin_amdgcn_s_barrier()
#define PG8_SCHED __builtin_amdgcn_sched_barrier(0)
    Unit cur, nxt; int ui = 0;
    if (!S.next(0, cur)) return;
    f32x4 acc[2][2][4][2];
#pragma unroll
    for (int a = 0; a < 2; ++a)
#pragma unroll
        for (int b = 0; b < 2; ++b)
#pragma unroll
            for (int m = 0; m < 4; ++m)
#pragma unroll
                for (int n = 0; n < 2; ++n) acc[a][b][m][n] = (f32x4){0.f, 0.f, 0.f, 0.f};
    bf16x8 At[4][2], B0[2][2], B1[2][2];
    const char* cA = (const char*)g.A + (size_t)cur.pm * tstepA; const char* cB = (const char*)g.Bt + (size_t)cur.pn * tstep;
    S.a_ready(cur);
    PG8_STAGE(PG8_SB(0, 0), cB, voffB); PG8_STAGE(PG8_SA(0, 0), cA, voffA); PG8_STAGE(PG8_SB(0, 1), cB + hstep, voffB); PG8_STAGE(PG8_SA(0, 1), cA + hstepA, voffA);
    if (wr == 1) PG8_BAR;
    PG8_WAIT_V(4); PG8_BAR;
    PG8_STAGE(PG8_SB(1, 0), cB + kstep, voffB); PG8_STAGE(PG8_SA(1, 0), cA + kstepA, voffA); PG8_STAGE(PG8_SB(1, 1), cB + hstep + kstep, voffB);
    PG8_WAIT_V(6); PG8_BAR;
    for (;;) {
        const bool has_next = S.next(ui + 1, nxt);
        const char* nA = has_next ? (const char*)g.A + (size_t)nxt.pm * tstepA : cA; const char* nB = has_next ? (const char*)g.Bt + (size_t)nxt.pn * tstep : cB;
        for (int t = 0; t < nt; t += 2) {
            const bool last = (t == nt - 2);
            const char* a1 = cA + (size_t)(t + 1) * kstepA;
            const char* a2 = last ? nA : cA + (size_t)(t + 2) * kstepA; const char* b2 = last ? nB : cB + (size_t)(t + 2) * kstep;
            const char* a3 = a2 + kstepA; const char* b3 = b2 + kstep;
            if (last && has_next) S.a_ready(nxt);
            PG8_LDB(B0, 0, 0); PG8_SCHED; PG8_LDA(At, 0, 0); PG8_STAGE(PG8_SA(1, 1), a1 + hstepA, voffA);
            PG8_WAIT_L(8); PG8_BAR; PG8_WAIT_L(0); PG8_MMA(0, 0, At, B0); PG8_BAR; PG8_SCHED;
            PG8_LDB(B1, 0, 1); PG8_STAGE(PG8_SB(0, 0), b2, voffB);
            PG8_BAR; PG8_WAIT_L(0); PG8_MMA(0, 1, At, B1); PG8_BAR;
            PG8_LDA(At, 0, 1); PG8_STAGE(PG8_SA(0, 0), a2, voffA);
            PG8_BAR; PG8_WAIT_L(0); PG8_MMA(1, 0, At, B0); PG8_BAR; PG8_SCHED;
            PG8_STAGE(PG8_SB(0, 1), b2 + hstep, voffB);
            PG8_WAIT_V(6); PG8_BAR; PG8_MMA(1, 1, At, B1); PG8_BAR;
            PG8_LDB(B0, 1, 0); PG8_SCHED; PG8_LDA(At, 1, 0); PG8_STAGE(PG8_SA(0, 1), a2 + hstepA, voffA);
            PG8_WAIT_L(8); PG8_BAR; PG8_WAIT_L(0); PG8_MMA(0, 0, At, B0); PG8_BAR; PG8_SCHED;
            PG8_LDB(B1, 1, 1); PG8_STAGE(PG8_SB(1, 0), b3, voffB);
            PG8_BAR; PG8_WAIT_L(0); PG8_MMA(0, 1, At, B1); PG8_BAR;
            PG8_LDA(At, 1, 1); PG8_STAGE(PG8_SA(1, 0), a3, voffA);
            PG8_BAR; PG8_WAIT_L(0); PG8_MMA(1, 0, At, B0); PG8_BAR; PG8_SCHED;
            PG8_STAGE(PG8_SB(1, 1), b3 + hstep, voffB);
            PG8_WAIT_V(6); PG8_BAR; PG8_MMA(1, 1, At, B1); PG8_BAR;
        }
        if constexpr (!Epi::AFTER_DRAIN) { E(acc, cur, wr, wc, fr, fq); S.done(cur); }
        if (!has_next) break;
#pragma unroll
        for (int a = 0; a < 2; ++a)
#pragma unroll
            for (int b = 0; b < 2; ++b)
#pragma unroll
                for (int m = 0; m < 4; ++m)
#pragma unroll
                    for (int n = 0; n < 2; ++n) acc[a][b][m][n] = (f32x4){0.f, 0.f, 0.f, 0.f};
        cur = nxt; cA = nA; cB = nB; ++ui;
    }
    PG8_WAIT_V(0);
    if (wr == 0) PG8_BAR;
    PG8_BAR;
    if constexpr (Epi::AFTER_DRAIN) { E.fused(acc, cur, wr, wc, fr, fq, lds, wid, lane); S.done(cur); }
#undef PG8_SA
#undef PG8_SB
#undef PG8_STAGE
#undef PG8_LDA
#undef PG8_LDB
#undef PG8_MMA
#undef PG8_WAIT_V
#undef PG8_WAIT_L
#undef PG8_BAR
#undef PG8_SCHED
}
}

__device__ __forceinline__ uint2 pack4(pg8::f32x4 v) {
  uint2 r;
  r.x = (unsigned)f2bf(v[0]) | ((unsigned)f2bf(v[1]) << 16);
  r.y = (unsigned)f2bf(v[2]) | ((unsigned)f2bf(v[3]) << 16);
  return r;
}
struct EpiAttnIn {
  static constexpr bool PERM = false, AFTER_DRAIN = false;
  u16* O; const float* rope;
  __device__ __forceinline__ void operator()(const pg8::f32x4 (&acc)[2][2][4][2], const pg8::Unit& u, int wr, int wc, int fr, int fq) const {
    const int row0 = u.pm * 256 + wr * 64 + fr, col0 = u.pn * 256 + wc * 32 + 4 * fq;
    const bool dorope = (u.pn < 10);
    const int axis = wc >> 1, i0 = (wc & 1) * 16 + 4 * fq;
#pragma unroll
    for (int ai = 0; ai < 2; ++ai)
#pragma unroll
      for (int m = 0; m < 4; ++m) {
        const int row = row0 + ai * 128 + m * 16;
        u16* rowp = O + (size_t)row * 5120 + col0;
        if (dorope) {
          const int s = row & 2047;
          const int pos = axis ? (s & 63) : (s >> 6);
          const float4* rp = (const float4*)(rope + (pos * 32 + i0) * 2);
          float4 c01 = rp[0], c23 = rp[1];
#pragma unroll
          for (int bj = 0; bj < 2; ++bj) {
            pg8::f32x4 a = acc[ai][bj][m][0], b = acc[ai][bj][m][1], o0, o1;
            o0[0] = a[0] * c01.x - b[0] * c01.y; o1[0] = b[0] * c01.x + a[0] * c01.y;
            o0[1] = a[1] * c01.z - b[1] * c01.w; o1[1] = b[1] * c01.z + a[1] * c01.w;
            o0[2] = a[2] * c23.x - b[2] * c23.y; o1[2] = b[2] * c23.x + a[2] * c23.y;
            o0[3] = a[3] * c23.z - b[3] * c23.w; o1[3] = b[3] * c23.z + a[3] * c23.w;
            *(uint2*)(rowp + bj * 128) = pack4(o0);
            *(uint2*)(rowp + bj * 128 + 16) = pack4(o1);
          }
        } else {
#pragma unroll
          for (int bj = 0; bj < 2; ++bj) {
            *(uint2*)(rowp + bj * 128) = pack4(acc[ai][bj][m][0]);
            *(uint2*)(rowp + bj * 128 + 16) = pack4(acc[ai][bj][m][1]);
          }
        }
      }
  }
};
struct EpiRaw {
  static constexpr bool PERM = false, AFTER_DRAIN = false;
  u16* O; int ldc;
  __device__ __forceinline__ void operator()(const pg8::f32x4 (&acc)[2][2][4][2], const pg8::Unit& u, int wr, int wc, int fr, int fq) const {
    const int row0 = u.pm * 256 + wr * 64 + fr, col0 = u.pn * 256 + wc * 32 + 4 * fq;
#pragma unroll
    for (int ai = 0; ai < 2; ++ai)
#pragma unroll
      for (int m = 0; m < 4; ++m) {
        u16* rowp = O + (size_t)(row0 + ai * 128 + m * 16) * ldc + col0;
#pragma unroll
        for (int bj = 0; bj < 2; ++bj) {
          *(uint2*)(rowp + bj * 128) = pack4(acc[ai][bj][m][0]);
          *(uint2*)(rowp + bj * 128 + 16) = pack4(acc[ai][bj][m][1]);
        }
      }
  }
};
struct EpiRes {
  static constexpr bool PERM = false, AFTER_DRAIN = false;
  float* out; const float* base; const float* gate;
  __device__ __forceinline__ void operator()(const pg8::f32x4 (&acc)[2][2][4][2], const pg8::Unit& u, int wr, int wc, int fr, int fq) const {
    const int row0 = u.pm * 256 + wr * 64 + fr, col0 = u.pn * 256 + wc * 32 + 4 * fq;
    const int b = (u.pm * 256) >> 11;
    pg8::f32x4 gv[2][2];
#pragma unroll
    for (int bj = 0; bj < 2; ++bj)
#pragma unroll
      for (int n = 0; n < 2; ++n) gv[bj][n] = *(const pg8::f32x4*)(gate + b * 6144 + col0 + bj * 128 + n * 16);
#pragma unroll
    for (int ai = 0; ai < 2; ++ai)
#pragma unroll
      for (int m = 0; m < 4; ++m) {
        const size_t off = (size_t)(row0 + ai * 128 + m * 16) * 2048 + col0;
#pragma unroll
        for (int bj = 0; bj < 2; ++bj)
#pragma unroll
          for (int n = 0; n < 2; ++n) {
            pg8::f32x4 bv = *(const pg8::f32x4*)(base + off + bj * 128 + n * 16);
            *(pg8::f32x4*)(out + off + bj * 128 + n * 16) = bv + gv[bj][n] * acc[ai][bj][m][n];
          }
      }
  }
};

struct EpiResNorm {
  static constexpr bool PERM = false, AFTER_DRAIN = true;
  float* out; const float* base; const float* gate;
  float* rowss; unsigned* pcnt;
  const float* g; const float* shsc;
  u16* hx;
  __device__ __forceinline__ void fused(pg8::f32x4 (&acc)[2][2][4][2], const pg8::Unit& u, int wr, int wc, int fr, int fq,
                                        PG8_LAS unsigned char*, int, int) const {
    const int row0 = u.pm * 256 + wr * 64 + fr, col0 = u.pn * 256 + wc * 32 + 4 * fq;
    const int b = (u.pm * 256) >> 11;
    {
      pg8::f32x4 gv[2][2];
#pragma unroll
      for (int bj = 0; bj < 2; ++bj)
#pragma unroll
        for (int n = 0; n < 2; ++n) gv[bj][n] = *(const pg8::f32x4*)(gate + b * 6144 + col0 + bj * 128 + n * 16);
#pragma unroll
      for (int ai = 0; ai < 2; ++ai)
#pragma unroll
        for (int m = 0; m < 4; ++m) {
          const int row = row0 + ai * 128 + m * 16;
          const size_t off = (size_t)row * 2048 + col0;
          float ss = 0.f;
#pragma unroll
          for (int bj = 0; bj < 2; ++bj)
#pragma unroll
            for (int n = 0; n < 2; ++n) {
              const pg8::f32x4 bv = *(const pg8::f32x4*)(base + off + bj * 128 + n * 16);
              const pg8::f32x4 v = bv + gv[bj][n] * acc[ai][bj][m][n];
              acc[ai][bj][m][n] = v;
              ss += v[0] * v[0] + v[1] * v[1] + v[2] * v[2] + v[3] * v[3];
            }
          ss += __shfl_xor(ss, 16, 64);
          ss += __shfl_xor(ss, 32, 64);
          if (fq == 0) unsafeAtomicAdd(rowss + row, ss);
        }
    }
    asm volatile("s_waitcnt vmcnt(0)" ::: "memory");
    __syncthreads();
    if (threadIdx.x == 0) {
      unsigned* c = pcnt + u.pm * 64;
      __hip_atomic_fetch_add(c, 1u, __ATOMIC_RELAXED, __HIP_MEMORY_SCOPE_AGENT);
      unsigned spins = 0;
      while (__hip_atomic_load(c, __ATOMIC_RELAXED, __HIP_MEMORY_SCOPE_AGENT) < 8u && ++spins < (1u << 22)) __builtin_amdgcn_s_sleep(1);
    }
    __syncthreads();
    float rr[2][4];
#pragma unroll
    for (int ai = 0; ai < 2; ++ai)
#pragma unroll
      for (int m = 0; m < 4; ++m) {
        const float ss = __hip_atomic_load(rowss + row0 + ai * 128 + m * 16, __ATOMIC_RELAXED, __HIP_MEMORY_SCOPE_AGENT);
        rr[ai][m] = rsqrtf(ss * (1.f / 2048.f) + 1e-6f);
      }
#pragma unroll
    for (int bj = 0; bj < 2; ++bj)
#pragma unroll
      for (int n = 0; n < 2; ++n) {
        const int cofs = bj * 128 + n * 16;
        const pg8::f32x4 gg = *(const pg8::f32x4*)(g + col0 + cofs);
        pg8::f32x4 sh = gg, sc = gg;
        if (hx) {
          sh = *(const pg8::f32x4*)(shsc + b * 6144 + col0 + cofs);
          sc = *(const pg8::f32x4*)(shsc + b * 6144 + 2048 + col0 + cofs) + 1.f;
        }
#pragma unroll
        for (int ai = 0; ai < 2; ++ai)
#pragma unroll
          for (int m = 0; m < 4; ++m) {
            const size_t off = (size_t)(row0 + ai * 128 + m * 16) * 2048 + col0 + cofs;
            const pg8::f32x4 v = acc[ai][bj][m][n];
            pg8::f32x4 o = v * rr[ai][m] * gg;
            if (hx) {
              *(pg8::f32x4*)(out + off) = v;
              o = o * sc + sh;
              *(uint2*)(hx + off) = pack4(o);
            } else {
              *(pg8::f32x4*)(out + off) = o;
            }
          }
      }
  }
};
template <class Epi, bool AGROUP = false>
__device__ __forceinline__ void run_gemm(float* sm, const u16* A, const u16* Bt, int M, int N, const Epi& E, int c) {
  pg8::Gemm g{A, Bt, M, N, 2048, AGROUP ? 1 : 0};
  pg8::StaticOrder S; S.init(M, N, (int)gridDim.x, c);
  pg8::gemm_phase<Epi, pg8::StaticOrder, AGROUP>((PG8_LAS unsigned char*)sm, g, S, E);
  __syncthreads();
}

template <int MODE>
__device__ __forceinline__ void epi_pair(const Params& p, int m, int n, float a0, float a1) {
  if (MODE == 1) {
    u16* px = (u16*)(p.ws + OFF_BIG);
    float o0 = a0, o1 = a1;
    if (n < 2560) {
      int g = (n >> 5) & 3, fr = n & 15;
      int axis = g >> 1, i = (g & 1) * 16 + fr;
      int s = m & 2047;
      int pos = axis ? (s & 63) : (s >> 6);
      float2 cs = ((const float2*)(p.ws + OFF_ROPE))[pos * 32 + i];
      o0 = a0 * cs.x - a1 * cs.y;
      o1 = a1 * cs.x + a0 * cs.y;
    }
    px[(size_t)m * 5120 + n] = f2bf(o0);
    px[(size_t)m * 5120 + n + 16] = f2bf(o1);
  } else if (MODE == 5) {
    u16* kvc = (u16*)(p.ws + OFF_KVC);
    kvc[(size_t)m * 1024 + n] = f2bf(a0);
    kvc[(size_t)m * 1024 + n + 16] = f2bf(a1);
  } else if (MODE == 2) {
    const float* mod = (const float*)(p.ws + OFF_MOD);
    int b = m >> 11;
    const float* gate = mod + (0 * 5 + b) * 6144 + 4096;
    p.out[(size_t)m * 2048 + n] = p.x[(size_t)m * 2048 + n] + gate[n] * a0;
    p.out[(size_t)m * 2048 + n + 16] = p.x[(size_t)m * 2048 + n + 16] + gate[n + 16] * a1;
  } else if (MODE == 3) {
    u16* pp = (u16*)(p.ws + OFF_BIG);
    pp[(size_t)m * 8192 + n] = f2bf(a0);
    pp[(size_t)m * 8192 + n + 16] = f2bf(a1);
  } else if (MODE == 4) {
    const float* mod = (const float*)(p.ws + OFF_MOD);
    int b = m >> 11;
    const float* gate = mod + (1 * 5 + b) * 6144 + 4096;
    p.out[(size_t)m * 2048 + n] += gate[n] * a0;
    p.out[(size_t)m * 2048 + n + 16] += gate[n + 16] * a1;
  }
}

template <int MODE>
__device__ __forceinline__ void naive_gemm(const Params& p, const u16* __restrict__ A, const u16* __restrict__ Wt, int M, int N) {
  const int tid = threadIdx.x;
  const int ml = tid >> 5, pl = tid & 31;
  const int ntn = N / 64, ntm = M / 16;
  for (int tile = blockIdx.x; tile < ntn * ntm; tile += gridDim.x) {
    int tm = tile / ntn, tn = tile % ntn;
    int m = tm * 16 + ml;
    int n = tn * 64 + (pl >> 4) * 32 + (pl & 15);
    const uint4* a = (const uint4*)(A + (size_t)m * 2048);
    const uint4* w0 = (const uint4*)(Wt + (size_t)n * 2048);
    const uint4* w1 = (const uint4*)(Wt + (size_t)(n + 16) * 2048);
    float acc0 = 0.f, acc1 = 0.f;
#pragma unroll 2
    for (int k = 0; k < 256; ++k) {
      uint4 av = a[k], b0 = w0[k], b1 = w1[k];
      acc0 += bflo(av.x) * bflo(b0.x) + bfhi(av.x) * bfhi(b0.x) + bflo(av.y) * bflo(b0.y) + bfhi(av.y) * bfhi(b0.y)
            + bflo(av.z) * bflo(b0.z) + bfhi(av.z) * bfhi(b0.z) + bflo(av.w) * bflo(b0.w) + bfhi(av.w) * bfhi(b0.w);
      acc1 += bflo(av.x) * bflo(b1.x) + bfhi(av.x) * bfhi(b1.x) + bflo(av.y) * bflo(b1.y) + bfhi(av.y) * bfhi(b1.y)
            + bflo(av.z) * bflo(b1.z) + bfhi(av.z) * bfhi(b1.z) + bflo(av.w) * bflo(b1.w) + bfhi(av.w) * bfhi(b1.w);
    }
    epi_pair<MODE>(p, m, n, acc0, acc1);
  }
}

__device__ __forceinline__ void phase_attn_naive(const Params& p, float* sm) {
  const int wid = threadIdx.x >> 6, lane = threadIdx.x & 63;
  float* qs = sm + wid * (128 + 640);
  float* pr = qs + 128;
  const u16* px = (const u16*)(p.ws + OFF_BIG);
  const u16* kvc = (const u16*)(p.ws + OFF_KVC);
  u16* og = (u16*)(p.ws + OFF_ACT);
  const float scale = 0.08838834764831845f;
  for (int item = blockIdx.x * 8 + wid; item < MT * 16; item += gridDim.x * 8) {
    int m = item >> 4, h = item & 15;
    int b = m >> 11, s = m & 2047, kvh = h >> 2, nblk = s >> 7;
    const u16* qrow = px + (size_t)m * 5120 + h * 128;
    qs[lane] = bf2f(qrow[lane]) * scale;
    qs[lane + 64] = bf2f(qrow[lane + 64]) * scale;
    asm volatile("s_waitcnt lgkmcnt(0)" ::: "memory");
    float mx = p.attn_sink[h];
#pragma unroll 1
    for (int j = 0; j < 10; ++j) {
      int kidx = j * 64 + lane;
      const u16* krow;
      bool valid;
      if (kidx < 384) {
        int kpos = (nblk - 1) * 128 + kidx;
        int rel = kpos - s;
        valid = (kpos >= 0) && (kpos < 2048) && (rel <= 128) && (rel >= -128);
        krow = px + (size_t)(b * 2048 + (valid ? kpos : 0)) * 5120 + 2048 + kvh * 128;
      } else {
        valid = true;
        krow = kvc + (size_t)(b * 256 + (kidx - 384)) * 1024 + kvh * 128;
      }
      float d = -1e30f;
      if (valid) {
        d = 0.f;
#pragma unroll 4
        for (int c = 0; c < 16; ++c) {
          uint4 kk = *(const uint4*)(krow + c * 8);
          const float* q8 = qs + c * 8;
          d += q8[0] * bflo(kk.x) + q8[1] * bfhi(kk.x) + q8[2] * bflo(kk.y) + q8[3] * bfhi(kk.y)
             + q8[4] * bflo(kk.z) + q8[5] * bfhi(kk.z) + q8[6] * bflo(kk.w) + q8[7] * bfhi(kk.w);
        }
      }
      pr[kidx] = d;
      mx = fmaxf(mx, d);
    }
    mx = wave_max(mx);
    float sum = 0.f;
#pragma unroll 1
    for (int j = 0; j < 10; ++j) {
      float d = pr[j * 64 + lane];
      float e = (d > -1e29f) ? __expf(d - mx) : 0.f;
      pr[j * 64 + lane] = e;
      sum += e;
    }
    sum = wave_sum(sum);
    sum += __expf(p.attn_sink[h] - mx);
    asm volatile("s_waitcnt lgkmcnt(0)" ::: "memory");
    float o0 = 0.f, o1 = 0.f;
    int k0 = s - 128 < 0 ? 0 : s - 128, k1 = s + 128 > 2047 ? 2047 : s + 128;
    for (int kpos = k0; kpos <= k1; ++kpos) {
      float pv = pr[kpos - (nblk - 1) * 128];
      unsigned vv = *(const unsigned*)(px + (size_t)(b * 2048 + kpos) * 5120 + 2560 + kvh * 128 + lane * 2);
      o0 += pv * bflo(vv); o1 += pv * bfhi(vv);
    }
    for (int c = 0; c < 256; ++c) {
      float pv = pr[384 + c];
      unsigned vv = *(const unsigned*)(kvc + (size_t)(b * 256 + c) * 1024 + 512 + kvh * 128 + lane * 2);
      o0 += pv * bflo(vv); o1 += pv * bfhi(vv);
    }
    float inv = 1.f / sum;
    unsigned gg = *(const unsigned*)(px + (size_t)m * 5120 + 3072 + h * 128 + lane * 2);
    float r0 = o0 * inv * siluf(bflo(gg)), r1 = o1 * inv * siluf(bfhi(gg));
    *(unsigned*)(og + (size_t)m * 2048 + h * 128 + lane * 2) = (unsigned)f2bf(r0) | ((unsigned)f2bf(r1) << 16);
    asm volatile("s_waitcnt lgkmcnt(0)" ::: "memory");
  }
}

__device__ __forceinline__ float sconv(const u16* pp, const float* cw, const float* cb, int b, int t, int c) {
  const u16* base = pp + (size_t)(b * 2048 + t) * 8192 + c;
  float v = cw[6144 + c] * bf2f(base[0]) + cb[c];
  if (t > 0) v += cw[c] * bf2f(base[-8192]);
  if (t < 2047) v += cw[2 * 6144 + c] * bf2f(base[8192]);
  return v;
}

__device__ __forceinline__ void phase_conv_naive(const Params& p, float* sm) {
  const int tid = threadIdx.x;
  float* u = sm;
  float* R = sm + 8192;
  const u16* pp = (const u16*)(p.ws + OFF_BIG);
  const u16* Rg = (const u16*)(p.ws + OFF_FILT);
  u16* yg = (u16*)(p.ws + OFF_ACT);
  for (int ch = blockIdx.x; ch < 2048; ch += gridDim.x) {
    for (int i = tid; i < 8192; i += NTHREADS) u[i] = sconv(pp, p.hy_conv_w, p.hy_conv_b, i >> 11, i & 2047, 4096 + ch);
    for (int i = tid; i < 4096; i += NTHREADS) R[i] = bf2f(Rg[((size_t)0 * 2048 + ch) * 4096 + i]);
    __syncthreads();
    float zr[16];
#pragma unroll
    for (int q = 0; q < 16; ++q) {
      int i = tid + q * NTHREADS;
      int b = i >> 11, t = i & 2047;
      const float* ub = u + b * 2048;
      const float* Rb = R + 2048 - t;
      float a = 0.f;
      for (int s = 0; s < 2048; ++s) a += Rb[s] * ub[s];
      zr[q] = a * sconv(pp, p.hy_conv_w, p.hy_conv_b, b, t, ch);
    }
    __syncthreads();
#pragma unroll
    for (int q = 0; q < 16; ++q) u[tid + q * NTHREADS] = zr[q];
    for (int i = tid; i < 4096; i += NTHREADS) R[i] = bf2f(Rg[((size_t)1 * 2048 + ch) * 4096 + i]);
    __syncthreads();
#pragma unroll
    for (int q = 0; q < 16; ++q) {
      int i = tid + q * NTHREADS;
      int b = i >> 11, t = i & 2047;
      const float* ub = u + b * 2048;
      const float* Rb = R + 2048 - t;
      float a = 0.f;
      for (int s = 0; s < 2048; ++s) a += Rb[s] * ub[s];
      float y = a * sconv(pp, p.hy_conv_w, p.hy_conv_b, b, t, 2048 + ch);
      float g = bf2f(pp[(size_t)(b * 2048 + t) * 8192 + 6144 + ch]);
      yg[(size_t)(b * 2048 + t) * 2048 + ch] = f2bf(y * siluf(g));
    }
    __syncthreads();
  }
}


typedef float f32x16 __attribute__((ext_vector_type(16)));
typedef pg8::bf16x8 bfx8;
constexpr int CONV_RF_BYTES = 4 * 8192;
constexpr int CONV_UB_ONE = 192 * 64;
__device__ __forceinline__ int ub_addr(int col, int chunk) { return col * 64 + ((chunk ^ ((col >> 2) & 3)) << 4); }

__device__ __forceinline__ void conv_mfma(const char* Rf_ci, const char* Ub_w, int lane, f32x16 (&acc)[4]) {
  const int t2 = lane & 31, h = lane >> 5, n = lane & 31;
  const unsigned sh = (unsigned)(t2 & 1) * 16u;
  const int lanedw = (2048 - t2 + 8 * h) >> 1;
#pragma unroll
  for (int j = 0; j < 4; ++j)
#pragma unroll
    for (int r = 0; r < 16; ++r) acc[j][r] = 0.f;
#pragma unroll 1
  for (int f = 0; f < 16; ++f) {
    bfx8 Bw[5][2];
#pragma unroll
    for (int m = 0; m < 5; ++m) {
      const int col = (16 * m - f + 16) * 2 + n;
#pragma unroll
      for (int kh = 0; kh < 2; ++kh) Bw[m][kh] = *(const bfx8*)(Ub_w + ub_addr(col, 2 * kh + h));
    }
    const unsigned* Rp = (const unsigned*)Rf_ci + lanedw - 16 * f;
#pragma unroll
    for (int e = -4; e <= 3; ++e) {
      int ee = e;
      if (e == -4) ee = (f == 0) ? -3 : -4;
      bfx8 A[2];
#pragma unroll
      for (int kh = 0; kh < 2; ++kh) {
        const unsigned* q = Rp - 256 * ee + 8 * kh;
        unsigned w0 = q[0], w1 = q[1], w2 = q[2], w3 = q[3], w4 = q[4];
        pg8::u32x4 pk;
        pk[0] = __builtin_amdgcn_alignbit(w1, w0, sh);
        pk[1] = __builtin_amdgcn_alignbit(w2, w1, sh);
        pk[2] = __builtin_amdgcn_alignbit(w3, w2, sh);
        pk[3] = __builtin_amdgcn_alignbit(w4, w3, sh);
        A[kh] = __builtin_bit_cast(bfx8, pk);
      }
#pragma unroll
      for (int j = 0; j < 4; ++j) {
        const int m = j - e;
        if (m >= 0 && m <= 4) acc[j] = __builtin_amdgcn_mfma_f32_32x32x16_bf16(A[0], Bw[m][0], acc[j], 0, 0, 0);
      }
#pragma unroll
      for (int j = 0; j < 4; ++j) {
        const int m = j - e;
        if (m >= 0 && m <= 4) acc[j] = __builtin_amdgcn_mfma_f32_32x32x16_bf16(A[1], Bw[m][1], acc[j], 0, 0, 0);
      }
    }
  }
}

__device__ __forceinline__ void sconv4(const u16* xp, int t, float w0, float w1, float w2, float cb, float (&o)[4]) {
  uint2 x4 = *(const uint2*)xp;
  float pv = t > 0 ? bf2f(xp[-1]) : 0.f;
  float nx = (t + 4 < 2048) ? bf2f(xp[4]) : 0.f;
  float e0 = bflo(x4.x), e1 = bfhi(x4.x), e2 = bflo(x4.y), e3 = bfhi(x4.y);
  o[0] = w0 * pv + w1 * e0 + w2 * e1 + cb;
  o[1] = w0 * e0 + w1 * e1 + w2 * e2 + cb;
  o[2] = w0 * e1 + w1 * e2 + w2 * e3 + cb;
  o[3] = w0 * e2 + w1 * e3 + w2 * nx + cb;
}

struct SC4 { uint2 x; unsigned pn; };
__device__ __forceinline__ SC4 sc4_load(const u16* xp, int t) {
  SC4 r;
  r.x = *(const uint2*)xp;
  const unsigned pv = t > 0 ? (unsigned)xp[-1] : 0u;
  const unsigned nx = (t + 4 < 2048) ? (unsigned)xp[4] : 0u;
  r.pn = pv | (nx << 16);
  return r;
}
__device__ __forceinline__ void sc4_apply(const SC4& r, float w0, float w1, float w2, float cb, float (&o)[4]) {
  const float pv = bflo(r.pn), nx = bfhi(r.pn);
  const float e0 = bflo(r.x.x), e1 = bfhi(r.x.x), e2 = bflo(r.x.y), e3 = bfhi(r.x.y);
  o[0] = w0 * pv + w1 * e0 + w2 * e1 + cb;
  o[1] = w0 * e0 + w1 * e1 + w2 * e2 + cb;
  o[2] = w0 * e1 + w1 * e2 + w2 * e3 + cb;
  o[3] = w0 * e2 + w1 * e3 + w2 * nx + cb;
}

__device__ __forceinline__ void phase_conv(const Params& p, float* smf) {
  char* sm = (char*)smf;
  char* Rf = sm;
  char* Ub = sm + CONV_RF_BYTES;
  int tid = threadIdx.x;
  asm volatile("" : "+v"(tid));
  const int wid = tid >> 6, lane = tid & 63;
  const int ci = wid >> 1, bp = wid & 1;
  const u16* pT = (const u16*)(p.ws + OFF_BIG);
  const u16* Rg = (const u16*)(p.ws + OFF_FILT);
  u16* yg = (u16*)(p.ws + OFF_ACT);
  for (int kk = 0; kk < 8 * CONV_UB_ONE / 16 / NTHREADS; ++kk) ((uint4*)Ub)[tid + kk * NTHREADS] = make_uint4(0, 0, 0, 0);
  __syncthreads();
  char* Ub_w = Ub + (ci * 2 + bp) * CONV_UB_ONE;
  const char* Rf_ci = Rf + ci * 8192;
  const int h = lane >> 5, n = lane & 31;
  for (int it0 = blockIdx.x * 2; it0 < 512; it0 += gridDim.x * 2)
#pragma unroll 1
  for (int sub = 0; sub < 2; ++sub) {
    const int item = it0 + sub;
    const int ch0 = item * 4;
    {
      const int q = tid & 255, hb = tid >> 8;
      uint4 x8[8]; unsigned pn[8]; uint4 fr[4];
#pragma unroll
      for (int k = 0; k < 8; ++k) {
        const int cc = 4096 + ch0 + (k >> 1), b = (k & 1) * 2 + hb;
        const u16* xp = pT + (size_t)cc * 8192 + b * 2048 + q * 8;
        x8[k] = *(const uint4*)xp;
        const unsigned pv = q > 0 ? (unsigned)xp[-1] : 0u;
        const unsigned nx = q < 255 ? (unsigned)xp[8] : 0u;
        pn[k] = pv | (nx << 16);
      }
#pragma unroll
      for (int k = 0; k < 4; ++k) fr[k] = ((const uint4*)(Rg + ((size_t)0 * 2048 + ch0 + k) * 4096))[tid];
#pragma unroll
      for (int k = 0; k < 8; ++k) {
        const int c = k >> 1, cc = 4096 + ch0 + c, b = (k & 1) * 2 + hb;
        const float w0 = p.hy_conv_w[cc], w1 = p.hy_conv_w[6144 + cc], w2 = p.hy_conv_w[2 * 6144 + cc], cb = p.hy_conv_b[cc];
        float e[10];
        e[0] = bflo(pn[k]); e[1] = bflo(x8[k].x); e[2] = bfhi(x8[k].x); e[3] = bflo(x8[k].y); e[4] = bfhi(x8[k].y);
        e[5] = bflo(x8[k].z); e[6] = bfhi(x8[k].z); e[7] = bflo(x8[k].w); e[8] = bfhi(x8[k].w); e[9] = bfhi(pn[k]);
        unsigned o[4];
#pragma unroll
        for (int kk = 0; kk < 4; ++kk) {
          float a = w0 * e[2 * kk] + w1 * e[2 * kk + 1] + w2 * e[2 * kk + 2] + cb;
          float bb = w0 * e[2 * kk + 1] + w1 * e[2 * kk + 2] + w2 * e[2 * kk + 3] + cb;
          o[kk] = (unsigned)f2bf(a) | ((unsigned)f2bf(bb) << 16);
        }
        const int t0 = q * 8, s1 = t0 >> 5, s2 = t0 & 31;
        const int col = (s1 + 16) * 2 + (b & 1);
        *(uint4*)(Ub + (c * 2 + (b >> 1)) * CONV_UB_ONE + ub_addr(col, s2 >> 3)) = make_uint4(o[0], o[1], o[2], o[3]);
      }
#pragma unroll
      for (int k = 0; k < 4; ++k) ((uint4*)(Rf + k * 8192))[tid] = fr[k];
    }
    __syncthreads();
    f32x16 acc[4];
    const int ch = ch0 + ci;
    {
      conv_mfma(Rf_ci, Ub_w, lane, acc);
      SC4 xr[16];
#pragma unroll
      for (int j = 0; j < 4; ++j)
#pragma unroll
        for (int vg = 0; vg < 4; ++vg) {
          const int t1 = 16 * j + (n >> 1), b = 2 * bp + (n & 1), t = 32 * t1 + 8 * vg + 4 * h;
          xr[j * 4 + vg] = sc4_load(pT + (size_t)ch * 8192 + b * 2048 + t, t);
        }
      const uint4 f1a = ((const uint4*)(Rg + ((size_t)1 * 2048 + ch0 + 0) * 4096))[tid];
      const uint4 f1b = ((const uint4*)(Rg + ((size_t)1 * 2048 + ch0 + 1) * 4096))[tid];
      const uint4 f1c = ((const uint4*)(Rg + ((size_t)1 * 2048 + ch0 + 2) * 4096))[tid];
      const uint4 f1d = ((const uint4*)(Rg + ((size_t)1 * 2048 + ch0 + 3) * 4096))[tid];
      const float w0 = p.hy_conv_w[ch], w1 = p.hy_conv_w[6144 + ch], w2 = p.hy_conv_w[2 * 6144 + ch], cb = p.hy_conv_b[ch];
#pragma unroll
      for (int j = 0; j < 4; ++j)
#pragma unroll
        for (int vg = 0; vg < 4; ++vg) {
          const int t1 = 16 * j + (n >> 1), bl = n & 1;
          float x1[4];
          sc4_apply(xr[j * 4 + vg], w0, w1, w2, cb, x1);
          uint2 pk;
          pk.x = (unsigned)f2bf(x1[0] * acc[j][4 * vg + 0]) | ((unsigned)f2bf(x1[1] * acc[j][4 * vg + 1]) << 16);
          pk.y = (unsigned)f2bf(x1[2] * acc[j][4 * vg + 2]) | ((unsigned)f2bf(x1[3] * acc[j][4 * vg + 3]) << 16);
          const int col = (t1 + 16) * 2 + bl;
          *(uint2*)(Ub_w + ub_addr(col, vg) + 8 * h) = pk;
        }
      __syncthreads();
      ((uint4*)(Rf + 0 * 8192))[tid] = f1a;
      ((uint4*)(Rf + 1 * 8192))[tid] = f1b;
      ((uint4*)(Rf + 2 * 8192))[tid] = f1c;
      ((uint4*)(Rf + 3 * 8192))[tid] = f1d;
    }
    __syncthreads();
    {
      const int c2 = 2048 + ch;
      SC4 xr[16]; uint2 gr[16];
      conv_mfma(Rf_ci, Ub_w, lane, acc);
#pragma unroll
      for (int j = 0; j < 4; ++j)
#pragma unroll
        for (int vg = 0; vg < 4; ++vg) {
          const int t1 = 16 * j + (n >> 1), b = 2 * bp + (n & 1), t = 32 * t1 + 8 * vg + 4 * h;
          xr[j * 4 + vg] = sc4_load(pT + (size_t)c2 * 8192 + b * 2048 + t, t);
          gr[j * 4 + vg] = *(const uint2*)(pT + (size_t)(6144 + ch) * 8192 + b * 2048 + t);
        }
      const float w0 = p.hy_conv_w[c2], w1 = p.hy_conv_w[6144 + c2], w2 = p.hy_conv_w[2 * 6144 + c2], cb = p.hy_conv_b[c2];
#pragma unroll
      for (int j = 0; j < 4; ++j)
#pragma unroll
        for (int vg = 0; vg < 4; ++vg) {
          const int t1 = 16 * j + (n >> 1), bl = n & 1;
          float x2[4];
          sc4_apply(xr[j * 4 + vg], w0, w1, w2, cb, x2);
          const uint2 g4 = gr[j * 4 + vg];
          float y0 = x2[0] * acc[j][4 * vg + 0] * siluf(bflo(g4.x));
          float y1 = x2[1] * acc[j][4 * vg + 1] * siluf(bfhi(g4.x));
          float y2 = x2[2] * acc[j][4 * vg + 2] * siluf(bflo(g4.y));
          float y3 = x2[3] * acc[j][4 * vg + 3] * siluf(bfhi(g4.y));
          uint2 pk;
          pk.x = (unsigned)f2bf(y0) | ((unsigned)f2bf(y1) << 16);
          pk.y = (unsigned)f2bf(y2) | ((unsigned)f2bf(y3) << 16);
          const int col = (t1 + 16) * 2 + bl;
          *(uint2*)(Ub_w + ub_addr(col, vg) + 8 * h) = pk;
        }
    }
    __syncthreads();
    int tw = tid;
    asm volatile("" : "+v"(tw));
#pragma unroll 4
    for (int kk = 0; kk < 16; ++kk) {
      const int idx = tw + kk * NTHREADS;
      const int b = idx >> 11, t = idx & 2047;
      const int s1 = t >> 5, s2 = t & 31;
      const int col = (s1 + 16) * 2 + (b & 1);
      const int a = ub_addr(col, s2 >> 3) + (s2 & 7) * 2;
      const char* base = Ub + (b >> 1) * CONV_UB_ONE + a;
      unsigned v0 = *(const u16*)(base + 0 * 2 * CONV_UB_ONE), v1 = *(const u16*)(base + 1 * 2 * CONV_UB_ONE);
      unsigned v2 = *(const u16*)(base + 2 * 2 * CONV_UB_ONE), v3 = *(const u16*)(base + 3 * 2 * CONV_UB_ONE);
      const uint2 cur = make_uint2(v0 | (v1 << 16), v2 | (v3 << 16));
      *(uint2*)(yg + ((size_t)(item >> 1) * 8192 + idx) * 8 + (item & 1) * 4) = cur;
    }
    __syncthreads();
  }
}

constexpr int AT_KROW = 272, AT_VROW = 136;
constexpr int AT_K_BYTES = 64 * AT_KROW, AT_V_BYTES = 128 * AT_VROW;
__device__ __forceinline__ void phase_attn(const Params& p, float* smf) {
  char* sm = (char*)smf;
  char* Ks = sm;
  char* Vs = sm + AT_K_BYTES;
  const int tid = threadIdx.x, wid = tid >> 6, lane = tid & 63, r = lane & 31, h = lane >> 5;
  const u16* px = (const u16*)(p.ws + OFF_BIG);
  const u16* kvc = (const u16*)(p.ws + OFF_KVC);
  const u16* vT = (const u16*)(p.ws + OFF_VT);
  const u16* vcT = (const u16*)(p.ws + OFF_VCT);
  u16* og = (u16*)(p.ws + OFF_ACT);
  const float LOG2E = 1.4426950408889634f;
  const float sl2 = 0.08838834764831845f * LOG2E;
  for (int item = blockIdx.x; item < 512; item += gridDim.x) {
    const int hp = item & 1, kvh = (item >> 1) & 3, nblk = (item >> 3) & 15, b = item >> 7;
    const int hq = kvh * 4 + hp * 2 + (wid >> 2);
    const int qs = nblk * 128 + (wid & 3) * 32 + r;
    bfx8 Q[8];
    {
      const u16* qrow = px + (size_t)(b * 2048 + qs) * 5120 + hq * 128 + 8 * h;
#pragma unroll
      for (int st = 0; st < 8; ++st) Q[st] = *(const bfx8*)(qrow + 16 * st);
    }
    f32x16 O[4];
#pragma unroll
    for (int dt = 0; dt < 4; ++dt)
#pragma unroll
      for (int i = 0; i < 16; ++i) O[dt][i] = 0.f;
    float m = p.attn_sink[hq] * LOG2E;
    float l = (h == 0) ? 1.f : 0.f;
    const int first = (nblk == 0) ? 2 : 0, lastlocal = (nblk == 15) ? 3 : 5;
    uint4 kreg0, kreg1, vreg0, vreg1;
#define AT_LOAD_TILE(TI) do { \
      const int _ti = (TI); const bool _loc = _ti < 6; \
      const int _kpos0 = 128 * (nblk - 1) + 64 * _ti, _c0 = 64 * (_ti - 6); \
      const u16* _kb = _loc ? px + (size_t)(b * 2048 + _kpos0) * 5120 + 2048 + kvh * 128 : kvc + (size_t)(b * 256 + _c0) * 1024 + kvh * 128; \
      const size_t _ks = _loc ? 5120 : 1024; \
      const u16* _vb = _loc ? vT + (size_t)(kvh * 128) * 8192 + b * 2048 + _kpos0 : vcT + (size_t)(kvh * 128) * 1024 + b * 256 + _c0; \
      const size_t _vs = _loc ? 8192 : 1024; \
      const int _c1 = tid + NTHREADS; \
      kreg0 = *(const uint4*)(_kb + (size_t)(tid >> 4) * _ks + (tid & 15) * 8); \
      kreg1 = *(const uint4*)(_kb + (size_t)(_c1 >> 4) * _ks + (_c1 & 15) * 8); \
      vreg0 = *(const uint4*)(_vb + (size_t)(tid >> 3) * _vs + (tid & 7) * 8); \
      vreg1 = *(const uint4*)(_vb + (size_t)(_c1 >> 3) * _vs + (_c1 & 7) * 8); \
    } while (0)
    int ti = first;
    AT_LOAD_TILE(ti);
    while (true) {
      __syncthreads();
      {
        const int c1 = tid + NTHREADS;
        *(uint4*)(Ks + (tid >> 4) * AT_KROW + (tid & 15) * 16) = kreg0;
        *(uint4*)(Ks + (c1 >> 4) * AT_KROW + (c1 & 15) * 16) = kreg1;
        char* v0p = Vs + (tid >> 3) * AT_VROW + (tid & 7) * 16;
        char* v1p = Vs + (c1 >> 3) * AT_VROW + (c1 & 7) * 16;
        *(uint2*)(v0p) = make_uint2(vreg0.x, vreg0.y);
        *(uint2*)(v0p + 8) = make_uint2(vreg0.z, vreg0.w);
        *(uint2*)(v1p) = make_uint2(vreg1.x, vreg1.y);
        *(uint2*)(v1p + 8) = make_uint2(vreg1.z, vreg1.w);
      }
      __syncthreads();
      int tn = ti + 1;
      if (tn > lastlocal && tn < 6) tn = 6;
      if (tn < 10) AT_LOAD_TILE(tn);
      {
        const bool local = ti < 6;
        const int kpos0 = 128 * (nblk - 1) + 64 * ti;
        f32x16 S[2];
#pragma unroll
        for (int ks = 0; ks < 2; ++ks) {
#pragma unroll
          for (int i = 0; i < 16; ++i) S[ks][i] = 0.f;
#pragma unroll
          for (int st = 0; st < 8; ++st) {
            bfx8 A = *(const bfx8*)(Ks + (ks * 32 + r) * AT_KROW + (16 * st + 8 * h) * 2);
            S[ks] = __builtin_amdgcn_mfma_f32_32x32x16_bf16(A, Q[st], S[ks], 0, 0, 0);
          }
        }
        float mx = m;
#pragma unroll
        for (int ks = 0; ks < 2; ++ks)
#pragma unroll
          for (int i = 0; i < 16; ++i) {
            float sv = S[ks][i] * sl2;
            if (local) {
              const int kpos = kpos0 + ks * 32 + (i & 3) + 8 * (i >> 2) + 4 * h;
              const int rel = kpos - qs;
              if (rel > 128 || rel < -128) sv = -1e30f;
            }
            S[ks][i] = sv;
            mx = fmaxf(mx, sv);
          }
        mx = fmaxf(mx, __shfl_xor(mx, 32, 64));
        const float alpha = __builtin_amdgcn_exp2f(m - mx);
        m = mx;
        l *= alpha;
#pragma unroll
        for (int dt = 0; dt < 4; ++dt)
#pragma unroll
          for (int i = 0; i < 16; ++i) O[dt][i] *= alpha;
#pragma unroll
        for (int ks = 0; ks < 2; ++ks)
#pragma unroll
          for (int i = 0; i < 16; ++i) {
            float pv = __builtin_amdgcn_exp2f(S[ks][i] - m);
            l += pv;
            S[ks][i] = pv;
          }
#pragma unroll
        for (int s4 = 0; s4 < 4; ++s4) {
          const int ks = s4 >> 1, hf = s4 & 1;
          pg8::u32x4 pk;
#pragma unroll
          for (int j = 0; j < 4; ++j)
            pk[j] = (unsigned)f2bf(S[ks][8 * hf + 2 * j]) | ((unsigned)f2bf(S[ks][8 * hf + 2 * j + 1]) << 16);
          bfx8 P = __builtin_bit_cast(bfx8, pk);
#pragma unroll
          for (int dt = 0; dt < 4; ++dt) {
            const char* vp = Vs + (dt * 32 + r) * AT_VROW + (32 * ks + 16 * hf + 4 * h) * 2;
            uint2 v0 = *(const uint2*)vp, v1 = *(const uint2*)(vp + 16);
            pg8::u32x4 vv; vv[0] = v0.x; vv[1] = v0.y; vv[2] = v1.x; vv[3] = v1.y;
            O[dt] = __builtin_amdgcn_mfma_f32_32x32x16_bf16(__builtin_bit_cast(bfx8, vv), P, O[dt], 0, 0, 0);
          }
        }
      }
      if (tn >= 10) break;
      ti = tn;
    }
    const float ltot = l + __shfl_xor(l, 32, 64);
    const float inv = 1.f / ltot;
    const size_t tok = (size_t)(b * 2048 + qs);
#pragma unroll
    for (int dt = 0; dt < 4; ++dt)
#pragma unroll
      for (int g4 = 0; g4 < 4; ++g4) {
        const int d = dt * 32 + 8 * g4 + 4 * h;
        uint2 gg = *(const uint2*)(px + tok * 5120 + 3072 + hq * 128 + d);
        float o0 = O[dt][4 * g4 + 0] * inv * siluf(bflo(gg.x));
        float o1 = O[dt][4 * g4 + 1] * inv * siluf(bfhi(gg.x));
        float o2 = O[dt][4 * g4 + 2] * inv * siluf(bflo(gg.y));
        float o3 = O[dt][4 * g4 + 3] * inv * siluf(bfhi(gg.y));
        uint2 pk;
        pk.x = (unsigned)f2bf(o0) | ((unsigned)f2bf(o1) << 16);
        pk.y = (unsigned)f2bf(o2) | ((unsigned)f2bf(o3) << 16);
        *(uint2*)(og + tok * 2048 + hq * 128 + d) = pk;
      }
  }
}

#define XB_TMO      128
#define XB_XCNT(j)  (256  + 64 * (j))
#define XB_XSUB(j)  (1280 + 64 * (j))
#define XB_XGEN(j)  (2304 + 64 * (j))
#define XB_TOP      3328
#define XB_TOPGEN   3392
#define XCD_BAR_WORDS 3456
#define XB_SPIN_CAP (1u << 18)
#define LAS __attribute__((address_space(3)))

__device__ __forceinline__ unsigned xb_ld(unsigned* p)              { return __hip_atomic_load(p, __ATOMIC_RELAXED, __HIP_MEMORY_SCOPE_AGENT); }
__device__ __forceinline__ unsigned xb_add(unsigned* p, unsigned v) { return __hip_atomic_fetch_add(p, v, __ATOMIC_RELAXED, __HIP_MEMORY_SCOPE_AGENT); }
__device__ __forceinline__ unsigned xb_xcc_id() { return (unsigned)__builtin_amdgcn_s_getreg((3 << 11) | 20) & 0xFu; }
#define XB_SPIN(cond, bar) do { unsigned _sp = 0; while (cond) { __builtin_amdgcn_s_sleep(1); \
    if ((++_sp & 255u) == 0u) { if (xb_ld(&(bar)[XB_TMO])) break; if (_sp > XB_SPIN_CAP) { atomicAdd(&(bar)[XB_TMO], 1u); break; } } } } while (0)

struct XcdBarrier {
    unsigned* bar; unsigned x;
    volatile LAS unsigned* st;
};

__device__ __forceinline__ XcdBarrier xcd_barrier_post(unsigned* bar, volatile LAS unsigned* st) {
    XcdBarrier b; b.bar = bar; b.x = xb_xcc_id(); b.st = st;
    if (threadIdx.x == 0) (void)xb_add(&bar[XB_XCNT(b.x)], 1u);
    return b;
}
__device__ __forceinline__ void xcd_barrier_complete(unsigned* bar, unsigned x, unsigned& nloc, unsigned& nx) {
    const unsigned G = gridDim.x * gridDim.y * gridDim.z;
    unsigned sum, cnt, mine, sp = 0u;
    for (;;) {
        sum = 0u; cnt = 0u; mine = 0u;
#pragma unroll
        for (unsigned j = 0; j < 16; ++j) { const unsigned c = xb_ld(&bar[XB_XCNT(j)]); sum += c; cnt += (c > 0u) ? 1u : 0u; mine = (j == x) ? c : mine; }
        if (sum == G) break;
        __builtin_amdgcn_s_sleep(1);
        if ((++sp & 255u) == 0u) { if (xb_ld(&bar[XB_TMO])) break; if (sp > XB_SPIN_CAP) { atomicAdd(&bar[XB_TMO], 1u); break; } }
    }
    nloc = mine > 0u ? mine : 1u; nx = cnt > 0u ? cnt : 1u;
}

__device__ __forceinline__ void xcd_barrier(const XcdBarrier& b) {
    asm volatile("s_waitcnt vmcnt(0)" ::: "memory");
    __syncthreads();
    if (threadIdx.x == 0) {
        unsigned* bar = b.bar;
        __builtin_amdgcn_s_waitcnt(0);
        unsigned nloc = b.st[0], nx = b.st[1];
        if (nloc == 0u) { xcd_barrier_complete(bar, b.x, nloc, nx); b.st[0] = nloc; b.st[1] = nx; }
        const unsigned old = xb_add(&bar[XB_XSUB(b.x)], 1u);
        const unsigned gen = old / nloc;
        if (old + 1u == (gen + 1u) * nloc) {
            __builtin_amdgcn_fence(__ATOMIC_RELEASE, "agent");
            asm volatile("s_waitcnt vmcnt(0)" ::: "memory");
            const unsigned og = xb_add(&bar[XB_TOP], 1u);
            const unsigned tg = og / nx;
            if (og + 1u == (tg + 1u) * nx) xb_add(&bar[XB_TOPGEN], 1u);
            else XB_SPIN(xb_ld(&bar[XB_TOPGEN]) == tg, bar);
            __builtin_amdgcn_fence(__ATOMIC_ACQUIRE, "agent");
            xb_add(&bar[XB_XGEN(b.x)], 1u);
            asm volatile("s_waitcnt vmcnt(0)" ::: "memory");
        } else {
            XB_SPIN(xb_ld(&bar[XB_XGEN(b.x)]) == gen, bar);
            __builtin_amdgcn_fence(__ATOMIC_ACQUIRE, "agent");
            asm volatile("s_waitcnt vmcnt(0)" ::: "memory");
        }
    }
    __syncthreads();
}


constexpr int N_PHASES = 9;
__global__ void __launch_bounds__(NTHREADS, 2) mega(Params p, int ph0, int ph1) {
  extern __shared__ __attribute__((aligned(16))) float sm[];
  volatile LAS unsigned* xb_st = (volatile LAS unsigned*)((LAS unsigned char*)sm + 131072);
  if (threadIdx.x < 4) xb_st[threadIdx.x] = 0u;
  __syncthreads();
  const XcdBarrier xb = xcd_barrier_post((unsigned*)(p.ws + OFF_BAR), xb_st);
#define PH(i, body) if (ph0 <= (i) && (i) < ph1) { body; if ((i) + 1 < ph1) { if ((i) == 0) cg::this_grid().sync(); else xcd_barrier(xb); } }
  PH(0, phase0(p, sm))
  PH(1, phase_norm(p, 0))
  PH(2, run_gemm(sm, (const u16*)(p.ws + OFF_ACT), (const u16*)(p.ws + OFF_WT_AI), MT, ATTN_IN,
                 EpiAttnIn{(u16*)(p.ws + OFF_BIG), (const float*)(p.ws + OFF_ROPE)}, (int)blockIdx.x);
        run_gemm(sm, (const u16*)(p.ws + OFF_HC), (const u16*)(p.ws + OFF_WT_AI) + (size_t)2048 * 2048, MC, 1024,
                 EpiRaw{(u16*)(p.ws + OFF_KVC), 1024}, (int)((blockIdx.x + 64) % gridDim.x));
        run_gemm(sm, (const u16*)(p.ws + OFF_WT_AI) + (size_t)2560 * 2048, (const u16*)(p.ws + OFF_ACT), 512, MT,
                 EpiRaw{(u16*)(p.ws + OFF_VT), 8192}, (int)((blockIdx.x + 128) % gridDim.x));
        run_gemm(sm, (const u16*)(p.ws + OFF_WT_AI) + (size_t)2560 * 2048, (const u16*)(p.ws + OFF_HC), 512, MC,
                 EpiRaw{(u16*)(p.ws + OFF_VCT), 1024}, (int)((blockIdx.x + 48) % gridDim.x)))
  PH(3, phase_attn(p, sm))
  PH(4, run_gemm(sm, (const u16*)(p.ws + OFF_ACT), (const u16*)(p.ws + OFF_WT_AO), MT, 2048,
                 EpiResNorm{p.out, p.x, (const float*)(p.ws + OFF_MOD) + 4096, (float*)(p.ws + OFF_ROWSS), (unsigned*)(p.ws + OFF_PCNT),
                            p.norm_g + 2048, (const float*)(p.ws + OFF_MOD) + 5 * 6144, (u16*)(p.ws + OFF_ACT)}, (int)blockIdx.x))
  PH(6, run_gemm(sm, (const u16*)(p.ws + OFF_WT_HI), (const u16*)(p.ws + OFF_ACT), HY_IN, MT,
                 EpiRaw{(u16*)(p.ws + OFF_BIG), 8192}, (int)blockIdx.x))
  PH(7, phase_conv(p, sm))
  PH(8, (run_gemm<EpiResNorm, true>(sm, (const u16*)(p.ws + OFF_ACT), (const u16*)(p.ws + OFF_WT_HO), MT, 2048,
                 EpiResNorm{p.out, p.out, (const float*)(p.ws + OFF_MOD) + 5 * 6144 + 4096, (float*)(p.ws + OFF_ROWSS) + 8192,
                            (unsigned*)(p.ws + OFF_PCNT) + 32 * 64, p.final_g, nullptr, nullptr}, (int)blockIdx.x)))
}

extern "C" void kernel_launch(void* const* d_in, const int* in_sizes, int n_in, void* d_out, int out_size,
                              void* d_ws, size_t ws_size, hipStream_t stream) {
  Params p{};
  const float** f = (const float**)&p;
  for (int i = 0; i < 23; ++i) f[i] = (const float*)d_in[i];
  p.out = (float*)d_out;
  p.ws = (char*)d_ws;
  constexpr size_t kLds = 128 * 1024 + 16;
  static int grid_blocks = 0;
  if (!grid_blocks) {
    (void)hipFuncSetAttribute((const void*)mega, hipFuncAttributeMaxDynamicSharedMemorySize, (int)kLds);
    int dev = 0, cus = 0, per_cu = 0;
    (void)hipGetDevice(&dev);
    (void)hipDeviceGetAttribute(&cus, hipDeviceAttributeMultiprocessorCount, dev);
    (void)hipOccupancyMaxActiveBlocksPerMultiprocessor(&per_cu, mega, NTHREADS, kLds);
    if (per_cu < 1) per_cu = 1;
    grid_blocks = cus * per_cu;
  }
  (void)hipMemsetAsync((char*)d_ws + OFF_BAR, 0, ZERO_BYTES, stream);
  int ph0 = 0, ph1 = N_PHASES;
  void* args[] = {(void*)&p, (void*)&ph0, (void*)&ph1};
  hipError_t e = hipLaunchCooperativeKernel((const void*)mega, dim3(grid_blocks), dim3(NTHREADS), args, kLds, stream);
  if (e != hipSuccess) fprintf(stderr, "cooperative launch failed: %s (grid %d)\n", hipGetErrorString(e), grid_blocks);
}
```

```cpp
#include <hip/hip_runtime.h>
#include <hip/hip_bf16.h>
#include <hip/hip_cooperative_groups.h>
#include <cstdio>
namespace cg = cooperative_groups;
typedef unsigned short u16;

#define NTHREADS 512
constexpr int Bn = 4, Sn = 2048, Dn = 2048, Cn = 256;
constexpr int MT = Bn * Sn;
constexpr int MC = Bn * Cn;
constexpr int ATTN_IN = 5120;
constexpr int HY_IN = 8192;

constexpr size_t OFF_WT_AI = 0;
constexpr size_t OFF_WT_AO = OFF_WT_AI + (size_t)5120 * 2048 * 2;
constexpr size_t OFF_WT_HI = OFF_WT_AO + (size_t)2048 * 2048 * 2;
constexpr size_t OFF_WT_HO = OFF_WT_HI + (size_t)8192 * 2048 * 2;
constexpr size_t OFF_MOD   = OFF_WT_HO + (size_t)2048 * 2048 * 2;
constexpr size_t OFF_ROPE  = OFF_MOD + (size_t)2 * 5 * 6144 * 4 + 256;
constexpr size_t OFF_FILT  = OFF_ROPE + (size_t)64 * 32 * 8;
constexpr size_t OFF_ACT   = OFF_FILT + (size_t)2 * 2048 * 4096 * 2;
constexpr size_t OFF_HC    = OFF_ACT + (size_t)8192 * 2048 * 2;
constexpr size_t OFF_KVC   = OFF_HC + (size_t)1024 * 2048 * 2;
constexpr size_t OFF_VT    = OFF_KVC + (size_t)1024 * 1024 * 2;
constexpr size_t OFF_VCT   = OFF_VT + (size_t)512 * 8192 * 2;
constexpr size_t OFF_BIG   = OFF_VCT + (size_t)512 * 1024 * 2;

constexpr size_t OFF_BAR   = OFF_BIG + (size_t)8192 * 8192 * 2;

constexpr size_t OFF_ROWSS = OFF_BAR + 16384;
constexpr size_t OFF_PCNT  = OFF_ROWSS + (size_t)2 * 8192 * 4;
constexpr size_t ZERO_BYTES = 16384 + (size_t)2 * 8192 * 4 + (size_t)2 * 32 * 64 * 4;

struct Params {
  const float *x, *c, *ctx, *c_ctx, *norm_g, *ada_w, *ada_b, *attn_w_in, *attn_w_out, *attn_sink;
  const float *hy_w_in, *hy_conv_w, *hy_conv_b, *hy_w1, *hy_b1, *hy_w2, *hy_b2, *hy_w3, *hy_b3;
  const float *hy_freq, *hy_bias_d, *hy_w_out, *final_g;
  float* out;
  char* ws;
};

__device__ __forceinline__ u16 f2bf(float f) {
  unsigned u = __float_as_uint(f);
  u += 0x7fffu + ((u >> 16) & 1u);
  return (u16)(u >> 16);
}
__device__ __forceinline__ float bf2f(u16 h) { return __uint_as_float(((unsigned)h) << 16); }
__device__ __forceinline__ float bflo(unsigned w) { return __uint_as_float(w << 16); }
__device__ __forceinline__ float bfhi(unsigned w) { return __uint_as_float(w & 0xffff0000u); }
__device__ __forceinline__ float siluf(float v) { return v / (1.f + __expf(-v)); }
__device__ __forceinline__ float wave_sum(float v) {
#pragma unroll
  for (int o = 32; o > 0; o >>= 1) v += __shfl_xor(v, o, 64);
  return v;
}
__device__ __forceinline__ float wave_max(float v) {
#pragma unroll
  for (int o = 32; o > 0; o >>= 1) v = fmaxf(v, __shfl_xor(v, o, 64));
  return v;
}

__device__ __forceinline__ void p0_convert(const float* __restrict__ W, u16* __restrict__ Wt, int N, int tk, int tn,
                           bool perm, float* sm) {
  const int tid = threadIdx.x;
  for (int i = tid; i < 64 * 32; i += NTHREADS) {
    int r = i >> 5, c4 = i & 31;
    float4 v = *(const float4*)(W + (size_t)(tk * 64 + r) * N + tn * 128 + c4 * 4);
    float* d = sm + r * 129 + c4 * 4;
    d[0] = v.x; d[1] = v.y; d[2] = v.z; d[3] = v.w;
  }
  __syncthreads();
  for (int i = tid; i < 128 * 8; i += NTHREADS) {
    int nrow = i >> 3, kc = i & 7;
    int src = nrow;
    if (perm && (tn * 128 < 2560)) {
      int g = nrow >> 5, nn = (nrow >> 4) & 1, fr = nrow & 15;
      src = (g >> 1) * 64 + nn * 32 + (g & 1) * 16 + fr;
    }
    unsigned w[4];
#pragma unroll
    for (int j = 0; j < 4; ++j) {
      float a = sm[(kc * 8 + 2 * j) * 129 + src];
      float b = sm[(kc * 8 + 2 * j + 1) * 129 + src];
      w[j] = (unsigned)f2bf(a) | ((unsigned)f2bf(b) << 16);
    }
    *(uint4*)(Wt + (size_t)(tn * 128 + nrow) * 2048 + tk * 64 + kc * 8) = make_uint4(w[0], w[1], w[2], w[3]);
  }
  __syncthreads();
}

__device__ __forceinline__ void p0_adaln(const Params& p, int item, float* sm) {
  const int tid = threadIdx.x;
  float* sv = sm;
  float* red = sm + 5 * 2048;
  int col0 = item * 48;
  int l = col0 / 6144, n0 = col0 % 6144;
  for (int i = tid; i < 5 * 2048; i += NTHREADS) {
    int v = i >> 11, k = i & 2047;
    float cv = v < 4 ? p.c[v * 2048 + k] : p.c_ctx[k];
    sv[i] = cv / (1.f + expf(-cv));
  }
  __syncthreads();
  int kg = tid / 12, cq = tid % 12;
  float acc[5][4];
#pragma unroll
  for (int v = 0; v < 5; ++v)
#pragma unroll
    for (int j = 0; j < 4; ++j) acc[v][j] = 0.f;
  if (kg < 42) {
    const float* W = p.ada_w + (size_t)l * 2048 * 6144 + n0 + cq * 4;
#pragma unroll 8
    for (int k = kg; k < 2048; k += 42) {
      float4 w = *(const float4*)(W + (size_t)k * 6144);
#pragma unroll
      for (int v = 0; v < 5; ++v) {
        float s = sv[v * 2048 + k];
        acc[v][0] += s * w.x; acc[v][1] += s * w.y; acc[v][2] += s * w.z; acc[v][3] += s * w.w;
      }
    }
  }
  if (kg >= 21 && kg < 42) {
#pragma unroll
    for (int v = 0; v < 5; ++v)
#pragma unroll
      for (int j = 0; j < 4; ++j) red[((kg - 21) * 5 + v) * 48 + cq * 4 + j] = acc[v][j];
  }
  __syncthreads();
  if (kg < 21) {
#pragma unroll
    for (int v = 0; v < 5; ++v)
#pragma unroll
      for (int j = 0; j < 4; ++j) red[(kg * 5 + v) * 48 + cq * 4 + j] += acc[v][j];
  }
  __syncthreads();
  if (tid < 240) {
    int v = tid / 48, cc = tid % 48;
    float s = 0.f;
    for (int g = 0; g < 21; ++g) s += red[(g * 5 + v) * 48 + cc];
    float* mod = (float*)(p.ws + OFF_MOD);
    mod[(l * 5 + v) * 6144 + n0 + cc] = s + p.ada_b[l * 6144 + n0 + cc];
  }
  __syncthreads();
}

__device__ __forceinline__ void p0_rope(const Params& p) {
  float2* rope = (float2*)(p.ws + OFF_ROPE);
  for (int i = threadIdx.x; i < 64 * 32; i += NTHREADS) {
    int pos = i >> 5, j = i & 31;
    float inv = powf(10000.f, -(float)(2 * j) / 64.f);
    float ang = (float)pos * inv;
    rope[i] = make_float2(cosf(ang), sinf(ang));
  }
}

typedef short bf16x8_t __attribute__((ext_vector_type(8)));
typedef unsigned u32x4_t __attribute__((ext_vector_type(4)));
typedef float f32x16_t __attribute__((ext_vector_type(16)));
__device__ __forceinline__ void split8(const float (&v)[8], bf16x8_t& hi, bf16x8_t& lo) {
  u32x4_t H, L;
#pragma unroll
  for (int j = 0; j < 4; ++j) {
    const u16 h0 = f2bf(v[2 * j]), h1 = f2bf(v[2 * j + 1]);
    const float r0 = v[2 * j] - bf2f(h0), r1 = v[2 * j + 1] - bf2f(h1);
    H[j] = (unsigned)h0 | ((unsigned)h1 << 16);
    L[j] = (unsigned)f2bf(r0) | ((unsigned)f2bf(r1) << 16);
  }
  hi = __builtin_bit_cast(bf16x8_t, H);
  lo = __builtin_bit_cast(bf16x8_t, L);
}
__device__ __forceinline__ void p0_filter(const Params& p, int item, float* sm) {
  int tid = threadIdx.x;
  asm volatile("" : "+v"(tid));
  const int lane = tid & 63, wid = tid >> 6, r = lane & 31, h = lane >> 5;
  const int cc = item & 15, pg = item >> 4;
  float* z = sm;
  float* h1 = z + 128 * 36;
  float* h2 = h1 + 128 * 64;
  for (int i = tid; i < 128 * 33; i += NTHREADS) {
    int pos = i / 33, e = i % 33;
    int t = pg * 128 + pos;
    float val;
    if (e == 0) val = (float)t / 2047.f;
    else {
      int bi = (e - 1) & 15;
      float w = 6.283185307179586f * (float)t / 2048.f;
      float fr = 1e-4f + (float)bi * ((15.f - 1e-4f) / 15.f);
      float ang = w * fr;
      val = (e <= 16) ? cosf(ang) : -sinf(ang);
    }
    z[pos * 36 + e] = val;
  }
  __syncthreads();
  {
    const int j = lane;
    float w1r[33];
#pragma unroll
    for (int e = 0; e < 33; ++e) w1r[e] = p.hy_w1[e * 64 + j];
    const float fq = p.hy_freq[j], b1 = p.hy_b1[j];
#pragma unroll 1
    for (int q = 0; q < 16; ++q) {
      const int pos = wid * 16 + q;
      const float4* zp = (const float4*)(z + pos * 36);
      float a = b1;
#pragma unroll
      for (int e4 = 0; e4 < 8; ++e4) {
        float4 zv = zp[e4];
        a += zv.x * w1r[4 * e4] + zv.y * w1r[4 * e4 + 1] + zv.z * w1r[4 * e4 + 2] + zv.w * w1r[4 * e4 + 3];
      }
      a += z[pos * 36 + 32] * w1r[32];
      h1[pos * 64 + j] = sinf(fq * a);
    }
  }
  __syncthreads();
  {
    const int j = lane;
    float w2r[64];
#pragma unroll
    for (int e = 0; e < 64; ++e) w2r[e] = p.hy_w2[e * 64 + j];
    const float fq = p.hy_freq[j], b2 = p.hy_b2[j];
#pragma unroll 1
    for (int q = 0; q < 16; ++q) {
      const int pos = wid * 16 + q;
      const float4* hp = (const float4*)(h1 + pos * 64);
      float a = b2;
#pragma unroll
      for (int e4 = 0; e4 < 16; ++e4) {
        float4 hv = hp[e4];
        a += hv.x * w2r[4 * e4] + hv.y * w2r[4 * e4 + 1] + hv.z * w2r[4 * e4 + 2] + hv.w * w2r[4 * e4 + 3];
      }
      h2[pos * 68 + j] = sinf(fq * a);
    }
  }
  __syncthreads();
  const int colw = cc * 512 + wid * 64;
  bf16x8_t Ahi[2][4], Alo[2][4];
#pragma unroll
  for (int ct = 0; ct < 2; ++ct)
#pragma unroll
    for (int ks = 0; ks < 4; ++ks) {
      float v[8];
#pragma unroll
      for (int j = 0; j < 8; ++j) v[j] = p.hy_w3[(size_t)(16 * ks + 8 * h + j) * 8192 + colw + ct * 32 + r];
      split8(v, Ahi[ct][ks], Alo[ct][ks]);
    }
  const int o = cc >> 3, dir = (cc >> 2) & 1;
  u16* Rg = (u16*)(p.ws + OFF_FILT) + (size_t)o * 2048 * 4096;
  const float min_decay = -3.0701134573253945f, max_decay = -15.350567286626972f;
#pragma unroll 1
  for (int pp = 0; pp < 2; ++pp) {
    f32x16_t acc[2][2];
#pragma unroll
    for (int ct = 0; ct < 2; ++ct)
#pragma unroll
      for (int q = 0; q < 2; ++q)
#pragma unroll
        for (int i = 0; i < 16; ++i) acc[ct][q][i] = 0.f;
#pragma unroll
    for (int q = 0; q < 2; ++q)
#pragma unroll
      for (int ks = 0; ks < 4; ++ks) {
        const float* hp = h2 + ((pp * 2 + q) * 32 + r) * 68 + 16 * ks + 8 * h;
        float4 x0 = *(const float4*)hp, x1 = *(const float4*)(hp + 4);
        float v[8] = {x0.x, x0.y, x0.z, x0.w, x1.x, x1.y, x1.z, x1.w};
        bf16x8_t Bhi, Blo;
        split8(v, Bhi, Blo);
#pragma unroll
        for (int ct = 0; ct < 2; ++ct) {
          acc[ct][q] = __builtin_amdgcn_mfma_f32_32x32x16_bf16(Ahi[ct][ks], Bhi, acc[ct][q], 0, 0, 0);
          acc[ct][q] = __builtin_amdgcn_mfma_f32_32x32x16_bf16(Ahi[ct][ks], Blo, acc[ct][q], 0, 0, 0);
          acc[ct][q] = __builtin_amdgcn_mfma_f32_32x32x16_bf16(Alo[ct][ks], Bhi, acc[ct][q], 0, 0, 0);
        }
      }
    int hh = h;
    asm volatile("" : "+v"(hh));
#pragma unroll
    for (int ct = 0; ct < 2; ++ct)
#pragma unroll
      for (int i = 0; i < 16; ++i) {
        const int col = colw + ct * 32 + (i & 3) + 8 * (i >> 2) + 4 * hh;
        const int ch = col & 2047;
        const float b3 = p.hy_b3[col];
        const float ad = fabsf(min_decay + (float)ch * ((max_decay - min_decay) / 2047.f));
        u16* R = Rg + (size_t)ch * 4096;
#pragma unroll
        for (int q = 0; q < 2; ++q) {
          const int t = pg * 128 + (pp * 2 + q) * 32 + r;
          const float tn = (float)t / 2047.f;
          float v = (acc[ct][q][i] + b3) * (__expf(-tn * ad) + 0.05f);
          if (dir == 0) {
            if (t == 0) v += p.hy_bias_d[o * 2048 + ch];
            R[2048 - t] = f2bf(v);
          } else {
            if (t > 0) R[2048 + t] = f2bf(v);
            else R[0] = 0;
          }
        }
      }
  }
  __syncthreads();
}

constexpr int N_CV_AI = 16 * 40, N_CV_AO = 16 * 16, N_CV_HI = 16 * 64, N_CV_HO = 16 * 16;
constexpr int N_CV = N_CV_AI + N_CV_AO + N_CV_HI + N_CV_HO;
#define CV_DECODE(I, W_, Wt_, N_, tk_, tn_, perm_) do { int _i = (I); \
    const bool _a = _i < N_CV_AI, _b2 = _i < N_CV_AI + N_CV_AO, _c = _i < N_CV_AI + N_CV_AO + N_CV_HI; \
    W_ = _a ? p.attn_w_in : (_b2 ? p.attn_w_out : (_c ? p.hy_w_in : p.hy_w_out)); \
    Wt_ = (u16*)(p.ws + (_a ? OFF_WT_AI : (_b2 ? OFF_WT_AO : (_c ? OFF_WT_HI : OFF_WT_HO)))); \
    N_ = _a ? 5120 : (_b2 ? 2048 : (_c ? 8192 : 2048)); \
    const int _nt = _a ? 40 : (_b2 ? 16 : (_c ? 64 : 16)); \
    _i -= _a ? 0 : (_b2 ? N_CV_AI : (_c ? N_CV_AI + N_CV_AO : N_CV_AI + N_CV_AO + N_CV_HI)); \
    tk_ = _i / _nt; tn_ = _i - tk_ * _nt; perm_ = _a && (tn_ * 128 < 2560); } while (0)
__device__ __forceinline__ void p0_convert_all(const Params& p, float* sm) {
  const int tid = threadIdx.x;
  float4 r0, r1, r2, r3, r4, r5, r6, r7;
#define CV_LOAD(W_, N_, tk_, tn_) do { const float* _b = (W_) + (size_t)((tk_) * 128 + (tid >> 5)) * (N_) + (tn_) * 128 + (tid & 31) * 4; const size_t _s = (size_t)16 * (N_); \
    r0 = *(const float4*)(_b); r1 = *(const float4*)(_b + _s); r2 = *(const float4*)(_b + 2 * _s); r3 = *(const float4*)(_b + 3 * _s); \
    r4 = *(const float4*)(_b + 4 * _s); r5 = *(const float4*)(_b + 5 * _s); r6 = *(const float4*)(_b + 6 * _s); r7 = *(const float4*)(_b + 7 * _s); } while (0)
#define CV_PUT(R, I) do { float* _d = sm + ((tid >> 5) + 16 * (I)) * 129 + (tid & 31) * 4; _d[0] = (R).x; _d[1] = (R).y; _d[2] = (R).z; _d[3] = (R).w; } while (0)
  int it = blockIdx.x;
  const float* cW; u16* cWt; int cN, ctk, ctn; bool cperm;
  CV_DECODE(it < N_CV ? it : 0, cW, cWt, cN, ctk, ctn, cperm);
  if (it < N_CV) CV_LOAD(cW, cN, ctk, ctn);
  while (it < N_CV) {
    __syncthreads();
    CV_PUT(r0, 0); CV_PUT(r1, 1); CV_PUT(r2, 2); CV_PUT(r3, 3); CV_PUT(r4, 4); CV_PUT(r5, 5); CV_PUT(r6, 6); CV_PUT(r7, 7);
    __syncthreads();
    const int nit = it + gridDim.x;
    const float* nW; u16* nWt; int nN, ntk, ntn; bool nperm;
    CV_DECODE(nit < N_CV ? nit : 0, nW, nWt, nN, ntk, ntn, nperm);
    if (nit < N_CV) CV_LOAD(nW, nN, ntk, ntn);
    const int row = (tid & 15) | (((tid >> 6) & 7) << 4);
    int src = row;
    if (cperm) { const int g = row >> 5, nn = (row >> 4) & 1, fr = row & 15; src = (g >> 1) * 64 + nn * 32 + (g & 1) * 16 + fr; }
#pragma unroll
    for (int i = 0; i < 4; ++i) {
      const int kch = ((tid >> 4) & 3) | (i << 2);
      unsigned w[4];
#pragma unroll
      for (int j = 0; j < 4; ++j) {
        float a = sm[(kch * 8 + 2 * j) * 129 + src];
        float b = sm[(kch * 8 + 2 * j + 1) * 129 + src];
        w[j] = (unsigned)f2bf(a) | ((unsigned)f2bf(b) << 16);
      }
      *(uint4*)(cWt + (size_t)(ctn * 128 + row) * 2048 + ctk * 128 + kch * 8) = make_uint4(w[0], w[1], w[2], w[3]);
    }
    cW = nW; cWt = nWt; cN = nN; ctk = ntk; ctn = ntn; cperm = nperm;
    it = nit;
  }
#undef CV_LOAD
#undef CV_PUT
}

__device__ __forceinline__ void phase0(const Params& p, float* sm) {
  for (int it = blockIdx.x; it < 256; it += gridDim.x) p0_adaln(p, it, sm);
  if (blockIdx.x == gridDim.x - 1) p0_rope(p);
  __syncthreads();
  for (int it = blockIdx.x; it < 256; it += gridDim.x) p0_filter(p, it, sm);
  __syncthreads();
  p0_convert_all(p, sm);
}

__device__ __forceinline__ void norm_row(const float* __restrict__ src, const float* __restrict__ g, const float* shift,
                         const float* scale, u16* dst_bf, float* dst_f, int lane) {
  float4 v[8];
  float ss = 0.f;
#pragma unroll
  for (int j = 0; j < 8; ++j) {
    v[j] = *(const float4*)(src + (j * 64 + lane) * 4);
    ss += v[j].x * v[j].x + v[j].y * v[j].y + v[j].z * v[j].z + v[j].w * v[j].w;
  }
  ss = wave_sum(ss);
  float r = rsqrtf(ss * (1.f / 2048.f) + 1e-6f);
#pragma unroll
  for (int j = 0; j < 8; ++j) {
    int c = (j * 64 + lane) * 4;
    float4 gg = *(const float4*)(g + c);
    float4 o = make_float4(v[j].x * r * gg.x, v[j].y * r * gg.y, v[j].z * r * gg.z, v[j].w * r * gg.w);
    if (dst_bf) {
      float4 sh = *(const float4*)(shift + c);
      float4 sc = *(const float4*)(scale + c);
      o.x = o.x * (1.f + sc.x) + sh.x; o.y = o.y * (1.f + sc.y) + sh.y;
      o.z = o.z * (1.f + sc.z) + sh.z; o.w = o.w * (1.f + sc.w) + sh.w;
      uint2 pk;
      pk.x = (unsigned)f2bf(o.x) | ((unsigned)f2bf(o.y) << 16);
      pk.y = (unsigned)f2bf(o.z) | ((unsigned)f2bf(o.w) << 16);
      *(uint2*)(dst_bf + c) = pk;
    } else {
      *(float4*)(dst_f + c) = o;
    }
  }
}

__device__ __forceinline__ void phase_norm(const Params& p, int mode) {
  const int wid = threadIdx.x >> 6, lane = threadIdx.x & 63;
  const float* mod = (const float*)(p.ws + OFF_MOD);
  int nrows = (mode == 0) ? (MT + MC) : MT;
  for (int row = blockIdx.x * 8 + wid; row < nrows; row += gridDim.x * 8) {
    if (mode == 0) {
      if (row < MT) {
        int b = row >> 11;
        const float* m = mod + (0 * 5 + b) * 6144;
        norm_row(p.x + (size_t)row * 2048, p.norm_g, m, m + 2048, (u16*)(p.ws + OFF_ACT) + (size_t)row * 2048, nullptr, lane);
      } else {
        int rc = row - MT;
        const float* m = mod + (0 * 5 + 4) * 6144;
        norm_row(p.ctx + (size_t)rc * 2048, p.norm_g, m, m + 2048, (u16*)(p.ws + OFF_HC) + (size_t)rc * 2048, nullptr, lane);
      }
    } else if (mode == 1) {
      int b = row >> 11;
      const float* m = mod + (1 * 5 + b) * 6144;
      norm_row(p.out + (size_t)row * 2048, p.norm_g + 2048, m, m + 2048, (u16*)(p.ws + OFF_ACT) + (size_t)row * 2048, nullptr, lane);
    } else {
      norm_row(p.out + (size_t)row * 2048, p.final_g, nullptr, nullptr, nullptr, p.out + (size_t)row * 2048, lane);
    }
  }
}

namespace pg8 {
#define PG8_LAS __attribute__((address_space(3)))
typedef unsigned short bf16_t;
typedef short bf16x8 __attribute__((ext_vector_type(8)));
typedef float f32x4 __attribute__((ext_vector_type(4)));
typedef unsigned u32x4 __attribute__((ext_vector_type(4)));
constexpr int BM = 256, BK = 64, HALF = 128, HTB = HALF * BK * 2  , STAGE_BYTES = 8 * HTB, NXCD = 8, WGM = 8;

__host__ __device__ __forceinline__ int lds_byte(int r, int c) { const int st = (r >> 4) * 2 + (c >> 5), rr = r & 15, cc = c & 31, ob = rr * 64 + cc * 2; return st * 1024 + (ob ^ (((ob >> 9) & 1) << 5)); }
__host__ __device__ __forceinline__ void stage_rc(int b, int& R, int& C) { const int st = b / 1024, sb = b % 1024, swz = sb ^ (((sb >> 9) & 1) << 5); R = (st >> 1) * 16 + swz / 64; C = (st & 1) * 32 + (swz % 64) / 2; }
__host__ __device__ __forceinline__ int perm32(int rho) { const int n = rho >> 4, i = rho & 15; return 8 * (i >> 2) + 4 * n + (i & 3); }

struct Unit { int pm, pn; };
struct Gemm { const bf16_t* A; const bf16_t* Bt; int M, N, K; int agroup; };

struct StaticOrder {
    int nM, nN, nwg, G, c;
    __host__ __device__ void init(int M, int N, int G_, int c_) { nM = M / BM; nN = N / BM; nwg = nM * nN; G = G_; c = c_; }
    __host__ __device__ bool next(int i, Unit& u) const {
        const long L = (long)i * G + c; if (L >= nwg) return false;
        int wgid = (int)L; { const int q = nwg / NXCD, r = nwg % NXCD, xcd = wgid % NXCD, off = wgid / NXCD; wgid = (xcd < r ? xcd * (q + 1) : r * (q + 1) + (xcd - r) * q) + off; }
        const int nig = WGM * nN, gid = wgid / nig, fm = gid * WGM, gsz = (nM - fm) < WGM ? (nM - fm) : WGM;
        u.pm = fm + ((wgid % nig) % gsz); u.pn = (wgid % nig) / gsz; return true;
    }
    __device__ __forceinline__ void a_ready(const Unit&) const {}
    __device__ __forceinline__ void done(const Unit&) const {}
};
__device__ __forceinline__ unsigned cvt_pk_bf16(float lo, float hi) { unsigned r; asm volatile("v_cvt_pk_bf16_f32 %0, %1, %2" : "=v"(r) : "v"(lo), "v"(hi)); return r; }
template <class Epi, class Sched, bool AGROUP = false>
__device__ __forceinline__ void gemm_phase(PG8_LAS unsigned char* lds, const Gemm g, const Sched& S, const Epi& E) {
    const int tid = threadIdx.x, wid = __builtin_amdgcn_readfirstlane(tid >> 6), lane = tid & 63, wr = wid >> 2, wc = wid & 3, fr = lane & 15, fq = lane >> 4;
    const int K = g.K, nt = K / BK;
    unsigned voffA[2], voffB[2];
#pragma unroll
    for (int i = 0; i < 2; ++i) { int R, C; stage_rc(tid * 16 + i * 8192, R, C); const int Rb = Epi::PERM ? ((R & ~31) + perm32(R & 31)) : R;
        voffA[i] = AGROUP ? (unsigned)((C >> 3) * g.M + R) * 16u : (unsigned)(R * K + C) * 2u; voffB[i] = (unsigned)(Rb * K + C) * 2u; }
    const size_t kstep = (size_t)(BK * 2);
    const size_t hstep = (size_t)HALF * K * 2;
    const size_t tstep = 2 * hstep;
    const size_t kstepA = AGROUP ? (size_t)(BK / 8) * g.M * 16 : kstep, hstepA = AGROUP ? (size_t)HALF * 16 : hstep, tstepA = 2 * hstepA;
    const unsigned ldsw = (unsigned)wid * 1024u;
    const int aoff = lds_byte(wr * 64 + fr, fq * 8), boff = lds_byte(wc * 32 + fr, fq * 8);
#define PG8_SA(b, h) (((b) * 2 + (h)) * HTB)
#define PG8_SB(b, h) ((4 + (b) * 2 + (h)) * HTB)
#define PG8_STAGE(bufoff, gbase, voff) do { _Pragma("unroll") for (int _i = 0; _i < 2; ++_i) \
        __builtin_amdgcn_global_load_lds((const unsigned*)((const char*)(gbase) + (voff)[_i]), (PG8_LAS unsigned*)(lds + (bufoff) + ldsw + _i * 8192), 16, 0, 0); } while (0)
#define PG8_LDA(dst, b, h) do { _Pragma("unroll") for (int m = 0; m < 4; ++m) _Pragma("unroll") for (int k = 0; k < 2; ++k) dst[m][k] = *(const PG8_LAS bf16x8*)(lds + PG8_SA(b, h) + aoff + m * 2048 + k * 1024); } while (0)
#define PG8_LDB(dst, b, h) do { _Pragma("unroll") for (int n = 0; n < 2; ++n) _Pragma("unroll") for (int k = 0; k < 2; ++k) dst[n][k] = *(const PG8_LAS bf16x8*)(lds + PG8_SB(b, h) + boff + n * 2048 + k * 1024); } while (0)
#define PG8_MMA(ai, bj, At, Bt) do { __builtin_amdgcn_s_setprio(1); _Pragma("unroll") for (int m = 0; m < 4; ++m) _Pragma("unroll") for (int n = 0; n < 2; ++n) _Pragma("unroll") for (int k = 0; k < 2; ++k) \
        acc[ai][bj][m][n] = __builtin_amdgcn_mfma_f32_16x16x32_bf16(Bt[n][k], At[m][k], acc[ai][bj][m][n], 0, 0, 0); __builtin_amdgcn_s_setprio(0); } while (0)
#define PG8_WAIT_V(n) asm volatile("s_waitcnt vmcnt(" #n ")" ::: "memory")
#define PG8_WAIT_L(n) asm volatile("s_waitcnt lgkmcnt(" #n ")" ::: "memory")
#define PG8_BAR __builtin_amdgcn_s_barrier()
#define PG8_SCHED __builtin_amdgcn_sched_barrier(0)
    Unit cur, nxt; int ui = 0;
    if (!S.next(0, cur)) return;
    f32x4 acc[2][2][4][2];
#pragma unroll
    for (int a = 0; a < 2; ++a)
#pragma unroll
        for (int b = 0; b < 2; ++b)
#pragma unroll
            for (int m = 0; m < 4; ++m)
#pragma unroll
                for (int n = 0; n < 2; ++n) acc[a][b][m][n] = (f32x4){0.f, 0.f, 0.f, 0.f};
    bf16x8 At[4][2], B0[2][2], B1[2][2];
    const char* cA = (const char*)g.A + (size_t)cur.pm * tstepA; const char* cB = (const char*)g.Bt + (size_t)cur.pn * tstep;
    S.a_ready(cur);
    PG8_STAGE(PG8_SB(0, 0), cB, voffB); PG8_STAGE(PG8_SA(0, 0), cA, voffA); PG8_STAGE(PG8_SB(0, 1), cB + hstep, voffB); PG8_STAGE(PG8_SA(0, 1), cA + hstepA, voffA);
    if (wr == 1) PG8_BAR;
    PG8_WAIT_V(4); PG8_BAR;
    PG8_STAGE(PG8_SB(1, 0), cB + kstep, voffB); PG8_STAGE(PG8_SA(1, 0), cA + kstepA, voffA); PG8_STAGE(PG8_SB(1, 1), cB + hstep + kstep, voffB);
    PG8_WAIT_V(6); PG8_BAR;
    for (;;) {
        const bool has_next = S.next(ui + 1, nxt);
        const char* nA = has_next ? (const char*)g.A + (size_t)nxt.pm * tstepA : cA; const char* nB = has_next ? (const char*)g.Bt + (size_t)nxt.pn * tstep : cB;
        for (int t = 0; t < nt; t += 2) {
            const bool last = (t == nt - 2);
            const char* a1 = cA + (size_t)(t + 1) * kstepA;
            const char* a2 = last ? nA : cA + (size_t)(t + 2) * kstepA; const char* b2 = last ? nB : cB + (size_t)(t + 2) * kstep;
            const char* a3 = a2 + kstepA; const char* b3 = b2 + kstep;
            if (last && has_next) S.a_ready(nxt);
            PG8_LDB(B0, 0, 0); PG8_SCHED; PG8_LDA(At, 0, 0); PG8_STAGE(PG8_SA(1, 1), a1 + hstepA, voffA);
            PG8_WAIT_L(8); PG8_BAR; PG8_WAIT_L(0); PG8_MMA(0, 0, At, B0); PG8_BAR; PG8_SCHED;
            PG8_LDB(B1, 0, 1); PG8_STAGE(PG8_SB(0, 0), b2, voffB);
            PG8_BAR; PG8_WAIT_L(0); PG8_MMA(0, 1, At, B1); PG8_BAR;
            PG8_LDA(At, 0, 1); PG8_STAGE(PG8_SA(0, 0), a2, voffA);
            PG8_BAR; PG8_WAIT_L(0); PG8_MMA(1, 0, At, B0); PG8_BAR; PG8_SCHED;
            PG8_STAGE(PG8_SB(0, 1), b2 + hstep, voffB);
            PG8_WAIT_V(6); PG8_BAR; PG8_MMA(1, 1, At, B1); PG8_BAR;
            PG8_LDB(B0, 1, 0); PG8_SCHED; PG8_LDA(At, 1, 0); PG8_STAGE(PG8_SA(0, 1), a2 + hstepA, voffA);
            PG8_WAIT_L(8); PG8_BAR; PG8_WAIT_L(0); PG8_MMA(0, 0, At, B0); PG8_BAR; PG8_SCHED;
            PG8_LDB(B1, 1, 1); PG8_STAGE(PG8_SB(1, 0), b3, voffB);
            PG8_BAR; PG8_WAIT_L(0); PG8_MMA(0, 1, At, B1); PG8_BAR;
            PG8_LDA(At, 1, 1); PG8_STAGE(PG8_SA(1, 0), a3, voffA);
            PG8_BAR; PG8_WAIT_L(0); PG8_MMA(1, 0, At, B0); PG8_BAR; PG8_SCHED;
            PG8_STAGE(PG8_SB(1, 1), b3 + hstep, voffB);
            PG8_WAIT_V(6); PG8_BAR; PG8_MMA(1, 1, At, B1); PG8_BAR;
        }
        if constexpr (!Epi::AFTER_DRAIN) { E(acc, cur, wr, wc, fr, fq); S.done(cur); }
        if (!has_next) break;
#pragma unroll
        for (int a = 0; a < 2; ++a)
#pragma unroll
            for (int b = 0; b < 2; ++b)
#pragma unroll
                for (int m = 0; m < 4; ++m)
#pragma unroll
                    for (int n = 0; n < 2; ++n) acc[a][b][m][n] = (f32x4){0.f, 0.f, 0.f, 0.f};
        cur = nxt; cA = nA; cB = nB; ++ui;
    }
    PG8_WAIT_V(0);
    if (wr == 0) PG8_BAR;
    PG8_BAR;
    if constexpr (Epi::AFTER_DRAIN) { E.fused(acc, cur, wr, wc, fr, fq, lds, wid, lane); S.done(cur); }
#undef PG8_SA
#undef PG8_SB
#undef PG8_STAGE
#undef PG8_LDA
#undef PG8_LDB
#undef PG8_MMA
#undef PG8_WAIT_V
#undef PG8_WAIT_L
#undef PG8_BAR
#undef PG8_SCHED
}
}

__device__ __forceinline__ uint2 pack4(pg8::f32x4 v) {
  uint2 r;
  r.x = (unsigned)f2bf(v[0]) | ((unsigned)f2bf(v[1]) << 16);
  r.y = (unsigned)f2bf(v[2]) | ((unsigned)f2bf(v[3]) << 16);
  return r;
}
struct EpiAttnIn {
  static constexpr bool PERM = false, AFTER_DRAIN = false;
  u16* O; const float* rope;
  __device__ __forceinline__ void operator()(const pg8::f32x4 (&acc)[2][2][4][2], const pg8::Unit& u, int wr, int wc, int fr, int fq) const {
    const int row0 = u.pm * 256 + wr * 64 + fr, col0 = u.pn * 256 + wc * 32 + 4 * fq;
    const bool dorope = (u.pn < 10);
    const int axis = wc >> 1, i0 = (wc & 1) * 16 + 4 * fq;
#pragma unroll
    for (int ai = 0; ai < 2; ++ai)
#pragma unroll
      for (int m = 0; m < 4; ++m) {
        const int row = row0 + ai * 128 + m * 16;
        u16* rowp = O + (size_t)row * 5120 + col0;
        if (dorope) {
          const int s = row & 2047;
          const int pos = axis ? (s & 63) : (s >> 6);
          const float4* rp = (const float4*)(rope + (pos * 32 + i0) * 2);
          float4 c01 = rp[0], c23 = rp[1];
#pragma unroll
          for (int bj = 0; bj < 2; ++bj) {
            pg8::f32x4 a = acc[ai][bj][m][0], b = acc[ai][bj][m][1], o0, o1;
            o0[0] = a[0] * c01.x - b[0] * c01.y; o1[0] = b[0] * c01.x + a[0] * c01.y;
            o0[1] = a[1] * c01.z - b[1] * c01.w; o1[1] = b[1] * c01.z + a[1] * c01.w;
            o0[2] = a[2] * c23.x - b[2] * c23.y; o1[2] = b[2] * c23.x + a[2] * c23.y;
            o0[3] = a[3] * c23.z - b[3] * c23.w; o1[3] = b[3] * c23.z + a[3] * c23.w;
            *(uint2*)(rowp + bj * 128) = pack4(o0);
            *(uint2*)(rowp + bj * 128 + 16) = pack4(o1);
          }
        } else {
#pragma unroll
          for (int bj = 0; bj < 2; ++bj) {
            *(uint2*)(rowp + bj * 128) = pack4(acc[ai][bj][m][0]);
            *(uint2*)(rowp + bj * 128 + 16) = pack4(acc[ai][bj][m][1]);
          }
        }
      }
  }
};
struct EpiRaw {
  static constexpr bool PERM = false, AFTER_DRAIN = false;
  u16* O; int ldc;
  __device__ __forceinline__ void operator()(const pg8::f32x4 (&acc)[2][2][4][2], const pg8::Unit& u, int wr, int wc, int fr, int fq) const {
    const int row0 = u.pm * 256 + wr * 64 + fr, col0 = u.pn * 256 + wc * 32 + 4 * fq;
#pragma unroll
    for (int ai = 0; ai < 2; ++ai)
#pragma unroll
      for (int m = 0; m < 4; ++m) {
        u16* rowp = O + (size_t)(row0 + ai * 128 + m * 16) * ldc + col0;
#pragma unroll
        for (int bj = 0; bj < 2; ++bj) {
          *(uint2*)(rowp + bj * 128) = pack4(acc[ai][bj][m][0]);
          *(uint2*)(rowp + bj * 128 + 16) = pack4(acc[ai][bj][m][1]);
        }
      }
  }
};
struct EpiRes {
  static constexpr bool PERM = false, AFTER_DRAIN = false;
  float* out; const float* base; const float* gate;
  __device__ __forceinline__ void operator()(const pg8::f32x4 (&acc)[2][2][4][2], const pg8::Unit& u, int wr, int wc, int fr, int fq) const {
    const int row0 = u.pm * 256 + wr * 64 + fr, col0 = u.pn * 256 + wc * 32 + 4 * fq;
    const int b = (u.pm * 256) >> 11;
    pg8::f32x4 gv[2][2];
#pragma unroll
    for (int bj = 0; bj < 2; ++bj)
#pragma unroll
      for (int n = 0; n < 2; ++n) gv[bj][n] = *(const pg8::f32x4*)(gate + b * 6144 + col0 + bj * 128 + n * 16);
#pragma unroll
    for (int ai = 0; ai < 2; ++ai)
#pragma unroll
      for (int m = 0; m < 4; ++m) {
        const size_t off = (size_t)(row0 + ai * 128 + m * 16) * 2048 + col0;
#pragma unroll
        for (int bj = 0; bj < 2; ++bj)
#pragma unroll
          for (int n = 0; n < 2; ++n) {
            pg8::f32x4 bv = *(const pg8::f32x4*)(base + off + bj * 128 + n * 16);
            *(pg8::f32x4*)(out + off + bj * 128 + n * 16) = bv + gv[bj][n] * acc[ai][bj][m][n];
          }
      }
  }
};

struct EpiResNorm {
  static constexpr bool PERM = false, AFTER_DRAIN = true;
  float* out; const float* base; const float* gate;
  float* rowss; unsigned* pcnt;
  const float* g; const float* shsc;
  u16* hx;
  __device__ __forceinline__ void fused(pg8::f32x4 (&acc)[2][2][4][2], const pg8::Unit& u, int wr, int wc, int fr, int fq,
                                        PG8_LAS unsigned char*, int, int) const {
    const int row0 = u.pm * 256 + wr * 64 + fr, col0 = u.pn * 256 + wc * 32 + 4 * fq;
    const int b = (u.pm * 256) >> 11;
    {
      pg8::f32x4 gv[2][2];
#pragma unroll
      for (int bj = 0; bj < 2; ++bj)
#pragma unroll
        for (int n = 0; n < 2; ++n) gv[bj][n] = *(const pg8::f32x4*)(gate + b * 6144 + col0 + bj * 128 + n * 16);
#pragma unroll
      for (int ai = 0; ai < 2; ++ai)
#pragma unroll
        for (int m = 0; m < 4; ++m) {
          const int row = row0 + ai * 128 + m * 16;
          const size_t off = (size_t)row * 2048 + col0;
          float ss = 0.f;
#pragma unroll
          for (int bj = 0; bj < 2; ++bj)
#pragma unroll
            for (int n = 0; n < 2; ++n) {
              const pg8::f32x4 bv = *(const pg8::f32x4*)(base + off + bj * 128 + n * 16);
              const pg8::f32x4 v = bv + gv[bj][n] * acc[ai][bj][m][n];
              acc[ai][bj][m][n] = v;
              ss += v[0] * v[0] + v[1] * v[1] + v[2] * v[2] + v[3] * v[3];
            }
          ss += __shfl_xor(ss, 16, 64);
          ss += __shfl_xor(ss, 32, 64);
          if (fq == 0) unsafeAtomicAdd(rowss + row, ss);
        }
    }
    asm volatile("s_waitcnt vmcnt(0)" ::: "memory");
    __syncthreads();
    if (threadIdx.x == 0) {
      unsigned* c = pcnt + u.pm * 64;
      __hip_atomic_fetch_add(c, 1u, __ATOMIC_RELAXED, __HIP_MEMORY_SCOPE_AGENT);
      unsigned spins = 0;
      while (__hip_atomic_load(c, __ATOMIC_RELAXED, __HIP_MEMORY_SCOPE_AGENT) < 8u && ++spins < (1u << 22)) __builtin_amdgcn_s_sleep(1);
    }
    __syncthreads();
    float rr[2][4];
#pragma unroll
    for (int ai = 0; ai < 2; ++ai)
#pragma unroll
      for (int m = 0; m < 4; ++m) {
        const float ss = __hip_atomic_load(rowss + row0 + ai * 128 + m * 16, __ATOMIC_RELAXED, __HIP_MEMORY_SCOPE_AGENT);
        rr[ai][m] = rsqrtf(ss * (1.f / 2048.f) + 1e-6f);
      }
#pragma unroll
    for (int bj = 0; bj < 2; ++bj)
#pragma unroll
      for (int n = 0; n < 2; ++n) {
        const int cofs = bj * 128 + n * 16;
        const pg8::f32x4 gg = *(const pg8::f32x4*)(g + col0 + cofs);
        pg8::f32x4 sh = gg, sc = gg;
        if (hx) {
          sh = *(const pg8::f32x4*)(shsc + b * 6144 + col0 + cofs);
          sc = *(const pg8::f32x4*)(shsc + b * 6144 + 2048 + col0 + cofs) + 1.f;
        }
#pragma unroll
        for (int ai = 0; ai < 2; ++ai)
#pragma unroll
          for (int m = 0; m < 4; ++m) {
            const size_t off = (size_t)(row0 + ai * 128 + m * 16) * 2048 + col0 + cofs;
            const pg8::f32x4 v = acc[ai][bj][m][n];
            pg8::f32x4 o = v * rr[ai][m] * gg;
            if (hx) {
              *(pg8::f32x4*)(out + off) = v;
              o = o * sc + sh;
              *(uint2*)(hx + off) = pack4(o);
            } else {
              *(pg8::f32x4*)(out + off) = o;
            }
          }
      }
  }
};
template <class Epi, bool AGROUP = false>
__device__ __forceinline__ void run_gemm(float* sm, const u16* A, const u16* Bt, int M, int N, const Epi& E, int c) {
  pg8::Gemm g{A, Bt, M, N, 2048, AGROUP ? 1 : 0};
  pg8::StaticOrder S; S.init(M, N, (int)gridDim.x, c);
  pg8::gemm_phase<Epi, pg8::StaticOrder, AGROUP>((PG8_LAS unsigned char*)sm, g, S, E);
  __syncthreads();
}

template <int MODE>
__device__ __forceinline__ void epi_pair(const Params& p, int m, int n, float a0, float a1) {
  if (MODE == 1) {
    u16* px = (u16*)(p.ws + OFF_BIG);
    float o0 = a0, o1 = a1;
    if (n < 2560) {
      int g = (n >> 5) & 3, fr = n & 15;
      int axis = g >> 1, i = (g & 1) * 16 + fr;
      int s = m & 2047;
      int pos = axis ? (s & 63) : (s >> 6);
      float2 cs = ((const float2*)(p.ws + OFF_ROPE))[pos * 32 + i];
      o0 = a0 * cs.x - a1 * cs.y;
      o1 = a1 * cs.x + a0 * cs.y;
    }
    px[(size_t)m * 5120 + n] = f2bf(o0);
    px[(size_t)m * 5120 + n + 16] = f2bf(o1);
  } else if (MODE == 5) {
    u16* kvc = (u16*)(p.ws + OFF_KVC);
    kvc[(size_t)m * 1024 + n] = f2bf(a0);
    kvc[(size_t)m * 1024 + n + 16] = f2bf(a1);
  } else if (MODE == 2) {
    const float* mod = (const float*)(p.ws + OFF_MOD);
    int b = m >> 11;
    const float* gate = mod + (0 * 5 + b) * 6144 + 4096;
    p.out[(size_t)m * 2048 + n] = p.x[(size_t)m * 2048 + n] + gate[n] * a0;
    p.out[(size_t)m * 2048 + n + 16] = p.x[(size_t)m * 2048 + n + 16] + gate[n + 16] * a1;
  } else if (MODE == 3) {
    u16* pp = (u16*)(p.ws + OFF_BIG);
    pp[(size_t)m * 8192 + n] = f2bf(a0);
    pp[(size_t)m * 8192 + n + 16] = f2bf(a1);
  } else if (MODE == 4) {
    const float* mod = (const float*)(p.ws + OFF_MOD);
    int b = m >> 11;
    const float* gate = mod + (1 * 5 + b) * 6144 + 4096;
    p.out[(size_t)m * 2048 + n] += gate[n] * a0;
    p.out[(size_t)m * 2048 + n + 16] += gate[n + 16] * a1;
  }
}

template <int MODE>
__device__ __forceinline__ void naive_gemm(const Params& p, const u16* __restrict__ A, const u16* __restrict__ Wt, int M, int N) {
  const int tid = threadIdx.x;
  const int ml = tid >> 5, pl = tid & 31;
  const int ntn = N / 64, ntm = M / 16;
  for (int tile = blockIdx.x; tile < ntn * ntm; tile += gridDim.x) {
    int tm = tile / ntn, tn = tile % ntn;
    int m = tm * 16 + ml;
    int n = tn * 64 + (pl >> 4) * 32 + (pl & 15);
    const uint4* a = (const uint4*)(A + (size_t)m * 2048);
    const uint4* w0 = (const uint4*)(Wt + (size_t)n * 2048);
    const uint4* w1 = (const uint4*)(Wt + (size_t)(n + 16) * 2048);
    float acc0 = 0.f, acc1 = 0.f;
#pragma unroll 2
    for (int k = 0; k < 256; ++k) {
      uint4 av = a[k], b0 = w0[k], b1 = w1[k];
      acc0 += bflo(av.x) * bflo(b0.x) + bfhi(av.x) * bfhi(b0.x) + bflo(av.y) * bflo(b0.y) + bfhi(av.y) * bfhi(b0.y)
            + bflo(av.z) * bflo(b0.z) + bfhi(av.z) * bfhi(b0.z) + bflo(av.w) * bflo(b0.w) + bfhi(av.w) * bfhi(b0.w);
      acc1 += bflo(av.x) * bflo(b1.x) + bfhi(av.x) * bfhi(b1.x) + bflo(av.y) * bflo(b1.y) + bfhi(av.y) * bfhi(b1.y)
            + bflo(av.z) * bflo(b1.z) + bfhi(av.z) * bfhi(b1.z) + bflo(av.w) * bflo(b1.w) + bfhi(av.w) * bfhi(b1.w);
    }
    epi_pair<MODE>(p, m, n, acc0, acc1);
  }
}

__device__ __forceinline__ void phase_attn_naive(const Params& p, float* sm) {
  const int wid = threadIdx.x >> 6, lane = threadIdx.x & 63;
  float* qs = sm + wid * (128 + 640);
  float* pr = qs + 128;
  const u16* px = (const u16*)(p.ws + OFF_BIG);
  const u16* kvc = (const u16*)(p.ws + OFF_KVC);
  u16* og = (u16*)(p.ws + OFF_ACT);
  const float scale = 0.08838834764831845f;
  for (int item = blockIdx.x * 8 + wid; item < MT * 16; item += gridDim.x * 8) {
    int m = item >> 4, h = item & 15;
    int b = m >> 11, s = m & 2047, kvh = h >> 2, nblk = s >> 7;
    const u16* qrow = px + (size_t)m * 5120 + h * 128;
    qs[lane] = bf2f(qrow[lane]) * scale;
    qs[lane + 64] = bf2f(qrow[lane + 64]) * scale;
    asm volatile("s_waitcnt lgkmcnt(0)" ::: "memory");
    float mx = p.attn_sink[h];
#pragma unroll 1
    for (int j = 0; j < 10; ++j) {
      int kidx = j * 64 + lane;
      const u16* krow;
      bool valid;
      if (kidx < 384) {
        int kpos = (nblk - 1) * 128 + kidx;
        int rel = kpos - s;
        valid = (kpos >= 0) && (kpos < 2048) && (rel <= 128) && (rel >= -128);
        krow = px + (size_t)(b * 2048 + (valid ? kpos : 0)) * 5120 + 2048 + kvh * 128;
      } else {
        valid = true;
        krow = kvc + (size_t)(b * 256 + (kidx - 384)) * 1024 + kvh * 128;
      }
      float d = -1e30f;
      if (valid) {
        d = 0.f;
#pragma unroll 4
        for (int c = 0; c < 16; ++c) {
          uint4 kk = *(const uint4*)(krow + c * 8);
          const float* q8 = qs + c * 8;
          d += q8[0] * bflo(kk.x) + q8[1] * bfhi(kk.x) + q8[2] * bflo(kk.y) + q8[3] * bfhi(kk.y)
             + q8[4] * bflo(kk.z) + q8[5] * bfhi(kk.z) + q8[6] * bflo(kk.w) + q8[7] * bfhi(kk.w);
        }
      }
      pr[kidx] = d;
      mx = fmaxf(mx, d);
    }
    mx = wave_max(mx);
    float sum = 0.f;
#pragma unroll 1
    for (int j = 0; j < 10; ++j) {
      float d = pr[j * 64 + lane];
      float e = (d > -1e29f) ? __expf(d - mx) : 0.f;
      pr[j * 64 + lane] = e;
      sum += e;
    }
    sum = wave_sum(sum);
    sum += __expf(p.attn_sink[h] - mx);
    asm volatile("s_waitcnt lgkmcnt(0)" ::: "memory");
    float o0 = 0.f, o1 = 0.f;
    int k0 = s - 128 < 0 ? 0 : s - 128, k1 = s + 128 > 2047 ? 2047 : s + 128;
    for (int kpos = k0; kpos <= k1; ++kpos) {
      float pv = pr[kpos - (nblk - 1) * 128];
      unsigned vv = *(const unsigned*)(px + (size_t)(b * 2048 + kpos) * 5120 + 2560 + kvh * 128 + lane * 2);
      o0 += pv * bflo(vv); o1 += pv * bfhi(vv);
    }
    for (int c = 0; c < 256; ++c) {
      float pv = pr[384 + c];
      unsigned vv = *(const unsigned*)(kvc + (size_t)(b * 256 + c) * 1024 + 512 + kvh * 128 + lane * 2);
      o0 += pv * bflo(vv); o1 += pv * bfhi(vv);
    }
    float inv = 1.f / sum;
    unsigned gg = *(const unsigned*)(px + (size_t)m * 5120 + 3072 + h * 128 + lane * 2);
    float r0 = o0 * inv * siluf(bflo(gg)), r1 = o1 * inv * siluf(bfhi(gg));
    *(unsigned*)(og + (size_t)m * 2048 + h * 128 + lane * 2) = (unsigned)f2bf(r0) | ((unsigned)f2bf(r1) << 16);
    asm volatile("s_waitcnt lgkmcnt(0)" ::: "memory");
  }
}

__device__ __forceinline__ float sconv(const u16* pp, const float* cw, const float* cb, int b, int t, int c) {
  const u16* base = pp + (size_t)(b * 2048 + t) * 8192 + c;
  float v = cw[6144 + c] * bf2f(base[0]) + cb[c];
  if (t > 0) v += cw[c] * bf2f(base[-8192]);
  if (t < 2047) v += cw[2 * 6144 + c] * bf2f(base[8192]);
  return v;
}

__device__ __forceinline__ void phase_conv_naive(const Params& p, float* sm) {
  const int tid = threadIdx.x;
  float* u = sm;
  float* R = sm + 8192;
  const u16* pp = (const u16*)(p.ws + OFF_BIG);
  const u16* Rg = (const u16*)(p.ws + OFF_FILT);
  u16* yg = (u16*)(p.ws + OFF_ACT);
  for (int ch = blockIdx.x; ch < 2048; ch += gridDim.x) {
    for (int i = tid; i < 8192; i += NTHREADS) u[i] = sconv(pp, p.hy_conv_w, p.hy_conv_b, i >> 11, i & 2047, 4096 + ch);
    for (int i = tid; i < 4096; i += NTHREADS) R[i] = bf2f(Rg[((size_t)0 * 2048 + ch) * 4096 + i]);
    __syncthreads();
    float zr[16];
#pragma unroll
    for (int q = 0; q < 16; ++q) {
      int i = tid + q * NTHREADS;
      int b = i >> 11, t = i & 2047;
      const float* ub = u + b * 2048;
      const float* Rb = R + 2048 - t;
      float a = 0.f;
      for (int s = 0; s < 2048; ++s) a += Rb[s] * ub[s];
      zr[q] = a * sconv(pp, p.hy_conv_w, p.hy_conv_b, b, t, ch);
    }
    __syncthreads();
#pragma unroll
    for (int q = 0; q < 16; ++q) u[tid + q * NTHREADS] = zr[q];
    for (int i = tid; i < 4096; i += NTHREADS) R[i] = bf2f(Rg[((size_t)1 * 2048 + ch) * 4096 + i]);
    __syncthreads();
#pragma unroll
    for (int q = 0; q < 16; ++q) {
      int i = tid + q * NTHREADS;
      int b = i >> 11, t = i & 2047;
      const float* ub = u + b * 2048;
      const float* Rb = R + 2048 - t;
      float a = 0.f;
      for (int s = 0; s < 2048; ++s) a += Rb[s] * ub[s];
      float y = a * sconv(pp, p.hy_conv_w, p.hy_conv_b, b, t, 2048 + ch);
      float g = bf2f(pp[(size_t)(b * 2048 + t) * 8192 + 6144 + ch]);
      yg[(size_t)(b * 2048 + t) * 2048 + ch] = f2bf(y * siluf(g));
    }
    __syncthreads();
  }
}


typedef float f32x16 __attribute__((ext_vector_type(16)));
typedef pg8::bf16x8 bfx8;
constexpr int CONV_RF_BYTES = 4 * 8192;
constexpr int CONV_UB_ONE = 192 * 64;
__device__ __forceinline__ int ub_addr(int col, int chunk) { return col * 64 + ((chunk ^ ((col >> 2) & 3)) << 4); }

__device__ __forceinline__ void conv_mfma(const char* Rf_ci, const char* Ub_w, int lane, f32x16 (&acc)[4]) {
  const int t2 = lane & 31, h = lane >> 5, n = lane & 31;
  const unsigned sh = (unsigned)(t2 & 1) * 16u;
  const int lanedw = (2048 - t2 + 8 * h) >> 1;
#pragma unroll
  for (int j = 0; j < 4; ++j)
#pragma unroll
    for (int r = 0; r < 16; ++r) acc[j][r] = 0.f;
#pragma unroll 1
  for (int f = 0; f < 16; ++f) {
    bfx8 Bw[5][2];
#pragma unroll
    for (int m = 0; m < 5; ++m) {
      const int col = (16 * m - f + 16) * 2 + n;
#pragma unroll
      for (int kh = 0; kh < 2; ++kh) Bw[m][kh] = *(const bfx8*)(Ub_w + ub_addr(col, 2 * kh + h));
    }
    const unsigned* Rp = (const unsigned*)Rf_ci + lanedw - 16 * f;
#pragma unroll
    for (int e = -4; e <= 3; ++e) {
      int ee = e;
      if (e == -4) ee = (f == 0) ? -3 : -4;
      bfx8 A[2];
#pragma unroll
      for (int kh = 0; kh < 2; ++kh) {
        const unsigned* q = Rp - 256 * ee + 8 * kh;
        unsigned w0 = q[0], w1 = q[1], w2 = q[2], w3 = q[3], w4 = q[4];
        pg8::u32x4 pk;
        pk[0] = __builtin_amdgcn_alignbit(w1, w0, sh);
        pk[1] = __builtin_amdgcn_alignbit(w2, w1, sh);
        pk[2] = __builtin_amdgcn_alignbit(w3, w2, sh);
        pk[3] = __builtin_amdgcn_alignbit(w4, w3, sh);
        A[kh] = __builtin_bit_cast(bfx8, pk);
      }
#pragma unroll
      for (int j = 0; j < 4; ++j) {
        const int m = j - e;
        if (m >= 0 && m <= 4) acc[j] = __builtin_amdgcn_mfma_f32_32x32x16_bf16(A[0], Bw[m][0], acc[j], 0, 0, 0);
      }
#pragma unroll
      for (int j = 0; j < 4; ++j) {
        const int m = j - e;
        if (m >= 0 && m <= 4) acc[j] = __builtin_amdgcn_mfma_f32_32x32x16_bf16(A[1], Bw[m][1], acc[j], 0, 0, 0);
      }
    }
  }
}

__device__ __forceinline__ void sconv4(const u16* xp, int t, float w0, float w1, float w2, float cb, float (&o)[4]) {
  uint2 x4 = *(const uint2*)xp;
  float pv = t > 0 ? bf2f(xp[-1]) : 0.f;
  float nx = (t + 4 < 2048) ? bf2f(xp[4]) : 0.f;
  float e0 = bflo(x4.x), e1 = bfhi(x4.x), e2 = bflo(x4.y), e3 = bfhi(x4.y);
  o[0] = w0 * pv + w1 * e0 + w2 * e1 + cb;
  o[1] = w0 * e0 + w1 * e1 + w2 * e2 + cb;
  o[2] = w0 * e1 + w1 * e2 + w2 * e3 + cb;
  o[3] = w0 * e2 + w1 * e3 + w2 * nx + cb;
}

struct SC4 { uint2 x; unsigned pn; };
__device__ __forceinline__ SC4 sc4_load(const u16* xp, int t) {
  SC4 r;
  r.x = *(const uint2*)xp;
  const unsigned pv = t > 0 ? (unsigned)xp[-1] : 0u;
  const unsigned nx = (t + 4 < 2048) ? (unsigned)xp[4] : 0u;
  r.pn = pv | (nx << 16);
  return r;
}
__device__ __forceinline__ void sc4_apply(const SC4& r, float w0, float w1, float w2, float cb, float (&o)[4]) {
  const float pv = bflo(r.pn), nx = bfhi(r.pn);
  const float e0 = bflo(r.x.x), e1 = bfhi(r.x.x), e2 = bflo(r.x.y), e3 = bfhi(r.x.y);
  o[0] = w0 * pv + w1 * e0 + w2 * e1 + cb;
  o[1] = w0 * e0 + w1 * e1 + w2 * e2 + cb;
  o[2] = w0 * e1 + w1 * e2 + w2 * e3 + cb;
  o[3] = w0 * e2 + w1 * e3 + w2 * nx + cb;
}

__device__ __forceinline__ void phase_conv(const Params& p, float* smf) {
  char* sm = (char*)smf;
  char* Rf = sm;
  char* Ub = sm + CONV_RF_BYTES;
  int tid = threadIdx.x;
  asm volatile("" : "+v"(tid));
  const int wid = tid >> 6, lane = tid & 63;
  const int ci = wid >> 1, bp = wid & 1;
  const u16* pT = (const u16*)(p.ws + OFF_BIG);
  const u16* Rg = (const u16*)(p.ws + OFF_FILT);
  u16* yg = (u16*)(p.ws + OFF_ACT);
  for (int kk = 0; kk < 8 * CONV_UB_ONE / 16 / NTHREADS; ++kk) ((uint4*)Ub)[tid + kk * NTHREADS] = make_uint4(0, 0, 0, 0);
  __syncthreads();
  char* Ub_w = Ub + (ci * 2 + bp) * CONV_UB_ONE;
  const char* Rf_ci = Rf + ci * 8192;
  const int h = lane >> 5, n = lane & 31;
  for (int it0 = blockIdx.x * 2; it0 < 512; it0 += gridDim.x * 2)
#pragma unroll 1
  for (int sub = 0; sub < 2; ++sub) {
    const int item = it0 + sub;
    const int ch0 = item * 4;
    {
      const int q = tid & 255, hb = tid >> 8;
      uint4 x8[8]; unsigned pn[8]; uint4 fr[4];
#pragma unroll
      for (int k = 0; k < 8; ++k) {
        const int cc = 4096 + ch0 + (k >> 1), b = (k & 1) * 2 + hb;
        const u16* xp = pT + (size_t)cc * 8192 + b * 2048 + q * 8;
        x8[k] = *(const uint4*)xp;
        const unsigned pv = q > 0 ? (unsigned)xp[-1] : 0u;
        const unsigned nx = q < 255 ? (unsigned)xp[8] : 0u;
        pn[k] = pv | (nx << 16);
      }
#pragma unroll
      for (int k = 0; k < 4; ++k) fr[k] = ((const uint4*)(Rg + ((size_t)0 * 2048 + ch0 + k) * 4096))[tid];
#pragma unroll
      for (int k = 0; k < 8; ++k) {
        const int c = k >> 1, cc = 4096 + ch0 + c, b = (k & 1) * 2 + hb;
        const float w0 = p.hy_conv_w[cc], w1 = p.hy_conv_w[6144 + cc], w2 = p.hy_conv_w[2 * 6144 + cc], cb = p.hy_conv_b[cc];
        float e[10];
        e[0] = bflo(pn[k]); e[1] = bflo(x8[k].x); e[2] = bfhi(x8[k].x); e[3] = bflo(x8[k].y); e[4] = bfhi(x8[k].y);
        e[5] = bflo(x8[k].z); e[6] = bfhi(x8[k].z); e[7] = bflo(x8[k].w); e[8] = bfhi(x8[k].w); e[9] = bfhi(pn[k]);
        unsigned o[4];
#pragma unroll
        for (int kk = 0; kk < 4; ++kk) {
          float a = w0 * e[2 * kk] + w1 * e[2 * kk + 1] + w2 * e[2 * kk + 2] + cb;
          float bb = w0 * e[2 * kk + 1] + w1 * e[2 * kk + 2] + w2 * e[2 * kk + 3] + cb;
          o[kk] = (unsigned)f2bf(a) | ((unsigned)f2bf(bb) << 16);
        }
        const int t0 = q * 8, s1 = t0 >> 5, s2 = t0 & 31;
        const int col = (s1 + 16) * 2 + (b & 1);
        *(uint4*)(Ub + (c * 2 + (b >> 1)) * CONV_UB_ONE + ub_addr(col, s2 >> 3)) = make_uint4(o[0], o[1], o[2], o[3]);
      }
#pragma unroll
      for (int k = 0; k < 4; ++k) ((uint4*)(Rf + k * 8192))[tid] = fr[k];
    }
    __syncthreads();
    f32x16 acc[4];
    const int ch = ch0 + ci;
    {
      conv_mfma(Rf_ci, Ub_w, lane, acc);
      SC4 xr[16];
#pragma unroll
      for (int j = 0; j < 4; ++j)
#pragma unroll
        for (int vg = 0; vg < 4; ++vg) {
          const int t1 = 16 * j + (n >> 1), b = 2 * bp + (n & 1), t = 32 * t1 + 8 * vg + 4 * h;
          xr[j * 4 + vg] = sc4_load(pT + (size_t)ch * 8192 + b * 2048 + t, t);
        }
      const uint4 f1a = ((const uint4*)(Rg + ((size_t)1 * 2048 + ch0 + 0) * 4096))[tid];
      const uint4 f1b = ((const uint4*)(Rg + ((size_t)1 * 2048 + ch0 + 1) * 4096))[tid];
      const uint4 f1c = ((const uint4*)(Rg + ((size_t)1 * 2048 + ch0 + 2) * 4096))[tid];
      const uint4 f1d = ((const uint4*)(Rg + ((size_t)1 * 2048 + ch0 + 3) * 4096))[tid];
      const float w0 = p.hy_conv_w[ch], w1 = p.hy_conv_w[6144 + ch], w2 = p.hy_conv_w[2 * 6144 + ch], cb = p.hy_conv_b[ch];
#pragma unroll
      for (int j = 0; j < 4; ++j)
#pragma unroll
        for (int vg = 0; vg < 4; ++vg) {
          const int t1 = 16 * j + (n >> 1), bl = n & 1;
          float x1[4];
          sc4_apply(xr[j * 4 + vg], w0, w1, w2, cb, x1);
          uint2 pk;
          pk.x = (unsigned)f2bf(x1[0] * acc[j][4 * vg + 0]) | ((unsigned)f2bf(x1[1] * acc[j][4 * vg + 1]) << 16);
          pk.y = (unsigned)f2bf(x1[2] * acc[j][4 * vg + 2]) | ((unsigned)f2bf(x1[3] * acc[j][4 * vg + 3]) << 16);
          const int col = (t1 + 16) * 2 + bl;
          *(uint2*)(Ub_w + ub_addr(col, vg) + 8 * h) = pk;
        }
      __syncthreads();
      ((uint4*)(Rf + 0 * 8192))[tid] = f1a;
      ((uint4*)(Rf + 1 * 8192))[tid] = f1b;
      ((uint4*)(Rf + 2 * 8192))[tid] = f1c;
      ((uint4*)(Rf + 3 * 8192))[tid] = f1d;
    }
    __syncthreads();
    {
      const int c2 = 2048 + ch;
      SC4 xr[16]; uint2 gr[16];
      conv_mfma(Rf_ci, Ub_w, lane, acc);
#pragma unroll
      for (int j = 0; j < 4; ++j)
#pragma unroll
        for (int vg = 0; vg < 4; ++vg) {
          const int t1 = 16 * j + (n >> 1), b = 2 * bp + (n & 1), t = 32 * t1 + 8 * vg + 4 * h;
          xr[j * 4 + vg] = sc4_load(pT + (size_t)c2 * 8192 + b * 2048 + t, t);
          gr[j * 4 + vg] = *(const uint2*)(pT + (size_t)(6144 + ch) * 8192 + b * 2048 + t);
        }
      const float w0 = p.hy_conv_w[c2], w1 = p.hy_conv_w[6144 + c2], w2 = p.hy_conv_w[2 * 6144 + c2], cb = p.hy_conv_b[c2];
#pragma unroll
      for (int j = 0; j < 4; ++j)
#pragma unroll
        for (int vg = 0; vg < 4; ++vg) {
          const int t1 = 16 * j + (n >> 1), bl = n & 1;
          float x2[4];
          sc4_apply(xr[j * 4 + vg], w0, w1, w2, cb, x2);
          const uint2 g4 = gr[j * 4 + vg];
          float y0 = x2[0] * acc[j][4 * vg + 0] * siluf(bflo(g4.x));
          float y1 = x2[1] * acc[j][4 * vg + 1] * siluf(bfhi(g4.x));
          float y2 = x2[2] * acc[j][4 * vg + 2] * siluf(bflo(g4.y));
          float y3 = x2[3] * acc[j][4 * vg + 3] * siluf(bfhi(g4.y));
          uint2 pk;
          pk.x = (unsigned)f2bf(y0) | ((unsigned)f2bf(y1) << 16);
          pk.y = (unsigned)f2bf(y2) | ((unsigned)f2bf(y3) << 16);
          const int col = (t1 + 16) * 2 + bl;
          *(uint2*)(Ub_w + ub_addr(col, vg) + 8 * h) = pk;
        }
    }
    __syncthreads();
    int tw = tid;
    asm volatile("" : "+v"(tw));
#pragma unroll 4
    for (int kk = 0; kk < 16; ++kk) {
      const int idx = tw + kk * NTHREADS;
      const int b = idx >> 11, t = idx & 2047;
      const int s1 = t >> 5, s2 = t & 31;
      const int col = (s1 + 16) * 2 + (b & 1);
      const int a = ub_addr(col, s2 >> 3) + (s2 & 7) * 2;
      const char* base = Ub + (b >> 1) * CONV_UB_ONE + a;
      unsigned v0 = *(const u16*)(base + 0 * 2 * CONV_UB_ONE), v1 = *(const u16*)(base + 1 * 2 * CONV_UB_ONE);
      unsigned v2 = *(const u16*)(base + 2 * 2 * CONV_UB_ONE), v3 = *(const u16*)(base + 3 * 2 * CONV_UB_ONE);
      const uint2 cur = make_uint2(v0 | (v1 << 16), v2 | (v3 << 16));
      *(uint2*)(yg + ((size_t)(item >> 1) * 8192 + idx) * 8 + (item & 1) * 4) = cur;
    }
    __syncthreads();
  }
}

constexpr int AT_KROW = 272, AT_VROW = 136;
constexpr int AT_K_BYTES = 64 * AT_KROW, AT_V_BYTES = 128 * AT_VROW;
__device__ __forceinline__ void phase_attn(const Params& p, float* smf) {
  char* sm = (char*)smf;
  char* Ks = sm;
  char* Vs = sm + AT_K_BYTES;
  const int tid = threadIdx.x, wid = tid >> 6, lane = tid & 63, r = lane & 31, h = lane >> 5;
  const u16* px = (const u16*)(p.ws + OFF_BIG);
  const u16* kvc = (const u16*)(p.ws + OFF_KVC);
  const u16* vT = (const u16*)(p.ws + OFF_VT);
  const u16* vcT = (const u16*)(p.ws + OFF_VCT);
  u16* og = (u16*)(p.ws + OFF_ACT);
  const float LOG2E = 1.4426950408889634f;
  const float sl2 = 0.08838834764831845f * LOG2E;
  for (int item = blockIdx.x; item < 512; item += gridDim.x) {
    const int hp = item & 1, kvh = (item >> 1) & 3, nblk = (item >> 3) & 15, b = item >> 7;
    const int hq = kvh * 4 + hp * 2 + (wid >> 2);
    const int qs = nblk * 128 + (wid & 3) * 32 + r;
    bfx8 Q[8];
    {
      const u16* qrow = px + (size_t)(b * 2048 + qs) * 5120 + hq * 128 + 8 * h;
#pragma unroll
      for (int st = 0; st < 8; ++st) Q[st] = *(const bfx8*)(qrow + 16 * st);
    }
    f32x16 O[4];
#pragma unroll
    for (int dt = 0; dt < 4; ++dt)
#pragma unroll
      for (int i = 0; i < 16; ++i) O[dt][i] = 0.f;
    float m = p.attn_sink[hq] * LOG2E;
    float l = (h == 0) ? 1.f : 0.f;
    const int first = (nblk == 0) ? 2 : 0, lastlocal = (nblk == 15) ? 3 : 5;
    uint4 kreg0, kreg1, vreg0, vreg1;
#define AT_LOAD_TILE(TI) do { \
      const int _ti = (TI); const bool _loc = _ti < 6; \
      const int _kpos0 = 128 * (nblk - 1) + 64 * _ti, _c0 = 64 * (_ti - 6); \
      const u16* _kb = _loc ? px + (size_t)(b * 2048 + _kpos0) * 5120 + 2048 + kvh * 128 : kvc + (size_t)(b * 256 + _c0) * 1024 + kvh * 128; \
      const size_t _ks = _loc ? 5120 : 1024; \
      const u16* _vb = _loc ? vT + (size_t)(kvh * 128) * 8192 + b * 2048 + _kpos0 : vcT + (size_t)(kvh * 128) * 1024 + b * 256 + _c0; \
      const size_t _vs = _loc ? 8192 : 1024; \
      const int _c1 = tid + NTHREADS; \
      kreg0 = *(const uint4*)(_kb + (size_t)(tid >> 4) * _ks + (tid & 15) * 8); \
      kreg1 = *(const uint4*)(_kb + (size_t)(_c1 >> 4) * _ks + (_c1 & 15) * 8); \
      vreg0 = *(const uint4*)(_vb + (size_t)(tid >> 3) * _vs + (tid & 7) * 8); \
      vreg1 = *(const uint4*)(_vb + (size_t)(_c1 >> 3) * _vs + (_c1 & 7) * 8); \
    } while (0)
    int ti = first;
    AT_LOAD_TILE(ti);
    while (true) {
      __syncthreads();
      {
        const int c1 = tid + NTHREADS;
        *(uint4*)(Ks + (tid >> 4) * AT_KROW + (tid & 15) * 16) = kreg0;
        *(uint4*)(Ks + (c1 >> 4) * AT_KROW + (c1 & 15) * 16) = kreg1;
        char* v0p = Vs + (tid >> 3) * AT_VROW + (tid & 7) * 16;
        char* v1p = Vs + (c1 >> 3) * AT_VROW + (c1 & 7) * 16;
        *(uint2*)(v0p) = make_uint2(vreg0.x, vreg0.y);
        *(uint2*)(v0p + 8) = make_uint2(vreg0.z, vreg0.w);
        *(uint2*)(v1p) = make_uint2(vreg1.x, vreg1.y);
        *(uint2*)(v1p + 8) = make_uint2(vreg1.z, vreg1.w);
      }
      __syncthreads();
      int tn = ti + 1;
      if (tn > lastlocal && tn < 6) tn = 6;
      if (tn < 10) AT_LOAD_TILE(tn);
      const int q0w = nblk * 128 + (wid & 3) * 32;
      const int kp0 = 128 * (nblk - 1) + 64 * ti;
      if (!(ti < 6 && (kp0 > q0w + 31 + 128 || kp0 + 63 < q0w - 128))) {
        const bool local = ti < 6;
        const int kpos0 = 128 * (nblk - 1) + 64 * ti;
        f32x16 S[2];
#pragma unroll
        for (int ks = 0; ks < 2; ++ks) {
#pragma unroll
          for (int i = 0; i < 16; ++i) S[ks][i] = 0.f;
#pragma unroll
          for (int st = 0; st < 8; ++st) {
            bfx8 A = *(const bfx8*)(Ks + (ks * 32 + r) * AT_KROW + (16 * st + 8 * h) * 2);
            S[ks] = __builtin_amdgcn_mfma_f32_32x32x16_bf16(A, Q[st], S[ks], 0, 0, 0);
          }
        }
        float mx = m;
#pragma unroll
        for (int ks = 0; ks < 2; ++ks)
#pragma unroll
          for (int i = 0; i < 16; ++i) {
            float sv = S[ks][i] * sl2;
            if (local) {
              const int kpos = kpos0 + ks * 32 + (i & 3) + 8 * (i >> 2) + 4 * h;
              const int rel = kpos - qs;
              if (rel > 128 || rel < -128) sv = -1e30f;
            }
            S[ks][i] = sv;
            mx = fmaxf(mx, sv);
          }
        mx = fmaxf(mx, __shfl_xor(mx, 32, 64));
        const float alpha = __builtin_amdgcn_exp2f(m - mx);
        m = mx;
        l *= alpha;
#pragma unroll
        for (int dt = 0; dt < 4; ++dt)
#pragma unroll
          for (int i = 0; i < 16; ++i) O[dt][i] *= alpha;
#pragma unroll
        for (int ks = 0; ks < 2; ++ks)
#pragma unroll
          for (int i = 0; i < 16; ++i) {
            float pv = __builtin_amdgcn_exp2f(S[ks][i] - m);
            l += pv;
            S[ks][i] = pv;
          }
#pragma unroll
        for (int s4 = 0; s4 < 4; ++s4) {
          const int ks = s4 >> 1, hf = s4 & 1;
          pg8::u32x4 pk;
#pragma unroll
          for (int j = 0; j < 4; ++j)
            pk[j] = (unsigned)f2bf(S[ks][8 * hf + 2 * j]) | ((unsigned)f2bf(S[ks][8 * hf + 2 * j + 1]) << 16);
          bfx8 P = __builtin_bit_cast(bfx8, pk);
#pragma unroll
          for (int dt = 0; dt < 4; ++dt) {
            const char* vp = Vs + (dt * 32 + r) * AT_VROW + (32 * ks + 16 * hf + 4 * h) * 2;
            uint2 v0 = *(const uint2*)vp, v1 = *(const uint2*)(vp + 16);
            pg8::u32x4 vv; vv[0] = v0.x; vv[1] = v0.y; vv[2] = v1.x; vv[3] = v1.y;
            O[dt] = __builtin_amdgcn_mfma_f32_32x32x16_bf16(__builtin_bit_cast(bfx8, vv), P, O[dt], 0, 0, 0);
          }
        }
      }
      if (tn >= 10) break;
      ti = tn;
    }
    const float ltot = l + __shfl_xor(l, 32, 64);
    const float inv = 1.f / ltot;
    const size_t tok = (size_t)(b * 2048 + qs);
#pragma unroll
    for (int dt = 0; dt < 4; ++dt)
#pragma unroll
      for (int g4 = 0; g4 < 4; ++g4) {
        const int d = dt * 32 + 8 * g4 + 4 * h;
        uint2 gg = *(const uint2*)(px + tok * 5120 + 3072 + hq * 128 + d);
        float o0 = O[dt][4 * g4 + 0] * inv * siluf(bflo(gg.x));
        float o1 = O[dt][4 * g4 + 1] * inv * siluf(bfhi(gg.x));
        float o2 = O[dt][4 * g4 + 2] * inv * siluf(bflo(gg.y));
        float o3 = O[dt][4 * g4 + 3] * inv * siluf(bfhi(gg.y));
        uint2 pk;
        pk.x = (unsigned)f2bf(o0) | ((unsigned)f2bf(o1) << 16);
        pk.y = (unsigned)f2bf(o2) | ((unsigned)f2bf(o3) << 16);
        *(uint2*)(og + tok * 2048 + hq * 128 + d) = pk;
      }
  }
}

#define XB_TMO      128
#define XB_XCNT(j)  (256  + 64 * (j))
#define XB_XSUB(j)  (1280 + 64 * (j))
#define XB_XGEN(j)  (2304 + 64 * (j))
#define XB_TOP      3328
#define XB_TOPGEN   3392
#define XCD_BAR_WORDS 3456
#define XB_SPIN_CAP (1u << 18)
#define LAS __attribute__((address_space(3)))

__device__ __forceinline__ unsigned xb_ld(unsigned* p)              { return __hip_atomic_load(p, __ATOMIC_RELAXED, __HIP_MEMORY_SCOPE_AGENT); }
__device__ __forceinline__ unsigned xb_add(unsigned* p, unsigned v) { return __hip_atomic_fetch_add(p, v, __ATOMIC_RELAXED, __HIP_MEMORY_SCOPE_AGENT); }
__device__ __forceinline__ unsigned xb_xcc_id() { return (unsigned)__builtin_amdgcn_s_getreg((3 << 11) | 20) & 0xFu; }
#define XB_SPIN(cond, bar) do { unsigned _sp = 0; while (cond) { __builtin_amdgcn_s_sleep(1); \
    if ((++_sp & 255u) == 0u) { if (xb_ld(&(bar)[XB_TMO])) break; if (_sp > XB_SPIN_CAP) { atomicAdd(&(bar)[XB_TMO], 1u); break; } } } } while (0)

struct XcdBarrier {
    unsigned* bar; unsigned x;
    volatile LAS unsigned* st;
};

__device__ __forceinline__ XcdBarrier xcd_barrier_post(unsigned* bar, volatile LAS unsigned* st) {
    XcdBarrier b; b.bar = bar; b.x = xb_xcc_id(); b.st = st;
    if (threadIdx.x == 0) (void)xb_add(&bar[XB_XCNT(b.x)], 1u);
    return b;
}
__device__ __forceinline__ void xcd_barrier_complete(unsigned* bar, unsigned x, unsigned& nloc, unsigned& nx) {
    const unsigned G = gridDim.x * gridDim.y * gridDim.z;
    unsigned sum, cnt, mine, sp = 0u;
    for (;;) {
        sum = 0u; cnt = 0u; mine = 0u;
#pragma unroll
        for (unsigned j = 0; j < 16; ++j) { const unsigned c = xb_ld(&bar[XB_XCNT(j)]); sum += c; cnt += (c > 0u) ? 1u : 0u; mine = (j == x) ? c : mine; }
        if (sum == G) break;
        __builtin_amdgcn_s_sleep(1);
        if ((++sp & 255u) == 0u) { if (xb_ld(&bar[XB_TMO])) break; if (sp > XB_SPIN_CAP) { atomicAdd(&bar[XB_TMO], 1u); break; } }
    }
    nloc = mine > 0u ? mine : 1u; nx = cnt > 0u ? cnt : 1u;
}

__device__ __forceinline__ void xcd_barrier(const XcdBarrier& b) {
    asm volatile("s_waitcnt vmcnt(0)" ::: "memory");
    __syncthreads();
    if (threadIdx.x == 0) {
        unsigned* bar = b.bar;
        __builtin_amdgcn_s_waitcnt(0);
        unsigned nloc = b.st[0], nx = b.st[1];
        if (nloc == 0u) { xcd_barrier_complete(bar, b.x, nloc, nx); b.st[0] = nloc; b.st[1] = nx; }
        const unsigned old = xb_add(&bar[XB_XSUB(b.x)], 1u);
        const unsigned gen = old / nloc;
        if (old + 1u == (gen + 1u) * nloc) {
            __builtin_amdgcn_fence(__ATOMIC_RELEASE, "agent");
            asm volatile("s_waitcnt vmcnt(0)" ::: "memory");
            const unsigned og = xb_add(&bar[XB_TOP], 1u);
            const unsigned tg = og / nx;
            if (og + 1u == (tg + 1u) * nx) xb_add(&bar[XB_TOPGEN], 1u);
            else XB_SPIN(xb_ld(&bar[XB_TOPGEN]) == tg, bar);
            __builtin_amdgcn_fence(__ATOMIC_ACQUIRE, "agent");
            xb_add(&bar[XB_XGEN(b.x)], 1u);
            asm volatile("s_waitcnt vmcnt(0)" ::: "memory");
        } else {
            XB_SPIN(xb_ld(&bar[XB_XGEN(b.x)]) == gen, bar);
            __builtin_amdgcn_fence(__ATOMIC_ACQUIRE, "agent");
            asm volatile("s_waitcnt vmcnt(0)" ::: "memory");
        }
    }
    __syncthreads();
}


constexpr int N_PHASES = 9;
__global__ void __launch_bounds__(NTHREADS, 2) mega(Params p, int ph0, int ph1) {
  extern __shared__ __attribute__((aligned(16))) float sm[];
  volatile LAS unsigned* xb_st = (volatile LAS unsigned*)((LAS unsigned char*)sm + 131072);
  if (threadIdx.x < 4) xb_st[threadIdx.x] = 0u;
  __syncthreads();
  const XcdBarrier xb = xcd_barrier_post((unsigned*)(p.ws + OFF_BAR), xb_st);
#define PH(i, body) if (ph0 <= (i) && (i) < ph1) { body; if ((i) + 1 < ph1) xcd_barrier(xb); }
  if (ph0 < 0) cg::this_grid().sync();
  PH(0, phase0(p, sm))
  PH(1, phase_norm(p, 0))
  PH(2, run_gemm(sm, (const u16*)(p.ws + OFF_ACT), (const u16*)(p.ws + OFF_WT_AI), MT, ATTN_IN,
                 EpiAttnIn{(u16*)(p.ws + OFF_BIG), (const float*)(p.ws + OFF_ROPE)}, (int)blockIdx.x);
        run_gemm(sm, (const u16*)(p.ws + OFF_HC), (const u16*)(p.ws + OFF_WT_AI) + (size_t)2048 * 2048, MC, 1024,
                 EpiRaw{(u16*)(p.ws + OFF_KVC), 1024}, (int)((blockIdx.x + 64) % gridDim.x));
        run_gemm(sm, (const u16*)(p.ws + OFF_WT_AI) + (size_t)2560 * 2048, (const u16*)(p.ws + OFF_ACT), 512, MT,
                 EpiRaw{(u16*)(p.ws + OFF_VT), 8192}, (int)((blockIdx.x + 128) % gridDim.x));
        run_gemm(sm, (const u16*)(p.ws + OFF_WT_AI) + (size_t)2560 * 2048, (const u16*)(p.ws + OFF_HC), 512, MC,
                 EpiRaw{(u16*)(p.ws + OFF_VCT), 1024}, (int)((blockIdx.x + 48) % gridDim.x)))
  PH(3, phase_attn(p, sm))
  PH(4, run_gemm(sm, (const u16*)(p.ws + OFF_ACT), (const u16*)(p.ws + OFF_WT_AO), MT, 2048,
                 EpiResNorm{p.out, p.x, (const float*)(p.ws + OFF_MOD) + 4096, (float*)(p.ws + OFF_ROWSS), (unsigned*)(p.ws + OFF_PCNT),
                            p.norm_g + 2048, (const float*)(p.ws + OFF_MOD) + 5 * 6144, (u16*)(p.ws + OFF_ACT)}, (int)blockIdx.x))
  PH(6, run_gemm(sm, (const u16*)(p.ws + OFF_WT_HI), (const u16*)(p.ws + OFF_ACT), HY_IN, MT,
                 EpiRaw{(u16*)(p.ws + OFF_BIG), 8192}, (int)blockIdx.x))
  PH(7, phase_conv(p, sm))
  PH(8, (run_gemm<EpiResNorm, true>(sm, (const u16*)(p.ws + OFF_ACT), (const u16*)(p.ws + OFF_WT_HO), MT, 2048,
                 EpiResNorm{p.out, p.out, (const float*)(p.ws + OFF_MOD) + 5 * 6144 + 4096, (float*)(p.ws + OFF_ROWSS) + 8192,
                            (unsigned*)(p.ws + OFF_PCNT) + 32 * 64, p.final_g, nullptr, nullptr}, (int)blockIdx.x)))
}

extern "C" void kernel_launch(void* const* d_in, const int* in_sizes, int n_in, void* d_out, int out_size,
                              void* d_ws, size_t ws_size, hipStream_t stream) {
  Params p{};
  const float** f = (const float**)&p;
  for (int i = 0; i < 23; ++i) f[i] = (const float*)d_in[i];
  p.out = (float*)d_out;
  p.ws = (char*)d_ws;
  constexpr size_t kLds = 128 * 1024 + 16;
  static int grid_blocks = 0;
  if (!grid_blocks) {
    (void)hipFuncSetAttribute((const void*)mega, hipFuncAttributeMaxDynamicSharedMemorySize, (int)kLds);
    int dev = 0, cus = 0, per_cu = 0;
    (void)hipGetDevice(&dev);
    (void)hipDeviceGetAttribute(&cus, hipDeviceAttributeMultiprocessorCount, dev);
    (void)hipOccupancyMaxActiveBlocksPerMultiprocessor(&per_cu, mega, NTHREADS, kLds);
    if (per_cu < 1) per_cu = 1;
    grid_blocks = cus * per_cu;
  }
  (void)hipMemsetAsync((char*)d_ws + OFF_BAR, 0, ZERO_BYTES, stream);
  int ph0 = 0, ph1 = N_PHASES;
  void* args[] = {(void*)&p, (void*)&ph0, (void*)&ph1};
  hipError_t e = hipLaunchCooperativeKernel((const void*)mega, dim3(grid_blocks), dim3(NTHREADS), args, kLds, stream);
  if (e != hipSuccess) fprintf(stderr, "cooperative launch failed: %s (grid %d)\n", hipGetErrorString(e), grid_blocks);
}
```

```cpp
#include <hip/hip_runtime.h>
#include <hip/hip_bf16.h>
#include <hip/hip_cooperative_groups.h>
#include <cstdio>
namespace cg = cooperative_groups;
typedef unsigned short u16;

#define NTHREADS 512
constexpr int Bn = 4, Sn = 2048, Dn = 2048, Cn = 256;
constexpr int MT = Bn * Sn;
constexpr int MC = Bn * Cn;
constexpr int ATTN_IN = 5120;
constexpr int HY_IN = 8192;

constexpr size_t OFF_WT_AI = 0;
constexpr size_t OFF_WT_AO = OFF_WT_AI + (size_t)5120 * 2048 * 2;
constexpr size_t OFF_WT_HI = OFF_WT_AO + (size_t)2048 * 2048 * 2;
constexpr size_t OFF_WT_HO = OFF_WT_HI + (size_t)8192 * 2048 * 2;
constexpr size_t OFF_MOD   = OFF_WT_HO + (size_t)2048 * 2048 * 2;
constexpr size_t OFF_ROPE  = OFF_MOD + (size_t)2 * 5 * 6144 * 4 + 256;
constexpr size_t OFF_FILT  = OFF_ROPE + (size_t)64 * 32 * 8;
constexpr size_t OFF_ACT   = OFF_FILT + (size_t)2 * 2048 * 4096 * 2;
constexpr size_t OFF_HC    = OFF_ACT + (size_t)8192 * 2048 * 2;
constexpr size_t OFF_KVC   = OFF_HC + (size_t)1024 * 2048 * 2;
constexpr size_t OFF_VT    = OFF_KVC + (size_t)1024 * 1024 * 2;
constexpr size_t OFF_VCT   = OFF_VT + (size_t)512 * 8192 * 2;
constexpr size_t OFF_BIG   = OFF_VCT + (size_t)512 * 1024 * 2;

constexpr size_t OFF_BAR   = OFF_BIG + (size_t)8192 * 8192 * 2;

constexpr size_t OFF_ROWSS = OFF_BAR + 16384;
constexpr size_t OFF_PCNT  = OFF_ROWSS + (size_t)2 * 8192 * 4;
constexpr size_t ZERO_BYTES = 16384 + (size_t)2 * 8192 * 4 + (size_t)2 * 32 * 64 * 4;

struct Params {
  const float *x, *c, *ctx, *c_ctx, *norm_g, *ada_w, *ada_b, *attn_w_in, *attn_w_out, *attn_sink;
  const float *hy_w_in, *hy_conv_w, *hy_conv_b, *hy_w1, *hy_b1, *hy_w2, *hy_b2, *hy_w3, *hy_b3;
  const float *hy_freq, *hy_bias_d, *hy_w_out, *final_g;
  float* out;
  char* ws;
};

__device__ __forceinline__ u16 f2bf(float f) {
  unsigned u = __float_as_uint(f);
  u += 0x7fffu + ((u >> 16) & 1u);
  return (u16)(u >> 16);
}
__device__ __forceinline__ float bf2f(u16 h) { return __uint_as_float(((unsigned)h) << 16); }
__device__ __forceinline__ unsigned pk2(float lo, float hi) { unsigned r; asm("v_cvt_pk_bf16_f32 %0, %1, %2" : "=v"(r) : "v"(lo), "v"(hi)); return r; }
__device__ __forceinline__ float bflo(unsigned w) { return __uint_as_float(w << 16); }
__device__ __forceinline__ float bfhi(unsigned w) { return __uint_as_float(w & 0xffff0000u); }
__device__ __forceinline__ float siluf(float v) { return v / (1.f + __expf(-v)); }
__device__ __forceinline__ float wave_sum(float v) {
#pragma unroll
  for (int o = 32; o > 0; o >>= 1) v += __shfl_xor(v, o, 64);
  return v;
}
__device__ __forceinline__ float wave_max(float v) {
#pragma unroll
  for (int o = 32; o > 0; o >>= 1) v = fmaxf(v, __shfl_xor(v, o, 64));
  return v;
}

__device__ __forceinline__ void p0_convert(const float* __restrict__ W, u16* __restrict__ Wt, int N, int tk, int tn,
                           bool perm, float* sm) {
  const int tid = threadIdx.x;
  for (int i = tid; i < 64 * 32; i += NTHREADS) {
    int r = i >> 5, c4 = i & 31;
    float4 v = *(const float4*)(W + (size_t)(tk * 64 + r) * N + tn * 128 + c4 * 4);
    float* d = sm + r * 129 + c4 * 4;
    d[0] = v.x; d[1] = v.y; d[2] = v.z; d[3] = v.w;
  }
  __syncthreads();
  for (int i = tid; i < 128 * 8; i += NTHREADS) {
    int nrow = i >> 3, kc = i & 7;
    int src = nrow;
    if (perm && (tn * 128 < 2560)) {
      int g = nrow >> 5, nn = (nrow >> 4) & 1, fr = nrow & 15;
      src = (g >> 1) * 64 + nn * 32 + (g & 1) * 16 + fr;
    }
    unsigned w[4];
#pragma unroll
    for (int j = 0; j < 4; ++j) {
      float a = sm[(kc * 8 + 2 * j) * 129 + src];
      float b = sm[(kc * 8 + 2 * j + 1) * 129 + src];
      w[j] = pk2(a, b);
    }
    *(uint4*)(Wt + (size_t)(tn * 128 + nrow) * 2048 + tk * 64 + kc * 8) = make_uint4(w[0], w[1], w[2], w[3]);
  }
  __syncthreads();
}

__device__ __forceinline__ void p0_adaln(const Params& p, int item, float* sm) {
  const int tid = threadIdx.x;
  float* sv = sm;
  float* red = sm + 5 * 2048;
  int col0 = item * 48;
  int l = col0 / 6144, n0 = col0 % 6144;
  for (int i = tid; i < 5 * 2048; i += NTHREADS) {
    int v = i >> 11, k = i & 2047;
    float cv = v < 4 ? p.c[v * 2048 + k] : p.c_ctx[k];
    sv[i] = cv / (1.f + expf(-cv));
  }
  __syncthreads();
  int kg = tid / 12, cq = tid % 12;
  float acc[5][4];
#pragma unroll
  for (int v = 0; v < 5; ++v)
#pragma unroll
    for (int j = 0; j < 4; ++j) acc[v][j] = 0.f;
  if (kg < 42) {
    const float* W = p.ada_w + (size_t)l * 2048 * 6144 + n0 + cq * 4;
#pragma unroll 8
    for (int k = kg; k < 2048; k += 42) {
      float4 w = *(const float4*)(W + (size_t)k * 6144);
#pragma unroll
      for (int v = 0; v < 5; ++v) {
        float s = sv[v * 2048 + k];
        acc[v][0] += s * w.x; acc[v][1] += s * w.y; acc[v][2] += s * w.z; acc[v][3] += s * w.w;
      }
    }
  }
  if (kg >= 21 && kg < 42) {
#pragma unroll
    for (int v = 0; v < 5; ++v)
#pragma unroll
      for (int j = 0; j < 4; ++j) red[((kg - 21) * 5 + v) * 48 + cq * 4 + j] = acc[v][j];
  }
  __syncthreads();
  if (kg < 21) {
#pragma unroll
    for (int v = 0; v < 5; ++v)
#pragma unroll
      for (int j = 0; j < 4; ++j) red[(kg * 5 + v) * 48 + cq * 4 + j] += acc[v][j];
  }
  __syncthreads();
  if (tid < 240) {
    int v = tid / 48, cc = tid % 48;
    float s = 0.f;
    for (int g = 0; g < 21; ++g) s += red[(g * 5 + v) * 48 + cc];
    float* mod = (float*)(p.ws + OFF_MOD);
    mod[(l * 5 + v) * 6144 + n0 + cc] = s + p.ada_b[l * 6144 + n0 + cc];
  }
  __syncthreads();
}

__device__ __forceinline__ void p0_rope(const Params& p) {
  float2* rope = (float2*)(p.ws + OFF_ROPE);
  for (int i = threadIdx.x; i < 64 * 32; i += NTHREADS) {
    int pos = i >> 5, j = i & 31;
    float inv = powf(10000.f, -(float)(2 * j) / 64.f);
    float ang = (float)pos * inv;
    rope[i] = make_float2(cosf(ang), sinf(ang));
  }
}

typedef short bf16x8_t __attribute__((ext_vector_type(8)));
typedef unsigned u32x4_t __attribute__((ext_vector_type(4)));
typedef float f32x16_t __attribute__((ext_vector_type(16)));
__device__ __forceinline__ void split8(const float (&v)[8], bf16x8_t& hi, bf16x8_t& lo) {
  u32x4_t H, L;
#pragma unroll
  for (int j = 0; j < 4; ++j) {
    const u16 h0 = f2bf(v[2 * j]), h1 = f2bf(v[2 * j + 1]);
    const float r0 = v[2 * j] - bf2f(h0), r1 = v[2 * j + 1] - bf2f(h1);
    H[j] = (unsigned)h0 | ((unsigned)h1 << 16);
    L[j] = pk2(r0, r1);
  }
  hi = __builtin_bit_cast(bf16x8_t, H);
  lo = __builtin_bit_cast(bf16x8_t, L);
}
__device__ __forceinline__ void p0_filter(const Params& p, int item, float* sm) {
  int tid = threadIdx.x;
  asm volatile("" : "+v"(tid));
  const int lane = tid & 63, wid = tid >> 6, r = lane & 31, h = lane >> 5;
  const int cc = item & 15, pg = item >> 4;
  float* z = sm;
  float* h1 = z + 128 * 36;
  float* h2 = h1 + 128 * 64;
  for (int i = tid; i < 128 * 33; i += NTHREADS) {
    int pos = i / 33, e = i % 33;
    int t = pg * 128 + pos;
    float val;
    if (e == 0) val = (float)t / 2047.f;
    else {
      int bi = (e - 1) & 15;
      float w = 6.283185307179586f * (float)t / 2048.f;
      float fr = 1e-4f + (float)bi * ((15.f - 1e-4f) / 15.f);
      float ang = w * fr;
      val = (e <= 16) ? cosf(ang) : -sinf(ang);
    }
    z[pos * 36 + e] = val;
  }
  __syncthreads();
  {
    const int j = lane;
    float w1r[33];
#pragma unroll
    for (int e = 0; e < 33; ++e) w1r[e] = p.hy_w1[e * 64 + j];
    const float fq = p.hy_freq[j], b1 = p.hy_b1[j];
#pragma unroll 1
    for (int q = 0; q < 16; ++q) {
      const int pos = wid * 16 + q;
      const float4* zp = (const float4*)(z + pos * 36);
      float a = b1;
#pragma unroll
      for (int e4 = 0; e4 < 8; ++e4) {
        float4 zv = zp[e4];
        a += zv.x * w1r[4 * e4] + zv.y * w1r[4 * e4 + 1] + zv.z * w1r[4 * e4 + 2] + zv.w * w1r[4 * e4 + 3];
      }
      a += z[pos * 36 + 32] * w1r[32];
      h1[pos * 64 + j] = sinf(fq * a);
    }
  }
  __syncthreads();
  {
    const int j = lane;
    float w2r[64];
#pragma unroll
    for (int e = 0; e < 64; ++e) w2r[e] = p.hy_w2[e * 64 + j];
    const float fq = p.hy_freq[j], b2 = p.hy_b2[j];
#pragma unroll 1
    for (int q = 0; q < 16; ++q) {
      const int pos = wid * 16 + q;
      const float4* hp = (const float4*)(h1 + pos * 64);
      float a = b2;
#pragma unroll
      for (int e4 = 0; e4 < 16; ++e4) {
        float4 hv = hp[e4];
        a += hv.x * w2r[4 * e4] + hv.y * w2r[4 * e4 + 1] + hv.z * w2r[4 * e4 + 2] + hv.w * w2r[4 * e4 + 3];
      }
      h2[pos * 68 + j] = sinf(fq * a);
    }
  }
  __syncthreads();
  const int colw = cc * 512 + wid * 64;
  bf16x8_t Ahi[2][4], Alo[2][4];
#pragma unroll
  for (int ct = 0; ct < 2; ++ct)
#pragma unroll
    for (int ks = 0; ks < 4; ++ks) {
      float v[8];
#pragma unroll
      for (int j = 0; j < 8; ++j) v[j] = p.hy_w3[(size_t)(16 * ks + 8 * h + j) * 8192 + colw + ct * 32 + r];
      split8(v, Ahi[ct][ks], Alo[ct][ks]);
    }
  const int o = cc >> 3, dir = (cc >> 2) & 1;
  u16* Rg = (u16*)(p.ws + OFF_FILT) + (size_t)o * 2048 * 4096;
  const float min_decay = -3.0701134573253945f, max_decay = -15.350567286626972f;
#pragma unroll 1
  for (int pp = 0; pp < 2; ++pp) {
    f32x16_t acc[2][2];
#pragma unroll
    for (int ct = 0; ct < 2; ++ct)
#pragma unroll
      for (int q = 0; q < 2; ++q)
#pragma unroll
        for (int i = 0; i < 16; ++i) acc[ct][q][i] = 0.f;
#pragma unroll
    for (int q = 0; q < 2; ++q)
#pragma unroll
      for (int ks = 0; ks < 4; ++ks) {
        const float* hp = h2 + ((pp * 2 + q) * 32 + r) * 68 + 16 * ks + 8 * h;
        float4 x0 = *(const float4*)hp, x1 = *(const float4*)(hp + 4);
        float v[8] = {x0.x, x0.y, x0.z, x0.w, x1.x, x1.y, x1.z, x1.w};
        bf16x8_t Bhi, Blo;
        split8(v, Bhi, Blo);
#pragma unroll
        for (int ct = 0; ct < 2; ++ct) {
          acc[ct][q] = __builtin_amdgcn_mfma_f32_32x32x16_bf16(Ahi[ct][ks], Bhi, acc[ct][q], 0, 0, 0);
          acc[ct][q] = __builtin_amdgcn_mfma_f32_32x32x16_bf16(Ahi[ct][ks], Blo, acc[ct][q], 0, 0, 0);
          acc[ct][q] = __builtin_amdgcn_mfma_f32_32x32x16_bf16(Alo[ct][ks], Bhi, acc[ct][q], 0, 0, 0);
        }
      }
    int hh = h;
    asm volatile("" : "+v"(hh));
#pragma unroll
    for (int ct = 0; ct < 2; ++ct)
#pragma unroll
      for (int i = 0; i < 16; ++i) {
        const int col = colw + ct * 32 + (i & 3) + 8 * (i >> 2) + 4 * hh;
        const int ch = col & 2047;
        const float b3 = p.hy_b3[col];
        const float ad = fabsf(min_decay + (float)ch * ((max_decay - min_decay) / 2047.f));
        u16* R = Rg + (size_t)ch * 4096;
#pragma unroll
        for (int q = 0; q < 2; ++q) {
          const int t = pg * 128 + (pp * 2 + q) * 32 + r;
          const float tn = (float)t / 2047.f;
          float v = (acc[ct][q][i] + b3) * (__expf(-tn * ad) + 0.05f);
          if (dir == 0) {
            if (t == 0) v += p.hy_bias_d[o * 2048 + ch];
            R[2048 - t] = f2bf(v);
          } else {
            if (t > 0) R[2048 + t] = f2bf(v);
            else R[0] = 0;
          }
        }
      }
  }
  __syncthreads();
}

constexpr int N_CV_AI = 16 * 40, N_CV_AO = 16 * 16, N_CV_HI = 16 * 64, N_CV_HO = 16 * 16;
constexpr int N_CV = N_CV_AI + N_CV_AO + N_CV_HI + N_CV_HO;
#define CV_DECODE(I, W_, Wt_, N_, tk_, tn_, perm_) do { int _i = (I); \
    const bool _a = _i < N_CV_AI, _b2 = _i < N_CV_AI + N_CV_AO, _c = _i < N_CV_AI + N_CV_AO + N_CV_HI; \
    W_ = _a ? p.attn_w_in : (_b2 ? p.attn_w_out : (_c ? p.hy_w_in : p.hy_w_out)); \
    Wt_ = (u16*)(p.ws + (_a ? OFF_WT_AI : (_b2 ? OFF_WT_AO : (_c ? OFF_WT_HI : OFF_WT_HO)))); \
    N_ = _a ? 5120 : (_b2 ? 2048 : (_c ? 8192 : 2048)); \
    const int _nt = _a ? 40 : (_b2 ? 16 : (_c ? 64 : 16)); \
    _i -= _a ? 0 : (_b2 ? N_CV_AI : (_c ? N_CV_AI + N_CV_AO : N_CV_AI + N_CV_AO + N_CV_HI)); \
    tk_ = _i / _nt; tn_ = _i - tk_ * _nt; perm_ = _a && (tn_ * 128 < 2560); } while (0)
__device__ __forceinline__ void p0_convert_all(const Params& p, float* sm) {
  const int tid = threadIdx.x;
  float4 r0, r1, r2, r3, r4, r5, r6, r7;
#define CV_LOAD(W_, N_, tk_, tn_) do { const float* _b = (W_) + (size_t)((tk_) * 128 + (tid >> 5)) * (N_) + (tn_) * 128 + (tid & 31) * 4; const size_t _s = (size_t)16 * (N_); \
    r0 = *(const float4*)(_b); r1 = *(const float4*)(_b + _s); r2 = *(const float4*)(_b + 2 * _s); r3 = *(const float4*)(_b + 3 * _s); \
    r4 = *(const float4*)(_b + 4 * _s); r5 = *(const float4*)(_b + 5 * _s); r6 = *(const float4*)(_b + 6 * _s); r7 = *(const float4*)(_b + 7 * _s); } while (0)
#define CV_PUT(R, I) do { float* _d = sm + ((tid >> 5) + 16 * (I)) * 129 + (tid & 31) * 4; _d[0] = (R).x; _d[1] = (R).y; _d[2] = (R).z; _d[3] = (R).w; } while (0)
  int it = blockIdx.x;
  const float* cW; u16* cWt; int cN, ctk, ctn; bool cperm;
  CV_DECODE(it < N_CV ? it : 0, cW, cWt, cN, ctk, ctn, cperm);
  if (it < N_CV) CV_LOAD(cW, cN, ctk, ctn);
  while (it < N_CV) {
    __syncthreads();
    CV_PUT(r0, 0); CV_PUT(r1, 1); CV_PUT(r2, 2); CV_PUT(r3, 3); CV_PUT(r4, 4); CV_PUT(r5, 5); CV_PUT(r6, 6); CV_PUT(r7, 7);
    __syncthreads();
    const int nit = it + gridDim.x;
    const float* nW; u16* nWt; int nN, ntk, ntn; bool nperm;
    CV_DECODE(nit < N_CV ? nit : 0, nW, nWt, nN, ntk, ntn, nperm);
    if (nit < N_CV) CV_LOAD(nW, nN, ntk, ntn);
    const int row = (tid & 15) | (((tid >> 6) & 7) << 4);
    int src = row;
    if (cperm) { const int g = row >> 5, w = row & 31, i16 = 4 * (w >> 3) + (w & 3), nn = (w >> 2) & 1; src = (g >> 1) * 64 + nn * 32 + (g & 1) * 16 + i16; }
#pragma unroll
    for (int i = 0; i < 4; ++i) {
      const int kch = ((tid >> 4) & 3) | (i << 2);
      unsigned w[4];
#pragma unroll
      for (int j = 0; j < 4; ++j) {
        float a = sm[(kch * 8 + 2 * j) * 129 + src];
        float b = sm[(kch * 8 + 2 * j + 1) * 129 + src];
        w[j] = pk2(a, b);
      }
      *(uint4*)(cWt + (size_t)(ctn * 128 + row) * 2048 + ctk * 128 + kch * 8) = make_uint4(w[0], w[1], w[2], w[3]);
    }
    cW = nW; cWt = nWt; cN = nN; ctk = ntk; ctn = ntn; cperm = nperm;
    it = nit;
  }
#undef CV_LOAD
#undef CV_PUT
}

__device__ __forceinline__ void phase0(const Params& p, float* sm) {
  for (int it = blockIdx.x; it < 256; it += gridDim.x) p0_adaln(p, it, sm);
  if (blockIdx.x == gridDim.x - 1) p0_rope(p);
  __syncthreads();
  for (int it = blockIdx.x; it < 256; it += gridDim.x) p0_filter(p, it, sm);
  __syncthreads();
  p0_convert_all(p, sm);
}

__device__ __forceinline__ void norm_row(const float* __restrict__ src, const float* __restrict__ g, const float* shift,
                         const float* scale, u16* dst_bf, float* dst_f, int lane) {
  float4 v[8];
  float ss = 0.f;
#pragma unroll
  for (int j = 0; j < 8; ++j) {
    v[j] = *(const float4*)(src + (j * 64 + lane) * 4);
    ss += v[j].x * v[j].x + v[j].y * v[j].y + v[j].z * v[j].z + v[j].w * v[j].w;
  }
  ss = wave_sum(ss);
  float r = rsqrtf(ss * (1.f / 2048.f) + 1e-6f);
#pragma unroll
  for (int j = 0; j < 8; ++j) {
    int c = (j * 64 + lane) * 4;
    float4 gg = *(const float4*)(g + c);
    float4 o = make_float4(v[j].x * r * gg.x, v[j].y * r * gg.y, v[j].z * r * gg.z, v[j].w * r * gg.w);
    if (dst_bf) {
      float4 sh = *(const float4*)(shift + c);
      float4 sc = *(const float4*)(scale + c);
      o.x = o.x * (1.f + sc.x) + sh.x; o.y = o.y * (1.f + sc.y) + sh.y;
      o.z = o.z * (1.f + sc.z) + sh.z; o.w = o.w * (1.f + sc.w) + sh.w;
      uint2 pk;
      pk.x = pk2(o.x, o.y);
      pk.y = pk2(o.z, o.w);
      *(uint2*)(dst_bf + c) = pk;
    } else {
      *(float4*)(dst_f + c) = o;
    }
  }
}

__device__ __forceinline__ void phase_norm(const Params& p, int mode) {
  const int wid = threadIdx.x >> 6, lane = threadIdx.x & 63;
  const float* mod = (const float*)(p.ws + OFF_MOD);
  int nrows = (mode == 0) ? (MT + MC) : MT;
  for (int row = blockIdx.x * 8 + wid; row < nrows; row += gridDim.x * 8) {
    if (mode == 0) {
      if (row < MT) {
        int b = row >> 11;
        const float* m = mod + (0 * 5 + b) * 6144;
        norm_row(p.x + (size_t)row * 2048, p.norm_g, m, m + 2048, (u16*)(p.ws + OFF_ACT) + (size_t)row * 2048, nullptr, lane);
      } else {
        int rc = row - MT;
        const float* m = mod + (0 * 5 + 4) * 6144;
        norm_row(p.ctx + (size_t)rc * 2048, p.norm_g, m, m + 2048, (u16*)(p.ws + OFF_HC) + (size_t)rc * 2048, nullptr, lane);
      }
    } else if (mode == 1) {
      int b = row >> 11;
      const float* m = mod + (1 * 5 + b) * 6144;
      norm_row(p.out + (size_t)row * 2048, p.norm_g + 2048, m, m + 2048, (u16*)(p.ws + OFF_ACT) + (size_t)row * 2048, nullptr, lane);
    } else {
      norm_row(p.out + (size_t)row * 2048, p.final_g, nullptr, nullptr, nullptr, p.out + (size_t)row * 2048, lane);
    }
  }
}

namespace pg8 {
#define PG8_LAS __attribute__((address_space(3)))
typedef unsigned short bf16_t;
typedef short bf16x8 __attribute__((ext_vector_type(8)));
typedef float f32x4 __attribute__((ext_vector_type(4)));
typedef unsigned u32x4 __attribute__((ext_vector_type(4)));
constexpr int BM = 256, BK = 64, HALF = 128, HTB = HALF * BK * 2  , STAGE_BYTES = 8 * HTB, NXCD = 8, WGM = 8;

__host__ __device__ __forceinline__ int lds_byte(int r, int c) { const int st = (r >> 4) * 2 + (c >> 5), rr = r & 15, cc = c & 31, ob = rr * 64 + cc * 2; return st * 1024 + (ob ^ (((ob >> 9) & 1) << 5)); }
__host__ __device__ __forceinline__ void stage_rc(int b, int& R, int& C) { const int st = b / 1024, sb = b % 1024, swz = sb ^ (((sb >> 9) & 1) << 5); R = (st >> 1) * 16 + swz / 64; C = (st & 1) * 32 + (swz % 64) / 2; }
__host__ __device__ __forceinline__ int perm32(int rho) { const int n = rho >> 4, i = rho & 15; return 8 * (i >> 2) + 4 * n + (i & 3); }

struct Unit { int pm, pn; };
struct Gemm { const bf16_t* A; const bf16_t* Bt; int M, N, K; int agroup; };

struct StaticOrder {
    int nM, nN, nwg, G, c;
    __host__ __device__ void init(int M, int N, int G_, int c_) { nM = M / BM; nN = N / BM; nwg = nM * nN; G = G_; c = c_; }
    __host__ __device__ bool next(int i, Unit& u) const {
        const long L = (long)i * G + c; if (L >= nwg) return false;
        int wgid = (int)L; { const int q = nwg / NXCD, r = nwg % NXCD, xcd = wgid % NXCD, off = wgid / NXCD; wgid = (xcd < r ? xcd * (q + 1) : r * (q + 1) + (xcd - r) * q) + off; }
        const int nig = WGM * nN, gid = wgid / nig, fm = gid * WGM, gsz = (nM - fm) < WGM ? (nM - fm) : WGM;
        u.pm = fm + ((wgid % nig) % gsz); u.pn = (wgid % nig) / gsz; return true;
    }
    __device__ __forceinline__ void a_ready(const Unit&) const {}
    __device__ __forceinline__ void done(const Unit&) const {}
};
__device__ __forceinline__ unsigned cvt_pk_bf16(float lo, float hi) { unsigned r; asm volatile("v_cvt_pk_bf16_f32 %0, %1, %2" : "=v"(r) : "v"(lo), "v"(hi)); return r; }
template <class Epi, class Sched, bool AGROUP = false>
__device__ __forceinline__ void gemm_phase(PG8_LAS unsigned char* lds, const Gemm g, const Sched& S, const Epi& E) {
    const int tid = threadIdx.x, wid = __builtin_amdgcn_readfirstlane(tid >> 6), lane = tid & 63, wr = wid >> 2, wc = wid & 3, fr = lane & 15, fq = lane >> 4;
    const int K = g.K, nt = K / BK;
    unsigned voffA[2], voffB[2];
#pragma unroll
    for (int i = 0; i < 2; ++i) { int R, C; stage_rc(tid * 16 + i * 8192, R, C); const int Rb = Epi::PERM ? ((R & ~31) + perm32(R & 31)) : R;
        voffA[i] = AGROUP ? (unsigned)((C >> 3) * g.M + R) * 16u : (unsigned)(R * K + C) * 2u; voffB[i] = (unsigned)(Rb * K + C) * 2u; }
    const size_t kstep = (size_t)(BK * 2);
    const size_t hstep = (size_t)HALF * K * 2;
    const size_t tstep = 2 * hstep;
    const size_t kstepA = AGROUP ? (size_t)(BK / 8) * g.M * 16 : kstep, hstepA = AGROUP ? (size_t)HALF * 16 : hstep, tstepA = 2 * hstepA;
    const unsigned ldsw = (unsigned)wid * 1024u;
    const int aoff = lds_byte(wr * 64 + fr, fq * 8), boff = lds_byte(wc * 32 + fr, fq * 8);
#define PG8_SA(b, h) (((b) * 2 + (h)) * HTB)
#define PG8_SB(b, h) ((4 + (b) * 2 + (h)) * HTB)
#define PG8_STAGE(bufoff, gbase, voff) do { _Pragma("unroll") for (int _i = 0; _i < 2; ++_i) \
        __builtin_amdgcn_global_load_lds((const unsigned*)((const char*)(gbase) + (voff)[_i]), (PG8_LAS unsigned*)(lds + (bufoff) + ldsw + _i * 8192), 16, 0, 0); } while (0)
#define PG8_LDA(dst, b, h) do { _Pragma("unroll") for (int m = 0; m < 4; ++m) _Pragma("unroll") for (int k = 0; k < 2; ++k) dst[m][k] = *(const PG8_LAS bf16x8*)(lds + PG8_SA(b, h) + aoff + m * 2048 + k * 1024); } while (0)
#define PG8_LDB(dst, b, h) do { _Pragma("unroll") for (int n = 0; n < 2; ++n) _Pragma("unroll") for (int k = 0; k < 2; ++k) dst[n][k] = *(const PG8_LAS bf16x8*)(lds + PG8_SB(b, h) + boff + n * 2048 + k * 1024); } while (0)
#define PG8_MMA(ai, bj, At, Bt) do { __builtin_amdgcn_s_setprio(1); _Pragma("unroll") for (int m = 0; m < 4; ++m) _Pragma("unroll") for (int n = 0; n < 2; ++n) _Pragma("unroll") for (int k = 0; k < 2; ++k) \
        acc[ai][bj][m][n] = __builtin_amdgcn_mfma_f32_16x16x32_bf16(Bt[n][k], At[m][k], acc[ai][bj][m][n], 0, 0, 0); __builtin_amdgcn_s_setprio(0); } while (0)
#define PG8_WAIT_V(n) asm volatile("s_waitcnt vmcnt(" #n ")" ::: "memory")
#define PG8_WAIT_L(n) asm volatile("s_waitcnt lgkmcnt(" #n ")" ::: "memory")
#define PG8_BAR __builtin_amdgcn_s_barrier()
#define PG8_SCHED __builtin_amdgcn_sched_barrier(0)
    Unit cur, nxt; int ui = 0;
    if (!S.next(0, cur)) return;
    f32x4 acc[2][2][4][2];
#pragma unroll
    for (int a = 0; a < 2; ++a)
#pragma unroll
        for (int b = 0; b < 2; ++b)
#pragma unroll
            for (int m = 0; m < 4; ++m)
#pragma unroll
                for (int n = 0; n < 2; ++n) acc[a][b][m][n] = (f32x4){0.f, 0.f, 0.f, 0.f};
    bf16x8 At[4][2], B0[2][2], B1[2][2];
    const char* cA = (const char*)g.A + (size_t)cur.pm * tstepA; const char* cB = (const char*)g.Bt + (size_t)cur.pn * tstep;
    S.a_ready(cur);
    PG8_STAGE(PG8_SB(0, 0), cB, voffB); PG8_STAGE(PG8_SA(0, 0), cA, voffA); PG8_STAGE(PG8_SB(0, 1), cB + hstep, voffB); PG8_STAGE(PG8_SA(0, 1), cA + hstepA, voffA);
    if (wr == 1) PG8_BAR;
    PG8_WAIT_V(4); PG8_BAR;
    PG8_STAGE(PG8_SB(1, 0), cB + kstep, voffB); PG8_STAGE(PG8_SA(1, 0), cA + kstepA, voffA); PG8_STAGE(PG8_SB(1, 1), cB + hstep + kstep, voffB);
    PG8_WAIT_V(6); PG8_BAR;
    for (;;) {
        const bool has_next = S.next(ui + 1, nxt);
        const char* nA = has_next ? (const char*)g.A + (size_t)nxt.pm * tstepA : cA; const char* nB = has_next ? (const char*)g.Bt + (size_t)nxt.pn * tstep : cB;
        for (int t = 0; t < nt; t += 2) {
            const bool last = (t == nt - 2);
            const char* a1 = cA + (size_t)(t + 1) * kstepA;
            const char* a2 = last ? nA : cA + (size_t)(t + 2) * kstepA; const char* b2 = last ? nB : cB + (size_t)(t + 2) * kstep;
            const char* a3 = a2 + kstepA; const char* b3 = b2 + kstep;
            if (last && has_next) S.a_ready(nxt);
            PG8_LDB(B0, 0, 0); PG8_SCHED; PG8_LDA(At, 0, 0); PG8_STAGE(PG8_SA(1, 1), a1 + hstepA, voffA);
            PG8_WAIT_L(8); PG8_BAR; PG8_WAIT_L(0); PG8_MMA(0, 0, At, B0); PG8_BAR; PG8_SCHED;
            PG8_LDB(B1, 0, 1); PG8_STAGE(PG8_SB(0, 0), b2, voffB);
            PG8_BAR; PG8_WAIT_L(0); PG8_MMA(0, 1, At, B1); PG8_BAR;
            PG8_LDA(At, 0, 1); PG8_STAGE(PG8_SA(0, 0), a2, voffA);
            PG8_BAR; PG8_WAIT_L(0); PG8_MMA(1, 0, At, B0); PG8_BAR; PG8_SCHED;
            PG8_STAGE(PG8_SB(0, 1), b2 + hstep, voffB);
            PG8_WAIT_V(6); PG8_BAR; PG8_MMA(1, 1, At, B1); PG8_BAR;
            PG8_LDB(B0, 1, 0); PG8_SCHED; PG8_LDA(At, 1, 0); PG8_STAGE(PG8_SA(0, 1), a2 + hstepA, voffA);
            PG8_WAIT_L(8); PG8_BAR; PG8_WAIT_L(0); PG8_MMA(0, 0, At, B0); PG8_BAR; PG8_SCHED;
            PG8_LDB(B1, 1, 1); PG8_STAGE(PG8_SB(1, 0), b3, voffB);
            PG8_BAR; PG8_WAIT_L(0); PG8_MMA(0, 1, At, B1); PG8_BAR;
            PG8_LDA(At, 1, 1); PG8_STAGE(PG8_SA(1, 0), a3, voffA);
            PG8_BAR; PG8_WAIT_L(0); PG8_MMA(1, 0, At, B0); PG8_BAR; PG8_SCHED;
            PG8_STAGE(PG8_SB(1, 1), b3 + hstep, voffB);
            PG8_WAIT_V(6); PG8_BAR; PG8_MMA(1, 1, At, B1); PG8_BAR;
        }
        if constexpr (!Epi::AFTER_DRAIN) { E(acc, cur, wr, wc, fr, fq); S.done(cur); }
        if (!has_next) break;
#pragma unroll
        for (int a = 0; a < 2; ++a)
#pragma unroll
            for (int b = 0; b < 2; ++b)
#pragma unroll
                for (int m = 0; m < 4; ++m)
#pragma unroll
                    for (int n = 0; n < 2; ++n) acc[a][b][m][n] = (f32x4){0.f, 0.f, 0.f, 0.f};
        cur = nxt; cA = nA; cB = nB; ++ui;
    }
    PG8_WAIT_V(0);
    if (wr == 0) PG8_BAR;
    PG8_BAR;
    if constexpr (Epi::AFTER_DRAIN) { E.fused(acc, cur, wr, wc, fr, fq, lds, wid, lane); S.done(cur); }
#undef PG8_SA
#undef PG8_SB
#undef PG8_STAGE
#undef PG8_LDA
#undef PG8_LDB
#undef PG8_MMA
#undef PG8_WAIT_V
#undef PG8_WAIT_L
#undef PG8_BAR
#undef PG8_SCHED
}
}

__device__ __forceinline__ uint2 pack4(pg8::f32x4 v) {
  uint2 r;
  r.x = pk2(v[0], v[1]);
  r.y = pk2(v[2], v[3]);
  return r;
}
struct EpiAttnIn {
  static constexpr bool PERM = true, AFTER_DRAIN = false;
  u16* O; const float* rope;
  __device__ __forceinline__ void operator()(const pg8::f32x4 (&acc)[2][2][4][2], const pg8::Unit& u, int wr, int wc, int fr, int fq) const {
    const int row0 = u.pm * 256 + wr * 64 + fr, col0 = u.pn * 256 + wc * 32 + 8 * fq;
    const bool dorope = (u.pn < 10);
    const int axis = wc >> 1, i0 = (wc & 1) * 16 + 4 * fq;
#pragma unroll
    for (int ai = 0; ai < 2; ++ai)
#pragma unroll
      for (int m = 0; m < 4; ++m) {
        const int row = row0 + ai * 128 + m * 16;
        u16* rowp = O + (size_t)row * 5120 + col0;
        if (dorope) {
          const int s = row & 2047;
          const int pos = axis ? (s & 63) : (s >> 6);
          const float4* rp = (const float4*)(rope + (pos * 32 + i0) * 2);
          float4 c01 = rp[0], c23 = rp[1];
#pragma unroll
          for (int bj = 0; bj < 2; ++bj) {
            pg8::f32x4 a = acc[ai][bj][m][0], b = acc[ai][bj][m][1], o0, o1;
            o0[0] = a[0] * c01.x - b[0] * c01.y; o1[0] = b[0] * c01.x + a[0] * c01.y;
            o0[1] = a[1] * c01.z - b[1] * c01.w; o1[1] = b[1] * c01.z + a[1] * c01.w;
            o0[2] = a[2] * c23.x - b[2] * c23.y; o1[2] = b[2] * c23.x + a[2] * c23.y;
            o0[3] = a[3] * c23.z - b[3] * c23.w; o1[3] = b[3] * c23.z + a[3] * c23.w;
            const uint2 lo = pack4(o0), hi = pack4(o1);
            *(uint4*)(rowp + bj * 128) = make_uint4(lo.x, lo.y, hi.x, hi.y);
          }
        } else {
#pragma unroll
          for (int bj = 0; bj < 2; ++bj) {
            const uint2 lo = pack4(acc[ai][bj][m][0]), hi = pack4(acc[ai][bj][m][1]);
            *(uint4*)(rowp + bj * 128) = make_uint4(lo.x, lo.y, hi.x, hi.y);
          }
        }
      }
  }
};
struct EpiRaw {
  static constexpr bool PERM = true, AFTER_DRAIN = false;
  u16* O; int ldc;
  __device__ __forceinline__ void operator()(const pg8::f32x4 (&acc)[2][2][4][2], const pg8::Unit& u, int wr, int wc, int fr, int fq) const {
    const int row0 = u.pm * 256 + wr * 64 + fr, col0 = u.pn * 256 + wc * 32 + 8 * fq;
#pragma unroll
    for (int ai = 0; ai < 2; ++ai)
#pragma unroll
      for (int m = 0; m < 4; ++m) {
        u16* rowp = O + (size_t)(row0 + ai * 128 + m * 16) * ldc + col0;
#pragma unroll
        for (int bj = 0; bj < 2; ++bj) {
          const uint2 lo = pack4(acc[ai][bj][m][0]), hi = pack4(acc[ai][bj][m][1]);
          *(uint4*)(rowp + bj * 128) = make_uint4(lo.x, lo.y, hi.x, hi.y);
        }
      }
  }
};
struct EpiRes {
  static constexpr bool PERM = false, AFTER_DRAIN = false;
  float* out; const float* base; const float* gate;
  __device__ __forceinline__ void operator()(const pg8::f32x4 (&acc)[2][2][4][2], const pg8::Unit& u, int wr, int wc, int fr, int fq) const {
    const int row0 = u.pm * 256 + wr * 64 + fr, col0 = u.pn * 256 + wc * 32 + 4 * fq;
    const int b = (u.pm * 256) >> 11;
    pg8::f32x4 gv[2][2];
#pragma unroll
    for (int bj = 0; bj < 2; ++bj)
#pragma unroll
      for (int n = 0; n < 2; ++n) gv[bj][n] = *(const pg8::f32x4*)(gate + b * 6144 + col0 + bj * 128 + n * 16);
#pragma unroll
    for (int ai = 0; ai < 2; ++ai)
#pragma unroll
      for (int m = 0; m < 4; ++m) {
        const size_t off = (size_t)(row0 + ai * 128 + m * 16) * 2048 + col0;
#pragma unroll
        for (int bj = 0; bj < 2; ++bj)
#pragma unroll
          for (int n = 0; n < 2; ++n) {
            pg8::f32x4 bv = *(const pg8::f32x4*)(base + off + bj * 128 + n * 16);
            *(pg8::f32x4*)(out + off + bj * 128 + n * 16) = bv + gv[bj][n] * acc[ai][bj][m][n];
          }
      }
  }
};

struct EpiResNorm {
  static constexpr bool PERM = false, AFTER_DRAIN = true;
  float* out; const float* base; const float* gate;
  float* rowss; unsigned* pcnt;
  const float* g; const float* shsc;
  u16* hx;
  static __device__ __forceinline__ int loff(int row, int chunk) { return row * 1024 + ((chunk ^ (row & 63)) << 4); }
  __device__ __forceinline__ void fused(pg8::f32x4 (&acc)[2][2][4][2], const pg8::Unit& u, int wr, int wc, int fr, int fq,
                                        PG8_LAS unsigned char* lds, int wid, int lane) const {
    const int R0 = u.pm * 256, C0 = u.pn * 256;
    const int b = R0 >> 11;
    const int frow = wr * 64 + fr, fchunk = wc * 8 + fq;
    {
      pg8::f32x4 gv[2][2];
#pragma unroll
      for (int bj = 0; bj < 2; ++bj)
#pragma unroll
        for (int n = 0; n < 2; ++n) gv[bj][n] = *(const pg8::f32x4*)(gate + b * 6144 + C0 + wc * 32 + 4 * fq + bj * 128 + n * 16);
#pragma unroll
      for (int ai = 0; ai < 2; ++ai) {
        {
          pg8::f32x4 t[16];
#pragma unroll
          for (int i = 0; i < 16; ++i) t[i] = *(const pg8::f32x4*)(base + (size_t)(R0 + ai * 128 + wid * 16 + i) * 2048 + C0 + 4 * lane);
#pragma unroll
          for (int i = 0; i < 16; ++i) *(PG8_LAS pg8::f32x4*)(lds + loff(wid * 16 + i, lane)) = t[i];
        }
        __syncthreads();
#pragma unroll
        for (int m = 0; m < 4; ++m) {
          float ss = 0.f;
#pragma unroll
          for (int bj = 0; bj < 2; ++bj)
#pragma unroll
            for (int n = 0; n < 2; ++n) {
              const pg8::f32x4 bv = *(const PG8_LAS pg8::f32x4*)(lds + loff(frow + 16 * m, fchunk + 32 * bj + 4 * n));
              const pg8::f32x4 v = bv + gv[bj][n] * acc[ai][bj][m][n];
              acc[ai][bj][m][n] = v;
              ss += v[0] * v[0] + v[1] * v[1] + v[2] * v[2] + v[3] * v[3];
            }
          ss += __shfl_xor(ss, 16, 64);
          ss += __shfl_xor(ss, 32, 64);
          if (fq == 0) unsafeAtomicAdd(rowss + R0 + ai * 128 + frow + 16 * m, ss);
        }
        __syncthreads();
      }
    }
    asm volatile("s_waitcnt vmcnt(0)" ::: "memory");
    __syncthreads();
    if (threadIdx.x == 0) {
      unsigned* c = pcnt + u.pm * 64;
      __hip_atomic_fetch_add(c, 1u, __ATOMIC_RELAXED, __HIP_MEMORY_SCOPE_AGENT);
      unsigned spins = 0;
      while (__hip_atomic_load(c, __ATOMIC_RELAXED, __HIP_MEMORY_SCOPE_AGENT) < 8u && ++spins < (1u << 22)) __builtin_amdgcn_s_sleep(1);
    }
    __syncthreads();
    const pg8::f32x4 gg = *(const pg8::f32x4*)(g + C0 + 4 * lane);
    pg8::f32x4 sh = gg, sc = gg;
    if (hx) {
      sh = *(const pg8::f32x4*)(shsc + b * 6144 + C0 + 4 * lane);
      sc = *(const pg8::f32x4*)(shsc + b * 6144 + 2048 + C0 + 4 * lane) + 1.f;
    }
#pragma unroll
    for (int ai = 0; ai < 2; ++ai) {
#pragma unroll
      for (int m = 0; m < 4; ++m)
#pragma unroll
        for (int bj = 0; bj < 2; ++bj)
#pragma unroll
          for (int n = 0; n < 2; ++n)
            *(PG8_LAS pg8::f32x4*)(lds + loff(frow + 16 * m, fchunk + 32 * bj + 4 * n)) = acc[ai][bj][m][n];
      __syncthreads();
#pragma unroll 4
      for (int i = 0; i < 16; ++i) {
        const int lrow = wid * 16 + i, row = R0 + ai * 128 + lrow;
        const pg8::f32x4 v = *(const PG8_LAS pg8::f32x4*)(lds + loff(lrow, lane));
        const float ss = __hip_atomic_load(rowss + row, __ATOMIC_RELAXED, __HIP_MEMORY_SCOPE_AGENT);
        const float r = rsqrtf(ss * (1.f / 2048.f) + 1e-6f);
        const size_t off = (size_t)row * 2048 + C0 + 4 * lane;
        pg8::f32x4 o = v * r * gg;
        if (hx) {
          *(pg8::f32x4*)(out + off) = v;
          o = o * sc + sh;
          *(uint2*)(hx + off) = pack4(o);
        } else {
          *(pg8::f32x4*)(out + off) = o;
        }
      }
      __syncthreads();
    }
  }
};
template <class Epi, bool AGROUP = false>
__device__ __forceinline__ void run_gemm(float* sm, const u16* A, const u16* Bt, int M, int N, const Epi& E, int c) {
  pg8::Gemm g{A, Bt, M, N, 2048, AGROUP ? 1 : 0};
  pg8::StaticOrder S; S.init(M, N, (int)gridDim.x, c);
  pg8::gemm_phase<Epi, pg8::StaticOrder, AGROUP>((PG8_LAS unsigned char*)sm, g, S, E);
  __syncthreads();
}

template <int MODE>
__device__ __forceinline__ void epi_pair(const Params& p, int m, int n, float a0, float a1) {
  if (MODE == 1) {
    u16* px = (u16*)(p.ws + OFF_BIG);
    float o0 = a0, o1 = a1;
    if (n < 2560) {
      int g = (n >> 5) & 3, fr = n & 15;
      int axis = g >> 1, i = (g & 1) * 16 + fr;
      int s = m & 2047;
      int pos = axis ? (s & 63) : (s >> 6);
      float2 cs = ((const float2*)(p.ws + OFF_ROPE))[pos * 32 + i];
      o0 = a0 * cs.x - a1 * cs.y;
      o1 = a1 * cs.x + a0 * cs.y;
    }
    px[(size_t)m * 5120 + n] = f2bf(o0);
    px[(size_t)m * 5120 + n + 16] = f2bf(o1);
  } else if (MODE == 5) {
    u16* kvc = (u16*)(p.ws + OFF_KVC);
    kvc[(size_t)m * 1024 + n] = f2bf(a0);
    kvc[(size_t)m * 1024 + n + 16] = f2bf(a1);
  } else if (MODE == 2) {
    const float* mod = (const float*)(p.ws + OFF_MOD);
    int b = m >> 11;
    const float* gate = mod + (0 * 5 + b) * 6144 + 4096;
    p.out[(size_t)m * 2048 + n] = p.x[(size_t)m * 2048 + n] + gate[n] * a0;
    p.out[(size_t)m * 2048 + n + 16] = p.x[(size_t)m * 2048 + n + 16] + gate[n + 16] * a1;
  } else if (MODE == 3) {
    u16* pp = (u16*)(p.ws + OFF_BIG);
    pp[(size_t)m * 8192 + n] = f2bf(a0);
    pp[(size_t)m * 8192 + n + 16] = f2bf(a1);
  } else if (MODE == 4) {
    const float* mod = (const float*)(p.ws + OFF_MOD);
    int b = m >> 11;
    const float* gate = mod + (1 * 5 + b) * 6144 + 4096;
    p.out[(size_t)m * 2048 + n] += gate[n] * a0;
    p.out[(size_t)m * 2048 + n + 16] += gate[n + 16] * a1;
  }
}

template <int MODE>
__device__ __forceinline__ void naive_gemm(const Params& p, const u16* __restrict__ A, const u16* __restrict__ Wt, int M, int N) {
  const int tid = threadIdx.x;
  const int ml = tid >> 5, pl = tid & 31;
  const int ntn = N / 64, ntm = M / 16;
  for (int tile = blockIdx.x; tile < ntn * ntm; tile += gridDim.x) {
    int tm = tile / ntn, tn = tile % ntn;
    int m = tm * 16 + ml;
    int n = tn * 64 + (pl >> 4) * 32 + (pl & 15);
    const uint4* a = (const uint4*)(A + (size_t)m * 2048);
    const uint4* w0 = (const uint4*)(Wt + (size_t)n * 2048);
    const uint4* w1 = (const uint4*)(Wt + (size_t)(n + 16) * 2048);
    float acc0 = 0.f, acc1 = 0.f;
#pragma unroll 2
    for (int k = 0; k < 256; ++k) {
      uint4 av = a[k], b0 = w0[k], b1 = w1[k];
      acc0 += bflo(av.x) * bflo(b0.x) + bfhi(av.x) * bfhi(b0.x) + bflo(av.y) * bflo(b0.y) + bfhi(av.y) * bfhi(b0.y)
            + bflo(av.z) * bflo(b0.z) + bfhi(av.z) * bfhi(b0.z) + bflo(av.w) * bflo(b0.w) + bfhi(av.w) * bfhi(b0.w);
      acc1 += bflo(av.x) * bflo(b1.x) + bfhi(av.x) * bfhi(b1.x) + bflo(av.y) * bflo(b1.y) + bfhi(av.y) * bfhi(b1.y)
            + bflo(av.z) * bflo(b1.z) + bfhi(av.z) * bfhi(b1.z) + bflo(av.w) * bflo(b1.w) + bfhi(av.w) * bfhi(b1.w);
    }
    epi_pair<MODE>(p, m, n, acc0, acc1);
  }
}

__device__ __forceinline__ void phase_attn_naive(const Params& p, float* sm) {
  const int wid = threadIdx.x >> 6, lane = threadIdx.x & 63;
  float* qs = sm + wid * (128 + 640);
  float* pr = qs + 128;
  const u16* px = (const u16*)(p.ws + OFF_BIG);
  const u16* kvc = (const u16*)(p.ws + OFF_KVC);
  u16* og = (u16*)(p.ws + OFF_ACT);
  const float scale = 0.08838834764831845f;
  for (int item = blockIdx.x * 8 + wid; item < MT * 16; item += gridDim.x * 8) {
    int m = item >> 4, h = item & 15;
    int b = m >> 11, s = m & 2047, kvh = h >> 2, nblk = s >> 7;
    const u16* qrow = px + (size_t)m * 5120 + h * 128;
    qs[lane] = bf2f(qrow[lane]) * scale;
    qs[lane + 64] = bf2f(qrow[lane + 64]) * scale;
    asm volatile("s_waitcnt lgkmcnt(0)" ::: "memory");
    float mx = p.attn_sink[h];
#pragma unroll 1
    for (int j = 0; j < 10; ++j) {
      int kidx = j * 64 + lane;
      const u16* krow;
      bool valid;
      if (kidx < 384) {
        int kpos = (nblk - 1) * 128 + kidx;
        int rel = kpos - s;
        valid = (kpos >= 0) && (kpos < 2048) && (rel <= 128) && (rel >= -128);
        krow = px + (size_t)(b * 2048 + (valid ? kpos : 0)) * 5120 + 2048 + kvh * 128;
      } else {
        valid = true;
        krow = kvc + (size_t)(b * 256 + (kidx - 384)) * 1024 + kvh * 128;
      }
      float d = -1e30f;
      if (valid) {
        d = 0.f;
#pragma unroll 4
        for (int c = 0; c < 16; ++c) {
          uint4 kk = *(const uint4*)(krow + c * 8);
          const float* q8 = qs + c * 8;
          d += q8[0] * bflo(kk.x) + q8[1] * bfhi(kk.x) + q8[2] * bflo(kk.y) + q8[3] * bfhi(kk.y)
             + q8[4] * bflo(kk.z) + q8[5] * bfhi(kk.z) + q8[6] * bflo(kk.w) + q8[7] * bfhi(kk.w);
        }
      }
      pr[kidx] = d;
      mx = fmaxf(mx, d);
    }
    mx = wave_max(mx);
    float sum = 0.f;
#pragma unroll 1
    for (int j = 0; j < 10; ++j) {
      float d = pr[j * 64 + lane];
      float e = (d > -1e29f) ? __expf(d - mx) : 0.f;
      pr[j * 64 + lane] = e;
      sum += e;
    }
    sum = wave_sum(sum);
    sum += __expf(p.attn_sink[h] - mx);
    asm volatile("s_waitcnt lgkmcnt(0)" ::: "memory");
    float o0 = 0.f, o1 = 0.f;
    int k0 = s - 128 < 0 ? 0 : s - 128, k1 = s + 128 > 2047 ? 2047 : s + 128;
    for (int kpos = k0; kpos <= k1; ++kpos) {
      float pv = pr[kpos - (nblk - 1) * 128];
      unsigned vv = *(const unsigned*)(px + (size_t)(b * 2048 + kpos) * 5120 + 2560 + kvh * 128 + lane * 2);
      o0 += pv * bflo(vv); o1 += pv * bfhi(vv);
    }
    for (int c = 0; c < 256; ++c) {
      float pv = pr[384 + c];
      unsigned vv = *(const unsigned*)(kvc + (size_t)(b * 256 + c) * 1024 + 512 + kvh * 128 + lane * 2);
      o0 += pv * bflo(vv); o1 += pv * bfhi(vv);
    }
    float inv = 1.f / sum;
    unsigned gg = *(const unsigned*)(px + (size_t)m * 5120 + 3072 + h * 128 + lane * 2);
    float r0 = o0 * inv * siluf(bflo(gg)), r1 = o1 * inv * siluf(bfhi(gg));
    *(unsigned*)(og + (size_t)m * 2048 + h * 128 + lane * 2) = pk2(r0, r1);
    asm volatile("s_waitcnt lgkmcnt(0)" ::: "memory");
  }
}

__device__ __forceinline__ float sconv(const u16* pp, const float* cw, const float* cb, int b, int t, int c) {
  const u16* base = pp + (size_t)(b * 2048 + t) * 8192 + c;
  float v = cw[6144 + c] * bf2f(base[0]) + cb[c];
  if (t > 0) v += cw[c] * bf2f(base[-8192]);
  if (t < 2047) v += cw[2 * 6144 + c] * bf2f(base[8192]);
  return v;
}

__device__ __forceinline__ void phase_conv_naive(const Params& p, float* sm) {
  const int tid = threadIdx.x;
  float* u = sm;
  float* R = sm + 8192;
  const u16* pp = (const u16*)(p.ws + OFF_BIG);
  const u16* Rg = (const u16*)(p.ws + OFF_FILT);
  u16* yg = (u16*)(p.ws + OFF_ACT);
  for (int ch = blockIdx.x; ch < 2048; ch += gridDim.x) {
    for (int i = tid; i < 8192; i += NTHREADS) u[i] = sconv(pp, p.hy_conv_w, p.hy_conv_b, i >> 11, i & 2047, 4096 + ch);
    for (int i = tid; i < 4096; i += NTHREADS) R[i] = bf2f(Rg[((size_t)0 * 2048 + ch) * 4096 + i]);
    __syncthreads();
    float zr[16];
#pragma unroll
    for (int q = 0; q < 16; ++q) {
      int i = tid + q * NTHREADS;
      int b = i >> 11, t = i & 2047;
      const float* ub = u + b * 2048;
      const float* Rb = R + 2048 - t;
      float a = 0.f;
      for (int s = 0; s < 2048; ++s) a += Rb[s] * ub[s];
      zr[q] = a * sconv(pp, p.hy_conv_w, p.hy_conv_b, b, t, ch);
    }
    __syncthreads();
#pragma unroll
    for (int q = 0; q < 16; ++q) u[tid + q * NTHREADS] = zr[q];
    for (int i = tid; i < 4096; i += NTHREADS) R[i] = bf2f(Rg[((size_t)1 * 2048 + ch) * 4096 + i]);
    __syncthreads();
#pragma unroll
    for (int q = 0; q < 16; ++q) {
      int i = tid + q * NTHREADS;
      int b = i >> 11, t = i & 2047;
      const float* ub = u + b * 2048;
      const float* Rb = R + 2048 - t;
      float a = 0.f;
      for (int s = 0; s < 2048; ++s) a += Rb[s] * ub[s];
      float y = a * sconv(pp, p.hy_conv_w, p.hy_conv_b, b, t, 2048 + ch);
      float g = bf2f(pp[(size_t)(b * 2048 + t) * 8192 + 6144 + ch]);
      yg[(size_t)(b * 2048 + t) * 2048 + ch] = f2bf(y * siluf(g));
    }
    __syncthreads();
  }
}


typedef float f32x16 __attribute__((ext_vector_type(16)));
typedef pg8::bf16x8 bfx8;
constexpr int CONV_RF_BYTES = 4 * 8192;
constexpr int CONV_UB_ONE = 192 * 64;
__device__ __forceinline__ int ub_addr(int col, int chunk) { return col * 64 + ((chunk ^ ((col >> 2) & 3)) << 4); }

__device__ __forceinline__ void conv_mfma(const char* Rf_ci, const char* Ub_w, int lane, f32x16 (&acc)[4]) {
  const int t2 = lane & 31, h = lane >> 5, n = lane & 31;
  const unsigned sh = (unsigned)(t2 & 1) * 16u;
  const int lanedw = (2048 - t2 + 8 * h) >> 1;
#pragma unroll
  for (int j = 0; j < 4; ++j)
#pragma unroll
    for (int r = 0; r < 16; ++r) acc[j][r] = 0.f;
#pragma unroll 1
  for (int f = 0; f < 16; ++f) {
    bfx8 Bw[5][2];
#pragma unroll
    for (int m = 0; m < 5; ++m) {
      const int col = (16 * m - f + 16) * 2 + n;
#pragma unroll
      for (int kh = 0; kh < 2; ++kh) Bw[m][kh] = *(const bfx8*)(Ub_w + ub_addr(col, 2 * kh + h));
    }
    const unsigned* Rp = (const unsigned*)Rf_ci + lanedw - 16 * f;
#pragma unroll
    for (int e = -4; e <= 3; ++e) {
      int ee = e;
      if (e == -4) ee = (f == 0) ? -3 : -4;
      bfx8 A[2];
#pragma unroll
      for (int kh = 0; kh < 2; ++kh) {
        const unsigned* q = Rp - 256 * ee + 8 * kh;
        unsigned w0 = q[0], w1 = q[1], w2 = q[2], w3 = q[3], w4 = q[4];
        pg8::u32x4 pk;
        pk[0] = __builtin_amdgcn_alignbit(w1, w0, sh);
        pk[1] = __builtin_amdgcn_alignbit(w2, w1, sh);
        pk[2] = __builtin_amdgcn_alignbit(w3, w2, sh);
        pk[3] = __builtin_amdgcn_alignbit(w4, w3, sh);
        A[kh] = __builtin_bit_cast(bfx8, pk);
      }
#pragma unroll
      for (int j = 0; j < 4; ++j) {
        const int m = j - e;
        if (m >= 0 && m <= 4) acc[j] = __builtin_amdgcn_mfma_f32_32x32x16_bf16(A[0], Bw[m][0], acc[j], 0, 0, 0);
      }
#pragma unroll
      for (int j = 0; j < 4; ++j) {
        const int m = j - e;
        if (m >= 0 && m <= 4) acc[j] = __builtin_amdgcn_mfma_f32_32x32x16_bf16(A[1], Bw[m][1], acc[j], 0, 0, 0);
      }
    }
  }
}

__device__ __forceinline__ void sconv4(const u16* xp, int t, float w0, float w1, float w2, float cb, float (&o)[4]) {
  uint2 x4 = *(const uint2*)xp;
  float pv = t > 0 ? bf2f(xp[-1]) : 0.f;
  float nx = (t + 4 < 2048) ? bf2f(xp[4]) : 0.f;
  float e0 = bflo(x4.x), e1 = bfhi(x4.x), e2 = bflo(x4.y), e3 = bfhi(x4.y);
  o[0] = w0 * pv + w1 * e0 + w2 * e1 + cb;
  o[1] = w0 * e0 + w1 * e1 + w2 * e2 + cb;
  o[2] = w0 * e1 + w1 * e2 + w2 * e3 + cb;
  o[3] = w0 * e2 + w1 * e3 + w2 * nx + cb;
}

struct SC4 { uint2 x; unsigned pn; };
__device__ __forceinline__ SC4 sc4_load(const u16* xp, int t) {
  SC4 r;
  r.x = *(const uint2*)xp;
  const unsigned pv = t > 0 ? (unsigned)xp[-1] : 0u;
  const unsigned nx = (t + 4 < 2048) ? (unsigned)xp[4] : 0u;
  r.pn = pv | (nx << 16);
  return r;
}
__device__ __forceinline__ void sc4_apply(const SC4& r, float w0, float w1, float w2, float cb, float (&o)[4]) {
  const float pv = bflo(r.pn), nx = bfhi(r.pn);
  const float e0 = bflo(r.x.x), e1 = bfhi(r.x.x), e2 = bflo(r.x.y), e3 = bfhi(r.x.y);
  o[0] = w0 * pv + w1 * e0 + w2 * e1 + cb;
  o[1] = w0 * e0 + w1 * e1 + w2 * e2 + cb;
  o[2] = w0 * e1 + w1 * e2 + w2 * e3 + cb;
  o[3] = w0 * e2 + w1 * e3 + w2 * nx + cb;
}

__device__ __forceinline__ void phase_conv(const Params& p, float* smf) {
  char* sm = (char*)smf;
  char* Rf = sm;
  char* Ub = sm + CONV_RF_BYTES;
  int tid = threadIdx.x;
  asm volatile("" : "+v"(tid));
  const int wid = tid >> 6, lane = tid & 63;
  const int ci = wid >> 1, bp = wid & 1;
  const u16* pT = (const u16*)(p.ws + OFF_BIG);
  const u16* Rg = (const u16*)(p.ws + OFF_FILT);
  u16* yg = (u16*)(p.ws + OFF_ACT);
  for (int kk = 0; kk < 8 * CONV_UB_ONE / 16 / NTHREADS; ++kk) ((uint4*)Ub)[tid + kk * NTHREADS] = make_uint4(0, 0, 0, 0);
  __syncthreads();
  char* Ub_w = Ub + (ci * 2 + bp) * CONV_UB_ONE;
  const char* Rf_ci = Rf + ci * 8192;
  const int h = lane >> 5, n = lane & 31;
  for (int it0 = blockIdx.x * 2; it0 < 512; it0 += gridDim.x * 2)
#pragma unroll 1
  for (int sub = 0; sub < 2; ++sub) {
    const int item = it0 + sub;
    const int ch0 = item * 4;
    {
      const int q = tid & 255, hb = tid >> 8;
      uint4 x8[8]; unsigned pn[8]; uint4 fr[4];
#pragma unroll
      for (int k = 0; k < 8; ++k) {
        const int cc = 4096 + ch0 + (k >> 1), b = (k & 1) * 2 + hb;
        const u16* xp = pT + (size_t)cc * 8192 + b * 2048 + q * 8;
        x8[k] = *(const uint4*)xp;
        const unsigned pv = q > 0 ? (unsigned)xp[-1] : 0u;
        const unsigned nx = q < 255 ? (unsigned)xp[8] : 0u;
        pn[k] = pv | (nx << 16);
      }
#pragma unroll
      for (int k = 0; k < 4; ++k) fr[k] = ((const uint4*)(Rg + ((size_t)0 * 2048 + ch0 + k) * 4096))[tid];
#pragma unroll
      for (int k = 0; k < 8; ++k) {
        const int c = k >> 1, cc = 4096 + ch0 + c, b = (k & 1) * 2 + hb;
        const float w0 = p.hy_conv_w[cc], w1 = p.hy_conv_w[6144 + cc], w2 = p.hy_conv_w[2 * 6144 + cc], cb = p.hy_conv_b[cc];
        float e[10];
        e[0] = bflo(pn[k]); e[1] = bflo(x8[k].x); e[2] = bfhi(x8[k].x); e[3] = bflo(x8[k].y); e[4] = bfhi(x8[k].y);
        e[5] = bflo(x8[k].z); e[6] = bfhi(x8[k].z); e[7] = bflo(x8[k].w); e[8] = bfhi(x8[k].w); e[9] = bfhi(pn[k]);
        unsigned o[4];
#pragma unroll
        for (int kk = 0; kk < 4; ++kk) {
          float a = w0 * e[2 * kk] + w1 * e[2 * kk + 1] + w2 * e[2 * kk + 2] + cb;
          float bb = w0 * e[2 * kk + 1] + w1 * e[2 * kk + 2] + w2 * e[2 * kk + 3] + cb;
          o[kk] = pk2(a, bb);
        }
        const int t0 = q * 8, s1 = t0 >> 5, s2 = t0 & 31;
        const int col = (s1 + 16) * 2 + (b & 1);
        *(uint4*)(Ub + (c * 2 + (b >> 1)) * CONV_UB_ONE + ub_addr(col, s2 >> 3)) = make_uint4(o[0], o[1], o[2], o[3]);
      }
#pragma unroll
      for (int k = 0; k < 4; ++k) ((uint4*)(Rf + k * 8192))[tid] = fr[k];
    }
    __syncthreads();
    f32x16 acc[4];
    const int ch = ch0 + ci;
    {
      conv_mfma(Rf_ci, Ub_w, lane, acc);
      SC4 xr[16];
#pragma unroll
      for (int j = 0; j < 4; ++j)
#pragma unroll
        for (int vg = 0; vg < 4; ++vg) {
          const int t1 = 16 * j + (n >> 1), b = 2 * bp + (n & 1), t = 32 * t1 + 8 * vg + 4 * h;
          xr[j * 4 + vg] = sc4_load(pT + (size_t)ch * 8192 + b * 2048 + t, t);
        }
      const uint4 f1a = ((const uint4*)(Rg + ((size_t)1 * 2048 + ch0 + 0) * 4096))[tid];
      const uint4 f1b = ((const uint4*)(Rg + ((size_t)1 * 2048 + ch0 + 1) * 4096))[tid];
      const uint4 f1c = ((const uint4*)(Rg + ((size_t)1 * 2048 + ch0 + 2) * 4096))[tid];
      const uint4 f1d = ((const uint4*)(Rg + ((size_t)1 * 2048 + ch0 + 3) * 4096))[tid];
      const float w0 = p.hy_conv_w[ch], w1 = p.hy_conv_w[6144 + ch], w2 = p.hy_conv_w[2 * 6144 + ch], cb = p.hy_conv_b[ch];
#pragma unroll
      for (int j = 0; j < 4; ++j)
#pragma unroll
        for (int vg = 0; vg < 4; ++vg) {
          const int t1 = 16 * j + (n >> 1), bl = n & 1;
          float x1[4];
          sc4_apply(xr[j * 4 + vg], w0, w1, w2, cb, x1);
          uint2 pk;
          pk.x = pk2(x1[0] * acc[j][4 * vg + 0], x1[1] * acc[j][4 * vg + 1]);
          pk.y = pk2(x1[2] * acc[j][4 * vg + 2], x1[3] * acc[j][4 * vg + 3]);
          const int col = (t1 + 16) * 2 + bl;
          *(uint2*)(Ub_w + ub_addr(col, vg) + 8 * h) = pk;
        }
      __syncthreads();
      ((uint4*)(Rf + 0 * 8192))[tid] = f1a;
      ((uint4*)(Rf + 1 * 8192))[tid] = f1b;
      ((uint4*)(Rf + 2 * 8192))[tid] = f1c;
      ((uint4*)(Rf + 3 * 8192))[tid] = f1d;
    }
    __syncthreads();
    {
      const int c2 = 2048 + ch;
      SC4 xr[16]; uint2 gr[16];
      conv_mfma(Rf_ci, Ub_w, lane, acc);
#pragma unroll
      for (int j = 0; j < 4; ++j)
#pragma unroll
        for (int vg = 0; vg < 4; ++vg) {
          const int t1 = 16 * j + (n >> 1), b = 2 * bp + (n & 1), t = 32 * t1 + 8 * vg + 4 * h;
          xr[j * 4 + vg] = sc4_load(pT + (size_t)c2 * 8192 + b * 2048 + t, t);
          gr[j * 4 + vg] = *(const uint2*)(pT + (size_t)(6144 + ch) * 8192 + b * 2048 + t);
        }
      const float w0 = p.hy_conv_w[c2], w1 = p.hy_conv_w[6144 + c2], w2 = p.hy_conv_w[2 * 6144 + c2], cb = p.hy_conv_b[c2];
#pragma unroll
      for (int j = 0; j < 4; ++j)
#pragma unroll
        for (int vg = 0; vg < 4; ++vg) {
          const int t1 = 16 * j + (n >> 1), bl = n & 1;
          float x2[4];
          sc4_apply(xr[j * 4 + vg], w0, w1, w2, cb, x2);
          const uint2 g4 = gr[j * 4 + vg];
          float y0 = x2[0] * acc[j][4 * vg + 0] * siluf(bflo(g4.x));
          float y1 = x2[1] * acc[j][4 * vg + 1] * siluf(bfhi(g4.x));
          float y2 = x2[2] * acc[j][4 * vg + 2] * siluf(bflo(g4.y));
          float y3 = x2[3] * acc[j][4 * vg + 3] * siluf(bfhi(g4.y));
          uint2 pk;
          pk.x = pk2(y0, y1);
          pk.y = pk2(y2, y3);
          const int col = (t1 + 16) * 2 + bl;
          *(uint2*)(Ub_w + ub_addr(col, vg) + 8 * h) = pk;
        }
    }
    __syncthreads();
    int tw = tid;
    asm volatile("" : "+v"(tw));
#pragma unroll 4
    for (int kk = 0; kk < 16; ++kk) {
      const int idx = tw + kk * NTHREADS;
      const int b = idx >> 11, t = idx & 2047;
      const int s1 = t >> 5, s2 = t & 31;
      const int col = (s1 + 16) * 2 + (b & 1);
      const int a = ub_addr(col, s2 >> 3) + (s2 & 7) * 2;
      const char* base = Ub + (b >> 1) * CONV_UB_ONE + a;
      unsigned v0 = *(const u16*)(base + 0 * 2 * CONV_UB_ONE), v1 = *(const u16*)(base + 1 * 2 * CONV_UB_ONE);
      unsigned v2 = *(const u16*)(base + 2 * 2 * CONV_UB_ONE), v3 = *(const u16*)(base + 3 * 2 * CONV_UB_ONE);
      const uint2 cur = make_uint2(v0 | (v1 << 16), v2 | (v3 << 16));
      *(uint2*)(yg + ((size_t)(item >> 1) * 8192 + idx) * 8 + (item & 1) * 4) = cur;
    }
    __syncthreads();
  }
}

constexpr int AT_KROW = 272, AT_VROW = 136;
constexpr int AT_K_BYTES = 64 * AT_KROW, AT_V_BYTES = 128 * AT_VROW;
__device__ __forceinline__ void phase_attn(const Params& p, float* smf) {
  char* sm = (char*)smf;
  char* Ks = sm;
  char* Vs = sm + AT_K_BYTES;
  const int tid = threadIdx.x, wid = tid >> 6, lane = tid & 63, r = lane & 31, h = lane >> 5;
  const u16* px = (const u16*)(p.ws + OFF_BIG);
  const u16* kvc = (const u16*)(p.ws + OFF_KVC);
  const u16* vT = (const u16*)(p.ws + OFF_VT);
  const u16* vcT = (const u16*)(p.ws + OFF_VCT);
  u16* og = (u16*)(p.ws + OFF_ACT);
  const float LOG2E = 1.4426950408889634f;
  const float sl2 = 0.08838834764831845f * LOG2E;
  for (int item = blockIdx.x; item < 512; item += gridDim.x) {
    const int hp = item & 1, kvh = (item >> 1) & 3, nblk = (item >> 3) & 15, b = item >> 7;
    const int hq = kvh * 4 + hp * 2 + (wid >> 2);
    const int qs = nblk * 128 + (wid & 3) * 32 + r;
    bfx8 Q[8];
    {
      const u16* qrow = px + (size_t)(b * 2048 + qs) * 5120 + hq * 128 + 8 * h;
#pragma unroll
      for (int st = 0; st < 8; ++st) Q[st] = *(const bfx8*)(qrow + 16 * st);
    }
    f32x16 O[4];
#pragma unroll
    for (int dt = 0; dt < 4; ++dt)
#pragma unroll
      for (int i = 0; i < 16; ++i) O[dt][i] = 0.f;
    float m = p.attn_sink[hq] * LOG2E;
    float l = (h == 0) ? 1.f : 0.f;
    const int first = (nblk == 0) ? 2 : 0, lastlocal = (nblk == 15) ? 3 : 5;
    uint4 kA0, kA1, vA0, vA1, kB0, kB1, vB0, vB1;
#define AT_LOAD_TILE(TI, K0, K1, V0, V1) do { \
      const int _ti = (TI); const bool _loc = _ti < 6; \
      const int _kpos0 = 128 * (nblk - 1) + 64 * _ti, _c0 = 64 * (_ti - 6); \
      const u16* _kb = _loc ? px + (size_t)(b * 2048 + _kpos0) * 5120 + 2048 + kvh * 128 : kvc + (size_t)(b * 256 + _c0) * 1024 + kvh * 128; \
      const size_t _ks = _loc ? 5120 : 1024; \
      const u16* _vb = _loc ? vT + (size_t)(kvh * 128) * 8192 + b * 2048 + _kpos0 : vcT + (size_t)(kvh * 128) * 1024 + b * 256 + _c0; \
      const size_t _vs = _loc ? 8192 : 1024; \
      const int _c1 = tid + NTHREADS; \
      K0 = *(const uint4*)(_kb + (size_t)(tid >> 4) * _ks + (tid & 15) * 8); \
      K1 = *(const uint4*)(_kb + (size_t)(_c1 >> 4) * _ks + (_c1 & 15) * 8); \
      V0 = *(const uint4*)(_vb + (size_t)(tid >> 3) * _vs + (tid & 7) * 8); \
      V1 = *(const uint4*)(_vb + (size_t)(_c1 >> 3) * _vs + (_c1 & 7) * 8); \
    } while (0)
#define AT_STORE_TILE(K0, K1, V0, V1) do { \
      const int c1 = tid + NTHREADS; \
      *(uint4*)(Ks + (tid >> 4) * AT_KROW + (tid & 15) * 16) = K0; \
      *(uint4*)(Ks + (c1 >> 4) * AT_KROW + (c1 & 15) * 16) = K1; \
      char* v0p = Vs + (tid >> 3) * AT_VROW + (tid & 7) * 16; \
      char* v1p = Vs + (c1 >> 3) * AT_VROW + (c1 & 7) * 16; \
      *(uint2*)(v0p) = make_uint2(V0.x, V0.y); \
      *(uint2*)(v0p + 8) = make_uint2(V0.z, V0.w); \
      *(uint2*)(v1p) = make_uint2(V1.x, V1.y); \
      *(uint2*)(v1p + 8) = make_uint2(V1.z, V1.w); \
    } while (0)
    int ti = first;
    int t1 = ti + 1;
    if (t1 > lastlocal && t1 < 6) t1 = 6;
    AT_LOAD_TILE(ti, kA0, kA1, vA0, vA1);
    if (t1 < 10) AT_LOAD_TILE(t1, kB0, kB1, vB0, vB1);
    while (true) {
#pragma unroll
     for (int half = 0; half < 2; ++half) {
      __syncthreads();
      if (half == 0) AT_STORE_TILE(kA0, kA1, vA0, vA1); else AT_STORE_TILE(kB0, kB1, vB0, vB1);
      __syncthreads();
      int t2 = t1 + 1;
      if (t2 > lastlocal && t2 < 6) t2 = 6;
      if (t1 >= 10) t2 = 10;
      if (t2 < 10) { if (half == 0) AT_LOAD_TILE(t2, kA0, kA1, vA0, vA1); else AT_LOAD_TILE(t2, kB0, kB1, vB0, vB1); }
      const int q0w = nblk * 128 + (wid & 3) * 32;
      const int kp0 = 128 * (nblk - 1) + 64 * ti;
      if (!(ti < 6 && (kp0 > q0w + 31 + 128 || kp0 + 63 < q0w - 128))) {
        const bool local = ti < 6;
        const int kpos0 = 128 * (nblk - 1) + 64 * ti;
        f32x16 S[2];
#pragma unroll
        for (int ks = 0; ks < 2; ++ks) {
#pragma unroll
          for (int i = 0; i < 16; ++i) S[ks][i] = 0.f;
#pragma unroll
          for (int st = 0; st < 8; ++st) {
            bfx8 A = *(const bfx8*)(Ks + (ks * 32 + r) * AT_KROW + (16 * st + 8 * h) * 2);
            S[ks] = __builtin_amdgcn_mfma_f32_32x32x16_bf16(A, Q[st], S[ks], 0, 0, 0);
          }
        }
        const bool needmask = local && (kp0 > q0w + 65 || kp0 < q0w - 97);
        float mraw = -1e30f;
        if (needmask) {
          const int relb = kpos0 + 4 * h - qs;
#pragma unroll
          for (int ks = 0; ks < 2; ++ks)
#pragma unroll
            for (int i = 0; i < 16; ++i) {
              const int rel = relb + ks * 32 + (i & 3) + 8 * (i >> 2);
              float sv = S[ks][i];
              if (rel > 128 || rel < -128) sv = -1e30f;
              S[ks][i] = sv;
              mraw = fmaxf(mraw, sv);
            }
        } else {
#pragma unroll
          for (int ks = 0; ks < 2; ++ks)
#pragma unroll
            for (int i = 0; i < 16; ++i) mraw = fmaxf(mraw, S[ks][i]);
        }
        float mx = fmaxf(m, mraw * sl2);
        mx = fmaxf(mx, __shfl_xor(mx, 32, 64));
        if (__builtin_amdgcn_ballot_w64(mx != m) != 0ull) {
          const float alpha = __builtin_amdgcn_exp2f(m - mx);
          m = mx;
          l *= alpha;
#pragma unroll
          for (int dt = 0; dt < 4; ++dt)
#pragma unroll
            for (int i = 0; i < 16; ++i) O[dt][i] *= alpha;
        }
#pragma unroll
        for (int ks = 0; ks < 2; ++ks)
#pragma unroll
          for (int i = 0; i < 16; ++i) {
            float pv = __builtin_amdgcn_exp2f(__builtin_fmaf(S[ks][i], sl2, -m));
            l += pv;
            S[ks][i] = pv;
          }
#pragma unroll
        for (int s4 = 0; s4 < 4; ++s4) {
          const int ks = s4 >> 1, hf = s4 & 1;
          pg8::u32x4 pk;
#pragma unroll
          for (int j = 0; j < 4; ++j)
            pk[j] = pk2(S[ks][8 * hf + 2 * j], S[ks][8 * hf + 2 * j + 1]);
          bfx8 P = __builtin_bit_cast(bfx8, pk);
#pragma unroll
          for (int dt = 0; dt < 4; ++dt) {
            const char* vp = Vs + (dt * 32 + r) * AT_VROW + (32 * ks + 16 * hf + 4 * h) * 2;
            uint2 v0 = *(const uint2*)vp, v1 = *(const uint2*)(vp + 16);
            pg8::u32x4 vv; vv[0] = v0.x; vv[1] = v0.y; vv[2] = v1.x; vv[3] = v1.y;
            O[dt] = __builtin_amdgcn_mfma_f32_32x32x16_bf16(__builtin_bit_cast(bfx8, vv), P, O[dt], 0, 0, 0);
          }
        }
      }
      if (t1 >= 10) goto attn_done;
      ti = t1; t1 = t2;
     }
    }
    attn_done:;
    const float ltot = l + __shfl_xor(l, 32, 64);
    const float inv = 1.f / ltot;
    const size_t tok = (size_t)(b * 2048 + qs);
#pragma unroll
    for (int dt = 0; dt < 4; ++dt)
#pragma unroll
      for (int g4 = 0; g4 < 4; ++g4) {
        const int d = dt * 32 + 8 * g4 + 4 * h;
        uint2 gg = *(const uint2*)(px + tok * 5120 + 3072 + hq * 128 + d);
        float o0 = O[dt][4 * g4 + 0] * inv * siluf(bflo(gg.x));
        float o1 = O[dt][4 * g4 + 1] * inv * siluf(bfhi(gg.x));
        float o2 = O[dt][4 * g4 + 2] * inv * siluf(bflo(gg.y));
        float o3 = O[dt][4 * g4 + 3] * inv * siluf(bfhi(gg.y));
        uint2 pk;
        pk.x = pk2(o0, o1);
        pk.y = pk2(o2, o3);
        *(uint2*)(og + tok * 2048 + hq * 128 + d) = pk;
      }
  }
}

#define XB_TMO      128
#define XB_XCNT(j)  (256  + 64 * (j))
#define XB_XSUB(j)  (1280 + 64 * (j))
#define XB_XGEN(j)  (2304 + 64 * (j))
#define XB_TOP      3328
#define XB_TOPGEN   3392
#define XCD_BAR_WORDS 3456
#define XB_SPIN_CAP (1u << 18)
#define LAS __attribute__((address_space(3)))

__device__ __forceinline__ unsigned xb_ld(unsigned* p)              { return __hip_atomic_load(p, __ATOMIC_RELAXED, __HIP_MEMORY_SCOPE_AGENT); }
__device__ __forceinline__ unsigned xb_add(unsigned* p, unsigned v) { return __hip_atomic_fetch_add(p, v, __ATOMIC_RELAXED, __HIP_MEMORY_SCOPE_AGENT); }
__device__ __forceinline__ unsigned xb_xcc_id() { return (unsigned)__builtin_amdgcn_s_getreg((3 << 11) | 20) & 0xFu; }
#define XB_SPIN(cond, bar) do { unsigned _sp = 0; while (cond) { __builtin_amdgcn_s_sleep(1); \
    if ((++_sp & 255u) == 0u) { if (xb_ld(&(bar)[XB_TMO])) break; if (_sp > XB_SPIN_CAP) { atomicAdd(&(bar)[XB_TMO], 1u); break; } } } } while (0)

struct XcdBarrier {
    unsigned* bar; unsigned x;
    volatile LAS unsigned* st;
};

__device__ __forceinline__ XcdBarrier xcd_barrier_post(unsigned* bar, volatile LAS unsigned* st) {
    XcdBarrier b; b.bar = bar; b.x = xb_xcc_id(); b.st = st;
    if (threadIdx.x == 0) (void)xb_add(&bar[XB_XCNT(b.x)], 1u);
    return b;
}
__device__ __forceinline__ void xcd_barrier_complete(unsigned* bar, unsigned x, unsigned& nloc, unsigned& nx) {
    const unsigned G = gridDim.x * gridDim.y * gridDim.z;
    unsigned sum, cnt, mine, sp = 0u;
    for (;;) {
        sum = 0u; cnt = 0u; mine = 0u;
#pragma unroll
        for (unsigned j = 0; j < 16; ++j) { const unsigned c = xb_ld(&bar[XB_XCNT(j)]); sum += c; cnt += (c > 0u) ? 1u : 0u; mine = (j == x) ? c : mine; }
        if (sum == G) break;
        __builtin_amdgcn_s_sleep(1);
        if ((++sp & 255u) == 0u) { if (xb_ld(&bar[XB_TMO])) break; if (sp > XB_SPIN_CAP) { atomicAdd(&bar[XB_TMO], 1u); break; } }
    }
    nloc = mine > 0u ? mine : 1u; nx = cnt > 0u ? cnt : 1u;
}

__device__ __forceinline__ void xcd_barrier(const XcdBarrier& b) {
    asm volatile("s_waitcnt vmcnt(0)" ::: "memory");
    __syncthreads();
    if (threadIdx.x == 0) {
        unsigned* bar = b.bar;
        __builtin_amdgcn_s_waitcnt(0);
        unsigned nloc = b.st[0], nx = b.st[1];
        if (nloc == 0u) { xcd_barrier_complete(bar, b.x, nloc, nx); b.st[0] = nloc; b.st[1] = nx; }
        const unsigned old = xb_add(&bar[XB_XSUB(b.x)], 1u);
        const unsigned gen = old / nloc;
        if (old + 1u == (gen + 1u) * nloc) {
            __builtin_amdgcn_fence(__ATOMIC_RELEASE, "agent");
            asm volatile("s_waitcnt vmcnt(0)" ::: "memory");
            const unsigned og = xb_add(&bar[XB_TOP], 1u);
            const unsigned tg = og / nx;
            if (og + 1u == (tg + 1u) * nx) xb_add(&bar[XB_TOPGEN], 1u);
            else XB_SPIN(xb_ld(&bar[XB_TOPGEN]) == tg, bar);
            __builtin_amdgcn_fence(__ATOMIC_ACQUIRE, "agent");
            xb_add(&bar[XB_XGEN(b.x)], 1u);
            asm volatile("s_waitcnt vmcnt(0)" ::: "memory");
        } else {
            XB_SPIN(xb_ld(&bar[XB_XGEN(b.x)]) == gen, bar);
            __builtin_amdgcn_fence(__ATOMIC_ACQUIRE, "agent");
            asm volatile("s_waitcnt vmcnt(0)" ::: "memory");
        }
    }
    __syncthreads();
}


constexpr int N_PHASES = 9;
__global__ void __launch_bounds__(NTHREADS, 2) mega(Params p, int ph0, int ph1) {
  extern __shared__ __attribute__((aligned(16))) float sm[];
  volatile LAS unsigned* xb_st = (volatile LAS unsigned*)((LAS unsigned char*)sm + 131072);
  if (threadIdx.x < 4) xb_st[threadIdx.x] = 0u;
  __syncthreads();
  const XcdBarrier xb = xcd_barrier_post((unsigned*)(p.ws + OFF_BAR), xb_st);
#define PH(i, body) if (ph0 <= (i) && (i) < ph1) { body; if ((i) + 1 < ph1) xcd_barrier(xb); }
  if (ph0 < 0) cg::this_grid().sync();
  PH(0, phase0(p, sm))
  PH(1, phase_norm(p, 0))
  PH(2, run_gemm(sm, (const u16*)(p.ws + OFF_ACT), (const u16*)(p.ws + OFF_WT_AI), MT, ATTN_IN,
                 EpiAttnIn{(u16*)(p.ws + OFF_BIG), (const float*)(p.ws + OFF_ROPE)}, (int)blockIdx.x);
        run_gemm(sm, (const u16*)(p.ws + OFF_HC), (const u16*)(p.ws + OFF_WT_AI) + (size_t)2048 * 2048, MC, 1024,
                 EpiRaw{(u16*)(p.ws + OFF_KVC), 1024}, (int)((blockIdx.x + 64) % gridDim.x));
        run_gemm(sm, (const u16*)(p.ws + OFF_WT_AI) + (size_t)2560 * 2048, (const u16*)(p.ws + OFF_ACT), 512, MT,
                 EpiRaw{(u16*)(p.ws + OFF_VT), 8192}, (int)((blockIdx.x + 128) % gridDim.x));
        run_gemm(sm, (const u16*)(p.ws + OFF_WT_AI) + (size_t)2560 * 2048, (const u16*)(p.ws + OFF_HC), 512, MC,
                 EpiRaw{(u16*)(p.ws + OFF_VCT), 1024}, (int)((blockIdx.x + 48) % gridDim.x)))
  PH(3, phase_attn(p, sm))
  PH(4, run_gemm(sm, (const u16*)(p.ws + OFF_ACT), (const u16*)(p.ws + OFF_WT_AO), MT, 2048,
                 EpiResNorm{p.out, p.x, (const float*)(p.ws + OFF_MOD) + 4096, (float*)(p.ws + OFF_ROWSS), (unsigned*)(p.ws + OFF_PCNT),
                            p.norm_g + 2048, (const float*)(p.ws + OFF_MOD) + 5 * 6144, (u16*)(p.ws + OFF_ACT)}, (int)blockIdx.x))
  PH(6, run_gemm(sm, (const u16*)(p.ws + OFF_WT_HI), (const u16*)(p.ws + OFF_ACT), HY_IN, MT,
                 EpiRaw{(u16*)(p.ws + OFF_BIG), 8192}, (int)blockIdx.x))
  PH(7, phase_conv(p, sm))
  PH(8, (run_gemm<EpiResNorm, true>(sm, (const u16*)(p.ws + OFF_ACT), (const u16*)(p.ws + OFF_WT_HO), MT, 2048,
                 EpiResNorm{p.out, p.out, (const float*)(p.ws + OFF_MOD) + 5 * 6144 + 4096, (float*)(p.ws + OFF_ROWSS) + 8192,
                            (unsigned*)(p.ws + OFF_PCNT) + 32 * 64, p.final_g, nullptr, nullptr}, (int)blockIdx.x)))
}

extern "C" void kernel_launch(void* const* d_in, const int* in_sizes, int n_in, void* d_out, int out_size,
                              void* d_ws, size_t ws_size, hipStream_t stream) {
  Params p{};
  const float** f = (const float**)&p;
  for (int i = 0; i < 23; ++i) f[i] = (const float*)d_in[i];
  p.out = (float*)d_out;
  p.ws = (char*)d_ws;
  constexpr size_t kLds = 128 * 1024 + 16;
  static int grid_blocks = 0;
  if (!grid_blocks) {
    (void)hipFuncSetAttribute((const void*)mega, hipFuncAttributeMaxDynamicSharedMemorySize, (int)kLds);
    int dev = 0, cus = 0, per_cu = 0;
    (void)hipGetDevice(&dev);
    (void)hipDeviceGetAttribute(&cus, hipDeviceAttributeMultiprocessorCount, dev);
    (void)hipOccupancyMaxActiveBlocksPerMultiprocessor(&per_cu, mega, NTHREADS, kLds);
    if (per_cu < 1) per_cu = 1;
    grid_blocks = cus * per_cu;
  }
  (void)hipMemsetAsync((char*)d_ws + OFF_BAR, 0, ZERO_BYTES, stream);
  int ph0 = 0, ph1 = N_PHASES;
  void* args[] = {(void*)&p, (void*)&ph0, (void*)&ph1};
  hipError_t e = hipLaunchCooperativeKernel((const void*)mega, dim3(grid_blocks), dim3(NTHREADS), args, kLds, stream);
  if (e != hipSuccess) fprintf(stderr, "cooperative launch failed: %s (grid %d)\n", hipGetErrorString(e), grid_blocks);
}
```

```cpp
#include <hip/hip_runtime.h>
#include <hip/hip_bf16.h>
#include <hip/hip_cooperative_groups.h>
#include <cstdio>
namespace cg = cooperative_groups;
typedef unsigned short u16;

#define NTHREADS 512
constexpr int Bn = 4, Sn = 2048, Dn = 2048, Cn = 256;
constexpr int MT = Bn * Sn;
constexpr int MC = Bn * Cn;
constexpr int ATTN_IN = 5120;
constexpr int HY_IN = 8192;

constexpr size_t OFF_WT_AI = 0;
constexpr size_t OFF_WT_AO = OFF_WT_AI + (size_t)5120 * 2048 * 2;
constexpr size_t OFF_WT_HI = OFF_WT_AO + (size_t)2048 * 2048 * 2;
constexpr size_t OFF_WT_HO = OFF_WT_HI + (size_t)8192 * 2048 * 2;
constexpr size_t OFF_MOD   = OFF_WT_HO + (size_t)2048 * 2048 * 2;
constexpr size_t OFF_ROPE  = OFF_MOD + (size_t)2 * 5 * 6144 * 4 + 256;
constexpr size_t OFF_FILT  = OFF_ROPE + (size_t)64 * 32 * 8;
constexpr size_t OFF_ACT   = OFF_FILT + (size_t)2 * 2048 * 4096 * 2;
constexpr size_t OFF_HC    = OFF_ACT + (size_t)8192 * 2048 * 2;
constexpr size_t OFF_KVC   = OFF_HC + (size_t)1024 * 2048 * 2;
constexpr size_t OFF_VT    = OFF_KVC + (size_t)1024 * 1024 * 2;
constexpr size_t OFF_VCT   = OFF_VT + (size_t)512 * 8192 * 2;
constexpr size_t OFF_BIG   = OFF_VCT + (size_t)512 * 1024 * 2;

constexpr size_t OFF_BAR   = OFF_BIG + (size_t)8192 * 8192 * 2;

constexpr size_t OFF_ROWSS = OFF_BAR + 16384;
constexpr size_t OFF_PCNT  = OFF_ROWSS + (size_t)2 * 8192 * 4;
constexpr size_t ZERO_BYTES = 16384 + (size_t)2 * 8192 * 4 + (size_t)2 * 32 * 64 * 4;

struct Params {
  const float *x, *c, *ctx, *c_ctx, *norm_g, *ada_w, *ada_b, *attn_w_in, *attn_w_out, *attn_sink;
  const float *hy_w_in, *hy_conv_w, *hy_conv_b, *hy_w1, *hy_b1, *hy_w2, *hy_b2, *hy_w3, *hy_b3;
  const float *hy_freq, *hy_bias_d, *hy_w_out, *final_g;
  float* out;
  char* ws;
};

__device__ __forceinline__ u16 f2bf(float f) {
  unsigned u = __float_as_uint(f);
  u += 0x7fffu + ((u >> 16) & 1u);
  return (u16)(u >> 16);
}
__device__ __forceinline__ float bf2f(u16 h) { return __uint_as_float(((unsigned)h) << 16); }
__device__ __forceinline__ unsigned pk2(float lo, float hi) { unsigned r; asm("v_cvt_pk_bf16_f32 %0, %1, %2" : "=v"(r) : "v"(lo), "v"(hi)); return r; }
__device__ __forceinline__ float bflo(unsigned w) { return __uint_as_float(w << 16); }
__device__ __forceinline__ float bfhi(unsigned w) { return __uint_as_float(w & 0xffff0000u); }
__device__ __forceinline__ float siluf(float v) { return v / (1.f + __expf(-v)); }
__device__ __forceinline__ float wave_sum(float v) {
#pragma unroll
  for (int o = 32; o > 0; o >>= 1) v += __shfl_xor(v, o, 64);
  return v;
}
__device__ __forceinline__ float wave_max(float v) {
#pragma unroll
  for (int o = 32; o > 0; o >>= 1) v = fmaxf(v, __shfl_xor(v, o, 64));
  return v;
}

__device__ __forceinline__ void p0_convert(const float* __restrict__ W, u16* __restrict__ Wt, int N, int tk, int tn,
                           bool perm, float* sm) {
  const int tid = threadIdx.x;
  for (int i = tid; i < 64 * 32; i += NTHREADS) {
    int r = i >> 5, c4 = i & 31;
    float4 v = *(const float4*)(W + (size_t)(tk * 64 + r) * N + tn * 128 + c4 * 4);
    float* d = sm + r * 129 + c4 * 4;
    d[0] = v.x; d[1] = v.y; d[2] = v.z; d[3] = v.w;
  }
  __syncthreads();
  for (int i = tid; i < 128 * 8; i += NTHREADS) {
    int nrow = i >> 3, kc = i & 7;
    int src = nrow;
    if (perm && (tn * 128 < 2560)) {
      int g = nrow >> 5, nn = (nrow >> 4) & 1, fr = nrow & 15;
      src = (g >> 1) * 64 + nn * 32 + (g & 1) * 16 + fr;
    }
    unsigned w[4];
#pragma unroll
    for (int j = 0; j < 4; ++j) {
      float a = sm[(kc * 8 + 2 * j) * 129 + src];
      float b = sm[(kc * 8 + 2 * j + 1) * 129 + src];
      w[j] = pk2(a, b);
    }
    *(uint4*)(Wt + (size_t)(tn * 128 + nrow) * 2048 + tk * 64 + kc * 8) = make_uint4(w[0], w[1], w[2], w[3]);
  }
  __syncthreads();
}

__device__ __forceinline__ void p0_adaln(const Params& p, int item, float* sm) {
  const int tid = threadIdx.x;
  float* sv = sm;
  float* red = sm + 5 * 2048;
  int col0 = item * 48;
  int l = col0 / 6144, n0 = col0 % 6144;
  for (int i = tid; i < 5 * 2048; i += NTHREADS) {
    int v = i >> 11, k = i & 2047;
    float cv = v < 4 ? p.c[v * 2048 + k] : p.c_ctx[k];
    sv[i] = cv / (1.f + expf(-cv));
  }
  __syncthreads();
  int kg = tid / 12, cq = tid % 12;
  float acc[5][4];
#pragma unroll
  for (int v = 0; v < 5; ++v)
#pragma unroll
    for (int j = 0; j < 4; ++j) acc[v][j] = 0.f;
  if (kg < 42) {
    const float* W = p.ada_w + (size_t)l * 2048 * 6144 + n0 + cq * 4;
#pragma unroll 8
    for (int k = kg; k < 2048; k += 42) {
      float4 w = *(const float4*)(W + (size_t)k * 6144);
#pragma unroll
      for (int v = 0; v < 5; ++v) {
        float s = sv[v * 2048 + k];
        acc[v][0] += s * w.x; acc[v][1] += s * w.y; acc[v][2] += s * w.z; acc[v][3] += s * w.w;
      }
    }
  }
  if (kg >= 21 && kg < 42) {
#pragma unroll
    for (int v = 0; v < 5; ++v)
#pragma unroll
      for (int j = 0; j < 4; ++j) red[((kg - 21) * 5 + v) * 48 + cq * 4 + j] = acc[v][j];
  }
  __syncthreads();
  if (kg < 21) {
#pragma unroll
    for (int v = 0; v < 5; ++v)
#pragma unroll
      for (int j = 0; j < 4; ++j) red[(kg * 5 + v) * 48 + cq * 4 + j] += acc[v][j];
  }
  __syncthreads();
  if (tid < 240) {
    int v = tid / 48, cc = tid % 48;
    float s = 0.f;
    for (int g = 0; g < 21; ++g) s += red[(g * 5 + v) * 48 + cc];
    float* mod = (float*)(p.ws + OFF_MOD);
    mod[(l * 5 + v) * 6144 + n0 + cc] = s + p.ada_b[l * 6144 + n0 + cc];
  }
  __syncthreads();
}

__device__ __forceinline__ void p0_rope(const Params& p) {
  float2* rope = (float2*)(p.ws + OFF_ROPE);
  for (int i = threadIdx.x; i < 64 * 32; i += NTHREADS) {
    int pos = i >> 5, j = i & 31;
    float inv = powf(10000.f, -(float)(2 * j) / 64.f);
    float ang = (float)pos * inv;
    rope[i] = make_float2(cosf(ang), sinf(ang));
  }
}

typedef short bf16x8_t __attribute__((ext_vector_type(8)));
typedef unsigned u32x4_t __attribute__((ext_vector_type(4)));
typedef float f32x16_t __attribute__((ext_vector_type(16)));
__device__ __forceinline__ void split8(const float (&v)[8], bf16x8_t& hi, bf16x8_t& lo) {
  u32x4_t H, L;
#pragma unroll
  for (int j = 0; j < 4; ++j) {
    const u16 h0 = f2bf(v[2 * j]), h1 = f2bf(v[2 * j + 1]);
    const float r0 = v[2 * j] - bf2f(h0), r1 = v[2 * j + 1] - bf2f(h1);
    H[j] = (unsigned)h0 | ((unsigned)h1 << 16);
    L[j] = pk2(r0, r1);
  }
  hi = __builtin_bit_cast(bf16x8_t, H);
  lo = __builtin_bit_cast(bf16x8_t, L);
}
__device__ __forceinline__ void p0_filter(const Params& p, int item, float* sm) {
  int tid = threadIdx.x;
  asm volatile("" : "+v"(tid));
  const int lane = tid & 63, wid = tid >> 6, r = lane & 31, h = lane >> 5;
  const int cc = item & 15, pg = item >> 4;
  float* z = sm;
  float* h1 = z + 128 * 36;
  float* h2 = h1 + 128 * 64;
  for (int i = tid; i < 128 * 33; i += NTHREADS) {
    int pos = i / 33, e = i % 33;
    int t = pg * 128 + pos;
    float val;
    if (e == 0) val = (float)t / 2047.f;
    else {
      int bi = (e - 1) & 15;
      float w = 6.283185307179586f * (float)t / 2048.f;
      float fr = 1e-4f + (float)bi * ((15.f - 1e-4f) / 15.f);
      float ang = w * fr;
      val = (e <= 16) ? cosf(ang) : -sinf(ang);
    }
    z[pos * 36 + e] = val;
  }
  __syncthreads();
  {
    const int j = lane;
    float w1r[33];
#pragma unroll
    for (int e = 0; e < 33; ++e) w1r[e] = p.hy_w1[e * 64 + j];
    const float fq = p.hy_freq[j], b1 = p.hy_b1[j];
#pragma unroll 1
    for (int q = 0; q < 16; ++q) {
      const int pos = wid * 16 + q;
      const float4* zp = (const float4*)(z + pos * 36);
      float a = b1;
#pragma unroll
      for (int e4 = 0; e4 < 8; ++e4) {
        float4 zv = zp[e4];
        a += zv.x * w1r[4 * e4] + zv.y * w1r[4 * e4 + 1] + zv.z * w1r[4 * e4 + 2] + zv.w * w1r[4 * e4 + 3];
      }
      a += z[pos * 36 + 32] * w1r[32];
      h1[pos * 64 + j] = __sinf(fq * a);
    }
  }
  __syncthreads();
  {
    const int j = lane;
    float w2r[64];
#pragma unroll
    for (int e = 0; e < 64; ++e) w2r[e] = p.hy_w2[e * 64 + j];
    const float fq = p.hy_freq[j], b2 = p.hy_b2[j];
#pragma unroll 1
    for (int q = 0; q < 16; ++q) {
      const int pos = wid * 16 + q;
      const float4* hp = (const float4*)(h1 + pos * 64);
      float a = b2;
#pragma unroll
      for (int e4 = 0; e4 < 16; ++e4) {
        float4 hv = hp[e4];
        a += hv.x * w2r[4 * e4] + hv.y * w2r[4 * e4 + 1] + hv.z * w2r[4 * e4 + 2] + hv.w * w2r[4 * e4 + 3];
      }
      h2[pos * 68 + j] = __sinf(fq * a);
    }
  }
  __syncthreads();
  const int colw = cc * 512 + wid * 64;
  bf16x8_t Ahi[2][4], Alo[2][4];
#pragma unroll
  for (int ct = 0; ct < 2; ++ct)
#pragma unroll
    for (int ks = 0; ks < 4; ++ks) {
      float v[8];
#pragma unroll
      for (int j = 0; j < 8; ++j) v[j] = p.hy_w3[(size_t)(16 * ks + 8 * h + j) * 8192 + colw + ct * 32 + r];
      split8(v, Ahi[ct][ks], Alo[ct][ks]);
    }
  const int o = cc >> 3, dir = (cc >> 2) & 1;
  u16* Rg = (u16*)(p.ws + OFF_FILT) + (size_t)o * 2048 * 4096;
  const float min_decay = -3.0701134573253945f, max_decay = -15.350567286626972f;
#pragma unroll 1
  for (int pp = 0; pp < 2; ++pp) {
    f32x16_t acc[2][2];
#pragma unroll
    for (int ct = 0; ct < 2; ++ct)
#pragma unroll
      for (int q = 0; q < 2; ++q)
#pragma unroll
        for (int i = 0; i < 16; ++i) acc[ct][q][i] = 0.f;
#pragma unroll
    for (int q = 0; q < 2; ++q)
#pragma unroll
      for (int ks = 0; ks < 4; ++ks) {
        const float* hp = h2 + ((pp * 2 + q) * 32 + r) * 68 + 16 * ks + 8 * h;
        float4 x0 = *(const float4*)hp, x1 = *(const float4*)(hp + 4);
        float v[8] = {x0.x, x0.y, x0.z, x0.w, x1.x, x1.y, x1.z, x1.w};
        bf16x8_t Bhi, Blo;
        split8(v, Bhi, Blo);
#pragma unroll
        for (int ct = 0; ct < 2; ++ct) {
          acc[ct][q] = __builtin_amdgcn_mfma_f32_32x32x16_bf16(Ahi[ct][ks], Bhi, acc[ct][q], 0, 0, 0);
          acc[ct][q] = __builtin_amdgcn_mfma_f32_32x32x16_bf16(Ahi[ct][ks], Blo, acc[ct][q], 0, 0, 0);
          acc[ct][q] = __builtin_amdgcn_mfma_f32_32x32x16_bf16(Alo[ct][ks], Bhi, acc[ct][q], 0, 0, 0);
        }
      }
    int hh = h;
    asm volatile("" : "+v"(hh));
#pragma unroll
    for (int ct = 0; ct < 2; ++ct)
#pragma unroll
      for (int i = 0; i < 16; ++i) {
        const int col = colw + ct * 32 + (i & 3) + 8 * (i >> 2) + 4 * hh;
        const int ch = col & 2047;
        const float b3 = p.hy_b3[col];
        const float ad = fabsf(min_decay + (float)ch * ((max_decay - min_decay) / 2047.f));
        u16* R = Rg + (size_t)ch * 4096;
#pragma unroll
        for (int q = 0; q < 2; ++q) {
          const int t = pg * 128 + (pp * 2 + q) * 32 + r;
          const float tn = (float)t / 2047.f;
          float v = (acc[ct][q][i] + b3) * (__expf(-tn * ad) + 0.05f);
          if (dir == 0) {
            if (t == 0) v += p.hy_bias_d[o * 2048 + ch];
            R[2048 - t] = f2bf(v);
          } else {
            if (t > 0) R[2048 + t] = f2bf(v);
            else R[0] = 0;
          }
        }
      }
  }
  __syncthreads();
}

constexpr int N_CV_AI = 16 * 40, N_CV_AO = 16 * 16, N_CV_HI = 16 * 64, N_CV_HO = 16 * 16;
constexpr int N_CV = N_CV_AI + N_CV_AO + N_CV_HI + N_CV_HO;
#define CV_DECODE(I, W_, Wt_, N_, tk_, tn_, perm_) do { int _i = (I); \
    const bool _a = _i < N_CV_AI, _b2 = _i < N_CV_AI + N_CV_AO, _c = _i < N_CV_AI + N_CV_AO + N_CV_HI; \
    W_ = _a ? p.attn_w_in : (_b2 ? p.attn_w_out : (_c ? p.hy_w_in : p.hy_w_out)); \
    Wt_ = (u16*)(p.ws + (_a ? OFF_WT_AI : (_b2 ? OFF_WT_AO : (_c ? OFF_WT_HI : OFF_WT_HO)))); \
    N_ = _a ? 5120 : (_b2 ? 2048 : (_c ? 8192 : 2048)); \
    const int _nt = _a ? 40 : (_b2 ? 16 : (_c ? 64 : 16)); \
    _i -= _a ? 0 : (_b2 ? N_CV_AI : (_c ? N_CV_AI + N_CV_AO : N_CV_AI + N_CV_AO + N_CV_HI)); \
    tk_ = _i / _nt; tn_ = _i - tk_ * _nt; perm_ = _a && (tn_ * 128 < 2560); } while (0)
__device__ __forceinline__ void p0_convert_all(const Params& p, float* sm) {
  const int tid = threadIdx.x;
  float4 r0, r1, r2, r3, r4, r5, r6, r7;
#define CV_LOAD(W_, N_, tk_, tn_) do { const float* _b = (W_) + (size_t)((tk_) * 128 + (tid >> 5)) * (N_) + (tn_) * 128 + (tid & 31) * 4; const size_t _s = (size_t)16 * (N_); \
    r0 = *(const float4*)(_b); r1 = *(const float4*)(_b + _s); r2 = *(const float4*)(_b + 2 * _s); r3 = *(const float4*)(_b + 3 * _s); \
    r4 = *(const float4*)(_b + 4 * _s); r5 = *(const float4*)(_b + 5 * _s); r6 = *(const float4*)(_b + 6 * _s); r7 = *(const float4*)(_b + 7 * _s); } while (0)
#define CV_PUT(R, I) do { float* _d = sm + ((tid >> 5) + 16 * (I)) * 129 + (tid & 31) * 4; _d[0] = (R).x; _d[1] = (R).y; _d[2] = (R).z; _d[3] = (R).w; } while (0)
  int it = blockIdx.x;
  const float* cW; u16* cWt; int cN, ctk, ctn; bool cperm;
  CV_DECODE(it < N_CV ? it : 0, cW, cWt, cN, ctk, ctn, cperm);
  if (it < N_CV) CV_LOAD(cW, cN, ctk, ctn);
  while (it < N_CV) {
    __syncthreads();
    CV_PUT(r0, 0); CV_PUT(r1, 1); CV_PUT(r2, 2); CV_PUT(r3, 3); CV_PUT(r4, 4); CV_PUT(r5, 5); CV_PUT(r6, 6); CV_PUT(r7, 7);
    __syncthreads();
    const int nit = it + gridDim.x;
    const float* nW; u16* nWt; int nN, ntk, ntn; bool nperm;
    CV_DECODE(nit < N_CV ? nit : 0, nW, nWt, nN, ntk, ntn, nperm);
    if (nit < N_CV) CV_LOAD(nW, nN, ntk, ntn);
    const int row = (tid & 15) | (((tid >> 6) & 7) << 4);
    int src = row;
    if (cperm) { const int g = row >> 5, w = row & 31, i16 = 4 * (w >> 3) + (w & 3), nn = (w >> 2) & 1; src = (g >> 1) * 64 + nn * 32 + (g & 1) * 16 + i16; }
#pragma unroll
    for (int i = 0; i < 4; ++i) {
      const int kch = ((tid >> 4) & 3) | (i << 2);
      unsigned w[4];
#pragma unroll
      for (int j = 0; j < 4; ++j) {
        float a = sm[(kch * 8 + 2 * j) * 129 + src];
        float b = sm[(kch * 8 + 2 * j + 1) * 129 + src];
        w[j] = pk2(a, b);
      }
      *(uint4*)(cWt + (size_t)(ctn * 128 + row) * 2048 + ctk * 128 + kch * 8) = make_uint4(w[0], w[1], w[2], w[3]);
    }
    cW = nW; cWt = nWt; cN = nN; ctk = ntk; ctn = ntn; cperm = nperm;
    it = nit;
  }
#undef CV_LOAD
#undef CV_PUT
}

__device__ __forceinline__ void phase0(const Params& p, float* sm) {
  for (int it = blockIdx.x; it < 256; it += gridDim.x) p0_adaln(p, it, sm);
  if (blockIdx.x == gridDim.x - 1) p0_rope(p);
  __syncthreads();
  for (int it = blockIdx.x; it < 256; it += gridDim.x) p0_filter(p, it, sm);
  __syncthreads();
  p0_convert_all(p, sm);
}

__device__ __forceinline__ void norm_row(const float* __restrict__ src, const float* __restrict__ g, const float* shift,
                         const float* scale, u16* dst_bf, float* dst_f, int lane) {
  float4 v[8];
  float ss = 0.f;
#pragma unroll
  for (int j = 0; j < 8; ++j) {
    v[j] = *(const float4*)(src + (j * 64 + lane) * 4);
    ss += v[j].x * v[j].x + v[j].y * v[j].y + v[j].z * v[j].z + v[j].w * v[j].w;
  }
  ss = wave_sum(ss);
  float r = rsqrtf(ss * (1.f / 2048.f) + 1e-6f);
#pragma unroll
  for (int j = 0; j < 8; ++j) {
    int c = (j * 64 + lane) * 4;
    float4 gg = *(const float4*)(g + c);
    float4 o = make_float4(v[j].x * r * gg.x, v[j].y * r * gg.y, v[j].z * r * gg.z, v[j].w * r * gg.w);
    if (dst_bf) {
      float4 sh = *(const float4*)(shift + c);
      float4 sc = *(const float4*)(scale + c);
      o.x = o.x * (1.f + sc.x) + sh.x; o.y = o.y * (1.f + sc.y) + sh.y;
      o.z = o.z * (1.f + sc.z) + sh.z; o.w = o.w * (1.f + sc.w) + sh.w;
      uint2 pk;
      pk.x = pk2(o.x, o.y);
      pk.y = pk2(o.z, o.w);
      *(uint2*)(dst_bf + c) = pk;
    } else {
      *(float4*)(dst_f + c) = o;
    }
  }
}

__device__ __forceinline__ void phase_norm(const Params& p, int mode) {
  const int wid = threadIdx.x >> 6, lane = threadIdx.x & 63;
  const float* mod = (const float*)(p.ws + OFF_MOD);
  int nrows = (mode == 0) ? (MT + MC) : MT;
  for (int row = blockIdx.x * 8 + wid; row < nrows; row += gridDim.x * 8) {
    if (mode == 0) {
      if (row < MT) {
        int b = row >> 11;
        const float* m = mod + (0 * 5 + b) * 6144;
        norm_row(p.x + (size_t)row * 2048, p.norm_g, m, m + 2048, (u16*)(p.ws + OFF_ACT) + (size_t)row * 2048, nullptr, lane);
      } else {
        int rc = row - MT;
        const float* m = mod + (0 * 5 + 4) * 6144;
        norm_row(p.ctx + (size_t)rc * 2048, p.norm_g, m, m + 2048, (u16*)(p.ws + OFF_HC) + (size_t)rc * 2048, nullptr, lane);
      }
    } else if (mode == 1) {
      int b = row >> 11;
      const float* m = mod + (1 * 5 + b) * 6144;
      norm_row(p.out + (size_t)row * 2048, p.norm_g + 2048, m, m + 2048, (u16*)(p.ws + OFF_ACT) + (size_t)row * 2048, nullptr, lane);
    } else {
      norm_row(p.out + (size_t)row * 2048, p.final_g, nullptr, nullptr, nullptr, p.out + (size_t)row * 2048, lane);
    }
  }
}

namespace pg8 {
#define PG8_LAS __attribute__((address_space(3)))
typedef unsigned short bf16_t;
typedef short bf16x8 __attribute__((ext_vector_type(8)));
typedef float f32x4 __attribute__((ext_vector_type(4)));
typedef unsigned u32x4 __attribute__((ext_vector_type(4)));
constexpr int BM = 256, BK = 64, HALF = 128, HTB = HALF * BK * 2  , STAGE_BYTES = 8 * HTB, NXCD = 8, WGM = 8;

__host__ __device__ __forceinline__ int lds_byte(int r, int c) { const int st = (r >> 4) * 2 + (c >> 5), rr = r & 15, cc = c & 31, ob = rr * 64 + cc * 2; return st * 1024 + (ob ^ (((ob >> 9) & 1) << 5)); }
__host__ __device__ __forceinline__ void stage_rc(int b, int& R, int& C) { const int st = b / 1024, sb = b % 1024, swz = sb ^ (((sb >> 9) & 1) << 5); R = (st >> 1) * 16 + swz / 64; C = (st & 1) * 32 + (swz % 64) / 2; }
__host__ __device__ __forceinline__ int perm32(int rho) { const int n = rho >> 4, i = rho & 15; return 8 * (i >> 2) + 4 * n + (i & 3); }

struct Unit { int pm, pn; };
struct Gemm { const bf16_t* A; const bf16_t* Bt; int M, N, K; int agroup; };

struct StaticOrder {
    int nM, nN, nwg, G, c;
    __host__ __device__ void init(int M, int N, int G_, int c_) { nM = M / BM; nN = N / BM; nwg = nM * nN; G = G_; c = c_; }
    __host__ __device__ bool next(int i, Unit& u) const {
        const long L = (long)i * G + c; if (L >= nwg) return false;
        int wgid = (int)L; { const int q = nwg / NXCD, r = nwg % NXCD, xcd = wgid % NXCD, off = wgid / NXCD; wgid = (xcd < r ? xcd * (q + 1) : r * (q + 1) + (xcd - r) * q) + off; }
        const int nig = WGM * nN, gid = wgid / nig, fm = gid * WGM, gsz = (nM - fm) < WGM ? (nM - fm) : WGM;
        u.pm = fm + ((wgid % nig) % gsz); u.pn = (wgid % nig) / gsz; return true;
    }
    __device__ __forceinline__ void a_ready(const Unit&) const {}
    __device__ __forceinline__ void done(const Unit&) const {}
};
__device__ __forceinline__ unsigned cvt_pk_bf16(float lo, float hi) { unsigned r; asm volatile("v_cvt_pk_bf16_f32 %0, %1, %2" : "=v"(r) : "v"(lo), "v"(hi)); return r; }
template <class Epi, class Sched, bool AGROUP = false>
__device__ __forceinline__ void gemm_phase(PG8_LAS unsigned char* lds, const Gemm g, const Sched& S, const Epi& E) {
    const int tid = threadIdx.x, wid = __builtin_amdgcn_readfirstlane(tid >> 6), lane = tid & 63, wr = wid >> 2, wc = wid & 3, fr = lane & 15, fq = lane >> 4;
    const int K = g.K, nt = K / BK;
    unsigned voffA[2], voffB[2];
#pragma unroll
    for (int i = 0; i < 2; ++i) { int R, C; stage_rc(tid * 16 + i * 8192, R, C); const int Rb = Epi::PERM ? ((R & ~31) + perm32(R & 31)) : R;
        voffA[i] = AGROUP ? (unsigned)((C >> 3) * g.M + R) * 16u : (unsigned)(R * K + C) * 2u; voffB[i] = (unsigned)(Rb * K + C) * 2u; }
    const size_t kstep = (size_t)(BK * 2);
    const size_t hstep = (size_t)HALF * K * 2;
    const size_t tstep = 2 * hstep;
    const size_t kstepA = AGROUP ? (size_t)(BK / 8) * g.M * 16 : kstep, hstepA = AGROUP ? (size_t)HALF * 16 : hstep, tstepA = 2 * hstepA;
    const unsigned ldsw = (unsigned)wid * 1024u;
    const int aoff = lds_byte(wr * 64 + fr, fq * 8), boff = lds_byte(wc * 32 + fr, fq * 8);
#define PG8_SA(b, h) (((b) * 2 + (h)) * HTB)
#define PG8_SB(b, h) ((4 + (b) * 2 + (h)) * HTB)
#define PG8_STAGE(bufoff, gbase, voff) do { _Pragma("unroll") for (int _i = 0; _i < 2; ++_i) \
        __builtin_amdgcn_global_load_lds((const unsigned*)((const char*)(gbase) + (voff)[_i]), (PG8_LAS unsigned*)(lds + (bufoff) + ldsw + _i * 8192), 16, 0, 0); } while (0)
#define PG8_LDA(dst, b, h) do { _Pragma("unroll") for (int m = 0; m < 4; ++m) _Pragma("unroll") for (int k = 0; k < 2; ++k) dst[m][k] = *(const PG8_LAS bf16x8*)(lds + PG8_SA(b, h) + aoff + m * 2048 + k * 1024); } while (0)
#define PG8_LDB(dst, b, h) do { _Pragma("unroll") for (int n = 0; n < 2; ++n) _Pragma("unroll") for (int k = 0; k < 2; ++k) dst[n][k] = *(const PG8_LAS bf16x8*)(lds + PG8_SB(b, h) + boff + n * 2048 + k * 1024); } while (0)
#define PG8_MMA(ai, bj, At, Bt) do { __builtin_amdgcn_s_setprio(1); _Pragma("unroll") for (int m = 0; m < 4; ++m) _Pragma("unroll") for (int n = 0; n < 2; ++n) _Pragma("unroll") for (int k = 0; k < 2; ++k) \
        acc[ai][bj][m][n] = __builtin_amdgcn_mfma_f32_16x16x32_bf16(Bt[n][k], At[m][k], acc[ai][bj][m][n], 0, 0, 0); __builtin_amdgcn_s_setprio(0); } while (0)
#define PG8_WAIT_V(n) asm volatile("s_waitcnt vmcnt(" #n ")" ::: "memory")
#define PG8_WAIT_L(n) asm volatile("s_waitcnt lgkmcnt(" #n ")" ::: "memory")
#define PG8_BAR __builtin_amdgcn_s_barrier()
#define PG8_SCHED __builtin_amdgcn_sched_barrier(0)
    Unit cur, nxt; int ui = 0;
    if (!S.next(0, cur)) return;
    f32x4 acc[2][2][4][2];
#pragma unroll
    for (int a = 0; a < 2; ++a)
#pragma unroll
        for (int b = 0; b < 2; ++b)
#pragma unroll
            for (int m = 0; m < 4; ++m)
#pragma unroll
                for (int n = 0; n < 2; ++n) acc[a][b][m][n] = (f32x4){0.f, 0.f, 0.f, 0.f};
    bf16x8 At[4][2], B0[2][2], B1[2][2];
    const char* cA = (const char*)g.A + (size_t)cur.pm * tstepA; const char* cB = (const char*)g.Bt + (size_t)cur.pn * tstep;
    S.a_ready(cur);
    PG8_STAGE(PG8_SB(0, 0), cB, voffB); PG8_STAGE(PG8_SA(0, 0), cA, voffA); PG8_STAGE(PG8_SB(0, 1), cB + hstep, voffB); PG8_STAGE(PG8_SA(0, 1), cA + hstepA, voffA);
    if (wr == 1) PG8_BAR;
    PG8_WAIT_V(4); PG8_BAR;
    PG8_STAGE(PG8_SB(1, 0), cB + kstep, voffB); PG8_STAGE(PG8_SA(1, 0), cA + kstepA, voffA); PG8_STAGE(PG8_SB(1, 1), cB + hstep + kstep, voffB);
    PG8_WAIT_V(6); PG8_BAR;
    for (;;) {
        const bool has_next = S.next(ui + 1, nxt);
        const char* nA = has_next ? (const char*)g.A + (size_t)nxt.pm * tstepA : cA; const char* nB = has_next ? (const char*)g.Bt + (size_t)nxt.pn * tstep : cB;
        for (int t = 0; t < nt; t += 2) {
            const bool last = (t == nt - 2);
            const char* a1 = cA + (size_t)(t + 1) * kstepA;
            const char* a2 = last ? nA : cA + (size_t)(t + 2) * kstepA; const char* b2 = last ? nB : cB + (size_t)(t + 2) * kstep;
            const char* a3 = a2 + kstepA; const char* b3 = b2 + kstep;
            if (last && has_next) S.a_ready(nxt);
            PG8_LDB(B0, 0, 0); PG8_SCHED; PG8_LDA(At, 0, 0); PG8_STAGE(PG8_SA(1, 1), a1 + hstepA, voffA);
            PG8_WAIT_L(8); PG8_BAR; PG8_WAIT_L(0); PG8_MMA(0, 0, At, B0); PG8_BAR; PG8_SCHED;
            PG8_LDB(B1, 0, 1); PG8_STAGE(PG8_SB(0, 0), b2, voffB);
            PG8_BAR; PG8_WAIT_L(0); PG8_MMA(0, 1, At, B1); PG8_BAR;
            PG8_LDA(At, 0, 1); PG8_STAGE(PG8_SA(0, 0), a2, voffA);
            PG8_BAR; PG8_WAIT_L(0); PG8_MMA(1, 0, At, B0); PG8_BAR; PG8_SCHED;
            PG8_STAGE(PG8_SB(0, 1), b2 + hstep, voffB);
            PG8_WAIT_V(6); PG8_BAR; PG8_MMA(1, 1, At, B1); PG8_BAR;
            PG8_LDB(B0, 1, 0); PG8_SCHED; PG8_LDA(At, 1, 0); PG8_STAGE(PG8_SA(0, 1), a2 + hstepA, voffA);
            PG8_WAIT_L(8); PG8_BAR; PG8_WAIT_L(0); PG8_MMA(0, 0, At, B0); PG8_BAR; PG8_SCHED;
            PG8_LDB(B1, 1, 1); PG8_STAGE(PG8_SB(1, 0), b3, voffB);
            PG8_BAR; PG8_WAIT_L(0); PG8_MMA(0, 1, At, B1); PG8_BAR;
            PG8_LDA(At, 1, 1); PG8_STAGE(PG8_SA(1, 0), a3, voffA);
            PG8_BAR; PG8_WAIT_L(0); PG8_MMA(1, 0, At, B0); PG8_BAR; PG8_SCHED;
            PG8_STAGE(PG8_SB(1, 1), b3 + hstep, voffB);
            PG8_WAIT_V(6); PG8_BAR; PG8_MMA(1, 1, At, B1); PG8_BAR;
        }
        if constexpr (!Epi::AFTER_DRAIN) { E(acc, cur, wr, wc, fr, fq); S.done(cur); }
        if (!has_next) break;
#pragma unroll
        for (int a = 0; a < 2; ++a)
#pragma unroll
            for (int b = 0; b < 2; ++b)
#pragma unroll
                for (int m = 0; m < 4; ++m)
#pragma unroll
                    for (int n = 0; n < 2; ++n) acc[a][b][m][n] = (f32x4){0.f, 0.f, 0.f, 0.f};
        cur = nxt; cA = nA; cB = nB; ++ui;
    }
    PG8_WAIT_V(0);
    if (wr == 0) PG8_BAR;
    PG8_BAR;
    if constexpr (Epi::AFTER_DRAIN) { E.fused(acc, cur, wr, wc, fr, fq, lds, wid, lane); S.done(cur); }
#undef PG8_SA
#undef PG8_SB
#undef PG8_STAGE
#undef PG8_LDA
#undef PG8_LDB
#undef PG8_MMA
#undef PG8_WAIT_V
#undef PG8_WAIT_L
#undef PG8_BAR
#undef PG8_SCHED
}
}

__device__ __forceinline__ uint2 pack4(pg8::f32x4 v) {
  uint2 r;
  r.x = pk2(v[0], v[1]);
  r.y = pk2(v[2], v[3]);
  return r;
}
struct EpiAttnIn {
  static constexpr bool PERM = true, AFTER_DRAIN = false;
  u16* O; const float* rope;
  __device__ __forceinline__ void operator()(const pg8::f32x4 (&acc)[2][2][4][2], const pg8::Unit& u, int wr, int wc, int fr, int fq) const {
    const int row0 = u.pm * 256 + wr * 64 + fr, col0 = u.pn * 256 + wc * 32 + 8 * fq;
    const bool dorope = (u.pn < 10);
    const int axis = wc >> 1, i0 = (wc & 1) * 16 + 4 * fq;
#pragma unroll
    for (int ai = 0; ai < 2; ++ai)
#pragma unroll
      for (int m = 0; m < 4; ++m) {
        const int row = row0 + ai * 128 + m * 16;
        u16* rowp = O + (size_t)row * 5120 + col0;
        if (dorope) {
          const int s = row & 2047;
          const int pos = axis ? (s & 63) : (s >> 6);
          const float4* rp = (const float4*)(rope + (pos * 32 + i0) * 2);
          float4 c01 = rp[0], c23 = rp[1];
#pragma unroll
          for (int bj = 0; bj < 2; ++bj) {
            pg8::f32x4 a = acc[ai][bj][m][0], b = acc[ai][bj][m][1], o0, o1;
            o0[0] = a[0] * c01.x - b[0] * c01.y; o1[0] = b[0] * c01.x + a[0] * c01.y;
            o0[1] = a[1] * c01.z - b[1] * c01.w; o1[1] = b[1] * c01.z + a[1] * c01.w;
            o0[2] = a[2] * c23.x - b[2] * c23.y; o1[2] = b[2] * c23.x + a[2] * c23.y;
            o0[3] = a[3] * c23.z - b[3] * c23.w; o1[3] = b[3] * c23.z + a[3] * c23.w;
            const uint2 lo = pack4(o0), hi = pack4(o1);
            *(uint4*)(rowp + bj * 128) = make_uint4(lo.x, lo.y, hi.x, hi.y);
          }
        } else {
#pragma unroll
          for (int bj = 0; bj < 2; ++bj) {
            const uint2 lo = pack4(acc[ai][bj][m][0]), hi = pack4(acc[ai][bj][m][1]);
            *(uint4*)(rowp + bj * 128) = make_uint4(lo.x, lo.y, hi.x, hi.y);
          }
        }
      }
  }
};
struct EpiRaw {
  static constexpr bool PERM = true, AFTER_DRAIN = false;
  u16* O; int ldc;
  __device__ __forceinline__ void operator()(const pg8::f32x4 (&acc)[2][2][4][2], const pg8::Unit& u, int wr, int wc, int fr, int fq) const {
    const int row0 = u.pm * 256 + wr * 64 + fr, col0 = u.pn * 256 + wc * 32 + 8 * fq;
#pragma unroll
    for (int ai = 0; ai < 2; ++ai)
#pragma unroll
      for (int m = 0; m < 4; ++m) {
        u16* rowp = O + (size_t)(row0 + ai * 128 + m * 16) * ldc + col0;
#pragma unroll
        for (int bj = 0; bj < 2; ++bj) {
          const uint2 lo = pack4(acc[ai][bj][m][0]), hi = pack4(acc[ai][bj][m][1]);
          *(uint4*)(rowp + bj * 128) = make_uint4(lo.x, lo.y, hi.x, hi.y);
        }
      }
  }
};
struct EpiRes {
  static constexpr bool PERM = false, AFTER_DRAIN = false;
  float* out; const float* base; const float* gate;
  __device__ __forceinline__ void operator()(const pg8::f32x4 (&acc)[2][2][4][2], const pg8::Unit& u, int wr, int wc, int fr, int fq) const {
    const int row0 = u.pm * 256 + wr * 64 + fr, col0 = u.pn * 256 + wc * 32 + 4 * fq;
    const int b = (u.pm * 256) >> 11;
    pg8::f32x4 gv[2][2];
#pragma unroll
    for (int bj = 0; bj < 2; ++bj)
#pragma unroll
      for (int n = 0; n < 2; ++n) gv[bj][n] = *(const pg8::f32x4*)(gate + b * 6144 + col0 + bj * 128 + n * 16);
#pragma unroll
    for (int ai = 0; ai < 2; ++ai)
#pragma unroll
      for (int m = 0; m < 4; ++m) {
        const size_t off = (size_t)(row0 + ai * 128 + m * 16) * 2048 + col0;
#pragma unroll
        for (int bj = 0; bj < 2; ++bj)
#pragma unroll
          for (int n = 0; n < 2; ++n) {
            pg8::f32x4 bv = *(const pg8::f32x4*)(base + off + bj * 128 + n * 16);
            *(pg8::f32x4*)(out + off + bj * 128 + n * 16) = bv + gv[bj][n] * acc[ai][bj][m][n];
          }
      }
  }
};

struct EpiResNorm {
  static constexpr bool PERM = false, AFTER_DRAIN = true;
  float* out; const float* base; const float* gate;
  float* rowss; unsigned* pcnt;
  const float* g; const float* shsc;
  u16* hx;
  static __device__ __forceinline__ int loff(int row, int chunk) { return row * 1024 + ((chunk ^ (row & 63)) << 4); }
  __device__ __forceinline__ void fused(pg8::f32x4 (&acc)[2][2][4][2], const pg8::Unit& u, int wr, int wc, int fr, int fq,
                                        PG8_LAS unsigned char* lds, int wid, int lane) const {
    const int R0 = u.pm * 256, C0 = u.pn * 256;
    const int b = R0 >> 11;
    const int frow = wr * 64 + fr, fchunk = wc * 8 + fq;
    {
      pg8::f32x4 gv[2][2];
#pragma unroll
      for (int bj = 0; bj < 2; ++bj)
#pragma unroll
        for (int n = 0; n < 2; ++n) gv[bj][n] = *(const pg8::f32x4*)(gate + b * 6144 + C0 + wc * 32 + 4 * fq + bj * 128 + n * 16);
#pragma unroll
      for (int ai = 0; ai < 2; ++ai) {
        {
          pg8::f32x4 t[16];
#pragma unroll
          for (int i = 0; i < 16; ++i) t[i] = *(const pg8::f32x4*)(base + (size_t)(R0 + ai * 128 + wid * 16 + i) * 2048 + C0 + 4 * lane);
#pragma unroll
          for (int i = 0; i < 16; ++i) *(PG8_LAS pg8::f32x4*)(lds + loff(wid * 16 + i, lane)) = t[i];
        }
        __syncthreads();
#pragma unroll
        for (int m = 0; m < 4; ++m) {
          float ss = 0.f;
#pragma unroll
          for (int bj = 0; bj < 2; ++bj)
#pragma unroll
            for (int n = 0; n < 2; ++n) {
              const pg8::f32x4 bv = *(const PG8_LAS pg8::f32x4*)(lds + loff(frow + 16 * m, fchunk + 32 * bj + 4 * n));
              const pg8::f32x4 v = bv + gv[bj][n] * acc[ai][bj][m][n];
              acc[ai][bj][m][n] = v;
              ss += v[0] * v[0] + v[1] * v[1] + v[2] * v[2] + v[3] * v[3];
            }
          ss += __shfl_xor(ss, 16, 64);
          ss += __shfl_xor(ss, 32, 64);
          if (fq == 0) unsafeAtomicAdd(rowss + R0 + ai * 128 + frow + 16 * m, ss);
        }
        __syncthreads();
      }
    }
    asm volatile("s_waitcnt vmcnt(0)" ::: "memory");
    __syncthreads();
    if (threadIdx.x == 0) {
      unsigned* c = pcnt + u.pm * 64;
      __hip_atomic_fetch_add(c, 1u, __ATOMIC_RELAXED, __HIP_MEMORY_SCOPE_AGENT);
      unsigned spins = 0;
      while (__hip_atomic_load(c, __ATOMIC_RELAXED, __HIP_MEMORY_SCOPE_AGENT) < 8u && ++spins < (1u << 22)) __builtin_amdgcn_s_sleep(1);
    }
    __syncthreads();
    const pg8::f32x4 gg = *(const pg8::f32x4*)(g + C0 + 4 * lane);
    pg8::f32x4 sh = gg, sc = gg;
    if (hx) {
      sh = *(const pg8::f32x4*)(shsc + b * 6144 + C0 + 4 * lane);
      sc = *(const pg8::f32x4*)(shsc + b * 6144 + 2048 + C0 + 4 * lane) + 1.f;
    }
#pragma unroll
    for (int ai = 0; ai < 2; ++ai) {
#pragma unroll
      for (int m = 0; m < 4; ++m)
#pragma unroll
        for (int bj = 0; bj < 2; ++bj)
#pragma unroll
          for (int n = 0; n < 2; ++n)
            *(PG8_LAS pg8::f32x4*)(lds + loff(frow + 16 * m, fchunk + 32 * bj + 4 * n)) = acc[ai][bj][m][n];
      __syncthreads();
#pragma unroll 4
      for (int i = 0; i < 16; ++i) {
        const int lrow = wid * 16 + i, row = R0 + ai * 128 + lrow;
        const pg8::f32x4 v = *(const PG8_LAS pg8::f32x4*)(lds + loff(lrow, lane));
        const float ss = __hip_atomic_load(rowss + row, __ATOMIC_RELAXED, __HIP_MEMORY_SCOPE_AGENT);
        const float r = rsqrtf(ss * (1.f / 2048.f) + 1e-6f);
        const size_t off = (size_t)row * 2048 + C0 + 4 * lane;
        pg8::f32x4 o = v * r * gg;
        if (hx) {
          *(pg8::f32x4*)(out + off) = v;
          o = o * sc + sh;
          *(uint2*)(hx + off) = pack4(o);
        } else {
          *(pg8::f32x4*)(out + off) = o;
        }
      }
      __syncthreads();
    }
  }
};
template <class Epi, bool AGROUP = false>
__device__ __forceinline__ void run_gemm(float* sm, const u16* A, const u16* Bt, int M, int N, const Epi& E, int c) {
  pg8::Gemm g{A, Bt, M, N, 2048, AGROUP ? 1 : 0};
  pg8::StaticOrder S; S.init(M, N, (int)gridDim.x, c);
  pg8::gemm_phase<Epi, pg8::StaticOrder, AGROUP>((PG8_LAS unsigned char*)sm, g, S, E);
  __syncthreads();
}

template <int MODE>
__device__ __forceinline__ void epi_pair(const Params& p, int m, int n, float a0, float a1) {
  if (MODE == 1) {
    u16* px = (u16*)(p.ws + OFF_BIG);
    float o0 = a0, o1 = a1;
    if (n < 2560) {
      int g = (n >> 5) & 3, fr = n & 15;
      int axis = g >> 1, i = (g & 1) * 16 + fr;
      int s = m & 2047;
      int pos = axis ? (s & 63) : (s >> 6);
      float2 cs = ((const float2*)(p.ws + OFF_ROPE))[pos * 32 + i];
      o0 = a0 * cs.x - a1 * cs.y;
      o1 = a1 * cs.x + a0 * cs.y;
    }
    px[(size_t)m * 5120 + n] = f2bf(o0);
    px[(size_t)m * 5120 + n + 16] = f2bf(o1);
  } else if (MODE == 5) {
    u16* kvc = (u16*)(p.ws + OFF_KVC);
    kvc[(size_t)m * 1024 + n] = f2bf(a0);
    kvc[(size_t)m * 1024 + n + 16] = f2bf(a1);
  } else if (MODE == 2) {
    const float* mod = (const float*)(p.ws + OFF_MOD);
    int b = m >> 11;
    const float* gate = mod + (0 * 5 + b) * 6144 + 4096;
    p.out[(size_t)m * 2048 + n] = p.x[(size_t)m * 2048 + n] + gate[n] * a0;
    p.out[(size_t)m * 2048 + n + 16] = p.x[(size_t)m * 2048 + n + 16] + gate[n + 16] * a1;
  } else if (MODE == 3) {
    u16* pp = (u16*)(p.ws + OFF_BIG);
    pp[(size_t)m * 8192 + n] = f2bf(a0);
    pp[(size_t)m * 8192 + n + 16] = f2bf(a1);
  } else if (MODE == 4) {
    const float* mod = (const float*)(p.ws + OFF_MOD);
    int b = m >> 11;
    const float* gate = mod + (1 * 5 + b) * 6144 + 4096;
    p.out[(size_t)m * 2048 + n] += gate[n] * a0;
    p.out[(size_t)m * 2048 + n + 16] += gate[n + 16] * a1;
  }
}

template <int MODE>
__device__ __forceinline__ void naive_gemm(const Params& p, const u16* __restrict__ A, const u16* __restrict__ Wt, int M, int N) {
  const int tid = threadIdx.x;
  const int ml = tid >> 5, pl = tid & 31;
  const int ntn = N / 64, ntm = M / 16;
  for (int tile = blockIdx.x; tile < ntn * ntm; tile += gridDim.x) {
    int tm = tile / ntn, tn = tile % ntn;
    int m = tm * 16 + ml;
    int n = tn * 64 + (pl >> 4) * 32 + (pl & 15);
    const uint4* a = (const uint4*)(A + (size_t)m * 2048);
    const uint4* w0 = (const uint4*)(Wt + (size_t)n * 2048);
    const uint4* w1 = (const uint4*)(Wt + (size_t)(n + 16) * 2048);
    float acc0 = 0.f, acc1 = 0.f;
#pragma unroll 2
    for (int k = 0; k < 256; ++k) {
      uint4 av = a[k], b0 = w0[k], b1 = w1[k];
      acc0 += bflo(av.x) * bflo(b0.x) + bfhi(av.x) * bfhi(b0.x) + bflo(av.y) * bflo(b0.y) + bfhi(av.y) * bfhi(b0.y)
            + bflo(av.z) * bflo(b0.z) + bfhi(av.z) * bfhi(b0.z) + bflo(av.w) * bflo(b0.w) + bfhi(av.w) * bfhi(b0.w);
      acc1 += bflo(av.x) * bflo(b1.x) + bfhi(av.x) * bfhi(b1.x) + bflo(av.y) * bflo(b1.y) + bfhi(av.y) * bfhi(b1.y)
            + bflo(av.z) * bflo(b1.z) + bfhi(av.z) * bfhi(b1.z) + bflo(av.w) * bflo(b1.w) + bfhi(av.w) * bfhi(b1.w);
    }
    epi_pair<MODE>(p, m, n, acc0, acc1);
  }
}

__device__ __forceinline__ void phase_attn_naive(const Params& p, float* sm) {
  const int wid = threadIdx.x >> 6, lane = threadIdx.x & 63;
  float* qs = sm + wid * (128 + 640);
  float* pr = qs + 128;
  const u16* px = (const u16*)(p.ws + OFF_BIG);
  const u16* kvc = (const u16*)(p.ws + OFF_KVC);
  u16* og = (u16*)(p.ws + OFF_ACT);
  const float scale = 0.08838834764831845f;
  for (int item = blockIdx.x * 8 + wid; item < MT * 16; item += gridDim.x * 8) {
    int m = item >> 4, h = item & 15;
    int b = m >> 11, s = m & 2047, kvh = h >> 2, nblk = s >> 7;
    const u16* qrow = px + (size_t)m * 5120 + h * 128;
    qs[lane] = bf2f(qrow[lane]) * scale;
    qs[lane + 64] = bf2f(qrow[lane + 64]) * scale;
    asm volatile("s_waitcnt lgkmcnt(0)" ::: "memory");
    float mx = p.attn_sink[h];
#pragma unroll 1
    for (int j = 0; j < 10; ++j) {
      int kidx = j * 64 + lane;
      const u16* krow;
      bool valid;
      if (kidx < 384) {
        int kpos = (nblk - 1) * 128 + kidx;
        int rel = kpos - s;
        valid = (kpos >= 0) && (kpos < 2048) && (rel <= 128) && (rel >= -128);
        krow = px + (size_t)(b * 2048 + (valid ? kpos : 0)) * 5120 + 2048 + kvh * 128;
      } else {
        valid = true;
        krow = kvc + (size_t)(b * 256 + (kidx - 384)) * 1024 + kvh * 128;
      }
      float d = -1e30f;
      if (valid) {
        d = 0.f;
#pragma unroll 4
        for (int c = 0; c < 16; ++c) {
          uint4 kk = *(const uint4*)(krow + c * 8);
          const float* q8 = qs + c * 8;
          d += q8[0] * bflo(kk.x) + q8[1] * bfhi(kk.x) + q8[2] * bflo(kk.y) + q8[3] * bfhi(kk.y)
             + q8[4] * bflo(kk.z) + q8[5] * bfhi(kk.z) + q8[6] * bflo(kk.w) + q8[7] * bfhi(kk.w);
        }
      }
      pr[kidx] = d;
      mx = fmaxf(mx, d);
    }
    mx = wave_max(mx);
    float sum = 0.f;
#pragma unroll 1
    for (int j = 0; j < 10; ++j) {
      float d = pr[j * 64 + lane];
      float e = (d > -1e29f) ? __expf(d - mx) : 0.f;
      pr[j * 64 + lane] = e;
      sum += e;
    }
    sum = wave_sum(sum);
    sum += __expf(p.attn_sink[h] - mx);
    asm volatile("s_waitcnt lgkmcnt(0)" ::: "memory");
    float o0 = 0.f, o1 = 0.f;
    int k0 = s - 128 < 0 ? 0 : s - 128, k1 = s + 128 > 2047 ? 2047 : s + 128;
    for (int kpos = k0; kpos <= k1; ++kpos) {
      float pv = pr[kpos - (nblk - 1) * 128];
      unsigned vv = *(const unsigned*)(px + (size_t)(b * 2048 + kpos) * 5120 + 2560 + kvh * 128 + lane * 2);
      o0 += pv * bflo(vv); o1 += pv * bfhi(vv);
    }
    for (int c = 0; c < 256; ++c) {
      float pv = pr[384 + c];
      unsigned vv = *(const unsigned*)(kvc + (size_t)(b * 256 + c) * 1024 + 512 + kvh * 128 + lane * 2);
      o0 += pv * bflo(vv); o1 += pv * bfhi(vv);
    }
    float inv = 1.f / sum;
    unsigned gg = *(const unsigned*)(px + (size_t)m * 5120 + 3072 + h * 128 + lane * 2);
    float r0 = o0 * inv * siluf(bflo(gg)), r1 = o1 * inv * siluf(bfhi(gg));
    *(unsigned*)(og + (size_t)m * 2048 + h * 128 + lane * 2) = pk2(r0, r1);
    asm volatile("s_waitcnt lgkmcnt(0)" ::: "memory");
  }
}

__device__ __forceinline__ float sconv(const u16* pp, const float* cw, const float* cb, int b, int t, int c) {
  const u16* base = pp + (size_t)(b * 2048 + t) * 8192 + c;
  float v = cw[6144 + c] * bf2f(base[0]) + cb[c];
  if (t > 0) v += cw[c] * bf2f(base[-8192]);
  if (t < 2047) v += cw[2 * 6144 + c] * bf2f(base[8192]);
  return v;
}

__device__ __forceinline__ void phase_conv_naive(const Params& p, float* sm) {
  const int tid = threadIdx.x;
  float* u = sm;
  float* R = sm + 8192;
  const u16* pp = (const u16*)(p.ws + OFF_BIG);
  const u16* Rg = (const u16*)(p.ws + OFF_FILT);
  u16* yg = (u16*)(p.ws + OFF_ACT);
  for (int ch = blockIdx.x; ch < 2048; ch += gridDim.x) {
    for (int i = tid; i < 8192; i += NTHREADS) u[i] = sconv(pp, p.hy_conv_w, p.hy_conv_b, i >> 11, i & 2047, 4096 + ch);
    for (int i = tid; i < 4096; i += NTHREADS) R[i] = bf2f(Rg[((size_t)0 * 2048 + ch) * 4096 + i]);
    __syncthreads();
    float zr[16];
#pragma unroll
    for (int q = 0; q < 16; ++q) {
      int i = tid + q * NTHREADS;
      int b = i >> 11, t = i & 2047;
      const float* ub = u + b * 2048;
      const float* Rb = R + 2048 - t;
      float a = 0.f;
      for (int s = 0; s < 2048; ++s) a += Rb[s] * ub[s];
      zr[q] = a * sconv(pp, p.hy_conv_w, p.hy_conv_b, b, t, ch);
    }
    __syncthreads();
#pragma unroll
    for (int q = 0; q < 16; ++q) u[tid + q * NTHREADS] = zr[q];
    for (int i = tid; i < 4096; i += NTHREADS) R[i] = bf2f(Rg[((size_t)1 * 2048 + ch) * 4096 + i]);
    __syncthreads();
#pragma unroll
    for (int q = 0; q < 16; ++q) {
      int i = tid + q * NTHREADS;
      int b = i >> 11, t = i & 2047;
      const float* ub = u + b * 2048;
      const float* Rb = R + 2048 - t;
      float a = 0.f;
      for (int s = 0; s < 2048; ++s) a += Rb[s] * ub[s];
      float y = a * sconv(pp, p.hy_conv_w, p.hy_conv_b, b, t, 2048 + ch);
      float g = bf2f(pp[(size_t)(b * 2048 + t) * 8192 + 6144 + ch]);
      yg[(size_t)(b * 2048 + t) * 2048 + ch] = f2bf(y * siluf(g));
    }
    __syncthreads();
  }
}


typedef float f32x16 __attribute__((ext_vector_type(16)));
typedef pg8::bf16x8 bfx8;
constexpr int CONV_RF_BYTES = 4 * 2 * 8192;
constexpr int CONV_PAD = 15;
constexpr int CONV_UB_ONE = 190 * 64;
__device__ __forceinline__ int ub_addr(int col, int chunk) { return col * 64 + ((chunk ^ ((col >> 2) & 3)) << 4); }

__device__ __forceinline__ void conv_mfma(const char* Rf_ci, const char* Ub_w, int lane, f32x16 (&acc)[4]) {
  const int t2 = lane & 31, h = lane >> 5, n = lane & 31;
  const int lanedw = (2048 - t2 + 8 * h) >> 1;
#pragma unroll
  for (int j = 0; j < 4; ++j)
#pragma unroll
    for (int r = 0; r < 16; ++r) acc[j][r] = 0.f;
#pragma unroll 1
  for (int f = 0; f < 16; ++f) {
    bfx8 Bw[5][2];
#pragma unroll
    for (int m = 0; m < 5; ++m) {
      const int col = (16 * m - f + CONV_PAD) * 2 + n;
#pragma unroll
      for (int kh = 0; kh < 2; ++kh) Bw[m][kh] = *(const bfx8*)(Ub_w + ub_addr(col, 2 * kh + h));
    }
    const unsigned* Rp = (const unsigned*)(Rf_ci + ((t2 & 1) ? 8192 : 0)) + lanedw - 16 * f;
#pragma unroll
    for (int e = -4; e <= 3; ++e) {
      int ee = e;
      if (e == -4) ee = (f == 0) ? -3 : -4;
      bfx8 A[2];
#pragma unroll
      for (int kh = 0; kh < 2; ++kh) {
        const unsigned* q = Rp - 256 * ee + 8 * kh;
        pg8::u32x4 pk;
        pk[0] = q[0]; pk[1] = q[1]; pk[2] = q[2]; pk[3] = q[3];
        A[kh] = __builtin_bit_cast(bfx8, pk);
      }
#pragma unroll
      for (int j = 0; j < 4; ++j) {
        const int m = j - e;
        if (m >= 0 && m <= 4) acc[j] = __builtin_amdgcn_mfma_f32_32x32x16_bf16(A[0], Bw[m][0], acc[j], 0, 0, 0);
      }
#pragma unroll
      for (int j = 0; j < 4; ++j) {
        const int m = j - e;
        if (m >= 0 && m <= 4) acc[j] = __builtin_amdgcn_mfma_f32_32x32x16_bf16(A[1], Bw[m][1], acc[j], 0, 0, 0);
      }
    }
  }
}

__device__ __forceinline__ void sconv4(const u16* xp, int t, float w0, float w1, float w2, float cb, float (&o)[4]) {
  uint2 x4 = *(const uint2*)xp;
  float pv = t > 0 ? bf2f(xp[-1]) : 0.f;
  float nx = (t + 4 < 2048) ? bf2f(xp[4]) : 0.f;
  float e0 = bflo(x4.x), e1 = bfhi(x4.x), e2 = bflo(x4.y), e3 = bfhi(x4.y);
  o[0] = w0 * pv + w1 * e0 + w2 * e1 + cb;
  o[1] = w0 * e0 + w1 * e1 + w2 * e2 + cb;
  o[2] = w0 * e1 + w1 * e2 + w2 * e3 + cb;
  o[3] = w0 * e2 + w1 * e3 + w2 * nx + cb;
}

struct SC4 { uint2 x; unsigned pn; };
__device__ __forceinline__ SC4 sc4_load(const u16* xp, int t) {
  SC4 r;
  r.x = *(const uint2*)xp;
  const unsigned pv = t > 0 ? (unsigned)xp[-1] : 0u;
  const unsigned nx = (t + 4 < 2048) ? (unsigned)xp[4] : 0u;
  r.pn = pv | (nx << 16);
  return r;
}
__device__ __forceinline__ void sc4_apply(const SC4& r, float w0, float w1, float w2, float cb, float (&o)[4]) {
  const float pv = bflo(r.pn), nx = bfhi(r.pn);
  const float e0 = bflo(r.x.x), e1 = bfhi(r.x.x), e2 = bflo(r.x.y), e3 = bfhi(r.x.y);
  o[0] = w0 * pv + w1 * e0 + w2 * e1 + cb;
  o[1] = w0 * e0 + w1 * e1 + w2 * e2 + cb;
  o[2] = w0 * e1 + w1 * e2 + w2 * e3 + cb;
  o[3] = w0 * e2 + w1 * e3 + w2 * nx + cb;
}

__device__ __forceinline__ void phase_conv(const Params& p, float* smf) {
  char* sm = (char*)smf;
  char* Rf = sm;
  char* Ub = sm + CONV_RF_BYTES;
  int tid = threadIdx.x;
  asm volatile("" : "+v"(tid));
  const int wid = tid >> 6, lane = tid & 63;
  const int ci = wid >> 1, bp = wid & 1;
  const u16* pT = (const u16*)(p.ws + OFF_BIG);
  const u16* Rg = (const u16*)(p.ws + OFF_FILT);
  u16* yg = (u16*)(p.ws + OFF_ACT);
  for (int kk = 0; kk < (8 * CONV_UB_ONE / 16 + NTHREADS - 1) / NTHREADS; ++kk) { const int zi = tid + kk * NTHREADS; if (zi < 8 * CONV_UB_ONE / 16) ((uint4*)Ub)[zi] = make_uint4(0, 0, 0, 0); }
  __syncthreads();
  char* Ub_w = Ub + (ci * 2 + bp) * CONV_UB_ONE;
  const char* Rf_ci = Rf + ci * 16384;
  const int h = lane >> 5, n = lane & 31;
  for (int it0 = blockIdx.x * 2; it0 < 512; it0 += gridDim.x * 2)
#pragma unroll 1
  for (int sub = 0; sub < 2; ++sub) {
    const int item = it0 + sub;
    const int ch0 = item * 4;
    {
      const int q = tid & 255, hb = tid >> 8;
      uint4 x8[8]; unsigned pn[8]; uint4 fr[4];
#pragma unroll
      for (int k = 0; k < 8; ++k) {
        const int cc = 4096 + ch0 + (k >> 1), b = (k & 1) * 2 + hb;
        const u16* xp = pT + (size_t)cc * 8192 + b * 2048 + q * 8;
        x8[k] = *(const uint4*)xp;
        const unsigned pv = q > 0 ? (unsigned)xp[-1] : 0u;
        const unsigned nx = q < 255 ? (unsigned)xp[8] : 0u;
        pn[k] = pv | (nx << 16);
      }
      unsigned fx[4];
#pragma unroll
      for (int k = 0; k < 4; ++k) {
        const unsigned* fp = (const unsigned*)(Rg + ((size_t)0 * 2048 + ch0 + k) * 4096);
        fr[k] = ((const uint4*)fp)[tid];
        fx[k] = tid < 511 ? fp[4 * tid + 4] : 0u;
      }
#pragma unroll
      for (int k = 0; k < 8; ++k) {
        const int c = k >> 1, cc = 4096 + ch0 + c, b = (k & 1) * 2 + hb;
        const float w0 = p.hy_conv_w[cc], w1 = p.hy_conv_w[6144 + cc], w2 = p.hy_conv_w[2 * 6144 + cc], cb = p.hy_conv_b[cc];
        float e[10];
        e[0] = bflo(pn[k]); e[1] = bflo(x8[k].x); e[2] = bfhi(x8[k].x); e[3] = bflo(x8[k].y); e[4] = bfhi(x8[k].y);
        e[5] = bflo(x8[k].z); e[6] = bfhi(x8[k].z); e[7] = bflo(x8[k].w); e[8] = bfhi(x8[k].w); e[9] = bfhi(pn[k]);
        unsigned o[4];
#pragma unroll
        for (int kk = 0; kk < 4; ++kk) {
          float a = w0 * e[2 * kk] + w1 * e[2 * kk + 1] + w2 * e[2 * kk + 2] + cb;
          float bb = w0 * e[2 * kk + 1] + w1 * e[2 * kk + 2] + w2 * e[2 * kk + 3] + cb;
          o[kk] = pk2(a, bb);
        }
        const int t0 = q * 8, s1 = t0 >> 5, s2 = t0 & 31;
        const int col = (s1 + CONV_PAD) * 2 + (b & 1);
        *(uint4*)(Ub + (c * 2 + (b >> 1)) * CONV_UB_ONE + ub_addr(col, s2 >> 3)) = make_uint4(o[0], o[1], o[2], o[3]);
      }
#pragma unroll
      for (int k = 0; k < 4; ++k) {
        ((uint4*)(Rf + k * 16384))[tid] = fr[k];
        ((uint4*)(Rf + k * 16384 + 8192))[tid] = make_uint4(__builtin_amdgcn_alignbit(fr[k].y, fr[k].x, 16), __builtin_amdgcn_alignbit(fr[k].z, fr[k].y, 16),
                                                             __builtin_amdgcn_alignbit(fr[k].w, fr[k].z, 16), __builtin_amdgcn_alignbit(fx[k], fr[k].w, 16));
      }
    }
    __syncthreads();
    f32x16 acc[4];
    const int ch = ch0 + ci;
    {
      conv_mfma(Rf_ci, Ub_w, lane, acc);
      SC4 xr[16];
#pragma unroll
      for (int j = 0; j < 4; ++j)
#pragma unroll
        for (int vg = 0; vg < 4; ++vg) {
          const int t1 = 16 * j + (n >> 1), b = 2 * bp + (n & 1), t = 32 * t1 + 8 * vg + 4 * h;
          xr[j * 4 + vg] = sc4_load(pT + (size_t)ch * 8192 + b * 2048 + t, t);
        }
      const unsigned* f1p = (const unsigned*)(Rg + ((size_t)1 * 2048 + ch0) * 4096);
      const uint4 f1a = ((const uint4*)(f1p + 0 * 2048))[tid];
      const uint4 f1b = ((const uint4*)(f1p + 1 * 2048))[tid];
      const uint4 f1c = ((const uint4*)(f1p + 2 * 2048))[tid];
      const uint4 f1d = ((const uint4*)(f1p + 3 * 2048))[tid];
      const unsigned x1a = tid < 511 ? f1p[0 * 2048 + 4 * tid + 4] : 0u, x1b = tid < 511 ? f1p[1 * 2048 + 4 * tid + 4] : 0u;
      const unsigned x1c = tid < 511 ? f1p[2 * 2048 + 4 * tid + 4] : 0u, x1d = tid < 511 ? f1p[3 * 2048 + 4 * tid + 4] : 0u;
      const float w0 = p.hy_conv_w[ch], w1 = p.hy_conv_w[6144 + ch], w2 = p.hy_conv_w[2 * 6144 + ch], cb = p.hy_conv_b[ch];
#pragma unroll
      for (int j = 0; j < 4; ++j)
#pragma unroll
        for (int vg = 0; vg < 4; ++vg) {
          const int t1 = 16 * j + (n >> 1), bl = n & 1;
          float x1[4];
          sc4_apply(xr[j * 4 + vg], w0, w1, w2, cb, x1);
          uint2 pk;
          pk.x = pk2(x1[0] * acc[j][4 * vg + 0], x1[1] * acc[j][4 * vg + 1]);
          pk.y = pk2(x1[2] * acc[j][4 * vg + 2], x1[3] * acc[j][4 * vg + 3]);
          const int col = (t1 + CONV_PAD) * 2 + bl;
          *(uint2*)(Ub_w + ub_addr(col, vg) + 8 * h) = pk;
        }
      __syncthreads();
#define CONV_PUT_F(K, F, X) do { ((uint4*)(Rf + (K) * 16384))[tid] = F; \
        ((uint4*)(Rf + (K) * 16384 + 8192))[tid] = make_uint4(__builtin_amdgcn_alignbit(F.y, F.x, 16), __builtin_amdgcn_alignbit(F.z, F.y, 16), \
                                                               __builtin_amdgcn_alignbit(F.w, F.z, 16), __builtin_amdgcn_alignbit(X, F.w, 16)); } while (0)
      CONV_PUT_F(0, f1a, x1a); CONV_PUT_F(1, f1b, x1b); CONV_PUT_F(2, f1c, x1c); CONV_PUT_F(3, f1d, x1d);
#undef CONV_PUT_F
    }
    __syncthreads();
    {
      const int c2 = 2048 + ch;
      SC4 xr[16]; uint2 gr[16];
      conv_mfma(Rf_ci, Ub_w, lane, acc);
#pragma unroll
      for (int j = 0; j < 4; ++j)
#pragma unroll
        for (int vg = 0; vg < 4; ++vg) {
          const int t1 = 16 * j + (n >> 1), b = 2 * bp + (n & 1), t = 32 * t1 + 8 * vg + 4 * h;
          xr[j * 4 + vg] = sc4_load(pT + (size_t)c2 * 8192 + b * 2048 + t, t);
          gr[j * 4 + vg] = *(const uint2*)(pT + (size_t)(6144 + ch) * 8192 + b * 2048 + t);
        }
      const float w0 = p.hy_conv_w[c2], w1 = p.hy_conv_w[6144 + c2], w2 = p.hy_conv_w[2 * 6144 + c2], cb = p.hy_conv_b[c2];
#pragma unroll
      for (int j = 0; j < 4; ++j)
#pragma unroll
        for (int vg = 0; vg < 4; ++vg) {
          const int t1 = 16 * j + (n >> 1), bl = n & 1;
          float x2[4];
          sc4_apply(xr[j * 4 + vg], w0, w1, w2, cb, x2);
          const uint2 g4 = gr[j * 4 + vg];
          float y0 = x2[0] * acc[j][4 * vg + 0] * siluf(bflo(g4.x));
          float y1 = x2[1] * acc[j][4 * vg + 1] * siluf(bfhi(g4.x));
          float y2 = x2[2] * acc[j][4 * vg + 2] * siluf(bflo(g4.y));
          float y3 = x2[3] * acc[j][4 * vg + 3] * siluf(bfhi(g4.y));
          uint2 pk;
          pk.x = pk2(y0, y1);
          pk.y = pk2(y2, y3);
          const int col = (t1 + CONV_PAD) * 2 + bl;
          *(uint2*)(Ub_w + ub_addr(col, vg) + 8 * h) = pk;
        }
    }
    __syncthreads();
    int tw = tid;
    asm volatile("" : "+v"(tw));
#pragma unroll 4
    for (int kk = 0; kk < 16; ++kk) {
      const int idx = tw + kk * NTHREADS;
      const int b = idx >> 11, t = idx & 2047;
      const int s1 = t >> 5, s2 = t & 31;
      const int col = (s1 + CONV_PAD) * 2 + (b & 1);
      const int a = ub_addr(col, s2 >> 3) + (s2 & 7) * 2;
      const char* base = Ub + (b >> 1) * CONV_UB_ONE + a;
      unsigned v0 = *(const u16*)(base + 0 * 2 * CONV_UB_ONE), v1 = *(const u16*)(base + 1 * 2 * CONV_UB_ONE);
      unsigned v2 = *(const u16*)(base + 2 * 2 * CONV_UB_ONE), v3 = *(const u16*)(base + 3 * 2 * CONV_UB_ONE);
      const uint2 cur = make_uint2(v0 | (v1 << 16), v2 | (v3 << 16));
      *(uint2*)(yg + ((size_t)(item >> 1) * 8192 + idx) * 8 + (item & 1) * 4) = cur;
    }
    __syncthreads();
  }
}

constexpr int AT_KROW = 272, AT_VROW = 136;
constexpr int AT_K_BYTES = 64 * AT_KROW, AT_V_BYTES = 128 * AT_VROW;
__device__ __forceinline__ void phase_attn(const Params& p, float* smf) {
  char* sm = (char*)smf;
  char* Ks = sm;
  char* Vs = sm + AT_K_BYTES;
  const int tid = threadIdx.x, wid = tid >> 6, lane = tid & 63, r = lane & 31, h = lane >> 5;
  const u16* px = (const u16*)(p.ws + OFF_BIG);
  const u16* kvc = (const u16*)(p.ws + OFF_KVC);
  const u16* vT = (const u16*)(p.ws + OFF_VT);
  const u16* vcT = (const u16*)(p.ws + OFF_VCT);
  u16* og = (u16*)(p.ws + OFF_ACT);
  const float LOG2E = 1.4426950408889634f;
  const float sl2 = 0.08838834764831845f * LOG2E;
  for (int item = blockIdx.x; item < 512; item += gridDim.x) {
    const int hp = item & 1, kvh = (item >> 1) & 3, nblk = (item >> 3) & 15, b = item >> 7;
    const int hq = kvh * 4 + hp * 2 + (wid >> 2);
    const int qs = nblk * 128 + (wid & 3) * 32 + r;
    bfx8 Q[8];
    {
      const u16* qrow = px + (size_t)(b * 2048 + qs) * 5120 + hq * 128 + 8 * h;
#pragma unroll
      for (int st = 0; st < 8; ++st) Q[st] = *(const bfx8*)(qrow + 16 * st);
    }
    f32x16 O[4];
#pragma unroll
    for (int dt = 0; dt < 4; ++dt)
#pragma unroll
      for (int i = 0; i < 16; ++i) O[dt][i] = 0.f;
    float m = p.attn_sink[hq] * LOG2E;
    float l = (h == 0) ? 1.f : 0.f;
    const int first = (nblk == 0) ? 2 : 0, lastlocal = (nblk == 15) ? 3 : 5;
    uint4 kA0, kA1, vA0, vA1, kB0, kB1, vB0, vB1;
#define AT_LOAD_TILE(TI, K0, K1, V0, V1) do { \
      const int _ti = (TI); const bool _loc = _ti < 6; \
      const int _kpos0 = 128 * (nblk - 1) + 64 * _ti, _c0 = 64 * (_ti - 6); \
      const u16* _kb = _loc ? px + (size_t)(b * 2048 + _kpos0) * 5120 + 2048 + kvh * 128 : kvc + (size_t)(b * 256 + _c0) * 1024 + kvh * 128; \
      const size_t _ks = _loc ? 5120 : 1024; \
      const u16* _vb = _loc ? vT + (size_t)(kvh * 128) * 8192 + b * 2048 + _kpos0 : vcT + (size_t)(kvh * 128) * 1024 + b * 256 + _c0; \
      const size_t _vs = _loc ? 8192 : 1024; \
      const int _c1 = tid + NTHREADS; \
      K0 = *(const uint4*)(_kb + (size_t)(tid >> 4) * _ks + (tid & 15) * 8); \
      K1 = *(const uint4*)(_kb + (size_t)(_c1 >> 4) * _ks + (_c1 & 15) * 8); \
      V0 = *(const uint4*)(_vb + (size_t)(tid >> 3) * _vs + (tid & 7) * 8); \
      V1 = *(const uint4*)(_vb + (size_t)(_c1 >> 3) * _vs + (_c1 & 7) * 8); \
    } while (0)
#define AT_STORE_TILE(K0, K1, V0, V1) do { \
      const int c1 = tid + NTHREADS; \
      *(uint4*)(Ks + (tid >> 4) * AT_KROW + (tid & 15) * 16) = K0; \
      *(uint4*)(Ks + (c1 >> 4) * AT_KROW + (c1 & 15) * 16) = K1; \
      char* v0p = Vs + (tid >> 3) * AT_VROW + (tid & 7) * 16; \
      char* v1p = Vs + (c1 >> 3) * AT_VROW + (c1 & 7) * 16; \
      *(uint2*)(v0p) = make_uint2(V0.x, V0.y); \
      *(uint2*)(v0p + 8) = make_uint2(V0.z, V0.w); \
      *(uint2*)(v1p) = make_uint2(V1.x, V1.y); \
      *(uint2*)(v1p + 8) = make_uint2(V1.z, V1.w); \
    } while (0)
    int ti = first;
    int t1 = ti + 1;
    if (t1 > lastlocal && t1 < 6) t1 = 6;
    AT_LOAD_TILE(ti, kA0, kA1, vA0, vA1);
    if (t1 < 10) AT_LOAD_TILE(t1, kB0, kB1, vB0, vB1);
    while (true) {
#pragma unroll
     for (int half = 0; half < 2; ++half) {
      __syncthreads();
      if (half == 0) AT_STORE_TILE(kA0, kA1, vA0, vA1); else AT_STORE_TILE(kB0, kB1, vB0, vB1);
      __syncthreads();
      int t2 = t1 + 1;
      if (t2 > lastlocal && t2 < 6) t2 = 6;
      if (t1 >= 10) t2 = 10;
      if (t2 < 10) { if (half == 0) AT_LOAD_TILE(t2, kA0, kA1, vA0, vA1); else AT_LOAD_TILE(t2, kB0, kB1, vB0, vB1); }
      const int q0w = nblk * 128 + (wid & 3) * 32;
      const int kp0 = 128 * (nblk - 1) + 64 * ti;
      if (!(ti < 6 && (kp0 > q0w + 31 + 128 || kp0 + 63 < q0w - 128))) {
        const bool local = ti < 6;
        const int kpos0 = 128 * (nblk - 1) + 64 * ti;
        f32x16 S[2];
#pragma unroll
        for (int ks = 0; ks < 2; ++ks) {
#pragma unroll
          for (int i = 0; i < 16; ++i) S[ks][i] = 0.f;
#pragma unroll
          for (int st = 0; st < 8; ++st) {
            bfx8 A = *(const bfx8*)(Ks + (ks * 32 + r) * AT_KROW + (16 * st + 8 * h) * 2);
            S[ks] = __builtin_amdgcn_mfma_f32_32x32x16_bf16(A, Q[st], S[ks], 0, 0, 0);
          }
        }
        const bool needmask = local && (kp0 > q0w + 65 || kp0 < q0w - 97);
        float mraw = -1e30f;
        if (needmask) {
          const int relb = kpos0 + 4 * h - qs;
#pragma unroll
          for (int ks = 0; ks < 2; ++ks)
#pragma unroll
            for (int i = 0; i < 16; ++i) {
              const int rel = relb + ks * 32 + (i & 3) + 8 * (i >> 2);
              float sv = S[ks][i];
              if (rel > 128 || rel < -128) sv = -1e30f;
              S[ks][i] = sv;
              mraw = fmaxf(mraw, sv);
            }
        } else {
#pragma unroll
          for (int ks = 0; ks < 2; ++ks)
#pragma unroll
            for (int i = 0; i < 16; ++i) mraw = fmaxf(mraw, S[ks][i]);
        }
        float mx = fmaxf(m, mraw * sl2);
        mx = fmaxf(mx, __shfl_xor(mx, 32, 64));
        if (__builtin_amdgcn_ballot_w64(mx != m) != 0ull) {
          const float alpha = __builtin_amdgcn_exp2f(m - mx);
          m = mx;
          l *= alpha;
#pragma unroll
          for (int dt = 0; dt < 4; ++dt)
#pragma unroll
            for (int i = 0; i < 16; ++i) O[dt][i] *= alpha;
        }
#pragma unroll
        for (int ks = 0; ks < 2; ++ks)
#pragma unroll
          for (int i = 0; i < 16; ++i) {
            float pv = __builtin_amdgcn_exp2f(__builtin_fmaf(S[ks][i], sl2, -m));
            l += pv;
            S[ks][i] = pv;
          }
#pragma unroll
        for (int s4 = 0; s4 < 4; ++s4) {
          const int ks = s4 >> 1, hf = s4 & 1;
          pg8::u32x4 pk;
#pragma unroll
          for (int j = 0; j < 4; ++j)
            pk[j] = pk2(S[ks][8 * hf + 2 * j], S[ks][8 * hf + 2 * j + 1]);
          bfx8 P = __builtin_bit_cast(bfx8, pk);
#pragma unroll
          for (int dt = 0; dt < 4; ++dt) {
            const char* vp = Vs + (dt * 32 + r) * AT_VROW + (32 * ks + 16 * hf + 4 * h) * 2;
            uint2 v0 = *(const uint2*)vp, v1 = *(const uint2*)(vp + 16);
            pg8::u32x4 vv; vv[0] = v0.x; vv[1] = v0.y; vv[2] = v1.x; vv[3] = v1.y;
            O[dt] = __builtin_amdgcn_mfma_f32_32x32x16_bf16(__builtin_bit_cast(bfx8, vv), P, O[dt], 0, 0, 0);
          }
        }
      }
      if (t1 >= 10) goto attn_done;
      ti = t1; t1 = t2;
     }
    }
    attn_done:;
    const float ltot = l + __shfl_xor(l, 32, 64);
    const float inv = 1.f / ltot;
    const size_t tok = (size_t)(b * 2048 + qs);
#pragma unroll
    for (int dt = 0; dt < 4; ++dt)
#pragma unroll
      for (int g4 = 0; g4 < 4; ++g4) {
        const int d = dt * 32 + 8 * g4 + 4 * h;
        uint2 gg = *(const uint2*)(px + tok * 5120 + 3072 + hq * 128 + d);
        float o0 = O[dt][4 * g4 + 0] * inv * siluf(bflo(gg.x));
        float o1 = O[dt][4 * g4 + 1] * inv * siluf(bfhi(gg.x));
        float o2 = O[dt][4 * g4 + 2] * inv * siluf(bflo(gg.y));
        float o3 = O[dt][4 * g4 + 3] * inv * siluf(bfhi(gg.y));
        uint2 pk;
        pk.x = pk2(o0, o1);
        pk.y = pk2(o2, o3);
        *(uint2*)(og + tok * 2048 + hq * 128 + d) = pk;
      }
  }
}

#define XB_TMO      128
#define XB_XCNT(j)  (256  + 64 * (j))
#define XB_XSUB(j)  (1280 + 64 * (j))
#define XB_XGEN(j)  (2304 + 64 * (j))
#define XB_TOP      3328
#define XB_TOPGEN   3392
#define XCD_BAR_WORDS 3456
#define XB_SPIN_CAP (1u << 18)
#define LAS __attribute__((address_space(3)))

__device__ __forceinline__ unsigned xb_ld(unsigned* p)              { return __hip_atomic_load(p, __ATOMIC_RELAXED, __HIP_MEMORY_SCOPE_AGENT); }
__device__ __forceinline__ unsigned xb_add(unsigned* p, unsigned v) { return __hip_atomic_fetch_add(p, v, __ATOMIC_RELAXED, __HIP_MEMORY_SCOPE_AGENT); }
__device__ __forceinline__ unsigned xb_xcc_id() { return (unsigned)__builtin_amdgcn_s_getreg((3 << 11) | 20) & 0xFu; }
#define XB_SPIN(cond, bar) do { unsigned _sp = 0; while (cond) { __builtin_amdgcn_s_sleep(1); \
    if ((++_sp & 255u) == 0u) { if (xb_ld(&(bar)[XB_TMO])) break; if (_sp > XB_SPIN_CAP) { atomicAdd(&(bar)[XB_TMO], 1u); break; } } } } while (0)

struct XcdBarrier {
    unsigned* bar; unsigned x;
    volatile LAS unsigned* st;
};

__device__ __forceinline__ XcdBarrier xcd_barrier_post(unsigned* bar, volatile LAS unsigned* st) {
    XcdBarrier b; b.bar = bar; b.x = xb_xcc_id(); b.st = st;
    if (threadIdx.x == 0) (void)xb_add(&bar[XB_XCNT(b.x)], 1u);
    return b;
}
__device__ __forceinline__ void xcd_barrier_complete(unsigned* bar, unsigned x, unsigned& nloc, unsigned& nx) {
    const unsigned G = gridDim.x * gridDim.y * gridDim.z;
    unsigned sum, cnt, mine, sp = 0u;
    for (;;) {
        sum = 0u; cnt = 0u; mine = 0u;
#pragma unroll
        for (unsigned j = 0; j < 16; ++j) { const unsigned c = xb_ld(&bar[XB_XCNT(j)]); sum += c; cnt += (c > 0u) ? 1u : 0u; mine = (j == x) ? c : mine; }
        if (sum == G) break;
        __builtin_amdgcn_s_sleep(1);
        if ((++sp & 255u) == 0u) { if (xb_ld(&bar[XB_TMO])) break; if (sp > XB_SPIN_CAP) { atomicAdd(&bar[XB_TMO], 1u); break; } }
    }
    nloc = mine > 0u ? mine : 1u; nx = cnt > 0u ? cnt : 1u;
}

__device__ __forceinline__ void xcd_barrier(const XcdBarrier& b) {
    asm volatile("s_waitcnt vmcnt(0)" ::: "memory");
    __syncthreads();
    if (threadIdx.x == 0) {
        unsigned* bar = b.bar;
        __builtin_amdgcn_s_waitcnt(0);
        unsigned nloc = b.st[0], nx = b.st[1];
        if (nloc == 0u) { xcd_barrier_complete(bar, b.x, nloc, nx); b.st[0] = nloc; b.st[1] = nx; }
        const unsigned old = xb_add(&bar[XB_XSUB(b.x)], 1u);
        const unsigned gen = old / nloc;
        if (old + 1u == (gen + 1u) * nloc) {
            __builtin_amdgcn_fence(__ATOMIC_RELEASE, "agent");
            asm volatile("s_waitcnt vmcnt(0)" ::: "memory");
            const unsigned og = xb_add(&bar[XB_TOP], 1u);
            const unsigned tg = og / nx;
            if (og + 1u == (tg + 1u) * nx) xb_add(&bar[XB_TOPGEN], 1u);
            else XB_SPIN(xb_ld(&bar[XB_TOPGEN]) == tg, bar);
            __builtin_amdgcn_fence(__ATOMIC_ACQUIRE, "agent");
            xb_add(&bar[XB_XGEN(b.x)], 1u);
            asm volatile("s_waitcnt vmcnt(0)" ::: "memory");
        } else {
            XB_SPIN(xb_ld(&bar[XB_XGEN(b.x)]) == gen, bar);
            __builtin_amdgcn_fence(__ATOMIC_ACQUIRE, "agent");
            asm volatile("s_waitcnt vmcnt(0)" ::: "memory");
        }
    }
    __syncthreads();
}


constexpr int N_PHASES = 9;
__global__ void __launch_bounds__(NTHREADS, 2) mega(Params p, int ph0, int ph1) {
  extern __shared__ __attribute__((aligned(16))) float sm[];
  volatile LAS unsigned* xb_st = (volatile LAS unsigned*)((LAS unsigned char*)sm + 162816);
  if (threadIdx.x < 4) xb_st[threadIdx.x] = 0u;
  __syncthreads();
  const XcdBarrier xb = xcd_barrier_post((unsigned*)(p.ws + OFF_BAR), xb_st);
#define PH(i, body) if (ph0 <= (i) && (i) < ph1) { body; if ((i) + 1 < ph1) xcd_barrier(xb); }
  if (ph0 < 0) cg::this_grid().sync();
  PH(0, phase0(p, sm))
  PH(1, phase_norm(p, 0))
  PH(2, run_gemm(sm, (const u16*)(p.ws + OFF_ACT), (const u16*)(p.ws + OFF_WT_AI), MT, ATTN_IN,
                 EpiAttnIn{(u16*)(p.ws + OFF_BIG), (const float*)(p.ws + OFF_ROPE)}, (int)blockIdx.x);
        run_gemm(sm, (const u16*)(p.ws + OFF_HC), (const u16*)(p.ws + OFF_WT_AI) + (size_t)2048 * 2048, MC, 1024,
                 EpiRaw{(u16*)(p.ws + OFF_KVC), 1024}, (int)((blockIdx.x + 64) % gridDim.x));
        run_gemm(sm, (const u16*)(p.ws + OFF_WT_AI) + (size_t)2560 * 2048, (const u16*)(p.ws + OFF_ACT), 512, MT,
                 EpiRaw{(u16*)(p.ws + OFF_VT), 8192}, (int)((blockIdx.x + 128) % gridDim.x));
        run_gemm(sm, (const u16*)(p.ws + OFF_WT_AI) + (size_t)2560 * 2048, (const u16*)(p.ws + OFF_HC), 512, MC,
                 EpiRaw{(u16*)(p.ws + OFF_VCT), 1024}, (int)((blockIdx.x + 48) % gridDim.x)))
  PH(3, phase_attn(p, sm))
  PH(4, run_gemm(sm, (const u16*)(p.ws + OFF_ACT), (const u16*)(p.ws + OFF_WT_AO), MT, 2048,
                 EpiResNorm{p.out, p.x, (const float*)(p.ws + OFF_MOD) + 4096, (float*)(p.ws + OFF_ROWSS), (unsigned*)(p.ws + OFF_PCNT),
                            p.norm_g + 2048, (const float*)(p.ws + OFF_MOD) + 5 * 6144, (u16*)(p.ws + OFF_ACT)}, (int)blockIdx.x))
  PH(6, run_gemm(sm, (const u16*)(p.ws + OFF_WT_HI), (const u16*)(p.ws + OFF_ACT), HY_IN, MT,
                 EpiRaw{(u16*)(p.ws + OFF_BIG), 8192}, (int)blockIdx.x))
  PH(7, phase_conv(p, sm))
  PH(8, (run_gemm<EpiResNorm, true>(sm, (const u16*)(p.ws + OFF_ACT), (const u16*)(p.ws + OFF_WT_HO), MT, 2048,
                 EpiResNorm{p.out, p.out, (const float*)(p.ws + OFF_MOD) + 5 * 6144 + 4096, (float*)(p.ws + OFF_ROWSS) + 8192,
                            (unsigned*)(p.ws + OFF_PCNT) + 32 * 64, p.final_g, nullptr, nullptr}, (int)blockIdx.x)))
}

extern "C" void kernel_launch(void* const* d_in, const int* in_sizes, int n_in, void* d_out, int out_size,
                              void* d_ws, size_t ws_size, hipStream_t stream) {
  Params p{};
  const float** f = (const float**)&p;
  for (int i = 0; i < 23; ++i) f[i] = (const float*)d_in[i];
  p.out = (float*)d_out;
  p.ws = (char*)d_ws;
  constexpr size_t kLds = 162816 + 16;
  static int grid_blocks = 0;
  if (!grid_blocks) {
    (void)hipFuncSetAttribute((const void*)mega, hipFuncAttributeMaxDynamicSharedMemorySize, (int)kLds);
    int dev = 0, cus = 0, per_cu = 0;
    (void)hipGetDevice(&dev);
    (void)hipDeviceGetAttribute(&cus, hipDeviceAttributeMultiprocessorCount, dev);
    (void)hipOccupancyMaxActiveBlocksPerMultiprocessor(&per_cu, mega, NTHREADS, kLds);
    if (per_cu < 1) per_cu = 1;
    grid_blocks = cus * per_cu;
  }
  (void)hipMemsetAsync((char*)d_ws + OFF_BAR, 0, ZERO_BYTES, stream);
  int ph0 = 0, ph1 = N_PHASES;
  void* args[] = {(void*)&p, (void*)&ph0, (void*)&ph1};
  hipError_t e = hipLaunchCooperativeKernel((const void*)mega, dim3(grid_blocks), dim3(NTHREADS), args, kLds, stream);
  if (e != hipSuccess) fprintf(stderr, "cooperative launch failed: %s (grid %d)\n", hipGetErrorString(e), grid_blocks);
}
```

```cpp
#include <hip/hip_runtime.h>
#include <hip/hip_bf16.h>
#include <hip/hip_cooperative_groups.h>
#include <cstdio>
namespace cg = cooperative_groups;
typedef unsigned short u16;

#define NTHREADS 512
constexpr int Bn = 4, Sn = 2048, Dn = 2048, Cn = 256;
constexpr int MT = Bn * Sn;
constexpr int MC = Bn * Cn;
constexpr int ATTN_IN = 5120;
constexpr int HY_IN = 8192;

constexpr size_t OFF_WT_AI = 0;
constexpr size_t OFF_WT_AO = OFF_WT_AI + (size_t)5120 * 2048 * 2;
constexpr size_t OFF_WT_HI = OFF_WT_AO + (size_t)2048 * 2048 * 2;
constexpr size_t OFF_WT_HO = OFF_WT_HI + (size_t)8192 * 2048 * 2;
constexpr size_t OFF_MOD   = OFF_WT_HO + (size_t)2048 * 2048 * 2;
constexpr size_t OFF_ROPE  = OFF_MOD + (size_t)2 * 5 * 6144 * 4 + 256;
constexpr size_t OFF_FILT  = OFF_ROPE + (size_t)64 * 32 * 8;
constexpr size_t OFF_ACT   = OFF_FILT + (size_t)2 * 2048 * 4096 * 2;
constexpr size_t OFF_HC    = OFF_ACT + (size_t)8192 * 2048 * 2;
constexpr size_t OFF_KVC   = OFF_HC + (size_t)1024 * 2048 * 2;
constexpr size_t OFF_VT    = OFF_KVC + (size_t)1024 * 1024 * 2;
constexpr size_t OFF_VCT   = OFF_VT + (size_t)512 * 8192 * 2;
constexpr size_t OFF_BIG   = OFF_VCT + (size_t)512 * 1024 * 2;

constexpr size_t OFF_BAR   = OFF_BIG + (size_t)8192 * 8192 * 2;

constexpr size_t OFF_ROWSS = OFF_BAR + 16384;
constexpr size_t OFF_PCNT  = OFF_ROWSS + (size_t)2 * 8192 * 4;
constexpr size_t ZERO_BYTES = 16384 + (size_t)2 * 8192 * 4 + (size_t)2 * 32 * 64 * 4;

struct Params {
  const float *x, *c, *ctx, *c_ctx, *norm_g, *ada_w, *ada_b, *attn_w_in, *attn_w_out, *attn_sink;
  const float *hy_w_in, *hy_conv_w, *hy_conv_b, *hy_w1, *hy_b1, *hy_w2, *hy_b2, *hy_w3, *hy_b3;
  const float *hy_freq, *hy_bias_d, *hy_w_out, *final_g;
  float* out;
  char* ws;
};

__device__ __forceinline__ u16 f2bf(float f) {
  unsigned u = __float_as_uint(f);
  u += 0x7fffu + ((u >> 16) & 1u);
  return (u16)(u >> 16);
}
__device__ __forceinline__ float bf2f(u16 h) { return __uint_as_float(((unsigned)h) << 16); }
__device__ __forceinline__ unsigned pk2(float lo, float hi) { unsigned r; asm("v_cvt_pk_bf16_f32 %0, %1, %2" : "=v"(r) : "v"(lo), "v"(hi)); return r; }
__device__ __forceinline__ float bflo(unsigned w) { return __uint_as_float(w << 16); }
__device__ __forceinline__ float bfhi(unsigned w) { return __uint_as_float(w & 0xffff0000u); }
__device__ __forceinline__ float siluf(float v) { return v / (1.f + __expf(-v)); }
__device__ __forceinline__ float wave_sum(float v) {
#pragma unroll
  for (int o = 32; o > 0; o >>= 1) v += __shfl_xor(v, o, 64);
  return v;
}
__device__ __forceinline__ float wave_max(float v) {
#pragma unroll
  for (int o = 32; o > 0; o >>= 1) v = fmaxf(v, __shfl_xor(v, o, 64));
  return v;
}

__device__ __forceinline__ void p0_convert(const float* __restrict__ W, u16* __restrict__ Wt, int N, int tk, int tn,
                           bool perm, float* sm) {
  const int tid = threadIdx.x;
  for (int i = tid; i < 64 * 32; i += NTHREADS) {
    int r = i >> 5, c4 = i & 31;
    float4 v = *(const float4*)(W + (size_t)(tk * 64 + r) * N + tn * 128 + c4 * 4);
    float* d = sm + r * 129 + c4 * 4;
    d[0] = v.x; d[1] = v.y; d[2] = v.z; d[3] = v.w;
  }
  __syncthreads();
  for (int i = tid; i < 128 * 8; i += NTHREADS) {
    int nrow = i >> 3, kc = i & 7;
    int src = nrow;
    if (perm && (tn * 128 < 2560)) {
      int g = nrow >> 5, nn = (nrow >> 4) & 1, fr = nrow & 15;
      src = (g >> 1) * 64 + nn * 32 + (g & 1) * 16 + fr;
    }
    unsigned w[4];
#pragma unroll
    for (int j = 0; j < 4; ++j) {
      float a = sm[(kc * 8 + 2 * j) * 129 + src];
      float b = sm[(kc * 8 + 2 * j + 1) * 129 + src];
      w[j] = pk2(a, b);
    }
    *(uint4*)(Wt + (size_t)(tn * 128 + nrow) * 2048 + tk * 64 + kc * 8) = make_uint4(w[0], w[1], w[2], w[3]);
  }
  __syncthreads();
}

__device__ __forceinline__ void p0_adaln(const Params& p, int item, float* sm) {
  const int tid = threadIdx.x;
  float* sv = sm;
  float* red = sm + 5 * 2048;
  int col0 = item * 48;
  int l = col0 / 6144, n0 = col0 % 6144;
  for (int i = tid; i < 5 * 2048; i += NTHREADS) {
    int v = i >> 11, k = i & 2047;
    float cv = v < 4 ? p.c[v * 2048 + k] : p.c_ctx[k];
    sv[i] = cv / (1.f + expf(-cv));
  }
  __syncthreads();
  int kg = tid / 12, cq = tid % 12;
  float acc[5][4];
#pragma unroll
  for (int v = 0; v < 5; ++v)
#pragma unroll
    for (int j = 0; j < 4; ++j) acc[v][j] = 0.f;
  if (kg < 42) {
    const float* W = p.ada_w + (size_t)l * 2048 * 6144 + n0 + cq * 4;
#pragma unroll 8
    for (int k = kg; k < 2048; k += 42) {
      float4 w = *(const float4*)(W + (size_t)k * 6144);
#pragma unroll
      for (int v = 0; v < 5; ++v) {
        float s = sv[v * 2048 + k];
        acc[v][0] += s * w.x; acc[v][1] += s * w.y; acc[v][2] += s * w.z; acc[v][3] += s * w.w;
      }
    }
  }
  if (kg >= 21 && kg < 42) {
#pragma unroll
    for (int v = 0; v < 5; ++v)
#pragma unroll
      for (int j = 0; j < 4; ++j) red[((kg - 21) * 5 + v) * 48 + cq * 4 + j] = acc[v][j];
  }
  __syncthreads();
  if (kg < 21) {
#pragma unroll
    for (int v = 0; v < 5; ++v)
#pragma unroll
      for (int j = 0; j < 4; ++j) red[(kg * 5 + v) * 48 + cq * 4 + j] += acc[v][j];
  }
  __syncthreads();
  if (tid < 240) {
    int v = tid / 48, cc = tid % 48;
    float s = 0.f;
    for (int g = 0; g < 21; ++g) s += red[(g * 5 + v) * 48 + cc];
    float* mod = (float*)(p.ws + OFF_MOD);
    mod[(l * 5 + v) * 6144 + n0 + cc] = s + p.ada_b[l * 6144 + n0 + cc];
  }
  __syncthreads();
}

__device__ __forceinline__ void p0_rope(const Params& p) {
  float2* rope = (float2*)(p.ws + OFF_ROPE);
  for (int i = threadIdx.x; i < 64 * 32; i += NTHREADS) {
    int pos = i >> 5, j = i & 31;
    float inv = powf(10000.f, -(float)(2 * j) / 64.f);
    float ang = (float)pos * inv;
    rope[i] = make_float2(cosf(ang), sinf(ang));
  }
}

typedef short bf16x8_t __attribute__((ext_vector_type(8)));
typedef unsigned u32x4_t __attribute__((ext_vector_type(4)));
typedef float f32x16_t __attribute__((ext_vector_type(16)));
__device__ __forceinline__ void split8(const float (&v)[8], bf16x8_t& hi, bf16x8_t& lo) {
  u32x4_t H, L;
#pragma unroll
  for (int j = 0; j < 4; ++j) {
    const u16 h0 = f2bf(v[2 * j]), h1 = f2bf(v[2 * j + 1]);
    const float r0 = v[2 * j] - bf2f(h0), r1 = v[2 * j + 1] - bf2f(h1);
    H[j] = (unsigned)h0 | ((unsigned)h1 << 16);
    L[j] = pk2(r0, r1);
  }
  hi = __builtin_bit_cast(bf16x8_t, H);
  lo = __builtin_bit_cast(bf16x8_t, L);
}
__device__ __forceinline__ void p0_filter(const Params& p, int item, float* sm) {
  int tid = threadIdx.x;
  asm volatile("" : "+v"(tid));
  const int lane = tid & 63, wid = tid >> 6, r = lane & 31, h = lane >> 5;
  const int cc = item & 15, pg = item >> 4;
  float* z = sm;
  float* h1 = z + 128 * 36;
  float* h2 = h1 + 128 * 64;
  for (int i = tid; i < 128 * 33; i += NTHREADS) {
    int pos = i / 33, e = i % 33;
    int t = pg * 128 + pos;
    float val;
    if (e == 0) val = (float)t / 2047.f;
    else {
      int bi = (e - 1) & 15;
      float w = 6.283185307179586f * (float)t / 2048.f;
      float fr = 1e-4f + (float)bi * ((15.f - 1e-4f) / 15.f);
      float ang = w * fr;
      val = (e <= 16) ? cosf(ang) : -sinf(ang);
    }
    z[pos * 36 + e] = val;
  }
  __syncthreads();
  {
    const int j = lane;
    float w1r[33];
#pragma unroll
    for (int e = 0; e < 33; ++e) w1r[e] = p.hy_w1[e * 64 + j];
    const float fq = p.hy_freq[j], b1 = p.hy_b1[j];
#pragma unroll 1
    for (int q = 0; q < 16; ++q) {
      const int pos = wid * 16 + q;
      const float4* zp = (const float4*)(z + pos * 36);
      float a = b1;
#pragma unroll
      for (int e4 = 0; e4 < 8; ++e4) {
        float4 zv = zp[e4];
        a += zv.x * w1r[4 * e4] + zv.y * w1r[4 * e4 + 1] + zv.z * w1r[4 * e4 + 2] + zv.w * w1r[4 * e4 + 3];
      }
      a += z[pos * 36 + 32] * w1r[32];
      h1[pos * 64 + j] = __sinf(fq * a);
    }
  }
  __syncthreads();
  {
    const int j = lane;
    float w2r[64];
#pragma unroll
    for (int e = 0; e < 64; ++e) w2r[e] = p.hy_w2[e * 64 + j];
    const float fq = p.hy_freq[j], b2 = p.hy_b2[j];
#pragma unroll 1
    for (int q = 0; q < 16; ++q) {
      const int pos = wid * 16 + q;
      const float4* hp = (const float4*)(h1 + pos * 64);
      float a = b2;
#pragma unroll
      for (int e4 = 0; e4 < 16; ++e4) {
        float4 hv = hp[e4];
        a += hv.x * w2r[4 * e4] + hv.y * w2r[4 * e4 + 1] + hv.z * w2r[4 * e4 + 2] + hv.w * w2r[4 * e4 + 3];
      }
      h2[pos * 68 + j] = __sinf(fq * a);
    }
  }
  __syncthreads();
  const int colw = cc * 512 + wid * 64;
  bf16x8_t Ahi[2][4], Alo[2][4];
#pragma unroll
  for (int ct = 0; ct < 2; ++ct)
#pragma unroll
    for (int ks = 0; ks < 4; ++ks) {
      float v[8];
#pragma unroll
      for (int j = 0; j < 8; ++j) v[j] = p.hy_w3[(size_t)(16 * ks + 8 * h + j) * 8192 + colw + ct * 32 + r];
      split8(v, Ahi[ct][ks], Alo[ct][ks]);
    }
  const int o = cc >> 3, dir = (cc >> 2) & 1;
  u16* Rg = (u16*)(p.ws + OFF_FILT) + (size_t)o * 2048 * 4096;
  const float min_decay = -3.0701134573253945f, max_decay = -15.350567286626972f;
#pragma unroll 1
  for (int pp = 0; pp < 2; ++pp) {
    f32x16_t acc[2][2];
#pragma unroll
    for (int ct = 0; ct < 2; ++ct)
#pragma unroll
      for (int q = 0; q < 2; ++q)
#pragma unroll
        for (int i = 0; i < 16; ++i) acc[ct][q][i] = 0.f;
#pragma unroll
    for (int q = 0; q < 2; ++q)
#pragma unroll
      for (int ks = 0; ks < 4; ++ks) {
        const float* hp = h2 + ((pp * 2 + q) * 32 + r) * 68 + 16 * ks + 8 * h;
        float4 x0 = *(const float4*)hp, x1 = *(const float4*)(hp + 4);
        float v[8] = {x0.x, x0.y, x0.z, x0.w, x1.x, x1.y, x1.z, x1.w};
        bf16x8_t Bhi, Blo;
        split8(v, Bhi, Blo);
#pragma unroll
        for (int ct = 0; ct < 2; ++ct) {
          acc[ct][q] = __builtin_amdgcn_mfma_f32_32x32x16_bf16(Ahi[ct][ks], Bhi, acc[ct][q], 0, 0, 0);
          acc[ct][q] = __builtin_amdgcn_mfma_f32_32x32x16_bf16(Ahi[ct][ks], Blo, acc[ct][q], 0, 0, 0);
          acc[ct][q] = __builtin_amdgcn_mfma_f32_32x32x16_bf16(Alo[ct][ks], Bhi, acc[ct][q], 0, 0, 0);
        }
      }
    int hh = h;
    asm volatile("" : "+v"(hh));
#pragma unroll
    for (int ct = 0; ct < 2; ++ct)
#pragma unroll
      for (int i = 0; i < 16; ++i) {
        const int col = colw + ct * 32 + (i & 3) + 8 * (i >> 2) + 4 * hh;
        const int ch = col & 2047;
        const float b3 = p.hy_b3[col];
        const float ad = fabsf(min_decay + (float)ch * ((max_decay - min_decay) / 2047.f));
        u16* R = Rg + (size_t)ch * 4096;
#pragma unroll
        for (int q = 0; q < 2; ++q) {
          const int t = pg * 128 + (pp * 2 + q) * 32 + r;
          const float tn = (float)t / 2047.f;
          float v = (acc[ct][q][i] + b3) * (__expf(-tn * ad) + 0.05f);
          if (dir == 0) {
            if (t == 0) v += p.hy_bias_d[o * 2048 + ch];
            R[2048 - t] = f2bf(v);
          } else {
            if (t > 0) R[2048 + t] = f2bf(v);
            else R[0] = 0;
          }
        }
      }
  }
  __syncthreads();
}

constexpr int N_CV_AI = 16 * 40, N_CV_AO = 16 * 16, N_CV_HI = 16 * 64, N_CV_HO = 16 * 16;
constexpr int N_CV = N_CV_AI + N_CV_AO + N_CV_HI + N_CV_HO;
#define CV_DECODE(I, W_, Wt_, N_, tk_, tn_, perm_) do { int _i = (I); \
    const bool _a = _i < N_CV_AI, _b2 = _i < N_CV_AI + N_CV_AO, _c = _i < N_CV_AI + N_CV_AO + N_CV_HI; \
    W_ = _a ? p.attn_w_in : (_b2 ? p.attn_w_out : (_c ? p.hy_w_in : p.hy_w_out)); \
    Wt_ = (u16*)(p.ws + (_a ? OFF_WT_AI : (_b2 ? OFF_WT_AO : (_c ? OFF_WT_HI : OFF_WT_HO)))); \
    N_ = _a ? 5120 : (_b2 ? 2048 : (_c ? 8192 : 2048)); \
    const int _nt = _a ? 40 : (_b2 ? 16 : (_c ? 64 : 16)); \
    _i -= _a ? 0 : (_b2 ? N_CV_AI : (_c ? N_CV_AI + N_CV_AO : N_CV_AI + N_CV_AO + N_CV_HI)); \
    tk_ = _i / _nt; tn_ = _i - tk_ * _nt; perm_ = _a && (tn_ * 128 < 2560); } while (0)
__device__ __forceinline__ void p0_convert_all(const Params& p, float* sm) {
  const int tid = threadIdx.x;
  float4 r0, r1, r2, r3, r4, r5, r6, r7;
#define CV_LOAD(W_, N_, tk_, tn_) do { const float* _b = (W_) + (size_t)((tk_) * 128 + (tid >> 5)) * (N_) + (tn_) * 128 + (tid & 31) * 4; const size_t _s = (size_t)16 * (N_); \
    r0 = *(const float4*)(_b); r1 = *(const float4*)(_b + _s); r2 = *(const float4*)(_b + 2 * _s); r3 = *(const float4*)(_b + 3 * _s); \
    r4 = *(const float4*)(_b + 4 * _s); r5 = *(const float4*)(_b + 5 * _s); r6 = *(const float4*)(_b + 6 * _s); r7 = *(const float4*)(_b + 7 * _s); } while (0)
#define CV_PUT(R, I) do { float* _d = sm + ((tid >> 5) + 16 * (I)) * 129 + (tid & 31) * 4; _d[0] = (R).x; _d[1] = (R).y; _d[2] = (R).z; _d[3] = (R).w; } while (0)
  int it = blockIdx.x;
  const float* cW; u16* cWt; int cN, ctk, ctn; bool cperm;
  CV_DECODE(it < N_CV ? it : 0, cW, cWt, cN, ctk, ctn, cperm);
  if (it < N_CV) CV_LOAD(cW, cN, ctk, ctn);
  while (it < N_CV) {
    __syncthreads();
    CV_PUT(r0, 0); CV_PUT(r1, 1); CV_PUT(r2, 2); CV_PUT(r3, 3); CV_PUT(r4, 4); CV_PUT(r5, 5); CV_PUT(r6, 6); CV_PUT(r7, 7);
    __syncthreads();
    const int nit = it + gridDim.x;
    const float* nW; u16* nWt; int nN, ntk, ntn; bool nperm;
    CV_DECODE(nit < N_CV ? nit : 0, nW, nWt, nN, ntk, ntn, nperm);
    if (nit < N_CV) CV_LOAD(nW, nN, ntk, ntn);
    const int row = (tid & 15) | (((tid >> 6) & 7) << 4);
    int src = row;
    if (cperm) { const int g = row >> 5, w = row & 31, i16 = 4 * (w >> 3) + (w & 3), nn = (w >> 2) & 1; src = (g >> 1) * 64 + nn * 32 + (g & 1) * 16 + i16; }
#pragma unroll
    for (int i = 0; i < 4; ++i) {
      const int kch = ((tid >> 4) & 3) | (i << 2);
      unsigned w[4];
#pragma unroll
      for (int j = 0; j < 4; ++j) {
        float a = sm[(kch * 8 + 2 * j) * 129 + src];
        float b = sm[(kch * 8 + 2 * j + 1) * 129 + src];
        w[j] = pk2(a, b);
      }
      *(uint4*)(cWt + (size_t)(ctn * 128 + row) * 2048 + ctk * 128 + kch * 8) = make_uint4(w[0], w[1], w[2], w[3]);
    }
    cW = nW; cWt = nWt; cN = nN; ctk = ntk; ctn = ntn; cperm = nperm;
    it = nit;
  }
#undef CV_LOAD
#undef CV_PUT
}

__device__ __forceinline__ void phase0(const Params& p, float* sm) {
  for (int it = blockIdx.x; it < 256; it += gridDim.x) p0_adaln(p, it, sm);
  if (blockIdx.x == gridDim.x - 1) p0_rope(p);
  __syncthreads();
  for (int it = blockIdx.x; it < 256; it += gridDim.x) p0_filter(p, it, sm);
  __syncthreads();
  p0_convert_all(p, sm);
}

__device__ __forceinline__ void norm_row(const float* __restrict__ src, const float* __restrict__ g, const float* shift,
                         const float* scale, u16* dst_bf, float* dst_f, int lane) {
  float4 v[8];
  float ss = 0.f;
#pragma unroll
  for (int j = 0; j < 8; ++j) {
    v[j] = *(const float4*)(src + (j * 64 + lane) * 4);
    ss += v[j].x * v[j].x + v[j].y * v[j].y + v[j].z * v[j].z + v[j].w * v[j].w;
  }
  ss = wave_sum(ss);
  float r = rsqrtf(ss * (1.f / 2048.f) + 1e-6f);
#pragma unroll
  for (int j = 0; j < 8; ++j) {
    int c = (j * 64 + lane) * 4;
    float4 gg = *(const float4*)(g + c);
    float4 o = make_float4(v[j].x * r * gg.x, v[j].y * r * gg.y, v[j].z * r * gg.z, v[j].w * r * gg.w);
    if (dst_bf) {
      float4 sh = *(const float4*)(shift + c);
      float4 sc = *(const float4*)(scale + c);
      o.x = o.x * (1.f + sc.x) + sh.x; o.y = o.y * (1.f + sc.y) + sh.y;
      o.z = o.z * (1.f + sc.z) + sh.z; o.w = o.w * (1.f + sc.w) + sh.w;
      uint2 pk;
      pk.x = pk2(o.x, o.y);
      pk.y = pk2(o.z, o.w);
      *(uint2*)(dst_bf + c) = pk;
    } else {
      *(float4*)(dst_f + c) = o;
    }
  }
}

__device__ __forceinline__ void phase_norm(const Params& p, int mode) {
  const int wid = threadIdx.x >> 6, lane = threadIdx.x & 63;
  const float* mod = (const float*)(p.ws + OFF_MOD);
  int nrows = (mode == 0) ? (MT + MC) : MT;
  for (int row = blockIdx.x * 8 + wid; row < nrows; row += gridDim.x * 8) {
    if (mode == 0) {
      if (row < MT) {
        int b = row >> 11;
        const float* m = mod + (0 * 5 + b) * 6144;
        norm_row(p.x + (size_t)row * 2048, p.norm_g, m, m + 2048, (u16*)(p.ws + OFF_ACT) + (size_t)row * 2048, nullptr, lane);
      } else {
        int rc = row - MT;
        const float* m = mod + (0 * 5 + 4) * 6144;
        norm_row(p.ctx + (size_t)rc * 2048, p.norm_g, m, m + 2048, (u16*)(p.ws + OFF_HC) + (size_t)rc * 2048, nullptr, lane);
      }
    } else if (mode == 1) {
      int b = row >> 11;
      const float* m = mod + (1 * 5 + b) * 6144;
      norm_row(p.out + (size_t)row * 2048, p.norm_g + 2048, m, m + 2048, (u16*)(p.ws + OFF_ACT) + (size_t)row * 2048, nullptr, lane);
    } else {
      norm_row(p.out + (size_t)row * 2048, p.final_g, nullptr, nullptr, nullptr, p.out + (size_t)row * 2048, lane);
    }
  }
}

namespace pg8 {
#define PG8_LAS __attribute__((address_space(3)))
typedef unsigned short bf16_t;
typedef short bf16x8 __attribute__((ext_vector_type(8)));
typedef float f32x4 __attribute__((ext_vector_type(4)));
typedef unsigned u32x4 __attribute__((ext_vector_type(4)));
constexpr int BM = 256, BK = 64, HALF = 128, HTB = HALF * BK * 2  , STAGE_BYTES = 8 * HTB, NXCD = 8, WGM = 8;

__host__ __device__ __forceinline__ int lds_byte(int r, int c) { const int st = (r >> 4) * 2 + (c >> 5), rr = r & 15, cc = c & 31, ob = rr * 64 + cc * 2; return st * 1024 + (ob ^ (((ob >> 9) & 1) << 5)); }
__host__ __device__ __forceinline__ void stage_rc(int b, int& R, int& C) { const int st = b / 1024, sb = b % 1024, swz = sb ^ (((sb >> 9) & 1) << 5); R = (st >> 1) * 16 + swz / 64; C = (st & 1) * 32 + (swz % 64) / 2; }
__host__ __device__ __forceinline__ int perm32(int rho) { const int n = rho >> 4, i = rho & 15; return 8 * (i >> 2) + 4 * n + (i & 3); }

struct Unit { int pm, pn; };
struct Gemm { const bf16_t* A; const bf16_t* Bt; int M, N, K; int agroup; };

struct StaticOrder {
    int nM, nN, nwg, G, c;
    __host__ __device__ void init(int M, int N, int G_, int c_) { nM = M / BM; nN = N / BM; nwg = nM * nN; G = G_; c = c_; }
    __host__ __device__ bool next(int i, Unit& u) const {
        const long L = (long)i * G + c; if (L >= nwg) return false;
        int wgid = (int)L; { const int q = nwg / NXCD, r = nwg % NXCD, xcd = wgid % NXCD, off = wgid / NXCD; wgid = (xcd < r ? xcd * (q + 1) : r * (q + 1) + (xcd - r) * q) + off; }
        const int nig = WGM * nN, gid = wgid / nig, fm = gid * WGM, gsz = (nM - fm) < WGM ? (nM - fm) : WGM;
        u.pm = fm + ((wgid % nig) % gsz); u.pn = (wgid % nig) / gsz; return true;
    }
    __device__ __forceinline__ void a_ready(const Unit&) const {}
    __device__ __forceinline__ void done(const Unit&) const {}
};
__device__ __forceinline__ unsigned cvt_pk_bf16(float lo, float hi) { unsigned r; asm volatile("v_cvt_pk_bf16_f32 %0, %1, %2" : "=v"(r) : "v"(lo), "v"(hi)); return r; }
template <class Epi, class Sched, bool AGROUP = false>
__device__ __forceinline__ void gemm_phase(PG8_LAS unsigned char* lds, const Gemm g, const Sched& S, const Epi& E) {
    const int tid = threadIdx.x, wid = __builtin_amdgcn_readfirstlane(tid >> 6), lane = tid & 63, wr = wid >> 2, wc = wid & 3, fr = lane & 15, fq = lane >> 4;
    const int K = g.K, nt = K / BK;
    unsigned voffA[2], voffB[2];
#pragma unroll
    for (int i = 0; i < 2; ++i) { int R, C; stage_rc(tid * 16 + i * 8192, R, C); const int Rb = Epi::PERM ? ((R & ~31) + perm32(R & 31)) : R;
        voffA[i] = AGROUP ? (unsigned)((C >> 3) * g.M + R) * 16u : (unsigned)(R * K + C) * 2u; voffB[i] = (unsigned)(Rb * K + C) * 2u; }
    const size_t kstep = (size_t)(BK * 2);
    const size_t hstep = (size_t)HALF * K * 2;
    const size_t tstep = 2 * hstep;
    const size_t kstepA = AGROUP ? (size_t)(BK / 8) * g.M * 16 : kstep, hstepA = AGROUP ? (size_t)HALF * 16 : hstep, tstepA = 2 * hstepA;
    const unsigned ldsw = (unsigned)wid * 1024u;
    const int aoff = lds_byte(wr * 64 + fr, fq * 8), boff = lds_byte(wc * 32 + fr, fq * 8);
#define PG8_SA(b, h) (((b) * 2 + (h)) * HTB)
#define PG8_SB(b, h) ((4 + (b) * 2 + (h)) * HTB)
#define PG8_STAGE(bufoff, gbase, voff) do { _Pragma("unroll") for (int _i = 0; _i < 2; ++_i) \
        __builtin_amdgcn_global_load_lds((const unsigned*)((const char*)(gbase) + (voff)[_i]), (PG8_LAS unsigned*)(lds + (bufoff) + ldsw + _i * 8192), 16, 0, 0); } while (0)
#define PG8_LDA(dst, b, h) do { _Pragma("unroll") for (int m = 0; m < 4; ++m) _Pragma("unroll") for (int k = 0; k < 2; ++k) dst[m][k] = *(const PG8_LAS bf16x8*)(lds + PG8_SA(b, h) + aoff + m * 2048 + k * 1024); } while (0)
#define PG8_LDB(dst, b, h) do { _Pragma("unroll") for (int n = 0; n < 2; ++n) _Pragma("unroll") for (int k = 0; k < 2; ++k) dst[n][k] = *(const PG8_LAS bf16x8*)(lds + PG8_SB(b, h) + boff + n * 2048 + k * 1024); } while (0)
#define PG8_MMA(ai, bj, At, Bt) do { __builtin_amdgcn_s_setprio(1); _Pragma("unroll") for (int m = 0; m < 4; ++m) _Pragma("unroll") for (int n = 0; n < 2; ++n) _Pragma("unroll") for (int k = 0; k < 2; ++k) \
        acc[ai][bj][m][n] = __builtin_amdgcn_mfma_f32_16x16x32_bf16(Bt[n][k], At[m][k], acc[ai][bj][m][n], 0, 0, 0); __builtin_amdgcn_s_setprio(0); } while (0)
#define PG8_WAIT_V(n) asm volatile("s_waitcnt vmcnt(" #n ")" ::: "memory")
#define PG8_WAIT_L(n) asm volatile("s_waitcnt lgkmcnt(" #n ")" ::: "memory")
#define PG8_BAR __builtin_amdgcn_s_barrier()
#define PG8_SCHED __builtin_amdgcn_sched_barrier(0)
    Unit cur, nxt; int ui = 0;
    if (!S.next(0, cur)) return;
    f32x4 acc[2][2][4][2];
#pragma unroll
    for (int a = 0; a < 2; ++a)
#pragma unroll
        for (int b = 0; b < 2; ++b)
#pragma unroll
            for (int m = 0; m < 4; ++m)
#pragma unroll
                for (int n = 0; n < 2; ++n) acc[a][b][m][n] = (f32x4){0.f, 0.f, 0.f, 0.f};
    bf16x8 At[4][2], B0[2][2], B1[2][2];
    const char* cA = (const char*)g.A + (size_t)cur.pm * tstepA; const char* cB = (const char*)g.Bt + (size_t)cur.pn * tstep;
    S.a_ready(cur);
    PG8_STAGE(PG8_SB(0, 0), cB, voffB); PG8_STAGE(PG8_SA(0, 0), cA, voffA); PG8_STAGE(PG8_SB(0, 1), cB + hstep, voffB); PG8_STAGE(PG8_SA(0, 1), cA + hstepA, voffA);
    if (wr == 1) PG8_BAR;
    PG8_WAIT_V(4); PG8_BAR;
    PG8_STAGE(PG8_SB(1, 0), cB + kstep, voffB); PG8_STAGE(PG8_SA(1, 0), cA + kstepA, voffA); PG8_STAGE(PG8_SB(1, 1), cB + hstep + kstep, voffB);
    PG8_WAIT_V(6); PG8_BAR;
    for (;;) {
        const bool has_next = S.next(ui + 1, nxt);
        const char* nA = has_next ? (const char*)g.A + (size_t)nxt.pm * tstepA : cA; const char* nB = has_next ? (const char*)g.Bt + (size_t)nxt.pn * tstep : cB;
        for (int t = 0; t < nt; t += 2) {
            const bool last = (t == nt - 2);
            const char* a1 = cA + (size_t)(t + 1) * kstepA;
            const char* a2 = last ? nA : cA + (size_t)(t + 2) * kstepA; const char* b2 = last ? nB : cB + (size_t)(t + 2) * kstep;
            const char* a3 = a2 + kstepA; const char* b3 = b2 + kstep;
            if (last && has_next) S.a_ready(nxt);
            PG8_LDB(B0, 0, 0); PG8_SCHED; PG8_LDA(At, 0, 0); PG8_STAGE(PG8_SA(1, 1), a1 + hstepA, voffA);
            PG8_WAIT_L(8); PG8_BAR; PG8_WAIT_L(0); PG8_MMA(0, 0, At, B0); PG8_BAR; PG8_SCHED;
            PG8_LDB(B1, 0, 1); PG8_STAGE(PG8_SB(0, 0), b2, voffB);
            PG8_BAR; PG8_WAIT_L(0); PG8_MMA(0, 1, At, B1); PG8_BAR;
            PG8_LDA(At, 0, 1); PG8_STAGE(PG8_SA(0, 0), a2, voffA);
            PG8_BAR; PG8_WAIT_L(0); PG8_MMA(1, 0, At, B0); PG8_BAR; PG8_SCHED;
            PG8_STAGE(PG8_SB(0, 1), b2 + hstep, voffB);
            PG8_WAIT_V(6); PG8_BAR; PG8_MMA(1, 1, At, B1); PG8_BAR;
            PG8_LDB(B0, 1, 0); PG8_SCHED; PG8_LDA(At, 1, 0); PG8_STAGE(PG8_SA(0, 1), a2 + hstepA, voffA);
            PG8_WAIT_L(8); PG8_BAR; PG8_WAIT_L(0); PG8_MMA(0, 0, At, B0); PG8_BAR; PG8_SCHED;
            PG8_LDB(B1, 1, 1); PG8_STAGE(PG8_SB(1, 0), b3, voffB);
            PG8_BAR; PG8_WAIT_L(0); PG8_MMA(0, 1, At, B1); PG8_BAR;
            PG8_LDA(At, 1, 1); PG8_STAGE(PG8_SA(1, 0), a3, voffA);
            PG8_BAR; PG8_WAIT_L(0); PG8_MMA(1, 0, At, B0); PG8_BAR; PG8_SCHED;
            PG8_STAGE(PG8_SB(1, 1), b3 + hstep, voffB);
            PG8_WAIT_V(6); PG8_BAR; PG8_MMA(1, 1, At, B1); PG8_BAR;
        }
        if constexpr (!Epi::AFTER_DRAIN) { E(acc, cur, wr, wc, fr, fq); S.done(cur); }
        if (!has_next) break;
#pragma unroll
        for (int a = 0; a < 2; ++a)
#pragma unroll
            for (int b = 0; b < 2; ++b)
#pragma unroll
                for (int m = 0; m < 4; ++m)
#pragma unroll
                    for (int n = 0; n < 2; ++n) acc[a][b][m][n] = (f32x4){0.f, 0.f, 0.f, 0.f};
        cur = nxt; cA = nA; cB = nB; ++ui;
    }
    PG8_WAIT_V(0);
    if (wr == 0) PG8_BAR;
    PG8_BAR;
    if constexpr (Epi::AFTER_DRAIN) { E.fused(acc, cur, wr, wc, fr, fq, lds, wid, lane); S.done(cur); }
#undef PG8_SA
#undef PG8_SB
#undef PG8_STAGE
#undef PG8_LDA
#undef PG8_LDB
#undef PG8_MMA
#undef PG8_WAIT_V
#undef PG8_WAIT_L
#undef PG8_BAR
#undef PG8_SCHED
}
}

__device__ __forceinline__ uint2 pack4(pg8::f32x4 v) {
  uint2 r;
  r.x = pk2(v[0], v[1]);
  r.y = pk2(v[2], v[3]);
  return r;
}
struct EpiAttnIn {
  static constexpr bool PERM = true, AFTER_DRAIN = false;
  u16* O; const float* rope;
  __device__ __forceinline__ void operator()(const pg8::f32x4 (&acc)[2][2][4][2], const pg8::Unit& u, int wr, int wc, int fr, int fq) const {
    const int row0 = u.pm * 256 + wr * 64 + fr, col0 = u.pn * 256 + wc * 32 + 8 * fq;
    const bool dorope = (u.pn < 10);
    const int axis = wc >> 1, i0 = (wc & 1) * 16 + 4 * fq;
#pragma unroll
    for (int ai = 0; ai < 2; ++ai)
#pragma unroll
      for (int m = 0; m < 4; ++m) {
        const int row = row0 + ai * 128 + m * 16;
        u16* rowp = O + (size_t)row * 5120 + col0;
        if (dorope) {
          const int s = row & 2047;
          const int pos = axis ? (s & 63) : (s >> 6);
          const float4* rp = (const float4*)(rope + (pos * 32 + i0) * 2);
          float4 c01 = rp[0], c23 = rp[1];
#pragma unroll
          for (int bj = 0; bj < 2; ++bj) {
            pg8::f32x4 a = acc[ai][bj][m][0], b = acc[ai][bj][m][1], o0, o1;
            o0[0] = a[0] * c01.x - b[0] * c01.y; o1[0] = b[0] * c01.x + a[0] * c01.y;
            o0[1] = a[1] * c01.z - b[1] * c01.w; o1[1] = b[1] * c01.z + a[1] * c01.w;
            o0[2] = a[2] * c23.x - b[2] * c23.y; o1[2] = b[2] * c23.x + a[2] * c23.y;
            o0[3] = a[3] * c23.z - b[3] * c23.w; o1[3] = b[3] * c23.z + a[3] * c23.w;
            const uint2 lo = pack4(o0), hi = pack4(o1);
            *(uint4*)(rowp + bj * 128) = make_uint4(lo.x, lo.y, hi.x, hi.y);
          }
        } else {
#pragma unroll
          for (int bj = 0; bj < 2; ++bj) {
            const uint2 lo = pack4(acc[ai][bj][m][0]), hi = pack4(acc[ai][bj][m][1]);
            *(uint4*)(rowp + bj * 128) = make_uint4(lo.x, lo.y, hi.x, hi.y);
          }
        }
      }
  }
};
struct EpiRaw {
  static constexpr bool PERM = true, AFTER_DRAIN = false;
  u16* O; int ldc;
  __device__ __forceinline__ void operator()(const pg8::f32x4 (&acc)[2][2][4][2], const pg8::Unit& u, int wr, int wc, int fr, int fq) const {
    const int row0 = u.pm * 256 + wr * 64 + fr, col0 = u.pn * 256 + wc * 32 + 8 * fq;
#pragma unroll
    for (int ai = 0; ai < 2; ++ai)
#pragma unroll
      for (int m = 0; m < 4; ++m) {
        u16* rowp = O + (size_t)(row0 + ai * 128 + m * 16) * ldc + col0;
#pragma unroll
        for (int bj = 0; bj < 2; ++bj) {
          const uint2 lo = pack4(acc[ai][bj][m][0]), hi = pack4(acc[ai][bj][m][1]);
          *(uint4*)(rowp + bj * 128) = make_uint4(lo.x, lo.y, hi.x, hi.y);
        }
      }
  }
};
struct EpiRes {
  static constexpr bool PERM = false, AFTER_DRAIN = false;
  float* out; const float* base; const float* gate;
  __device__ __forceinline__ void operator()(const pg8::f32x4 (&acc)[2][2][4][2], const pg8::Unit& u, int wr, int wc, int fr, int fq) const {
    const int row0 = u.pm * 256 + wr * 64 + fr, col0 = u.pn * 256 + wc * 32 + 4 * fq;
    const int b = (u.pm * 256) >> 11;
    pg8::f32x4 gv[2][2];
#pragma unroll
    for (int bj = 0; bj < 2; ++bj)
#pragma unroll
      for (int n = 0; n < 2; ++n) gv[bj][n] = *(const pg8::f32x4*)(gate + b * 6144 + col0 + bj * 128 + n * 16);
#pragma unroll
    for (int ai = 0; ai < 2; ++ai)
#pragma unroll
      for (int m = 0; m < 4; ++m) {
        const size_t off = (size_t)(row0 + ai * 128 + m * 16) * 2048 + col0;
#pragma unroll
        for (int bj = 0; bj < 2; ++bj)
#pragma unroll
          for (int n = 0; n < 2; ++n) {
            pg8::f32x4 bv = *(const pg8::f32x4*)(base + off + bj * 128 + n * 16);
            *(pg8::f32x4*)(out + off + bj * 128 + n * 16) = bv + gv[bj][n] * acc[ai][bj][m][n];
          }
      }
  }
};

struct EpiResNorm {
  static constexpr bool PERM = false, AFTER_DRAIN = true;
  float* out; const float* base; const float* gate;
  float* rowss; unsigned* pcnt;
  const float* g; const float* shsc;
  u16* hx;
  static __device__ __forceinline__ int loff(int row, int chunk) { return row * 1024 + ((chunk ^ (row & 63)) << 4); }
  __device__ __forceinline__ void fused(pg8::f32x4 (&acc)[2][2][4][2], const pg8::Unit& u, int wr, int wc, int fr, int fq,
                                        PG8_LAS unsigned char* lds, int wid, int lane) const {
    const int R0 = u.pm * 256, C0 = u.pn * 256;
    const int b = R0 >> 11;
    const int frow = wr * 64 + fr, fchunk = wc * 8 + fq;
    {
      pg8::f32x4 gv[2][2];
#pragma unroll
      for (int bj = 0; bj < 2; ++bj)
#pragma unroll
        for (int n = 0; n < 2; ++n) gv[bj][n] = *(const pg8::f32x4*)(gate + b * 6144 + C0 + wc * 32 + 4 * fq + bj * 128 + n * 16);
#pragma unroll
      for (int ai = 0; ai < 2; ++ai) {
        {
          pg8::f32x4 t[16];
#pragma unroll
          for (int i = 0; i < 16; ++i) t[i] = *(const pg8::f32x4*)(base + (size_t)(R0 + ai * 128 + wid * 16 + i) * 2048 + C0 + 4 * lane);
#pragma unroll
          for (int i = 0; i < 16; ++i) *(PG8_LAS pg8::f32x4*)(lds + loff(wid * 16 + i, lane)) = t[i];
        }
        __syncthreads();
#pragma unroll
        for (int m = 0; m < 4; ++m) {
          float ss = 0.f;
#pragma unroll
          for (int bj = 0; bj < 2; ++bj)
#pragma unroll
            for (int n = 0; n < 2; ++n) {
              const pg8::f32x4 bv = *(const PG8_LAS pg8::f32x4*)(lds + loff(frow + 16 * m, fchunk + 32 * bj + 4 * n));
              const pg8::f32x4 v = bv + gv[bj][n] * acc[ai][bj][m][n];
              acc[ai][bj][m][n] = v;
              ss += v[0] * v[0] + v[1] * v[1] + v[2] * v[2] + v[3] * v[3];
            }
          ss += __shfl_xor(ss, 16, 64);
          ss += __shfl_xor(ss, 32, 64);
          if (fq == 0) unsafeAtomicAdd(rowss + R0 + ai * 128 + frow + 16 * m, ss);
        }
        __syncthreads();
      }
    }
    asm volatile("s_waitcnt vmcnt(0)" ::: "memory");
    __syncthreads();
    if (threadIdx.x == 0) {
      unsigned* c = pcnt + u.pm * 64;
      __hip_atomic_fetch_add(c, 1u, __ATOMIC_RELAXED, __HIP_MEMORY_SCOPE_AGENT);
      unsigned spins = 0;
      while (__hip_atomic_load(c, __ATOMIC_RELAXED, __HIP_MEMORY_SCOPE_AGENT) < 8u && ++spins < (1u << 22)) __builtin_amdgcn_s_sleep(1);
    }
    __syncthreads();
    const pg8::f32x4 gg = *(const pg8::f32x4*)(g + C0 + 4 * lane);
    pg8::f32x4 sh = gg, sc = gg;
    if (hx) {
      sh = *(const pg8::f32x4*)(shsc + b * 6144 + C0 + 4 * lane);
      sc = *(const pg8::f32x4*)(shsc + b * 6144 + 2048 + C0 + 4 * lane) + 1.f;
    }
#pragma unroll
    for (int ai = 0; ai < 2; ++ai) {
#pragma unroll
      for (int m = 0; m < 4; ++m)
#pragma unroll
        for (int bj = 0; bj < 2; ++bj)
#pragma unroll
          for (int n = 0; n < 2; ++n)
            *(PG8_LAS pg8::f32x4*)(lds + loff(frow + 16 * m, fchunk + 32 * bj + 4 * n)) = acc[ai][bj][m][n];
      __syncthreads();
#pragma unroll 4
      for (int i = 0; i < 16; ++i) {
        const int lrow = wid * 16 + i, row = R0 + ai * 128 + lrow;
        const pg8::f32x4 v = *(const PG8_LAS pg8::f32x4*)(lds + loff(lrow, lane));
        const float ss = __hip_atomic_load(rowss + row, __ATOMIC_RELAXED, __HIP_MEMORY_SCOPE_AGENT);
        const float r = rsqrtf(ss * (1.f / 2048.f) + 1e-6f);
        const size_t off = (size_t)row * 2048 + C0 + 4 * lane;
        pg8::f32x4 o = v * r * gg;
        if (hx) {
          *(pg8::f32x4*)(out + off) = v;
          o = o * sc + sh;
          *(uint2*)(hx + off) = pack4(o);
        } else {
          *(pg8::f32x4*)(out + off) = o;
        }
      }
      __syncthreads();
    }
  }
};
template <class Epi, bool AGROUP = false>
__device__ __forceinline__ void run_gemm(float* sm, const u16* A, const u16* Bt, int M, int N, const Epi& E, int c) {
  pg8::Gemm g{A, Bt, M, N, 2048, AGROUP ? 1 : 0};
  pg8::StaticOrder S; S.init(M, N, (int)gridDim.x, c);
  pg8::gemm_phase<Epi, pg8::StaticOrder, AGROUP>((PG8_LAS unsigned char*)sm, g, S, E);
  __syncthreads();
}

template <int MODE>
__device__ __forceinline__ void epi_pair(const Params& p, int m, int n, float a0, float a1) {
  if (MODE == 1) {
    u16* px = (u16*)(p.ws + OFF_BIG);
    float o0 = a0, o1 = a1;
    if (n < 2560) {
      int g = (n >> 5) & 3, fr = n & 15;
      int axis = g >> 1, i = (g & 1) * 16 + fr;
      int s = m & 2047;
      int pos = axis ? (s & 63) : (s >> 6);
      float2 cs = ((const float2*)(p.ws + OFF_ROPE))[pos * 32 + i];
      o0 = a0 * cs.x - a1 * cs.y;
      o1 = a1 * cs.x + a0 * cs.y;
    }
    px[(size_t)m * 5120 + n] = f2bf(o0);
    px[(size_t)m * 5120 + n + 16] = f2bf(o1);
  } else if (MODE == 5) {
    u16* kvc = (u16*)(p.ws + OFF_KVC);
    kvc[(size_t)m * 1024 + n] = f2bf(a0);
    kvc[(size_t)m * 1024 + n + 16] = f2bf(a1);
  } else if (MODE == 2) {
    const float* mod = (const float*)(p.ws + OFF_MOD);
    int b = m >> 11;
    const float* gate = mod + (0 * 5 + b) * 6144 + 4096;
    p.out[(size_t)m * 2048 + n] = p.x[(size_t)m * 2048 + n] + gate[n] * a0;
    p.out[(size_t)m * 2048 + n + 16] = p.x[(size_t)m * 2048 + n + 16] + gate[n + 16] * a1;
  } else if (MODE == 3) {
    u16* pp = (u16*)(p.ws + OFF_BIG);
    pp[(size_t)m * 8192 + n] = f2bf(a0);
    pp[(size_t)m * 8192 + n + 16] = f2bf(a1);
  } else if (MODE == 4) {
    const float* mod = (const float*)(p.ws + OFF_MOD);
    int b = m >> 11;
    const float* gate = mod + (1 * 5 + b) * 6144 + 4096;
    p.out[(size_t)m * 2048 + n] += gate[n] * a0;
    p.out[(size_t)m * 2048 + n + 16] += gate[n + 16] * a1;
  }
}

template <int MODE>
__device__ __forceinline__ void naive_gemm(const Params& p, const u16* __restrict__ A, const u16* __restrict__ Wt, int M, int N) {
  const int tid = threadIdx.x;
  const int ml = tid >> 5, pl = tid & 31;
  const int ntn = N / 64, ntm = M / 16;
  for (int tile = blockIdx.x; tile < ntn * ntm; tile += gridDim.x) {
    int tm = tile / ntn, tn = tile % ntn;
    int m = tm * 16 + ml;
    int n = tn * 64 + (pl >> 4) * 32 + (pl & 15);
    const uint4* a = (const uint4*)(A + (size_t)m * 2048);
    const uint4* w0 = (const uint4*)(Wt + (size_t)n * 2048);
    const uint4* w1 = (const uint4*)(Wt + (size_t)(n + 16) * 2048);
    float acc0 = 0.f, acc1 = 0.f;
#pragma unroll 2
    for (int k = 0; k < 256; ++k) {
      uint4 av = a[k], b0 = w0[k], b1 = w1[k];
      acc0 += bflo(av.x) * bflo(b0.x) + bfhi(av.x) * bfhi(b0.x) + bflo(av.y) * bflo(b0.y) + bfhi(av.y) * bfhi(b0.y)
            + bflo(av.z) * bflo(b0.z) + bfhi(av.z) * bfhi(b0.z) + bflo(av.w) * bflo(b0.w) + bfhi(av.w) * bfhi(b0.w);
      acc1 += bflo(av.x) * bflo(b1.x) + bfhi(av.x) * bfhi(b1.x) + bflo(av.y) * bflo(b1.y) + bfhi(av.y) * bfhi(b1.y)
            + bflo(av.z) * bflo(b1.z) + bfhi(av.z) * bfhi(b1.z) + bflo(av.w) * bflo(b1.w) + bfhi(av.w) * bfhi(b1.w);
    }
    epi_pair<MODE>(p, m, n, acc0, acc1);
  }
}

__device__ __forceinline__ void phase_attn_naive(const Params& p, float* sm) {
  const int wid = threadIdx.x >> 6, lane = threadIdx.x & 63;
  float* qs = sm + wid * (128 + 640);
  float* pr = qs + 128;
  const u16* px = (const u16*)(p.ws + OFF_BIG);
  const u16* kvc = (const u16*)(p.ws + OFF_KVC);
  u16* og = (u16*)(p.ws + OFF_ACT);
  const float scale = 0.08838834764831845f;
  for (int item = blockIdx.x * 8 + wid; item < MT * 16; item += gridDim.x * 8) {
    int m = item >> 4, h = item & 15;
    int b = m >> 11, s = m & 2047, kvh = h >> 2, nblk = s >> 7;
    const u16* qrow = px + (size_t)m * 5120 + h * 128;
    qs[lane] = bf2f(qrow[lane]) * scale;
    qs[lane + 64] = bf2f(qrow[lane + 64]) * scale;
    asm volatile("s_waitcnt lgkmcnt(0)" ::: "memory");
    float mx = p.attn_sink[h];
#pragma unroll 1
    for (int j = 0; j < 10; ++j) {
      int kidx = j * 64 + lane;
      const u16* krow;
      bool valid;
      if (kidx < 384) {
        int kpos = (nblk - 1) * 128 + kidx;
        int rel = kpos - s;
        valid = (kpos >= 0) && (kpos < 2048) && (rel <= 128) && (rel >= -128);
        krow = px + (size_t)(b * 2048 + (valid ? kpos : 0)) * 5120 + 2048 + kvh * 128;
      } else {
        valid = true;
        krow = kvc + (size_t)(b * 256 + (kidx - 384)) * 1024 + kvh * 128;
      }
      float d = -1e30f;
      if (valid) {
        d = 0.f;
#pragma unroll 4
        for (int c = 0; c < 16; ++c) {
          uint4 kk = *(const uint4*)(krow + c * 8);
          const float* q8 = qs + c * 8;
          d += q8[0] * bflo(kk.x) + q8[1] * bfhi(kk.x) + q8[2] * bflo(kk.y) + q8[3] * bfhi(kk.y)
             + q8[4] * bflo(kk.z) + q8[5] * bfhi(kk.z) + q8[6] * bflo(kk.w) + q8[7] * bfhi(kk.w);
        }
      }
      pr[kidx] = d;
      mx = fmaxf(mx, d);
    }
    mx = wave_max(mx);
    float sum = 0.f;
#pragma unroll 1
    for (int j = 0; j < 10; ++j) {
      float d = pr[j * 64 + lane];
      float e = (d > -1e29f) ? __expf(d - mx) : 0.f;
      pr[j * 64 + lane] = e;
      sum += e;
    }
    sum = wave_sum(sum);
    sum += __expf(p.attn_sink[h] - mx);
    asm volatile("s_waitcnt lgkmcnt(0)" ::: "memory");
    float o0 = 0.f, o1 = 0.f;
    int k0 = s - 128 < 0 ? 0 : s - 128, k1 = s + 128 > 2047 ? 2047 : s + 128;
    for (int kpos = k0; kpos <= k1; ++kpos) {
      float pv = pr[kpos - (nblk - 1) * 128];
      unsigned vv = *(const unsigned*)(px + (size_t)(b * 2048 + kpos) * 5120 + 2560 + kvh * 128 + lane * 2);
      o0 += pv * bflo(vv); o1 += pv * bfhi(vv);
    }
    for (int c = 0; c < 256; ++c) {
      float pv = pr[384 + c];
      unsigned vv = *(const unsigned*)(kvc + (size_t)(b * 256 + c) * 1024 + 512 + kvh * 128 + lane * 2);
      o0 += pv * bflo(vv); o1 += pv * bfhi(vv);
    }
    float inv = 1.f / sum;
    unsigned gg = *(const unsigned*)(px + (size_t)m * 5120 + 3072 + h * 128 + lane * 2);
    float r0 = o0 * inv * siluf(bflo(gg)), r1 = o1 * inv * siluf(bfhi(gg));
    *(unsigned*)(og + (size_t)m * 2048 + h * 128 + lane * 2) = pk2(r0, r1);
    asm volatile("s_waitcnt lgkmcnt(0)" ::: "memory");
  }
}

__device__ __forceinline__ float sconv(const u16* pp, const float* cw, const float* cb, int b, int t, int c) {
  const u16* base = pp + (size_t)(b * 2048 + t) * 8192 + c;
  float v = cw[6144 + c] * bf2f(base[0]) + cb[c];
  if (t > 0) v += cw[c] * bf2f(base[-8192]);
  if (t < 2047) v += cw[2 * 6144 + c] * bf2f(base[8192]);
  return v;
}

__device__ __forceinline__ void phase_conv_naive(const Params& p, float* sm) {
  const int tid = threadIdx.x;
  float* u = sm;
  float* R = sm + 8192;
  const u16* pp = (const u16*)(p.ws + OFF_BIG);
  const u16* Rg = (const u16*)(p.ws + OFF_FILT);
  u16* yg = (u16*)(p.ws + OFF_ACT);
  for (int ch = blockIdx.x; ch < 2048; ch += gridDim.x) {
    for (int i = tid; i < 8192; i += NTHREADS) u[i] = sconv(pp, p.hy_conv_w, p.hy_conv_b, i >> 11, i & 2047, 4096 + ch);
    for (int i = tid; i < 4096; i += NTHREADS) R[i] = bf2f(Rg[((size_t)0 * 2048 + ch) * 4096 + i]);
    __syncthreads();
    float zr[16];
#pragma unroll
    for (int q = 0; q < 16; ++q) {
      int i = tid + q * NTHREADS;
      int b = i >> 11, t = i & 2047;
      const float* ub = u + b * 2048;
      const float* Rb = R + 2048 - t;
      float a = 0.f;
      for (int s = 0; s < 2048; ++s) a += Rb[s] * ub[s];
      zr[q] = a * sconv(pp, p.hy_conv_w, p.hy_conv_b, b, t, ch);
    }
    __syncthreads();
#pragma unroll
    for (int q = 0; q < 16; ++q) u[tid + q * NTHREADS] = zr[q];
    for (int i = tid; i < 4096; i += NTHREADS) R[i] = bf2f(Rg[((size_t)1 * 2048 + ch) * 4096 + i]);
    __syncthreads();
#pragma unroll
    for (int q = 0; q < 16; ++q) {
      int i = tid + q * NTHREADS;
      int b = i >> 11, t = i & 2047;
      const float* ub = u + b * 2048;
      const float* Rb = R + 2048 - t;
      float a = 0.f;
      for (int s = 0; s < 2048; ++s) a += Rb[s] * ub[s];
      float y = a * sconv(pp, p.hy_conv_w, p.hy_conv_b, b, t, 2048 + ch);
      float g = bf2f(pp[(size_t)(b * 2048 + t) * 8192 + 6144 + ch]);
      yg[(size_t)(b * 2048 + t) * 2048 + ch] = f2bf(y * siluf(g));
    }
    __syncthreads();
  }
}


typedef float f32x16 __attribute__((ext_vector_type(16)));
typedef pg8::bf16x8 bfx8;
constexpr int CONV_RF_BYTES = 4 * 2 * 8192;
constexpr int CONV_PAD = 15;
constexpr int CONV_UB_ONE = 190 * 64;
__device__ __forceinline__ int ub_addr(int col, int chunk) { return col * 64 + ((chunk ^ ((col >> 2) & 3)) << 4); }

__device__ __forceinline__ void conv_mfma(const char* Rf_ci, const char* Ub_w, int lane, f32x16 (&acc)[4]) {
  const int t2 = lane & 31, h = lane >> 5, n = lane & 31;
  const int lanedw = (2048 - t2 + 8 * h) >> 1;
#pragma unroll
  for (int j = 0; j < 4; ++j)
#pragma unroll
    for (int r = 0; r < 16; ++r) acc[j][r] = 0.f;
#pragma unroll 2
  for (int f = 0; f < 16; ++f) {
    bfx8 Bw[5][2];
#pragma unroll
    for (int m = 0; m < 5; ++m) {
      const int col = (16 * m - f + CONV_PAD) * 2 + n;
#pragma unroll
      for (int kh = 0; kh < 2; ++kh) Bw[m][kh] = *(const bfx8*)(Ub_w + ub_addr(col, 2 * kh + h));
    }
    const unsigned* Rp = (const unsigned*)(Rf_ci + ((t2 & 1) ? 8192 : 0)) + lanedw - 16 * f;
#pragma unroll
    for (int e = -4; e <= 3; ++e) {
      int ee = e;
      if (e == -4) ee = (f == 0) ? -3 : -4;
      bfx8 A[2];
#pragma unroll
      for (int kh = 0; kh < 2; ++kh) {
        const unsigned* q = Rp - 256 * ee + 8 * kh;
        pg8::u32x4 pk;
        pk[0] = q[0]; pk[1] = q[1]; pk[2] = q[2]; pk[3] = q[3];
        A[kh] = __builtin_bit_cast(bfx8, pk);
      }
#pragma unroll
      for (int j = 0; j < 4; ++j) {
        const int m = j - e;
        if (m >= 0 && m <= 4) acc[j] = __builtin_amdgcn_mfma_f32_32x32x16_bf16(A[0], Bw[m][0], acc[j], 0, 0, 0);
      }
#pragma unroll
      for (int j = 0; j < 4; ++j) {
        const int m = j - e;
        if (m >= 0 && m <= 4) acc[j] = __builtin_amdgcn_mfma_f32_32x32x16_bf16(A[1], Bw[m][1], acc[j], 0, 0, 0);
      }
    }
  }
}

__device__ __forceinline__ void sconv4(const u16* xp, int t, float w0, float w1, float w2, float cb, float (&o)[4]) {
  uint2 x4 = *(const uint2*)xp;
  float pv = t > 0 ? bf2f(xp[-1]) : 0.f;
  float nx = (t + 4 < 2048) ? bf2f(xp[4]) : 0.f;
  float e0 = bflo(x4.x), e1 = bfhi(x4.x), e2 = bflo(x4.y), e3 = bfhi(x4.y);
  o[0] = w0 * pv + w1 * e0 + w2 * e1 + cb;
  o[1] = w0 * e0 + w1 * e1 + w2 * e2 + cb;
  o[2] = w0 * e1 + w1 * e2 + w2 * e3 + cb;
  o[3] = w0 * e2 + w1 * e3 + w2 * nx + cb;
}

struct SC4 { uint2 x; unsigned pn; };
__device__ __forceinline__ SC4 sc4_load(const u16* xp, int t) {
  SC4 r;
  r.x = *(const uint2*)xp;
  const unsigned pv = t > 0 ? (unsigned)xp[-1] : 0u;
  const unsigned nx = (t + 4 < 2048) ? (unsigned)xp[4] : 0u;
  r.pn = pv | (nx << 16);
  return r;
}
__device__ __forceinline__ void sc4_apply(const SC4& r, float w0, float w1, float w2, float cb, float (&o)[4]) {
  const float pv = bflo(r.pn), nx = bfhi(r.pn);
  const float e0 = bflo(r.x.x), e1 = bfhi(r.x.x), e2 = bflo(r.x.y), e3 = bfhi(r.x.y);
  o[0] = w0 * pv + w1 * e0 + w2 * e1 + cb;
  o[1] = w0 * e0 + w1 * e1 + w2 * e2 + cb;
  o[2] = w0 * e1 + w1 * e2 + w2 * e3 + cb;
  o[3] = w0 * e2 + w1 * e3 + w2 * nx + cb;
}

__device__ __forceinline__ void phase_conv(const Params& p, float* smf) {
  char* sm = (char*)smf;
  char* Rf = sm;
  char* Ub = sm + CONV_RF_BYTES;
  int tid = threadIdx.x;
  asm volatile("" : "+v"(tid));
  const int wid = tid >> 6, lane = tid & 63;
  const int ci = wid >> 1, bp = wid & 1;
  const u16* pT = (const u16*)(p.ws + OFF_BIG);
  const u16* Rg = (const u16*)(p.ws + OFF_FILT);
  u16* yg = (u16*)(p.ws + OFF_ACT);
  for (int kk = 0; kk < (8 * CONV_UB_ONE / 16 + NTHREADS - 1) / NTHREADS; ++kk) { const int zi = tid + kk * NTHREADS; if (zi < 8 * CONV_UB_ONE / 16) ((uint4*)Ub)[zi] = make_uint4(0, 0, 0, 0); }
  __syncthreads();
  char* Ub_w = Ub + (ci * 2 + bp) * CONV_UB_ONE;
  const char* Rf_ci = Rf + ci * 16384;
  const int h = lane >> 5, n = lane & 31;
  for (int it0 = blockIdx.x * 2; it0 < 512; it0 += gridDim.x * 2)
#pragma unroll 1
  for (int sub = 0; sub < 2; ++sub) {
    const int item = it0 + sub;
    const int ch0 = item * 4;
    {
      const int q = tid & 255, hb = tid >> 8;
      uint4 x8[8]; unsigned pn[8]; uint4 fr[4];
#pragma unroll
      for (int k = 0; k < 8; ++k) {
        const int cc = 4096 + ch0 + (k >> 1), b = (k & 1) * 2 + hb;
        const u16* xp = pT + (size_t)cc * 8192 + b * 2048 + q * 8;
        x8[k] = *(const uint4*)xp;
        const unsigned pv = q > 0 ? (unsigned)xp[-1] : 0u;
        const unsigned nx = q < 255 ? (unsigned)xp[8] : 0u;
        pn[k] = pv | (nx << 16);
      }
      unsigned fx[4];
#pragma unroll
      for (int k = 0; k < 4; ++k) {
        const unsigned* fp = (const unsigned*)(Rg + ((size_t)0 * 2048 + ch0 + k) * 4096);
        fr[k] = ((const uint4*)fp)[tid];
        fx[k] = tid < 511 ? fp[4 * tid + 4] : 0u;
      }
#pragma unroll
      for (int k = 0; k < 8; ++k) {
        const int c = k >> 1, cc = 4096 + ch0 + c, b = (k & 1) * 2 + hb;
        const float w0 = p.hy_conv_w[cc], w1 = p.hy_conv_w[6144 + cc], w2 = p.hy_conv_w[2 * 6144 + cc], cb = p.hy_conv_b[cc];
        float e[10];
        e[0] = bflo(pn[k]); e[1] = bflo(x8[k].x); e[2] = bfhi(x8[k].x); e[3] = bflo(x8[k].y); e[4] = bfhi(x8[k].y);
        e[5] = bflo(x8[k].z); e[6] = bfhi(x8[k].z); e[7] = bflo(x8[k].w); e[8] = bfhi(x8[k].w); e[9] = bfhi(pn[k]);
        unsigned o[4];
#pragma unroll
        for (int kk = 0; kk < 4; ++kk) {
          float a = w0 * e[2 * kk] + w1 * e[2 * kk + 1] + w2 * e[2 * kk + 2] + cb;
          float bb = w0 * e[2 * kk + 1] + w1 * e[2 * kk + 2] + w2 * e[2 * kk + 3] + cb;
          o[kk] = pk2(a, bb);
        }
        const int t0 = q * 8, s1 = t0 >> 5, s2 = t0 & 31;
        const int col = (s1 + CONV_PAD) * 2 + (b & 1);
        *(uint4*)(Ub + (c * 2 + (b >> 1)) * CONV_UB_ONE + ub_addr(col, s2 >> 3)) = make_uint4(o[0], o[1], o[2], o[3]);
      }
#pragma unroll
      for (int k = 0; k < 4; ++k) {
        ((uint4*)(Rf + k * 16384))[tid] = fr[k];
        ((uint4*)(Rf + k * 16384 + 8192))[tid] = make_uint4(__builtin_amdgcn_alignbit(fr[k].y, fr[k].x, 16), __builtin_amdgcn_alignbit(fr[k].z, fr[k].y, 16),
                                                             __builtin_amdgcn_alignbit(fr[k].w, fr[k].z, 16), __builtin_amdgcn_alignbit(fx[k], fr[k].w, 16));
      }
    }
    __syncthreads();
    f32x16 acc[4];
    const int ch = ch0 + ci;
    {
      conv_mfma(Rf_ci, Ub_w, lane, acc);
      SC4 xr[16];
#pragma unroll
      for (int j = 0; j < 4; ++j)
#pragma unroll
        for (int vg = 0; vg < 4; ++vg) {
          const int t1 = 16 * j + (n >> 1), b = 2 * bp + (n & 1), t = 32 * t1 + 8 * vg + 4 * h;
          xr[j * 4 + vg] = sc4_load(pT + (size_t)ch * 8192 + b * 2048 + t, t);
        }
      const unsigned* f1p = (const unsigned*)(Rg + ((size_t)1 * 2048 + ch0) * 4096);
      const uint4 f1a = ((const uint4*)(f1p + 0 * 2048))[tid];
      const uint4 f1b = ((const uint4*)(f1p + 1 * 2048))[tid];
      const uint4 f1c = ((const uint4*)(f1p + 2 * 2048))[tid];
      const uint4 f1d = ((const uint4*)(f1p + 3 * 2048))[tid];
      const unsigned x1a = tid < 511 ? f1p[0 * 2048 + 4 * tid + 4] : 0u, x1b = tid < 511 ? f1p[1 * 2048 + 4 * tid + 4] : 0u;
      const unsigned x1c = tid < 511 ? f1p[2 * 2048 + 4 * tid + 4] : 0u, x1d = tid < 511 ? f1p[3 * 2048 + 4 * tid + 4] : 0u;
      const float w0 = p.hy_conv_w[ch], w1 = p.hy_conv_w[6144 + ch], w2 = p.hy_conv_w[2 * 6144 + ch], cb = p.hy_conv_b[ch];
#pragma unroll
      for (int j = 0; j < 4; ++j)
#pragma unroll
        for (int vg = 0; vg < 4; ++vg) {
          const int t1 = 16 * j + (n >> 1), bl = n & 1;
          float x1[4];
          sc4_apply(xr[j * 4 + vg], w0, w1, w2, cb, x1);
          uint2 pk;
          pk.x = pk2(x1[0] * acc[j][4 * vg + 0], x1[1] * acc[j][4 * vg + 1]);
          pk.y = pk2(x1[2] * acc[j][4 * vg + 2], x1[3] * acc[j][4 * vg + 3]);
          const int col = (t1 + CONV_PAD) * 2 + bl;
          *(uint2*)(Ub_w + ub_addr(col, vg) + 8 * h) = pk;
        }
      __syncthreads();
#define CONV_PUT_F(K, F, X) do { ((uint4*)(Rf + (K) * 16384))[tid] = F; \
        ((uint4*)(Rf + (K) * 16384 + 8192))[tid] = make_uint4(__builtin_amdgcn_alignbit(F.y, F.x, 16), __builtin_amdgcn_alignbit(F.z, F.y, 16), \
                                                               __builtin_amdgcn_alignbit(F.w, F.z, 16), __builtin_amdgcn_alignbit(X, F.w, 16)); } while (0)
      CONV_PUT_F(0, f1a, x1a); CONV_PUT_F(1, f1b, x1b); CONV_PUT_F(2, f1c, x1c); CONV_PUT_F(3, f1d, x1d);
#undef CONV_PUT_F
    }
    __syncthreads();
    {
      const int c2 = 2048 + ch;
      SC4 xr[16]; uint2 gr[16];
      conv_mfma(Rf_ci, Ub_w, lane, acc);
#pragma unroll
      for (int j = 0; j < 4; ++j)
#pragma unroll
        for (int vg = 0; vg < 4; ++vg) {
          const int t1 = 16 * j + (n >> 1), b = 2 * bp + (n & 1), t = 32 * t1 + 8 * vg + 4 * h;
          xr[j * 4 + vg] = sc4_load(pT + (size_t)c2 * 8192 + b * 2048 + t, t);
          gr[j * 4 + vg] = *(const uint2*)(pT + (size_t)(6144 + ch) * 8192 + b * 2048 + t);
        }
      const float w0 = p.hy_conv_w[c2], w1 = p.hy_conv_w[6144 + c2], w2 = p.hy_conv_w[2 * 6144 + c2], cb = p.hy_conv_b[c2];
#pragma unroll
      for (int j = 0; j < 4; ++j)
#pragma unroll
        for (int vg = 0; vg < 4; ++vg) {
          const int t1 = 16 * j + (n >> 1), bl = n & 1;
          float x2[4];
          sc4_apply(xr[j * 4 + vg], w0, w1, w2, cb, x2);
          const uint2 g4 = gr[j * 4 + vg];
          float y0 = x2[0] * acc[j][4 * vg + 0] * siluf(bflo(g4.x));
          float y1 = x2[1] * acc[j][4 * vg + 1] * siluf(bfhi(g4.x));
          float y2 = x2[2] * acc[j][4 * vg + 2] * siluf(bflo(g4.y));
          float y3 = x2[3] * acc[j][4 * vg + 3] * siluf(bfhi(g4.y));
          uint2 pk;
          pk.x = pk2(y0, y1);
          pk.y = pk2(y2, y3);
          const int col = (t1 + CONV_PAD) * 2 + bl;
          *(uint2*)(Ub_w + ub_addr(col, vg) + 8 * h) = pk;
        }
    }
    __syncthreads();
    int tw = tid;
    asm volatile("" : "+v"(tw));
#pragma unroll 4
    for (int kk = 0; kk < 16; ++kk) {
      const int idx = tw + kk * NTHREADS;
      const int b = idx >> 11, t = idx & 2047;
      const int s1 = t >> 5, s2 = t & 31;
      const int col = (s1 + CONV_PAD) * 2 + (b & 1);
      const int a = ub_addr(col, s2 >> 3) + (s2 & 7) * 2;
      const char* base = Ub + (b >> 1) * CONV_UB_ONE + a;
      unsigned v0 = *(const u16*)(base + 0 * 2 * CONV_UB_ONE), v1 = *(const u16*)(base + 1 * 2 * CONV_UB_ONE);
      unsigned v2 = *(const u16*)(base + 2 * 2 * CONV_UB_ONE), v3 = *(const u16*)(base + 3 * 2 * CONV_UB_ONE);
      const uint2 cur = make_uint2(v0 | (v1 << 16), v2 | (v3 << 16));
      *(uint2*)(yg + ((size_t)(item >> 1) * 8192 + idx) * 8 + (item & 1) * 4) = cur;
    }
    __syncthreads();
  }
}

constexpr int AT_KROW = 272, AT_VROW = 136;
constexpr int AT_K_BYTES = 64 * AT_KROW, AT_V_BYTES = 128 * AT_VROW;
__device__ __forceinline__ void phase_attn(const Params& p, float* smf) {
  char* sm = (char*)smf;
  char* Ks = sm;
  char* Vs = sm + AT_K_BYTES;
  const int tid = threadIdx.x, wid = tid >> 6, lane = tid & 63, r = lane & 31, h = lane >> 5;
  const u16* px = (const u16*)(p.ws + OFF_BIG);
  const u16* kvc = (const u16*)(p.ws + OFF_KVC);
  const u16* vT = (const u16*)(p.ws + OFF_VT);
  const u16* vcT = (const u16*)(p.ws + OFF_VCT);
  u16* og = (u16*)(p.ws + OFF_ACT);
  const float LOG2E = 1.4426950408889634f;
  const float sl2 = 0.08838834764831845f * LOG2E;
  for (int item = blockIdx.x; item < 512; item += gridDim.x) {
    const int hp = item & 1, kvh = (item >> 1) & 3, nblk = (item >> 3) & 15, b = item >> 7;
    const int hq = kvh * 4 + hp * 2 + (wid >> 2);
    const int qs = nblk * 128 + (wid & 3) * 32 + r;
    bfx8 Q[8];
    {
      const u16* qrow = px + (size_t)(b * 2048 + qs) * 5120 + hq * 128 + 8 * h;
#pragma unroll
      for (int st = 0; st < 8; ++st) Q[st] = *(const bfx8*)(qrow + 16 * st);
    }
    f32x16 O[4];
#pragma unroll
    for (int dt = 0; dt < 4; ++dt)
#pragma unroll
      for (int i = 0; i < 16; ++i) O[dt][i] = 0.f;
    float m = p.attn_sink[hq] * LOG2E;
    float l = (h == 0) ? 1.f : 0.f;
    const int first = (nblk == 0) ? 2 : 0, lastlocal = (nblk == 15) ? 3 : 5;
    uint4 kA0, kA1, vA0, vA1, kB0, kB1, vB0, vB1;
#define AT_LOAD_TILE(TI, K0, K1, V0, V1) do { \
      const int _ti = (TI); const bool _loc = _ti < 6; \
      const int _kpos0 = 128 * (nblk - 1) + 64 * _ti, _c0 = 64 * (_ti - 6); \
      const u16* _kb = _loc ? px + (size_t)(b * 2048 + _kpos0) * 5120 + 2048 + kvh * 128 : kvc + (size_t)(b * 256 + _c0) * 1024 + kvh * 128; \
      const size_t _ks = _loc ? 5120 : 1024; \
      const u16* _vb = _loc ? vT + (size_t)(kvh * 128) * 8192 + b * 2048 + _kpos0 : vcT + (size_t)(kvh * 128) * 1024 + b * 256 + _c0; \
      const size_t _vs = _loc ? 8192 : 1024; \
      const int _c1 = tid + NTHREADS; \
      K0 = *(const uint4*)(_kb + (size_t)(tid >> 4) * _ks + (tid & 15) * 8); \
      K1 = *(const uint4*)(_kb + (size_t)(_c1 >> 4) * _ks + (_c1 & 15) * 8); \
      V0 = *(const uint4*)(_vb + (size_t)(tid >> 3) * _vs + (tid & 7) * 8); \
      V1 = *(const uint4*)(_vb + (size_t)(_c1 >> 3) * _vs + (_c1 & 7) * 8); \
    } while (0)
#define AT_STORE_TILE(K0, K1, V0, V1) do { \
      const int c1 = tid + NTHREADS; \
      *(uint4*)(Ks + (tid >> 4) * AT_KROW + (tid & 15) * 16) = K0; \
      *(uint4*)(Ks + (c1 >> 4) * AT_KROW + (c1 & 15) * 16) = K1; \
      char* v0p = Vs + (tid >> 3) * AT_VROW + (tid & 7) * 16; \
      char* v1p = Vs + (c1 >> 3) * AT_VROW + (c1 & 7) * 16; \
      *(uint2*)(v0p) = make_uint2(V0.x, V0.y); \
      *(uint2*)(v0p + 8) = make_uint2(V0.z, V0.w); \
      *(uint2*)(v1p) = make_uint2(V1.x, V1.y); \
      *(uint2*)(v1p + 8) = make_uint2(V1.z, V1.w); \
    } while (0)
    int ti = first;
    int t1 = ti + 1;
    if (t1 > lastlocal && t1 < 6) t1 = 6;
    AT_LOAD_TILE(ti, kA0, kA1, vA0, vA1);
    if (t1 < 10) AT_LOAD_TILE(t1, kB0, kB1, vB0, vB1);
    while (true) {
#pragma unroll
     for (int half = 0; half < 2; ++half) {
      __syncthreads();
      if (half == 0) AT_STORE_TILE(kA0, kA1, vA0, vA1); else AT_STORE_TILE(kB0, kB1, vB0, vB1);
      __syncthreads();
      int t2 = t1 + 1;
      if (t2 > lastlocal && t2 < 6) t2 = 6;
      if (t1 >= 10) t2 = 10;
      if (t2 < 10) { if (half == 0) AT_LOAD_TILE(t2, kA0, kA1, vA0, vA1); else AT_LOAD_TILE(t2, kB0, kB1, vB0, vB1); }
      const int q0w = nblk * 128 + (wid & 3) * 32;
      const int kp0 = 128 * (nblk - 1) + 64 * ti;
      if (!(ti < 6 && (kp0 > q0w + 31 + 128 || kp0 + 63 < q0w - 128))) {
        const bool local = ti < 6;
        const int kpos0 = 128 * (nblk - 1) + 64 * ti;
        f32x16 S[2];
#pragma unroll
        for (int ks = 0; ks < 2; ++ks) {
#pragma unroll
          for (int i = 0; i < 16; ++i) S[ks][i] = 0.f;
#pragma unroll
          for (int st = 0; st < 8; ++st) {
            bfx8 A = *(const bfx8*)(Ks + (ks * 32 + r) * AT_KROW + (16 * st + 8 * h) * 2);
            S[ks] = __builtin_amdgcn_mfma_f32_32x32x16_bf16(A, Q[st], S[ks], 0, 0, 0);
          }
        }
        const bool needmask = local && (kp0 > q0w + 65 || kp0 < q0w - 97);
        float mraw = -1e30f;
        if (needmask) {
          const int relb = kpos0 + 4 * h - qs;
#pragma unroll
          for (int ks = 0; ks < 2; ++ks)
#pragma unroll
            for (int i = 0; i < 16; ++i) {
              const int rel = relb + ks * 32 + (i & 3) + 8 * (i >> 2);
              float sv = S[ks][i];
              if (rel > 128 || rel < -128) sv = -1e30f;
              S[ks][i] = sv;
              mraw = fmaxf(mraw, sv);
            }
        } else {
#pragma unroll
          for (int ks = 0; ks < 2; ++ks)
#pragma unroll
            for (int i = 0; i < 16; ++i) mraw = fmaxf(mraw, S[ks][i]);
        }
        float mx = fmaxf(m, mraw * sl2);
        mx = fmaxf(mx, __shfl_xor(mx, 32, 64));
        if (__builtin_amdgcn_ballot_w64(mx != m) != 0ull) {
          const float alpha = __builtin_amdgcn_exp2f(m - mx);
          m = mx;
          l *= alpha;
#pragma unroll
          for (int dt = 0; dt < 4; ++dt)
#pragma unroll
            for (int i = 0; i < 16; ++i) O[dt][i] *= alpha;
        }
#pragma unroll
        for (int ks = 0; ks < 2; ++ks)
#pragma unroll
          for (int i = 0; i < 16; ++i) {
            float pv = __builtin_amdgcn_exp2f(__builtin_fmaf(S[ks][i], sl2, -m));
            l += pv;
            S[ks][i] = pv;
          }
#pragma unroll
        for (int s4 = 0; s4 < 4; ++s4) {
          const int ks = s4 >> 1, hf = s4 & 1;
          pg8::u32x4 pk;
#pragma unroll
          for (int j = 0; j < 4; ++j)
            pk[j] = pk2(S[ks][8 * hf + 2 * j], S[ks][8 * hf + 2 * j + 1]);
          bfx8 P = __builtin_bit_cast(bfx8, pk);
#pragma unroll
          for (int dt = 0; dt < 4; ++dt) {
            const char* vp = Vs + (dt * 32 + r) * AT_VROW + (32 * ks + 16 * hf + 4 * h) * 2;
            uint2 v0 = *(const uint2*)vp, v1 = *(const uint2*)(vp + 16);
            pg8::u32x4 vv; vv[0] = v0.x; vv[1] = v0.y; vv[2] = v1.x; vv[3] = v1.y;
            O[dt] = __builtin_amdgcn_mfma_f32_32x32x16_bf16(__builtin_bit_cast(bfx8, vv), P, O[dt], 0, 0, 0);
          }
        }
      }
      if (t1 >= 10) goto attn_done;
      ti = t1; t1 = t2;
     }
    }
    attn_done:;
    const float ltot = l + __shfl_xor(l, 32, 64);
    const float inv = 1.f / ltot;
    const size_t tok = (size_t)(b * 2048 + qs);
#pragma unroll
    for (int dt = 0; dt < 4; ++dt)
#pragma unroll
      for (int g4 = 0; g4 < 4; ++g4) {
        const int d = dt * 32 + 8 * g4 + 4 * h;
        uint2 gg = *(const uint2*)(px + tok * 5120 + 3072 + hq * 128 + d);
        float o0 = O[dt][4 * g4 + 0] * inv * siluf(bflo(gg.x));
        float o1 = O[dt][4 * g4 + 1] * inv * siluf(bfhi(gg.x));
        float o2 = O[dt][4 * g4 + 2] * inv * siluf(bflo(gg.y));
        float o3 = O[dt][4 * g4 + 3] * inv * siluf(bfhi(gg.y));
        uint2 pk;
        pk.x = pk2(o0, o1);
        pk.y = pk2(o2, o3);
        *(uint2*)(og + tok * 2048 + hq * 128 + d) = pk;
      }
  }
}

#define XB_TMO      128
#define XB_XCNT(j)  (256  + 64 * (j))
#define XB_XSUB(j)  (1280 + 64 * (j))
#define XB_XGEN(j)  (2304 + 64 * (j))
#define XB_TOP      3328
#define XB_TOPGEN   3392
#define XCD_BAR_WORDS 3456
#define XB_SPIN_CAP (1u << 18)
#define LAS __attribute__((address_space(3)))

__device__ __forceinline__ unsigned xb_ld(unsigned* p)              { return __hip_atomic_load(p, __ATOMIC_RELAXED, __HIP_MEMORY_SCOPE_AGENT); }
__device__ __forceinline__ unsigned xb_add(unsigned* p, unsigned v) { return __hip_atomic_fetch_add(p, v, __ATOMIC_RELAXED, __HIP_MEMORY_SCOPE_AGENT); }
__device__ __forceinline__ unsigned xb_xcc_id() { return (unsigned)__builtin_amdgcn_s_getreg((3 << 11) | 20) & 0xFu; }
#define XB_SPIN(cond, bar) do { unsigned _sp = 0; while (cond) { __builtin_amdgcn_s_sleep(1); \
    if ((++_sp & 255u) == 0u) { if (xb_ld(&(bar)[XB_TMO])) break; if (_sp > XB_SPIN_CAP) { atomicAdd(&(bar)[XB_TMO], 1u); break; } } } } while (0)

struct XcdBarrier {
    unsigned* bar; unsigned x;
    volatile LAS unsigned* st;
};

__device__ __forceinline__ XcdBarrier xcd_barrier_post(unsigned* bar, volatile LAS unsigned* st) {
    XcdBarrier b; b.bar = bar; b.x = xb_xcc_id(); b.st = st;
    if (threadIdx.x == 0) (void)xb_add(&bar[XB_XCNT(b.x)], 1u);
    return b;
}
__device__ __forceinline__ void xcd_barrier_complete(unsigned* bar, unsigned x, unsigned& nloc, unsigned& nx) {
    const unsigned G = gridDim.x * gridDim.y * gridDim.z;
    unsigned sum, cnt, mine, sp = 0u;
    for (;;) {
        sum = 0u; cnt = 0u; mine = 0u;
#pragma unroll
        for (unsigned j = 0; j < 16; ++j) { const unsigned c = xb_ld(&bar[XB_XCNT(j)]); sum += c; cnt += (c > 0u) ? 1u : 0u; mine = (j == x) ? c : mine; }
        if (sum == G) break;
        __builtin_amdgcn_s_sleep(1);
        if ((++sp & 255u) == 0u) { if (xb_ld(&bar[XB_TMO])) break; if (sp > XB_SPIN_CAP) { atomicAdd(&bar[XB_TMO], 1u); break; } }
    }
    nloc = mine > 0u ? mine : 1u; nx = cnt > 0u ? cnt : 1u;
}

__device__ __forceinline__ void xcd_barrier(const XcdBarrier& b) {
    asm volatile("s_waitcnt vmcnt(0)" ::: "memory");
    __syncthreads();
    if (threadIdx.x == 0) {
        unsigned* bar = b.bar;
        __builtin_amdgcn_s_waitcnt(0);
        unsigned nloc = b.st[0], nx = b.st[1];
        if (nloc == 0u) { xcd_barrier_complete(bar, b.x, nloc, nx); b.st[0] = nloc; b.st[1] = nx; }
        const unsigned old = xb_add(&bar[XB_XSUB(b.x)], 1u);
        const unsigned gen = old / nloc;
        if (old + 1u == (gen + 1u) * nloc) {
            __builtin_amdgcn_fence(__ATOMIC_RELEASE, "agent");
            asm volatile("s_waitcnt vmcnt(0)" ::: "memory");
            const unsigned og = xb_add(&bar[XB_TOP], 1u);
            const unsigned tg = og / nx;
            if (og + 1u == (tg + 1u) * nx) xb_add(&bar[XB_TOPGEN], 1u);
            else XB_SPIN(xb_ld(&bar[XB_TOPGEN]) == tg, bar);
            __builtin_amdgcn_fence(__ATOMIC_ACQUIRE, "agent");
            xb_add(&bar[XB_XGEN(b.x)], 1u);
            asm volatile("s_waitcnt vmcnt(0)" ::: "memory");
        } else {
            XB_SPIN(xb_ld(&bar[XB_XGEN(b.x)]) == gen, bar);
            __builtin_amdgcn_fence(__ATOMIC_ACQUIRE, "agent");
            asm volatile("s_waitcnt vmcnt(0)" ::: "memory");
        }
    }
    __syncthreads();
}


constexpr int N_PHASES = 9;
__global__ void __launch_bounds__(NTHREADS, 2) mega(Params p, int ph0, int ph1) {
  extern __shared__ __attribute__((aligned(16))) float sm[];
  volatile LAS unsigned* xb_st = (volatile LAS unsigned*)((LAS unsigned char*)sm + 162816);
  if (threadIdx.x < 4) xb_st[threadIdx.x] = 0u;
  __syncthreads();
  const XcdBarrier xb = xcd_barrier_post((unsigned*)(p.ws + OFF_BAR), xb_st);
#define PH(i, body) if (ph0 <= (i) && (i) < ph1) { body; if ((i) + 1 < ph1) xcd_barrier(xb); }
  if (ph0 < 0) cg::this_grid().sync();
  PH(0, phase0(p, sm))
  PH(1, phase_norm(p, 0))
  PH(2, run_gemm(sm, (const u16*)(p.ws + OFF_ACT), (const u16*)(p.ws + OFF_WT_AI), MT, ATTN_IN,
                 EpiAttnIn{(u16*)(p.ws + OFF_BIG), (const float*)(p.ws + OFF_ROPE)}, (int)blockIdx.x);
        run_gemm(sm, (const u16*)(p.ws + OFF_HC), (const u16*)(p.ws + OFF_WT_AI) + (size_t)2048 * 2048, MC, 1024,
                 EpiRaw{(u16*)(p.ws + OFF_KVC), 1024}, (int)((blockIdx.x + 64) % gridDim.x));
        run_gemm(sm, (const u16*)(p.ws + OFF_WT_AI) + (size_t)2560 * 2048, (const u16*)(p.ws + OFF_ACT), 512, MT,
                 EpiRaw{(u16*)(p.ws + OFF_VT), 8192}, (int)((blockIdx.x + 128) % gridDim.x));
        run_gemm(sm, (const u16*)(p.ws + OFF_WT_AI) + (size_t)2560 * 2048, (const u16*)(p.ws + OFF_HC), 512, MC,
                 EpiRaw{(u16*)(p.ws + OFF_VCT), 1024}, (int)((blockIdx.x + 48) % gridDim.x)))
  PH(3, phase_attn(p, sm))
  PH(4, run_gemm(sm, (const u16*)(p.ws + OFF_ACT), (const u16*)(p.ws + OFF_WT_AO), MT, 2048,
                 EpiResNorm{p.out, p.x, (const float*)(p.ws + OFF_MOD) + 4096, (float*)(p.ws + OFF_ROWSS), (unsigned*)(p.ws + OFF_PCNT),
                            p.norm_g + 2048, (const float*)(p.ws + OFF_MOD) + 5 * 6144, (u16*)(p.ws + OFF_ACT)}, (int)blockIdx.x))
  PH(6, run_gemm(sm, (const u16*)(p.ws + OFF_WT_HI), (const u16*)(p.ws + OFF_ACT), HY_IN, MT,
                 EpiRaw{(u16*)(p.ws + OFF_BIG), 8192}, (int)blockIdx.x))
  PH(7, phase_conv(p, sm))
  PH(8, (run_gemm<EpiResNorm, true>(sm, (const u16*)(p.ws + OFF_ACT), (const u16*)(p.ws + OFF_WT_HO), MT, 2048,
                 EpiResNorm{p.out, p.out, (const float*)(p.ws + OFF_MOD) + 5 * 6144 + 4096, (float*)(p.ws + OFF_ROWSS) + 8192,
                            (unsigned*)(p.ws + OFF_PCNT) + 32 * 64, p.final_g, nullptr, nullptr}, (int)blockIdx.x)))
}

extern "C" void kernel_launch(void* const* d_in, const int* in_sizes, int n_in, void* d_out, int out_size,
                              void* d_ws, size_t ws_size, hipStream_t stream) {
  Params p{};
  const float** f = (const float**)&p;
  for (int i = 0; i < 23; ++i) f[i] = (const float*)d_in[i];
  p.out = (float*)d_out;
  p.ws = (char*)d_ws;
  constexpr size_t kLds = 162816 + 16;
  static int grid_blocks = 0;
  if (!grid_blocks) {
    (void)hipFuncSetAttribute((const void*)mega, hipFuncAttributeMaxDynamicSharedMemorySize, (int)kLds);
    int dev = 0, cus = 0, per_cu = 0;
    (void)hipGetDevice(&dev);
    (void)hipDeviceGetAttribute(&cus, hipDeviceAttributeMultiprocessorCount, dev);
    (void)hipOccupancyMaxActiveBlocksPerMultiprocessor(&per_cu, mega, NTHREADS, kLds);
    if (per_cu < 1) per_cu = 1;
    grid_blocks = cus * per_cu;
  }
  (void)hipMemsetAsync((char*)d_ws + OFF_BAR, 0, ZERO_BYTES, stream);
  int ph0 = 0, ph1 = N_PHASES;
  void* args[] = {(void*)&p, (void*)&ph0, (void*)&ph1};
  hipError_t e = hipLaunchCooperativeKernel((const void*)mega, dim3(grid_blocks), dim3(NTHREADS), args, kLds, stream);
  if (e != hipSuccess) fprintf(stderr, "cooperative launch failed: %s (grid %d)\n", hipGetErrorString(e), grid_blocks);
}
```

```cpp
#include <hip/hip_runtime.h>
#include <hip/hip_bf16.h>
#include <hip/hip_cooperative_groups.h>
#include <cstdio>
namespace cg = cooperative_groups;
typedef unsigned short u16;

#define NTHREADS 512
constexpr int Bn = 4, Sn = 2048, Dn = 2048, Cn = 256;
constexpr int MT = Bn * Sn;
constexpr int MC = Bn * Cn;
constexpr int ATTN_IN = 5120;
constexpr int HY_IN = 8192;

constexpr size_t OFF_WT_AI = 0;
constexpr size_t OFF_WT_AO = OFF_WT_AI + (size_t)5120 * 2048 * 2;
constexpr size_t OFF_WT_HI = OFF_WT_AO + (size_t)2048 * 2048 * 2;
constexpr size_t OFF_WT_HO = OFF_WT_HI + (size_t)8192 * 2048 * 2;
constexpr size_t OFF_MOD   = OFF_WT_HO + (size_t)2048 * 2048 * 2;
constexpr size_t OFF_ROPE  = OFF_MOD + (size_t)2 * 5 * 6144 * 4 + 256;
constexpr size_t OFF_FILT  = OFF_ROPE + (size_t)64 * 32 * 8;
constexpr size_t OFF_ACT   = OFF_FILT + (size_t)2 * 2048 * 4096 * 2;
constexpr size_t OFF_HC    = OFF_ACT + (size_t)8192 * 2048 * 2;
constexpr size_t OFF_KVC   = OFF_HC + (size_t)1024 * 2048 * 2;
constexpr size_t OFF_VT    = OFF_KVC + (size_t)1024 * 1024 * 2;
constexpr size_t OFF_VCT   = OFF_VT + (size_t)512 * 8192 * 2;
constexpr size_t OFF_BIG   = OFF_VCT + (size_t)512 * 1024 * 2;

constexpr size_t OFF_BAR   = OFF_BIG + (size_t)8192 * 8192 * 2;

constexpr size_t OFF_ROWSS = OFF_BAR + 16384;
constexpr size_t OFF_PCNT  = OFF_ROWSS + (size_t)2 * 8192 * 4;
constexpr size_t ZERO_BYTES = 16384 + (size_t)2 * 8192 * 4 + (size_t)2 * 32 * 64 * 4;

struct Params {
  const float *x, *c, *ctx, *c_ctx, *norm_g, *ada_w, *ada_b, *attn_w_in, *attn_w_out, *attn_sink;
  const float *hy_w_in, *hy_conv_w, *hy_conv_b, *hy_w1, *hy_b1, *hy_w2, *hy_b2, *hy_w3, *hy_b3;
  const float *hy_freq, *hy_bias_d, *hy_w_out, *final_g;
  float* out;
  char* ws;
};

__device__ __forceinline__ u16 f2bf(float f) {
  unsigned u = __float_as_uint(f);
  u += 0x7fffu + ((u >> 16) & 1u);
  return (u16)(u >> 16);
}
__device__ __forceinline__ float bf2f(u16 h) { return __uint_as_float(((unsigned)h) << 16); }
__device__ __forceinline__ unsigned pk2(float lo, float hi) { unsigned r; asm("v_cvt_pk_bf16_f32 %0, %1, %2" : "=v"(r) : "v"(lo), "v"(hi)); return r; }
__device__ __forceinline__ float bflo(unsigned w) { return __uint_as_float(w << 16); }
__device__ __forceinline__ float bfhi(unsigned w) { return __uint_as_float(w & 0xffff0000u); }
__device__ __forceinline__ float siluf(float v) { return v / (1.f + __expf(-v)); }
__device__ __forceinline__ float wave_sum(float v) {
#pragma unroll
  for (int o = 32; o > 0; o >>= 1) v += __shfl_xor(v, o, 64);
  return v;
}
__device__ __forceinline__ float wave_max(float v) {
#pragma unroll
  for (int o = 32; o > 0; o >>= 1) v = fmaxf(v, __shfl_xor(v, o, 64));
  return v;
}

__device__ __forceinline__ void p0_convert(const float* __restrict__ W, u16* __restrict__ Wt, int N, int tk, int tn,
                           bool perm, float* sm) {
  const int tid = threadIdx.x;
  for (int i = tid; i < 64 * 32; i += NTHREADS) {
    int r = i >> 5, c4 = i & 31;
    float4 v = *(const float4*)(W + (size_t)(tk * 64 + r) * N + tn * 128 + c4 * 4);
    float* d = sm + r * 129 + c4 * 4;
    d[0] = v.x; d[1] = v.y; d[2] = v.z; d[3] = v.w;
  }
  __syncthreads();
  for (int i = tid; i < 128 * 8; i += NTHREADS) {
    int nrow = i >> 3, kc = i & 7;
    int src = nrow;
    if (perm && (tn * 128 < 2560)) {
      int g = nrow >> 5, nn = (nrow >> 4) & 1, fr = nrow & 15;
      src = (g >> 1) * 64 + nn * 32 + (g & 1) * 16 + fr;
    }
    unsigned w[4];
#pragma unroll
    for (int j = 0; j < 4; ++j) {
      float a = sm[(kc * 8 + 2 * j) * 129 + src];
      float b = sm[(kc * 8 + 2 * j + 1) * 129 + src];
      w[j] = pk2(a, b);
    }
    *(uint4*)(Wt + (size_t)(tn * 128 + nrow) * 2048 + tk * 64 + kc * 8) = make_uint4(w[0], w[1], w[2], w[3]);
  }
  __syncthreads();
}

__device__ __forceinline__ void p0_adaln(const Params& p, int item, float* sm) {
  const int tid = threadIdx.x;
  float* sv = sm;
  float* red = sm + 5 * 2048;
  int col0 = item * 48;
  int l = col0 / 6144, n0 = col0 % 6144;
  for (int i = tid; i < 5 * 2048; i += NTHREADS) {
    int v = i >> 11, k = i & 2047;
    float cv = v < 4 ? p.c[v * 2048 + k] : p.c_ctx[k];
    sv[i] = cv / (1.f + expf(-cv));
  }
  __syncthreads();
  int kg = tid / 12, cq = tid % 12;
  float acc[5][4];
#pragma unroll
  for (int v = 0; v < 5; ++v)
#pragma unroll
    for (int j = 0; j < 4; ++j) acc[v][j] = 0.f;
  if (kg < 42) {
    const float* W = p.ada_w + (size_t)l * 2048 * 6144 + n0 + cq * 4;
#pragma unroll 8
    for (int k = kg; k < 2048; k += 42) {
      float4 w = *(const float4*)(W + (size_t)k * 6144);
#pragma unroll
      for (int v = 0; v < 5; ++v) {
        float s = sv[v * 2048 + k];
        acc[v][0] += s * w.x; acc[v][1] += s * w.y; acc[v][2] += s * w.z; acc[v][3] += s * w.w;
      }
    }
  }
  if (kg >= 21 && kg < 42) {
#pragma unroll
    for (int v = 0; v < 5; ++v)
#pragma unroll
      for (int j = 0; j < 4; ++j) red[((kg - 21) * 5 + v) * 48 + cq * 4 + j] = acc[v][j];
  }
  __syncthreads();
  if (kg < 21) {
#pragma unroll
    for (int v = 0; v < 5; ++v)
#pragma unroll
      for (int j = 0; j < 4; ++j) red[(kg * 5 + v) * 48 + cq * 4 + j] += acc[v][j];
  }
  __syncthreads();
  if (tid < 240) {
    int v = tid / 48, cc = tid % 48;
    float s = 0.f;
    for (int g = 0; g < 21; ++g) s += red[(g * 5 + v) * 48 + cc];
    float* mod = (float*)(p.ws + OFF_MOD);
    mod[(l * 5 + v) * 6144 + n0 + cc] = s + p.ada_b[l * 6144 + n0 + cc];
  }
  __syncthreads();
}

__device__ __forceinline__ void p0_rope(const Params& p) {
  float2* rope = (float2*)(p.ws + OFF_ROPE);
  for (int i = threadIdx.x; i < 64 * 32; i += NTHREADS) {
    int pos = i >> 5, j = i & 31;
    float inv = powf(10000.f, -(float)(2 * j) / 64.f);
    float ang = (float)pos * inv;
    rope[i] = make_float2(cosf(ang), sinf(ang));
  }
}

typedef short bf16x8_t __attribute__((ext_vector_type(8)));
typedef unsigned u32x4_t __attribute__((ext_vector_type(4)));
typedef float f32x16_t __attribute__((ext_vector_type(16)));
__device__ __forceinline__ void split8(const float (&v)[8], bf16x8_t& hi, bf16x8_t& lo) {
  u32x4_t H, L;
#pragma unroll
  for (int j = 0; j < 4; ++j) {
    const u16 h0 = f2bf(v[2 * j]), h1 = f2bf(v[2 * j + 1]);
    const float r0 = v[2 * j] - bf2f(h0), r1 = v[2 * j + 1] - bf2f(h1);
    H[j] = (unsigned)h0 | ((unsigned)h1 << 16);
    L[j] = pk2(r0, r1);
  }
  hi = __builtin_bit_cast(bf16x8_t, H);
  lo = __builtin_bit_cast(bf16x8_t, L);
}
__device__ __forceinline__ void p0_filter(const Params& p, int item, float* sm) {
  int tid = threadIdx.x;
  asm volatile("" : "+v"(tid));
  const int lane = tid & 63, wid = tid >> 6, r = lane & 31, h = lane >> 5;
  const int cc = item & 15, pg = item >> 4;
  float* z = sm;
  float* h1 = z + 128 * 36;
  float* h2 = h1 + 128 * 64;
  for (int i = tid; i < 128 * 33; i += NTHREADS) {
    int pos = i / 33, e = i % 33;
    int t = pg * 128 + pos;
    float val;
    if (e == 0) val = (float)t / 2047.f;
    else {
      int bi = (e - 1) & 15;
      float w = 6.283185307179586f * (float)t / 2048.f;
      float fr = 1e-4f + (float)bi * ((15.f - 1e-4f) / 15.f);
      float ang = w * fr;
      val = (e <= 16) ? cosf(ang) : -sinf(ang);
    }
    z[pos * 36 + e] = val;
  }
  __syncthreads();
  {
    const int j = lane;
    float w1r[33];
#pragma unroll
    for (int e = 0; e < 33; ++e) w1r[e] = p.hy_w1[e * 64 + j];
    const float fq = p.hy_freq[j], b1 = p.hy_b1[j];
#pragma unroll 1
    for (int q = 0; q < 16; ++q) {
      const int pos = wid * 16 + q;
      const float4* zp = (const float4*)(z + pos * 36);
      float a = b1;
#pragma unroll
      for (int e4 = 0; e4 < 8; ++e4) {
        float4 zv = zp[e4];
        a += zv.x * w1r[4 * e4] + zv.y * w1r[4 * e4 + 1] + zv.z * w1r[4 * e4 + 2] + zv.w * w1r[4 * e4 + 3];
      }
      a += z[pos * 36 + 32] * w1r[32];
      h1[pos * 64 + j] = __sinf(fq * a);
    }
  }
  __syncthreads();
  {
    const int j = lane;
    float w2r[64];
#pragma unroll
    for (int e = 0; e < 64; ++e) w2r[e] = p.hy_w2[e * 64 + j];
    const float fq = p.hy_freq[j], b2 = p.hy_b2[j];
#pragma unroll 1
    for (int q = 0; q < 16; ++q) {
      const int pos = wid * 16 + q;
      const float4* hp = (const float4*)(h1 + pos * 64);
      float a = b2;
#pragma unroll
      for (int e4 = 0; e4 < 16; ++e4) {
        float4 hv = hp[e4];
        a += hv.x * w2r[4 * e4] + hv.y * w2r[4 * e4 + 1] + hv.z * w2r[4 * e4 + 2] + hv.w * w2r[4 * e4 + 3];
      }
      h2[pos * 68 + j] = __sinf(fq * a);
    }
  }
  __syncthreads();
  const int colw = cc * 512 + wid * 64;
  bf16x8_t Ahi[2][4], Alo[2][4];
#pragma unroll
  for (int ct = 0; ct < 2; ++ct)
#pragma unroll
    for (int ks = 0; ks < 4; ++ks) {
      float v[8];
#pragma unroll
      for (int j = 0; j < 8; ++j) v[j] = p.hy_w3[(size_t)(16 * ks + 8 * h + j) * 8192 + colw + ct * 32 + r];
      split8(v, Ahi[ct][ks], Alo[ct][ks]);
    }
  const int o = cc >> 3, dir = (cc >> 2) & 1;
  u16* Rg = (u16*)(p.ws + OFF_FILT) + (size_t)o * 2048 * 4096;
  const float min_decay = -3.0701134573253945f, max_decay = -15.350567286626972f;
#pragma unroll 1
  for (int pp = 0; pp < 2; ++pp) {
    f32x16_t acc[2][2];
#pragma unroll
    for (int ct = 0; ct < 2; ++ct)
#pragma unroll
      for (int q = 0; q < 2; ++q)
#pragma unroll
        for (int i = 0; i < 16; ++i) acc[ct][q][i] = 0.f;
#pragma unroll
    for (int q = 0; q < 2; ++q)
#pragma unroll
      for (int ks = 0; ks < 4; ++ks) {
        const float* hp = h2 + ((pp * 2 + q) * 32 + r) * 68 + 16 * ks + 8 * h;
        float4 x0 = *(const float4*)hp, x1 = *(const float4*)(hp + 4);
        float v[8] = {x0.x, x0.y, x0.z, x0.w, x1.x, x1.y, x1.z, x1.w};
        bf16x8_t Bhi, Blo;
        split8(v, Bhi, Blo);
#pragma unroll
        for (int ct = 0; ct < 2; ++ct) {
          acc[ct][q] = __builtin_amdgcn_mfma_f32_32x32x16_bf16(Ahi[ct][ks], Bhi, acc[ct][q], 0, 0, 0);
          acc[ct][q] = __builtin_amdgcn_mfma_f32_32x32x16_bf16(Ahi[ct][ks], Blo, acc[ct][q], 0, 0, 0);
          acc[ct][q] = __builtin_amdgcn_mfma_f32_32x32x16_bf16(Alo[ct][ks], Bhi, acc[ct][q], 0, 0, 0);
        }
      }
    int hh = h;
    asm volatile("" : "+v"(hh));
#pragma unroll
    for (int ct = 0; ct < 2; ++ct)
#pragma unroll
      for (int i = 0; i < 16; ++i) {
        const int col = colw + ct * 32 + (i & 3) + 8 * (i >> 2) + 4 * hh;
        const int ch = col & 2047;
        const float b3 = p.hy_b3[col];
        const float ad = fabsf(min_decay + (float)ch * ((max_decay - min_decay) / 2047.f));
        u16* R = Rg + (size_t)ch * 4096;
#pragma unroll
        for (int q = 0; q < 2; ++q) {
          const int t = pg * 128 + (pp * 2 + q) * 32 + r;
          const float tn = (float)t / 2047.f;
          float v = (acc[ct][q][i] + b3) * (__expf(-tn * ad) + 0.05f);
          if (dir == 0) {
            if (t == 0) v += p.hy_bias_d[o * 2048 + ch];
            R[2048 - t] = f2bf(v);
          } else {
            if (t > 0) R[2048 + t] = f2bf(v);
            else R[0] = 0;
          }
        }
      }
  }
  __syncthreads();
}

constexpr int N_CV_AI = 16 * 40, N_CV_AO = 16 * 16, N_CV_HI = 16 * 64, N_CV_HO = 16 * 16;
constexpr int N_CV = N_CV_AI + N_CV_AO + N_CV_HI + N_CV_HO;
#define CV_DECODE(I, W_, Wt_, N_, tk_, tn_, perm_) do { int _i = (I); \
    const bool _a = _i < N_CV_AI, _b2 = _i < N_CV_AI + N_CV_AO, _c = _i < N_CV_AI + N_CV_AO + N_CV_HI; \
    W_ = _a ? p.attn_w_in : (_b2 ? p.attn_w_out : (_c ? p.hy_w_in : p.hy_w_out)); \
    Wt_ = (u16*)(p.ws + (_a ? OFF_WT_AI : (_b2 ? OFF_WT_AO : (_c ? OFF_WT_HI : OFF_WT_HO)))); \
    N_ = _a ? 5120 : (_b2 ? 2048 : (_c ? 8192 : 2048)); \
    const int _nt = _a ? 40 : (_b2 ? 16 : (_c ? 64 : 16)); \
    _i -= _a ? 0 : (_b2 ? N_CV_AI : (_c ? N_CV_AI + N_CV_AO : N_CV_AI + N_CV_AO + N_CV_HI)); \
    tk_ = _i / _nt; tn_ = _i - tk_ * _nt; perm_ = _a && (tn_ * 128 < 2560); } while (0)
__device__ __forceinline__ void p0_convert_all(const Params& p, float* sm) {
  const int tid = threadIdx.x;
  float4 r0, r1, r2, r3, r4, r5, r6, r7;
#define CV_LOAD(W_, N_, tk_, tn_) do { const float* _b = (W_) + (size_t)((tk_) * 128 + (tid >> 5)) * (N_) + (tn_) * 128 + (tid & 31) * 4; const size_t _s = (size_t)16 * (N_); \
    r0 = *(const float4*)(_b); r1 = *(const float4*)(_b + _s); r2 = *(const float4*)(_b + 2 * _s); r3 = *(const float4*)(_b + 3 * _s); \
    r4 = *(const float4*)(_b + 4 * _s); r5 = *(const float4*)(_b + 5 * _s); r6 = *(const float4*)(_b + 6 * _s); r7 = *(const float4*)(_b + 7 * _s); } while (0)
#define CV_PUT(R, I) do { float* _d = sm + ((tid >> 5) + 16 * (I)) * 129 + (tid & 31) * 4; _d[0] = (R).x; _d[1] = (R).y; _d[2] = (R).z; _d[3] = (R).w; } while (0)
  int it = blockIdx.x;
  const float* cW; u16* cWt; int cN, ctk, ctn; bool cperm;
  CV_DECODE(it < N_CV ? it : 0, cW, cWt, cN, ctk, ctn, cperm);
  if (it < N_CV) CV_LOAD(cW, cN, ctk, ctn);
  while (it < N_CV) {
    __syncthreads();
    CV_PUT(r0, 0); CV_PUT(r1, 1); CV_PUT(r2, 2); CV_PUT(r3, 3); CV_PUT(r4, 4); CV_PUT(r5, 5); CV_PUT(r6, 6); CV_PUT(r7, 7);
    __syncthreads();
    const int nit = it + gridDim.x;
    const float* nW; u16* nWt; int nN, ntk, ntn; bool nperm;
    CV_DECODE(nit < N_CV ? nit : 0, nW, nWt, nN, ntk, ntn, nperm);
    if (nit < N_CV) CV_LOAD(nW, nN, ntk, ntn);
    const int row = (tid & 15) | (((tid >> 6) & 7) << 4);
    int src = row;
    if (cperm) { const int g = row >> 5, w = row & 31, i16 = 4 * (w >> 3) + (w & 3), nn = (w >> 2) & 1; src = (g >> 1) * 64 + nn * 32 + (g & 1) * 16 + i16; }
#pragma unroll
    for (int i = 0; i < 4; ++i) {
      const int kch = ((tid >> 4) & 3) | (i << 2);
      unsigned w[4];
#pragma unroll
      for (int j = 0; j < 4; ++j) {
        float a = sm[(kch * 8 + 2 * j) * 129 + src];
        float b = sm[(kch * 8 + 2 * j + 1) * 129 + src];
        w[j] = pk2(a, b);
      }
      *(uint4*)(cWt + (size_t)(ctn * 128 + row) * 2048 + ctk * 128 + kch * 8) = make_uint4(w[0], w[1], w[2], w[3]);
    }
    cW = nW; cWt = nWt; cN = nN; ctk = ntk; ctn = ntn; cperm = nperm;
    it = nit;
  }
#undef CV_LOAD
#undef CV_PUT
}

__device__ __forceinline__ void phase0(const Params& p, float* sm) {
  for (int it = blockIdx.x; it < 256; it += gridDim.x) p0_adaln(p, it, sm);
  if (blockIdx.x == gridDim.x - 1) p0_rope(p);
  __syncthreads();
  for (int it = blockIdx.x; it < 256; it += gridDim.x) p0_filter(p, it, sm);
  __syncthreads();
  p0_convert_all(p, sm);
}

__device__ __forceinline__ void norm_row(const float* __restrict__ src, const float* __restrict__ g, const float* shift,
                         const float* scale, u16* dst_bf, float* dst_f, int lane) {
  float4 v[8];
  float ss = 0.f;
#pragma unroll
  for (int j = 0; j < 8; ++j) {
    v[j] = *(const float4*)(src + (j * 64 + lane) * 4);
    ss += v[j].x * v[j].x + v[j].y * v[j].y + v[j].z * v[j].z + v[j].w * v[j].w;
  }
  ss = wave_sum(ss);
  float r = rsqrtf(ss * (1.f / 2048.f) + 1e-6f);
#pragma unroll
  for (int j = 0; j < 8; ++j) {
    int c = (j * 64 + lane) * 4;
    float4 gg = *(const float4*)(g + c);
    float4 o = make_float4(v[j].x * r * gg.x, v[j].y * r * gg.y, v[j].z * r * gg.z, v[j].w * r * gg.w);
    if (dst_bf) {
      float4 sh = *(const float4*)(shift + c);
      float4 sc = *(const float4*)(scale + c);
      o.x = o.x * (1.f + sc.x) + sh.x; o.y = o.y * (1.f + sc.y) + sh.y;
      o.z = o.z * (1.f + sc.z) + sh.z; o.w = o.w * (1.f + sc.w) + sh.w;
      uint2 pk;
      pk.x = pk2(o.x, o.y);
      pk.y = pk2(o.z, o.w);
      *(uint2*)(dst_bf + c) = pk;
    } else {
      *(float4*)(dst_f + c) = o;
    }
  }
}

__device__ __forceinline__ void phase_norm(const Params& p, int mode) {
  const int wid = threadIdx.x >> 6, lane = threadIdx.x & 63;
  const float* mod = (const float*)(p.ws + OFF_MOD);
  int nrows = (mode == 0) ? (MT + MC) : MT;
  for (int row = blockIdx.x * 8 + wid; row < nrows; row += gridDim.x * 8) {
    if (mode == 0) {
      if (row < MT) {
        int b = row >> 11;
        const float* m = mod + (0 * 5 + b) * 6144;
        norm_row(p.x + (size_t)row * 2048, p.norm_g, m, m + 2048, (u16*)(p.ws + OFF_ACT) + (size_t)row * 2048, nullptr, lane);
      } else {
        int rc = row - MT;
        const float* m = mod + (0 * 5 + 4) * 6144;
        norm_row(p.ctx + (size_t)rc * 2048, p.norm_g, m, m + 2048, (u16*)(p.ws + OFF_HC) + (size_t)rc * 2048, nullptr, lane);
      }
    } else if (mode == 1) {
      int b = row >> 11;
      const float* m = mod + (1 * 5 + b) * 6144;
      norm_row(p.out + (size_t)row * 2048, p.norm_g + 2048, m, m + 2048, (u16*)(p.ws + OFF_ACT) + (size_t)row * 2048, nullptr, lane);
    } else {
      norm_row(p.out + (size_t)row * 2048, p.final_g, nullptr, nullptr, nullptr, p.out + (size_t)row * 2048, lane);
    }
  }
}

namespace pg8 {
#define PG8_LAS __attribute__((address_space(3)))
typedef unsigned short bf16_t;
typedef short bf16x8 __attribute__((ext_vector_type(8)));
typedef float f32x4 __attribute__((ext_vector_type(4)));
typedef unsigned u32x4 __attribute__((ext_vector_type(4)));
constexpr int BM = 256, BK = 64, HALF = 128, HTB = HALF * BK * 2  , STAGE_BYTES = 8 * HTB, NXCD = 8, WGM = 8;

__host__ __device__ __forceinline__ int lds_byte(int r, int c) { const int st = (r >> 4) * 2 + (c >> 5), rr = r & 15, cc = c & 31, ob = rr * 64 + cc * 2; return st * 1024 + (ob ^ (((ob >> 9) & 1) << 5)); }
__host__ __device__ __forceinline__ void stage_rc(int b, int& R, int& C) { const int st = b / 1024, sb = b % 1024, swz = sb ^ (((sb >> 9) & 1) << 5); R = (st >> 1) * 16 + swz / 64; C = (st & 1) * 32 + (swz % 64) / 2; }
__host__ __device__ __forceinline__ int perm32(int rho) { const int n = rho >> 4, i = rho & 15; return 8 * (i >> 2) + 4 * n + (i & 3); }

struct Unit { int pm, pn; };
struct Gemm { const bf16_t* A; const bf16_t* Bt; int M, N, K; int agroup; };

struct StaticOrder {
    int nM, nN, nwg, G, c;
    __host__ __device__ void init(int M, int N, int G_, int c_) { nM = M / BM; nN = N / BM; nwg = nM * nN; G = G_; c = c_; }
    __host__ __device__ bool next(int i, Unit& u) const {
        const long L = (long)i * G + c; if (L >= nwg) return false;
        int wgid = (int)L; { const int q = nwg / NXCD, r = nwg % NXCD, xcd = wgid % NXCD, off = wgid / NXCD; wgid = (xcd < r ? xcd * (q + 1) : r * (q + 1) + (xcd - r) * q) + off; }
        const int nig = WGM * nN, gid = wgid / nig, fm = gid * WGM, gsz = (nM - fm) < WGM ? (nM - fm) : WGM;
        u.pm = fm + ((wgid % nig) % gsz); u.pn = (wgid % nig) / gsz; return true;
    }
    __device__ __forceinline__ void a_ready(const Unit&) const {}
    __device__ __forceinline__ void done(const Unit&) const {}
};
__device__ __forceinline__ unsigned cvt_pk_bf16(float lo, float hi) { unsigned r; asm volatile("v_cvt_pk_bf16_f32 %0, %1, %2" : "=v"(r) : "v"(lo), "v"(hi)); return r; }
template <class Epi, class Sched, bool AGROUP = false>
__device__ __forceinline__ void gemm_phase(PG8_LAS unsigned char* lds, const Gemm g, const Sched& S, const Epi& E) {
    const int tid = threadIdx.x, wid = __builtin_amdgcn_readfirstlane(tid >> 6), lane = tid & 63, wr = wid >> 2, wc = wid & 3, fr = lane & 15, fq = lane >> 4;
    const int K = g.K, nt = K / BK;
    unsigned voffA[2], voffB[2];
#pragma unroll
    for (int i = 0; i < 2; ++i) { int R, C; stage_rc(tid * 16 + i * 8192, R, C); const int Rb = Epi::PERM ? ((R & ~31) + perm32(R & 31)) : R;
        voffA[i] = AGROUP ? (unsigned)((C >> 3) * g.M + R) * 16u : (unsigned)(R * K + C) * 2u; voffB[i] = (unsigned)(Rb * K + C) * 2u; }
    const size_t kstep = (size_t)(BK * 2);
    const size_t hstep = (size_t)HALF * K * 2;
    const size_t tstep = 2 * hstep;
    const size_t kstepA = AGROUP ? (size_t)(BK / 8) * g.M * 16 : kstep, hstepA = AGROUP ? (size_t)HALF * 16 : hstep, tstepA = 2 * hstepA;
    const unsigned ldsw = (unsigned)wid * 1024u;
    const int aoff = lds_byte(wr * 64 + fr, fq * 8), boff = lds_byte(wc * 32 + fr, fq * 8);
#define PG8_SA(b, h) (((b) * 2 + (h)) * HTB)
#define PG8_SB(b, h) ((4 + (b) * 2 + (h)) * HTB)
#define PG8_STAGE(bufoff, gbase, voff) do { _Pragma("unroll") for (int _i = 0; _i < 2; ++_i) \
        __builtin_amdgcn_global_load_lds((const unsigned*)((const char*)(gbase) + (voff)[_i]), (PG8_LAS unsigned*)(lds + (bufoff) + ldsw + _i * 8192), 16, 0, 0); } while (0)
#define PG8_LDA(dst, b, h) do { _Pragma("unroll") for (int m = 0; m < 4; ++m) _Pragma("unroll") for (int k = 0; k < 2; ++k) dst[m][k] = *(const PG8_LAS bf16x8*)(lds + PG8_SA(b, h) + aoff + m * 2048 + k * 1024); } while (0)
#define PG8_LDB(dst, b, h) do { _Pragma("unroll") for (int n = 0; n < 2; ++n) _Pragma("unroll") for (int k = 0; k < 2; ++k) dst[n][k] = *(const PG8_LAS bf16x8*)(lds + PG8_SB(b, h) + boff + n * 2048 + k * 1024); } while (0)
#define PG8_MMA(ai, bj, At, Bt) do { __builtin_amdgcn_s_setprio(1); _Pragma("unroll") for (int m = 0; m < 4; ++m) _Pragma("unroll") for (int n = 0; n < 2; ++n) _Pragma("unroll") for (int k = 0; k < 2; ++k) \
        acc[ai][bj][m][n] = __builtin_amdgcn_mfma_f32_16x16x32_bf16(Bt[n][k], At[m][k], acc[ai][bj][m][n], 0, 0, 0); __builtin_amdgcn_s_setprio(0); } while (0)
#define PG8_WAIT_V(n) asm volatile("s_waitcnt vmcnt(" #n ")" ::: "memory")
#define PG8_WAIT_L(n) asm volatile("s_waitcnt lgkmcnt(" #n ")" ::: "memory")
#define PG8_BAR __builtin_amdgcn_s_barrier()
#define PG8_SCHED __builtin_amdgcn_sched_barrier(0)
    Unit cur, nxt; int ui = 0;
    if (!S.next(0, cur)) return;
    f32x4 acc[2][2][4][2];
#pragma unroll
    for (int a = 0; a < 2; ++a)
#pragma unroll
        for (int b = 0; b < 2; ++b)
#pragma unroll
            for (int m = 0; m < 4; ++m)
#pragma unroll
                for (int n = 0; n < 2; ++n) acc[a][b][m][n] = (f32x4){0.f, 0.f, 0.f, 0.f};
    bf16x8 At[4][2], B0[2][2], B1[2][2];
    const char* cA = (const char*)g.A + (size_t)cur.pm * tstepA; const char* cB = (const char*)g.Bt + (size_t)cur.pn * tstep;
    S.a_ready(cur);
    PG8_STAGE(PG8_SB(0, 0), cB, voffB); PG8_STAGE(PG8_SA(0, 0), cA, voffA); PG8_STAGE(PG8_SB(0, 1), cB + hstep, voffB); PG8_STAGE(PG8_SA(0, 1), cA + hstepA, voffA);
    if (wr == 1) PG8_BAR;
    PG8_WAIT_V(4); PG8_BAR;
    PG8_STAGE(PG8_SB(1, 0), cB + kstep, voffB); PG8_STAGE(PG8_SA(1, 0), cA + kstepA, voffA); PG8_STAGE(PG8_SB(1, 1), cB + hstep + kstep, voffB);
    PG8_WAIT_V(6); PG8_BAR;
    for (;;) {
        const bool has_next = S.next(ui + 1, nxt);
        const char* nA = has_next ? (const char*)g.A + (size_t)nxt.pm * tstepA : cA; const char* nB = has_next ? (const char*)g.Bt + (size_t)nxt.pn * tstep : cB;
        for (int t = 0; t < nt; t += 2) {
            const bool last = (t == nt - 2);
            const char* a1 = cA + (size_t)(t + 1) * kstepA;
            const char* a2 = last ? nA : cA + (size_t)(t + 2) * kstepA; const char* b2 = last ? nB : cB + (size_t)(t + 2) * kstep;
            const char* a3 = a2 + kstepA; const char* b3 = b2 + kstep;
            if (last && has_next) S.a_ready(nxt);
            PG8_LDB(B0, 0, 0); PG8_SCHED; PG8_LDA(At, 0, 0); PG8_STAGE(PG8_SA(1, 1), a1 + hstepA, voffA);
            PG8_WAIT_L(8); PG8_BAR; PG8_WAIT_L(0); PG8_MMA(0, 0, At, B0); PG8_BAR; PG8_SCHED;
            PG8_LDB(B1, 0, 1); PG8_STAGE(PG8_SB(0, 0), b2, voffB);
            PG8_BAR; PG8_WAIT_L(0); PG8_MMA(0, 1, At, B1); PG8_BAR;
            PG8_LDA(At, 0, 1); PG8_STAGE(PG8_SA(0, 0), a2, voffA);
            PG8_BAR; PG8_WAIT_L(0); PG8_MMA(1, 0, At, B0); PG8_BAR; PG8_SCHED;
            PG8_STAGE(PG8_SB(0, 1), b2 + hstep, voffB);
            PG8_WAIT_V(6); PG8_BAR; PG8_MMA(1, 1, At, B1); PG8_BAR;
            PG8_LDB(B0, 1, 0); PG8_SCHED; PG8_LDA(At, 1, 0); PG8_STAGE(PG8_SA(0, 1), a2 + hstepA, voffA);
            PG8_WAIT_L(8); PG8_BAR; PG8_WAIT_L(0); PG8_MMA(0, 0, At, B0); PG8_BAR; PG8_SCHED;
            PG8_LDB(B1, 1, 1); PG8_STAGE(PG8_SB(1, 0), b3, voffB);
            PG8_BAR; PG8_WAIT_L(0); PG8_MMA(0, 1, At, B1); PG8_BAR;
            PG8_LDA(At, 1, 1); PG8_STAGE(PG8_SA(1, 0), a3, voffA);
            PG8_BAR; PG8_WAIT_L(0); PG8_MMA(1, 0, At, B0); PG8_BAR; PG8_SCHED;
            PG8_STAGE(PG8_SB(1, 1), b3 + hstep, voffB);
            PG8_WAIT_V(6); PG8_BAR; PG8_MMA(1, 1, At, B1); PG8_BAR;
        }
        if constexpr (!Epi::AFTER_DRAIN) { E(acc, cur, wr, wc, fr, fq); S.done(cur); }
        if (!has_next) break;
#pragma unroll
        for (int a = 0; a < 2; ++a)
#pragma unroll
            for (int b = 0; b < 2; ++b)
#pragma unroll
                for (int m = 0; m < 4; ++m)
#pragma unroll
                    for (int n = 0; n < 2; ++n) acc[a][b][m][n] = (f32x4){0.f, 0.f, 0.f, 0.f};
        cur = nxt; cA = nA; cB = nB; ++ui;
    }
    PG8_WAIT_V(0);
    if (wr == 0) PG8_BAR;
    PG8_BAR;
    if constexpr (Epi::AFTER_DRAIN) { E.fused(acc, cur, wr, wc, fr, fq, lds, wid, lane); S.done(cur); }
#undef PG8_SA
#undef PG8_SB
#undef PG8_STAGE
#undef PG8_LDA
#undef PG8_LDB
#undef PG8_MMA
#undef PG8_WAIT_V
#undef PG8_WAIT_L
#undef PG8_BAR
#undef PG8_SCHED
}
}

__device__ __forceinline__ uint2 pack4(pg8::f32x4 v) {
  uint2 r;
  r.x = pk2(v[0], v[1]);
  r.y = pk2(v[2], v[3]);
  return r;
}
struct EpiAttnIn {
  static constexpr bool PERM = true, AFTER_DRAIN = false;
  u16* O; const float* rope;
  __device__ __forceinline__ void operator()(const pg8::f32x4 (&acc)[2][2][4][2], const pg8::Unit& u, int wr, int wc, int fr, int fq) const {
    const int row0 = u.pm * 256 + wr * 64 + fr, col0 = u.pn * 256 + wc * 32 + 8 * fq;
    const bool dorope = (u.pn < 10);
    const int axis = wc >> 1, i0 = (wc & 1) * 16 + 4 * fq;
#pragma unroll
    for (int ai = 0; ai < 2; ++ai)
#pragma unroll
      for (int m = 0; m < 4; ++m) {
        const int row = row0 + ai * 128 + m * 16;
        u16* rowp = O + (size_t)row * 5120 + col0;
        if (dorope) {
          const int s = row & 2047;
          const int pos = axis ? (s & 63) : (s >> 6);
          const float4* rp = (const float4*)(rope + (pos * 32 + i0) * 2);
          float4 c01 = rp[0], c23 = rp[1];
#pragma unroll
          for (int bj = 0; bj < 2; ++bj) {
            pg8::f32x4 a = acc[ai][bj][m][0], b = acc[ai][bj][m][1], o0, o1;
            o0[0] = a[0] * c01.x - b[0] * c01.y; o1[0] = b[0] * c01.x + a[0] * c01.y;
            o0[1] = a[1] * c01.z - b[1] * c01.w; o1[1] = b[1] * c01.z + a[1] * c01.w;
            o0[2] = a[2] * c23.x - b[2] * c23.y; o1[2] = b[2] * c23.x + a[2] * c23.y;
            o0[3] = a[3] * c23.z - b[3] * c23.w; o1[3] = b[3] * c23.z + a[3] * c23.w;
            const uint2 lo = pack4(o0), hi = pack4(o1);
            *(uint4*)(rowp + bj * 128) = make_uint4(lo.x, lo.y, hi.x, hi.y);
          }
        } else {
#pragma unroll
          for (int bj = 0; bj < 2; ++bj) {
            const uint2 lo = pack4(acc[ai][bj][m][0]), hi = pack4(acc[ai][bj][m][1]);
            *(uint4*)(rowp + bj * 128) = make_uint4(lo.x, lo.y, hi.x, hi.y);
          }
        }
      }
  }
};
struct EpiRaw {
  static constexpr bool PERM = true, AFTER_DRAIN = false;
  u16* O; int ldc;
  __device__ __forceinline__ void operator()(const pg8::f32x4 (&acc)[2][2][4][2], const pg8::Unit& u, int wr, int wc, int fr, int fq) const {
    const int row0 = u.pm * 256 + wr * 64 + fr, col0 = u.pn * 256 + wc * 32 + 8 * fq;
#pragma unroll
    for (int ai = 0; ai < 2; ++ai)
#pragma unroll
      for (int m = 0; m < 4; ++m) {
        u16* rowp = O + (size_t)(row0 + ai * 128 + m * 16) * ldc + col0;
#pragma unroll
        for (int bj = 0; bj < 2; ++bj) {
          const uint2 lo = pack4(acc[ai][bj][m][0]), hi = pack4(acc[ai][bj][m][1]);
          *(uint4*)(rowp + bj * 128) = make_uint4(lo.x, lo.y, hi.x, hi.y);
        }
      }
  }
};
struct EpiRes {
  static constexpr bool PERM = false, AFTER_DRAIN = false;
  float* out; const float* base; const float* gate;
  __device__ __forceinline__ void operator()(const pg8::f32x4 (&acc)[2][2][4][2], const pg8::Unit& u, int wr, int wc, int fr, int fq) const {
    const int row0 = u.pm * 256 + wr * 64 + fr, col0 = u.pn * 256 + wc * 32 + 4 * fq;
    const int b = (u.pm * 256) >> 11;
    pg8::f32x4 gv[2][2];
#pragma unroll
    for (int bj = 0; bj < 2; ++bj)
#pragma unroll
      for (int n = 0; n < 2; ++n) gv[bj][n] = *(const pg8::f32x4*)(gate + b * 6144 + col0 + bj * 128 + n * 16);
#pragma unroll
    for (int ai = 0; ai < 2; ++ai)
#pragma unroll
      for (int m = 0; m < 4; ++m) {
        const size_t off = (size_t)(row0 + ai * 128 + m * 16) * 2048 + col0;
#pragma unroll
        for (int bj = 0; bj < 2; ++bj)
#pragma unroll
          for (int n = 0; n < 2; ++n) {
            pg8::f32x4 bv = *(const pg8::f32x4*)(base + off + bj * 128 + n * 16);
            *(pg8::f32x4*)(out + off + bj * 128 + n * 16) = bv + gv[bj][n] * acc[ai][bj][m][n];
          }
      }
  }
};

struct EpiResNorm {
  static constexpr bool PERM = false, AFTER_DRAIN = true;
  float* out; const float* base; const float* gate;
  float* rowss; unsigned* pcnt;
  const float* g; const float* shsc;
  u16* hx;
  static __device__ __forceinline__ int loff(int row, int chunk) { return row * 1024 + ((chunk ^ (row & 63)) << 4); }
  __device__ __forceinline__ void fused(pg8::f32x4 (&acc)[2][2][4][2], const pg8::Unit& u, int wr, int wc, int fr, int fq,
                                        PG8_LAS unsigned char* lds, int wid, int lane) const {
    const int R0 = u.pm * 256, C0 = u.pn * 256;
    const int b = R0 >> 11;
    const int frow = wr * 64 + fr, fchunk = wc * 8 + fq;
    {
      pg8::f32x4 gv[2][2];
#pragma unroll
      for (int bj = 0; bj < 2; ++bj)
#pragma unroll
        for (int n = 0; n < 2; ++n) gv[bj][n] = *(const pg8::f32x4*)(gate + b * 6144 + C0 + wc * 32 + 4 * fq + bj * 128 + n * 16);
#pragma unroll
      for (int ai = 0; ai < 2; ++ai) {
        {
          pg8::f32x4 t[16];
#pragma unroll
          for (int i = 0; i < 16; ++i) t[i] = *(const pg8::f32x4*)(base + (size_t)(R0 + ai * 128 + wid * 16 + i) * 2048 + C0 + 4 * lane);
#pragma unroll
          for (int i = 0; i < 16; ++i) *(PG8_LAS pg8::f32x4*)(lds + loff(wid * 16 + i, lane)) = t[i];
        }
        __syncthreads();
#pragma unroll
        for (int m = 0; m < 4; ++m) {
          float ss = 0.f;
#pragma unroll
          for (int bj = 0; bj < 2; ++bj)
#pragma unroll
            for (int n = 0; n < 2; ++n) {
              const pg8::f32x4 bv = *(const PG8_LAS pg8::f32x4*)(lds + loff(frow + 16 * m, fchunk + 32 * bj + 4 * n));
              const pg8::f32x4 v = bv + gv[bj][n] * acc[ai][bj][m][n];
              acc[ai][bj][m][n] = v;
              ss += v[0] * v[0] + v[1] * v[1] + v[2] * v[2] + v[3] * v[3];
            }
          ss += __shfl_xor(ss, 16, 64);
          ss += __shfl_xor(ss, 32, 64);
          if (fq == 0) unsafeAtomicAdd(rowss + R0 + ai * 128 + frow + 16 * m, ss);
        }
        __syncthreads();
      }
    }
    asm volatile("s_waitcnt vmcnt(0)" ::: "memory");
    __syncthreads();
    if (threadIdx.x == 0) {
      unsigned* c = pcnt + u.pm * 64;
      __hip_atomic_fetch_add(c, 1u, __ATOMIC_RELAXED, __HIP_MEMORY_SCOPE_AGENT);
      unsigned spins = 0;
      while (__hip_atomic_load(c, __ATOMIC_RELAXED, __HIP_MEMORY_SCOPE_AGENT) < 8u && ++spins < (1u << 22)) __builtin_amdgcn_s_sleep(1);
    }
    __syncthreads();
    const pg8::f32x4 gg = *(const pg8::f32x4*)(g + C0 + 4 * lane);
    pg8::f32x4 sh = gg, sc = gg;
    if (hx) {
      sh = *(const pg8::f32x4*)(shsc + b * 6144 + C0 + 4 * lane);
      sc = *(const pg8::f32x4*)(shsc + b * 6144 + 2048 + C0 + 4 * lane) + 1.f;
    }
#pragma unroll
    for (int ai = 0; ai < 2; ++ai) {
#pragma unroll
      for (int m = 0; m < 4; ++m)
#pragma unroll
        for (int bj = 0; bj < 2; ++bj)
#pragma unroll
          for (int n = 0; n < 2; ++n)
            *(PG8_LAS pg8::f32x4*)(lds + loff(frow + 16 * m, fchunk + 32 * bj + 4 * n)) = acc[ai][bj][m][n];
      __syncthreads();
#pragma unroll 4
      for (int i = 0; i < 16; ++i) {
        const int lrow = wid * 16 + i, row = R0 + ai * 128 + lrow;
        const pg8::f32x4 v = *(const PG8_LAS pg8::f32x4*)(lds + loff(lrow, lane));
        const float ss = __hip_atomic_load(rowss + row, __ATOMIC_RELAXED, __HIP_MEMORY_SCOPE_AGENT);
        const float r = rsqrtf(ss * (1.f / 2048.f) + 1e-6f);
        const size_t off = (size_t)row * 2048 + C0 + 4 * lane;
        pg8::f32x4 o = v * r * gg;
        if (hx) {
          *(pg8::f32x4*)(out + off) = v;
          o = o * sc + sh;
          *(uint2*)(hx + off) = pack4(o);
        } else {
          *(pg8::f32x4*)(out + off) = o;
        }
      }
      __syncthreads();
    }
  }
};
template <class Epi, bool AGROUP = false>
__device__ __forceinline__ void run_gemm(float* sm, const u16* A, const u16* Bt, int M, int N, const Epi& E, int c) {
  pg8::Gemm g{A, Bt, M, N, 2048, AGROUP ? 1 : 0};
  pg8::StaticOrder S; S.init(M, N, (int)gridDim.x, c);
  pg8::gemm_phase<Epi, pg8::StaticOrder, AGROUP>((PG8_LAS unsigned char*)sm, g, S, E);
  __syncthreads();
}

template <int MODE>
__device__ __forceinline__ void epi_pair(const Params& p, int m, int n, float a0, float a1) {
  if (MODE == 1) {
    u16* px = (u16*)(p.ws + OFF_BIG);
    float o0 = a0, o1 = a1;
    if (n < 2560) {
      int g = (n >> 5) & 3, fr = n & 15;
      int axis = g >> 1, i = (g & 1) * 16 + fr;
      int s = m & 2047;
      int pos = axis ? (s & 63) : (s >> 6);
      float2 cs = ((const float2*)(p.ws + OFF_ROPE))[pos * 32 + i];
      o0 = a0 * cs.x - a1 * cs.y;
      o1 = a1 * cs.x + a0 * cs.y;
    }
    px[(size_t)m * 5120 + n] = f2bf(o0);
    px[(size_t)m * 5120 + n + 16] = f2bf(o1);
  } else if (MODE == 5) {
    u16* kvc = (u16*)(p.ws + OFF_KVC);
    kvc[(size_t)m * 1024 + n] = f2bf(a0);
    kvc[(size_t)m * 1024 + n + 16] = f2bf(a1);
  } else if (MODE == 2) {
    const float* mod = (const float*)(p.ws + OFF_MOD);
    int b = m >> 11;
    const float* gate = mod + (0 * 5 + b) * 6144 + 4096;
    p.out[(size_t)m * 2048 + n] = p.x[(size_t)m * 2048 + n] + gate[n] * a0;
    p.out[(size_t)m * 2048 + n + 16] = p.x[(size_t)m * 2048 + n + 16] + gate[n + 16] * a1;
  } else if (MODE == 3) {
    u16* pp = (u16*)(p.ws + OFF_BIG);
    pp[(size_t)m * 8192 + n] = f2bf(a0);
    pp[(size_t)m * 8192 + n + 16] = f2bf(a1);
  } else if (MODE == 4) {
    const float* mod = (const float*)(p.ws + OFF_MOD);
    int b = m >> 11;
    const float* gate = mod + (1 * 5 + b) * 6144 + 4096;
    p.out[(size_t)m * 2048 + n] += gate[n] * a0;
    p.out[(size_t)m * 2048 + n + 16] += gate[n + 16] * a1;
  }
}

template <int MODE>
__device__ __forceinline__ void naive_gemm(const Params& p, const u16* __restrict__ A, const u16* __restrict__ Wt, int M, int N) {
  const int tid = threadIdx.x;
  const int ml = tid >> 5, pl = tid & 31;
  const int ntn = N / 64, ntm = M / 16;
  for (int tile = blockIdx.x; tile < ntn * ntm; tile += gridDim.x) {
    int tm = tile / ntn, tn = tile % ntn;
    int m = tm * 16 + ml;
    int n = tn * 64 + (pl >> 4) * 32 + (pl & 15);
    const uint4* a = (const uint4*)(A + (size_t)m * 2048);
    const uint4* w0 = (const uint4*)(Wt + (size_t)n * 2048);
    const uint4* w1 = (const uint4*)(Wt + (size_t)(n + 16) * 2048);
    float acc0 = 0.f, acc1 = 0.f;
#pragma unroll 2
    for (int k = 0; k < 256; ++k) {
      uint4 av = a[k], b0 = w0[k], b1 = w1[k];
      acc0 += bflo(av.x) * bflo(b0.x) + bfhi(av.x) * bfhi(b0.x) + bflo(av.y) * bflo(b0.y) + bfhi(av.y) * bfhi(b0.y)
            + bflo(av.z) * bflo(b0.z) + bfhi(av.z) * bfhi(b0.z) + bflo(av.w) * bflo(b0.w) + bfhi(av.w) * bfhi(b0.w);
      acc1 += bflo(av.x) * bflo(b1.x) + bfhi(av.x) * bfhi(b1.x) + bflo(av.y) * bflo(b1.y) + bfhi(av.y) * bfhi(b1.y)
            + bflo(av.z) * bflo(b1.z) + bfhi(av.z) * bfhi(b1.z) + bflo(av.w) * bflo(b1.w) + bfhi(av.w) * bfhi(b1.w);
    }
    epi_pair<MODE>(p, m, n, acc0, acc1);
  }
}

__device__ __forceinline__ void phase_attn_naive(const Params& p, float* sm) {
  const int wid = threadIdx.x >> 6, lane = threadIdx.x & 63;
  float* qs = sm + wid * (128 + 640);
  float* pr = qs + 128;
  const u16* px = (const u16*)(p.ws + OFF_BIG);
  const u16* kvc = (const u16*)(p.ws + OFF_KVC);
  u16* og = (u16*)(p.ws + OFF_ACT);
  const float scale = 0.08838834764831845f;
  for (int item = blockIdx.x * 8 + wid; item < MT * 16; item += gridDim.x * 8) {
    int m = item >> 4, h = item & 15;
    int b = m >> 11, s = m & 2047, kvh = h >> 2, nblk = s >> 7;
    const u16* qrow = px + (size_t)m * 5120 + h * 128;
    qs[lane] = bf2f(qrow[lane]) * scale;
    qs[lane + 64] = bf2f(qrow[lane + 64]) * scale;
    asm volatile("s_waitcnt lgkmcnt(0)" ::: "memory");
    float mx = p.attn_sink[h];
#pragma unroll 1
    for (int j = 0; j < 10; ++j) {
      int kidx = j * 64 + lane;
      const u16* krow;
      bool valid;
      if (kidx < 384) {
        int kpos = (nblk - 1) * 128 + kidx;
        int rel = kpos - s;
        valid = (kpos >= 0) && (kpos < 2048) && (rel <= 128) && (rel >= -128);
        krow = px + (size_t)(b * 2048 + (valid ? kpos : 0)) * 5120 + 2048 + kvh * 128;
      } else {
        valid = true;
        krow = kvc + (size_t)(b * 256 + (kidx - 384)) * 1024 + kvh * 128;
      }
      float d = -1e30f;
      if (valid) {
        d = 0.f;
#pragma unroll 4
        for (int c = 0; c < 16; ++c) {
          uint4 kk = *(const uint4*)(krow + c * 8);
          const float* q8 = qs + c * 8;
          d += q8[0] * bflo(kk.x) + q8[1] * bfhi(kk.x) + q8[2] * bflo(kk.y) + q8[3] * bfhi(kk.y)
             + q8[4] * bflo(kk.z) + q8[5] * bfhi(kk.z) + q8[6] * bflo(kk.w) + q8[7] * bfhi(kk.w);
        }
      }
      pr[kidx] = d;
      mx = fmaxf(mx, d);
    }
    mx = wave_max(mx);
    float sum = 0.f;
#pragma unroll 1
    for (int j = 0; j < 10; ++j) {
      float d = pr[j * 64 + lane];
      float e = (d > -1e29f) ? __expf(d - mx) : 0.f;
      pr[j * 64 + lane] = e;
      sum += e;
    }
    sum = wave_sum(sum);
    sum += __expf(p.attn_sink[h] - mx);
    asm volatile("s_waitcnt lgkmcnt(0)" ::: "memory");
    float o0 = 0.f, o1 = 0.f;
    int k0 = s - 128 < 0 ? 0 : s - 128, k1 = s + 128 > 2047 ? 2047 : s + 128;
    for (int kpos = k0; kpos <= k1; ++kpos) {
      float pv = pr[kpos - (nblk - 1) * 128];
      unsigned vv = *(const unsigned*)(px + (size_t)(b * 2048 + kpos) * 5120 + 2560 + kvh * 128 + lane * 2);
      o0 += pv * bflo(vv); o1 += pv * bfhi(vv);
    }
    for (int c = 0; c < 256; ++c) {
      float pv = pr[384 + c];
      unsigned vv = *(const unsigned*)(kvc + (size_t)(b * 256 + c) * 1024 + 512 + kvh * 128 + lane * 2);
      o0 += pv * bflo(vv); o1 += pv * bfhi(vv);
    }
    float inv = 1.f / sum;
    unsigned gg = *(const unsigned*)(px + (size_t)m * 5120 + 3072 + h * 128 + lane * 2);
    float r0 = o0 * inv * siluf(bflo(gg)), r1 = o1 * inv * siluf(bfhi(gg));
    *(unsigned*)(og + (size_t)m * 2048 + h * 128 + lane * 2) = pk2(r0, r1);
    asm volatile("s_waitcnt lgkmcnt(0)" ::: "memory");
  }
}

__device__ __forceinline__ float sconv(const u16* pp, const float* cw, const float* cb, int b, int t, int c) {
  const u16* base = pp + (size_t)(b * 2048 + t) * 8192 + c;
  float v = cw[6144 + c] * bf2f(base[0]) + cb[c];
  if (t > 0) v += cw[c] * bf2f(base[-8192]);
  if (t < 2047) v += cw[2 * 6144 + c] * bf2f(base[8192]);
  return v;
}

__device__ __forceinline__ void phase_conv_naive(const Params& p, float* sm) {
  const int tid = threadIdx.x;
  float* u = sm;
  float* R = sm + 8192;
  const u16* pp = (const u16*)(p.ws + OFF_BIG);
  const u16* Rg = (const u16*)(p.ws + OFF_FILT);
  u16* yg = (u16*)(p.ws + OFF_ACT);
  for (int ch = blockIdx.x; ch < 2048; ch += gridDim.x) {
    for (int i = tid; i < 8192; i += NTHREADS) u[i] = sconv(pp, p.hy_conv_w, p.hy_conv_b, i >> 11, i & 2047, 4096 + ch);
    for (int i = tid; i < 4096; i += NTHREADS) R[i] = bf2f(Rg[((size_t)0 * 2048 + ch) * 4096 + i]);
    __syncthreads();
    float zr[16];
#pragma unroll
    for (int q = 0; q < 16; ++q) {
      int i = tid + q * NTHREADS;
      int b = i >> 11, t = i & 2047;
      const float* ub = u + b * 2048;
      const float* Rb = R + 2048 - t;
      float a = 0.f;
      for (int s = 0; s < 2048; ++s) a += Rb[s] * ub[s];
      zr[q] = a * sconv(pp, p.hy_conv_w, p.hy_conv_b, b, t, ch);
    }
    __syncthreads();
#pragma unroll
    for (int q = 0; q < 16; ++q) u[tid + q * NTHREADS] = zr[q];
    for (int i = tid; i < 4096; i += NTHREADS) R[i] = bf2f(Rg[((size_t)1 * 2048 + ch) * 4096 + i]);
    __syncthreads();
#pragma unroll
    for (int q = 0; q < 16; ++q) {
      int i = tid + q * NTHREADS;
      int b = i >> 11, t = i & 2047;
      const float* ub = u + b * 2048;
      const float* Rb = R + 2048 - t;
      float a = 0.f;
      for (int s = 0; s < 2048; ++s) a += Rb[s] * ub[s];
      float y = a * sconv(pp, p.hy_conv_w, p.hy_conv_b, b, t, 2048 + ch);
      float g = bf2f(pp[(size_t)(b * 2048 + t) * 8192 + 6144 + ch]);
      yg[(size_t)(b * 2048 + t) * 2048 + ch] = f2bf(y * siluf(g));
    }
    __syncthreads();
  }
}


typedef float f32x16 __attribute__((ext_vector_type(16)));
typedef pg8::bf16x8 bfx8;
constexpr int CONV_RF_BYTES = 4 * 2 * 8192;
constexpr int CONV_PAD = 7;
constexpr int CONV_UB_ONE = 316 * 64;
__device__ __forceinline__ int ub_addr(int col, int chunk) { return col * 64 + ((chunk ^ ((col >> 2) & 3)) << 4); }

__device__ __forceinline__ void conv_mfma(const char* Rf_ci, const char* Ub_c, int lane, int jh, f32x16 (&acc)[4]) {
  const int t2 = lane & 31, h = lane >> 5, n = lane & 31;
  const int lanedw = ((2048 - t2 + 8 * h) >> 1) - 512 * jh;
#pragma unroll
  for (int j = 0; j < 4; ++j)
#pragma unroll
    for (int r = 0; r < 16; ++r) acc[j][r] = 0.f;
#pragma unroll 1
  for (int f = 0; f < 8; ++f) {
    bfx8 Bw[9][2];
#pragma unroll
    for (int m = 0; m < 9; ++m) {
      const int col = (8 * m - f + CONV_PAD) * 4 + n;
#pragma unroll
      for (int kh = 0; kh < 2; ++kh) Bw[m][kh] = *(const bfx8*)(Ub_c + ub_addr(col, 2 * kh + h));
    }
    const unsigned* Rp = (const unsigned*)(Rf_ci + ((t2 & 1) ? 8192 : 0)) + lanedw - 16 * f;
#pragma unroll
    for (int e = -8; e <= 3; ++e) {
      int ee = e;
      if (e == -8) ee = (f == 0) ? -7 : -8;
      bfx8 A[2];
#pragma unroll
      for (int kh = 0; kh < 2; ++kh) {
        const unsigned* q = Rp - 128 * ee + 8 * kh;
        pg8::u32x4 pk;
        pk[0] = q[0]; pk[1] = q[1]; pk[2] = q[2]; pk[3] = q[3];
        A[kh] = __builtin_bit_cast(bfx8, pk);
      }
#pragma unroll
      for (int j = 0; j < 4; ++j) {
        const int m = j - e;
        if (m >= 0 && m <= 8) acc[j] = __builtin_amdgcn_mfma_f32_32x32x16_bf16(A[0], Bw[m][0], acc[j], 0, 0, 0);
      }
#pragma unroll
      for (int j = 0; j < 4; ++j) {
        const int m = j - e;
        if (m >= 0 && m <= 8) acc[j] = __builtin_amdgcn_mfma_f32_32x32x16_bf16(A[1], Bw[m][1], acc[j], 0, 0, 0);
      }
    }
  }
}

__device__ __forceinline__ void sconv4(const u16* xp, int t, float w0, float w1, float w2, float cb, float (&o)[4]) {
  uint2 x4 = *(const uint2*)xp;
  float pv = t > 0 ? bf2f(xp[-1]) : 0.f;
  float nx = (t + 4 < 2048) ? bf2f(xp[4]) : 0.f;
  float e0 = bflo(x4.x), e1 = bfhi(x4.x), e2 = bflo(x4.y), e3 = bfhi(x4.y);
  o[0] = w0 * pv + w1 * e0 + w2 * e1 + cb;
  o[1] = w0 * e0 + w1 * e1 + w2 * e2 + cb;
  o[2] = w0 * e1 + w1 * e2 + w2 * e3 + cb;
  o[3] = w0 * e2 + w1 * e3 + w2 * nx + cb;
}

struct SC4 { uint2 x; unsigned pn; };
__device__ __forceinline__ SC4 sc4_load(const u16* xp, int t) {
  SC4 r;
  r.x = *(const uint2*)xp;
  const unsigned pv = t > 0 ? (unsigned)xp[-1] : 0u;
  const unsigned nx = (t + 4 < 2048) ? (unsigned)xp[4] : 0u;
  r.pn = pv | (nx << 16);
  return r;
}
__device__ __forceinline__ void sc4_apply(const SC4& r, float w0, float w1, float w2, float cb, float (&o)[4]) {
  const float pv = bflo(r.pn), nx = bfhi(r.pn);
  const float e0 = bflo(r.x.x), e1 = bfhi(r.x.x), e2 = bflo(r.x.y), e3 = bfhi(r.x.y);
  o[0] = w0 * pv + w1 * e0 + w2 * e1 + cb;
  o[1] = w0 * e0 + w1 * e1 + w2 * e2 + cb;
  o[2] = w0 * e1 + w1 * e2 + w2 * e3 + cb;
  o[3] = w0 * e2 + w1 * e3 + w2 * nx + cb;
}

__device__ __forceinline__ void phase_conv(const Params& p, float* smf) {
  char* sm = (char*)smf;
  char* Rf = sm;
  char* Ub = sm + CONV_RF_BYTES;
  int tid = threadIdx.x;
  asm volatile("" : "+v"(tid));
  const int wid = tid >> 6, lane = tid & 63;
  const int ci = wid >> 1, jh = wid & 1;
  const u16* pT = (const u16*)(p.ws + OFF_BIG);
  const u16* Rg = (const u16*)(p.ws + OFF_FILT);
  u16* yg = (u16*)(p.ws + OFF_ACT);
  for (int kk = 0; kk < (4 * CONV_UB_ONE / 16 + NTHREADS - 1) / NTHREADS; ++kk) { const int zi = tid + kk * NTHREADS; if (zi < 4 * CONV_UB_ONE / 16) ((uint4*)Ub)[zi] = make_uint4(0, 0, 0, 0); }
  __syncthreads();
  char* Ub_w = Ub + ci * CONV_UB_ONE;
  const char* Rf_ci = Rf + ci * 16384;
  const int h = lane >> 5, n = lane & 31;
  for (int it0 = blockIdx.x * 2; it0 < 512; it0 += gridDim.x * 2)
#pragma unroll 1
  for (int sub = 0; sub < 2; ++sub) {
    const int item = it0 + sub;
    const int ch0 = item * 4;
    {
      const int q = tid & 255, hb = tid >> 8;
      uint4 x8[8]; unsigned pn[8]; uint4 fr[4];
#pragma unroll
      for (int k = 0; k < 8; ++k) {
        const int cc = 4096 + ch0 + (k >> 1), b = (k & 1) * 2 + hb;
        const u16* xp = pT + (size_t)cc * 8192 + b * 2048 + q * 8;
        x8[k] = *(const uint4*)xp;
        const unsigned pv = q > 0 ? (unsigned)xp[-1] : 0u;
        const unsigned nx = q < 255 ? (unsigned)xp[8] : 0u;
        pn[k] = pv | (nx << 16);
      }
      unsigned fx[4];
#pragma unroll
      for (int k = 0; k < 4; ++k) {
        const unsigned* fp = (const unsigned*)(Rg + ((size_t)0 * 2048 + ch0 + k) * 4096);
        fr[k] = ((const uint4*)fp)[tid];
        fx[k] = tid < 511 ? fp[4 * tid + 4] : 0u;
      }
#pragma unroll
      for (int k = 0; k < 8; ++k) {
        const int c = k >> 1, cc = 4096 + ch0 + c, b = (k & 1) * 2 + hb;
        const float w0 = p.hy_conv_w[cc], w1 = p.hy_conv_w[6144 + cc], w2 = p.hy_conv_w[2 * 6144 + cc], cb = p.hy_conv_b[cc];
        float e[10];
        e[0] = bflo(pn[k]); e[1] = bflo(x8[k].x); e[2] = bfhi(x8[k].x); e[3] = bflo(x8[k].y); e[4] = bfhi(x8[k].y);
        e[5] = bflo(x8[k].z); e[6] = bfhi(x8[k].z); e[7] = bflo(x8[k].w); e[8] = bfhi(x8[k].w); e[9] = bfhi(pn[k]);
        unsigned o[4];
#pragma unroll
        for (int kk = 0; kk < 4; ++kk) {
          float a = w0 * e[2 * kk] + w1 * e[2 * kk + 1] + w2 * e[2 * kk + 2] + cb;
          float bb = w0 * e[2 * kk + 1] + w1 * e[2 * kk + 2] + w2 * e[2 * kk + 3] + cb;
          o[kk] = pk2(a, bb);
        }
        const int t0 = q * 8, s1 = t0 >> 5, s2 = t0 & 31;
        const int col = (s1 + CONV_PAD) * 4 + b;
        *(uint4*)(Ub + c * CONV_UB_ONE + ub_addr(col, s2 >> 3)) = make_uint4(o[0], o[1], o[2], o[3]);
      }
#pragma unroll
      for (int k = 0; k < 4; ++k) {
        ((uint4*)(Rf + k * 16384))[tid] = fr[k];
        ((uint4*)(Rf + k * 16384 + 8192))[tid] = make_uint4(__builtin_amdgcn_alignbit(fr[k].y, fr[k].x, 16), __builtin_amdgcn_alignbit(fr[k].z, fr[k].y, 16),
                                                             __builtin_amdgcn_alignbit(fr[k].w, fr[k].z, 16), __builtin_amdgcn_alignbit(fx[k], fr[k].w, 16));
      }
    }
    __syncthreads();
    f32x16 acc[4];
    const int ch = ch0 + ci;
    {
      conv_mfma(Rf_ci, Ub_w, lane, jh, acc);
      SC4 xr[16];
#pragma unroll
      for (int j = 0; j < 4; ++j)
#pragma unroll
        for (int vg = 0; vg < 4; ++vg) {
          const int t1 = 8 * (j + 4 * jh) + (n >> 2), b = n & 3, t = 32 * t1 + 8 * vg + 4 * h;
          xr[j * 4 + vg] = sc4_load(pT + (size_t)ch * 8192 + b * 2048 + t, t);
        }
      const unsigned* f1p = (const unsigned*)(Rg + ((size_t)1 * 2048 + ch0) * 4096);
      const uint4 f1a = ((const uint4*)(f1p + 0 * 2048))[tid];
      const uint4 f1b = ((const uint4*)(f1p + 1 * 2048))[tid];
      const uint4 f1c = ((const uint4*)(f1p + 2 * 2048))[tid];
      const uint4 f1d = ((const uint4*)(f1p + 3 * 2048))[tid];
      const unsigned x1a = tid < 511 ? f1p[0 * 2048 + 4 * tid + 4] : 0u, x1b = tid < 511 ? f1p[1 * 2048 + 4 * tid + 4] : 0u;
      const unsigned x1c = tid < 511 ? f1p[2 * 2048 + 4 * tid + 4] : 0u, x1d = tid < 511 ? f1p[3 * 2048 + 4 * tid + 4] : 0u;
      const float w0 = p.hy_conv_w[ch], w1 = p.hy_conv_w[6144 + ch], w2 = p.hy_conv_w[2 * 6144 + ch], cb = p.hy_conv_b[ch];
      __syncthreads();
#pragma unroll
      for (int j = 0; j < 4; ++j)
#pragma unroll
        for (int vg = 0; vg < 4; ++vg) {
          const int t1 = 8 * (j + 4 * jh) + (n >> 2), bl = n & 3;
          float x1[4];
          sc4_apply(xr[j * 4 + vg], w0, w1, w2, cb, x1);
          uint2 pk;
          pk.x = pk2(x1[0] * acc[j][4 * vg + 0], x1[1] * acc[j][4 * vg + 1]);
          pk.y = pk2(x1[2] * acc[j][4 * vg + 2], x1[3] * acc[j][4 * vg + 3]);
          const int col = (t1 + CONV_PAD) * 4 + bl;
          *(uint2*)(Ub_w + ub_addr(col, vg) + 8 * h) = pk;
        }
      __syncthreads();
#define CONV_PUT_F(K, F, X) do { ((uint4*)(Rf + (K) * 16384))[tid] = F; \
        ((uint4*)(Rf + (K) * 16384 + 8192))[tid] = make_uint4(__builtin_amdgcn_alignbit(F.y, F.x, 16), __builtin_amdgcn_alignbit(F.z, F.y, 16), \
                                                               __builtin_amdgcn_alignbit(F.w, F.z, 16), __builtin_amdgcn_alignbit(X, F.w, 16)); } while (0)
      CONV_PUT_F(0, f1a, x1a); CONV_PUT_F(1, f1b, x1b); CONV_PUT_F(2, f1c, x1c); CONV_PUT_F(3, f1d, x1d);
#undef CONV_PUT_F
    }
    __syncthreads();
    {
      const int c2 = 2048 + ch;
      SC4 xr[16]; uint2 gr[16];
      conv_mfma(Rf_ci, Ub_w, lane, jh, acc);
#pragma unroll
      for (int j = 0; j < 4; ++j)
#pragma unroll
        for (int vg = 0; vg < 4; ++vg) {
          const int t1 = 8 * (j + 4 * jh) + (n >> 2), b = n & 3, t = 32 * t1 + 8 * vg + 4 * h;
          xr[j * 4 + vg] = sc4_load(pT + (size_t)c2 * 8192 + b * 2048 + t, t);
          gr[j * 4 + vg] = *(const uint2*)(pT + (size_t)(6144 + ch) * 8192 + b * 2048 + t);
        }
      const float w0 = p.hy_conv_w[c2], w1 = p.hy_conv_w[6144 + c2], w2 = p.hy_conv_w[2 * 6144 + c2], cb = p.hy_conv_b[c2];
      __syncthreads();
#pragma unroll
      for (int j = 0; j < 4; ++j)
#pragma unroll
        for (int vg = 0; vg < 4; ++vg) {
          const int t1 = 8 * (j + 4 * jh) + (n >> 2), bl = n & 3;
          float x2[4];
          sc4_apply(xr[j * 4 + vg], w0, w1, w2, cb, x2);
          const uint2 g4 = gr[j * 4 + vg];
          float y0 = x2[0] * acc[j][4 * vg + 0] * siluf(bflo(g4.x));
          float y1 = x2[1] * acc[j][4 * vg + 1] * siluf(bfhi(g4.x));
          float y2 = x2[2] * acc[j][4 * vg + 2] * siluf(bflo(g4.y));
          float y3 = x2[3] * acc[j][4 * vg + 3] * siluf(bfhi(g4.y));
          uint2 pk;
          pk.x = pk2(y0, y1);
          pk.y = pk2(y2, y3);
          const int col = (t1 + CONV_PAD) * 4 + bl;
          *(uint2*)(Ub_w + ub_addr(col, vg) + 8 * h) = pk;
        }
    }
    __syncthreads();
    int tw = tid;
    asm volatile("" : "+v"(tw));
#pragma unroll 4
    for (int kk = 0; kk < 16; ++kk) {
      const int idx = tw + kk * NTHREADS;
      const int b = idx >> 11, t = idx & 2047;
      const int s1 = t >> 5, s2 = t & 31;
      const int col = (s1 + CONV_PAD) * 4 + b;
      const int a = ub_addr(col, s2 >> 3) + (s2 & 7) * 2;
      const char* base = Ub + a;
      unsigned v0 = *(const u16*)(base + 0 * CONV_UB_ONE), v1 = *(const u16*)(base + 1 * CONV_UB_ONE);
      unsigned v2 = *(const u16*)(base + 2 * CONV_UB_ONE), v3 = *(const u16*)(base + 3 * CONV_UB_ONE);
      const uint2 cur = make_uint2(v0 | (v1 << 16), v2 | (v3 << 16));
      *(uint2*)(yg + ((size_t)(item >> 1) * 8192 + idx) * 8 + (item & 1) * 4) = cur;
    }
    __syncthreads();
  }
}

constexpr int AT_KROW = 272, AT_VROW = 136;
constexpr int AT_K_BYTES = 64 * AT_KROW, AT_V_BYTES = 128 * AT_VROW;
__device__ __forceinline__ void phase_attn(const Params& p, float* smf) {
  char* sm = (char*)smf;
  char* Ks = sm;
  char* Vs = sm + AT_K_BYTES;
  const int tid = threadIdx.x, wid = tid >> 6, lane = tid & 63, r = lane & 31, h = lane >> 5;
  const u16* px = (const u16*)(p.ws + OFF_BIG);
  const u16* kvc = (const u16*)(p.ws + OFF_KVC);
  const u16* vT = (const u16*)(p.ws + OFF_VT);
  const u16* vcT = (const u16*)(p.ws + OFF_VCT);
  u16* og = (u16*)(p.ws + OFF_ACT);
  const float LOG2E = 1.4426950408889634f;
  const float sl2 = 0.08838834764831845f * LOG2E;
  for (int item = blockIdx.x; item < 512; item += gridDim.x) {
    const int hp = item & 1, kvh = (item >> 1) & 3, nblk = (item >> 3) & 15, b = item >> 7;
    const int hq = kvh * 4 + hp * 2 + (wid >> 2);
    const int qs = nblk * 128 + (wid & 3) * 32 + r;
    bfx8 Q[8];
    {
      const u16* qrow = px + (size_t)(b * 2048 + qs) * 5120 + hq * 128 + 8 * h;
#pragma unroll
      for (int st = 0; st < 8; ++st) Q[st] = *(const bfx8*)(qrow + 16 * st);
    }
    f32x16 O[4];
#pragma unroll
    for (int dt = 0; dt < 4; ++dt)
#pragma unroll
      for (int i = 0; i < 16; ++i) O[dt][i] = 0.f;
    float m = p.attn_sink[hq] * LOG2E;
    float l = (h == 0) ? 1.f : 0.f;
    const int first = (nblk == 0) ? 2 : 0, lastlocal = (nblk == 15) ? 3 : 5;
    uint4 kA0, kA1, vA0, vA1, kB0, kB1, vB0, vB1;
#define AT_LOAD_TILE(TI, K0, K1, V0, V1) do { \
      const int _ti = (TI); const bool _loc = _ti < 6; \
      const int _kpos0 = 128 * (nblk - 1) + 64 * _ti, _c0 = 64 * (_ti - 6); \
      const u16* _kb = _loc ? px + (size_t)(b * 2048 + _kpos0) * 5120 + 2048 + kvh * 128 : kvc + (size_t)(b * 256 + _c0) * 1024 + kvh * 128; \
      const size_t _ks = _loc ? 5120 : 1024; \
      const u16* _vb = _loc ? vT + (size_t)(kvh * 128) * 8192 + b * 2048 + _kpos0 : vcT + (size_t)(kvh * 128) * 1024 + b * 256 + _c0; \
      const size_t _vs = _loc ? 8192 : 1024; \
      const int _c1 = tid + NTHREADS; \
      K0 = *(const uint4*)(_kb + (size_t)(tid >> 4) * _ks + (tid & 15) * 8); \
      K1 = *(const uint4*)(_kb + (size_t)(_c1 >> 4) * _ks + (_c1 & 15) * 8); \
      V0 = *(const uint4*)(_vb + (size_t)(tid >> 3) * _vs + (tid & 7) * 8); \
      V1 = *(const uint4*)(_vb + (size_t)(_c1 >> 3) * _vs + (_c1 & 7) * 8); \
    } while (0)
#define AT_STORE_TILE(K0, K1, V0, V1) do { \
      const int c1 = tid + NTHREADS; \
      *(uint4*)(Ks + (tid >> 4) * AT_KROW + (tid & 15) * 16) = K0; \
      *(uint4*)(Ks + (c1 >> 4) * AT_KROW + (c1 & 15) * 16) = K1; \
      char* v0p = Vs + (tid >> 3) * AT_VROW + (tid & 7) * 16; \
      char* v1p = Vs + (c1 >> 3) * AT_VROW + (c1 & 7) * 16; \
      *(uint2*)(v0p) = make_uint2(V0.x, V0.y); \
      *(uint2*)(v0p + 8) = make_uint2(V0.z, V0.w); \
      *(uint2*)(v1p) = make_uint2(V1.x, V1.y); \
      *(uint2*)(v1p + 8) = make_uint2(V1.z, V1.w); \
    } while (0)
    int ti = first;
    int t1 = ti + 1;
    if (t1 > lastlocal && t1 < 6) t1 = 6;
    AT_LOAD_TILE(ti, kA0, kA1, vA0, vA1);
    if (t1 < 10) AT_LOAD_TILE(t1, kB0, kB1, vB0, vB1);
    while (true) {
#pragma unroll
     for (int half = 0; half < 2; ++half) {
      __syncthreads();
      if (half == 0) AT_STORE_TILE(kA0, kA1, vA0, vA1); else AT_STORE_TILE(kB0, kB1, vB0, vB1);
      __syncthreads();
      int t2 = t1 + 1;
      if (t2 > lastlocal && t2 < 6) t2 = 6;
      if (t1 >= 10) t2 = 10;
      if (t2 < 10) { if (half == 0) AT_LOAD_TILE(t2, kA0, kA1, vA0, vA1); else AT_LOAD_TILE(t2, kB0, kB1, vB0, vB1); }
      const int q0w = nblk * 128 + (wid & 3) * 32;
      const int kp0 = 128 * (nblk - 1) + 64 * ti;
      if (!(ti < 6 && (kp0 > q0w + 31 + 128 || kp0 + 63 < q0w - 128))) {
        const bool local = ti < 6;
        const int kpos0 = 128 * (nblk - 1) + 64 * ti;
        f32x16 S[2];
#pragma unroll
        for (int ks = 0; ks < 2; ++ks) {
#pragma unroll
          for (int i = 0; i < 16; ++i) S[ks][i] = 0.f;
#pragma unroll
          for (int st = 0; st < 8; ++st) {
            bfx8 A = *(const bfx8*)(Ks + (ks * 32 + r) * AT_KROW + (16 * st + 8 * h) * 2);
            S[ks] = __builtin_amdgcn_mfma_f32_32x32x16_bf16(A, Q[st], S[ks], 0, 0, 0);
          }
        }
        const bool needmask = local && (kp0 > q0w + 65 || kp0 < q0w - 97);
        float mraw = -1e30f;
        if (needmask) {
          const int relb = kpos0 + 4 * h - qs;
#pragma unroll
          for (int ks = 0; ks < 2; ++ks)
#pragma unroll
            for (int i = 0; i < 16; ++i) {
              const int rel = relb + ks * 32 + (i & 3) + 8 * (i >> 2);
              float sv = S[ks][i];
              if (rel > 128 || rel < -128) sv = -1e30f;
              S[ks][i] = sv;
              mraw = fmaxf(mraw, sv);
            }
        } else {
#pragma unroll
          for (int ks = 0; ks < 2; ++ks)
#pragma unroll
            for (int i = 0; i < 16; ++i) mraw = fmaxf(mraw, S[ks][i]);
        }
        float mx = fmaxf(m, mraw * sl2);
        mx = fmaxf(mx, __shfl_xor(mx, 32, 64));
        if (__builtin_amdgcn_ballot_w64(mx != m) != 0ull) {
          const float alpha = __builtin_amdgcn_exp2f(m - mx);
          m = mx;
          l *= alpha;
#pragma unroll
          for (int dt = 0; dt < 4; ++dt)
#pragma unroll
            for (int i = 0; i < 16; ++i) O[dt][i] *= alpha;
        }
#pragma unroll
        for (int ks = 0; ks < 2; ++ks)
#pragma unroll
          for (int i = 0; i < 16; ++i) {
            float pv = __builtin_amdgcn_exp2f(__builtin_fmaf(S[ks][i], sl2, -m));
            l += pv;
            S[ks][i] = pv;
          }
#pragma unroll
        for (int s4 = 0; s4 < 4; ++s4) {
          const int ks = s4 >> 1, hf = s4 & 1;
          pg8::u32x4 pk;
#pragma unroll
          for (int j = 0; j < 4; ++j)
            pk[j] = pk2(S[ks][8 * hf + 2 * j], S[ks][8 * hf + 2 * j + 1]);
          bfx8 P = __builtin_bit_cast(bfx8, pk);
#pragma unroll
          for (int dt = 0; dt < 4; ++dt) {
            const char* vp = Vs + (dt * 32 + r) * AT_VROW + (32 * ks + 16 * hf + 4 * h) * 2;
            uint2 v0 = *(const uint2*)vp, v1 = *(const uint2*)(vp + 16);
            pg8::u32x4 vv; vv[0] = v0.x; vv[1] = v0.y; vv[2] = v1.x; vv[3] = v1.y;
            O[dt] = __builtin_amdgcn_mfma_f32_32x32x16_bf16(__builtin_bit_cast(bfx8, vv), P, O[dt], 0, 0, 0);
          }
        }
      }
      if (t1 >= 10) goto attn_done;
      ti = t1; t1 = t2;
     }
    }
    attn_done:;
    const float ltot = l + __shfl_xor(l, 32, 64);
    const float inv = 1.f / ltot;
    const size_t tok = (size_t)(b * 2048 + qs);
#pragma unroll
    for (int dt = 0; dt < 4; ++dt)
#pragma unroll
      for (int g4 = 0; g4 < 4; ++g4) {
        const int d = dt * 32 + 8 * g4 + 4 * h;
        uint2 gg = *(const uint2*)(px + tok * 5120 + 3072 + hq * 128 + d);
        float o0 = O[dt][4 * g4 + 0] * inv * siluf(bflo(gg.x));
        float o1 = O[dt][4 * g4 + 1] * inv * siluf(bfhi(gg.x));
        float o2 = O[dt][4 * g4 + 2] * inv * siluf(bflo(gg.y));
        float o3 = O[dt][4 * g4 + 3] * inv * siluf(bfhi(gg.y));
        uint2 pk;
        pk.x = pk2(o0, o1);
        pk.y = pk2(o2, o3);
        *(uint2*)(og + tok * 2048 + hq * 128 + d) = pk;
      }
  }
}

#define XB_TMO      128
#define XB_XCNT(j)  (256  + 64 * (j))
#define XB_XSUB(j)  (1280 + 64 * (j))
#define XB_XGEN(j)  (2304 + 64 * (j))
#define XB_TOP      3328
#define XB_TOPGEN   3392
#define XCD_BAR_WORDS 3456
#define XB_SPIN_CAP (1u << 18)
#define LAS __attribute__((address_space(3)))

__device__ __forceinline__ unsigned xb_ld(unsigned* p)              { return __hip_atomic_load(p, __ATOMIC_RELAXED, __HIP_MEMORY_SCOPE_AGENT); }
__device__ __forceinline__ unsigned xb_add(unsigned* p, unsigned v) { return __hip_atomic_fetch_add(p, v, __ATOMIC_RELAXED, __HIP_MEMORY_SCOPE_AGENT); }
__device__ __forceinline__ unsigned xb_xcc_id() { return (unsigned)__builtin_amdgcn_s_getreg((3 << 11) | 20) & 0xFu; }
#define XB_SPIN(cond, bar) do { unsigned _sp = 0; while (cond) { __builtin_amdgcn_s_sleep(1); \
    if ((++_sp & 255u) == 0u) { if (xb_ld(&(bar)[XB_TMO])) break; if (_sp > XB_SPIN_CAP) { atomicAdd(&(bar)[XB_TMO], 1u); break; } } } } while (0)

struct XcdBarrier {
    unsigned* bar; unsigned x;
    volatile LAS unsigned* st;
};

__device__ __forceinline__ XcdBarrier xcd_barrier_post(unsigned* bar, volatile LAS unsigned* st) {
    XcdBarrier b; b.bar = bar; b.x = xb_xcc_id(); b.st = st;
    if (threadIdx.x == 0) (void)xb_add(&bar[XB_XCNT(b.x)], 1u);
    return b;
}
__device__ __forceinline__ void xcd_barrier_complete(unsigned* bar, unsigned x, unsigned& nloc, unsigned& nx) {
    const unsigned G = gridDim.x * gridDim.y * gridDim.z;
    unsigned sum, cnt, mine, sp = 0u;
    for (;;) {
        sum = 0u; cnt = 0u; mine = 0u;
#pragma unroll
        for (unsigned j = 0; j < 16; ++j) { const unsigned c = xb_ld(&bar[XB_XCNT(j)]); sum += c; cnt += (c > 0u) ? 1u : 0u; mine = (j == x) ? c : mine; }
        if (sum == G) break;
        __builtin_amdgcn_s_sleep(1);
        if ((++sp & 255u) == 0u) { if (xb_ld(&bar[XB_TMO])) break; if (sp > XB_SPIN_CAP) { atomicAdd(&bar[XB_TMO], 1u); break; } }
    }
    nloc = mine > 0u ? mine : 1u; nx = cnt > 0u ? cnt : 1u;
}

__device__ __forceinline__ void xcd_barrier(const XcdBarrier& b) {
    asm volatile("s_waitcnt vmcnt(0)" ::: "memory");
    __syncthreads();
    if (threadIdx.x == 0) {
        unsigned* bar = b.bar;
        __builtin_amdgcn_s_waitcnt(0);
        unsigned nloc = b.st[0], nx = b.st[1];
        if (nloc == 0u) { xcd_barrier_complete(bar, b.x, nloc, nx); b.st[0] = nloc; b.st[1] = nx; }
        const unsigned old = xb_add(&bar[XB_XSUB(b.x)], 1u);
        const unsigned gen = old / nloc;
        if (old + 1u == (gen + 1u) * nloc) {
            __builtin_amdgcn_fence(__ATOMIC_RELEASE, "agent");
            asm volatile("s_waitcnt vmcnt(0)" ::: "memory");
            const unsigned og = xb_add(&bar[XB_TOP], 1u);
            const unsigned tg = og / nx;
            if (og + 1u == (tg + 1u) * nx) xb_add(&bar[XB_TOPGEN], 1u);
            else XB_SPIN(xb_ld(&bar[XB_TOPGEN]) == tg, bar);
            __builtin_amdgcn_fence(__ATOMIC_ACQUIRE, "agent");
            xb_add(&bar[XB_XGEN(b.x)], 1u);
            asm volatile("s_waitcnt vmcnt(0)" ::: "memory");
        } else {
            XB_SPIN(xb_ld(&bar[XB_XGEN(b.x)]) == gen, bar);
            __builtin_amdgcn_fence(__ATOMIC_ACQUIRE, "agent");
            asm volatile("s_waitcnt vmcnt(0)" ::: "memory");
        }
    }
    __syncthreads();
}


constexpr int N_PHASES = 9;
__global__ void __launch_bounds__(NTHREADS, 2) mega(Params p, int ph0, int ph1) {
  extern __shared__ __attribute__((aligned(16))) float sm[];
  volatile LAS unsigned* xb_st = (volatile LAS unsigned*)((LAS unsigned char*)sm + 162816);
  if (threadIdx.x < 4) xb_st[threadIdx.x] = 0u;
  __syncthreads();
  const XcdBarrier xb = xcd_barrier_post((unsigned*)(p.ws + OFF_BAR), xb_st);
#define PH(i, body) if (ph0 <= (i) && (i) < ph1) { body; if ((i) + 1 < ph1) xcd_barrier(xb); }
  if (ph0 < 0) cg::this_grid().sync();
  PH(0, phase0(p, sm))
  PH(1, phase_norm(p, 0))
  PH(2, run_gemm(sm, (const u16*)(p.ws + OFF_ACT), (const u16*)(p.ws + OFF_WT_AI), MT, ATTN_IN,
                 EpiAttnIn{(u16*)(p.ws + OFF_BIG), (const float*)(p.ws + OFF_ROPE)}, (int)blockIdx.x);
        run_gemm(sm, (const u16*)(p.ws + OFF_HC), (const u16*)(p.ws + OFF_WT_AI) + (size_t)2048 * 2048, MC, 1024,
                 EpiRaw{(u16*)(p.ws + OFF_KVC), 1024}, (int)((blockIdx.x + 64) % gridDim.x));
        run_gemm(sm, (const u16*)(p.ws + OFF_WT_AI) + (size_t)2560 * 2048, (const u16*)(p.ws + OFF_ACT), 512, MT,
                 EpiRaw{(u16*)(p.ws + OFF_VT), 8192}, (int)((blockIdx.x + 128) % gridDim.x));
        run_gemm(sm, (const u16*)(p.ws + OFF_WT_AI) + (size_t)2560 * 2048, (const u16*)(p.ws + OFF_HC), 512, MC,
                 EpiRaw{(u16*)(p.ws + OFF_VCT), 1024}, (int)((blockIdx.x + 48) % gridDim.x)))
  PH(3, phase_attn(p, sm))
  PH(4, run_gemm(sm, (const u16*)(p.ws + OFF_ACT), (const u16*)(p.ws + OFF_WT_AO), MT, 2048,
                 EpiResNorm{p.out, p.x, (const float*)(p.ws + OFF_MOD) + 4096, (float*)(p.ws + OFF_ROWSS), (unsigned*)(p.ws + OFF_PCNT),
                            p.norm_g + 2048, (const float*)(p.ws + OFF_MOD) + 5 * 6144, (u16*)(p.ws + OFF_ACT)}, (int)blockIdx.x))
  PH(6, run_gemm(sm, (const u16*)(p.ws + OFF_WT_HI), (const u16*)(p.ws + OFF_ACT), HY_IN, MT,
                 EpiRaw{(u16*)(p.ws + OFF_BIG), 8192}, (int)blockIdx.x))
  PH(7, phase_conv(p, sm))
  PH(8, (run_gemm<EpiResNorm, true>(sm, (const u16*)(p.ws + OFF_ACT), (const u16*)(p.ws + OFF_WT_HO), MT, 2048,
                 EpiResNorm{p.out, p.out, (const float*)(p.ws + OFF_MOD) + 5 * 6144 + 4096, (float*)(p.ws + OFF_ROWSS) + 8192,
                            (unsigned*)(p.ws + OFF_PCNT) + 32 * 64, p.final_g, nullptr, nullptr}, (int)blockIdx.x)))
}

extern "C" void kernel_launch(void* const* d_in, const int* in_sizes, int n_in, void* d_out, int out_size,
                              void* d_ws, size_t ws_size, hipStream_t stream) {
  Params p{};
  const float** f = (const float**)&p;
  for (int i = 0; i < 23; ++i) f[i] = (const float*)d_in[i];
  p.out = (float*)d_out;
  p.ws = (char*)d_ws;
  constexpr size_t kLds = 162816 + 16;
  static int grid_blocks = 0;
  if (!grid_blocks) {
    (void)hipFuncSetAttribute((const void*)mega, hipFuncAttributeMaxDynamicSharedMemorySize, (int)kLds);
    int dev = 0, cus = 0, per_cu = 0;
    (void)hipGetDevice(&dev);
    (void)hipDeviceGetAttribute(&cus, hipDeviceAttributeMultiprocessorCount, dev);
    (void)hipOccupancyMaxActiveBlocksPerMultiprocessor(&per_cu, mega, NTHREADS, kLds);
    if (per_cu < 1) per_cu = 1;
    grid_blocks = cus * per_cu;
  }
  (void)hipMemsetAsync((char*)d_ws + OFF_BAR, 0, ZERO_BYTES, stream);
  int ph0 = 0, ph1 = N_PHASES;
  void* args[] = {(void*)&p, (void*)&ph0, (void*)&ph1};
  hipError_t e = hipLaunchCooperativeKernel((const void*)mega, dim3(grid_blocks), dim3(NTHREADS), args, kLds, stream);
  if (e != hipSuccess) fprintf(stderr, "cooperative launch failed: %s (grid %d)\n", hipGetErrorString(e), grid_blocks);
}
```

```cpp
#include <hip/hip_runtime.h>
#include <hip/hip_bf16.h>
#include <hip/hip_cooperative_groups.h>
#include <cstdio>
namespace cg = cooperative_groups;
typedef unsigned short u16;

#define NTHREADS 512
constexpr int Bn = 4, Sn = 2048, Dn = 2048, Cn = 256;
constexpr int MT = Bn * Sn;
constexpr int MC = Bn * Cn;
constexpr int ATTN_IN = 5120;
constexpr int HY_IN = 8192;

constexpr size_t OFF_WT_AI = 0;
constexpr size_t OFF_WT_AO = OFF_WT_AI + (size_t)5120 * 2048 * 2;
constexpr size_t OFF_WT_HI = OFF_WT_AO + (size_t)2048 * 2048 * 2;
constexpr size_t OFF_WT_HO = OFF_WT_HI + (size_t)8192 * 2048 * 2;
constexpr size_t OFF_MOD   = OFF_WT_HO + (size_t)2048 * 2048 * 2;
constexpr size_t OFF_ROPE  = OFF_MOD + (size_t)2 * 5 * 6144 * 4 + 256;
constexpr size_t OFF_FILT  = OFF_ROPE + (size_t)64 * 32 * 8;
constexpr size_t OFF_ACT   = OFF_FILT + (size_t)2 * 2048 * 4096 * 2;
constexpr size_t OFF_HC    = OFF_ACT + (size_t)8192 * 2048 * 2;
constexpr size_t OFF_KVC   = OFF_HC + (size_t)1024 * 2048 * 2;
constexpr size_t OFF_VT    = OFF_KVC + (size_t)1024 * 1024 * 2;
constexpr size_t OFF_VCT   = OFF_VT + (size_t)512 * 8192 * 2;
constexpr size_t OFF_BIG   = OFF_VCT + (size_t)512 * 1024 * 2;

constexpr size_t OFF_BAR   = OFF_BIG + (size_t)8192 * 8192 * 2;

constexpr size_t OFF_ROWSS = OFF_BAR + 16384;
constexpr size_t OFF_PCNT  = OFF_ROWSS + (size_t)2 * 8192 * 4;
constexpr size_t ZERO_BYTES = 16384 + (size_t)2 * 8192 * 4 + (size_t)2 * 32 * 64 * 4;

struct Params {
  const float *x, *c, *ctx, *c_ctx, *norm_g, *ada_w, *ada_b, *attn_w_in, *attn_w_out, *attn_sink;
  const float *hy_w_in, *hy_conv_w, *hy_conv_b, *hy_w1, *hy_b1, *hy_w2, *hy_b2, *hy_w3, *hy_b3;
  const float *hy_freq, *hy_bias_d, *hy_w_out, *final_g;
  float* out;
  char* ws;
};

__device__ __forceinline__ u16 f2bf(float f) {
  unsigned u = __float_as_uint(f);
  u += 0x7fffu + ((u >> 16) & 1u);
  return (u16)(u >> 16);
}
__device__ __forceinline__ float bf2f(u16 h) { return __uint_as_float(((unsigned)h) << 16); }
__device__ __forceinline__ unsigned pk2(float lo, float hi) { unsigned r; asm("v_cvt_pk_bf16_f32 %0, %1, %2" : "=v"(r) : "v"(lo), "v"(hi)); return r; }
__device__ __forceinline__ float bflo(unsigned w) { return __uint_as_float(w << 16); }
__device__ __forceinline__ float bfhi(unsigned w) { return __uint_as_float(w & 0xffff0000u); }
__device__ __forceinline__ float siluf(float v) { return v / (1.f + __expf(-v)); }
__device__ __forceinline__ float wave_sum(float v) {
#pragma unroll
  for (int o = 32; o > 0; o >>= 1) v += __shfl_xor(v, o, 64);
  return v;
}
__device__ __forceinline__ float wave_max(float v) {
#pragma unroll
  for (int o = 32; o > 0; o >>= 1) v = fmaxf(v, __shfl_xor(v, o, 64));
  return v;
}

__device__ __forceinline__ void p0_convert(const float* __restrict__ W, u16* __restrict__ Wt, int N, int tk, int tn,
                           bool perm, float* sm) {
  const int tid = threadIdx.x;
  for (int i = tid; i < 64 * 32; i += NTHREADS) {
    int r = i >> 5, c4 = i & 31;
    float4 v = *(const float4*)(W + (size_t)(tk * 64 + r) * N + tn * 128 + c4 * 4);
    float* d = sm + r * 129 + c4 * 4;
    d[0] = v.x; d[1] = v.y; d[2] = v.z; d[3] = v.w;
  }
  __syncthreads();
  for (int i = tid; i < 128 * 8; i += NTHREADS) {
    int nrow = i >> 3, kc = i & 7;
    int src = nrow;
    if (perm && (tn * 128 < 2560)) {
      int g = nrow >> 5, nn = (nrow >> 4) & 1, fr = nrow & 15;
      src = (g >> 1) * 64 + nn * 32 + (g & 1) * 16 + fr;
    }
    unsigned w[4];
#pragma unroll
    for (int j = 0; j < 4; ++j) {
      float a = sm[(kc * 8 + 2 * j) * 129 + src];
      float b = sm[(kc * 8 + 2 * j + 1) * 129 + src];
      w[j] = pk2(a, b);
    }
    *(uint4*)(Wt + (size_t)(tn * 128 + nrow) * 2048 + tk * 64 + kc * 8) = make_uint4(w[0], w[1], w[2], w[3]);
  }
  __syncthreads();
}

__device__ __forceinline__ void p0_adaln(const Params& p, int item, float* sm) {
  const int tid = threadIdx.x;
  float* sv = sm;
  float* red = sm + 5 * 2048;
  int col0 = item * 48;
  int l = col0 / 6144, n0 = col0 % 6144;
  for (int i = tid; i < 5 * 2048; i += NTHREADS) {
    int v = i >> 11, k = i & 2047;
    float cv = v < 4 ? p.c[v * 2048 + k] : p.c_ctx[k];
    sv[i] = cv / (1.f + expf(-cv));
  }
  __syncthreads();
  int kg = tid / 12, cq = tid % 12;
  float acc[5][4];
#pragma unroll
  for (int v = 0; v < 5; ++v)
#pragma unroll
    for (int j = 0; j < 4; ++j) acc[v][j] = 0.f;
  if (kg < 42) {
    const float* W = p.ada_w + (size_t)l * 2048 * 6144 + n0 + cq * 4;
#pragma unroll 8
    for (int k = kg; k < 2048; k += 42) {
      float4 w = *(const float4*)(W + (size_t)k * 6144);
#pragma unroll
      for (int v = 0; v < 5; ++v) {
        float s = sv[v * 2048 + k];
        acc[v][0] += s * w.x; acc[v][1] += s * w.y; acc[v][2] += s * w.z; acc[v][3] += s * w.w;
      }
    }
  }
  if (kg >= 21 && kg < 42) {
#pragma unroll
    for (int v = 0; v < 5; ++v)
#pragma unroll
      for (int j = 0; j < 4; ++j) red[((kg - 21) * 5 + v) * 48 + cq * 4 + j] = acc[v][j];
  }
  __syncthreads();
  if (kg < 21) {
#pragma unroll
    for (int v = 0; v < 5; ++v)
#pragma unroll
      for (int j = 0; j < 4; ++j) red[(kg * 5 + v) * 48 + cq * 4 + j] += acc[v][j];
  }
  __syncthreads();
  if (tid < 240) {
    int v = tid / 48, cc = tid % 48;
    float s = 0.f;
    for (int g = 0; g < 21; ++g) s += red[(g * 5 + v) * 48 + cc];
    float* mod = (float*)(p.ws + OFF_MOD);
    mod[(l * 5 + v) * 6144 + n0 + cc] = s + p.ada_b[l * 6144 + n0 + cc];
  }
  __syncthreads();
}

__device__ __forceinline__ void p0_rope(const Params& p) {
  float2* rope = (float2*)(p.ws + OFF_ROPE);
  for (int i = threadIdx.x; i < 64 * 32; i += NTHREADS) {
    int pos = i >> 5, j = i & 31;
    float inv = powf(10000.f, -(float)(2 * j) / 64.f);
    float ang = (float)pos * inv;
    rope[i] = make_float2(cosf(ang), sinf(ang));
  }
}

typedef short bf16x8_t __attribute__((ext_vector_type(8)));
typedef unsigned u32x4_t __attribute__((ext_vector_type(4)));
typedef float f32x16_t __attribute__((ext_vector_type(16)));
__device__ __forceinline__ void split8(const float (&v)[8], bf16x8_t& hi, bf16x8_t& lo) {
  u32x4_t H, L;
#pragma unroll
  for (int j = 0; j < 4; ++j) {
    const u16 h0 = f2bf(v[2 * j]), h1 = f2bf(v[2 * j + 1]);
    const float r0 = v[2 * j] - bf2f(h0), r1 = v[2 * j + 1] - bf2f(h1);
    H[j] = (unsigned)h0 | ((unsigned)h1 << 16);
    L[j] = pk2(r0, r1);
  }
  hi = __builtin_bit_cast(bf16x8_t, H);
  lo = __builtin_bit_cast(bf16x8_t, L);
}
__device__ __forceinline__ void p0_filter(const Params& p, int item, float* sm) {
  int tid = threadIdx.x;
  asm volatile("" : "+v"(tid));
  const int lane = tid & 63, wid = tid >> 6, r = lane & 31, h = lane >> 5;
  const int cc = item & 15, pg = item >> 4;
  float* z = sm;
  float* h1 = z + 128 * 36;
  float* h2 = h1 + 128 * 64;
  for (int i = tid; i < 128 * 33; i += NTHREADS) {
    int pos = i / 33, e = i % 33;
    int t = pg * 128 + pos;
    float val;
    if (e == 0) val = (float)t / 2047.f;
    else {
      int bi = (e - 1) & 15;
      float w = 6.283185307179586f * (float)t / 2048.f;
      float fr = 1e-4f + (float)bi * ((15.f - 1e-4f) / 15.f);
      float ang = w * fr;
      val = (e <= 16) ? cosf(ang) : -sinf(ang);
    }
    z[pos * 36 + e] = val;
  }
  __syncthreads();
  {
    const int j = lane;
    float w1r[33];
#pragma unroll
    for (int e = 0; e < 33; ++e) w1r[e] = p.hy_w1[e * 64 + j];
    const float fq = p.hy_freq[j], b1 = p.hy_b1[j];
#pragma unroll 1
    for (int q = 0; q < 16; ++q) {
      const int pos = wid * 16 + q;
      const float4* zp = (const float4*)(z + pos * 36);
      float a = b1;
#pragma unroll
      for (int e4 = 0; e4 < 8; ++e4) {
        float4 zv = zp[e4];
        a += zv.x * w1r[4 * e4] + zv.y * w1r[4 * e4 + 1] + zv.z * w1r[4 * e4 + 2] + zv.w * w1r[4 * e4 + 3];
      }
      a += z[pos * 36 + 32] * w1r[32];
      h1[pos * 64 + j] = __sinf(fq * a);
    }
  }
  __syncthreads();
  {
    const int j = lane;
    float w2r[64];
#pragma unroll
    for (int e = 0; e < 64; ++e) w2r[e] = p.hy_w2[e * 64 + j];
    const float fq = p.hy_freq[j], b2 = p.hy_b2[j];
#pragma unroll 1
    for (int q = 0; q < 16; ++q) {
      const int pos = wid * 16 + q;
      const float4* hp = (const float4*)(h1 + pos * 64);
      float a = b2;
#pragma unroll
      for (int e4 = 0; e4 < 16; ++e4) {
        float4 hv = hp[e4];
        a += hv.x * w2r[4 * e4] + hv.y * w2r[4 * e4 + 1] + hv.z * w2r[4 * e4 + 2] + hv.w * w2r[4 * e4 + 3];
      }
      h2[pos * 68 + j] = __sinf(fq * a);
    }
  }
  __syncthreads();
  const int colw = cc * 512 + wid * 64;
  bf16x8_t Ahi[2][4], Alo[2][4];
#pragma unroll
  for (int ct = 0; ct < 2; ++ct)
#pragma unroll
    for (int ks = 0; ks < 4; ++ks) {
      float v[8];
#pragma unroll
      for (int j = 0; j < 8; ++j) v[j] = p.hy_w3[(size_t)(16 * ks + 8 * h + j) * 8192 + colw + ct * 32 + r];
      split8(v, Ahi[ct][ks], Alo[ct][ks]);
    }
  const int o = cc >> 3, dir = (cc >> 2) & 1;
  u16* Rg = (u16*)(p.ws + OFF_FILT) + (size_t)o * 2048 * 4096;
  const float min_decay = -3.0701134573253945f, max_decay = -15.350567286626972f;
#pragma unroll 1
  for (int pp = 0; pp < 2; ++pp) {
    f32x16_t acc[2][2];
#pragma unroll
    for (int ct = 0; ct < 2; ++ct)
#pragma unroll
      for (int q = 0; q < 2; ++q)
#pragma unroll
        for (int i = 0; i < 16; ++i) acc[ct][q][i] = 0.f;
#pragma unroll
    for (int q = 0; q < 2; ++q)
#pragma unroll
      for (int ks = 0; ks < 4; ++ks) {
        const float* hp = h2 + ((pp * 2 + q) * 32 + r) * 68 + 16 * ks + 8 * h;
        float4 x0 = *(const float4*)hp, x1 = *(const float4*)(hp + 4);
        float v[8] = {x0.x, x0.y, x0.z, x0.w, x1.x, x1.y, x1.z, x1.w};
        bf16x8_t Bhi, Blo;
        split8(v, Bhi, Blo);
#pragma unroll
        for (int ct = 0; ct < 2; ++ct) {
          acc[ct][q] = __builtin_amdgcn_mfma_f32_32x32x16_bf16(Ahi[ct][ks], Bhi, acc[ct][q], 0, 0, 0);
          acc[ct][q] = __builtin_amdgcn_mfma_f32_32x32x16_bf16(Ahi[ct][ks], Blo, acc[ct][q], 0, 0, 0);
          acc[ct][q] = __builtin_amdgcn_mfma_f32_32x32x16_bf16(Alo[ct][ks], Bhi, acc[ct][q], 0, 0, 0);
        }
      }
    int hh = h;
    asm volatile("" : "+v"(hh));
#pragma unroll
    for (int ct = 0; ct < 2; ++ct)
#pragma unroll
      for (int i = 0; i < 16; ++i) {
        const int col = colw + ct * 32 + (i & 3) + 8 * (i >> 2) + 4 * hh;
        const int ch = col & 2047;
        const float b3 = p.hy_b3[col];
        const float ad = fabsf(min_decay + (float)ch * ((max_decay - min_decay) / 2047.f));
        u16* R = Rg + (size_t)ch * 4096;
#pragma unroll
        for (int q = 0; q < 2; ++q) {
          const int t = pg * 128 + (pp * 2 + q) * 32 + r;
          const float tn = (float)t / 2047.f;
          float v = (acc[ct][q][i] + b3) * (__expf(-tn * ad) + 0.05f);
          if (dir == 0) {
            if (t == 0) v += p.hy_bias_d[o * 2048 + ch];
            R[2048 - t] = f2bf(v);
          } else {
            if (t > 0) R[2048 + t] = f2bf(v);
            else R[0] = 0;
          }
        }
      }
  }
  __syncthreads();
}

constexpr int N_CV_AI = 16 * 40, N_CV_AO = 16 * 16, N_CV_HI = 16 * 64, N_CV_HO = 16 * 16;
constexpr int N_CV = N_CV_AI + N_CV_AO + N_CV_HI + N_CV_HO;
#define CV_DECODE(I, W_, Wt_, N_, tk_, tn_, perm_) do { int _i = (I); \
    const bool _a = _i < N_CV_AI, _b2 = _i < N_CV_AI + N_CV_AO, _c = _i < N_CV_AI + N_CV_AO + N_CV_HI; \
    W_ = _a ? p.attn_w_in : (_b2 ? p.attn_w_out : (_c ? p.hy_w_in : p.hy_w_out)); \
    Wt_ = (u16*)(p.ws + (_a ? OFF_WT_AI : (_b2 ? OFF_WT_AO : (_c ? OFF_WT_HI : OFF_WT_HO)))); \
    N_ = _a ? 5120 : (_b2 ? 2048 : (_c ? 8192 : 2048)); \
    const int _nt = _a ? 40 : (_b2 ? 16 : (_c ? 64 : 16)); \
    _i -= _a ? 0 : (_b2 ? N_CV_AI : (_c ? N_CV_AI + N_CV_AO : N_CV_AI + N_CV_AO + N_CV_HI)); \
    tk_ = _i / _nt; tn_ = _i - tk_ * _nt; perm_ = _a && (tn_ * 128 < 2560); } while (0)
__device__ __forceinline__ void p0_convert_all(const Params& p, float* sm) {
  const int tid = threadIdx.x;
  float4 r0, r1, r2, r3, r4, r5, r6, r7;
#define CV_LOAD(W_, N_, tk_, tn_) do { const float* _b = (W_) + (size_t)((tk_) * 128 + (tid >> 5)) * (N_) + (tn_) * 128 + (tid & 31) * 4; const size_t _s = (size_t)16 * (N_); \
    r0 = *(const float4*)(_b); r1 = *(const float4*)(_b + _s); r2 = *(const float4*)(_b + 2 * _s); r3 = *(const float4*)(_b + 3 * _s); \
    r4 = *(const float4*)(_b + 4 * _s); r5 = *(const float4*)(_b + 5 * _s); r6 = *(const float4*)(_b + 6 * _s); r7 = *(const float4*)(_b + 7 * _s); } while (0)
#define CV_PUT(R, I) do { float* _d = sm + ((tid >> 5) + 16 * (I)) * 129 + (tid & 31) * 4; _d[0] = (R).x; _d[1] = (R).y; _d[2] = (R).z; _d[3] = (R).w; } while (0)
  int it = blockIdx.x;
  const float* cW; u16* cWt; int cN, ctk, ctn; bool cperm;
  CV_DECODE(it < N_CV ? it : 0, cW, cWt, cN, ctk, ctn, cperm);
  if (it < N_CV) CV_LOAD(cW, cN, ctk, ctn);
  while (it < N_CV) {
    __syncthreads();
    CV_PUT(r0, 0); CV_PUT(r1, 1); CV_PUT(r2, 2); CV_PUT(r3, 3); CV_PUT(r4, 4); CV_PUT(r5, 5); CV_PUT(r6, 6); CV_PUT(r7, 7);
    __syncthreads();
    const int nit = it + gridDim.x;
    const float* nW; u16* nWt; int nN, ntk, ntn; bool nperm;
    CV_DECODE(nit < N_CV ? nit : 0, nW, nWt, nN, ntk, ntn, nperm);
    if (nit < N_CV) CV_LOAD(nW, nN, ntk, ntn);
    const int row = (tid & 15) | (((tid >> 6) & 7) << 4);
    int src = row;
    if (cperm) { const int g = row >> 5, w = row & 31, i16 = 4 * (w >> 3) + (w & 3), nn = (w >> 2) & 1; src = (g >> 1) * 64 + nn * 32 + (g & 1) * 16 + i16; }
#pragma unroll
    for (int i = 0; i < 4; ++i) {
      const int kch = ((tid >> 4) & 3) | (i << 2);
      unsigned w[4];
#pragma unroll
      for (int j = 0; j < 4; ++j) {
        float a = sm[(kch * 8 + 2 * j) * 129 + src];
        float b = sm[(kch * 8 + 2 * j + 1) * 129 + src];
        w[j] = pk2(a, b);
      }
      *(uint4*)(cWt + (size_t)(ctn * 128 + row) * 2048 + ctk * 128 + kch * 8) = make_uint4(w[0], w[1], w[2], w[3]);
    }
    cW = nW; cWt = nWt; cN = nN; ctk = ntk; ctn = ntn; cperm = nperm;
    it = nit;
  }
#undef CV_LOAD
#undef CV_PUT
}

__device__ __forceinline__ void phase0(const Params& p, float* sm) {
  for (int it = blockIdx.x; it < 256; it += gridDim.x) p0_adaln(p, it, sm);
  if (blockIdx.x == gridDim.x - 1) p0_rope(p);
  __syncthreads();
  for (int it = blockIdx.x; it < 256; it += gridDim.x) p0_filter(p, it, sm);
  __syncthreads();
  p0_convert_all(p, sm);
}

__device__ __forceinline__ void norm_row(const float* __restrict__ src, const float* __restrict__ g, const float* shift,
                         const float* scale, u16* dst_bf, float* dst_f, int lane) {
  float4 v[8];
  float ss = 0.f;
#pragma unroll
  for (int j = 0; j < 8; ++j) {
    v[j] = *(const float4*)(src + (j * 64 + lane) * 4);
    ss += v[j].x * v[j].x + v[j].y * v[j].y + v[j].z * v[j].z + v[j].w * v[j].w;
  }
  ss = wave_sum(ss);
  float r = rsqrtf(ss * (1.f / 2048.f) + 1e-6f);
#pragma unroll
  for (int j = 0; j < 8; ++j) {
    int c = (j * 64 + lane) * 4;
    float4 gg = *(const float4*)(g + c);
    float4 o = make_float4(v[j].x * r * gg.x, v[j].y * r * gg.y, v[j].z * r * gg.z, v[j].w * r * gg.w);
    if (dst_bf) {
      float4 sh = *(const float4*)(shift + c);
      float4 sc = *(const float4*)(scale + c);
      o.x = o.x * (1.f + sc.x) + sh.x; o.y = o.y * (1.f + sc.y) + sh.y;
      o.z = o.z * (1.f + sc.z) + sh.z; o.w = o.w * (1.f + sc.w) + sh.w;
      uint2 pk;
      pk.x = pk2(o.x, o.y);
      pk.y = pk2(o.z, o.w);
      *(uint2*)(dst_bf + c) = pk;
    } else {
      *(float4*)(dst_f + c) = o;
    }
  }
}

__device__ __forceinline__ void phase_norm(const Params& p, int mode) {
  const int wid = threadIdx.x >> 6, lane = threadIdx.x & 63;
  const float* mod = (const float*)(p.ws + OFF_MOD);
  int nrows = (mode == 0) ? (MT + MC) : MT;
  for (int row = blockIdx.x * 8 + wid; row < nrows; row += gridDim.x * 8) {
    if (mode == 0) {
      if (row < MT) {
        int b = row >> 11;
        const float* m = mod + (0 * 5 + b) * 6144;
        norm_row(p.x + (size_t)row * 2048, p.norm_g, m, m + 2048, (u16*)(p.ws + OFF_ACT) + (size_t)row * 2048, nullptr, lane);
      } else {
        int rc = row - MT;
        const float* m = mod + (0 * 5 + 4) * 6144;
        norm_row(p.ctx + (size_t)rc * 2048, p.norm_g, m, m + 2048, (u16*)(p.ws + OFF_HC) + (size_t)rc * 2048, nullptr, lane);
      }
    } else if (mode == 1) {
      int b = row >> 11;
      const float* m = mod + (1 * 5 + b) * 6144;
      norm_row(p.out + (size_t)row * 2048, p.norm_g + 2048, m, m + 2048, (u16*)(p.ws + OFF_ACT) + (size_t)row * 2048, nullptr, lane);
    } else {
      norm_row(p.out + (size_t)row * 2048, p.final_g, nullptr, nullptr, nullptr, p.out + (size_t)row * 2048, lane);
    }
  }
}

namespace pg8 {
#define PG8_LAS __attribute__((address_space(3)))
typedef unsigned short bf16_t;
typedef short bf16x8 __attribute__((ext_vector_type(8)));
typedef float f32x4 __attribute__((ext_vector_type(4)));
typedef unsigned u32x4 __attribute__((ext_vector_type(4)));
constexpr int BM = 256, BK = 64, HALF = 128, HTB = HALF * BK * 2  , STAGE_BYTES = 8 * HTB, NXCD = 8, WGM = 4;

__host__ __device__ __forceinline__ int lds_byte(int r, int c) { const int st = (r >> 4) * 2 + (c >> 5), rr = r & 15, cc = c & 31, ob = rr * 64 + cc * 2; return st * 1024 + (ob ^ (((ob >> 9) & 1) << 5)); }
__host__ __device__ __forceinline__ void stage_rc(int b, int& R, int& C) { const int st = b / 1024, sb = b % 1024, swz = sb ^ (((sb >> 9) & 1) << 5); R = (st >> 1) * 16 + swz / 64; C = (st & 1) * 32 + (swz % 64) / 2; }
__host__ __device__ __forceinline__ int perm32(int rho) { const int n = rho >> 4, i = rho & 15; return 8 * (i >> 2) + 4 * n + (i & 3); }

struct Unit { int pm, pn; };
struct Gemm { const bf16_t* A; const bf16_t* Bt; int M, N, K; int agroup; };

struct StaticOrder {
    int nM, nN, nwg, G, c;
    __host__ __device__ void init(int M, int N, int G_, int c_) { nM = M / BM; nN = N / BM; nwg = nM * nN; G = G_; c = c_; }
    __host__ __device__ bool next(int i, Unit& u) const {
        const long L = (long)i * G + c; if (L >= nwg) return false;
        int wgid = (int)L; { const int q = nwg / NXCD, r = nwg % NXCD, xcd = wgid % NXCD, off = wgid / NXCD; wgid = (xcd < r ? xcd * (q + 1) : r * (q + 1) + (xcd - r) * q) + off; }
        const int nig = WGM * nN, gid = wgid / nig, fm = gid * WGM, gsz = (nM - fm) < WGM ? (nM - fm) : WGM;
        u.pm = fm + ((wgid % nig) % gsz); u.pn = (wgid % nig) / gsz; return true;
    }
    __device__ __forceinline__ void a_ready(const Unit&) const {}
    __device__ __forceinline__ void done(const Unit&) const {}
};
__device__ __forceinline__ unsigned cvt_pk_bf16(float lo, float hi) { unsigned r; asm volatile("v_cvt_pk_bf16_f32 %0, %1, %2" : "=v"(r) : "v"(lo), "v"(hi)); return r; }
template <class Epi, class Sched, bool AGROUP = false>
__device__ __forceinline__ void gemm_phase(PG8_LAS unsigned char* lds, const Gemm g, const Sched& S, const Epi& E) {
    const int tid = threadIdx.x, wid = __builtin_amdgcn_readfirstlane(tid >> 6), lane = tid & 63, wr = wid >> 2, wc = wid & 3, fr = lane & 15, fq = lane >> 4;
    const int K = g.K, nt = K / BK;
    unsigned voffA[2], voffB[2];
#pragma unroll
    for (int i = 0; i < 2; ++i) { int R, C; stage_rc(tid * 16 + i * 8192, R, C); const int Rb = Epi::PERM ? ((R & ~31) + perm32(R & 31)) : R;
        voffA[i] = AGROUP ? (unsigned)((C >> 3) * g.M + R) * 16u : (unsigned)(R * K + C) * 2u; voffB[i] = (unsigned)(Rb * K + C) * 2u; }
    const size_t kstep = (size_t)(BK * 2);
    const size_t hstep = (size_t)HALF * K * 2;
    const size_t tstep = 2 * hstep;
    const size_t kstepA = AGROUP ? (size_t)(BK / 8) * g.M * 16 : kstep, hstepA = AGROUP ? (size_t)HALF * 16 : hstep, tstepA = 2 * hstepA;
    const unsigned ldsw = (unsigned)wid * 1024u;
    const int aoff = lds_byte(wr * 64 + fr, fq * 8), boff = lds_byte(wc * 32 + fr, fq * 8);
#define PG8_SA(b, h) (((b) * 2 + (h)) * HTB)
#define PG8_SB(b, h) ((4 + (b) * 2 + (h)) * HTB)
#define PG8_STAGE(bufoff, gbase, voff) do { _Pragma("unroll") for (int _i = 0; _i < 2; ++_i) \
        __builtin_amdgcn_global_load_lds((const unsigned*)((const char*)(gbase) + (voff)[_i]), (PG8_LAS unsigned*)(lds + (bufoff) + ldsw + _i * 8192), 16, 0, 0); } while (0)
#define PG8_LDA(dst, b, h) do { _Pragma("unroll") for (int m = 0; m < 4; ++m) _Pragma("unroll") for (int k = 0; k < 2; ++k) dst[m][k] = *(const PG8_LAS bf16x8*)(lds + PG8_SA(b, h) + aoff + m * 2048 + k * 1024); } while (0)
#define PG8_LDB(dst, b, h) do { _Pragma("unroll") for (int n = 0; n < 2; ++n) _Pragma("unroll") for (int k = 0; k < 2; ++k) dst[n][k] = *(const PG8_LAS bf16x8*)(lds + PG8_SB(b, h) + boff + n * 2048 + k * 1024); } while (0)
#define PG8_MMA(ai, bj, At, Bt) do { __builtin_amdgcn_s_setprio(1); _Pragma("unroll") for (int m = 0; m < 4; ++m) _Pragma("unroll") for (int n = 0; n < 2; ++n) _Pragma("unroll") for (int k = 0; k < 2; ++k) \
        acc[ai][bj][m][n] = __builtin_amdgcn_mfma_f32_16x16x32_bf16(Bt[n][k], At[m][k], acc[ai][bj][m][n], 0, 0, 0); __builtin_amdgcn_s_setprio(0); } while (0)
#define PG8_WAIT_V(n) asm volatile("s_waitcnt vmcnt(" #n ")" ::: "memory")
#define PG8_WAIT_L(n) asm volatile("s_waitcnt lgkmcnt(" #n ")" ::: "memory")
#define PG8_BAR __builtin_amdgcn_s_barrier()
#define PG8_SCHED __builtin_amdgcn_sched_barrier(0)
    Unit cur, nxt; int ui = 0;
    if (!S.next(0, cur)) return;
    f32x4 acc[2][2][4][2];
#pragma unroll
    for (int a = 0; a < 2; ++a)
#pragma unroll
        for (int b = 0; b < 2; ++b)
#pragma unroll
            for (int m = 0; m < 4; ++m)
#pragma unroll
                for (int n = 0; n < 2; ++n) acc[a][b][m][n] = (f32x4){0.f, 0.f, 0.f, 0.f};
    bf16x8 At[4][2], B0[2][2], B1[2][2];
    const char* cA = (const char*)g.A + (size_t)cur.pm * tstepA; const char* cB = (const char*)g.Bt + (size_t)cur.pn * tstep;
    S.a_ready(cur);
    PG8_STAGE(PG8_SB(0, 0), cB, voffB); PG8_STAGE(PG8_SA(0, 0), cA, voffA); PG8_STAGE(PG8_SB(0, 1), cB + hstep, voffB); PG8_STAGE(PG8_SA(0, 1), cA + hstepA, voffA);
    if (wr == 1) PG8_BAR;
    PG8_WAIT_V(4); PG8_BAR;
    PG8_STAGE(PG8_SB(1, 0), cB + kstep, voffB); PG8_STAGE(PG8_SA(1, 0), cA + kstepA, voffA); PG8_STAGE(PG8_SB(1, 1), cB + hstep + kstep, voffB);
    PG8_WAIT_V(6); PG8_BAR;
    for (;;) {
        const bool has_next = S.next(ui + 1, nxt);
        const char* nA = has_next ? (const char*)g.A + (size_t)nxt.pm * tstepA : cA; const char* nB = has_next ? (const char*)g.Bt + (size_t)nxt.pn * tstep : cB;
        for (int t = 0; t < nt; t += 2) {
            const bool last = (t == nt - 2);
            const char* a1 = cA + (size_t)(t + 1) * kstepA;
            const char* a2 = last ? nA : cA + (size_t)(t + 2) * kstepA; const char* b2 = last ? nB : cB + (size_t)(t + 2) * kstep;
            const char* a3 = a2 + kstepA; const char* b3 = b2 + kstep;
            if (last && has_next) S.a_ready(nxt);
            PG8_LDB(B0, 0, 0); PG8_SCHED; PG8_LDA(At, 0, 0); PG8_STAGE(PG8_SA(1, 1), a1 + hstepA, voffA);
            PG8_WAIT_L(8); PG8_BAR; PG8_WAIT_L(0); PG8_MMA(0, 0, At, B0); PG8_BAR; PG8_SCHED;
            PG8_LDB(B1, 0, 1); PG8_STAGE(PG8_SB(0, 0), b2, voffB);
            PG8_BAR; PG8_WAIT_L(0); PG8_MMA(0, 1, At, B1); PG8_BAR;
            PG8_LDA(At, 0, 1); PG8_STAGE(PG8_SA(0, 0), a2, voffA);
            PG8_BAR; PG8_WAIT_L(0); PG8_MMA(1, 0, At, B0); PG8_BAR; PG8_SCHED;
            PG8_STAGE(PG8_SB(0, 1), b2 + hstep, voffB);
            PG8_WAIT_V(6); PG8_BAR; PG8_MMA(1, 1, At, B1); PG8_BAR;
            PG8_LDB(B0, 1, 0); PG8_SCHED; PG8_LDA(At, 1, 0); PG8_STAGE(PG8_SA(0, 1), a2 + hstepA, voffA);
            PG8_WAIT_L(8); PG8_BAR; PG8_WAIT_L(0); PG8_MMA(0, 0, At, B0); PG8_BAR; PG8_SCHED;
            PG8_LDB(B1, 1, 1); PG8_STAGE(PG8_SB(1, 0), b3, voffB);
            PG8_BAR; PG8_WAIT_L(0); PG8_MMA(0, 1, At, B1); PG8_BAR;
            PG8_LDA(At, 1, 1); PG8_STAGE(PG8_SA(1, 0), a3, voffA);
            PG8_BAR; PG8_WAIT_L(0); PG8_MMA(1, 0, At, B0); PG8_BAR; PG8_SCHED;
            PG8_STAGE(PG8_SB(1, 1), b3 + hstep, voffB);
            PG8_WAIT_V(6); PG8_BAR; PG8_MMA(1, 1, At, B1); PG8_BAR;
        }
        if constexpr (!Epi::AFTER_DRAIN) { E(acc, cur, wr, wc, fr, fq); S.done(cur); }
        if (!has_next) break;
#pragma unroll
        for (int a = 0; a < 2; ++a)
#pragma unroll
            for (int b = 0; b < 2; ++b)
#pragma unroll
                for (int m = 0; m < 4; ++m)
#pragma unroll
                    for (int n = 0; n < 2; ++n) acc[a][b][m][n] = (f32x4){0.f, 0.f, 0.f, 0.f};
        cur = nxt; cA = nA; cB = nB; ++ui;
    }
    PG8_WAIT_V(0);
    if (wr == 0) PG8_BAR;
    PG8_BAR;
    if constexpr (Epi::AFTER_DRAIN) { E.fused(acc, cur, wr, wc, fr, fq, lds, wid, lane); S.done(cur); }
#undef PG8_SA
#undef PG8_SB
#undef PG8_STAGE
#undef PG8_LDA
#undef PG8_LDB
#undef PG8_MMA
#undef PG8_WAIT_V
#undef PG8_WAIT_L
#undef PG8_BAR
#undef PG8_SCHED
}
}

__device__ __forceinline__ uint2 pack4(pg8::f32x4 v) {
  uint2 r;
  r.x = pk2(v[0], v[1]);
  r.y = pk2(v[2], v[3]);
  return r;
}
struct EpiAttnIn {
  static constexpr bool PERM = true, AFTER_DRAIN = false;
  u16* O; const float* rope;
  __device__ __forceinline__ void operator()(const pg8::f32x4 (&acc)[2][2][4][2], const pg8::Unit& u, int wr, int wc, int fr, int fq) const {
    const int row0 = u.pm * 256 + wr * 64 + fr, col0 = u.pn * 256 + wc * 32 + 8 * fq;
    const bool dorope = (u.pn < 10);
    const int axis = wc >> 1, i0 = (wc & 1) * 16 + 4 * fq;
#pragma unroll
    for (int ai = 0; ai < 2; ++ai)
#pragma unroll
      for (int m = 0; m < 4; ++m) {
        const int row = row0 + ai * 128 + m * 16;
        u16* rowp = O + (size_t)row * 5120 + col0;
        if (dorope) {
          const int s = row & 2047;
          const int pos = axis ? (s & 63) : (s >> 6);
          const float4* rp = (const float4*)(rope + (pos * 32 + i0) * 2);
          float4 c01 = rp[0], c23 = rp[1];
#pragma unroll
          for (int bj = 0; bj < 2; ++bj) {
            pg8::f32x4 a = acc[ai][bj][m][0], b = acc[ai][bj][m][1], o0, o1;
            o0[0] = a[0] * c01.x - b[0] * c01.y; o1[0] = b[0] * c01.x + a[0] * c01.y;
            o0[1] = a[1] * c01.z - b[1] * c01.w; o1[1] = b[1] * c01.z + a[1] * c01.w;
            o0[2] = a[2] * c23.x - b[2] * c23.y; o1[2] = b[2] * c23.x + a[2] * c23.y;
            o0[3] = a[3] * c23.z - b[3] * c23.w; o1[3] = b[3] * c23.z + a[3] * c23.w;
            const uint2 lo = pack4(o0), hi = pack4(o1);
            *(uint4*)(rowp + bj * 128) = make_uint4(lo.x, lo.y, hi.x, hi.y);
          }
        } else {
#pragma unroll
          for (int bj = 0; bj < 2; ++bj) {
            const uint2 lo = pack4(acc[ai][bj][m][0]), hi = pack4(acc[ai][bj][m][1]);
            *(uint4*)(rowp + bj * 128) = make_uint4(lo.x, lo.y, hi.x, hi.y);
          }
        }
      }
  }
};
struct EpiRaw {
  static constexpr bool PERM = true, AFTER_DRAIN = false;
  u16* O; int ldc;
  __device__ __forceinline__ void operator()(const pg8::f32x4 (&acc)[2][2][4][2], const pg8::Unit& u, int wr, int wc, int fr, int fq) const {
    const int row0 = u.pm * 256 + wr * 64 + fr, col0 = u.pn * 256 + wc * 32 + 8 * fq;
#pragma unroll
    for (int ai = 0; ai < 2; ++ai)
#pragma unroll
      for (int m = 0; m < 4; ++m) {
        u16* rowp = O + (size_t)(row0 + ai * 128 + m * 16) * ldc + col0;
#pragma unroll
        for (int bj = 0; bj < 2; ++bj) {
          const uint2 lo = pack4(acc[ai][bj][m][0]), hi = pack4(acc[ai][bj][m][1]);
          *(uint4*)(rowp + bj * 128) = make_uint4(lo.x, lo.y, hi.x, hi.y);
        }
      }
  }
};
struct EpiRes {
  static constexpr bool PERM = false, AFTER_DRAIN = false;
  float* out; const float* base; const float* gate;
  __device__ __forceinline__ void operator()(const pg8::f32x4 (&acc)[2][2][4][2], const pg8::Unit& u, int wr, int wc, int fr, int fq) const {
    const int row0 = u.pm * 256 + wr * 64 + fr, col0 = u.pn * 256 + wc * 32 + 4 * fq;
    const int b = (u.pm * 256) >> 11;
    pg8::f32x4 gv[2][2];
#pragma unroll
    for (int bj = 0; bj < 2; ++bj)
#pragma unroll
      for (int n = 0; n < 2; ++n) gv[bj][n] = *(const pg8::f32x4*)(gate + b * 6144 + col0 + bj * 128 + n * 16);
#pragma unroll
    for (int ai = 0; ai < 2; ++ai)
#pragma unroll
      for (int m = 0; m < 4; ++m) {
        const size_t off = (size_t)(row0 + ai * 128 + m * 16) * 2048 + col0;
#pragma unroll
        for (int bj = 0; bj < 2; ++bj)
#pragma unroll
          for (int n = 0; n < 2; ++n) {
            pg8::f32x4 bv = *(const pg8::f32x4*)(base + off + bj * 128 + n * 16);
            *(pg8::f32x4*)(out + off + bj * 128 + n * 16) = bv + gv[bj][n] * acc[ai][bj][m][n];
          }
      }
  }
};

struct EpiResNorm {
  static constexpr bool PERM = false, AFTER_DRAIN = true;
  float* out; const float* base; const float* gate;
  float* rowss; unsigned* pcnt;
  const float* g; const float* shsc;
  u16* hx;
  static __device__ __forceinline__ int loff(int row, int chunk) { return row * 1024 + ((chunk ^ (row & 63)) << 4); }
  __device__ __forceinline__ void fused(pg8::f32x4 (&acc)[2][2][4][2], const pg8::Unit& u, int wr, int wc, int fr, int fq,
                                        PG8_LAS unsigned char* lds, int wid, int lane) const {
    const int R0 = u.pm * 256, C0 = u.pn * 256;
    const int b = R0 >> 11;
    const int frow = wr * 64 + fr, fchunk = wc * 8 + fq;
    {
      pg8::f32x4 gv[2][2];
#pragma unroll
      for (int bj = 0; bj < 2; ++bj)
#pragma unroll
        for (int n = 0; n < 2; ++n) gv[bj][n] = *(const pg8::f32x4*)(gate + b * 6144 + C0 + wc * 32 + 4 * fq + bj * 128 + n * 16);
#pragma unroll
      for (int ai = 0; ai < 2; ++ai) {
        {
          pg8::f32x4 t[16];
#pragma unroll
          for (int i = 0; i < 16; ++i) t[i] = *(const pg8::f32x4*)(base + (size_t)(R0 + ai * 128 + wid * 16 + i) * 2048 + C0 + 4 * lane);
#pragma unroll
          for (int i = 0; i < 16; ++i) *(PG8_LAS pg8::f32x4*)(lds + loff(wid * 16 + i, lane)) = t[i];
        }
        __syncthreads();
#pragma unroll
        for (int m = 0; m < 4; ++m) {
          float ss = 0.f;
#pragma unroll
          for (int bj = 0; bj < 2; ++bj)
#pragma unroll
            for (int n = 0; n < 2; ++n) {
              const pg8::f32x4 bv = *(const PG8_LAS pg8::f32x4*)(lds + loff(frow + 16 * m, fchunk + 32 * bj + 4 * n));
              const pg8::f32x4 v = bv + gv[bj][n] * acc[ai][bj][m][n];
              acc[ai][bj][m][n] = v;
              ss += v[0] * v[0] + v[1] * v[1] + v[2] * v[2] + v[3] * v[3];
            }
          ss += __shfl_xor(ss, 16, 64);
          ss += __shfl_xor(ss, 32, 64);
          if (fq == 0) unsafeAtomicAdd(rowss + R0 + ai * 128 + frow + 16 * m, ss);
        }
        __syncthreads();
      }
    }
    asm volatile("s_waitcnt vmcnt(0)" ::: "memory");
    __syncthreads();
    if (threadIdx.x == 0) {
      unsigned* c = pcnt + u.pm * 64;
      __hip_atomic_fetch_add(c, 1u, __ATOMIC_RELAXED, __HIP_MEMORY_SCOPE_AGENT);
      unsigned spins = 0;
      while (__hip_atomic_load(c, __ATOMIC_RELAXED, __HIP_MEMORY_SCOPE_AGENT) < 8u && ++spins < (1u << 22)) __builtin_amdgcn_s_sleep(1);
    }
    __syncthreads();
    const pg8::f32x4 gg = *(const pg8::f32x4*)(g + C0 + 4 * lane);
    pg8::f32x4 sh = gg, sc = gg;
    if (hx) {
      sh = *(const pg8::f32x4*)(shsc + b * 6144 + C0 + 4 * lane);
      sc = *(const pg8::f32x4*)(shsc + b * 6144 + 2048 + C0 + 4 * lane) + 1.f;
    }
#pragma unroll
    for (int ai = 0; ai < 2; ++ai) {
#pragma unroll
      for (int m = 0; m < 4; ++m)
#pragma unroll
        for (int bj = 0; bj < 2; ++bj)
#pragma unroll
          for (int n = 0; n < 2; ++n)
            *(PG8_LAS pg8::f32x4*)(lds + loff(frow + 16 * m, fchunk + 32 * bj + 4 * n)) = acc[ai][bj][m][n];
      __syncthreads();
#pragma unroll 4
      for (int i = 0; i < 16; ++i) {
        const int lrow = wid * 16 + i, row = R0 + ai * 128 + lrow;
        const pg8::f32x4 v = *(const PG8_LAS pg8::f32x4*)(lds + loff(lrow, lane));
        const float ss = __hip_atomic_load(rowss + row, __ATOMIC_RELAXED, __HIP_MEMORY_SCOPE_AGENT);
        const float r = rsqrtf(ss * (1.f / 2048.f) + 1e-6f);
        const size_t off = (size_t)row * 2048 + C0 + 4 * lane;
        pg8::f32x4 o = v * r * gg;
        if (hx) {
          *(pg8::f32x4*)(out + off) = v;
          o = o * sc + sh;
          *(uint2*)(hx + off) = pack4(o);
        } else {
          *(pg8::f32x4*)(out + off) = o;
        }
      }
      __syncthreads();
    }
  }
};
template <class Epi, bool AGROUP = false>
__device__ __forceinline__ void run_gemm(float* sm, const u16* A, const u16* Bt, int M, int N, const Epi& E, int c) {
  pg8::Gemm g{A, Bt, M, N, 2048, AGROUP ? 1 : 0};
  pg8::StaticOrder S; S.init(M, N, (int)gridDim.x, c);
  pg8::gemm_phase<Epi, pg8::StaticOrder, AGROUP>((PG8_LAS unsigned char*)sm, g, S, E);
  __syncthreads();
}

template <int MODE>
__device__ __forceinline__ void epi_pair(const Params& p, int m, int n, float a0, float a1) {
  if (MODE == 1) {
    u16* px = (u16*)(p.ws + OFF_BIG);
    float o0 = a0, o1 = a1;
    if (n < 2560) {
      int g = (n >> 5) & 3, fr = n & 15;
      int axis = g >> 1, i = (g & 1) * 16 + fr;
      int s = m & 2047;
      int pos = axis ? (s & 63) : (s >> 6);
      float2 cs = ((const float2*)(p.ws + OFF_ROPE))[pos * 32 + i];
      o0 = a0 * cs.x - a1 * cs.y;
      o1 = a1 * cs.x + a0 * cs.y;
    }
    px[(size_t)m * 5120 + n] = f2bf(o0);
    px[(size_t)m * 5120 + n + 16] = f2bf(o1);
  } else if (MODE == 5) {
    u16* kvc = (u16*)(p.ws + OFF_KVC);
    kvc[(size_t)m * 1024 + n] = f2bf(a0);
    kvc[(size_t)m * 1024 + n + 16] = f2bf(a1);
  } else if (MODE == 2) {
    const float* mod = (const float*)(p.ws + OFF_MOD);
    int b = m >> 11;
    const float* gate = mod + (0 * 5 + b) * 6144 + 4096;
    p.out[(size_t)m * 2048 + n] = p.x[(size_t)m * 2048 + n] + gate[n] * a0;
    p.out[(size_t)m * 2048 + n + 16] = p.x[(size_t)m * 2048 + n + 16] + gate[n + 16] * a1;
  } else if (MODE == 3) {
    u16* pp = (u16*)(p.ws + OFF_BIG);
    pp[(size_t)m * 8192 + n] = f2bf(a0);
    pp[(size_t)m * 8192 + n + 16] = f2bf(a1);
  } else if (MODE == 4) {
    const float* mod = (const float*)(p.ws + OFF_MOD);
    int b = m >> 11;
    const float* gate = mod + (1 * 5 + b) * 6144 + 4096;
    p.out[(size_t)m * 2048 + n] += gate[n] * a0;
    p.out[(size_t)m * 2048 + n + 16] += gate[n + 16] * a1;
  }
}

template <int MODE>
__device__ __forceinline__ void naive_gemm(const Params& p, const u16* __restrict__ A, const u16* __restrict__ Wt, int M, int N) {
  const int tid = threadIdx.x;
  const int ml = tid >> 5, pl = tid & 31;
  const int ntn = N / 64, ntm = M / 16;
  for (int tile = blockIdx.x; tile < ntn * ntm; tile += gridDim.x) {
    int tm = tile / ntn, tn = tile % ntn;
    int m = tm * 16 + ml;
    int n = tn * 64 + (pl >> 4) * 32 + (pl & 15);
    const uint4* a = (const uint4*)(A + (size_t)m * 2048);
    const uint4* w0 = (const uint4*)(Wt + (size_t)n * 2048);
    const uint4* w1 = (const uint4*)(Wt + (size_t)(n + 16) * 2048);
    float acc0 = 0.f, acc1 = 0.f;
#pragma unroll 2
    for (int k = 0; k < 256; ++k) {
      uint4 av = a[k], b0 = w0[k], b1 = w1[k];
      acc0 += bflo(av.x) * bflo(b0.x) + bfhi(av.x) * bfhi(b0.x) + bflo(av.y) * bflo(b0.y) + bfhi(av.y) * bfhi(b0.y)
            + bflo(av.z) * bflo(b0.z) + bfhi(av.z) * bfhi(b0.z) + bflo(av.w) * bflo(b0.w) + bfhi(av.w) * bfhi(b0.w);
      acc1 += bflo(av.x) * bflo(b1.x) + bfhi(av.x) * bfhi(b1.x) + bflo(av.y) * bflo(b1.y) + bfhi(av.y) * bfhi(b1.y)
            + bflo(av.z) * bflo(b1.z) + bfhi(av.z) * bfhi(b1.z) + bflo(av.w) * bflo(b1.w) + bfhi(av.w) * bfhi(b1.w);
    }
    epi_pair<MODE>(p, m, n, acc0, acc1);
  }
}

__device__ __forceinline__ void phase_attn_naive(const Params& p, float* sm) {
  const int wid = threadIdx.x >> 6, lane = threadIdx.x & 63;
  float* qs = sm + wid * (128 + 640);
  float* pr = qs + 128;
  const u16* px = (const u16*)(p.ws + OFF_BIG);
  const u16* kvc = (const u16*)(p.ws + OFF_KVC);
  u16* og = (u16*)(p.ws + OFF_ACT);
  const float scale = 0.08838834764831845f;
  for (int item = blockIdx.x * 8 + wid; item < MT * 16; item += gridDim.x * 8) {
    int m = item >> 4, h = item & 15;
    int b = m >> 11, s = m & 2047, kvh = h >> 2, nblk = s >> 7;
    const u16* qrow = px + (size_t)m * 5120 + h * 128;
    qs[lane] = bf2f(qrow[lane]) * scale;
    qs[lane + 64] = bf2f(qrow[lane + 64]) * scale;
    asm volatile("s_waitcnt lgkmcnt(0)" ::: "memory");
    float mx = p.attn_sink[h];
#pragma unroll 1
    for (int j = 0; j < 10; ++j) {
      int kidx = j * 64 + lane;
      const u16* krow;
      bool valid;
      if (kidx < 384) {
        int kpos = (nblk - 1) * 128 + kidx;
        int rel = kpos - s;
        valid = (kpos >= 0) && (kpos < 2048) && (rel <= 128) && (rel >= -128);
        krow = px + (size_t)(b * 2048 + (valid ? kpos : 0)) * 5120 + 2048 + kvh * 128;
      } else {
        valid = true;
        krow = kvc + (size_t)(b * 256 + (kidx - 384)) * 1024 + kvh * 128;
      }
      float d = -1e30f;
      if (valid) {
        d = 0.f;
#pragma unroll 4
        for (int c = 0; c < 16; ++c) {
          uint4 kk = *(const uint4*)(krow + c * 8);
          const float* q8 = qs + c * 8;
          d += q8[0] * bflo(kk.x) + q8[1] * bfhi(kk.x) + q8[2] * bflo(kk.y) + q8[3] * bfhi(kk.y)
             + q8[4] * bflo(kk.z) + q8[5] * bfhi(kk.z) + q8[6] * bflo(kk.w) + q8[7] * bfhi(kk.w);
        }
      }
      pr[kidx] = d;
      mx = fmaxf(mx, d);
    }
    mx = wave_max(mx);
    float sum = 0.f;
#pragma unroll 1
    for (int j = 0; j < 10; ++j) {
      float d = pr[j * 64 + lane];
      float e = (d > -1e29f) ? __expf(d - mx) : 0.f;
      pr[j * 64 + lane] = e;
      sum += e;
    }
    sum = wave_sum(sum);
    sum += __expf(p.attn_sink[h] - mx);
    asm volatile("s_waitcnt lgkmcnt(0)" ::: "memory");
    float o0 = 0.f, o1 = 0.f;
    int k0 = s - 128 < 0 ? 0 : s - 128, k1 = s + 128 > 2047 ? 2047 : s + 128;
    for (int kpos = k0; kpos <= k1; ++kpos) {
      float pv = pr[kpos - (nblk - 1) * 128];
      unsigned vv = *(const unsigned*)(px + (size_t)(b * 2048 + kpos) * 5120 + 2560 + kvh * 128 + lane * 2);
      o0 += pv * bflo(vv); o1 += pv * bfhi(vv);
    }
    for (int c = 0; c < 256; ++c) {
      float pv = pr[384 + c];
      unsigned vv = *(const unsigned*)(kvc + (size_t)(b * 256 + c) * 1024 + 512 + kvh * 128 + lane * 2);
      o0 += pv * bflo(vv); o1 += pv * bfhi(vv);
    }
    float inv = 1.f / sum;
    unsigned gg = *(const unsigned*)(px + (size_t)m * 5120 + 3072 + h * 128 + lane * 2);
    float r0 = o0 * inv * siluf(bflo(gg)), r1 = o1 * inv * siluf(bfhi(gg));
    *(unsigned*)(og + (size_t)m * 2048 + h * 128 + lane * 2) = pk2(r0, r1);
    asm volatile("s_waitcnt lgkmcnt(0)" ::: "memory");
  }
}

__device__ __forceinline__ float sconv(const u16* pp, const float* cw, const float* cb, int b, int t, int c) {
  const u16* base = pp + (size_t)(b * 2048 + t) * 8192 + c;
  float v = cw[6144 + c] * bf2f(base[0]) + cb[c];
  if (t > 0) v += cw[c] * bf2f(base[-8192]);
  if (t < 2047) v += cw[2 * 6144 + c] * bf2f(base[8192]);
  return v;
}

__device__ __forceinline__ void phase_conv_naive(const Params& p, float* sm) {
  const int tid = threadIdx.x;
  float* u = sm;
  float* R = sm + 8192;
  const u16* pp = (const u16*)(p.ws + OFF_BIG);
  const u16* Rg = (const u16*)(p.ws + OFF_FILT);
  u16* yg = (u16*)(p.ws + OFF_ACT);
  for (int ch = blockIdx.x; ch < 2048; ch += gridDim.x) {
    for (int i = tid; i < 8192; i += NTHREADS) u[i] = sconv(pp, p.hy_conv_w, p.hy_conv_b, i >> 11, i & 2047, 4096 + ch);
    for (int i = tid; i < 4096; i += NTHREADS) R[i] = bf2f(Rg[((size_t)0 * 2048 + ch) * 4096 + i]);
    __syncthreads();
    float zr[16];
#pragma unroll
    for (int q = 0; q < 16; ++q) {
      int i = tid + q * NTHREADS;
      int b = i >> 11, t = i & 2047;
      const float* ub = u + b * 2048;
      const float* Rb = R + 2048 - t;
      float a = 0.f;
      for (int s = 0; s < 2048; ++s) a += Rb[s] * ub[s];
      zr[q] = a * sconv(pp, p.hy_conv_w, p.hy_conv_b, b, t, ch);
    }
    __syncthreads();
#pragma unroll
    for (int q = 0; q < 16; ++q) u[tid + q * NTHREADS] = zr[q];
    for (int i = tid; i < 4096; i += NTHREADS) R[i] = bf2f(Rg[((size_t)1 * 2048 + ch) * 4096 + i]);
    __syncthreads();
#pragma unroll
    for (int q = 0; q < 16; ++q) {
      int i = tid + q * NTHREADS;
      int b = i >> 11, t = i & 2047;
      const float* ub = u + b * 2048;
      const float* Rb = R + 2048 - t;
      float a = 0.f;
      for (int s = 0; s < 2048; ++s) a += Rb[s] * ub[s];
      float y = a * sconv(pp, p.hy_conv_w, p.hy_conv_b, b, t, 2048 + ch);
      float g = bf2f(pp[(size_t)(b * 2048 + t) * 8192 + 6144 + ch]);
      yg[(size_t)(b * 2048 + t) * 2048 + ch] = f2bf(y * siluf(g));
    }
    __syncthreads();
  }
}


typedef float f32x16 __attribute__((ext_vector_type(16)));
typedef pg8::bf16x8 bfx8;
constexpr int CONV_RF_BYTES = 4 * 2 * 8192;
constexpr int CONV_PAD = 7;
constexpr int CONV_UB_ONE = 316 * 64;
__device__ __forceinline__ int ub_addr(int col, int chunk) { return col * 64 + ((chunk ^ ((col >> 2) & 3)) << 4); }

__device__ __forceinline__ void conv_mfma(const char* Rf_ci, const char* Ub_c, int lane, int jh, f32x16 (&acc)[4]) {
  const int t2 = lane & 31, h = lane >> 5, n = lane & 31;
  const int lanedw = ((2048 - t2 + 8 * h) >> 1) - 512 * jh;
#pragma unroll
  for (int j = 0; j < 4; ++j)
#pragma unroll
    for (int r = 0; r < 16; ++r) acc[j][r] = 0.f;
#pragma unroll 1
  for (int f = 0; f < 8; ++f) {
    bfx8 Bw[9][2];
#pragma unroll
    for (int m = 0; m < 9; ++m) {
      const int col = (8 * m - f + CONV_PAD) * 4 + n;
#pragma unroll
      for (int kh = 0; kh < 2; ++kh) Bw[m][kh] = *(const bfx8*)(Ub_c + ub_addr(col, 2 * kh + h));
    }
    const unsigned* Rp = (const unsigned*)(Rf_ci + ((t2 & 1) ? 8192 : 0)) + lanedw - 16 * f;
#pragma unroll
    for (int e = -8; e <= 3; ++e) {
      int ee = e;
      if (e == -8) ee = (f == 0) ? -7 : -8;
      bfx8 A[2];
#pragma unroll
      for (int kh = 0; kh < 2; ++kh) {
        const unsigned* q = Rp - 128 * ee + 8 * kh;
        pg8::u32x4 pk;
        pk[0] = q[0]; pk[1] = q[1]; pk[2] = q[2]; pk[3] = q[3];
        A[kh] = __builtin_bit_cast(bfx8, pk);
      }
#pragma unroll
      for (int j = 0; j < 4; ++j) {
        const int m = j - e;
        if (m >= 0 && m <= 8) acc[j] = __builtin_amdgcn_mfma_f32_32x32x16_bf16(A[0], Bw[m][0], acc[j], 0, 0, 0);
      }
#pragma unroll
      for (int j = 0; j < 4; ++j) {
        const int m = j - e;
        if (m >= 0 && m <= 8) acc[j] = __builtin_amdgcn_mfma_f32_32x32x16_bf16(A[1], Bw[m][1], acc[j], 0, 0, 0);
      }
    }
  }
}

__device__ __forceinline__ void sconv4(const u16* xp, int t, float w0, float w1, float w2, float cb, float (&o)[4]) {
  uint2 x4 = *(const uint2*)xp;
  float pv = t > 0 ? bf2f(xp[-1]) : 0.f;
  float nx = (t + 4 < 2048) ? bf2f(xp[4]) : 0.f;
  float e0 = bflo(x4.x), e1 = bfhi(x4.x), e2 = bflo(x4.y), e3 = bfhi(x4.y);
  o[0] = w0 * pv + w1 * e0 + w2 * e1 + cb;
  o[1] = w0 * e0 + w1 * e1 + w2 * e2 + cb;
  o[2] = w0 * e1 + w1 * e2 + w2 * e3 + cb;
  o[3] = w0 * e2 + w1 * e3 + w2 * nx + cb;
}

struct SC4 { uint2 x; unsigned pn; };
__device__ __forceinline__ SC4 sc4_load(const u16* xp, int t) {
  SC4 r;
  r.x = *(const uint2*)xp;
  const unsigned pv = t > 0 ? (unsigned)xp[-1] : 0u;
  const unsigned nx = (t + 4 < 2048) ? (unsigned)xp[4] : 0u;
  r.pn = pv | (nx << 16);
  return r;
}
__device__ __forceinline__ void sc4_apply(const SC4& r, float w0, float w1, float w2, float cb, float (&o)[4]) {
  const float pv = bflo(r.pn), nx = bfhi(r.pn);
  const float e0 = bflo(r.x.x), e1 = bfhi(r.x.x), e2 = bflo(r.x.y), e3 = bfhi(r.x.y);
  o[0] = w0 * pv + w1 * e0 + w2 * e1 + cb;
  o[1] = w0 * e0 + w1 * e1 + w2 * e2 + cb;
  o[2] = w0 * e1 + w1 * e2 + w2 * e3 + cb;
  o[3] = w0 * e2 + w1 * e3 + w2 * nx + cb;
}

__device__ __forceinline__ void phase_conv(const Params& p, float* smf) {
  char* sm = (char*)smf;
  char* Rf = sm;
  char* Ub = sm + CONV_RF_BYTES;
  int tid = threadIdx.x;
  asm volatile("" : "+v"(tid));
  const int wid = tid >> 6, lane = tid & 63;
  const int ci = wid >> 1, jh = wid & 1;
  const u16* pT = (const u16*)(p.ws + OFF_BIG);
  const u16* Rg = (const u16*)(p.ws + OFF_FILT);
  u16* yg = (u16*)(p.ws + OFF_ACT);
  for (int kk = 0; kk < (4 * CONV_UB_ONE / 16 + NTHREADS - 1) / NTHREADS; ++kk) { const int zi = tid + kk * NTHREADS; if (zi < 4 * CONV_UB_ONE / 16) ((uint4*)Ub)[zi] = make_uint4(0, 0, 0, 0); }
  __syncthreads();
  char* Ub_w = Ub + ci * CONV_UB_ONE;
  const char* Rf_ci = Rf + ci * 16384;
  const int h = lane >> 5, n = lane & 31;
  for (int it0 = blockIdx.x * 2; it0 < 512; it0 += gridDim.x * 2)
#pragma unroll 1
  for (int sub = 0; sub < 2; ++sub) {
    const int item = it0 + sub;
    const int ch0 = item * 4;
    {
      const int q = tid & 255, hb = tid >> 8;
      uint4 x8[8]; unsigned pn[8]; uint4 fr[4];
#pragma unroll
      for (int k = 0; k < 8; ++k) {
        const int cc = 4096 + ch0 + (k >> 1), b = (k & 1) * 2 + hb;
        const u16* xp = pT + (size_t)cc * 8192 + b * 2048 + q * 8;
        x8[k] = *(const uint4*)xp;
        const unsigned pv = q > 0 ? (unsigned)xp[-1] : 0u;
        const unsigned nx = q < 255 ? (unsigned)xp[8] : 0u;
        pn[k] = pv | (nx << 16);
      }
      unsigned fx[4];
#pragma unroll
      for (int k = 0; k < 4; ++k) {
        const unsigned* fp = (const unsigned*)(Rg + ((size_t)0 * 2048 + ch0 + k) * 4096);
        fr[k] = ((const uint4*)fp)[tid];
        fx[k] = tid < 511 ? fp[4 * tid + 4] : 0u;
      }
#pragma unroll
      for (int k = 0; k < 8; ++k) {
        const int c = k >> 1, cc = 4096 + ch0 + c, b = (k & 1) * 2 + hb;
        const float w0 = p.hy_conv_w[cc], w1 = p.hy_conv_w[6144 + cc], w2 = p.hy_conv_w[2 * 6144 + cc], cb = p.hy_conv_b[cc];
        float e[10];
        e[0] = bflo(pn[k]); e[1] = bflo(x8[k].x); e[2] = bfhi(x8[k].x); e[3] = bflo(x8[k].y); e[4] = bfhi(x8[k].y);
        e[5] = bflo(x8[k].z); e[6] = bfhi(x8[k].z); e[7] = bflo(x8[k].w); e[8] = bfhi(x8[k].w); e[9] = bfhi(pn[k]);
        unsigned o[4];
#pragma unroll
        for (int kk = 0; kk < 4; ++kk) {
          float a = w0 * e[2 * kk] + w1 * e[2 * kk + 1] + w2 * e[2 * kk + 2] + cb;
          float bb = w0 * e[2 * kk + 1] + w1 * e[2 * kk + 2] + w2 * e[2 * kk + 3] + cb;
          o[kk] = pk2(a, bb);
        }
        const int t0 = q * 8, s1 = t0 >> 5, s2 = t0 & 31;
        const int col = (s1 + CONV_PAD) * 4 + b;
        *(uint4*)(Ub + c * CONV_UB_ONE + ub_addr(col, s2 >> 3)) = make_uint4(o[0], o[1], o[2], o[3]);
      }
#pragma unroll
      for (int k = 0; k < 4; ++k) {
        ((uint4*)(Rf + k * 16384))[tid] = fr[k];
        ((uint4*)(Rf + k * 16384 + 8192))[tid] = make_uint4(__builtin_amdgcn_alignbit(fr[k].y, fr[k].x, 16), __builtin_amdgcn_alignbit(fr[k].z, fr[k].y, 16),
                                                             __builtin_amdgcn_alignbit(fr[k].w, fr[k].z, 16), __builtin_amdgcn_alignbit(fx[k], fr[k].w, 16));
      }
    }
    __syncthreads();
    f32x16 acc[4];
    const int ch = ch0 + ci;
    {
      conv_mfma(Rf_ci, Ub_w, lane, jh, acc);
      SC4 xr[16];
#pragma unroll
      for (int j = 0; j < 4; ++j)
#pragma unroll
        for (int vg = 0; vg < 4; ++vg) {
          const int t1 = 8 * (j + 4 * jh) + (n >> 2), b = n & 3, t = 32 * t1 + 8 * vg + 4 * h;
          xr[j * 4 + vg] = sc4_load(pT + (size_t)ch * 8192 + b * 2048 + t, t);
        }
      const unsigned* f1p = (const unsigned*)(Rg + ((size_t)1 * 2048 + ch0) * 4096);
      const uint4 f1a = ((const uint4*)(f1p + 0 * 2048))[tid];
      const uint4 f1b = ((const uint4*)(f1p + 1 * 2048))[tid];
      const uint4 f1c = ((const uint4*)(f1p + 2 * 2048))[tid];
      const uint4 f1d = ((const uint4*)(f1p + 3 * 2048))[tid];
      const unsigned x1a = tid < 511 ? f1p[0 * 2048 + 4 * tid + 4] : 0u, x1b = tid < 511 ? f1p[1 * 2048 + 4 * tid + 4] : 0u;
      const unsigned x1c = tid < 511 ? f1p[2 * 2048 + 4 * tid + 4] : 0u, x1d = tid < 511 ? f1p[3 * 2048 + 4 * tid + 4] : 0u;
      const float w0 = p.hy_conv_w[ch], w1 = p.hy_conv_w[6144 + ch], w2 = p.hy_conv_w[2 * 6144 + ch], cb = p.hy_conv_b[ch];
      __syncthreads();
#pragma unroll
      for (int j = 0; j < 4; ++j)
#pragma unroll
        for (int vg = 0; vg < 4; ++vg) {
          const int t1 = 8 * (j + 4 * jh) + (n >> 2), bl = n & 3;
          float x1[4];
          sc4_apply(xr[j * 4 + vg], w0, w1, w2, cb, x1);
          uint2 pk;
          pk.x = pk2(x1[0] * acc[j][4 * vg + 0], x1[1] * acc[j][4 * vg + 1]);
          pk.y = pk2(x1[2] * acc[j][4 * vg + 2], x1[3] * acc[j][4 * vg + 3]);
          const int col = (t1 + CONV_PAD) * 4 + bl;
          *(uint2*)(Ub_w + ub_addr(col, vg) + 8 * h) = pk;
        }
      __syncthreads();
#define CONV_PUT_F(K, F, X) do { ((uint4*)(Rf + (K) * 16384))[tid] = F; \
        ((uint4*)(Rf + (K) * 16384 + 8192))[tid] = make_uint4(__builtin_amdgcn_alignbit(F.y, F.x, 16), __builtin_amdgcn_alignbit(F.z, F.y, 16), \
                                                               __builtin_amdgcn_alignbit(F.w, F.z, 16), __builtin_amdgcn_alignbit(X, F.w, 16)); } while (0)
      CONV_PUT_F(0, f1a, x1a); CONV_PUT_F(1, f1b, x1b); CONV_PUT_F(2, f1c, x1c); CONV_PUT_F(3, f1d, x1d);
#undef CONV_PUT_F
    }
    __syncthreads();
    {
      const int c2 = 2048 + ch;
      SC4 xr[16]; uint2 gr[16];
      conv_mfma(Rf_ci, Ub_w, lane, jh, acc);
#pragma unroll
      for (int j = 0; j < 4; ++j)
#pragma unroll
        for (int vg = 0; vg < 4; ++vg) {
          const int t1 = 8 * (j + 4 * jh) + (n >> 2), b = n & 3, t = 32 * t1 + 8 * vg + 4 * h;
          xr[j * 4 + vg] = sc4_load(pT + (size_t)c2 * 8192 + b * 2048 + t, t);
          gr[j * 4 + vg] = *(const uint2*)(pT + (size_t)(6144 + ch) * 8192 + b * 2048 + t);
        }
      const float w0 = p.hy_conv_w[c2], w1 = p.hy_conv_w[6144 + c2], w2 = p.hy_conv_w[2 * 6144 + c2], cb = p.hy_conv_b[c2];
      __syncthreads();
#pragma unroll
      for (int j = 0; j < 4; ++j)
#pragma unroll
        for (int vg = 0; vg < 4; ++vg) {
          const int t1 = 8 * (j + 4 * jh) + (n >> 2), bl = n & 3;
          float x2[4];
          sc4_apply(xr[j * 4 + vg], w0, w1, w2, cb, x2);
          const uint2 g4 = gr[j * 4 + vg];
          float y0 = x2[0] * acc[j][4 * vg + 0] * siluf(bflo(g4.x));
          float y1 = x2[1] * acc[j][4 * vg + 1] * siluf(bfhi(g4.x));
          float y2 = x2[2] * acc[j][4 * vg + 2] * siluf(bflo(g4.y));
          float y3 = x2[3] * acc[j][4 * vg + 3] * siluf(bfhi(g4.y));
          uint2 pk;
          pk.x = pk2(y0, y1);
          pk.y = pk2(y2, y3);
          const int col = (t1 + CONV_PAD) * 4 + bl;
          *(uint2*)(Ub_w + ub_addr(col, vg) + 8 * h) = pk;
        }
    }
    __syncthreads();
    int tw = tid;
    asm volatile("" : "+v"(tw));
#pragma unroll 4
    for (int kk = 0; kk < 16; ++kk) {
      const int idx = tw + kk * NTHREADS;
      const int b = idx >> 11, t = idx & 2047;
      const int s1 = t >> 5, s2 = t & 31;
      const int col = (s1 + CONV_PAD) * 4 + b;
      const int a = ub_addr(col, s2 >> 3) + (s2 & 7) * 2;
      const char* base = Ub + a;
      unsigned v0 = *(const u16*)(base + 0 * CONV_UB_ONE), v1 = *(const u16*)(base + 1 * CONV_UB_ONE);
      unsigned v2 = *(const u16*)(base + 2 * CONV_UB_ONE), v3 = *(const u16*)(base + 3 * CONV_UB_ONE);
      const uint2 cur = make_uint2(v0 | (v1 << 16), v2 | (v3 << 16));
      *(uint2*)(yg + ((size_t)(item >> 1) * 8192 + idx) * 8 + (item & 1) * 4) = cur;
    }
    __syncthreads();
  }
}

constexpr int AT_KROW = 272, AT_VROW = 136;
constexpr int AT_K_BYTES = 64 * AT_KROW, AT_V_BYTES = 128 * AT_VROW;
__device__ __forceinline__ void phase_attn(const Params& p, float* smf) {
  char* sm = (char*)smf;
  char* Ks = sm;
  char* Vs = sm + AT_K_BYTES;
  const int tid = threadIdx.x, wid = tid >> 6, lane = tid & 63, r = lane & 31, h = lane >> 5;
  const u16* px = (const u16*)(p.ws + OFF_BIG);
  const u16* kvc = (const u16*)(p.ws + OFF_KVC);
  const u16* vT = (const u16*)(p.ws + OFF_VT);
  const u16* vcT = (const u16*)(p.ws + OFF_VCT);
  u16* og = (u16*)(p.ws + OFF_ACT);
  const float LOG2E = 1.4426950408889634f;
  const float sl2 = 0.08838834764831845f * LOG2E;
  for (int item = blockIdx.x; item < 512; item += gridDim.x) {
    const int hp = item & 1, kvh = (item >> 1) & 3, nblk = (item >> 3) & 15, b = item >> 7;
    const int hq = kvh * 4 + hp * 2 + (wid >> 2);
    const int qs = nblk * 128 + (wid & 3) * 32 + r;
    bfx8 Q[8];
    {
      const u16* qrow = px + (size_t)(b * 2048 + qs) * 5120 + hq * 128 + 8 * h;
#pragma unroll
      for (int st = 0; st < 8; ++st) Q[st] = *(const bfx8*)(qrow + 16 * st);
    }
    f32x16 O[4];
#pragma unroll
    for (int dt = 0; dt < 4; ++dt)
#pragma unroll
      for (int i = 0; i < 16; ++i) O[dt][i] = 0.f;
    float m = p.attn_sink[hq] * LOG2E;
    float l = (h == 0) ? 1.f : 0.f;
    const int first = (nblk == 0) ? 2 : 0, lastlocal = (nblk == 15) ? 3 : 5;
    uint4 kA0, kA1, vA0, vA1, kB0, kB1, vB0, vB1;
#define AT_LOAD_TILE(TI, K0, K1, V0, V1) do { \
      const int _ti = (TI); const bool _loc = _ti < 6; \
      const int _kpos0 = 128 * (nblk - 1) + 64 * _ti, _c0 = 64 * (_ti - 6); \
      const u16* _kb = _loc ? px + (size_t)(b * 2048 + _kpos0) * 5120 + 2048 + kvh * 128 : kvc + (size_t)(b * 256 + _c0) * 1024 + kvh * 128; \
      const size_t _ks = _loc ? 5120 : 1024; \
      const u16* _vb = _loc ? vT + (size_t)(kvh * 128) * 8192 + b * 2048 + _kpos0 : vcT + (size_t)(kvh * 128) * 1024 + b * 256 + _c0; \
      const size_t _vs = _loc ? 8192 : 1024; \
      const int _c1 = tid + NTHREADS; \
      K0 = *(const uint4*)(_kb + (size_t)(tid >> 4) * _ks + (tid & 15) * 8); \
      K1 = *(const uint4*)(_kb + (size_t)(_c1 >> 4) * _ks + (_c1 & 15) * 8); \
      V0 = *(const uint4*)(_vb + (size_t)(tid >> 3) * _vs + (tid & 7) * 8); \
      V1 = *(const uint4*)(_vb + (size_t)(_c1 >> 3) * _vs + (_c1 & 7) * 8); \
    } while (0)
#define AT_STORE_TILE(K0, K1, V0, V1) do { \
      const int c1 = tid + NTHREADS; \
      *(uint4*)(Ks + (tid >> 4) * AT_KROW + (tid & 15) * 16) = K0; \
      *(uint4*)(Ks + (c1 >> 4) * AT_KROW + (c1 & 15) * 16) = K1; \
      char* v0p = Vs + (tid >> 3) * AT_VROW + (tid & 7) * 16; \
      char* v1p = Vs + (c1 >> 3) * AT_VROW + (c1 & 7) * 16; \
      *(uint2*)(v0p) = make_uint2(V0.x, V0.y); \
      *(uint2*)(v0p + 8) = make_uint2(V0.z, V0.w); \
      *(uint2*)(v1p) = make_uint2(V1.x, V1.y); \
      *(uint2*)(v1p + 8) = make_uint2(V1.z, V1.w); \
    } while (0)
    int ti = first;
    int t1 = ti + 1;
    if (t1 > lastlocal && t1 < 6) t1 = 6;
    AT_LOAD_TILE(ti, kA0, kA1, vA0, vA1);
    if (t1 < 10) AT_LOAD_TILE(t1, kB0, kB1, vB0, vB1);
    while (true) {
#pragma unroll
     for (int half = 0; half < 2; ++half) {
      __syncthreads();
      if (half == 0) AT_STORE_TILE(kA0, kA1, vA0, vA1); else AT_STORE_TILE(kB0, kB1, vB0, vB1);
      __syncthreads();
      int t2 = t1 + 1;
      if (t2 > lastlocal && t2 < 6) t2 = 6;
      if (t1 >= 10) t2 = 10;
      if (t2 < 10) { if (half == 0) AT_LOAD_TILE(t2, kA0, kA1, vA0, vA1); else AT_LOAD_TILE(t2, kB0, kB1, vB0, vB1); }
      const int q0w = nblk * 128 + (wid & 3) * 32;
      const int kp0 = 128 * (nblk - 1) + 64 * ti;
      if (!(ti < 6 && (kp0 > q0w + 31 + 128 || kp0 + 63 < q0w - 128))) {
        const bool local = ti < 6;
        const int kpos0 = 128 * (nblk - 1) + 64 * ti;
        f32x16 S[2];
#pragma unroll
        for (int ks = 0; ks < 2; ++ks) {
#pragma unroll
          for (int i = 0; i < 16; ++i) S[ks][i] = 0.f;
#pragma unroll
          for (int st = 0; st < 8; ++st) {
            bfx8 A = *(const bfx8*)(Ks + (ks * 32 + r) * AT_KROW + (16 * st + 8 * h) * 2);
            S[ks] = __builtin_amdgcn_mfma_f32_32x32x16_bf16(A, Q[st], S[ks], 0, 0, 0);
          }
        }
        const bool needmask = local && (kp0 > q0w + 65 || kp0 < q0w - 97);
        float mraw = -1e30f;
        if (needmask) {
          const int relb = kpos0 + 4 * h - qs;
#pragma unroll
          for (int ks = 0; ks < 2; ++ks)
#pragma unroll
            for (int i = 0; i < 16; ++i) {
              const int rel = relb + ks * 32 + (i & 3) + 8 * (i >> 2);
              float sv = S[ks][i];
              if (rel > 128 || rel < -128) sv = -1e30f;
              S[ks][i] = sv;
              mraw = fmaxf(mraw, sv);
            }
        } else {
#pragma unroll
          for (int ks = 0; ks < 2; ++ks)
#pragma unroll
            for (int i = 0; i < 16; ++i) mraw = fmaxf(mraw, S[ks][i]);
        }
        float mx = fmaxf(m, mraw * sl2);
        mx = fmaxf(mx, __shfl_xor(mx, 32, 64));
        if (__builtin_amdgcn_ballot_w64(mx != m) != 0ull) {
          const float alpha = __builtin_amdgcn_exp2f(m - mx);
          m = mx;
          l *= alpha;
#pragma unroll
          for (int dt = 0; dt < 4; ++dt)
#pragma unroll
            for (int i = 0; i < 16; ++i) O[dt][i] *= alpha;
        }
#pragma unroll
        for (int ks = 0; ks < 2; ++ks)
#pragma unroll
          for (int i = 0; i < 16; ++i) {
            float pv = __builtin_amdgcn_exp2f(__builtin_fmaf(S[ks][i], sl2, -m));
            l += pv;
            S[ks][i] = pv;
          }
#pragma unroll
        for (int s4 = 0; s4 < 4; ++s4) {
          const int ks = s4 >> 1, hf = s4 & 1;
          pg8::u32x4 pk;
#pragma unroll
          for (int j = 0; j < 4; ++j)
            pk[j] = pk2(S[ks][8 * hf + 2 * j], S[ks][8 * hf + 2 * j + 1]);
          bfx8 P = __builtin_bit_cast(bfx8, pk);
#pragma unroll
          for (int dt = 0; dt < 4; ++dt) {
            const char* vp = Vs + (dt * 32 + r) * AT_VROW + (32 * ks + 16 * hf + 4 * h) * 2;
            uint2 v0 = *(const uint2*)vp, v1 = *(const uint2*)(vp + 16);
            pg8::u32x4 vv; vv[0] = v0.x; vv[1] = v0.y; vv[2] = v1.x; vv[3] = v1.y;
            O[dt] = __builtin_amdgcn_mfma_f32_32x32x16_bf16(__builtin_bit_cast(bfx8, vv), P, O[dt], 0, 0, 0);
          }
        }
      }
      if (t1 >= 10) goto attn_done;
      ti = t1; t1 = t2;
     }
    }
    attn_done:;
    const float ltot = l + __shfl_xor(l, 32, 64);
    const float inv = 1.f / ltot;
    const size_t tok = (size_t)(b * 2048 + qs);
#pragma unroll
    for (int dt = 0; dt < 4; ++dt)
#pragma unroll
      for (int g4 = 0; g4 < 4; ++g4) {
        const int d = dt * 32 + 8 * g4 + 4 * h;
        uint2 gg = *(const uint2*)(px + tok * 5120 + 3072 + hq * 128 + d);
        float o0 = O[dt][4 * g4 + 0] * inv * siluf(bflo(gg.x));
        float o1 = O[dt][4 * g4 + 1] * inv * siluf(bfhi(gg.x));
        float o2 = O[dt][4 * g4 + 2] * inv * siluf(bflo(gg.y));
        float o3 = O[dt][4 * g4 + 3] * inv * siluf(bfhi(gg.y));
        uint2 pk;
        pk.x = pk2(o0, o1);
        pk.y = pk2(o2, o3);
        *(uint2*)(og + tok * 2048 + hq * 128 + d) = pk;
      }
  }
}

#define XB_TMO      128
#define XB_XCNT(j)  (256  + 64 * (j))
#define XB_XSUB(j)  (1280 + 64 * (j))
#define XB_XGEN(j)  (2304 + 64 * (j))
#define XB_TOP      3328
#define XB_TOPGEN   3392
#define XCD_BAR_WORDS 3456
#define XB_SPIN_CAP (1u << 18)
#define LAS __attribute__((address_space(3)))

__device__ __forceinline__ unsigned xb_ld(unsigned* p)              { return __hip_atomic_load(p, __ATOMIC_RELAXED, __HIP_MEMORY_SCOPE_AGENT); }
__device__ __forceinline__ unsigned xb_add(unsigned* p, unsigned v) { return __hip_atomic_fetch_add(p, v, __ATOMIC_RELAXED, __HIP_MEMORY_SCOPE_AGENT); }
__device__ __forceinline__ unsigned xb_xcc_id() { return (unsigned)__builtin_amdgcn_s_getreg((3 << 11) | 20) & 0xFu; }
#define XB_SPIN(cond, bar) do { unsigned _sp = 0; while (cond) { __builtin_amdgcn_s_sleep(1); \
    if ((++_sp & 255u) == 0u) { if (xb_ld(&(bar)[XB_TMO])) break; if (_sp > XB_SPIN_CAP) { atomicAdd(&(bar)[XB_TMO], 1u); break; } } } } while (0)

struct XcdBarrier {
    unsigned* bar; unsigned x;
    volatile LAS unsigned* st;
};

__device__ __forceinline__ XcdBarrier xcd_barrier_post(unsigned* bar, volatile LAS unsigned* st) {
    XcdBarrier b; b.bar = bar; b.x = xb_xcc_id(); b.st = st;
    if (threadIdx.x == 0) (void)xb_add(&bar[XB_XCNT(b.x)], 1u);
    return b;
}
__device__ __forceinline__ void xcd_barrier_complete(unsigned* bar, unsigned x, unsigned& nloc, unsigned& nx) {
    const unsigned G = gridDim.x * gridDim.y * gridDim.z;
    unsigned sum, cnt, mine, sp = 0u;
    for (;;) {
        sum = 0u; cnt = 0u; mine = 0u;
#pragma unroll
        for (unsigned j = 0; j < 16; ++j) { const unsigned c = xb_ld(&bar[XB_XCNT(j)]); sum += c; cnt += (c > 0u) ? 1u : 0u; mine = (j == x) ? c : mine; }
        if (sum == G) break;
        __builtin_amdgcn_s_sleep(1);
        if ((++sp & 255u) == 0u) { if (xb_ld(&bar[XB_TMO])) break; if (sp > XB_SPIN_CAP) { atomicAdd(&bar[XB_TMO], 1u); break; } }
    }
    nloc = mine > 0u ? mine : 1u; nx = cnt > 0u ? cnt : 1u;
}

__device__ __forceinline__ void xcd_barrier(const XcdBarrier& b) {
    asm volatile("s_waitcnt vmcnt(0)" ::: "memory");
    __syncthreads();
    if (threadIdx.x == 0) {
        unsigned* bar = b.bar;
        __builtin_amdgcn_s_waitcnt(0);
        unsigned nloc = b.st[0], nx = b.st[1];
        if (nloc == 0u) { xcd_barrier_complete(bar, b.x, nloc, nx); b.st[0] = nloc; b.st[1] = nx; }
        const unsigned old = xb_add(&bar[XB_XSUB(b.x)], 1u);
        const unsigned gen = old / nloc;
        if (old + 1u == (gen + 1u) * nloc) {
            __builtin_amdgcn_fence(__ATOMIC_RELEASE, "agent");
            asm volatile("s_waitcnt vmcnt(0)" ::: "memory");
            const unsigned og = xb_add(&bar[XB_TOP], 1u);
            const unsigned tg = og / nx;
            if (og + 1u == (tg + 1u) * nx) xb_add(&bar[XB_TOPGEN], 1u);
            else XB_SPIN(xb_ld(&bar[XB_TOPGEN]) == tg, bar);
            __builtin_amdgcn_fence(__ATOMIC_ACQUIRE, "agent");
            xb_add(&bar[XB_XGEN(b.x)], 1u);
            asm volatile("s_waitcnt vmcnt(0)" ::: "memory");
        } else {
            XB_SPIN(xb_ld(&bar[XB_XGEN(b.x)]) == gen, bar);
            __builtin_amdgcn_fence(__ATOMIC_ACQUIRE, "agent");
            asm volatile("s_waitcnt vmcnt(0)" ::: "memory");
        }
    }
    __syncthreads();
}


constexpr int N_PHASES = 9;
__global__ void __launch_bounds__(NTHREADS, 2) mega(Params p, int ph0, int ph1) {
  extern __shared__ __attribute__((aligned(16))) float sm[];
  volatile LAS unsigned* xb_st = (volatile LAS unsigned*)((LAS unsigned char*)sm + 162816);
  if (threadIdx.x < 4) xb_st[threadIdx.x] = 0u;
  __syncthreads();
  const XcdBarrier xb = xcd_barrier_post((unsigned*)(p.ws + OFF_BAR), xb_st);
#define PH(i, body) if (ph0 <= (i) && (i) < ph1) { body; if ((i) + 1 < ph1) xcd_barrier(xb); }
  if (ph0 < 0) cg::this_grid().sync();
  PH(0, phase0(p, sm))
  PH(1, phase_norm(p, 0))
  PH(2, run_gemm(sm, (const u16*)(p.ws + OFF_ACT), (const u16*)(p.ws + OFF_WT_AI), MT, ATTN_IN,
                 EpiAttnIn{(u16*)(p.ws + OFF_BIG), (const float*)(p.ws + OFF_ROPE)}, (int)blockIdx.x);
        run_gemm(sm, (const u16*)(p.ws + OFF_HC), (const u16*)(p.ws + OFF_WT_AI) + (size_t)2048 * 2048, MC, 1024,
                 EpiRaw{(u16*)(p.ws + OFF_KVC), 1024}, (int)((blockIdx.x + 64) % gridDim.x));
        run_gemm(sm, (const u16*)(p.ws + OFF_WT_AI) + (size_t)2560 * 2048, (const u16*)(p.ws + OFF_ACT), 512, MT,
                 EpiRaw{(u16*)(p.ws + OFF_VT), 8192}, (int)((blockIdx.x + 128) % gridDim.x));
        run_gemm(sm, (const u16*)(p.ws + OFF_WT_AI) + (size_t)2560 * 2048, (const u16*)(p.ws + OFF_HC), 512, MC,
                 EpiRaw{(u16*)(p.ws + OFF_VCT), 1024}, (int)((blockIdx.x + 48) % gridDim.x)))
  PH(3, phase_attn(p, sm))
  PH(4, run_gemm(sm, (const u16*)(p.ws + OFF_ACT), (const u16*)(p.ws + OFF_WT_AO), MT, 2048,
                 EpiResNorm{p.out, p.x, (const float*)(p.ws + OFF_MOD) + 4096, (float*)(p.ws + OFF_ROWSS), (unsigned*)(p.ws + OFF_PCNT),
                            p.norm_g + 2048, (const float*)(p.ws + OFF_MOD) + 5 * 6144, (u16*)(p.ws + OFF_ACT)}, (int)blockIdx.x))
  PH(6, run_gemm(sm, (const u16*)(p.ws + OFF_WT_HI), (const u16*)(p.ws + OFF_ACT), HY_IN, MT,
                 EpiRaw{(u16*)(p.ws + OFF_BIG), 8192}, (int)blockIdx.x))
  PH(7, phase_conv(p, sm))
  PH(8, (run_gemm<EpiResNorm, true>(sm, (const u16*)(p.ws + OFF_ACT), (const u16*)(p.ws + OFF_WT_HO), MT, 2048,
                 EpiResNorm{p.out, p.out, (const float*)(p.ws + OFF_MOD) + 5 * 6144 + 4096, (float*)(p.ws + OFF_ROWSS) + 8192,
                            (unsigned*)(p.ws + OFF_PCNT) + 32 * 64, p.final_g, nullptr, nullptr}, (int)blockIdx.x)))
}

extern "C" void kernel_launch(void* const* d_in, const int* in_sizes, int n_in, void* d_out, int out_size,
                              void* d_ws, size_t ws_size, hipStream_t stream) {
  Params p{};
  const float** f = (const float**)&p;
  for (int i = 0; i < 23; ++i) f[i] = (const float*)d_in[i];
  p.out = (float*)d_out;
  p.ws = (char*)d_ws;
  constexpr size_t kLds = 162816 + 16;
  static int grid_blocks = 0;
  if (!grid_blocks) {
    (void)hipFuncSetAttribute((const void*)mega, hipFuncAttributeMaxDynamicSharedMemorySize, (int)kLds);
    int dev = 0, cus = 0, per_cu = 0;
    (void)hipGetDevice(&dev);
    (void)hipDeviceGetAttribute(&cus, hipDeviceAttributeMultiprocessorCount, dev);
    (void)hipOccupancyMaxActiveBlocksPerMultiprocessor(&per_cu, mega, NTHREADS, kLds);
    if (per_cu < 1) per_cu = 1;
    grid_blocks = cus * per_cu;
  }
  (void)hipMemsetAsync((char*)d_ws + OFF_BAR, 0, ZERO_BYTES, stream);
  int ph0 = 0, ph1 = N_PHASES;
  void* args[] = {(void*)&p, (void*)&ph0, (void*)&ph1};
  hipError_t e = hipLaunchCooperativeKernel((const void*)mega, dim3(grid_blocks), dim3(NTHREADS), args, kLds, stream);
  if (e != hipSuccess) fprintf(stderr, "cooperative launch failed: %s (grid %d)\n", hipGetErrorString(e), grid_blocks);
}
```

```cpp
#include <hip/hip_runtime.h>
#include <hip/hip_bf16.h>
#include <hip/hip_cooperative_groups.h>
#include <cstdio>
namespace cg = cooperative_groups;
typedef unsigned short u16;

#define NTHREADS 512
constexpr int Bn = 4, Sn = 2048, Dn = 2048, Cn = 256;
constexpr int MT = Bn * Sn;
constexpr int MC = Bn * Cn;
constexpr int ATTN_IN = 5120;
constexpr int HY_IN = 8192;

constexpr size_t OFF_WT_AI = 0;
constexpr size_t OFF_WT_AO = OFF_WT_AI + (size_t)5120 * 2048 * 2;
constexpr size_t OFF_WT_HI = OFF_WT_AO + (size_t)2048 * 2048 * 2;
constexpr size_t OFF_WT_HO = OFF_WT_HI + (size_t)8192 * 2048 * 2;
constexpr size_t OFF_MOD   = OFF_WT_HO + (size_t)2048 * 2048 * 2;
constexpr size_t OFF_ROPE  = OFF_MOD + (size_t)2 * 5 * 6144 * 4 + 256;
constexpr size_t OFF_FILT  = OFF_ROPE + (size_t)64 * 32 * 8;
constexpr size_t OFF_ACT   = OFF_FILT + (size_t)2 * 2048 * 4096 * 2;
constexpr size_t OFF_HC    = OFF_ACT + (size_t)8192 * 2048 * 2;
constexpr size_t OFF_KVC   = OFF_HC + (size_t)1024 * 2048 * 2;
constexpr size_t OFF_VT    = OFF_KVC + (size_t)1024 * 1024 * 2;
constexpr size_t OFF_VCT   = OFF_VT + (size_t)512 * 8192 * 2;
constexpr size_t OFF_BIG   = OFF_VCT + (size_t)512 * 1024 * 2;

constexpr size_t OFF_BAR   = OFF_BIG + (size_t)8192 * 8192 * 2;

constexpr size_t OFF_ROWSS = OFF_BAR + 16384;
constexpr size_t OFF_PCNT  = OFF_ROWSS + (size_t)2 * 8192 * 4;
constexpr size_t ZERO_BYTES = 16384 + (size_t)2 * 8192 * 4 + (size_t)2 * 32 * 64 * 4;

struct Params {
  const float *x, *c, *ctx, *c_ctx, *norm_g, *ada_w, *ada_b, *attn_w_in, *attn_w_out, *attn_sink;
  const float *hy_w_in, *hy_conv_w, *hy_conv_b, *hy_w1, *hy_b1, *hy_w2, *hy_b2, *hy_w3, *hy_b3;
  const float *hy_freq, *hy_bias_d, *hy_w_out, *final_g;
  float* out;
  char* ws;
};

__device__ __forceinline__ u16 f2bf(float f) {
  unsigned u = __float_as_uint(f);
  u += 0x7fffu + ((u >> 16) & 1u);
  return (u16)(u >> 16);
}
__device__ __forceinline__ float bf2f(u16 h) { return __uint_as_float(((unsigned)h) << 16); }
__device__ __forceinline__ unsigned pk2(float lo, float hi) { unsigned r; asm("v_cvt_pk_bf16_f32 %0, %1, %2" : "=v"(r) : "v"(lo), "v"(hi)); return r; }
typedef float nt_f4 __attribute__((ext_vector_type(4)));
__device__ __forceinline__ float4 ntl4(const float* p) { nt_f4 v = __builtin_nontemporal_load((const nt_f4*)p); return make_float4(v[0], v[1], v[2], v[3]); }
#define NTL4(P) ntl4(P)
__device__ __forceinline__ float bflo(unsigned w) { return __uint_as_float(w << 16); }
__device__ __forceinline__ float bfhi(unsigned w) { return __uint_as_float(w & 0xffff0000u); }
__device__ __forceinline__ float siluf(float v) { return v / (1.f + __expf(-v)); }
__device__ __forceinline__ float wave_sum(float v) {
#pragma unroll
  for (int o = 32; o > 0; o >>= 1) v += __shfl_xor(v, o, 64);
  return v;
}
__device__ __forceinline__ float wave_max(float v) {
#pragma unroll
  for (int o = 32; o > 0; o >>= 1) v = fmaxf(v, __shfl_xor(v, o, 64));
  return v;
}

__device__ __forceinline__ void p0_convert(const float* __restrict__ W, u16* __restrict__ Wt, int N, int tk, int tn,
                           bool perm, float* sm) {
  const int tid = threadIdx.x;
  for (int i = tid; i < 64 * 32; i += NTHREADS) {
    int r = i >> 5, c4 = i & 31;
    float4 v = *(const float4*)(W + (size_t)(tk * 64 + r) * N + tn * 128 + c4 * 4);
    float* d = sm + r * 129 + c4 * 4;
    d[0] = v.x; d[1] = v.y; d[2] = v.z; d[3] = v.w;
  }
  __syncthreads();
  for (int i = tid; i < 128 * 8; i += NTHREADS) {
    int nrow = i >> 3, kc = i & 7;
    int src = nrow;
    if (perm && (tn * 128 < 2560)) {
      int g = nrow >> 5, nn = (nrow >> 4) & 1, fr = nrow & 15;
      src = (g >> 1) * 64 + nn * 32 + (g & 1) * 16 + fr;
    }
    unsigned w[4];
#pragma unroll
    for (int j = 0; j < 4; ++j) {
      float a = sm[(kc * 8 + 2 * j) * 129 + src];
      float b = sm[(kc * 8 + 2 * j + 1) * 129 + src];
      w[j] = pk2(a, b);
    }
    *(uint4*)(Wt + (size_t)(tn * 128 + nrow) * 2048 + tk * 64 + kc * 8) = make_uint4(w[0], w[1], w[2], w[3]);
  }
  __syncthreads();
}

__device__ __forceinline__ void p0_adaln(const Params& p, int item, float* sm) {
  const int tid = threadIdx.x;
  float* sv = sm;
  float* red = sm + 5 * 2048;
  int col0 = item * 48;
  int l = col0 / 6144, n0 = col0 % 6144;
  for (int i = tid; i < 5 * 2048; i += NTHREADS) {
    int v = i >> 11, k = i & 2047;
    float cv = v < 4 ? p.c[v * 2048 + k] : p.c_ctx[k];
    sv[i] = cv / (1.f + expf(-cv));
  }
  __syncthreads();
  int kg = tid / 12, cq = tid % 12;
  float acc[5][4];
#pragma unroll
  for (int v = 0; v < 5; ++v)
#pragma unroll
    for (int j = 0; j < 4; ++j) acc[v][j] = 0.f;
  if (kg < 42) {
    const float* W = p.ada_w + (size_t)l * 2048 * 6144 + n0 + cq * 4;
#pragma unroll 8
    for (int k = kg; k < 2048; k += 42) {
      float4 w = ntl4(W + (size_t)k * 6144);
#pragma unroll
      for (int v = 0; v < 5; ++v) {
        float s = sv[v * 2048 + k];
        acc[v][0] += s * w.x; acc[v][1] += s * w.y; acc[v][2] += s * w.z; acc[v][3] += s * w.w;
      }
    }
  }
  if (kg >= 21 && kg < 42) {
#pragma unroll
    for (int v = 0; v < 5; ++v)
#pragma unroll
      for (int j = 0; j < 4; ++j) red[((kg - 21) * 5 + v) * 48 + cq * 4 + j] = acc[v][j];
  }
  __syncthreads();
  if (kg < 21) {
#pragma unroll
    for (int v = 0; v < 5; ++v)
#pragma unroll
      for (int j = 0; j < 4; ++j) red[(kg * 5 + v) * 48 + cq * 4 + j] += acc[v][j];
  }
  __syncthreads();
  if (tid < 240) {
    int v = tid / 48, cc = tid % 48;
    float s = 0.f;
    for (int g = 0; g < 21; ++g) s += red[(g * 5 + v) * 48 + cc];
    float* mod = (float*)(p.ws + OFF_MOD);
    mod[(l * 5 + v) * 6144 + n0 + cc] = s + p.ada_b[l * 6144 + n0 + cc];
  }
  __syncthreads();
}

__device__ __forceinline__ void p0_rope(const Params& p) {
  float2* rope = (float2*)(p.ws + OFF_ROPE);
  for (int i = threadIdx.x; i < 64 * 32; i += NTHREADS) {
    int pos = i >> 5, j = i & 31;
    float inv = powf(10000.f, -(float)(2 * j) / 64.f);
    float ang = (float)pos * inv;
    rope[i] = make_float2(cosf(ang), sinf(ang));
  }
}

typedef short bf16x8_t __attribute__((ext_vector_type(8)));
typedef unsigned u32x4_t __attribute__((ext_vector_type(4)));
typedef float f32x16_t __attribute__((ext_vector_type(16)));
__device__ __forceinline__ void split8(const float (&v)[8], bf16x8_t& hi, bf16x8_t& lo) {
  u32x4_t H, L;
#pragma unroll
  for (int j = 0; j < 4; ++j) {
    const u16 h0 = f2bf(v[2 * j]), h1 = f2bf(v[2 * j + 1]);
    const float r0 = v[2 * j] - bf2f(h0), r1 = v[2 * j + 1] - bf2f(h1);
    H[j] = (unsigned)h0 | ((unsigned)h1 << 16);
    L[j] = pk2(r0, r1);
  }
  hi = __builtin_bit_cast(bf16x8_t, H);
  lo = __builtin_bit_cast(bf16x8_t, L);
}
__device__ __forceinline__ void p0_filter(const Params& p, int item, float* sm) {
  int tid = threadIdx.x;
  asm volatile("" : "+v"(tid));
  const int lane = tid & 63, wid = tid >> 6, r = lane & 31, h = lane >> 5;
  const int cc = item & 15, pg = item >> 4;
  float* z = sm;
  float* h1 = z + 128 * 36;
  float* h2 = h1 + 128 * 64;
  for (int i = tid; i < 128 * 33; i += NTHREADS) {
    int pos = i / 33, e = i % 33;
    int t = pg * 128 + pos;
    float val;
    if (e == 0) val = (float)t / 2047.f;
    else {
      int bi = (e - 1) & 15;
      float w = 6.283185307179586f * (float)t / 2048.f;
      float fr = 1e-4f + (float)bi * ((15.f - 1e-4f) / 15.f);
      float ang = w * fr;
      val = (e <= 16) ? cosf(ang) : -sinf(ang);
    }
    z[pos * 36 + e] = val;
  }
  __syncthreads();
  {
    const int j = lane;
    float w1r[33];
#pragma unroll
    for (int e = 0; e < 33; ++e) w1r[e] = p.hy_w1[e * 64 + j];
    const float fq = p.hy_freq[j], b1 = p.hy_b1[j];
#pragma unroll 1
    for (int q = 0; q < 16; ++q) {
      const int pos = wid * 16 + q;
      const float4* zp = (const float4*)(z + pos * 36);
      float a = b1;
#pragma unroll
      for (int e4 = 0; e4 < 8; ++e4) {
        float4 zv = zp[e4];
        a += zv.x * w1r[4 * e4] + zv.y * w1r[4 * e4 + 1] + zv.z * w1r[4 * e4 + 2] + zv.w * w1r[4 * e4 + 3];
      }
      a += z[pos * 36 + 32] * w1r[32];
      h1[pos * 64 + j] = __sinf(fq * a);
    }
  }
  __syncthreads();
  {
    const int j = lane;
    float w2r[64];
#pragma unroll
    for (int e = 0; e < 64; ++e) w2r[e] = p.hy_w2[e * 64 + j];
    const float fq = p.hy_freq[j], b2 = p.hy_b2[j];
#pragma unroll 1
    for (int q = 0; q < 16; ++q) {
      const int pos = wid * 16 + q;
      const float4* hp = (const float4*)(h1 + pos * 64);
      float a = b2;
#pragma unroll
      for (int e4 = 0; e4 < 16; ++e4) {
        float4 hv = hp[e4];
        a += hv.x * w2r[4 * e4] + hv.y * w2r[4 * e4 + 1] + hv.z * w2r[4 * e4 + 2] + hv.w * w2r[4 * e4 + 3];
      }
      h2[pos * 68 + j] = __sinf(fq * a);
    }
  }
  __syncthreads();
  const int colw = cc * 512 + wid * 64;
  bf16x8_t Ahi[2][4], Alo[2][4];
#pragma unroll
  for (int ct = 0; ct < 2; ++ct)
#pragma unroll
    for (int ks = 0; ks < 4; ++ks) {
      float v[8];
#pragma unroll
      for (int j = 0; j < 8; ++j) v[j] = p.hy_w3[(size_t)(16 * ks + 8 * h + j) * 8192 + colw + ct * 32 + r];
      split8(v, Ahi[ct][ks], Alo[ct][ks]);
    }
  const int o = cc >> 3, dir = (cc >> 2) & 1;
  u16* Rg = (u16*)(p.ws + OFF_FILT) + (size_t)o * 2048 * 4096;
  const float min_decay = -3.0701134573253945f, max_decay = -15.350567286626972f;
#pragma unroll 1
  for (int pp = 0; pp < 2; ++pp) {
    f32x16_t acc[2][2];
#pragma unroll
    for (int ct = 0; ct < 2; ++ct)
#pragma unroll
      for (int q = 0; q < 2; ++q)
#pragma unroll
        for (int i = 0; i < 16; ++i) acc[ct][q][i] = 0.f;
#pragma unroll
    for (int q = 0; q < 2; ++q)
#pragma unroll
      for (int ks = 0; ks < 4; ++ks) {
        const float* hp = h2 + ((pp * 2 + q) * 32 + r) * 68 + 16 * ks + 8 * h;
        float4 x0 = *(const float4*)hp, x1 = *(const float4*)(hp + 4);
        float v[8] = {x0.x, x0.y, x0.z, x0.w, x1.x, x1.y, x1.z, x1.w};
        bf16x8_t Bhi, Blo;
        split8(v, Bhi, Blo);
#pragma unroll
        for (int ct = 0; ct < 2; ++ct) {
          acc[ct][q] = __builtin_amdgcn_mfma_f32_32x32x16_bf16(Ahi[ct][ks], Bhi, acc[ct][q], 0, 0, 0);
          acc[ct][q] = __builtin_amdgcn_mfma_f32_32x32x16_bf16(Ahi[ct][ks], Blo, acc[ct][q], 0, 0, 0);
          acc[ct][q] = __builtin_amdgcn_mfma_f32_32x32x16_bf16(Alo[ct][ks], Bhi, acc[ct][q], 0, 0, 0);
        }
      }
    int hh = h;
    asm volatile("" : "+v"(hh));
#pragma unroll
    for (int ct = 0; ct < 2; ++ct)
#pragma unroll
      for (int i = 0; i < 16; ++i) {
        const int col = colw + ct * 32 + (i & 3) + 8 * (i >> 2) + 4 * hh;
        const int ch = col & 2047;
        const float b3 = p.hy_b3[col];
        const float ad = fabsf(min_decay + (float)ch * ((max_decay - min_decay) / 2047.f));
        u16* R = Rg + (size_t)ch * 4096;
#pragma unroll
        for (int q = 0; q < 2; ++q) {
          const int t = pg * 128 + (pp * 2 + q) * 32 + r;
          const float tn = (float)t / 2047.f;
          float v = (acc[ct][q][i] + b3) * (__expf(-tn * ad) + 0.05f);
          if (dir == 0) {
            if (t == 0) v += p.hy_bias_d[o * 2048 + ch];
            R[2048 - t] = f2bf(v);
          } else {
            if (t > 0) R[2048 + t] = f2bf(v);
            else R[0] = 0;
          }
        }
      }
  }
  __syncthreads();
}

constexpr int N_CV_AI = 16 * 40, N_CV_AO = 16 * 16, N_CV_HI = 16 * 64, N_CV_HO = 16 * 16;
constexpr int N_CV = N_CV_AI + N_CV_AO + N_CV_HI + N_CV_HO;
#define CV_DECODE(I, W_, Wt_, N_, tk_, tn_, perm_) do { int _i = (I); \
    const bool _a = _i < N_CV_AI, _b2 = _i < N_CV_AI + N_CV_AO, _c = _i < N_CV_AI + N_CV_AO + N_CV_HI; \
    W_ = _a ? p.attn_w_in : (_b2 ? p.attn_w_out : (_c ? p.hy_w_in : p.hy_w_out)); \
    Wt_ = (u16*)(p.ws + (_a ? OFF_WT_AI : (_b2 ? OFF_WT_AO : (_c ? OFF_WT_HI : OFF_WT_HO)))); \
    N_ = _a ? 5120 : (_b2 ? 2048 : (_c ? 8192 : 2048)); \
    const int _nt = _a ? 40 : (_b2 ? 16 : (_c ? 64 : 16)); \
    _i -= _a ? 0 : (_b2 ? N_CV_AI : (_c ? N_CV_AI + N_CV_AO : N_CV_AI + N_CV_AO + N_CV_HI)); \
    tk_ = _i / _nt; tn_ = _i - tk_ * _nt; perm_ = _a && (tn_ * 128 < 2560); } while (0)
__device__ __forceinline__ void p0_convert_all(const Params& p, float* sm) {
  const int tid = threadIdx.x;
  float4 r0, r1, r2, r3, r4, r5, r6, r7;
#define CV_LOAD(W_, N_, tk_, tn_) do { const float* _b = (W_) + (size_t)((tk_) * 128 + (tid >> 5)) * (N_) + (tn_) * 128 + (tid & 31) * 4; const size_t _s = (size_t)16 * (N_); \
    r0 = NTL4(_b); r1 = NTL4(_b + _s); r2 = NTL4(_b + 2 * _s); r3 = NTL4(_b + 3 * _s); \
    r4 = NTL4(_b + 4 * _s); r5 = NTL4(_b + 5 * _s); r6 = NTL4(_b + 6 * _s); r7 = NTL4(_b + 7 * _s); } while (0)
#define CV_PUT(R, I) do { float* _d = sm + ((tid >> 5) + 16 * (I)) * 129 + (tid & 31) * 4; _d[0] = (R).x; _d[1] = (R).y; _d[2] = (R).z; _d[3] = (R).w; } while (0)
  int it = blockIdx.x;
  const float* cW; u16* cWt; int cN, ctk, ctn; bool cperm;
  CV_DECODE(it < N_CV ? it : 0, cW, cWt, cN, ctk, ctn, cperm);
  if (it < N_CV) CV_LOAD(cW, cN, ctk, ctn);
  while (it < N_CV) {
    __syncthreads();
    CV_PUT(r0, 0); CV_PUT(r1, 1); CV_PUT(r2, 2); CV_PUT(r3, 3); CV_PUT(r4, 4); CV_PUT(r5, 5); CV_PUT(r6, 6); CV_PUT(r7, 7);
    __syncthreads();
    const int nit = it + gridDim.x;
    const float* nW; u16* nWt; int nN, ntk, ntn; bool nperm;
    CV_DECODE(nit < N_CV ? nit : 0, nW, nWt, nN, ntk, ntn, nperm);
    if (nit < N_CV) CV_LOAD(nW, nN, ntk, ntn);
    const int row = (tid & 15) | (((tid >> 6) & 7) << 4);
    int src = row;
    if (cperm) { const int g = row >> 5, w = row & 31, i16 = 4 * (w >> 3) + (w & 3), nn = (w >> 2) & 1; src = (g >> 1) * 64 + nn * 32 + (g & 1) * 16 + i16; }
#pragma unroll
    for (int i = 0; i < 4; ++i) {
      const int kch = ((tid >> 4) & 3) | (i << 2);
      unsigned w[4];
#pragma unroll
      for (int j = 0; j < 4; ++j) {
        float a = sm[(kch * 8 + 2 * j) * 129 + src];
        float b = sm[(kch * 8 + 2 * j + 1) * 129 + src];
        w[j] = pk2(a, b);
      }
      *(uint4*)(cWt + (size_t)(ctn * 128 + row) * 2048 + ctk * 128 + kch * 8) = make_uint4(w[0], w[1], w[2], w[3]);
    }
    cW = nW; cWt = nWt; cN = nN; ctk = ntk; ctn = ntn; cperm = nperm;
    it = nit;
  }
#undef CV_LOAD
#undef CV_PUT
}

__device__ __forceinline__ void phase0(const Params& p, float* sm) {
  for (int it = blockIdx.x; it < 256; it += gridDim.x) p0_adaln(p, it, sm);
  if (blockIdx.x == gridDim.x - 1) p0_rope(p);
  __syncthreads();
  for (int it = blockIdx.x; it < 256; it += gridDim.x) p0_filter(p, it, sm);
  __syncthreads();
  p0_convert_all(p, sm);
}

__device__ __forceinline__ void norm_row(const float* __restrict__ src, const float* __restrict__ g, const float* shift,
                         const float* scale, u16* dst_bf, float* dst_f, int lane) {
  float4 v[8];
  float ss = 0.f;
#pragma unroll
  for (int j = 0; j < 8; ++j) {
    v[j] = ntl4(src + (j * 64 + lane) * 4);
    ss += v[j].x * v[j].x + v[j].y * v[j].y + v[j].z * v[j].z + v[j].w * v[j].w;
  }
  ss = wave_sum(ss);
  float r = rsqrtf(ss * (1.f / 2048.f) + 1e-6f);
#pragma unroll
  for (int j = 0; j < 8; ++j) {
    int c = (j * 64 + lane) * 4;
    float4 gg = *(const float4*)(g + c);
    float4 o = make_float4(v[j].x * r * gg.x, v[j].y * r * gg.y, v[j].z * r * gg.z, v[j].w * r * gg.w);
    if (dst_bf) {
      float4 sh = *(const float4*)(shift + c);
      float4 sc = *(const float4*)(scale + c);
      o.x = o.x * (1.f + sc.x) + sh.x; o.y = o.y * (1.f + sc.y) + sh.y;
      o.z = o.z * (1.f + sc.z) + sh.z; o.w = o.w * (1.f + sc.w) + sh.w;
      uint2 pk;
      pk.x = pk2(o.x, o.y);
      pk.y = pk2(o.z, o.w);
      *(uint2*)(dst_bf + c) = pk;
    } else {
      *(float4*)(dst_f + c) = o;
    }
  }
}

__device__ __forceinline__ void phase_norm(const Params& p, int mode) {
  const int wid = threadIdx.x >> 6, lane = threadIdx.x & 63;
  const float* mod = (const float*)(p.ws + OFF_MOD);
  int nrows = (mode == 0) ? (MT + MC) : MT;
  for (int row = blockIdx.x * 8 + wid; row < nrows; row += gridDim.x * 8) {
    if (mode == 0) {
      if (row < MT) {
        int b = row >> 11;
        const float* m = mod + (0 * 5 + b) * 6144;
        norm_row(p.x + (size_t)row * 2048, p.norm_g, m, m + 2048, (u16*)(p.ws + OFF_ACT) + (size_t)row * 2048, nullptr, lane);
      } else {
        int rc = row - MT;
        const float* m = mod + (0 * 5 + 4) * 6144;
        norm_row(p.ctx + (size_t)rc * 2048, p.norm_g, m, m + 2048, (u16*)(p.ws + OFF_HC) + (size_t)rc * 2048, nullptr, lane);
      }
    } else if (mode == 1) {
      int b = row >> 11;
      const float* m = mod + (1 * 5 + b) * 6144;
      norm_row(p.out + (size_t)row * 2048, p.norm_g + 2048, m, m + 2048, (u16*)(p.ws + OFF_ACT) + (size_t)row * 2048, nullptr, lane);
    } else {
      norm_row(p.out + (size_t)row * 2048, p.final_g, nullptr, nullptr, nullptr, p.out + (size_t)row * 2048, lane);
    }
  }
}

namespace pg8 {
#define PG8_LAS __attribute__((address_space(3)))
typedef unsigned short bf16_t;
typedef short bf16x8 __attribute__((ext_vector_type(8)));
typedef float f32x4 __attribute__((ext_vector_type(4)));
typedef unsigned u32x4 __attribute__((ext_vector_type(4)));
constexpr int BM = 256, BK = 64, HALF = 128, HTB = HALF * BK * 2  , STAGE_BYTES = 8 * HTB, NXCD = 8, WGM = 4;

__host__ __device__ __forceinline__ int lds_byte(int r, int c) { const int st = (r >> 4) * 2 + (c >> 5), rr = r & 15, cc = c & 31, ob = rr * 64 + cc * 2; return st * 1024 + (ob ^ (((ob >> 9) & 1) << 5)); }
__host__ __device__ __forceinline__ void stage_rc(int b, int& R, int& C) { const int st = b / 1024, sb = b % 1024, swz = sb ^ (((sb >> 9) & 1) << 5); R = (st >> 1) * 16 + swz / 64; C = (st & 1) * 32 + (swz % 64) / 2; }
__host__ __device__ __forceinline__ int perm32(int rho) { const int n = rho >> 4, i = rho & 15; return 8 * (i >> 2) + 4 * n + (i & 3); }

struct Unit { int pm, pn; };
struct Gemm { const bf16_t* A; const bf16_t* Bt; int M, N, K; int agroup; };

struct StaticOrder {
    int nM, nN, nwg, G, c;
    __host__ __device__ void init(int M, int N, int G_, int c_) { nM = M / BM; nN = N / BM; nwg = nM * nN; G = G_; c = c_; }
    __host__ __device__ bool next(int i, Unit& u) const {
        const long L = (long)i * G + c; if (L >= nwg) return false;
        int wgid = (int)L; { const int q = nwg / NXCD, r = nwg % NXCD, xcd = wgid % NXCD, off = wgid / NXCD; wgid = (xcd < r ? xcd * (q + 1) : r * (q + 1) + (xcd - r) * q) + off; }
        const int nig = WGM * nN, gid = wgid / nig, fm = gid * WGM, gsz = (nM - fm) < WGM ? (nM - fm) : WGM;
        u.pm = fm + ((wgid % nig) % gsz); u.pn = (wgid % nig) / gsz; return true;
    }
    __device__ __forceinline__ void a_ready(const Unit&) const {}
    __device__ __forceinline__ void done(const Unit&) const {}
};
__device__ __forceinline__ unsigned cvt_pk_bf16(float lo, float hi) { unsigned r; asm volatile("v_cvt_pk_bf16_f32 %0, %1, %2" : "=v"(r) : "v"(lo), "v"(hi)); return r; }
template <class Epi, class Sched, bool AGROUP = false>
__device__ __forceinline__ void gemm_phase(PG8_LAS unsigned char* lds, const Gemm g, const Sched& S, const Epi& E) {
    const int tid = threadIdx.x, wid = __builtin_amdgcn_readfirstlane(tid >> 6), lane = tid & 63, wr = wid >> 2, wc = wid & 3, fr = lane & 15, fq = lane >> 4;
    const int K = g.K, nt = K / BK;
    unsigned voffA[2], voffB[2];
#pragma unroll
    for (int i = 0; i < 2; ++i) { int R, C; stage_rc(tid * 16 + i * 8192, R, C); const int Rb = Epi::PERM ? ((R & ~31) + perm32(R & 31)) : R;
        voffA[i] = AGROUP ? (unsigned)((C >> 3) * g.M + R) * 16u : (unsigned)(R * K + C) * 2u; voffB[i] = (unsigned)(Rb * K + C) * 2u; }
    const size_t kstep = (size_t)(BK * 2);
    const size_t hstep = (size_t)HALF * K * 2;
    const size_t tstep = 2 * hstep;
    const size_t kstepA = AGROUP ? (size_t)(BK / 8) * g.M * 16 : kstep, hstepA = AGROUP ? (size_t)HALF * 16 : hstep, tstepA = 2 * hstepA;
    const unsigned ldsw = (unsigned)wid * 1024u;
    const int aoff = lds_byte(wr * 64 + fr, fq * 8), boff = lds_byte(wc * 32 + fr, fq * 8);
#define PG8_SA(b, h) (((b) * 2 + (h)) * HTB)
#define PG8_SB(b, h) ((4 + (b) * 2 + (h)) * HTB)
#define PG8_STAGE(bufoff, gbase, voff) do { _Pragma("unroll") for (int _i = 0; _i < 2; ++_i) \
        __builtin_amdgcn_global_load_lds((const unsigned*)((const char*)(gbase) + (voff)[_i]), (PG8_LAS unsigned*)(lds + (bufoff) + ldsw + _i * 8192), 16, 0, 0); } while (0)
#define PG8_LDA(dst, b, h) do { _Pragma("unroll") for (int m = 0; m < 4; ++m) _Pragma("unroll") for (int k = 0; k < 2; ++k) dst[m][k] = *(const PG8_LAS bf16x8*)(lds + PG8_SA(b, h) + aoff + m * 2048 + k * 1024); } while (0)
#define PG8_LDB(dst, b, h) do { _Pragma("unroll") for (int n = 0; n < 2; ++n) _Pragma("unroll") for (int k = 0; k < 2; ++k) dst[n][k] = *(const PG8_LAS bf16x8*)(lds + PG8_SB(b, h) + boff + n * 2048 + k * 1024); } while (0)
#define PG8_MMA(ai, bj, At, Bt) do { __builtin_amdgcn_s_setprio(1); _Pragma("unroll") for (int m = 0; m < 4; ++m) _Pragma("unroll") for (int n = 0; n < 2; ++n) _Pragma("unroll") for (int k = 0; k < 2; ++k) \
        acc[ai][bj][m][n] = __builtin_amdgcn_mfma_f32_16x16x32_bf16(Bt[n][k], At[m][k], acc[ai][bj][m][n], 0, 0, 0); __builtin_amdgcn_s_setprio(0); } while (0)
#define PG8_WAIT_V(n) asm volatile("s_waitcnt vmcnt(" #n ")" ::: "memory")
#define PG8_WAIT_L(n) asm volatile("s_waitcnt lgkmcnt(" #n ")" ::: "memory")
#define PG8_BAR __builtin_amdgcn_s_barrier()
#define PG8_SCHED __builtin_amdgcn_sched_barrier(0)
    Unit cur, nxt; int ui = 0;
    if (!S.next(0, cur)) return;
    f32x4 acc[2][2][4][2];
#pragma unroll
    for (int a = 0; a < 2; ++a)
#pragma unroll
        for (int b = 0; b < 2; ++b)
#pragma unroll
            for (int m = 0; m < 4; ++m)
#pragma unroll
                for (int n = 0; n < 2; ++n) acc[a][b][m][n] = (f32x4){0.f, 0.f, 0.f, 0.f};
    bf16x8 At[4][2], B0[2][2], B1[2][2];
    const char* cA = (const char*)g.A + (size_t)cur.pm * tstepA; const char* cB = (const char*)g.Bt + (size_t)cur.pn * tstep;
    S.a_ready(cur);
    PG8_STAGE(PG8_SB(0, 0), cB, voffB); PG8_STAGE(PG8_SA(0, 0), cA, voffA); PG8_STAGE(PG8_SB(0, 1), cB + hstep, voffB); PG8_STAGE(PG8_SA(0, 1), cA + hstepA, voffA);
    if (wr == 1) PG8_BAR;
    PG8_WAIT_V(4); PG8_BAR;
    PG8_STAGE(PG8_SB(1, 0), cB + kstep, voffB); PG8_STAGE(PG8_SA(1, 0), cA + kstepA, voffA); PG8_STAGE(PG8_SB(1, 1), cB + hstep + kstep, voffB);
    PG8_WAIT_V(6); PG8_BAR;
    for (;;) {
        const bool has_next = S.next(ui + 1, nxt);
        const char* nA = has_next ? (const char*)g.A + (size_t)nxt.pm * tstepA : cA; const char* nB = has_next ? (const char*)g.Bt + (size_t)nxt.pn * tstep : cB;
        for (int t = 0; t < nt; t += 2) {
            const bool last = (t == nt - 2);
            const char* a1 = cA + (size_t)(t + 1) * kstepA;
            const char* a2 = last ? nA : cA + (size_t)(t + 2) * kstepA; const char* b2 = last ? nB : cB + (size_t)(t + 2) * kstep;
            const char* a3 = a2 + kstepA; const char* b3 = b2 + kstep;
            if (last && has_next) S.a_ready(nxt);
            PG8_LDB(B0, 0, 0); PG8_SCHED; PG8_LDA(At, 0, 0); PG8_STAGE(PG8_SA(1, 1), a1 + hstepA, voffA);
            PG8_WAIT_L(8); PG8_BAR; PG8_WAIT_L(0); PG8_MMA(0, 0, At, B0); PG8_BAR; PG8_SCHED;
            PG8_LDB(B1, 0, 1); PG8_STAGE(PG8_SB(0, 0), b2, voffB);
            PG8_BAR; PG8_WAIT_L(0); PG8_MMA(0, 1, At, B1); PG8_BAR;
            PG8_LDA(At, 0, 1); PG8_STAGE(PG8_SA(0, 0), a2, voffA);
            PG8_BAR; PG8_WAIT_L(0); PG8_MMA(1, 0, At, B0); PG8_BAR; PG8_SCHED;
            PG8_STAGE(PG8_SB(0, 1), b2 + hstep, voffB);
            PG8_WAIT_V(6); PG8_BAR; PG8_MMA(1, 1, At, B1); PG8_BAR;
            PG8_LDB(B0, 1, 0); PG8_SCHED; PG8_LDA(At, 1, 0); PG8_STAGE(PG8_SA(0, 1), a2 + hstepA, voffA);
            PG8_WAIT_L(8); PG8_BAR; PG8_WAIT_L(0); PG8_MMA(0, 0, At, B0); PG8_BAR; PG8_SCHED;
            PG8_LDB(B1, 1, 1); PG8_STAGE(PG8_SB(1, 0), b3, voffB);
            PG8_BAR; PG8_WAIT_L(0); PG8_MMA(0, 1, At, B1); PG8_BAR;
            PG8_LDA(At, 1, 1); PG8_STAGE(PG8_SA(1, 0), a3, voffA);
            PG8_BAR; PG8_WAIT_L(0); PG8_MMA(1, 0, At, B0); PG8_BAR; PG8_SCHED;
            PG8_STAGE(PG8_SB(1, 1), b3 + hstep, voffB);
            PG8_WAIT_V(6); PG8_BAR; PG8_MMA(1, 1, At, B1); PG8_BAR;
        }
        if constexpr (!Epi::AFTER_DRAIN) { E(acc, cur, wr, wc, fr, fq); S.done(cur); }
        if (!has_next) break;
#pragma unroll
        for (int a = 0; a < 2; ++a)
#pragma unroll
            for (int b = 0; b < 2; ++b)
#pragma unroll
                for (int m = 0; m < 4; ++m)
#pragma unroll
                    for (int n = 0; n < 2; ++n) acc[a][b][m][n] = (f32x4){0.f, 0.f, 0.f, 0.f};
        cur = nxt; cA = nA; cB = nB; ++ui;
    }
    PG8_WAIT_V(0);
    if (wr == 0) PG8_BAR;
    PG8_BAR;
    if constexpr (Epi::AFTER_DRAIN) { E.fused(acc, cur, wr, wc, fr, fq, lds, wid, lane); S.done(cur); }
#undef PG8_SA
#undef PG8_SB
#undef PG8_STAGE
#undef PG8_LDA
#undef PG8_LDB
#undef PG8_MMA
#undef PG8_WAIT_V
#undef PG8_WAIT_L
#undef PG8_BAR
#undef PG8_SCHED
}
}

__device__ __forceinline__ uint2 pack4(pg8::f32x4 v) {
  uint2 r;
  r.x = pk2(v[0], v[1]);
  r.y = pk2(v[2], v[3]);
  return r;
}
struct EpiAttnIn {
  static constexpr bool PERM = true, AFTER_DRAIN = false;
  u16* O; const float* rope;
  __device__ __forceinline__ void operator()(const pg8::f32x4 (&acc)[2][2][4][2], const pg8::Unit& u, int wr, int wc, int fr, int fq) const {
    const int row0 = u.pm * 256 + wr * 64 + fr, col0 = u.pn * 256 + wc * 32 + 8 * fq;
    const bool dorope = (u.pn < 10);
    const int axis = wc >> 1, i0 = (wc & 1) * 16 + 4 * fq;
#pragma unroll
    for (int ai = 0; ai < 2; ++ai)
#pragma unroll
      for (int m = 0; m < 4; ++m) {
        const int row = row0 + ai * 128 + m * 16;
        u16* rowp = O + (size_t)row * 5120 + col0;
        if (dorope) {
          const int s = row & 2047;
          const int pos = axis ? (s & 63) : (s >> 6);
          const float4* rp = (const float4*)(rope + (pos * 32 + i0) * 2);
          float4 c01 = rp[0], c23 = rp[1];
#pragma unroll
          for (int bj = 0; bj < 2; ++bj) {
            pg8::f32x4 a = acc[ai][bj][m][0], b = acc[ai][bj][m][1], o0, o1;
            o0[0] = a[0] * c01.x - b[0] * c01.y; o1[0] = b[0] * c01.x + a[0] * c01.y;
            o0[1] = a[1] * c01.z - b[1] * c01.w; o1[1] = b[1] * c01.z + a[1] * c01.w;
            o0[2] = a[2] * c23.x - b[2] * c23.y; o1[2] = b[2] * c23.x + a[2] * c23.y;
            o0[3] = a[3] * c23.z - b[3] * c23.w; o1[3] = b[3] * c23.z + a[3] * c23.w;
            const uint2 lo = pack4(o0), hi = pack4(o1);
            *(uint4*)(rowp + bj * 128) = make_uint4(lo.x, lo.y, hi.x, hi.y);
          }
        } else {
#pragma unroll
          for (int bj = 0; bj < 2; ++bj) {
            const uint2 lo = pack4(acc[ai][bj][m][0]), hi = pack4(acc[ai][bj][m][1]);
            *(uint4*)(rowp + bj * 128) = make_uint4(lo.x, lo.y, hi.x, hi.y);
          }
        }
      }
  }
};
struct EpiRaw {
  static constexpr bool PERM = true, AFTER_DRAIN = false;
  u16* O; int ldc;
  __device__ __forceinline__ void operator()(const pg8::f32x4 (&acc)[2][2][4][2], const pg8::Unit& u, int wr, int wc, int fr, int fq) const {
    const int row0 = u.pm * 256 + wr * 64 + fr, col0 = u.pn * 256 + wc * 32 + 8 * fq;
#pragma unroll
    for (int ai = 0; ai < 2; ++ai)
#pragma unroll
      for (int m = 0; m < 4; ++m) {
        u16* rowp = O + (size_t)(row0 + ai * 128 + m * 16) * ldc + col0;
#pragma unroll
        for (int bj = 0; bj < 2; ++bj) {
          const uint2 lo = pack4(acc[ai][bj][m][0]), hi = pack4(acc[ai][bj][m][1]);
          *(uint4*)(rowp + bj * 128) = make_uint4(lo.x, lo.y, hi.x, hi.y);
        }
      }
  }
};
struct EpiRes {
  static constexpr bool PERM = false, AFTER_DRAIN = false;
  float* out; const float* base; const float* gate;
  __device__ __forceinline__ void operator()(const pg8::f32x4 (&acc)[2][2][4][2], const pg8::Unit& u, int wr, int wc, int fr, int fq) const {
    const int row0 = u.pm * 256 + wr * 64 + fr, col0 = u.pn * 256 + wc * 32 + 4 * fq;
    const int b = (u.pm * 256) >> 11;
    pg8::f32x4 gv[2][2];
#pragma unroll
    for (int bj = 0; bj < 2; ++bj)
#pragma unroll
      for (int n = 0; n < 2; ++n) gv[bj][n] = *(const pg8::f32x4*)(gate + b * 6144 + col0 + bj * 128 + n * 16);
#pragma unroll
    for (int ai = 0; ai < 2; ++ai)
#pragma unroll
      for (int m = 0; m < 4; ++m) {
        const size_t off = (size_t)(row0 + ai * 128 + m * 16) * 2048 + col0;
#pragma unroll
        for (int bj = 0; bj < 2; ++bj)
#pragma unroll
          for (int n = 0; n < 2; ++n) {
            pg8::f32x4 bv = *(const pg8::f32x4*)(base + off + bj * 128 + n * 16);
            *(pg8::f32x4*)(out + off + bj * 128 + n * 16) = bv + gv[bj][n] * acc[ai][bj][m][n];
          }
      }
  }
};

struct EpiResNorm {
  static constexpr bool PERM = false, AFTER_DRAIN = true;
  float* out; const float* base; const float* gate;
  float* rowss; unsigned* pcnt;
  const float* g; const float* shsc;
  u16* hx;
  static __device__ __forceinline__ int loff(int row, int chunk) { return row * 1024 + ((chunk ^ (row & 63)) << 4); }
  __device__ __forceinline__ void fused(pg8::f32x4 (&acc)[2][2][4][2], const pg8::Unit& u, int wr, int wc, int fr, int fq,
                                        PG8_LAS unsigned char* lds, int wid, int lane) const {
    const int R0 = u.pm * 256, C0 = u.pn * 256;
    const int b = R0 >> 11;
    const int frow = wr * 64 + fr, fchunk = wc * 8 + fq;
    {
      pg8::f32x4 gv[2][2];
#pragma unroll
      for (int bj = 0; bj < 2; ++bj)
#pragma unroll
        for (int n = 0; n < 2; ++n) gv[bj][n] = *(const pg8::f32x4*)(gate + b * 6144 + C0 + wc * 32 + 4 * fq + bj * 128 + n * 16);
#pragma unroll
      for (int ai = 0; ai < 2; ++ai) {
        {
          pg8::f32x4 t[16];
#pragma unroll
          for (int i = 0; i < 16; ++i) t[i] = __builtin_nontemporal_load((const pg8::f32x4*)(base + (size_t)(R0 + ai * 128 + wid * 16 + i) * 2048 + C0 + 4 * lane));
#pragma unroll
          for (int i = 0; i < 16; ++i) *(PG8_LAS pg8::f32x4*)(lds + loff(wid * 16 + i, lane)) = t[i];
        }
        __syncthreads();
#pragma unroll
        for (int m = 0; m < 4; ++m) {
          float ss = 0.f;
#pragma unroll
          for (int bj = 0; bj < 2; ++bj)
#pragma unroll
            for (int n = 0; n < 2; ++n) {
              const pg8::f32x4 bv = *(const PG8_LAS pg8::f32x4*)(lds + loff(frow + 16 * m, fchunk + 32 * bj + 4 * n));
              const pg8::f32x4 v = bv + gv[bj][n] * acc[ai][bj][m][n];
              acc[ai][bj][m][n] = v;
              ss += v[0] * v[0] + v[1] * v[1] + v[2] * v[2] + v[3] * v[3];
            }
          ss += __shfl_xor(ss, 16, 64);
          ss += __shfl_xor(ss, 32, 64);
          if (fq == 0) unsafeAtomicAdd(rowss + R0 + ai * 128 + frow + 16 * m, ss);
        }
        __syncthreads();
      }
    }
    asm volatile("s_waitcnt vmcnt(0)" ::: "memory");
    __syncthreads();
    if (threadIdx.x == 0) {
      unsigned* c = pcnt + u.pm * 64;
      __hip_atomic_fetch_add(c, 1u, __ATOMIC_RELAXED, __HIP_MEMORY_SCOPE_AGENT);
      unsigned spins = 0;
      while (__hip_atomic_load(c, __ATOMIC_RELAXED, __HIP_MEMORY_SCOPE_AGENT) < 8u && ++spins < (1u << 22)) __builtin_amdgcn_s_sleep(1);
    }
    __syncthreads();
    const pg8::f32x4 gg = *(const pg8::f32x4*)(g + C0 + 4 * lane);
    pg8::f32x4 sh = gg, sc = gg;
    if (hx) {
      sh = *(const pg8::f32x4*)(shsc + b * 6144 + C0 + 4 * lane);
      sc = *(const pg8::f32x4*)(shsc + b * 6144 + 2048 + C0 + 4 * lane) + 1.f;
    }
#pragma unroll
    for (int ai = 0; ai < 2; ++ai) {
#pragma unroll
      for (int m = 0; m < 4; ++m)
#pragma unroll
        for (int bj = 0; bj < 2; ++bj)
#pragma unroll
          for (int n = 0; n < 2; ++n)
            *(PG8_LAS pg8::f32x4*)(lds + loff(frow + 16 * m, fchunk + 32 * bj + 4 * n)) = acc[ai][bj][m][n];
      __syncthreads();
#pragma unroll 4
      for (int i = 0; i < 16; ++i) {
        const int lrow = wid * 16 + i, row = R0 + ai * 128 + lrow;
        const pg8::f32x4 v = *(const PG8_LAS pg8::f32x4*)(lds + loff(lrow, lane));
        const float ss = __hip_atomic_load(rowss + row, __ATOMIC_RELAXED, __HIP_MEMORY_SCOPE_AGENT);
        const float r = rsqrtf(ss * (1.f / 2048.f) + 1e-6f);
        const size_t off = (size_t)row * 2048 + C0 + 4 * lane;
        pg8::f32x4 o = v * r * gg;
        if (hx) {
          __builtin_nontemporal_store(v, (pg8::f32x4*)(out + off));
          o = o * sc + sh;
          *(uint2*)(hx + off) = pack4(o);
        } else {
          __builtin_nontemporal_store(o, (pg8::f32x4*)(out + off));
        }
      }
      __syncthreads();
    }
  }
};
template <class Epi, bool AGROUP = false>
__device__ __forceinline__ void run_gemm(float* sm, const u16* A, const u16* Bt, int M, int N, const Epi& E, int c) {
  pg8::Gemm g{A, Bt, M, N, 2048, AGROUP ? 1 : 0};
  pg8::StaticOrder S; S.init(M, N, (int)gridDim.x, c);
  pg8::gemm_phase<Epi, pg8::StaticOrder, AGROUP>((PG8_LAS unsigned char*)sm, g, S, E);
  __syncthreads();
}

template <int MODE>
__device__ __forceinline__ void epi_pair(const Params& p, int m, int n, float a0, float a1) {
  if (MODE == 1) {
    u16* px = (u16*)(p.ws + OFF_BIG);
    float o0 = a0, o1 = a1;
    if (n < 2560) {
      int g = (n >> 5) & 3, fr = n & 15;
      int axis = g >> 1, i = (g & 1) * 16 + fr;
      int s = m & 2047;
      int pos = axis ? (s & 63) : (s >> 6);
      float2 cs = ((const float2*)(p.ws + OFF_ROPE))[pos * 32 + i];
      o0 = a0 * cs.x - a1 * cs.y;
      o1 = a1 * cs.x + a0 * cs.y;
    }
    px[(size_t)m * 5120 + n] = f2bf(o0);
    px[(size_t)m * 5120 + n + 16] = f2bf(o1);
  } else if (MODE == 5) {
    u16* kvc = (u16*)(p.ws + OFF_KVC);
    kvc[(size_t)m * 1024 + n] = f2bf(a0);
    kvc[(size_t)m * 1024 + n + 16] = f2bf(a1);
  } else if (MODE == 2) {
    const float* mod = (const float*)(p.ws + OFF_MOD);
    int b = m >> 11;
    const float* gate = mod + (0 * 5 + b) * 6144 + 4096;
    p.out[(size_t)m * 2048 + n] = p.x[(size_t)m * 2048 + n] + gate[n] * a0;
    p.out[(size_t)m * 2048 + n + 16] = p.x[(size_t)m * 2048 + n + 16] + gate[n + 16] * a1;
  } else if (MODE == 3) {
    u16* pp = (u16*)(p.ws + OFF_BIG);
    pp[(size_t)m * 8192 + n] = f2bf(a0);
    pp[(size_t)m * 8192 + n + 16] = f2bf(a1);
  } else if (MODE == 4) {
    const float* mod = (const float*)(p.ws + OFF_MOD);
    int b = m >> 11;
    const float* gate = mod + (1 * 5 + b) * 6144 + 4096;
    p.out[(size_t)m * 2048 + n] += gate[n] * a0;
    p.out[(size_t)m * 2048 + n + 16] += gate[n + 16] * a1;
  }
}

template <int MODE>
__device__ __forceinline__ void naive_gemm(const Params& p, const u16* __restrict__ A, const u16* __restrict__ Wt, int M, int N) {
  const int tid = threadIdx.x;
  const int ml = tid >> 5, pl = tid & 31;
  const int ntn = N / 64, ntm = M / 16;
  for (int tile = blockIdx.x; tile < ntn * ntm; tile += gridDim.x) {
    int tm = tile / ntn, tn = tile % ntn;
    int m = tm * 16 + ml;
    int n = tn * 64 + (pl >> 4) * 32 + (pl & 15);
    const uint4* a = (const uint4*)(A + (size_t)m * 2048);
    const uint4* w0 = (const uint4*)(Wt + (size_t)n * 2048);
    const uint4* w1 = (const uint4*)(Wt + (size_t)(n + 16) * 2048);
    float acc0 = 0.f, acc1 = 0.f;
#pragma unroll 2
    for (int k = 0; k < 256; ++k) {
      uint4 av = a[k], b0 = w0[k], b1 = w1[k];
      acc0 += bflo(av.x) * bflo(b0.x) + bfhi(av.x) * bfhi(b0.x) + bflo(av.y) * bflo(b0.y) + bfhi(av.y) * bfhi(b0.y)
            + bflo(av.z) * bflo(b0.z) + bfhi(av.z) * bfhi(b0.z) + bflo(av.w) * bflo(b0.w) + bfhi(av.w) * bfhi(b0.w);
      acc1 += bflo(av.x) * bflo(b1.x) + bfhi(av.x) * bfhi(b1.x) + bflo(av.y) * bflo(b1.y) + bfhi(av.y) * bfhi(b1.y)
            + bflo(av.z) * bflo(b1.z) + bfhi(av.z) * bfhi(b1.z) + bflo(av.w) * bflo(b1.w) + bfhi(av.w) * bfhi(b1.w);
    }
    epi_pair<MODE>(p, m, n, acc0, acc1);
  }
}

__device__ __forceinline__ void phase_attn_naive(const Params& p, float* sm) {
  const int wid = threadIdx.x >> 6, lane = threadIdx.x & 63;
  float* qs = sm + wid * (128 + 640);
  float* pr = qs + 128;
  const u16* px = (const u16*)(p.ws + OFF_BIG);
  const u16* kvc = (const u16*)(p.ws + OFF_KVC);
  u16* og = (u16*)(p.ws + OFF_ACT);
  const float scale = 0.08838834764831845f;
  for (int item = blockIdx.x * 8 + wid; item < MT * 16; item += gridDim.x * 8) {
    int m = item >> 4, h = item & 15;
    int b = m >> 11, s = m & 2047, kvh = h >> 2, nblk = s >> 7;
    const u16* qrow = px + (size_t)m * 5120 + h * 128;
    qs[lane] = bf2f(qrow[lane]) * scale;
    qs[lane + 64] = bf2f(qrow[lane + 64]) * scale;
    asm volatile("s_waitcnt lgkmcnt(0)" ::: "memory");
    float mx = p.attn_sink[h];
#pragma unroll 1
    for (int j = 0; j < 10; ++j) {
      int kidx = j * 64 + lane;
      const u16* krow;
      bool valid;
      if (kidx < 384) {
        int kpos = (nblk - 1) * 128 + kidx;
        int rel = kpos - s;
        valid = (kpos >= 0) && (kpos < 2048) && (rel <= 128) && (rel >= -128);
        krow = px + (size_t)(b * 2048 + (valid ? kpos : 0)) * 5120 + 2048 + kvh * 128;
      } else {
        valid = true;
        krow = kvc + (size_t)(b * 256 + (kidx - 384)) * 1024 + kvh * 128;
      }
      float d = -1e30f;
      if (valid) {
        d = 0.f;
#pragma unroll 4
        for (int c = 0; c < 16; ++c) {
          uint4 kk = *(const uint4*)(krow + c * 8);
          const float* q8 = qs + c * 8;
          d += q8[0] * bflo(kk.x) + q8[1] * bfhi(kk.x) + q8[2] * bflo(kk.y) + q8[3] * bfhi(kk.y)
             + q8[4] * bflo(kk.z) + q8[5] * bfhi(kk.z) + q8[6] * bflo(kk.w) + q8[7] * bfhi(kk.w);
        }
      }
      pr[kidx] = d;
      mx = fmaxf(mx, d);
    }
    mx = wave_max(mx);
    float sum = 0.f;
#pragma unroll 1
    for (int j = 0; j < 10; ++j) {
      float d = pr[j * 64 + lane];
      float e = (d > -1e29f) ? __expf(d - mx) : 0.f;
      pr[j * 64 + lane] = e;
      sum += e;
    }
    sum = wave_sum(sum);
    sum += __expf(p.attn_sink[h] - mx);
    asm volatile("s_waitcnt lgkmcnt(0)" ::: "memory");
    float o0 = 0.f, o1 = 0.f;
    int k0 = s - 128 < 0 ? 0 : s - 128, k1 = s + 128 > 2047 ? 2047 : s + 128;
    for (int kpos = k0; kpos <= k1; ++kpos) {
      float pv = pr[kpos - (nblk - 1) * 128];
      unsigned vv = *(const unsigned*)(px + (size_t)(b * 2048 + kpos) * 5120 + 2560 + kvh * 128 + lane * 2);
      o0 += pv * bflo(vv); o1 += pv * bfhi(vv);
    }
    for (int c = 0; c < 256; ++c) {
      float pv = pr[384 + c];
      unsigned vv = *(const unsigned*)(kvc + (size_t)(b * 256 + c) * 1024 + 512 + kvh * 128 + lane * 2);
      o0 += pv * bflo(vv); o1 += pv * bfhi(vv);
    }
    float inv = 1.f / sum;
    unsigned gg = *(const unsigned*)(px + (size_t)m * 5120 + 3072 + h * 128 + lane * 2);
    float r0 = o0 * inv * siluf(bflo(gg)), r1 = o1 * inv * siluf(bfhi(gg));
    *(unsigned*)(og + (size_t)m * 2048 + h * 128 + lane * 2) = pk2(r0, r1);
    asm volatile("s_waitcnt lgkmcnt(0)" ::: "memory");
  }
}

__device__ __forceinline__ float sconv(const u16* pp, const float* cw, const float* cb, int b, int t, int c) {
  const u16* base = pp + (size_t)(b * 2048 + t) * 8192 + c;
  float v = cw[6144 + c] * bf2f(base[0]) + cb[c];
  if (t > 0) v += cw[c] * bf2f(base[-8192]);
  if (t < 2047) v += cw[2 * 6144 + c] * bf2f(base[8192]);
  return v;
}

__device__ __forceinline__ void phase_conv_naive(const Params& p, float* sm) {
  const int tid = threadIdx.x;
  float* u = sm;
  float* R = sm + 8192;
  const u16* pp = (const u16*)(p.ws + OFF_BIG);
  const u16* Rg = (const u16*)(p.ws + OFF_FILT);
  u16* yg = (u16*)(p.ws + OFF_ACT);
  for (int ch = blockIdx.x; ch < 2048; ch += gridDim.x) {
    for (int i = tid; i < 8192; i += NTHREADS) u[i] = sconv(pp, p.hy_conv_w, p.hy_conv_b, i >> 11, i & 2047, 4096 + ch);
    for (int i = tid; i < 4096; i += NTHREADS) R[i] = bf2f(Rg[((size_t)0 * 2048 + ch) * 4096 + i]);
    __syncthreads();
    float zr[16];
#pragma unroll
    for (int q = 0; q < 16; ++q) {
      int i = tid + q * NTHREADS;
      int b = i >> 11, t = i & 2047;
      const float* ub = u + b * 2048;
      const float* Rb = R + 2048 - t;
      float a = 0.f;
      for (int s = 0; s < 2048; ++s) a += Rb[s] * ub[s];
      zr[q] = a * sconv(pp, p.hy_conv_w, p.hy_conv_b, b, t, ch);
    }
    __syncthreads();
#pragma unroll
    for (int q = 0; q < 16; ++q) u[tid + q * NTHREADS] = zr[q];
    for (int i = tid; i < 4096; i += NTHREADS) R[i] = bf2f(Rg[((size_t)1 * 2048 + ch) * 4096 + i]);
    __syncthreads();
#pragma unroll
    for (int q = 0; q < 16; ++q) {
      int i = tid + q * NTHREADS;
      int b = i >> 11, t = i & 2047;
      const float* ub = u + b * 2048;
      const float* Rb = R + 2048 - t;
      float a = 0.f;
      for (int s = 0; s < 2048; ++s) a += Rb[s] * ub[s];
      float y = a * sconv(pp, p.hy_conv_w, p.hy_conv_b, b, t, 2048 + ch);
      float g = bf2f(pp[(size_t)(b * 2048 + t) * 8192 + 6144 + ch]);
      yg[(size_t)(b * 2048 + t) * 2048 + ch] = f2bf(y * siluf(g));
    }
    __syncthreads();
  }
}


typedef float f32x16 __attribute__((ext_vector_type(16)));
typedef pg8::bf16x8 bfx8;
constexpr int CONV_RF_BYTES = 4 * 2 * 8192;
constexpr int CONV_PAD = 7;
constexpr int CONV_UB_ONE = 316 * 64;
__device__ __forceinline__ int ub_addr(int col, int chunk) { return col * 64 + ((chunk ^ ((col >> 2) & 3)) << 4); }

__device__ __forceinline__ void conv_mfma(const char* Rf_ci, const char* Ub_c, int lane, int jh, f32x16 (&acc)[4]) {
  const int t2 = lane & 31, h = lane >> 5, n = lane & 31;
  const int lanedw = ((2048 - t2 + 8 * h) >> 1) - 512 * jh;
#pragma unroll
  for (int j = 0; j < 4; ++j)
#pragma unroll
    for (int r = 0; r < 16; ++r) acc[j][r] = 0.f;
#pragma unroll 1
  for (int f = 0; f < 8; ++f) {
    bfx8 Bw[9][2];
#pragma unroll
    for (int m = 0; m < 9; ++m) {
      const int col = (8 * m - f + CONV_PAD) * 4 + n;
#pragma unroll
      for (int kh = 0; kh < 2; ++kh) Bw[m][kh] = *(const bfx8*)(Ub_c + ub_addr(col, 2 * kh + h));
    }
    const unsigned* Rp = (const unsigned*)(Rf_ci + ((t2 & 1) ? 8192 : 0)) + lanedw - 16 * f;
#pragma unroll
    for (int e = -8; e <= 3; ++e) {
      int ee = e;
      if (e == -8) ee = (f == 0) ? -7 : -8;
      bfx8 A[2];
#pragma unroll
      for (int kh = 0; kh < 2; ++kh) {
        const unsigned* q = Rp - 128 * ee + 8 * kh;
        pg8::u32x4 pk;
        pk[0] = q[0]; pk[1] = q[1]; pk[2] = q[2]; pk[3] = q[3];
        A[kh] = __builtin_bit_cast(bfx8, pk);
      }
#pragma unroll
      for (int j = 0; j < 4; ++j) {
        const int m = j - e;
        if (m >= 0 && m <= 8) acc[j] = __builtin_amdgcn_mfma_f32_32x32x16_bf16(A[0], Bw[m][0], acc[j], 0, 0, 0);
      }
#pragma unroll
      for (int j = 0; j < 4; ++j) {
        const int m = j - e;
        if (m >= 0 && m <= 8) acc[j] = __builtin_amdgcn_mfma_f32_32x32x16_bf16(A[1], Bw[m][1], acc[j], 0, 0, 0);
      }
    }
  }
}

__device__ __forceinline__ void sconv4(const u16* xp, int t, float w0, float w1, float w2, float cb, float (&o)[4]) {
  uint2 x4 = *(const uint2*)xp;
  float pv = t > 0 ? bf2f(xp[-1]) : 0.f;
  float nx = (t + 4 < 2048) ? bf2f(xp[4]) : 0.f;
  float e0 = bflo(x4.x), e1 = bfhi(x4.x), e2 = bflo(x4.y), e3 = bfhi(x4.y);
  o[0] = w0 * pv + w1 * e0 + w2 * e1 + cb;
  o[1] = w0 * e0 + w1 * e1 + w2 * e2 + cb;
  o[2] = w0 * e1 + w1 * e2 + w2 * e3 + cb;
  o[3] = w0 * e2 + w1 * e3 + w2 * nx + cb;
}

struct SC4 { uint2 x; unsigned pn; };
__device__ __forceinline__ SC4 sc4_load(const u16* xp, int t) {
  SC4 r;
  r.x = *(const uint2*)xp;
  const unsigned pv = t > 0 ? (unsigned)xp[-1] : 0u;
  const unsigned nx = (t + 4 < 2048) ? (unsigned)xp[4] : 0u;
  r.pn = pv | (nx << 16);
  return r;
}
__device__ __forceinline__ void sc4_apply(const SC4& r, float w0, float w1, float w2, float cb, float (&o)[4]) {
  const float pv = bflo(r.pn), nx = bfhi(r.pn);
  const float e0 = bflo(r.x.x), e1 = bfhi(r.x.x), e2 = bflo(r.x.y), e3 = bfhi(r.x.y);
  o[0] = w0 * pv + w1 * e0 + w2 * e1 + cb;
  o[1] = w0 * e0 + w1 * e1 + w2 * e2 + cb;
  o[2] = w0 * e1 + w1 * e2 + w2 * e3 + cb;
  o[3] = w0 * e2 + w1 * e3 + w2 * nx + cb;
}

__device__ __forceinline__ void phase_conv(const Params& p, float* smf) {
  char* sm = (char*)smf;
  char* Rf = sm;
  char* Ub = sm + CONV_RF_BYTES;
  int tid = threadIdx.x;
  asm volatile("" : "+v"(tid));
  const int wid = tid >> 6, lane = tid & 63;
  const int ci = wid >> 1, jh = wid & 1;
  const u16* pT = (const u16*)(p.ws + OFF_BIG);
  const u16* Rg = (const u16*)(p.ws + OFF_FILT);
  u16* yg = (u16*)(p.ws + OFF_ACT);
  for (int kk = 0; kk < (4 * CONV_UB_ONE / 16 + NTHREADS - 1) / NTHREADS; ++kk) { const int zi = tid + kk * NTHREADS; if (zi < 4 * CONV_UB_ONE / 16) ((uint4*)Ub)[zi] = make_uint4(0, 0, 0, 0); }
  __syncthreads();
  char* Ub_w = Ub + ci * CONV_UB_ONE;
  const char* Rf_ci = Rf + ci * 16384;
  const int h = lane >> 5, n = lane & 31;
  for (int it0 = blockIdx.x * 2; it0 < 512; it0 += gridDim.x * 2)
#pragma unroll 1
  for (int sub = 0; sub < 2; ++sub) {
    const int item = it0 + sub;
    const int ch0 = item * 4;
    {
      const int q = tid & 255, hb = tid >> 8;
      uint4 x8[8]; unsigned pn[8]; uint4 fr[4];
#pragma unroll
      for (int k = 0; k < 8; ++k) {
        const int cc = 4096 + ch0 + (k >> 1), b = (k & 1) * 2 + hb;
        const u16* xp = pT + (size_t)cc * 8192 + b * 2048 + q * 8;
        x8[k] = *(const uint4*)xp;
        const unsigned pv = q > 0 ? (unsigned)xp[-1] : 0u;
        const unsigned nx = q < 255 ? (unsigned)xp[8] : 0u;
        pn[k] = pv | (nx << 16);
      }
      unsigned fx[4];
#pragma unroll
      for (int k = 0; k < 4; ++k) {
        const unsigned* fp = (const unsigned*)(Rg + ((size_t)0 * 2048 + ch0 + k) * 4096);
        fr[k] = ((const uint4*)fp)[tid];
        fx[k] = tid < 511 ? fp[4 * tid + 4] : 0u;
      }
#pragma unroll
      for (int k = 0; k < 8; ++k) {
        const int c = k >> 1, cc = 4096 + ch0 + c, b = (k & 1) * 2 + hb;
        const float w0 = p.hy_conv_w[cc], w1 = p.hy_conv_w[6144 + cc], w2 = p.hy_conv_w[2 * 6144 + cc], cb = p.hy_conv_b[cc];
        float e[10];
        e[0] = bflo(pn[k]); e[1] = bflo(x8[k].x); e[2] = bfhi(x8[k].x); e[3] = bflo(x8[k].y); e[4] = bfhi(x8[k].y);
        e[5] = bflo(x8[k].z); e[6] = bfhi(x8[k].z); e[7] = bflo(x8[k].w); e[8] = bfhi(x8[k].w); e[9] = bfhi(pn[k]);
        unsigned o[4];
#pragma unroll
        for (int kk = 0; kk < 4; ++kk) {
          float a = w0 * e[2 * kk] + w1 * e[2 * kk + 1] + w2 * e[2 * kk + 2] + cb;
          float bb = w0 * e[2 * kk + 1] + w1 * e[2 * kk + 2] + w2 * e[2 * kk + 3] + cb;
          o[kk] = pk2(a, bb);
        }
        const int t0 = q * 8, s1 = t0 >> 5, s2 = t0 & 31;
        const int col = (s1 + CONV_PAD) * 4 + b;
        *(uint4*)(Ub + c * CONV_UB_ONE + ub_addr(col, s2 >> 3)) = make_uint4(o[0], o[1], o[2], o[3]);
      }
#pragma unroll
      for (int k = 0; k < 4; ++k) {
        ((uint4*)(Rf + k * 16384))[tid] = fr[k];
        ((uint4*)(Rf + k * 16384 + 8192))[tid] = make_uint4(__builtin_amdgcn_alignbit(fr[k].y, fr[k].x, 16), __builtin_amdgcn_alignbit(fr[k].z, fr[k].y, 16),
                                                             __builtin_amdgcn_alignbit(fr[k].w, fr[k].z, 16), __builtin_amdgcn_alignbit(fx[k], fr[k].w, 16));
      }
    }
    __syncthreads();
    f32x16 acc[4];
    const int ch = ch0 + ci;
    {
      conv_mfma(Rf_ci, Ub_w, lane, jh, acc);
      SC4 xr[16];
#pragma unroll
      for (int j = 0; j < 4; ++j)
#pragma unroll
        for (int vg = 0; vg < 4; ++vg) {
          const int t1 = 8 * (j + 4 * jh) + (n >> 2), b = n & 3, t = 32 * t1 + 8 * vg + 4 * h;
          xr[j * 4 + vg] = sc4_load(pT + (size_t)ch * 8192 + b * 2048 + t, t);
        }
      const unsigned* f1p = (const unsigned*)(Rg + ((size_t)1 * 2048 + ch0) * 4096);
      const uint4 f1a = ((const uint4*)(f1p + 0 * 2048))[tid];
      const uint4 f1b = ((const uint4*)(f1p + 1 * 2048))[tid];
      const uint4 f1c = ((const uint4*)(f1p + 2 * 2048))[tid];
      const uint4 f1d = ((const uint4*)(f1p + 3 * 2048))[tid];
      const unsigned x1a = tid < 511 ? f1p[0 * 2048 + 4 * tid + 4] : 0u, x1b = tid < 511 ? f1p[1 * 2048 + 4 * tid + 4] : 0u;
      const unsigned x1c = tid < 511 ? f1p[2 * 2048 + 4 * tid + 4] : 0u, x1d = tid < 511 ? f1p[3 * 2048 + 4 * tid + 4] : 0u;
      const float w0 = p.hy_conv_w[ch], w1 = p.hy_conv_w[6144 + ch], w2 = p.hy_conv_w[2 * 6144 + ch], cb = p.hy_conv_b[ch];
      __syncthreads();
#pragma unroll
      for (int j = 0; j < 4; ++j)
#pragma unroll
        for (int vg = 0; vg < 4; ++vg) {
          const int t1 = 8 * (j + 4 * jh) + (n >> 2), bl = n & 3;
          float x1[4];
          sc4_apply(xr[j * 4 + vg], w0, w1, w2, cb, x1);
          uint2 pk;
          pk.x = pk2(x1[0] * acc[j][4 * vg + 0], x1[1] * acc[j][4 * vg + 1]);
          pk.y = pk2(x1[2] * acc[j][4 * vg + 2], x1[3] * acc[j][4 * vg + 3]);
          const int col = (t1 + CONV_PAD) * 4 + bl;
          *(uint2*)(Ub_w + ub_addr(col, vg) + 8 * h) = pk;
        }
      __syncthreads();
#define CONV_PUT_F(K, F, X) do { ((uint4*)(Rf + (K) * 16384))[tid] = F; \
        ((uint4*)(Rf + (K) * 16384 + 8192))[tid] = make_uint4(__builtin_amdgcn_alignbit(F.y, F.x, 16), __builtin_amdgcn_alignbit(F.z, F.y, 16), \
                                                               __builtin_amdgcn_alignbit(F.w, F.z, 16), __builtin_amdgcn_alignbit(X, F.w, 16)); } while (0)
      CONV_PUT_F(0, f1a, x1a); CONV_PUT_F(1, f1b, x1b); CONV_PUT_F(2, f1c, x1c); CONV_PUT_F(3, f1d, x1d);
#undef CONV_PUT_F
    }
    __syncthreads();
    {
      const int c2 = 2048 + ch;
      SC4 xr[16]; uint2 gr[16];
      conv_mfma(Rf_ci, Ub_w, lane, jh, acc);
#pragma unroll
      for (int j = 0; j < 4; ++j)
#pragma unroll
        for (int vg = 0; vg < 4; ++vg) {
          const int t1 = 8 * (j + 4 * jh) + (n >> 2), b = n & 3, t = 32 * t1 + 8 * vg + 4 * h;
          xr[j * 4 + vg] = sc4_load(pT + (size_t)c2 * 8192 + b * 2048 + t, t);
          gr[j * 4 + vg] = *(const uint2*)(pT + (size_t)(6144 + ch) * 8192 + b * 2048 + t);
        }
      const float w0 = p.hy_conv_w[c2], w1 = p.hy_conv_w[6144 + c2], w2 = p.hy_conv_w[2 * 6144 + c2], cb = p.hy_conv_b[c2];
      __syncthreads();
#pragma unroll
      for (int j = 0; j < 4; ++j)
#pragma unroll
        for (int vg = 0; vg < 4; ++vg) {
          const int t1 = 8 * (j + 4 * jh) + (n >> 2), bl = n & 3;
          float x2[4];
          sc4_apply(xr[j * 4 + vg], w0, w1, w2, cb, x2);
          const uint2 g4 = gr[j * 4 + vg];
          float y0 = x2[0] * acc[j][4 * vg + 0] * siluf(bflo(g4.x));
          float y1 = x2[1] * acc[j][4 * vg + 1] * siluf(bfhi(g4.x));
          float y2 = x2[2] * acc[j][4 * vg + 2] * siluf(bflo(g4.y));
          float y3 = x2[3] * acc[j][4 * vg + 3] * siluf(bfhi(g4.y));
          uint2 pk;
          pk.x = pk2(y0, y1);
          pk.y = pk2(y2, y3);
          const int col = (t1 + CONV_PAD) * 4 + bl;
          *(uint2*)(Ub_w + ub_addr(col, vg) + 8 * h) = pk;
        }
    }
    __syncthreads();
    int tw = tid;
    asm volatile("" : "+v"(tw));
#pragma unroll 4
    for (int kk = 0; kk < 16; ++kk) {
      const int idx = tw + kk * NTHREADS;
      const int b = idx >> 11, t = idx & 2047;
      const int s1 = t >> 5, s2 = t & 31;
      const int col = (s1 + CONV_PAD) * 4 + b;
      const int a = ub_addr(col, s2 >> 3) + (s2 & 7) * 2;
      const char* base = Ub + a;
      unsigned v0 = *(const u16*)(base + 0 * CONV_UB_ONE), v1 = *(const u16*)(base + 1 * CONV_UB_ONE);
      unsigned v2 = *(const u16*)(base + 2 * CONV_UB_ONE), v3 = *(const u16*)(base + 3 * CONV_UB_ONE);
      const uint2 cur = make_uint2(v0 | (v1 << 16), v2 | (v3 << 16));
      *(uint2*)(yg + ((size_t)(item >> 1) * 8192 + idx) * 8 + (item & 1) * 4) = cur;
    }
    __syncthreads();
  }
}

constexpr int AT_KROW = 272, AT_VROW = 136;
constexpr int AT_K_BYTES = 64 * AT_KROW, AT_V_BYTES = 128 * AT_VROW;
__device__ __forceinline__ void phase_attn(const Params& p, float* smf) {
  char* sm = (char*)smf;
  char* Ks = sm;
  char* Vs = sm + AT_K_BYTES;
  const int tid = threadIdx.x, wid = tid >> 6, lane = tid & 63, r = lane & 31, h = lane >> 5;
  const u16* px = (const u16*)(p.ws + OFF_BIG);
  const u16* kvc = (const u16*)(p.ws + OFF_KVC);
  const u16* vT = (const u16*)(p.ws + OFF_VT);
  const u16* vcT = (const u16*)(p.ws + OFF_VCT);
  u16* og = (u16*)(p.ws + OFF_ACT);
  const float LOG2E = 1.4426950408889634f;
  const float sl2 = 0.08838834764831845f * LOG2E;
  for (int item = blockIdx.x; item < 512; item += gridDim.x) {
    const int hp = item & 1, kvh = (item >> 1) & 3, nblk = (item >> 3) & 15, b = item >> 7;
    const int hq = kvh * 4 + hp * 2 + (wid >> 2);
    const int qs = nblk * 128 + (wid & 3) * 32 + r;
    bfx8 Q[8];
    {
      const u16* qrow = px + (size_t)(b * 2048 + qs) * 5120 + hq * 128 + 8 * h;
#pragma unroll
      for (int st = 0; st < 8; ++st) Q[st] = *(const bfx8*)(qrow + 16 * st);
    }
    f32x16 O[4];
#pragma unroll
    for (int dt = 0; dt < 4; ++dt)
#pragma unroll
      for (int i = 0; i < 16; ++i) O[dt][i] = 0.f;
    float m = p.attn_sink[hq] * LOG2E;
    float l = (h == 0) ? 1.f : 0.f;
    const int first = (nblk == 0) ? 2 : 0, lastlocal = (nblk == 15) ? 3 : 5;
    uint4 kA0, kA1, vA0, vA1, kB0, kB1, vB0, vB1;
#define AT_LOAD_TILE(TI, K0, K1, V0, V1) do { \
      const int _ti = (TI); const bool _loc = _ti < 6; \
      const int _kpos0 = 128 * (nblk - 1) + 64 * _ti, _c0 = 64 * (_ti - 6); \
      const u16* _kb = _loc ? px + (size_t)(b * 2048 + _kpos0) * 5120 + 2048 + kvh * 128 : kvc + (size_t)(b * 256 + _c0) * 1024 + kvh * 128; \
      const size_t _ks = _loc ? 5120 : 1024; \
      const u16* _vb = _loc ? vT + (size_t)(kvh * 128) * 8192 + b * 2048 + _kpos0 : vcT + (size_t)(kvh * 128) * 1024 + b * 256 + _c0; \
      const size_t _vs = _loc ? 8192 : 1024; \
      const int _c1 = tid + NTHREADS; \
      K0 = *(const uint4*)(_kb + (size_t)(tid >> 4) * _ks + (tid & 15) * 8); \
      K1 = *(const uint4*)(_kb + (size_t)(_c1 >> 4) * _ks + (_c1 & 15) * 8); \
      V0 = *(const uint4*)(_vb + (size_t)(tid >> 3) * _vs + (tid & 7) * 8); \
      V1 = *(const uint4*)(_vb + (size_t)(_c1 >> 3) * _vs + (_c1 & 7) * 8); \
    } while (0)
#define AT_STORE_TILE(K0, K1, V0, V1) do { \
      const int c1 = tid + NTHREADS; \
      *(uint4*)(Ks + (tid >> 4) * AT_KROW + (tid & 15) * 16) = K0; \
      *(uint4*)(Ks + (c1 >> 4) * AT_KROW + (c1 & 15) * 16) = K1; \
      char* v0p = Vs + (tid >> 3) * AT_VROW + (tid & 7) * 16; \
      char* v1p = Vs + (c1 >> 3) * AT_VROW + (c1 & 7) * 16; \
      *(uint2*)(v0p) = make_uint2(V0.x, V0.y); \
      *(uint2*)(v0p + 8) = make_uint2(V0.z, V0.w); \
      *(uint2*)(v1p) = make_uint2(V1.x, V1.y); \
      *(uint2*)(v1p + 8) = make_uint2(V1.z, V1.w); \
    } while (0)
    int ti = first;
    int t1 = ti + 1;
    if (t1 > lastlocal && t1 < 6) t1 = 6;
    AT_LOAD_TILE(ti, kA0, kA1, vA0, vA1);
    if (t1 < 10) AT_LOAD_TILE(t1, kB0, kB1, vB0, vB1);
    while (true) {
#pragma unroll
     for (int half = 0; half < 2; ++half) {
      __syncthreads();
      if (half == 0) AT_STORE_TILE(kA0, kA1, vA0, vA1); else AT_STORE_TILE(kB0, kB1, vB0, vB1);
      __syncthreads();
      int t2 = t1 + 1;
      if (t2 > lastlocal && t2 < 6) t2 = 6;
      if (t1 >= 10) t2 = 10;
      if (t2 < 10) { if (half == 0) AT_LOAD_TILE(t2, kA0, kA1, vA0, vA1); else AT_LOAD_TILE(t2, kB0, kB1, vB0, vB1); }
      const int q0w = nblk * 128 + (wid & 3) * 32;
      const int kp0 = 128 * (nblk - 1) + 64 * ti;
      if (!(ti < 6 && (kp0 > q0w + 31 + 128 || kp0 + 63 < q0w - 128))) {
        const bool local = ti < 6;
        const int kpos0 = 128 * (nblk - 1) + 64 * ti;
        f32x16 S[2];
#pragma unroll
        for (int ks = 0; ks < 2; ++ks) {
#pragma unroll
          for (int i = 0; i < 16; ++i) S[ks][i] = 0.f;
#pragma unroll
          for (int st = 0; st < 8; ++st) {
            bfx8 A = *(const bfx8*)(Ks + (ks * 32 + r) * AT_KROW + (16 * st + 8 * h) * 2);
            S[ks] = __builtin_amdgcn_mfma_f32_32x32x16_bf16(A, Q[st], S[ks], 0, 0, 0);
          }
        }
        const bool needmask = local && (kp0 > q0w + 65 || kp0 < q0w - 97);
        float mraw = -1e30f;
        if (needmask) {
          const int relb = kpos0 + 4 * h - qs;
#pragma unroll
          for (int ks = 0; ks < 2; ++ks)
#pragma unroll
            for (int i = 0; i < 16; ++i) {
              const int rel = relb + ks * 32 + (i & 3) + 8 * (i >> 2);
              float sv = S[ks][i];
              if (rel > 128 || rel < -128) sv = -1e30f;
              S[ks][i] = sv;
              mraw = fmaxf(mraw, sv);
            }
        } else {
#pragma unroll
          for (int ks = 0; ks < 2; ++ks)
#pragma unroll
            for (int i = 0; i < 16; ++i) mraw = fmaxf(mraw, S[ks][i]);
        }
        float mx = fmaxf(m, mraw * sl2);
        mx = fmaxf(mx, __shfl_xor(mx, 32, 64));
        if (__builtin_amdgcn_ballot_w64(mx != m) != 0ull) {
          const float alpha = __builtin_amdgcn_exp2f(m - mx);
          m = mx;
          l *= alpha;
#pragma unroll
          for (int dt = 0; dt < 4; ++dt)
#pragma unroll
            for (int i = 0; i < 16; ++i) O[dt][i] *= alpha;
        }
#pragma unroll
        for (int ks = 0; ks < 2; ++ks)
#pragma unroll
          for (int i = 0; i < 16; ++i) {
            float pv = __builtin_amdgcn_exp2f(__builtin_fmaf(S[ks][i], sl2, -m));
            l += pv;
            S[ks][i] = pv;
          }
#pragma unroll
        for (int s4 = 0; s4 < 4; ++s4) {
          const int ks = s4 >> 1, hf = s4 & 1;
          pg8::u32x4 pk;
#pragma unroll
          for (int j = 0; j < 4; ++j)
            pk[j] = pk2(S[ks][8 * hf + 2 * j], S[ks][8 * hf + 2 * j + 1]);
          bfx8 P = __builtin_bit_cast(bfx8, pk);
#pragma unroll
          for (int dt = 0; dt < 4; ++dt) {
            const char* vp = Vs + (dt * 32 + r) * AT_VROW + (32 * ks + 16 * hf + 4 * h) * 2;
            uint2 v0 = *(const uint2*)vp, v1 = *(const uint2*)(vp + 16);
            pg8::u32x4 vv; vv[0] = v0.x; vv[1] = v0.y; vv[2] = v1.x; vv[3] = v1.y;
            O[dt] = __builtin_amdgcn_mfma_f32_32x32x16_bf16(__builtin_bit_cast(bfx8, vv), P, O[dt], 0, 0, 0);
          }
        }
      }
      if (t1 >= 10) goto attn_done;
      ti = t1; t1 = t2;
     }
    }
    attn_done:;
    const float ltot = l + __shfl_xor(l, 32, 64);
    const float inv = 1.f / ltot;
    const size_t tok = (size_t)(b * 2048 + qs);
#pragma unroll
    for (int dt = 0; dt < 4; ++dt)
#pragma unroll
      for (int g4 = 0; g4 < 4; ++g4) {
        const int d = dt * 32 + 8 * g4 + 4 * h;
        uint2 gg = *(const uint2*)(px + tok * 5120 + 3072 + hq * 128 + d);
        float o0 = O[dt][4 * g4 + 0] * inv * siluf(bflo(gg.x));
        float o1 = O[dt][4 * g4 + 1] * inv * siluf(bfhi(gg.x));
        float o2 = O[dt][4 * g4 + 2] * inv * siluf(bflo(gg.y));
        float o3 = O[dt][4 * g4 + 3] * inv * siluf(bfhi(gg.y));
        uint2 pk;
        pk.x = pk2(o0, o1);
        pk.y = pk2(o2, o3);
        *(uint2*)(og + tok * 2048 + hq * 128 + d) = pk;
      }
  }
}

#define XB_TMO      128
#define XB_XCNT(j)  (256  + 64 * (j))
#define XB_XSUB(j)  (1280 + 64 * (j))
#define XB_XGEN(j)  (2304 + 64 * (j))
#define XB_TOP      3328
#define XB_TOPGEN   3392
#define XCD_BAR_WORDS 3456
#define XB_SPIN_CAP (1u << 18)
#define LAS __attribute__((address_space(3)))

__device__ __forceinline__ unsigned xb_ld(unsigned* p)              { return __hip_atomic_load(p, __ATOMIC_RELAXED, __HIP_MEMORY_SCOPE_AGENT); }
__device__ __forceinline__ unsigned xb_add(unsigned* p, unsigned v) { return __hip_atomic_fetch_add(p, v, __ATOMIC_RELAXED, __HIP_MEMORY_SCOPE_AGENT); }
__device__ __forceinline__ unsigned xb_xcc_id() { return (unsigned)__builtin_amdgcn_s_getreg((3 << 11) | 20) & 0xFu; }
#define XB_SPIN(cond, bar) do { unsigned _sp = 0; while (cond) { __builtin_amdgcn_s_sleep(1); \
    if ((++_sp & 255u) == 0u) { if (xb_ld(&(bar)[XB_TMO])) break; if (_sp > XB_SPIN_CAP) { atomicAdd(&(bar)[XB_TMO], 1u); break; } } } } while (0)

struct XcdBarrier {
    unsigned* bar; unsigned x;
    volatile LAS unsigned* st;
};

__device__ __forceinline__ XcdBarrier xcd_barrier_post(unsigned* bar, volatile LAS unsigned* st) {
    XcdBarrier b; b.bar = bar; b.x = xb_xcc_id(); b.st = st;
    if (threadIdx.x == 0) (void)xb_add(&bar[XB_XCNT(b.x)], 1u);
    return b;
}
__device__ __forceinline__ void xcd_barrier_complete(unsigned* bar, unsigned x, unsigned& nloc, unsigned& nx) {
    const unsigned G = gridDim.x * gridDim.y * gridDim.z;
    unsigned sum, cnt, mine, sp = 0u;
    for (;;) {
        sum = 0u; cnt = 0u; mine = 0u;
#pragma unroll
        for (unsigned j = 0; j < 16; ++j) { const unsigned c = xb_ld(&bar[XB_XCNT(j)]); sum += c; cnt += (c > 0u) ? 1u : 0u; mine = (j == x) ? c : mine; }
        if (sum == G) break;
        __builtin_amdgcn_s_sleep(1);
        if ((++sp & 255u) == 0u) { if (xb_ld(&bar[XB_TMO])) break; if (sp > XB_SPIN_CAP) { atomicAdd(&bar[XB_TMO], 1u); break; } }
    }
    nloc = mine > 0u ? mine : 1u; nx = cnt > 0u ? cnt : 1u;
}

__device__ __forceinline__ void xcd_barrier(const XcdBarrier& b) {
    asm volatile("s_waitcnt vmcnt(0)" ::: "memory");
    __syncthreads();
    if (threadIdx.x == 0) {
        unsigned* bar = b.bar;
        __builtin_amdgcn_s_waitcnt(0);
        unsigned nloc = b.st[0], nx = b.st[1];
        if (nloc == 0u) { xcd_barrier_complete(bar, b.x, nloc, nx); b.st[0] = nloc; b.st[1] = nx; }
        const unsigned old = xb_add(&bar[XB_XSUB(b.x)], 1u);
        const unsigned gen = old / nloc;
        if (old + 1u == (gen + 1u) * nloc) {
            __builtin_amdgcn_fence(__ATOMIC_RELEASE, "agent");
            asm volatile("s_waitcnt vmcnt(0)" ::: "memory");
            const unsigned og = xb_add(&bar[XB_TOP], 1u);
            const unsigned tg = og / nx;
            if (og + 1u == (tg + 1u) * nx) xb_add(&bar[XB_TOPGEN], 1u);
            else XB_SPIN(xb_ld(&bar[XB_TOPGEN]) == tg, bar);
            __builtin_amdgcn_fence(__ATOMIC_ACQUIRE, "agent");
            xb_add(&bar[XB_XGEN(b.x)], 1u);
            asm volatile("s_waitcnt vmcnt(0)" ::: "memory");
        } else {
            XB_SPIN(xb_ld(&bar[XB_XGEN(b.x)]) == gen, bar);
            __builtin_amdgcn_fence(__ATOMIC_ACQUIRE, "agent");
            asm volatile("s_waitcnt vmcnt(0)" ::: "memory");
        }
    }
    __syncthreads();
}


constexpr int N_PHASES = 9;
__global__ void __launch_bounds__(NTHREADS, 2) mega(Params p, int ph0, int ph1) {
  extern __shared__ __attribute__((aligned(16))) float sm[];
  volatile LAS unsigned* xb_st = (volatile LAS unsigned*)((LAS unsigned char*)sm + 162816);
  if (threadIdx.x < 4) xb_st[threadIdx.x] = 0u;
  __syncthreads();
  const XcdBarrier xb = xcd_barrier_post((unsigned*)(p.ws + OFF_BAR), xb_st);
#define PH(i, body) if (ph0 <= (i) && (i) < ph1) { body; if ((i) + 1 < ph1) xcd_barrier(xb); }
  if (ph0 < 0) cg::this_grid().sync();
  PH(0, phase0(p, sm))
  PH(1, phase_norm(p, 0))
  PH(2, run_gemm(sm, (const u16*)(p.ws + OFF_ACT), (const u16*)(p.ws + OFF_WT_AI), MT, ATTN_IN,
                 EpiAttnIn{(u16*)(p.ws + OFF_BIG), (const float*)(p.ws + OFF_ROPE)}, (int)blockIdx.x);
        run_gemm(sm, (const u16*)(p.ws + OFF_HC), (const u16*)(p.ws + OFF_WT_AI) + (size_t)2048 * 2048, MC, 1024,
                 EpiRaw{(u16*)(p.ws + OFF_KVC), 1024}, (int)((blockIdx.x + 64) % gridDim.x));
        run_gemm(sm, (const u16*)(p.ws + OFF_WT_AI) + (size_t)2560 * 2048, (const u16*)(p.ws + OFF_ACT), 512, MT,
                 EpiRaw{(u16*)(p.ws + OFF_VT), 8192}, (int)((blockIdx.x + 128) % gridDim.x));
        run_gemm(sm, (const u16*)(p.ws + OFF_WT_AI) + (size_t)2560 * 2048, (const u16*)(p.ws + OFF_HC), 512, MC,
                 EpiRaw{(u16*)(p.ws + OFF_VCT), 1024}, (int)((blockIdx.x + 48) % gridDim.x)))
  PH(3, phase_attn(p, sm))
  PH(4, run_gemm(sm, (const u16*)(p.ws + OFF_ACT), (const u16*)(p.ws + OFF_WT_AO), MT, 2048,
                 EpiResNorm{p.out, p.x, (const float*)(p.ws + OFF_MOD) + 4096, (float*)(p.ws + OFF_ROWSS), (unsigned*)(p.ws + OFF_PCNT),
                            p.norm_g + 2048, (const float*)(p.ws + OFF_MOD) + 5 * 6144, (u16*)(p.ws + OFF_ACT)}, (int)blockIdx.x))
  PH(6, run_gemm(sm, (const u16*)(p.ws + OFF_WT_HI), (const u16*)(p.ws + OFF_ACT), HY_IN, MT,
                 EpiRaw{(u16*)(p.ws + OFF_BIG), 8192}, (int)blockIdx.x))
  PH(7, phase_conv(p, sm))
  PH(8, (run_gemm<EpiResNorm, true>(sm, (const u16*)(p.ws + OFF_ACT), (const u16*)(p.ws + OFF_WT_HO), MT, 2048,
                 EpiResNorm{p.out, p.out, (const float*)(p.ws + OFF_MOD) + 5 * 6144 + 4096, (float*)(p.ws + OFF_ROWSS) + 8192,
                            (unsigned*)(p.ws + OFF_PCNT) + 32 * 64, p.final_g, nullptr, nullptr}, (int)blockIdx.x)))
}

extern "C" void kernel_launch(void* const* d_in, const int* in_sizes, int n_in, void* d_out, int out_size,
                              void* d_ws, size_t ws_size, hipStream_t stream) {
  Params p{};
  const float** f = (const float**)&p;
  for (int i = 0; i < 23; ++i) f[i] = (const float*)d_in[i];
  p.out = (float*)d_out;
  p.ws = (char*)d_ws;
  constexpr size_t kLds = 162816 + 16;
  static int grid_blocks = 0;
  if (!grid_blocks) {
    (void)hipFuncSetAttribute((const void*)mega, hipFuncAttributeMaxDynamicSharedMemorySize, (int)kLds);
    int dev = 0, cus = 0, per_cu = 0;
    (void)hipGetDevice(&dev);
    (void)hipDeviceGetAttribute(&cus, hipDeviceAttributeMultiprocessorCount, dev);
    (void)hipOccupancyMaxActiveBlocksPerMultiprocessor(&per_cu, mega, NTHREADS, kLds);
    if (per_cu < 1) per_cu = 1;
    grid_blocks = cus * per_cu;
  }
  (void)hipMemsetAsync((char*)d_ws + OFF_BAR, 0, ZERO_BYTES, stream);
  int ph0 = 0, ph1 = N_PHASES;
  void* args[] = {(void*)&p, (void*)&ph0, (void*)&ph1};
  hipError_t e = hipLaunchCooperativeKernel((const void*)mega, dim3(grid_blocks), dim3(NTHREADS), args, kLds, stream);
  if (e != hipSuccess) fprintf(stderr, "cooperative launch failed: %s (grid %d)\n", hipGetErrorString(e), grid_blocks);
}
```

```cpp
#include <hip/hip_runtime.h>
#include <hip/hip_bf16.h>
#include <hip/hip_cooperative_groups.h>
#include <cstdio>
namespace cg = cooperative_groups;
typedef unsigned short u16;

#define NTHREADS 512
constexpr int Bn = 4, Sn = 2048, Dn = 2048, Cn = 256;
constexpr int MT = Bn * Sn;
constexpr int MC = Bn * Cn;
constexpr int ATTN_IN = 5120;
constexpr int HY_IN = 8192;

constexpr size_t OFF_WT_AI = 0;
constexpr size_t OFF_WT_AO = OFF_WT_AI + (size_t)5120 * 2048 * 2;
constexpr size_t OFF_WT_HI = OFF_WT_AO + (size_t)2048 * 2048 * 2;
constexpr size_t OFF_WT_HO = OFF_WT_HI + (size_t)8192 * 2048 * 2;
constexpr size_t OFF_MOD   = OFF_WT_HO + (size_t)2048 * 2048 * 2;
constexpr size_t OFF_ROPE  = OFF_MOD + (size_t)2 * 5 * 6144 * 4 + 256;
constexpr size_t OFF_FILT  = OFF_ROPE + (size_t)64 * 32 * 8;
constexpr size_t OFF_ACT   = OFF_FILT + (size_t)2 * 2048 * 4096 * 2;
constexpr size_t OFF_HC    = OFF_ACT + (size_t)8192 * 2048 * 2;
constexpr size_t OFF_KVC   = OFF_HC + (size_t)1024 * 2048 * 2;
constexpr size_t OFF_VT    = OFF_KVC + (size_t)1024 * 1024 * 2;
constexpr size_t OFF_VCT   = OFF_VT + (size_t)512 * 8192 * 2;
constexpr size_t OFF_BIG   = OFF_VCT + (size_t)512 * 1024 * 2;

constexpr size_t OFF_BAR   = OFF_BIG + (size_t)8192 * 8192 * 2;

constexpr size_t OFF_ROWSS = OFF_BAR + 16384;
constexpr size_t OFF_PCNT  = OFF_ROWSS + (size_t)2 * 8192 * 4;
constexpr size_t ZERO_BYTES = 16384 + (size_t)2 * 8192 * 4 + (size_t)2 * 32 * 64 * 4;

struct Params {
  const float *x, *c, *ctx, *c_ctx, *norm_g, *ada_w, *ada_b, *attn_w_in, *attn_w_out, *attn_sink;
  const float *hy_w_in, *hy_conv_w, *hy_conv_b, *hy_w1, *hy_b1, *hy_w2, *hy_b2, *hy_w3, *hy_b3;
  const float *hy_freq, *hy_bias_d, *hy_w_out, *final_g;
  float* out;
  char* ws;
};

__device__ __forceinline__ u16 f2bf(float f) {
  unsigned u = __float_as_uint(f);
  u += 0x7fffu + ((u >> 16) & 1u);
  return (u16)(u >> 16);
}
__device__ __forceinline__ float bf2f(u16 h) { return __uint_as_float(((unsigned)h) << 16); }
__device__ __forceinline__ unsigned pk2(float lo, float hi) { unsigned r; asm("v_cvt_pk_bf16_f32 %0, %1, %2" : "=v"(r) : "v"(lo), "v"(hi)); return r; }
typedef float nt_f4 __attribute__((ext_vector_type(4)));
__device__ __forceinline__ float4 ntl4(const float* p) { nt_f4 v = __builtin_nontemporal_load((const nt_f4*)p); return make_float4(v[0], v[1], v[2], v[3]); }
#define NTL4(P) ntl4(P)
__device__ __forceinline__ float bflo(unsigned w) { return __uint_as_float(w << 16); }
__device__ __forceinline__ float bfhi(unsigned w) { return __uint_as_float(w & 0xffff0000u); }
__device__ __forceinline__ float siluf(float v) { return v / (1.f + __expf(-v)); }
__device__ __forceinline__ float wave_sum(float v) {
#pragma unroll
  for (int o = 32; o > 0; o >>= 1) v += __shfl_xor(v, o, 64);
  return v;
}
__device__ __forceinline__ float wave_max(float v) {
#pragma unroll
  for (int o = 32; o > 0; o >>= 1) v = fmaxf(v, __shfl_xor(v, o, 64));
  return v;
}

__device__ __forceinline__ void p0_convert(const float* __restrict__ W, u16* __restrict__ Wt, int N, int tk, int tn,
                           bool perm, float* sm) {
  const int tid = threadIdx.x;
  for (int i = tid; i < 64 * 32; i += NTHREADS) {
    int r = i >> 5, c4 = i & 31;
    float4 v = *(const float4*)(W + (size_t)(tk * 64 + r) * N + tn * 128 + c4 * 4);
    float* d = sm + r * 129 + c4 * 4;
    d[0] = v.x; d[1] = v.y; d[2] = v.z; d[3] = v.w;
  }
  __syncthreads();
  for (int i = tid; i < 128 * 8; i += NTHREADS) {
    int nrow = i >> 3, kc = i & 7;
    int src = nrow;
    if (perm && (tn * 128 < 2560)) {
      int g = nrow >> 5, nn = (nrow >> 4) & 1, fr = nrow & 15;
      src = (g >> 1) * 64 + nn * 32 + (g & 1) * 16 + fr;
    }
    unsigned w[4];
#pragma unroll
    for (int j = 0; j < 4; ++j) {
      float a = sm[(kc * 8 + 2 * j) * 129 + src];
      float b = sm[(kc * 8 + 2 * j + 1) * 129 + src];
      w[j] = pk2(a, b);
    }
    *(uint4*)(Wt + (size_t)(tn * 128 + nrow) * 2048 + tk * 64 + kc * 8) = make_uint4(w[0], w[1], w[2], w[3]);
  }
  __syncthreads();
}

__device__ __forceinline__ void p0_adaln(const Params& p, int item, float* sm) {
  const int tid = threadIdx.x;
  float* sv = sm;
  float* red = sm + 5 * 2048;
  int col0 = item * 48;
  int l = col0 / 6144, n0 = col0 % 6144;
  for (int i = tid; i < 5 * 2048; i += NTHREADS) {
    int v = i >> 11, k = i & 2047;
    float cv = v < 4 ? p.c[v * 2048 + k] : p.c_ctx[k];
    sv[i] = cv / (1.f + expf(-cv));
  }
  __syncthreads();
  int kg = tid / 12, cq = tid % 12;
  float acc[5][4];
#pragma unroll
  for (int v = 0; v < 5; ++v)
#pragma unroll
    for (int j = 0; j < 4; ++j) acc[v][j] = 0.f;
  if (kg < 42) {
    const float* W = p.ada_w + (size_t)l * 2048 * 6144 + n0 + cq * 4;
#pragma unroll 8
    for (int k = kg; k < 2048; k += 42) {
      float4 w = ntl4(W + (size_t)k * 6144);
#pragma unroll
      for (int v = 0; v < 5; ++v) {
        float s = sv[v * 2048 + k];
        acc[v][0] += s * w.x; acc[v][1] += s * w.y; acc[v][2] += s * w.z; acc[v][3] += s * w.w;
      }
    }
  }
  if (kg >= 21 && kg < 42) {
#pragma unroll
    for (int v = 0; v < 5; ++v)
#pragma unroll
      for (int j = 0; j < 4; ++j) red[((kg - 21) * 5 + v) * 48 + cq * 4 + j] = acc[v][j];
  }
  __syncthreads();
  if (kg < 21) {
#pragma unroll
    for (int v = 0; v < 5; ++v)
#pragma unroll
      for (int j = 0; j < 4; ++j) red[(kg * 5 + v) * 48 + cq * 4 + j] += acc[v][j];
  }
  __syncthreads();
  if (tid < 240) {
    int v = tid / 48, cc = tid % 48;
    float s = 0.f;
    for (int g = 0; g < 21; ++g) s += red[(g * 5 + v) * 48 + cc];
    float* mod = (float*)(p.ws + OFF_MOD);
    mod[(l * 5 + v) * 6144 + n0 + cc] = s + p.ada_b[l * 6144 + n0 + cc];
  }
  __syncthreads();
}

__device__ __forceinline__ void p0_rope(const Params& p) {
  float2* rope = (float2*)(p.ws + OFF_ROPE);
  for (int i = threadIdx.x; i < 64 * 32; i += NTHREADS) {
    int pos = i >> 5, j = i & 31;
    float inv = powf(10000.f, -(float)(2 * j) / 64.f);
    float ang = (float)pos * inv;
    rope[i] = make_float2(cosf(ang), sinf(ang));
  }
}

typedef short bf16x8_t __attribute__((ext_vector_type(8)));
typedef unsigned u32x4_t __attribute__((ext_vector_type(4)));
typedef float f32x16_t __attribute__((ext_vector_type(16)));
__device__ __forceinline__ void split8(const float (&v)[8], bf16x8_t& hi, bf16x8_t& lo) {
  u32x4_t H, L;
#pragma unroll
  for (int j = 0; j < 4; ++j) {
    const u16 h0 = f2bf(v[2 * j]), h1 = f2bf(v[2 * j + 1]);
    const float r0 = v[2 * j] - bf2f(h0), r1 = v[2 * j + 1] - bf2f(h1);
    H[j] = (unsigned)h0 | ((unsigned)h1 << 16);
    L[j] = pk2(r0, r1);
  }
  hi = __builtin_bit_cast(bf16x8_t, H);
  lo = __builtin_bit_cast(bf16x8_t, L);
}
__device__ __forceinline__ void p0_filter(const Params& p, int item, float* sm) {
  int tid = threadIdx.x;
  asm volatile("" : "+v"(tid));
  const int lane = tid & 63, wid = tid >> 6, r = lane & 31, h = lane >> 5;
  const int cc = item & 15, pg = item >> 4;
  float* z = sm;
  float* h1 = z + 128 * 36;
  float* h2 = h1 + 128 * 64;
  for (int i = tid; i < 128 * 33; i += NTHREADS) {
    int pos = i / 33, e = i % 33;
    int t = pg * 128 + pos;
    float val;
    if (e == 0) val = (float)t / 2047.f;
    else {
      int bi = (e - 1) & 15;
      float w = 6.283185307179586f * (float)t / 2048.f;
      float fr = 1e-4f + (float)bi * ((15.f - 1e-4f) / 15.f);
      float ang = w * fr;
      val = (e <= 16) ? cosf(ang) : -sinf(ang);
    }
    z[pos * 36 + e] = val;
  }
  __syncthreads();
  {
    const int j = lane;
    float w1r[33];
#pragma unroll
    for (int e = 0; e < 33; ++e) w1r[e] = p.hy_w1[e * 64 + j];
    const float fq = p.hy_freq[j], b1 = p.hy_b1[j];
#pragma unroll 1
    for (int q = 0; q < 16; ++q) {
      const int pos = wid * 16 + q;
      const float4* zp = (const float4*)(z + pos * 36);
      float a = b1;
#pragma unroll
      for (int e4 = 0; e4 < 8; ++e4) {
        float4 zv = zp[e4];
        a += zv.x * w1r[4 * e4] + zv.y * w1r[4 * e4 + 1] + zv.z * w1r[4 * e4 + 2] + zv.w * w1r[4 * e4 + 3];
      }
      a += z[pos * 36 + 32] * w1r[32];
      h1[pos * 64 + j] = __sinf(fq * a);
    }
  }
  __syncthreads();
  {
    const int j = lane;
    float w2r[64];
#pragma unroll
    for (int e = 0; e < 64; ++e) w2r[e] = p.hy_w2[e * 64 + j];
    const float fq = p.hy_freq[j], b2 = p.hy_b2[j];
#pragma unroll 1
    for (int q = 0; q < 16; ++q) {
      const int pos = wid * 16 + q;
      const float4* hp = (const float4*)(h1 + pos * 64);
      float a = b2;
#pragma unroll
      for (int e4 = 0; e4 < 16; ++e4) {
        float4 hv = hp[e4];
        a += hv.x * w2r[4 * e4] + hv.y * w2r[4 * e4 + 1] + hv.z * w2r[4 * e4 + 2] + hv.w * w2r[4 * e4 + 3];
      }
      h2[pos * 68 + j] = __sinf(fq * a);
    }
  }
  __syncthreads();
  const int colw = cc * 512 + wid * 64;
  bf16x8_t Ahi[2][4], Alo[2][4];
#pragma unroll
  for (int ct = 0; ct < 2; ++ct)
#pragma unroll
    for (int ks = 0; ks < 4; ++ks) {
      float v[8];
#pragma unroll
      for (int j = 0; j < 8; ++j) v[j] = p.hy_w3[(size_t)(16 * ks + 8 * h + j) * 8192 + colw + ct * 32 + r];
      split8(v, Ahi[ct][ks], Alo[ct][ks]);
    }
  const int o = cc >> 3, dir = (cc >> 2) & 1;
  u16* Rg = (u16*)(p.ws + OFF_FILT) + (size_t)o * 2048 * 4096;
  const float min_decay = -3.0701134573253945f, max_decay = -15.350567286626972f;
#pragma unroll 1
  for (int pp = 0; pp < 2; ++pp) {
    f32x16_t acc[2][2];
#pragma unroll
    for (int ct = 0; ct < 2; ++ct)
#pragma unroll
      for (int q = 0; q < 2; ++q)
#pragma unroll
        for (int i = 0; i < 16; ++i) acc[ct][q][i] = 0.f;
#pragma unroll
    for (int q = 0; q < 2; ++q)
#pragma unroll
      for (int ks = 0; ks < 4; ++ks) {
        const float* hp = h2 + ((pp * 2 + q) * 32 + r) * 68 + 16 * ks + 8 * h;
        float4 x0 = *(const float4*)hp, x1 = *(const float4*)(hp + 4);
        float v[8] = {x0.x, x0.y, x0.z, x0.w, x1.x, x1.y, x1.z, x1.w};
        bf16x8_t Bhi, Blo;
        split8(v, Bhi, Blo);
#pragma unroll
        for (int ct = 0; ct < 2; ++ct) {
          acc[ct][q] = __builtin_amdgcn_mfma_f32_32x32x16_bf16(Ahi[ct][ks], Bhi, acc[ct][q], 0, 0, 0);
          acc[ct][q] = __builtin_amdgcn_mfma_f32_32x32x16_bf16(Ahi[ct][ks], Blo, acc[ct][q], 0, 0, 0);
          acc[ct][q] = __builtin_amdgcn_mfma_f32_32x32x16_bf16(Alo[ct][ks], Bhi, acc[ct][q], 0, 0, 0);
        }
      }
    int hh = h;
    asm volatile("" : "+v"(hh));
#pragma unroll
    for (int ct = 0; ct < 2; ++ct)
#pragma unroll
      for (int i = 0; i < 16; ++i) {
        const int col = colw + ct * 32 + (i & 3) + 8 * (i >> 2) + 4 * hh;
        const int ch = col & 2047;
        const float b3 = p.hy_b3[col];
        const float ad = fabsf(min_decay + (float)ch * ((max_decay - min_decay) / 2047.f));
        u16* R = Rg + (size_t)ch * 4096;
#pragma unroll
        for (int q = 0; q < 2; ++q) {
          const int t = pg * 128 + (pp * 2 + q) * 32 + r;
          const float tn = (float)t / 2047.f;
          float v = (acc[ct][q][i] + b3) * (__expf(-tn * ad) + 0.05f);
          if (dir == 0) {
            if (t == 0) v += p.hy_bias_d[o * 2048 + ch];
            R[2048 - t] = f2bf(v);
          } else {
            if (t > 0) R[2048 + t] = f2bf(v);
            else R[0] = 0;
          }
        }
      }
  }
  __syncthreads();
}

constexpr int N_CV_AI = 16 * 40, N_CV_AO = 16 * 16, N_CV_HI = 16 * 64, N_CV_HO = 16 * 16;
constexpr int N_CV = N_CV_AI + N_CV_AO + N_CV_HI + N_CV_HO;
#define CV_DECODE(I, W_, Wt_, N_, tk_, tn_, perm_) do { int _i = (I); \
    const bool _a = _i < N_CV_AI, _b2 = _i < N_CV_AI + N_CV_AO, _c = _i < N_CV_AI + N_CV_AO + N_CV_HI; \
    W_ = _a ? p.attn_w_in : (_b2 ? p.attn_w_out : (_c ? p.hy_w_in : p.hy_w_out)); \
    Wt_ = (u16*)(p.ws + (_a ? OFF_WT_AI : (_b2 ? OFF_WT_AO : (_c ? OFF_WT_HI : OFF_WT_HO)))); \
    N_ = _a ? 5120 : (_b2 ? 2048 : (_c ? 8192 : 2048)); \
    const int _nt = _a ? 40 : (_b2 ? 16 : (_c ? 64 : 16)); \
    _i -= _a ? 0 : (_b2 ? N_CV_AI : (_c ? N_CV_AI + N_CV_AO : N_CV_AI + N_CV_AO + N_CV_HI)); \
    tk_ = _i / _nt; tn_ = _i - tk_ * _nt; perm_ = _a && (tn_ * 128 < 2560); } while (0)
__device__ __forceinline__ void p0_convert_all(const Params& p, float* sm) {
  const int tid = threadIdx.x;
  float4 r0, r1, r2, r3, r4, r5, r6, r7;
#define CV_LOAD(W_, N_, tk_, tn_) do { const float* _b = (W_) + (size_t)((tk_) * 128 + (tid >> 5)) * (N_) + (tn_) * 128 + (tid & 31) * 4; const size_t _s = (size_t)16 * (N_); \
    r0 = NTL4(_b); r1 = NTL4(_b + _s); r2 = NTL4(_b + 2 * _s); r3 = NTL4(_b + 3 * _s); \
    r4 = NTL4(_b + 4 * _s); r5 = NTL4(_b + 5 * _s); r6 = NTL4(_b + 6 * _s); r7 = NTL4(_b + 7 * _s); } while (0)
#define CV_PUT(R, I) do { float* _d = sm + ((tid >> 5) + 16 * (I)) * 129 + (tid & 31) * 4; _d[0] = (R).x; _d[1] = (R).y; _d[2] = (R).z; _d[3] = (R).w; } while (0)
  int it = blockIdx.x;
  const float* cW; u16* cWt; int cN, ctk, ctn; bool cperm;
  CV_DECODE(it < N_CV ? it : 0, cW, cWt, cN, ctk, ctn, cperm);
  if (it < N_CV) CV_LOAD(cW, cN, ctk, ctn);
  while (it < N_CV) {
    __syncthreads();
    CV_PUT(r0, 0); CV_PUT(r1, 1); CV_PUT(r2, 2); CV_PUT(r3, 3); CV_PUT(r4, 4); CV_PUT(r5, 5); CV_PUT(r6, 6); CV_PUT(r7, 7);
    __syncthreads();
    const int nit = it + gridDim.x;
    const float* nW; u16* nWt; int nN, ntk, ntn; bool nperm;
    CV_DECODE(nit < N_CV ? nit : 0, nW, nWt, nN, ntk, ntn, nperm);
    if (nit < N_CV) CV_LOAD(nW, nN, ntk, ntn);
    const int row = (tid & 15) | (((tid >> 6) & 7) << 4);
    int src = row;
    if (cperm) { const int g = row >> 5, w = row & 31, i16 = 4 * (w >> 3) + (w & 3), nn = (w >> 2) & 1; src = (g >> 1) * 64 + nn * 32 + (g & 1) * 16 + i16; }
#pragma unroll
    for (int i = 0; i < 4; ++i) {
      const int kch = ((tid >> 4) & 3) | (i << 2);
      unsigned w[4];
#pragma unroll
      for (int j = 0; j < 4; ++j) {
        float a = sm[(kch * 8 + 2 * j) * 129 + src];
        float b = sm[(kch * 8 + 2 * j + 1) * 129 + src];
        w[j] = pk2(a, b);
      }
      *(uint4*)(cWt + (size_t)(ctn * 128 + row) * 2048 + ctk * 128 + kch * 8) = make_uint4(w[0], w[1], w[2], w[3]);
    }
    cW = nW; cWt = nWt; cN = nN; ctk = ntk; ctn = ntn; cperm = nperm;
    it = nit;
  }
#undef CV_LOAD
#undef CV_PUT
}

__device__ __forceinline__ void phase0(const Params& p, float* sm) {
  for (int it = blockIdx.x; it < 256; it += gridDim.x) p0_adaln(p, it, sm);
  if (blockIdx.x == gridDim.x - 1) p0_rope(p);
  __syncthreads();
  for (int it = blockIdx.x; it < 256; it += gridDim.x) p0_filter(p, it, sm);
  __syncthreads();
  p0_convert_all(p, sm);
}

__device__ __forceinline__ void norm_row(const float* __restrict__ src, const float* __restrict__ g, const float* shift,
                         const float* scale, u16* dst_bf, float* dst_f, int lane) {
  float4 v[8];
  float ss = 0.f;
#pragma unroll
  for (int j = 0; j < 8; ++j) {
    v[j] = ntl4(src + (j * 64 + lane) * 4);
    ss += v[j].x * v[j].x + v[j].y * v[j].y + v[j].z * v[j].z + v[j].w * v[j].w;
  }
  ss = wave_sum(ss);
  float r = rsqrtf(ss * (1.f / 2048.f) + 1e-6f);
#pragma unroll
  for (int j = 0; j < 8; ++j) {
    int c = (j * 64 + lane) * 4;
    float4 gg = *(const float4*)(g + c);
    float4 o = make_float4(v[j].x * r * gg.x, v[j].y * r * gg.y, v[j].z * r * gg.z, v[j].w * r * gg.w);
    if (dst_bf) {
      float4 sh = *(const float4*)(shift + c);
      float4 sc = *(const float4*)(scale + c);
      o.x = o.x * (1.f + sc.x) + sh.x; o.y = o.y * (1.f + sc.y) + sh.y;
      o.z = o.z * (1.f + sc.z) + sh.z; o.w = o.w * (1.f + sc.w) + sh.w;
      uint2 pk;
      pk.x = pk2(o.x, o.y);
      pk.y = pk2(o.z, o.w);
      *(uint2*)(dst_bf + c) = pk;
    } else {
      *(float4*)(dst_f + c) = o;
    }
  }
}

__device__ __forceinline__ void phase_norm(const Params& p, int mode) {
  const int wid = threadIdx.x >> 6, lane = threadIdx.x & 63;
  const float* mod = (const float*)(p.ws + OFF_MOD);
  int nrows = (mode == 0) ? (MT + MC) : MT;
  for (int row = blockIdx.x * 8 + wid; row < nrows; row += gridDim.x * 8) {
    if (mode == 0) {
      if (row < MT) {
        int b = row >> 11;
        const float* m = mod + (0 * 5 + b) * 6144;
        norm_row(p.x + (size_t)row * 2048, p.norm_g, m, m + 2048, (u16*)(p.ws + OFF_ACT) + (size_t)row * 2048, nullptr, lane);
      } else {
        int rc = row - MT;
        const float* m = mod + (0 * 5 + 4) * 6144;
        norm_row(p.ctx + (size_t)rc * 2048, p.norm_g, m, m + 2048, (u16*)(p.ws + OFF_HC) + (size_t)rc * 2048, nullptr, lane);
      }
    } else if (mode == 1) {
      int b = row >> 11;
      const float* m = mod + (1 * 5 + b) * 6144;
      norm_row(p.out + (size_t)row * 2048, p.norm_g + 2048, m, m + 2048, (u16*)(p.ws + OFF_ACT) + (size_t)row * 2048, nullptr, lane);
    } else {
      norm_row(p.out + (size_t)row * 2048, p.final_g, nullptr, nullptr, nullptr, p.out + (size_t)row * 2048, lane);
    }
  }
}

namespace pg8 {
#define PG8_LAS __attribute__((address_space(3)))
typedef unsigned short bf16_t;
typedef short bf16x8 __attribute__((ext_vector_type(8)));
typedef float f32x4 __attribute__((ext_vector_type(4)));
typedef unsigned u32x4 __attribute__((ext_vector_type(4)));
constexpr int BM = 256, BK = 64, HALF = 128, HTB = HALF * BK * 2  , STAGE_BYTES = 8 * HTB, NXCD = 8, WGM = 4;

__host__ __device__ __forceinline__ int lds_byte(int r, int c) { const int st = (r >> 4) * 2 + (c >> 5), rr = r & 15, cc = c & 31, ob = rr * 64 + cc * 2; return st * 1024 + (ob ^ (((ob >> 9) & 1) << 5)); }
__host__ __device__ __forceinline__ void stage_rc(int b, int& R, int& C) { const int st = b / 1024, sb = b % 1024, swz = sb ^ (((sb >> 9) & 1) << 5); R = (st >> 1) * 16 + swz / 64; C = (st & 1) * 32 + (swz % 64) / 2; }
__host__ __device__ __forceinline__ int perm32(int rho) { const int n = rho >> 4, i = rho & 15; return 8 * (i >> 2) + 4 * n + (i & 3); }

struct Unit { int pm, pn; };
struct Gemm { const bf16_t* A; const bf16_t* Bt; int M, N, K; int agroup; };

struct StaticOrder {
    int nM, nN, nwg, G, c;
    __host__ __device__ void init(int M, int N, int G_, int c_) { nM = M / BM; nN = N / BM; nwg = nM * nN; G = G_; c = c_; }
    __host__ __device__ bool next(int i, Unit& u) const {
        const long L = (long)i * G + c; if (L >= nwg) return false;
        int wgid = (int)L; { const int q = nwg / NXCD, r = nwg % NXCD, xcd = wgid % NXCD, off = wgid / NXCD; wgid = (xcd < r ? xcd * (q + 1) : r * (q + 1) + (xcd - r) * q) + off; }
        const int nig = WGM * nN, gid = wgid / nig, fm = gid * WGM, gsz = (nM - fm) < WGM ? (nM - fm) : WGM;
        u.pm = fm + ((wgid % nig) % gsz); u.pn = (wgid % nig) / gsz; return true;
    }
    __device__ __forceinline__ void a_ready(const Unit&) const {}
    __device__ __forceinline__ void done(const Unit&) const {}
};
__device__ __forceinline__ unsigned cvt_pk_bf16(float lo, float hi) { unsigned r; asm volatile("v_cvt_pk_bf16_f32 %0, %1, %2" : "=v"(r) : "v"(lo), "v"(hi)); return r; }
template <class Epi, class Sched, bool AGROUP = false>
__device__ __forceinline__ void gemm_phase(PG8_LAS unsigned char* lds, const Gemm g, const Sched& S, const Epi& E) {
    const int tid = threadIdx.x, wid = __builtin_amdgcn_readfirstlane(tid >> 6), lane = tid & 63, wr = wid >> 2, wc = wid & 3, fr = lane & 15, fq = lane >> 4;
    const int K = g.K, nt = K / BK;
    unsigned voffA[2], voffB[2];
#pragma unroll
    for (int i = 0; i < 2; ++i) { int R, C; stage_rc(tid * 16 + i * 8192, R, C); const int Rb = Epi::PERM ? ((R & ~31) + perm32(R & 31)) : R;
        voffA[i] = AGROUP ? (unsigned)((C >> 3) * g.M + R) * 16u : (unsigned)(R * K + C) * 2u; voffB[i] = (unsigned)(Rb * K + C) * 2u; }
    const size_t kstep = (size_t)(BK * 2);
    const size_t hstep = (size_t)HALF * K * 2;
    const size_t tstep = 2 * hstep;
    const size_t kstepA = AGROUP ? (size_t)(BK / 8) * g.M * 16 : kstep, hstepA = AGROUP ? (size_t)HALF * 16 : hstep, tstepA = 2 * hstepA;
    const unsigned ldsw = (unsigned)wid * 1024u;
    const int aoff = lds_byte(wr * 64 + fr, fq * 8), boff = lds_byte(wc * 32 + fr, fq * 8);
#define PG8_SA(b, h) (((b) * 2 + (h)) * HTB)
#define PG8_SB(b, h) ((4 + (b) * 2 + (h)) * HTB)
#define PG8_STAGE(bufoff, gbase, voff) do { _Pragma("unroll") for (int _i = 0; _i < 2; ++_i) \
        __builtin_amdgcn_global_load_lds((const unsigned*)((const char*)(gbase) + (voff)[_i]), (PG8_LAS unsigned*)(lds + (bufoff) + ldsw + _i * 8192), 16, 0, 0); } while (0)
#define PG8_LDA(dst, b, h) do { _Pragma("unroll") for (int m = 0; m < 4; ++m) _Pragma("unroll") for (int k = 0; k < 2; ++k) dst[m][k] = *(const PG8_LAS bf16x8*)(lds + PG8_SA(b, h) + aoff + m * 2048 + k * 1024); } while (0)
#define PG8_LDB(dst, b, h) do { _Pragma("unroll") for (int n = 0; n < 2; ++n) _Pragma("unroll") for (int k = 0; k < 2; ++k) dst[n][k] = *(const PG8_LAS bf16x8*)(lds + PG8_SB(b, h) + boff + n * 2048 + k * 1024); } while (0)
#define PG8_MMA(ai, bj, At, Bt) do { __builtin_amdgcn_s_setprio(1); _Pragma("unroll") for (int m = 0; m < 4; ++m) _Pragma("unroll") for (int n = 0; n < 2; ++n) _Pragma("unroll") for (int k = 0; k < 2; ++k) \
        acc[ai][bj][m][n] = __builtin_amdgcn_mfma_f32_16x16x32_bf16(Bt[n][k], At[m][k], acc[ai][bj][m][n], 0, 0, 0); __builtin_amdgcn_s_setprio(0); } while (0)
#define PG8_WAIT_V(n) asm volatile("s_waitcnt vmcnt(" #n ")" ::: "memory")
#define PG8_WAIT_L(n) asm volatile("s_waitcnt lgkmcnt(" #n ")" ::: "memory")
#define PG8_BAR __builtin_amdgcn_s_barrier()
#define PG8_SCHED __builtin_amdgcn_sched_barrier(0)
    Unit cur, nxt; int ui = 0;
    if (!S.next(0, cur)) return;
    f32x4 acc[2][2][4][2];
#pragma unroll
    for (int a = 0; a < 2; ++a)
#pragma unroll
        for (int b = 0; b < 2; ++b)
#pragma unroll
            for (int m = 0; m < 4; ++m)
#pragma unroll
                for (int n = 0; n < 2; ++n) acc[a][b][m][n] = (f32x4){0.f, 0.f, 0.f, 0.f};
    bf16x8 At[4][2], B0[2][2], B1[2][2];
    const char* cA = (const char*)g.A + (size_t)cur.pm * tstepA; const char* cB = (const char*)g.Bt + (size_t)cur.pn * tstep;
    S.a_ready(cur);
    PG8_STAGE(PG8_SB(0, 0), cB, voffB); PG8_STAGE(PG8_SA(0, 0), cA, voffA); PG8_STAGE(PG8_SB(0, 1), cB + hstep, voffB); PG8_STAGE(PG8_SA(0, 1), cA + hstepA, voffA);
    if (wr == 1) PG8_BAR;
    PG8_WAIT_V(4); PG8_BAR;
    PG8_STAGE(PG8_SB(1, 0), cB + kstep, voffB); PG8_STAGE(PG8_SA(1, 0), cA + kstepA, voffA); PG8_STAGE(PG8_SB(1, 1), cB + hstep + kstep, voffB);
    PG8_WAIT_V(6); PG8_BAR;
    for (;;) {
        const bool has_next = S.next(ui + 1, nxt);
        const char* nA = has_next ? (const char*)g.A + (size_t)nxt.pm * tstepA : cA; const char* nB = has_next ? (const char*)g.Bt + (size_t)nxt.pn * tstep : cB;
        for (int t = 0; t < nt; t += 2) {
            const bool last = (t == nt - 2);
            const char* a1 = cA + (size_t)(t + 1) * kstepA;
            const char* a2 = last ? nA : cA + (size_t)(t + 2) * kstepA; const char* b2 = last ? nB : cB + (size_t)(t + 2) * kstep;
            const char* a3 = a2 + kstepA; const char* b3 = b2 + kstep;
            if (last && has_next) S.a_ready(nxt);
            PG8_LDB(B0, 0, 0); PG8_SCHED; PG8_LDA(At, 0, 0); PG8_STAGE(PG8_SA(1, 1), a1 + hstepA, voffA);
            PG8_WAIT_L(8); PG8_BAR; PG8_WAIT_L(0); PG8_MMA(0, 0, At, B0); PG8_BAR; PG8_SCHED;
            PG8_LDB(B1, 0, 1); PG8_STAGE(PG8_SB(0, 0), b2, voffB);
            PG8_BAR; PG8_WAIT_L(0); PG8_MMA(0, 1, At, B1); PG8_BAR;
            PG8_LDA(At, 0, 1); PG8_STAGE(PG8_SA(0, 0), a2, voffA);
            PG8_BAR; PG8_WAIT_L(0); PG8_MMA(1, 0, At, B0); PG8_BAR; PG8_SCHED;
            PG8_STAGE(PG8_SB(0, 1), b2 + hstep, voffB);
            PG8_WAIT_V(6); PG8_BAR; PG8_MMA(1, 1, At, B1); PG8_BAR;
            PG8_LDB(B0, 1, 0); PG8_SCHED; PG8_LDA(At, 1, 0); PG8_STAGE(PG8_SA(0, 1), a2 + hstepA, voffA);
            PG8_WAIT_L(8); PG8_BAR; PG8_WAIT_L(0); PG8_MMA(0, 0, At, B0); PG8_BAR; PG8_SCHED;
            PG8_LDB(B1, 1, 1); PG8_STAGE(PG8_SB(1, 0), b3, voffB);
            PG8_BAR; PG8_WAIT_L(0); PG8_MMA(0, 1, At, B1); PG8_BAR;
            PG8_LDA(At, 1, 1); PG8_STAGE(PG8_SA(1, 0), a3, voffA);
            PG8_BAR; PG8_WAIT_L(0); PG8_MMA(1, 0, At, B0); PG8_BAR; PG8_SCHED;
            PG8_STAGE(PG8_SB(1, 1), b3 + hstep, voffB);
            PG8_WAIT_V(6); PG8_BAR; PG8_MMA(1, 1, At, B1); PG8_BAR;
        }
        if constexpr (!Epi::AFTER_DRAIN) { E(acc, cur, wr, wc, fr, fq); S.done(cur); }
        if (!has_next) break;
#pragma unroll
        for (int a = 0; a < 2; ++a)
#pragma unroll
            for (int b = 0; b < 2; ++b)
#pragma unroll
                for (int m = 0; m < 4; ++m)
#pragma unroll
                    for (int n = 0; n < 2; ++n) acc[a][b][m][n] = (f32x4){0.f, 0.f, 0.f, 0.f};
        cur = nxt; cA = nA; cB = nB; ++ui;
    }
    PG8_WAIT_V(0);
    if (wr == 0) PG8_BAR;
    PG8_BAR;
    if constexpr (Epi::AFTER_DRAIN) { E.fused(acc, cur, wr, wc, fr, fq, lds, wid, lane); S.done(cur); }
#undef PG8_SA
#undef PG8_SB
#undef PG8_STAGE
#undef PG8_LDA
#undef PG8_LDB
#undef PG8_MMA
#undef PG8_WAIT_V
#undef PG8_WAIT_L
#undef PG8_BAR
#undef PG8_SCHED
}
}

__device__ __forceinline__ uint2 pack4(pg8::f32x4 v) {
  uint2 r;
  r.x = pk2(v[0], v[1]);
  r.y = pk2(v[2], v[3]);
  return r;
}
struct EpiAttnIn {
  static constexpr bool PERM = true, AFTER_DRAIN = false;
  u16* O; const float* rope;
  __device__ __forceinline__ void operator()(const pg8::f32x4 (&acc)[2][2][4][2], const pg8::Unit& u, int wr, int wc, int fr, int fq) const {
    const int row0 = u.pm * 256 + wr * 64 + fr, col0 = u.pn * 256 + wc * 32 + 8 * fq;
    const bool dorope = (u.pn < 10);
    const int axis = wc >> 1, i0 = (wc & 1) * 16 + 4 * fq;
#pragma unroll
    for (int ai = 0; ai < 2; ++ai)
#pragma unroll
      for (int m = 0; m < 4; ++m) {
        const int row = row0 + ai * 128 + m * 16;
        u16* rowp = O + (size_t)row * 5120 + col0;
        if (dorope) {
          const int s = row & 2047;
          const int pos = axis ? (s & 63) : (s >> 6);
          const float4* rp = (const float4*)(rope + (pos * 32 + i0) * 2);
          float4 c01 = rp[0], c23 = rp[1];
#pragma unroll
          for (int bj = 0; bj < 2; ++bj) {
            pg8::f32x4 a = acc[ai][bj][m][0], b = acc[ai][bj][m][1], o0, o1;
            o0[0] = a[0] * c01.x - b[0] * c01.y; o1[0] = b[0] * c01.x + a[0] * c01.y;
            o0[1] = a[1] * c01.z - b[1] * c01.w; o1[1] = b[1] * c01.z + a[1] * c01.w;
            o0[2] = a[2] * c23.x - b[2] * c23.y; o1[2] = b[2] * c23.x + a[2] * c23.y;
            o0[3] = a[3] * c23.z - b[3] * c23.w; o1[3] = b[3] * c23.z + a[3] * c23.w;
            const uint2 lo = pack4(o0), hi = pack4(o1);
            *(uint4*)(rowp + bj * 128) = make_uint4(lo.x, lo.y, hi.x, hi.y);
          }
        } else {
#pragma unroll
          for (int bj = 0; bj < 2; ++bj) {
            const uint2 lo = pack4(acc[ai][bj][m][0]), hi = pack4(acc[ai][bj][m][1]);
            *(uint4*)(rowp + bj * 128) = make_uint4(lo.x, lo.y, hi.x, hi.y);
          }
        }
      }
  }
};
struct EpiRaw {
  static constexpr bool PERM = true, AFTER_DRAIN = false;
  u16* O; int ldc;
  __device__ __forceinline__ void operator()(const pg8::f32x4 (&acc)[2][2][4][2], const pg8::Unit& u, int wr, int wc, int fr, int fq) const {
    const int row0 = u.pm * 256 + wr * 64 + fr, col0 = u.pn * 256 + wc * 32 + 8 * fq;
#pragma unroll
    for (int ai = 0; ai < 2; ++ai)
#pragma unroll
      for (int m = 0; m < 4; ++m) {
        u16* rowp = O + (size_t)(row0 + ai * 128 + m * 16) * ldc + col0;
#pragma unroll
        for (int bj = 0; bj < 2; ++bj) {
          const uint2 lo = pack4(acc[ai][bj][m][0]), hi = pack4(acc[ai][bj][m][1]);
          *(uint4*)(rowp + bj * 128) = make_uint4(lo.x, lo.y, hi.x, hi.y);
        }
      }
  }
};
struct EpiRes {
  static constexpr bool PERM = false, AFTER_DRAIN = false;
  float* out; const float* base; const float* gate;
  __device__ __forceinline__ void operator()(const pg8::f32x4 (&acc)[2][2][4][2], const pg8::Unit& u, int wr, int wc, int fr, int fq) const {
    const int row0 = u.pm * 256 + wr * 64 + fr, col0 = u.pn * 256 + wc * 32 + 4 * fq;
    const int b = (u.pm * 256) >> 11;
    pg8::f32x4 gv[2][2];
#pragma unroll
    for (int bj = 0; bj < 2; ++bj)
#pragma unroll
      for (int n = 0; n < 2; ++n) gv[bj][n] = *(const pg8::f32x4*)(gate + b * 6144 + col0 + bj * 128 + n * 16);
#pragma unroll
    for (int ai = 0; ai < 2; ++ai)
#pragma unroll
      for (int m = 0; m < 4; ++m) {
        const size_t off = (size_t)(row0 + ai * 128 + m * 16) * 2048 + col0;
#pragma unroll
        for (int bj = 0; bj < 2; ++bj)
#pragma unroll
          for (int n = 0; n < 2; ++n) {
            pg8::f32x4 bv = *(const pg8::f32x4*)(base + off + bj * 128 + n * 16);
            *(pg8::f32x4*)(out + off + bj * 128 + n * 16) = bv + gv[bj][n] * acc[ai][bj][m][n];
          }
      }
  }
};

struct EpiResNorm {
  static constexpr bool PERM = false, AFTER_DRAIN = true;
  float* out; const float* base; const float* gate;
  float* rowss; unsigned* pcnt;
  const float* g; const float* shsc;
  u16* hx;
  static __device__ __forceinline__ int loff(int row, int chunk) { return row * 1024 + ((chunk ^ (row & 63)) << 4); }
  __device__ __forceinline__ void fused(pg8::f32x4 (&acc)[2][2][4][2], const pg8::Unit& u, int wr, int wc, int fr, int fq,
                                        PG8_LAS unsigned char* lds, int wid, int lane) const {
    const int R0 = u.pm * 256, C0 = u.pn * 256;
    const int b = R0 >> 11;
    const int frow = wr * 64 + fr, fchunk = wc * 8 + fq;
    {
      pg8::f32x4 gv[2][2];
#pragma unroll
      for (int bj = 0; bj < 2; ++bj)
#pragma unroll
        for (int n = 0; n < 2; ++n) gv[bj][n] = *(const pg8::f32x4*)(gate + b * 6144 + C0 + wc * 32 + 4 * fq + bj * 128 + n * 16);
#pragma unroll
      for (int ai = 0; ai < 2; ++ai) {
        {
          pg8::f32x4 t[16];
#pragma unroll
          for (int i = 0; i < 16; ++i) t[i] = __builtin_nontemporal_load((const pg8::f32x4*)(base + (size_t)(R0 + ai * 128 + wid * 16 + i) * 2048 + C0 + 4 * lane));
#pragma unroll
          for (int i = 0; i < 16; ++i) *(PG8_LAS pg8::f32x4*)(lds + loff(wid * 16 + i, lane)) = t[i];
        }
        __syncthreads();
#pragma unroll
        for (int m = 0; m < 4; ++m) {
          float ss = 0.f;
#pragma unroll
          for (int bj = 0; bj < 2; ++bj)
#pragma unroll
            for (int n = 0; n < 2; ++n) {
              const pg8::f32x4 bv = *(const PG8_LAS pg8::f32x4*)(lds + loff(frow + 16 * m, fchunk + 32 * bj + 4 * n));
              const pg8::f32x4 v = bv + gv[bj][n] * acc[ai][bj][m][n];
              acc[ai][bj][m][n] = v;
              ss += v[0] * v[0] + v[1] * v[1] + v[2] * v[2] + v[3] * v[3];
            }
          ss += __shfl_xor(ss, 16, 64);
          ss += __shfl_xor(ss, 32, 64);
          if (fq == 0) unsafeAtomicAdd(rowss + R0 + ai * 128 + frow + 16 * m, ss);
        }
        __syncthreads();
      }
    }
    asm volatile("s_waitcnt vmcnt(0)" ::: "memory");
    __syncthreads();
    if (threadIdx.x == 0) {
      unsigned* c = pcnt + u.pm * 64;
      __hip_atomic_fetch_add(c, 1u, __ATOMIC_RELAXED, __HIP_MEMORY_SCOPE_AGENT);
      unsigned spins = 0;
      while (__hip_atomic_load(c, __ATOMIC_RELAXED, __HIP_MEMORY_SCOPE_AGENT) < 8u && ++spins < (1u << 22)) __builtin_amdgcn_s_sleep(1);
    }
    __syncthreads();
    const pg8::f32x4 gg = *(const pg8::f32x4*)(g + C0 + 4 * lane);
    pg8::f32x4 sh = gg, sc = gg;
    if (hx) {
      sh = *(const pg8::f32x4*)(shsc + b * 6144 + C0 + 4 * lane);
      sc = *(const pg8::f32x4*)(shsc + b * 6144 + 2048 + C0 + 4 * lane) + 1.f;
    }
#pragma unroll
    for (int ai = 0; ai < 2; ++ai) {
#pragma unroll
      for (int m = 0; m < 4; ++m)
#pragma unroll
        for (int bj = 0; bj < 2; ++bj)
#pragma unroll
          for (int n = 0; n < 2; ++n)
            *(PG8_LAS pg8::f32x4*)(lds + loff(frow + 16 * m, fchunk + 32 * bj + 4 * n)) = acc[ai][bj][m][n];
      __syncthreads();
#pragma unroll 4
      for (int i = 0; i < 16; ++i) {
        const int lrow = wid * 16 + i, row = R0 + ai * 128 + lrow;
        const pg8::f32x4 v = *(const PG8_LAS pg8::f32x4*)(lds + loff(lrow, lane));
        const float ss = __hip_atomic_load(rowss + row, __ATOMIC_RELAXED, __HIP_MEMORY_SCOPE_AGENT);
        const float r = rsqrtf(ss * (1.f / 2048.f) + 1e-6f);
        const size_t off = (size_t)row * 2048 + C0 + 4 * lane;
        pg8::f32x4 o = v * r * gg;
        if (hx) {
          __builtin_nontemporal_store(v, (pg8::f32x4*)(out + off));
          o = o * sc + sh;
          *(uint2*)(hx + off) = pack4(o);
        } else {
          __builtin_nontemporal_store(o, (pg8::f32x4*)(out + off));
        }
      }
      __syncthreads();
    }
  }
};
template <class Epi, bool AGROUP = false>
__device__ __forceinline__ void run_gemm(float* sm, const u16* A, const u16* Bt, int M, int N, const Epi& E, int c) {
  pg8::Gemm g{A, Bt, M, N, 2048, AGROUP ? 1 : 0};
  pg8::StaticOrder S; S.init(M, N, (int)gridDim.x, c);
  pg8::gemm_phase<Epi, pg8::StaticOrder, AGROUP>((PG8_LAS unsigned char*)sm, g, S, E);
  __syncthreads();
}

template <int MODE>
__device__ __forceinline__ void epi_pair(const Params& p, int m, int n, float a0, float a1) {
  if (MODE == 1) {
    u16* px = (u16*)(p.ws + OFF_BIG);
    float o0 = a0, o1 = a1;
    if (n < 2560) {
      int g = (n >> 5) & 3, fr = n & 15;
      int axis = g >> 1, i = (g & 1) * 16 + fr;
      int s = m & 2047;
      int pos = axis ? (s & 63) : (s >> 6);
      float2 cs = ((const float2*)(p.ws + OFF_ROPE))[pos * 32 + i];
      o0 = a0 * cs.x - a1 * cs.y;
      o1 = a1 * cs.x + a0 * cs.y;
    }
    px[(size_t)m * 5120 + n] = f2bf(o0);
    px[(size_t)m * 5120 + n + 16] = f2bf(o1);
  } else if (MODE == 5) {
    u16* kvc = (u16*)(p.ws + OFF_KVC);
    kvc[(size_t)m * 1024 + n] = f2bf(a0);
    kvc[(size_t)m * 1024 + n + 16] = f2bf(a1);
  } else if (MODE == 2) {
    const float* mod = (const float*)(p.ws + OFF_MOD);
    int b = m >> 11;
    const float* gate = mod + (0 * 5 + b) * 6144 + 4096;
    p.out[(size_t)m * 2048 + n] = p.x[(size_t)m * 2048 + n] + gate[n] * a0;
    p.out[(size_t)m * 2048 + n + 16] = p.x[(size_t)m * 2048 + n + 16] + gate[n + 16] * a1;
  } else if (MODE == 3) {
    u16* pp = (u16*)(p.ws + OFF_BIG);
    pp[(size_t)m * 8192 + n] = f2bf(a0);
    pp[(size_t)m * 8192 + n + 16] = f2bf(a1);
  } else if (MODE == 4) {
    const float* mod = (const float*)(p.ws + OFF_MOD);
    int b = m >> 11;
    const float* gate = mod + (1 * 5 + b) * 6144 + 4096;
    p.out[(size_t)m * 2048 + n] += gate[n] * a0;
    p.out[(size_t)m * 2048 + n + 16] += gate[n + 16] * a1;
  }
}

template <int MODE>
__device__ __forceinline__ void naive_gemm(const Params& p, const u16* __restrict__ A, const u16* __restrict__ Wt, int M, int N) {
  const int tid = threadIdx.x;
  const int ml = tid >> 5, pl = tid & 31;
  const int ntn = N / 64, ntm = M / 16;
  for (int tile = blockIdx.x; tile < ntn * ntm; tile += gridDim.x) {
    int tm = tile / ntn, tn = tile % ntn;
    int m = tm * 16 + ml;
    int n = tn * 64 + (pl >> 4) * 32 + (pl & 15);
    const uint4* a = (const uint4*)(A + (size_t)m * 2048);
    const uint4* w0 = (const uint4*)(Wt + (size_t)n * 2048);
    const uint4* w1 = (const uint4*)(Wt + (size_t)(n + 16) * 2048);
    float acc0 = 0.f, acc1 = 0.f;
#pragma unroll 2
    for (int k = 0; k < 256; ++k) {
      uint4 av = a[k], b0 = w0[k], b1 = w1[k];
      acc0 += bflo(av.x) * bflo(b0.x) + bfhi(av.x) * bfhi(b0.x) + bflo(av.y) * bflo(b0.y) + bfhi(av.y) * bfhi(b0.y)
            + bflo(av.z) * bflo(b0.z) + bfhi(av.z) * bfhi(b0.z) + bflo(av.w) * bflo(b0.w) + bfhi(av.w) * bfhi(b0.w);
      acc1 += bflo(av.x) * bflo(b1.x) + bfhi(av.x) * bfhi(b1.x) + bflo(av.y) * bflo(b1.y) + bfhi(av.y) * bfhi(b1.y)
            + bflo(av.z) * bflo(b1.z) + bfhi(av.z) * bfhi(b1.z) + bflo(av.w) * bflo(b1.w) + bfhi(av.w) * bfhi(b1.w);
    }
    epi_pair<MODE>(p, m, n, acc0, acc1);
  }
}

__device__ __forceinline__ void phase_attn_naive(const Params& p, float* sm) {
  const int wid = threadIdx.x >> 6, lane = threadIdx.x & 63;
  float* qs = sm + wid * (128 + 640);
  float* pr = qs + 128;
  const u16* px = (const u16*)(p.ws + OFF_BIG);
  const u16* kvc = (const u16*)(p.ws + OFF_KVC);
  u16* og = (u16*)(p.ws + OFF_ACT);
  const float scale = 0.08838834764831845f;
  for (int item = blockIdx.x * 8 + wid; item < MT * 16; item += gridDim.x * 8) {
    int m = item >> 4, h = item & 15;
    int b = m >> 11, s = m & 2047, kvh = h >> 2, nblk = s >> 7;
    const u16* qrow = px + (size_t)m * 5120 + h * 128;
    qs[lane] = bf2f(qrow[lane]) * scale;
    qs[lane + 64] = bf2f(qrow[lane + 64]) * scale;
    asm volatile("s_waitcnt lgkmcnt(0)" ::: "memory");
    float mx = p.attn_sink[h];
#pragma unroll 1
    for (int j = 0; j < 10; ++j) {
      int kidx = j * 64 + lane;
      const u16* krow;
      bool valid;
      if (kidx < 384) {
        int kpos = (nblk - 1) * 128 + kidx;
        int rel = kpos - s;
        valid = (kpos >= 0) && (kpos < 2048) && (rel <= 128) && (rel >= -128);
        krow = px + (size_t)(b * 2048 + (valid ? kpos : 0)) * 5120 + 2048 + kvh * 128;
      } else {
        valid = true;
        krow = kvc + (size_t)(b * 256 + (kidx - 384)) * 1024 + kvh * 128;
      }
      float d = -1e30f;
      if (valid) {
        d = 0.f;
#pragma unroll 4
        for (int c = 0; c < 16; ++c) {
          uint4 kk = *(const uint4*)(krow + c * 8);
          const float* q8 = qs + c * 8;
          d += q8[0] * bflo(kk.x) + q8[1] * bfhi(kk.x) + q8[2] * bflo(kk.y) + q8[3] * bfhi(kk.y)
             + q8[4] * bflo(kk.z) + q8[5] * bfhi(kk.z) + q8[6] * bflo(kk.w) + q8[7] * bfhi(kk.w);
        }
      }
      pr[kidx] = d;
      mx = fmaxf(mx, d);
    }
    mx = wave_max(mx);
    float sum = 0.f;
#pragma unroll 1
    for (int j = 0; j < 10; ++j) {
      float d = pr[j * 64 + lane];
      float e = (d > -1e29f) ? __expf(d - mx) : 0.f;
      pr[j * 64 + lane] = e;
      sum += e;
    }
    sum = wave_sum(sum);
    sum += __expf(p.attn_sink[h] - mx);
    asm volatile("s_waitcnt lgkmcnt(0)" ::: "memory");
    float o0 = 0.f, o1 = 0.f;
    int k0 = s - 128 < 0 ? 0 : s - 128, k1 = s + 128 > 2047 ? 2047 : s + 128;
    for (int kpos = k0; kpos <= k1; ++kpos) {
      float pv = pr[kpos - (nblk - 1) * 128];
      unsigned vv = *(const unsigned*)(px + (size_t)(b * 2048 + kpos) * 5120 + 2560 + kvh * 128 + lane * 2);
      o0 += pv * bflo(vv); o1 += pv * bfhi(vv);
    }
    for (int c = 0; c < 256; ++c) {
      float pv = pr[384 + c];
      unsigned vv = *(const unsigned*)(kvc + (size_t)(b * 256 + c) * 1024 + 512 + kvh * 128 + lane * 2);
      o0 += pv * bflo(vv); o1 += pv * bfhi(vv);
    }
    float inv = 1.f / sum;
    unsigned gg = *(const unsigned*)(px + (size_t)m * 5120 + 3072 + h * 128 + lane * 2);
    float r0 = o0 * inv * siluf(bflo(gg)), r1 = o1 * inv * siluf(bfhi(gg));
    *(unsigned*)(og + (size_t)m * 2048 + h * 128 + lane * 2) = pk2(r0, r1);
    asm volatile("s_waitcnt lgkmcnt(0)" ::: "memory");
  }
}

__device__ __forceinline__ float sconv(const u16* pp, const float* cw, const float* cb, int b, int t, int c) {
  const u16* base = pp + (size_t)(b * 2048 + t) * 8192 + c;
  float v = cw[6144 + c] * bf2f(base[0]) + cb[c];
  if (t > 0) v += cw[c] * bf2f(base[-8192]);
  if (t < 2047) v += cw[2 * 6144 + c] * bf2f(base[8192]);
  return v;
}

__device__ __forceinline__ void phase_conv_naive(const Params& p, float* sm) {
  const int tid = threadIdx.x;
  float* u = sm;
  float* R = sm + 8192;
  const u16* pp = (const u16*)(p.ws + OFF_BIG);
  const u16* Rg = (const u16*)(p.ws + OFF_FILT);
  u16* yg = (u16*)(p.ws + OFF_ACT);
  for (int ch = blockIdx.x; ch < 2048; ch += gridDim.x) {
    for (int i = tid; i < 8192; i += NTHREADS) u[i] = sconv(pp, p.hy_conv_w, p.hy_conv_b, i >> 11, i & 2047, 4096 + ch);
    for (int i = tid; i < 4096; i += NTHREADS) R[i] = bf2f(Rg[((size_t)0 * 2048 + ch) * 4096 + i]);
    __syncthreads();
    float zr[16];
#pragma unroll
    for (int q = 0; q < 16; ++q) {
      int i = tid + q * NTHREADS;
      int b = i >> 11, t = i & 2047;
      const float* ub = u + b * 2048;
      const float* Rb = R + 2048 - t;
      float a = 0.f;
      for (int s = 0; s < 2048; ++s) a += Rb[s] * ub[s];
      zr[q] = a * sconv(pp, p.hy_conv_w, p.hy_conv_b, b, t, ch);
    }
    __syncthreads();
#pragma unroll
    for (int q = 0; q < 16; ++q) u[tid + q * NTHREADS] = zr[q];
    for (int i = tid; i < 4096; i += NTHREADS) R[i] = bf2f(Rg[((size_t)1 * 2048 + ch) * 4096 + i]);
    __syncthreads();
#pragma unroll
    for (int q = 0; q < 16; ++q) {
      int i = tid + q * NTHREADS;
      int b = i >> 11, t = i & 2047;
      const float* ub = u + b * 2048;
      const float* Rb = R + 2048 - t;
      float a = 0.f;
      for (int s = 0; s < 2048; ++s) a += Rb[s] * ub[s];
      float y = a * sconv(pp, p.hy_conv_w, p.hy_conv_b, b, t, 2048 + ch);
      float g = bf2f(pp[(size_t)(b * 2048 + t) * 8192 + 6144 + ch]);
      yg[(size_t)(b * 2048 + t) * 2048 + ch] = f2bf(y * siluf(g));
    }
    __syncthreads();
  }
}


typedef float f32x16 __attribute__((ext_vector_type(16)));
typedef pg8::bf16x8 bfx8;
constexpr int CONV_RF_BYTES = 4 * 2 * 8192;
constexpr int CONV_PAD = 7;
constexpr int CONV_UB_ONE = 316 * 64;
__device__ __forceinline__ int ub_addr(int col, int chunk) { return col * 64 + ((chunk ^ ((col >> 2) & 3)) << 4); }

__device__ __forceinline__ void conv_mfma(const char* Rf_ci, const char* Ub_c, int lane, int jh, f32x16 (&acc)[4]) {
  const int t2 = lane & 31, h = lane >> 5, n = lane & 31;
  const int lanedw = ((2048 - t2 + 8 * h) >> 1) - 512 * jh;
#pragma unroll
  for (int j = 0; j < 4; ++j)
#pragma unroll
    for (int r = 0; r < 16; ++r) acc[j][r] = 0.f;
#pragma unroll 1
  for (int f = 0; f < 8; ++f) {
    bfx8 Bw[9][2];
#pragma unroll
    for (int m = 0; m < 9; ++m) {
      const int col = (8 * m - f + CONV_PAD) * 4 + n;
#pragma unroll
      for (int kh = 0; kh < 2; ++kh) Bw[m][kh] = *(const bfx8*)(Ub_c + ub_addr(col, 2 * kh + h));
    }
    const unsigned* Rp = (const unsigned*)(Rf_ci + ((t2 & 1) ? 8192 : 0)) + lanedw - 16 * f;
#pragma unroll
    for (int e = -8; e <= 3; ++e) {
      int ee = e;
      if (e == -8) ee = (f == 0) ? -7 : -8;
      bfx8 A[2];
#pragma unroll
      for (int kh = 0; kh < 2; ++kh) {
        const unsigned* q = Rp - 128 * ee + 8 * kh;
        pg8::u32x4 pk;
        pk[0] = q[0]; pk[1] = q[1]; pk[2] = q[2]; pk[3] = q[3];
        A[kh] = __builtin_bit_cast(bfx8, pk);
      }
#pragma unroll
      for (int j = 0; j < 4; ++j) {
        const int m = j - e;
        if (m >= 0 && m <= 8) acc[j] = __builtin_amdgcn_mfma_f32_32x32x16_bf16(A[0], Bw[m][0], acc[j], 0, 0, 0);
      }
#pragma unroll
      for (int j = 0; j < 4; ++j) {
        const int m = j - e;
        if (m >= 0 && m <= 8) acc[j] = __builtin_amdgcn_mfma_f32_32x32x16_bf16(A[1], Bw[m][1], acc[j], 0, 0, 0);
      }
    }
  }
}

__device__ __forceinline__ void sconv4(const u16* xp, int t, float w0, float w1, float w2, float cb, float (&o)[4]) {
  uint2 x4 = *(const uint2*)xp;
  float pv = t > 0 ? bf2f(xp[-1]) : 0.f;
  float nx = (t + 4 < 2048) ? bf2f(xp[4]) : 0.f;
  float e0 = bflo(x4.x), e1 = bfhi(x4.x), e2 = bflo(x4.y), e3 = bfhi(x4.y);
  o[0] = w0 * pv + w1 * e0 + w2 * e1 + cb;
  o[1] = w0 * e0 + w1 * e1 + w2 * e2 + cb;
  o[2] = w0 * e1 + w1 * e2 + w2 * e3 + cb;
  o[3] = w0 * e2 + w1 * e3 + w2 * nx + cb;
}

struct SC4 { uint2 x; unsigned pn; };
__device__ __forceinline__ SC4 sc4_load(const u16* xp, int t) {
  SC4 r;
  r.x = *(const uint2*)xp;
  const unsigned pv = t > 0 ? (unsigned)xp[-1] : 0u;
  const unsigned nx = (t + 4 < 2048) ? (unsigned)xp[4] : 0u;
  r.pn = pv | (nx << 16);
  return r;
}
__device__ __forceinline__ void sc4_apply(const SC4& r, float w0, float w1, float w2, float cb, float (&o)[4]) {
  const float pv = bflo(r.pn), nx = bfhi(r.pn);
  const float e0 = bflo(r.x.x), e1 = bfhi(r.x.x), e2 = bflo(r.x.y), e3 = bfhi(r.x.y);
  o[0] = w0 * pv + w1 * e0 + w2 * e1 + cb;
  o[1] = w0 * e0 + w1 * e1 + w2 * e2 + cb;
  o[2] = w0 * e1 + w1 * e2 + w2 * e3 + cb;
  o[3] = w0 * e2 + w1 * e3 + w2 * nx + cb;
}

__device__ __forceinline__ void phase_conv(const Params& p, float* smf) {
  char* sm = (char*)smf;
  char* Rf = sm;
  char* Ub = sm + CONV_RF_BYTES;
  int tid = threadIdx.x;
  asm volatile("" : "+v"(tid));
  const int wid = tid >> 6, lane = tid & 63;
  const int ci = wid >> 1, jh = wid & 1;
  const u16* pT = (const u16*)(p.ws + OFF_BIG);
  const u16* Rg = (const u16*)(p.ws + OFF_FILT);
  u16* yg = (u16*)(p.ws + OFF_ACT);
  for (int kk = 0; kk < (4 * CONV_UB_ONE / 16 + NTHREADS - 1) / NTHREADS; ++kk) { const int zi = tid + kk * NTHREADS; if (zi < 4 * CONV_UB_ONE / 16) ((uint4*)Ub)[zi] = make_uint4(0, 0, 0, 0); }
  __syncthreads();
  char* Ub_w = Ub + ci * CONV_UB_ONE;
  const char* Rf_ci = Rf + ci * 16384;
  const int h = lane >> 5, n = lane & 31;
  for (int it0 = blockIdx.x * 2; it0 < 512; it0 += gridDim.x * 2)
#pragma unroll 1
  for (int sub = 0; sub < 2; ++sub) {
    const int item = it0 + sub;
    const int ch0 = item * 4;
    {
      const int q = tid & 255, hb = tid >> 8;
      uint4 x8[8]; unsigned pn[8]; uint4 fr[4];
#pragma unroll
      for (int k = 0; k < 8; ++k) {
        const int cc = 4096 + ch0 + (k >> 1), b = (k & 1) * 2 + hb;
        const u16* xp = pT + (size_t)cc * 8192 + b * 2048 + q * 8;
        x8[k] = *(const uint4*)xp;
        const unsigned pv = q > 0 ? (unsigned)xp[-1] : 0u;
        const unsigned nx = q < 255 ? (unsigned)xp[8] : 0u;
        pn[k] = pv | (nx << 16);
      }
      unsigned fx[4];
#pragma unroll
      for (int k = 0; k < 4; ++k) {
        const unsigned* fp = (const unsigned*)(Rg + ((size_t)0 * 2048 + ch0 + k) * 4096);
        fr[k] = ((const uint4*)fp)[tid];
        fx[k] = tid < 511 ? fp[4 * tid + 4] : 0u;
      }
#pragma unroll
      for (int k = 0; k < 8; ++k) {
        const int c = k >> 1, cc = 4096 + ch0 + c, b = (k & 1) * 2 + hb;
        const float w0 = p.hy_conv_w[cc], w1 = p.hy_conv_w[6144 + cc], w2 = p.hy_conv_w[2 * 6144 + cc], cb = p.hy_conv_b[cc];
        float e[10];
        e[0] = bflo(pn[k]); e[1] = bflo(x8[k].x); e[2] = bfhi(x8[k].x); e[3] = bflo(x8[k].y); e[4] = bfhi(x8[k].y);
        e[5] = bflo(x8[k].z); e[6] = bfhi(x8[k].z); e[7] = bflo(x8[k].w); e[8] = bfhi(x8[k].w); e[9] = bfhi(pn[k]);
        unsigned o[4];
#pragma unroll
        for (int kk = 0; kk < 4; ++kk) {
          float a = w0 * e[2 * kk] + w1 * e[2 * kk + 1] + w2 * e[2 * kk + 2] + cb;
          float bb = w0 * e[2 * kk + 1] + w1 * e[2 * kk + 2] + w2 * e[2 * kk + 3] + cb;
          o[kk] = pk2(a, bb);
        }
        const int t0 = q * 8, s1 = t0 >> 5, s2 = t0 & 31;
        const int col = (s1 + CONV_PAD) * 4 + b;
        *(uint4*)(Ub + c * CONV_UB_ONE + ub_addr(col, s2 >> 3)) = make_uint4(o[0], o[1], o[2], o[3]);
      }
#pragma unroll
      for (int k = 0; k < 4; ++k) {
        ((uint4*)(Rf + k * 16384))[tid] = fr[k];
        ((uint4*)(Rf + k * 16384 + 8192))[tid] = make_uint4(__builtin_amdgcn_alignbit(fr[k].y, fr[k].x, 16), __builtin_amdgcn_alignbit(fr[k].z, fr[k].y, 16),
                                                             __builtin_amdgcn_alignbit(fr[k].w, fr[k].z, 16), __builtin_amdgcn_alignbit(fx[k], fr[k].w, 16));
      }
    }
    __syncthreads();
    f32x16 acc[4];
    const int ch = ch0 + ci;
    {
      conv_mfma(Rf_ci, Ub_w, lane, jh, acc);
      SC4 xr[16];
#pragma unroll
      for (int j = 0; j < 4; ++j)
#pragma unroll
        for (int vg = 0; vg < 4; ++vg) {
          const int t1 = 8 * (j + 4 * jh) + (n >> 2), b = n & 3, t = 32 * t1 + 8 * vg + 4 * h;
          xr[j * 4 + vg] = sc4_load(pT + (size_t)ch * 8192 + b * 2048 + t, t);
        }
      const unsigned* f1p = (const unsigned*)(Rg + ((size_t)1 * 2048 + ch0) * 4096);
      const uint4 f1a = ((const uint4*)(f1p + 0 * 2048))[tid];
      const uint4 f1b = ((const uint4*)(f1p + 1 * 2048))[tid];
      const uint4 f1c = ((const uint4*)(f1p + 2 * 2048))[tid];
      const uint4 f1d = ((const uint4*)(f1p + 3 * 2048))[tid];
      const unsigned x1a = tid < 511 ? f1p[0 * 2048 + 4 * tid + 4] : 0u, x1b = tid < 511 ? f1p[1 * 2048 + 4 * tid + 4] : 0u;
      const unsigned x1c = tid < 511 ? f1p[2 * 2048 + 4 * tid + 4] : 0u, x1d = tid < 511 ? f1p[3 * 2048 + 4 * tid + 4] : 0u;
      const float w0 = p.hy_conv_w[ch], w1 = p.hy_conv_w[6144 + ch], w2 = p.hy_conv_w[2 * 6144 + ch], cb = p.hy_conv_b[ch];
      __syncthreads();
#pragma unroll
      for (int j = 0; j < 4; ++j)
#pragma unroll
        for (int vg = 0; vg < 4; ++vg) {
          const int t1 = 8 * (j + 4 * jh) + (n >> 2), bl = n & 3;
          float x1[4];
          sc4_apply(xr[j * 4 + vg], w0, w1, w2, cb, x1);
          uint2 pk;
          pk.x = pk2(x1[0] * acc[j][4 * vg + 0], x1[1] * acc[j][4 * vg + 1]);
          pk.y = pk2(x1[2] * acc[j][4 * vg + 2], x1[3] * acc[j][4 * vg + 3]);
          const int col = (t1 + CONV_PAD) * 4 + bl;
          *(uint2*)(Ub_w + ub_addr(col, vg) + 8 * h) = pk;
        }
      __syncthreads();
#define CONV_PUT_F(K, F, X) do { ((uint4*)(Rf + (K) * 16384))[tid] = F; \
        ((uint4*)(Rf + (K) * 16384 + 8192))[tid] = make_uint4(__builtin_amdgcn_alignbit(F.y, F.x, 16), __builtin_amdgcn_alignbit(F.z, F.y, 16), \
                                                               __builtin_amdgcn_alignbit(F.w, F.z, 16), __builtin_amdgcn_alignbit(X, F.w, 16)); } while (0)
      CONV_PUT_F(0, f1a, x1a); CONV_PUT_F(1, f1b, x1b); CONV_PUT_F(2, f1c, x1c); CONV_PUT_F(3, f1d, x1d);
#undef CONV_PUT_F
    }
    __syncthreads();
    {
      const int c2 = 2048 + ch;
      SC4 xr[16]; uint2 gr[16];
      conv_mfma(Rf_ci, Ub_w, lane, jh, acc);
#pragma unroll
      for (int j = 0; j < 4; ++j)
#pragma unroll
        for (int vg = 0; vg < 4; ++vg) {
          const int t1 = 8 * (j + 4 * jh) + (n >> 2), b = n & 3, t = 32 * t1 + 8 * vg + 4 * h;
          xr[j * 4 + vg] = sc4_load(pT + (size_t)c2 * 8192 + b * 2048 + t, t);
          gr[j * 4 + vg] = *(const uint2*)(pT + (size_t)(6144 + ch) * 8192 + b * 2048 + t);
        }
      const float w0 = p.hy_conv_w[c2], w1 = p.hy_conv_w[6144 + c2], w2 = p.hy_conv_w[2 * 6144 + c2], cb = p.hy_conv_b[c2];
      __syncthreads();
#pragma unroll
      for (int j = 0; j < 4; ++j)
#pragma unroll
        for (int vg = 0; vg < 4; ++vg) {
          const int t1 = 8 * (j + 4 * jh) + (n >> 2), bl = n & 3;
          float x2[4];
          sc4_apply(xr[j * 4 + vg], w0, w1, w2, cb, x2);
          const uint2 g4 = gr[j * 4 + vg];
          float y0 = x2[0] * acc[j][4 * vg + 0] * siluf(bflo(g4.x));
          float y1 = x2[1] * acc[j][4 * vg + 1] * siluf(bfhi(g4.x));
          float y2 = x2[2] * acc[j][4 * vg + 2] * siluf(bflo(g4.y));
          float y3 = x2[3] * acc[j][4 * vg + 3] * siluf(bfhi(g4.y));
          uint2 pk;
          pk.x = pk2(y0, y1);
          pk.y = pk2(y2, y3);
          const int col = (t1 + CONV_PAD) * 4 + bl;
          *(uint2*)(Ub_w + ub_addr(col, vg) + 8 * h) = pk;
        }
    }
    __syncthreads();
    int tw = tid;
    asm volatile("" : "+v"(tw));
#pragma unroll 4
    for (int kk = 0; kk < 16; ++kk) {
      const int idx = tw + kk * NTHREADS;
      const int b = idx >> 11, t = idx & 2047;
      const int s1 = t >> 5, s2 = t & 31;
      const int col = (s1 + CONV_PAD) * 4 + b;
      const int a = ub_addr(col, s2 >> 3) + (s2 & 7) * 2;
      const char* base = Ub + a;
      unsigned v0 = *(const u16*)(base + 0 * CONV_UB_ONE), v1 = *(const u16*)(base + 1 * CONV_UB_ONE);
      unsigned v2 = *(const u16*)(base + 2 * CONV_UB_ONE), v3 = *(const u16*)(base + 3 * CONV_UB_ONE);
      const uint2 cur = make_uint2(v0 | (v1 << 16), v2 | (v3 << 16));
      *(uint2*)(yg + ((size_t)(item >> 1) * 8192 + idx) * 8 + (item & 1) * 4) = cur;
    }
    __syncthreads();
  }
}

constexpr int AT_KROW = 272, AT_VROW = 136;
constexpr int AT_K_BYTES = 64 * AT_KROW, AT_V_BYTES = 128 * AT_VROW;
__device__ __forceinline__ void phase_attn(const Params& p, float* smf) {
  char* sm = (char*)smf;
  char* Ks = sm;
  char* Vs = sm + AT_K_BYTES;
  const int tid = threadIdx.x, wid = tid >> 6, lane = tid & 63, r = lane & 31, h = lane >> 5;
  const u16* px = (const u16*)(p.ws + OFF_BIG);
  const u16* kvc = (const u16*)(p.ws + OFF_KVC);
  const u16* vT = (const u16*)(p.ws + OFF_VT);
  const u16* vcT = (const u16*)(p.ws + OFF_VCT);
  u16* og = (u16*)(p.ws + OFF_ACT);
  const float LOG2E = 1.4426950408889634f;
  const float sl2 = 0.08838834764831845f * LOG2E;
  for (int item = blockIdx.x; item < 512; item += gridDim.x) {
    const int hp = item & 1, kvh = (item >> 1) & 3, nblk = (item >> 3) & 15, b = item >> 7;
    const int hq = kvh * 4 + hp * 2 + (wid >> 2);
    const int qs = nblk * 128 + (wid & 3) * 32 + r;
    bfx8 Q[8];
    {
      const u16* qrow = px + (size_t)(b * 2048 + qs) * 5120 + hq * 128 + 8 * h;
#pragma unroll
      for (int st = 0; st < 8; ++st) Q[st] = *(const bfx8*)(qrow + 16 * st);
    }
    f32x16 O[4];
#pragma unroll
    for (int dt = 0; dt < 4; ++dt)
#pragma unroll
      for (int i = 0; i < 16; ++i) O[dt][i] = 0.f;
    float m = p.attn_sink[hq] * LOG2E;
    float l = (h == 0) ? 1.f : 0.f;
    const int first = (nblk == 0) ? 2 : 0, lastlocal = (nblk == 15) ? 3 : 5;
    uint4 kA0, kA1, vA0, vA1, kB0, kB1, vB0, vB1;
#define AT_LOAD_TILE(TI, K0, K1, V0, V1) do { \
      const int _ti = (TI); const bool _loc = _ti < 6; \
      const int _kpos0 = 128 * (nblk - 1) + 64 * _ti, _c0 = 64 * (_ti - 6); \
      const u16* _kb = _loc ? px + (size_t)(b * 2048 + _kpos0) * 5120 + 2048 + kvh * 128 : kvc + (size_t)(b * 256 + _c0) * 1024 + kvh * 128; \
      const size_t _ks = _loc ? 5120 : 1024; \
      const u16* _vb = _loc ? vT + (size_t)(kvh * 128) * 8192 + b * 2048 + _kpos0 : vcT + (size_t)(kvh * 128) * 1024 + b * 256 + _c0; \
      const size_t _vs = _loc ? 8192 : 1024; \
      const int _c1 = tid + NTHREADS; \
      K0 = *(const uint4*)(_kb + (size_t)(tid >> 4) * _ks + (tid & 15) * 8); \
      K1 = *(const uint4*)(_kb + (size_t)(_c1 >> 4) * _ks + (_c1 & 15) * 8); \
      V0 = *(const uint4*)(_vb + (size_t)(tid >> 3) * _vs + (tid & 7) * 8); \
      V1 = *(const uint4*)(_vb + (size_t)(_c1 >> 3) * _vs + (_c1 & 7) * 8); \
    } while (0)
#define AT_STORE_TILE(BO, K0, K1, V0, V1) do { \
      const int c1 = tid + NTHREADS; \
      *(uint4*)(Ks + (BO) + (tid >> 4) * AT_KROW + (tid & 15) * 16) = K0; \
      *(uint4*)(Ks + (BO) + (c1 >> 4) * AT_KROW + (c1 & 15) * 16) = K1; \
      char* v0p = Vs + (BO) + (tid >> 3) * AT_VROW + (tid & 7) * 16; \
      char* v1p = Vs + (BO) + (c1 >> 3) * AT_VROW + (c1 & 7) * 16; \
      *(uint2*)(v0p) = make_uint2(V0.x, V0.y); \
      *(uint2*)(v0p + 8) = make_uint2(V0.z, V0.w); \
      *(uint2*)(v1p) = make_uint2(V1.x, V1.y); \
      *(uint2*)(v1p + 8) = make_uint2(V1.z, V1.w); \
    } while (0)
#define AT_NX(T) ((T) >= 10 ? 10 : (((T) + 1 > lastlocal && (T) + 1 < 6) ? 6 : (T) + 1))
    constexpr int AT_BUF = AT_K_BYTES + AT_V_BYTES;
    int ti = first;
    int t1 = AT_NX(ti), t2 = AT_NX(t1);
    AT_LOAD_TILE(ti, kA0, kA1, vA0, vA1);
    if (t1 < 10) AT_LOAD_TILE(t1, kB0, kB1, vB0, vB1);
    AT_STORE_TILE(0, kA0, kA1, vA0, vA1);
    if (t2 < 10) AT_LOAD_TILE(t2, kA0, kA1, vA0, vA1);
    __syncthreads();
    while (true) {
#pragma unroll
     for (int half = 0; half < 2; ++half) {
      const int bo = half * AT_BUF;
      const int t3 = AT_NX(t2);
      if (t1 < 10) {
        if (half == 0) AT_STORE_TILE(AT_BUF, kB0, kB1, vB0, vB1); else AT_STORE_TILE(0, kA0, kA1, vA0, vA1);
        if (t3 < 10) { if (half == 0) AT_LOAD_TILE(t3, kB0, kB1, vB0, vB1); else AT_LOAD_TILE(t3, kA0, kA1, vA0, vA1); }
      }
      const int q0w = nblk * 128 + (wid & 3) * 32;
      const int kp0 = 128 * (nblk - 1) + 64 * ti;
      if (!(ti < 6 && (kp0 > q0w + 31 + 128 || kp0 + 63 < q0w - 128))) {
        const bool local = ti < 6;
        const int kpos0 = 128 * (nblk - 1) + 64 * ti;
        f32x16 S[2];
#pragma unroll
        for (int ks = 0; ks < 2; ++ks) {
#pragma unroll
          for (int i = 0; i < 16; ++i) S[ks][i] = 0.f;
#pragma unroll
          for (int st = 0; st < 8; ++st) {
            bfx8 A = *(const bfx8*)(Ks + bo + (ks * 32 + r) * AT_KROW + (16 * st + 8 * h) * 2);
            S[ks] = __builtin_amdgcn_mfma_f32_32x32x16_bf16(A, Q[st], S[ks], 0, 0, 0);
          }
        }
        const bool needmask = local && (kp0 > q0w + 65 || kp0 < q0w - 97);
        float mraw = -1e30f;
        if (needmask) {
          const int relb = kpos0 + 4 * h - qs;
#pragma unroll
          for (int ks = 0; ks < 2; ++ks)
#pragma unroll
            for (int i = 0; i < 16; ++i) {
              const int rel = relb + ks * 32 + (i & 3) + 8 * (i >> 2);
              float sv = S[ks][i];
              if (rel > 128 || rel < -128) sv = -1e30f;
              S[ks][i] = sv;
              mraw = fmaxf(mraw, sv);
            }
        } else {
#pragma unroll
          for (int ks = 0; ks < 2; ++ks)
#pragma unroll
            for (int i = 0; i < 16; ++i) mraw = fmaxf(mraw, S[ks][i]);
        }
        float mx = fmaxf(m, mraw * sl2);
        mx = fmaxf(mx, __shfl_xor(mx, 32, 64));
        if (__builtin_amdgcn_ballot_w64(mx != m) != 0ull) {
          const float alpha = __builtin_amdgcn_exp2f(m - mx);
          m = mx;
          l *= alpha;
#pragma unroll
          for (int dt = 0; dt < 4; ++dt)
#pragma unroll
            for (int i = 0; i < 16; ++i) O[dt][i] *= alpha;
        }
#pragma unroll
        for (int ks = 0; ks < 2; ++ks)
#pragma unroll
          for (int i = 0; i < 16; ++i) {
            float pv = __builtin_amdgcn_exp2f(__builtin_fmaf(S[ks][i], sl2, -m));
            l += pv;
            S[ks][i] = pv;
          }
#pragma unroll
        for (int s4 = 0; s4 < 4; ++s4) {
          const int ks = s4 >> 1, hf = s4 & 1;
          pg8::u32x4 pk;
#pragma unroll
          for (int j = 0; j < 4; ++j)
            pk[j] = pk2(S[ks][8 * hf + 2 * j], S[ks][8 * hf + 2 * j + 1]);
          bfx8 P = __builtin_bit_cast(bfx8, pk);
#pragma unroll
          for (int dt = 0; dt < 4; ++dt) {
            const char* vp = Vs + bo + (dt * 32 + r) * AT_VROW + (32 * ks + 16 * hf + 4 * h) * 2;
            uint2 v0 = *(const uint2*)vp, v1 = *(const uint2*)(vp + 16);
            pg8::u32x4 vv; vv[0] = v0.x; vv[1] = v0.y; vv[2] = v1.x; vv[3] = v1.y;
            O[dt] = __builtin_amdgcn_mfma_f32_32x32x16_bf16(__builtin_bit_cast(bfx8, vv), P, O[dt], 0, 0, 0);
          }
        }
      }
      __syncthreads();
      if (t1 >= 10) goto attn_done;
      ti = t1; t1 = t2; t2 = t3;
     }
    }
    attn_done:;
    const float ltot = l + __shfl_xor(l, 32, 64);
    const float inv = 1.f / ltot;
    const size_t tok = (size_t)(b * 2048 + qs);
#pragma unroll
    for (int dt = 0; dt < 4; ++dt)
#pragma unroll
      for (int g4 = 0; g4 < 4; ++g4) {
        const int d = dt * 32 + 8 * g4 + 4 * h;
        uint2 gg = *(const uint2*)(px + tok * 5120 + 3072 + hq * 128 + d);
        float o0 = O[dt][4 * g4 + 0] * inv * siluf(bflo(gg.x));
        float o1 = O[dt][4 * g4 + 1] * inv * siluf(bfhi(gg.x));
        float o2 = O[dt][4 * g4 + 2] * inv * siluf(bflo(gg.y));
        float o3 = O[dt][4 * g4 + 3] * inv * siluf(bfhi(gg.y));
        uint2 pk;
        pk.x = pk2(o0, o1);
        pk.y = pk2(o2, o3);
        *(uint2*)(og + tok * 2048 + hq * 128 + d) = pk;
      }
  }
}

#define XB_TMO      128
#define XB_XCNT(j)  (256  + 64 * (j))
#define XB_XSUB(j)  (1280 + 64 * (j))
#define XB_XGEN(j)  (2304 + 64 * (j))
#define XB_TOP      3328
#define XB_TOPGEN   3392
#define XCD_BAR_WORDS 3456
#define XB_SPIN_CAP (1u << 18)
#define LAS __attribute__((address_space(3)))

__device__ __forceinline__ unsigned xb_ld(unsigned* p)              { return __hip_atomic_load(p, __ATOMIC_RELAXED, __HIP_MEMORY_SCOPE_AGENT); }
__device__ __forceinline__ unsigned xb_add(unsigned* p, unsigned v) { return __hip_atomic_fetch_add(p, v, __ATOMIC_RELAXED, __HIP_MEMORY_SCOPE_AGENT); }
__device__ __forceinline__ unsigned xb_xcc_id() { return (unsigned)__builtin_amdgcn_s_getreg((3 << 11) | 20) & 0xFu; }
#define XB_SPIN(cond, bar) do { unsigned _sp = 0; while (cond) { __builtin_amdgcn_s_sleep(1); \
    if ((++_sp & 255u) == 0u) { if (xb_ld(&(bar)[XB_TMO])) break; if (_sp > XB_SPIN_CAP) { atomicAdd(&(bar)[XB_TMO], 1u); break; } } } } while (0)

struct XcdBarrier {
    unsigned* bar; unsigned x;
    volatile LAS unsigned* st;
};

__device__ __forceinline__ XcdBarrier xcd_barrier_post(unsigned* bar, volatile LAS unsigned* st) {
    XcdBarrier b; b.bar = bar; b.x = xb_xcc_id(); b.st = st;
    if (threadIdx.x == 0) (void)xb_add(&bar[XB_XCNT(b.x)], 1u);
    return b;
}
__device__ __forceinline__ void xcd_barrier_complete(unsigned* bar, unsigned x, unsigned& nloc, unsigned& nx) {
    const unsigned G = gridDim.x * gridDim.y * gridDim.z;
    unsigned sum, cnt, mine, sp = 0u;
    for (;;) {
        sum = 0u; cnt = 0u; mine = 0u;
#pragma unroll
        for (unsigned j = 0; j < 16; ++j) { const unsigned c = xb_ld(&bar[XB_XCNT(j)]); sum += c; cnt += (c > 0u) ? 1u : 0u; mine = (j == x) ? c : mine; }
        if (sum == G) break;
        __builtin_amdgcn_s_sleep(1);
        if ((++sp & 255u) == 0u) { if (xb_ld(&bar[XB_TMO])) break; if (sp > XB_SPIN_CAP) { atomicAdd(&bar[XB_TMO], 1u); break; } }
    }
    nloc = mine > 0u ? mine : 1u; nx = cnt > 0u ? cnt : 1u;
}

__device__ __forceinline__ void xcd_barrier(const XcdBarrier& b) {
    asm volatile("s_waitcnt vmcnt(0)" ::: "memory");
    __syncthreads();
    if (threadIdx.x == 0) {
        unsigned* bar = b.bar;
        __builtin_amdgcn_s_waitcnt(0);
        unsigned nloc = b.st[0], nx = b.st[1];
        if (nloc == 0u) { xcd_barrier_complete(bar, b.x, nloc, nx); b.st[0] = nloc; b.st[1] = nx; }
        const unsigned old = xb_add(&bar[XB_XSUB(b.x)], 1u);
        const unsigned gen = old / nloc;
        if (old + 1u == (gen + 1u) * nloc) {
            __builtin_amdgcn_fence(__ATOMIC_RELEASE, "agent");
            asm volatile("s_waitcnt vmcnt(0)" ::: "memory");
            const unsigned og = xb_add(&bar[XB_TOP], 1u);
            const unsigned tg = og / nx;
            if (og + 1u == (tg + 1u) * nx) xb_add(&bar[XB_TOPGEN], 1u);
            else XB_SPIN(xb_ld(&bar[XB_TOPGEN]) == tg, bar);
            __builtin_amdgcn_fence(__ATOMIC_ACQUIRE, "agent");
            xb_add(&bar[XB_XGEN(b.x)], 1u);
            asm volatile("s_waitcnt vmcnt(0)" ::: "memory");
        } else {
            XB_SPIN(xb_ld(&bar[XB_XGEN(b.x)]) == gen, bar);
            __builtin_amdgcn_fence(__ATOMIC_ACQUIRE, "agent");
            asm volatile("s_waitcnt vmcnt(0)" ::: "memory");
        }
    }
    __syncthreads();
}


constexpr int N_PHASES = 9;
__global__ void __launch_bounds__(NTHREADS, 2) mega(Params p, int ph0, int ph1) {
  extern __shared__ __attribute__((aligned(16))) float sm[];
  volatile LAS unsigned* xb_st = (volatile LAS unsigned*)((LAS unsigned char*)sm + 162816);
  if (threadIdx.x < 4) xb_st[threadIdx.x] = 0u;
  __syncthreads();
  const XcdBarrier xb = xcd_barrier_post((unsigned*)(p.ws + OFF_BAR), xb_st);
#define PH(i, body) if (ph0 <= (i) && (i) < ph1) { body; if ((i) + 1 < ph1) xcd_barrier(xb); }
  if (ph0 < 0) cg::this_grid().sync();
  PH(0, phase0(p, sm))
  PH(1, phase_norm(p, 0))
  PH(2, run_gemm(sm, (const u16*)(p.ws + OFF_ACT), (const u16*)(p.ws + OFF_WT_AI), MT, ATTN_IN,
                 EpiAttnIn{(u16*)(p.ws + OFF_BIG), (const float*)(p.ws + OFF_ROPE)}, (int)blockIdx.x);
        run_gemm(sm, (const u16*)(p.ws + OFF_HC), (const u16*)(p.ws + OFF_WT_AI) + (size_t)2048 * 2048, MC, 1024,
                 EpiRaw{(u16*)(p.ws + OFF_KVC), 1024}, (int)((blockIdx.x + 64) % gridDim.x));
        run_gemm(sm, (const u16*)(p.ws + OFF_WT_AI) + (size_t)2560 * 2048, (const u16*)(p.ws + OFF_ACT), 512, MT,
                 EpiRaw{(u16*)(p.ws + OFF_VT), 8192}, (int)((blockIdx.x + 128) % gridDim.x));
        run_gemm(sm, (const u16*)(p.ws + OFF_WT_AI) + (size_t)2560 * 2048, (const u16*)(p.ws + OFF_HC), 512, MC,
                 EpiRaw{(u16*)(p.ws + OFF_VCT), 1024}, (int)((blockIdx.x + 48) % gridDim.x)))
  PH(3, phase_attn(p, sm))
  PH(4, run_gemm(sm, (const u16*)(p.ws + OFF_ACT), (const u16*)(p.ws + OFF_WT_AO), MT, 2048,
                 EpiResNorm{p.out, p.x, (const float*)(p.ws + OFF_MOD) + 4096, (float*)(p.ws + OFF_ROWSS), (unsigned*)(p.ws + OFF_PCNT),
                            p.norm_g + 2048, (const float*)(p.ws + OFF_MOD) + 5 * 6144, (u16*)(p.ws + OFF_ACT)}, (int)blockIdx.x))
  PH(6, run_gemm(sm, (const u16*)(p.ws + OFF_WT_HI), (const u16*)(p.ws + OFF_ACT), HY_IN, MT,
                 EpiRaw{(u16*)(p.ws + OFF_BIG), 8192}, (int)blockIdx.x))
  PH(7, phase_conv(p, sm))
  PH(8, (run_gemm<EpiResNorm, true>(sm, (const u16*)(p.ws + OFF_ACT), (const u16*)(p.ws + OFF_WT_HO), MT, 2048,
                 EpiResNorm{p.out, p.out, (const float*)(p.ws + OFF_MOD) + 5 * 6144 + 4096, (float*)(p.ws + OFF_ROWSS) + 8192,
                            (unsigned*)(p.ws + OFF_PCNT) + 32 * 64, p.final_g, nullptr, nullptr}, (int)blockIdx.x)))
}

extern "C" void kernel_launch(void* const* d_in, const int* in_sizes, int n_in, void* d_out, int out_size,
                              void* d_ws, size_t ws_size, hipStream_t stream) {
  Params p{};
  const float** f = (const float**)&p;
  for (int i = 0; i < 23; ++i) f[i] = (const float*)d_in[i];
  p.out = (float*)d_out;
  p.ws = (char*)d_ws;
  constexpr size_t kLds = 162816 + 16;
  static int grid_blocks = 0;
  if (!grid_blocks) {
    (void)hipFuncSetAttribute((const void*)mega, hipFuncAttributeMaxDynamicSharedMemorySize, (int)kLds);
    int dev = 0, cus = 0, per_cu = 0;
    (void)hipGetDevice(&dev);
    (void)hipDeviceGetAttribute(&cus, hipDeviceAttributeMultiprocessorCount, dev);
    (void)hipOccupancyMaxActiveBlocksPerMultiprocessor(&per_cu, mega, NTHREADS, kLds);
    if (per_cu < 1) per_cu = 1;
    grid_blocks = cus * per_cu;
  }
  (void)hipMemsetAsync((char*)d_ws + OFF_BAR, 0, ZERO_BYTES, stream);
  int ph0 = 0, ph1 = N_PHASES;
  void* args[] = {(void*)&p, (void*)&ph0, (void*)&ph1};
  hipError_t e = hipLaunchCooperativeKernel((const void*)mega, dim3(grid_blocks), dim3(NTHREADS), args, kLds, stream);
  if (e != hipSuccess) fprintf(stderr, "cooperative launch failed: %s (grid %d)\n", hipGetErrorString(e), grid_blocks);
}
```
